# Optimizing an MI355X kernel written in HIP

```python
import math
import jax, jax.numpy as jnp
from jax import lax
import numpy as np

D_MODEL = 1024
BATCH = 32
SEQ = 2048
DEPTH = 2

N_MIXERS = 2
ROPE_THETA = 10000.0
EPS = 1e-6
Q_BLOCK = 128
NEG_INF = -1e30
MAX_POS_OFFSET = 1024
DA_HEAD_DIM = 64
DA_HEADS = D_MODEL // (2 * DA_HEAD_DIM)
MLA_HEADS = 16
MLA_NOPE = 64
MLA_ROPE = 32
MLA_V = 64
MLA_Q_RANK = 384
MLA_KV_RANK = 256
N_GROUPS = 4
EXPERTS_PER_GROUP = 8
TOP_K = 2
EXPERT_FF = 256

kernel_name = "hybrid_diffattn_mla_hmoe_adaln"


def rms_norm(x, g):
    xf = x.astype(jnp.float32)
    y = xf * lax.rsqrt(jnp.mean(xf * xf, axis=-1, keepdims=True) + EPS)
    return (y * g.astype(jnp.float32)).astype(x.dtype)


def rope_tables(positions, dim):
    inv_freq = ROPE_THETA ** (-jnp.arange(0, dim, 2, dtype=jnp.float32) / dim)
    ang = positions.astype(jnp.float32)[..., None] * inv_freq
    return jnp.cos(ang), jnp.sin(ang)


def apply_rope(x, cos, sin):
    extra = x.ndim - 3
    shp = cos.shape[:2] + (1,) * extra + cos.shape[-1:]
    cos = cos.reshape(shp)
    sin = sin.reshape(shp)
    xf = x.astype(jnp.float32)
    x1, x2 = jnp.split(xf, 2, axis=-1)
    return jnp.concatenate([x1 * cos - x2 * sin, x2 * cos + x1 * sin], axis=-1).astype(x.dtype)


def modulate(x, shift, scale):
    return x * (1.0 + scale[:, None, :]) + shift[:, None, :]


def causal_mask(start, q_len, k_len):
    qpos = start + jnp.arange(q_len)
    kpos = jnp.arange(k_len)
    return kpos[None, :] <= qpos[:, None]


def diff_attention(h, cos, sin, w_qkv, q_norm, k_norm, lq1, lk1, lq2, lk2, subln, w_o, lambda_init):
    B, S, _ = h.shape
    H, dh = DA_HEADS, DA_HEAD_DIM
    q, k, v = jnp.split(h @ w_qkv, 3, axis=-1)
    q = q.reshape(B, S, H, 2, dh)
    k = k.reshape(B, S, H, 2, dh)
    v = v.reshape(B, S, H, 2 * dh)
    q = apply_rope(rms_norm(q, q_norm), cos, sin)
    k = apply_rope(rms_norm(k, k_norm), cos, sin)
    lam = (jnp.exp(jnp.sum(lq1.astype(jnp.float32) * lk1.astype(jnp.float32)))
           - jnp.exp(jnp.sum(lq2.astype(jnp.float32) * lk2.astype(jnp.float32))) + lambda_init)
    scale = dh ** -0.5
    outs = []
    for j in range(S // Q_BLOCK):
        s0 = j * Q_BLOCK
        L = s0 + Q_BLOCK
        s = jnp.einsum('bqhcd,bkhcd->bhcqk', q[:, s0:L], k[:, :L],
                       preferred_element_type=jnp.float32) * scale
        p = jax.nn.softmax(jnp.where(causal_mask(s0, Q_BLOCK, L), s, NEG_INF), axis=-1)
        a = p[:, :, 0] - lam * p[:, :, 1]
        outs.append(jnp.einsum('bhqk,bkhd->bqhd', a.astype(v.dtype), v[:, :L]))
    o = jnp.concatenate(outs, axis=1)
    o = rms_norm(o, subln) * (1.0 - lambda_init)
    return o.reshape(B, S, H * 2 * dh) @ w_o


def mla_attention(h, cos, sin, w_in, q_a_norm, kv_a_norm, w_uq, w_ukv,
                  q_nope_norm, q_pe_norm, k_nope_norm, k_pe_norm, w_o):
    B, S, _ = h.shape
    H = MLA_HEADS
    lat = h @ w_in
    cq = lat[..., :MLA_Q_RANK]
    ckv = lat[..., MLA_Q_RANK:MLA_Q_RANK + MLA_KV_RANK]
    k_pe = lat[..., MLA_Q_RANK + MLA_KV_RANK:]
    q = (rms_norm(cq, q_a_norm) @ w_uq).reshape(B, S, H, MLA_NOPE + MLA_ROPE)
    kv = (rms_norm(ckv, kv_a_norm) @ w_ukv).reshape(B, S, H, MLA_NOPE + MLA_V)
    q_nope = rms_norm(q[..., :MLA_NOPE], q_nope_norm)
    q_pe = apply_rope(rms_norm(q[..., MLA_NOPE:], q_pe_norm), cos, sin)
    k_nope = rms_norm(kv[..., :MLA_NOPE], k_nope_norm)
    v = kv[..., MLA_NOPE:]
    k_pe = apply_rope(rms_norm(k_pe, k_pe_norm), cos, sin)
    scale = (MLA_NOPE + MLA_ROPE) ** -0.5
    outs = []
    for j in range(S // Q_BLOCK):
        s0 = j * Q_BLOCK
        L = s0 + Q_BLOCK
        s = (jnp.einsum('bqhd,bkhd->bhqk', q_nope[:, s0:L], k_nope[:, :L], preferred_element_type=jnp.float32)
             + jnp.einsum('bqhr,bkr->bhqk', q_pe[:, s0:L], k_pe[:, :L], preferred_element_type=jnp.float32)) * scale
        p = jax.nn.softmax(jnp.where(causal_mask(s0, Q_BLOCK, L), s, NEG_INF), axis=-1)
        outs.append(jnp.einsum('bhqk,bkhd->bqhd', p.astype(v.dtype), v[:, :L]))
    o = jnp.concatenate(outs, axis=1)
    return o.reshape(B, S, H * MLA_V) @ w_o


def hier_moe(h, w_group, b_group, w_router, b_router, w1, w3, w2):
    B, S, D = h.shape
    G, E = N_GROUPS, EXPERTS_PER_GROUP
    t = h.reshape(B * S, D)
    g_prob = jax.nn.softmax((t @ w_group).astype(jnp.float32), axis=-1)
    g_idx = jnp.argmax(g_prob + b_group.astype(jnp.float32), axis=-1)
    g_gate = jnp.take_along_axis(g_prob, g_idx[:, None], axis=1)
    e_logit = (t @ w_router).astype(jnp.float32).reshape(-1, G, E)
    e_logit = jnp.take_along_axis(e_logit, g_idx[:, None, None], axis=1)[:, 0]
    e_prob = jax.nn.softmax(e_logit, axis=-1)
    _, e_idx = lax.top_k(e_prob + b_router.astype(jnp.float32)[g_idx], TOP_K)
    e_w = jnp.take_along_axis(e_prob, e_idx, axis=1)
    e_w = e_w / jnp.sum(e_w, axis=-1, keepdims=True) * g_gate
    within = jnp.einsum('nk,nke->ne', e_w, jax.nn.one_hot(e_idx, E, dtype=jnp.float32))
    combine = (jax.nn.one_hot(g_idx, G, dtype=jnp.float32)[:, :, None] * within[:, None, :]).astype(t.dtype)
    out = jnp.zeros_like(t)
    for g in range(G):
        a = jnp.einsum('nd,edf->nef', t, w1[g])
        b = jnp.einsum('nd,edf->nef', t, w3[g])
        hid = jax.nn.silu(a) * b * combine[:, g, :, None]
        out = out + jnp.einsum('nef,efd->nd', hid, w2[g])
    return out.reshape(B, S, D)


def setup_inputs(seed: int = 0) -> dict:
    key = jax.random.key(seed)
    ks = iter(jax.random.split(key, 40))
    f32 = jnp.float32
    D = D_MODEL
    n_da = (DEPTH + 1) // 2
    n_mla = DEPTH // 2
    G, E, F = N_GROUPS, EXPERTS_PER_GROUP, EXPERT_FF

    def nrm(shape, scale):
        return jax.random.normal(next(ks), shape, f32) * scale

    def gain(shape):
        return 1.0 + 0.02 * jax.random.normal(next(ks), shape, f32)

    x = nrm((BATCH, SEQ, D), 1.0)
    c = nrm((BATCH, D), 1.0)
    offset = jax.random.randint(next(ks), (BATCH, 1), 0, MAX_POS_OFFSET, dtype=jnp.int32)
    positions = (offset + jnp.arange(SEQ, dtype=jnp.int32)[None, :]).astype(jnp.int32)
    qk_mla = MLA_NOPE + MLA_ROPE
    return {
        "x": x,
        "c": c,
        "positions": positions,
        "ada_w": nrm((DEPTH, D, 6 * D), 0.5 * D ** -0.5),
        "ada_b": nrm((DEPTH, 6 * D), 0.02),
        "norm_mix": gain((DEPTH, D)),
        "norm_ffn": gain((DEPTH, D)),
        "da_w_qkv": nrm((n_da, D, 3 * D), D ** -0.5),
        "da_q_norm": gain((n_da, DA_HEAD_DIM)),
        "da_k_norm": gain((n_da, DA_HEAD_DIM)),
        "da_lambda_q1": nrm((n_da, DA_HEAD_DIM), 0.1),
        "da_lambda_k1": nrm((n_da, DA_HEAD_DIM), 0.1),
        "da_lambda_q2": nrm((n_da, DA_HEAD_DIM), 0.1),
        "da_lambda_k2": nrm((n_da, DA_HEAD_DIM), 0.1),
        "da_subln": gain((n_da, 2 * DA_HEAD_DIM)),
        "da_w_o": nrm((n_da, D, D), D ** -0.5),
        "mla_w_in": nrm((n_mla, D, MLA_Q_RANK + MLA_KV_RANK + MLA_ROPE), D ** -0.5),
        "mla_q_a_norm": gain((n_mla, MLA_Q_RANK)),
        "mla_kv_a_norm": gain((n_mla, MLA_KV_RANK)),
        "mla_w_uq": nrm((n_mla, MLA_Q_RANK, MLA_HEADS * qk_mla), MLA_Q_RANK ** -0.5),
        "mla_w_ukv": nrm((n_mla, MLA_KV_RANK, MLA_HEADS * (MLA_NOPE + MLA_V)), MLA_KV_RANK ** -0.5),
        "mla_q_nope_norm": gain((n_mla, MLA_NOPE)),
        "mla_q_pe_norm": gain((n_mla, MLA_ROPE)),
        "mla_k_nope_norm": gain((n_mla, MLA_NOPE)),
        "mla_k_pe_norm": gain((n_mla, MLA_ROPE)),
        "mla_w_o": nrm((n_mla, MLA_HEADS * MLA_V, D), (MLA_HEADS * MLA_V) ** -0.5),
        "moe_w_group": nrm((DEPTH, D, G), D ** -0.5),
        "moe_b_group": nrm((DEPTH, G), 0.01),
        "moe_w_router": nrm((DEPTH, D, G * E), D ** -0.5),
        "moe_b_router": nrm((DEPTH, G, E), 0.01),
        "moe_w1": nrm((DEPTH, G, E, D, F), D ** -0.5),
        "moe_w3": nrm((DEPTH, G, E, D, F), D ** -0.5),
        "moe_w2": nrm((DEPTH, G, E, F, D), F ** -0.5),
    }


def reference(x, c, positions, ada_w, ada_b, norm_mix, norm_ffn,
              da_w_qkv, da_q_norm, da_k_norm, da_lambda_q1, da_lambda_k1, da_lambda_q2, da_lambda_k2,
              da_subln, da_w_o,
              mla_w_in, mla_q_a_norm, mla_kv_a_norm, mla_w_uq, mla_w_ukv,
              mla_q_nope_norm, mla_q_pe_norm, mla_k_nope_norm, mla_k_pe_norm, mla_w_o,
              moe_w_group, moe_b_group, moe_w_router, moe_b_router, moe_w1, moe_w3, moe_w2):
    cos_da, sin_da = rope_tables(positions, DA_HEAD_DIM)
    cos_mla, sin_mla = rope_tables(positions, MLA_ROPE)
    cond = jax.nn.silu(c)
    for i in range(DEPTH):
        mod = cond @ ada_w[i] + ada_b[i]
        sh_m, sc_m, g_m, sh_f, sc_f, g_f = jnp.split(mod, 6, axis=-1)
        h = modulate(rms_norm(x, norm_mix[i]), sh_m, sc_m)
        j = i // N_MIXERS
        if i % N_MIXERS == 0:
            lambda_init = 0.8 - 0.6 * math.exp(-0.3 * i)
            y = diff_attention(h, cos_da, sin_da, da_w_qkv[j], da_q_norm[j], da_k_norm[j],
                               da_lambda_q1[j], da_lambda_k1[j], da_lambda_q2[j], da_lambda_k2[j],
                               da_subln[j], da_w_o[j], lambda_init)
        else:
            y = mla_attention(h, cos_mla, sin_mla, mla_w_in[j], mla_q_a_norm[j], mla_kv_a_norm[j],
                              mla_w_uq[j], mla_w_ukv[j], mla_q_nope_norm[j], mla_q_pe_norm[j],
                              mla_k_nope_norm[j], mla_k_pe_norm[j], mla_w_o[j])
        x = x + g_m[:, None, :] * y
        h = modulate(rms_norm(x, norm_ffn[i]), sh_f, sc_f)
        x = x + g_f[:, None, :] * hier_moe(h, moe_w_group[i], moe_b_group[i], moe_w_router[i],
                                           moe_b_router[i], moe_w1[i], moe_w3[i], moe_w2[i])
    return x
```

```cpp
#include <hip/hip_runtime.h>
#include <cstdio>
#include <cstdint>

#define LAS __attribute__((address_space(3)))
typedef unsigned short bf16;
typedef float f32x4 __attribute__((ext_vector_type(4)));
typedef unsigned u32x4 __attribute__((ext_vector_type(4)));
typedef unsigned u32x2 __attribute__((ext_vector_type(2)));

constexpr int NB = 32, SEQ = 2048, D = 1024, NTOK = NB * SEQ;
constexpr float EPS = 1e-6f;
constexpr int NWAVES = 8, NTHR = 512;
constexpr int N_PHASES = 21;
#ifndef MK_ONE_LAUNCH
#define MK_ONE_LAUNCH 0
#endif

constexpr size_t MiB = 1u << 20;
constexpr size_t WS_CTL = 0, CTL_ZERO_BYTES = 1 * MiB;
constexpr size_t WS_MOD = 1 * MiB;
constexpr size_t WS_LAM = WS_MOD + 7 * MiB / 4;
constexpr size_t WS_MODP = 3 * MiB;
constexpr size_t WS_COSD = 16 * MiB, WS_SIND = 24 * MiB, WS_COSM = 32 * MiB, WS_SINM = 36 * MiB;
constexpr size_t WS_TOKW = 40 * MiB;
constexpr size_t WS_LIST = 42 * MiB;
constexpr size_t WS_WB = 50 * MiB;
constexpr size_t WS_H = 176 * MiB;
constexpr size_t WS_O = 304 * MiB;
constexpr size_t WS_A = 432 * MiB;
constexpr size_t WS_S = 880 * MiB;
constexpr size_t WS_END = 964 * MiB;
constexpr int CW_BAR = 4096;
constexpr int CW_CNT = 16384;
constexpr int HID_ROWS = 2 * NTOK + 32 * 128;

constexpr int LDS_BYTES = 147456;
constexpr int MISC_OFF = 131072 + 320;

__device__ __forceinline__ unsigned f2bf(float f) { unsigned u = __builtin_bit_cast(unsigned, f); return (u + 0x7fffu + ((u >> 16) & 1u)) >> 16; }
__device__ __forceinline__ float bf2f(unsigned h) { return __builtin_bit_cast(float, h << 16); }
__device__ __forceinline__ unsigned pk2(float lo, float hi) { return f2bf(lo) | (f2bf(hi) << 16); }
__device__ __forceinline__ float wave_sum(float v) {
#pragma unroll
    for (int o = 1; o < 64; o <<= 1) v += __shfl_xor(v, o);
    return v;
}
__device__ __forceinline__ float wave_max(float v) {
#pragma unroll
    for (int o = 1; o < 64; o <<= 1) v = fmaxf(v, __shfl_xor(v, o));
    return v;
}

#define XB_TMO      128
#define XB_XCNT(j)  (256  + 64 * (j))
#define XB_XSUB(j)  (1280 + 64 * (j))
#define XB_XGEN(j)  (2304 + 64 * (j))
#define XB_TOP      3328
#define XB_TOPGEN   3392
#define XCD_BAR_WORDS 3456
#define XB_SPIN_CAP (1u << 20)
__device__ __forceinline__ unsigned xb_ld(unsigned* p)              { return __hip_atomic_load(p, __ATOMIC_RELAXED, __HIP_MEMORY_SCOPE_AGENT); }
__device__ __forceinline__ unsigned xb_add(unsigned* p, unsigned v) { return __hip_atomic_fetch_add(p, v, __ATOMIC_RELAXED, __HIP_MEMORY_SCOPE_AGENT); }
__device__ __forceinline__ unsigned xb_xcc_id() { return (unsigned)__builtin_amdgcn_s_getreg((3 << 11) | 20) & 0xFu; }
#define XB_SPIN(cond, bar) do { unsigned _sp = 0; while (cond) { __builtin_amdgcn_s_sleep(1); \
    if ((++_sp & 255u) == 0u) { if (xb_ld(&(bar)[XB_TMO])) break; if (_sp > XB_SPIN_CAP) { atomicAdd(&(bar)[XB_TMO], 1u); break; } } } } while (0)
struct XcdBarrier { unsigned* bar; unsigned x; volatile LAS unsigned* st; };
__device__ __forceinline__ XcdBarrier xcd_barrier_post(unsigned* bar, volatile LAS unsigned* st) {
    XcdBarrier b; b.bar = bar; b.x = xb_xcc_id(); b.st = st;
    if (threadIdx.x == 0) (void)xb_add(&bar[XB_XCNT(b.x)], 1u);
    return b;
}
__device__ __forceinline__ void xcd_barrier_complete(unsigned* bar, unsigned x, unsigned& nloc, unsigned& nx) {
    const unsigned G = gridDim.x * gridDim.y * gridDim.z;
    unsigned sum, cnt, mine, sp = 0u;
    for (;;) {
        sum = 0u; cnt = 0u; mine = 0u;
#pragma unroll
        for (unsigned j = 0; j < 16; ++j) { const unsigned c = xb_ld(&bar[XB_XCNT(j)]); sum += c; cnt += (c > 0u) ? 1u : 0u; mine = (j == x) ? c : mine; }
        if (sum == G) break;
        __builtin_amdgcn_s_sleep(1);
        if ((++sp & 255u) == 0u) { if (xb_ld(&bar[XB_TMO])) break; if (sp > XB_SPIN_CAP) { atomicAdd(&bar[XB_TMO], 1u); break; } }
    }
    nloc = mine > 0u ? mine : 1u; nx = cnt > 0u ? cnt : 1u;
}
__device__ __forceinline__ void xcd_barrier(const XcdBarrier& b) {
    asm volatile("s_waitcnt vmcnt(0)" ::: "memory");
    __syncthreads();
    if (threadIdx.x == 0) {
        unsigned* bar = b.bar;
        __builtin_amdgcn_s_waitcnt(0);
        unsigned nloc = b.st[0], nx = b.st[1];
        if (nloc == 0u) { xcd_barrier_complete(bar, b.x, nloc, nx); b.st[0] = nloc; b.st[1] = nx; }
        const unsigned old = xb_add(&bar[XB_XSUB(b.x)], 1u);
        const unsigned gen = old / nloc;
        if (old + 1u == (gen + 1u) * nloc) {
            __builtin_amdgcn_fence(__ATOMIC_RELEASE, "agent");
            asm volatile("s_waitcnt vmcnt(0)" ::: "memory");
            const unsigned og = xb_add(&bar[XB_TOP], 1u);
            const unsigned tg = og / nx;
            if (og + 1u == (tg + 1u) * nx) xb_add(&bar[XB_TOPGEN], 1u);
            else XB_SPIN(xb_ld(&bar[XB_TOPGEN]) == tg, bar);
            __builtin_amdgcn_fence(__ATOMIC_ACQUIRE, "agent");
            xb_add(&bar[XB_XGEN(b.x)], 1u);
            asm volatile("s_waitcnt vmcnt(0)" ::: "memory");
        } else {
            XB_SPIN(xb_ld(&bar[XB_XGEN(b.x)]) == gen, bar);
            __builtin_amdgcn_fence(__ATOMIC_ACQUIRE, "agent");
            asm volatile("s_waitcnt vmcnt(0)" ::: "memory");
        }
    }
    __syncthreads();
}

struct Args { const float* in[33]; float* out; unsigned char* ws; int ph_lo, ph_hi; };
enum { I_X = 0, I_C, I_POS, I_ADAW, I_ADAB, I_NMIX, I_NFFN, I_DA_WQKV, I_DA_QN, I_DA_KN, I_DA_LQ1, I_DA_LK1, I_DA_LQ2, I_DA_LK2,
       I_DA_SUBLN, I_DA_WO, I_M_WIN, I_M_QAN, I_M_KVAN, I_M_WUQ, I_M_WUKV, I_M_QNN, I_M_QPN, I_M_KNN, I_M_KPN, I_M_WO,
       I_E_WG, I_E_BG, I_E_WR, I_E_BR, I_E_W1, I_E_W3, I_E_W2 };

template <bool DUAL, class Epi>
__device__ __forceinline__ void ngemm_tile(float* As, float* Ws, float* W2s, const bf16* A, int lda, const int* rows,
                                           const float* W, const float* W2, int ldw, int K, int col0, const Epi& epi, int tid) {
    f32x4 acc[4], acc2[4];
#pragma unroll
    for (int i = 0; i < 4; ++i) { acc[i] = (f32x4){0.f, 0.f, 0.f, 0.f}; acc2[i] = (f32x4){0.f, 0.f, 0.f, 0.f}; }
    const int ar = tid >> 2, akq = tid & 3, wk = tid >> 4, wc4 = tid & 15, ty = tid >> 4, tx = tid & 15;
    const bf16* arow = A + (size_t)rows[ar] * lda + akq * 8;
    for (int k0 = 0; k0 < K; k0 += 32) {
        const u32x4 av = *(const u32x4*)(arow + k0);
        const f32x4 wv = *(const f32x4*)(W + (size_t)(k0 + wk) * ldw + col0 + wc4 * 4);
        f32x4 wv2 = (f32x4){0.f, 0.f, 0.f, 0.f};
        if (DUAL) wv2 = *(const f32x4*)(W2 + (size_t)(k0 + wk) * ldw + col0 + wc4 * 4);
        __syncthreads();
#pragma unroll
        for (int i = 0; i < 4; ++i) {
            As[(akq * 8 + 2 * i) * 132 + ar] = bf2f(av[i] & 0xffffu);
            As[(akq * 8 + 2 * i + 1) * 132 + ar] = bf2f(av[i] >> 16);
        }
        *(f32x4*)(Ws + wk * 64 + wc4 * 4) = wv;
        if (DUAL) *(f32x4*)(W2s + wk * 64 + wc4 * 4) = wv2;
        __syncthreads();
#pragma unroll 8
        for (int k = 0; k < 32; ++k) {
            const f32x4 a4 = *(const f32x4*)(As + k * 132 + ty * 4);
            const f32x4 w4 = *(const f32x4*)(Ws + k * 64 + tx * 4);
#pragma unroll
            for (int i = 0; i < 4; ++i) acc[i] += a4[i] * w4;
            if (DUAL) {
                const f32x4 v4 = *(const f32x4*)(W2s + k * 64 + tx * 4);
#pragma unroll
                for (int i = 0; i < 4; ++i) acc2[i] += a4[i] * v4;
            }
        }
    }
#pragma unroll
    for (int i = 0; i < 4; ++i) epi(ty * 4 + i, tx * 4, acc[i], acc2[i]);
}

__device__ __forceinline__ void ngemm_phase(unsigned char* lds, const bf16* A, int lda, const float* W, int ldw, int K, int M, int N, bf16* C, int ldc) {
    float* As = (float*)lds; float* Ws = As + 32 * 132; int* rows = (int*)(Ws + 2 * 32 * 64);
    const int tid = threadIdx.x; const int nct = N / 64, ntiles = (M / 128) * nct;
    for (int t = blockIdx.x; t < ntiles; t += gridDim.x) {
        const int rt = t / nct, ct = t % nct, row0 = rt * 128, col0 = ct * 64;
        __syncthreads();
        if (tid < 128) rows[tid] = row0 + tid;
        __syncthreads();
        auto epi = [&](int r, int c, f32x4 a, f32x4) {
            u32x2 o; o.x = pk2(a[0], a[1]); o.y = pk2(a[2], a[3]);
            *(u32x2*)(C + (size_t)(row0 + r) * ldc + col0 + c) = o;
        };
        ngemm_tile<false>(As, Ws, Ws + 32 * 64, A, lda, rows, W, nullptr, ldw, K, col0, epi, tid);
    }
}

struct Ctx {
    const float* const* in; float* out; unsigned char* ws; unsigned char* lds;
    int tid, lane, wave, gw, ngw;
    __device__ __forceinline__ const float* mod(int layer, int b, int chunk) const { return (const float*)(ws + WS_MOD) + ((size_t)(layer * NB + b) * 6144 + chunk * 1024); }
};

__device__ __forceinline__ void normmod_row(const f32x4 (&v)[4], f32x4 (&h)[4], const float* g, const float* sh, const float* sc, int lane) {
    float s = 0.f;
#pragma unroll
    for (int j = 0; j < 4; ++j) s += (v[j].x * v[j].x + v[j].y * v[j].y) + (v[j].z * v[j].z + v[j].w * v[j].w);
    const float rstd = 1.0f / sqrtf(wave_sum(s) * (1.0f / D) + EPS);
#pragma unroll
    for (int j = 0; j < 4; ++j) {
        const f32x4 gg = *(const f32x4*)(g + 4 * lane + 256 * j), ss = *(const f32x4*)(sh + 4 * lane + 256 * j), cc = *(const f32x4*)(sc + 4 * lane + 256 * j);
        h[j] = (v[j] * rstd) * gg * (cc + 1.0f) + ss;
    }
}
__device__ __forceinline__ void store_row_bf16(bf16* row, const f32x4 (&h)[4], int lane) {
#pragma unroll
    for (int j = 0; j < 4; ++j) { u32x2 o; o.x = pk2(h[j].x, h[j].y); o.y = pk2(h[j].z, h[j].w); *(u32x2*)(row + 4 * lane + 256 * j) = o; }
}
__device__ __forceinline__ void load_row_bf16(const bf16* row, f32x4 (&h)[4], int lane) {
#pragma unroll
    for (int j = 0; j < 4; ++j) { const u32x2 o = *(const u32x2*)(row + 4 * lane + 256 * j);
        h[j] = (f32x4){bf2f(o.x & 0xffffu), bf2f(o.x >> 16), bf2f(o.y & 0xffffu), bf2f(o.y >> 16)}; }
}

__device__ __forceinline__ void ph_prologue(const Ctx& C) {
    float* sc = (float*)C.lds;
    const float* c = C.in[I_C]; const float* adaw = C.in[I_ADAW];
    float* modp = (float*)(C.ws + WS_MODP);
    for (int item = blockIdx.x; item < 384; item += gridDim.x) {
        const int layer = item / 192, r = item % 192, cc = r / 8, kc = r % 8;
        __syncthreads();
        for (int idx = C.tid; idx < 4096; idx += NTHR) { const int b = idx >> 7, kk = idx & 127; const float v = c[b * D + kc * 128 + kk]; sc[idx] = v / (1.0f + expf(-v)); }
        __syncthreads();
        const int col = cc * 256 + (C.tid & 255), bh = C.tid >> 8;
        float acc[16];
#pragma unroll
        for (int i = 0; i < 16; ++i) acc[i] = 0.f;
        const float* wp = adaw + ((size_t)layer * D + kc * 128) * 6144 + col;
        for (int kk = 0; kk < 128; ++kk) {
            const float w = wp[(size_t)kk * 6144];
#pragma unroll
            for (int i = 0; i < 16; ++i) acc[i] += sc[(bh * 16 + i) * 128 + kk] * w;
        }
#pragma unroll
        for (int i = 0; i < 16; ++i) modp[((size_t)(kc * 2 + layer) * NB + bh * 16 + i) * 6144 + col] = acc[i];
    }
    const int* pos = (const int*)C.in[I_POS];
    float* cosD = (float*)(C.ws + WS_COSD); float* sinD = (float*)(C.ws + WS_SIND); float* cosM = (float*)(C.ws + WS_COSM); float* sinM = (float*)(C.ws + WS_SINM);
    const int gt = blockIdx.x * NTHR + C.tid, ngt = gridDim.x * NTHR;
    for (int idx = gt; idx < NTOK * 32; idx += ngt) {
        const int tok = idx >> 5, i = idx & 31; const float inv = powf(10000.0f, -(float)(2 * i) / 64.0f); const float ang = (float)pos[tok] * inv;
        float s, co; sincosf(ang, &s, &co); cosD[idx] = co; sinD[idx] = s;
    }
    for (int idx = gt; idx < NTOK * 16; idx += ngt) {
        const int tok = idx >> 4, i = idx & 15; const float inv = powf(10000.0f, -(float)(2 * i) / 32.0f); const float ang = (float)pos[tok] * inv;
        float s, co; sincosf(ang, &s, &co); cosM[idx] = co; sinM[idx] = s;
    }
}
__device__ __forceinline__ void ph_modreduce(const Ctx& C) {
    const float* modp = (const float*)(C.ws + WS_MODP); float* mod = (float*)(C.ws + WS_MOD); const float* adab = C.in[I_ADAB];
    const int gt = blockIdx.x * NTHR + C.tid, ngt = gridDim.x * NTHR;
    for (int idx = gt; idx < 2 * NB * 6144; idx += ngt) {
        const int layer = idx / (NB * 6144), j = idx % 6144;
        float s = adab[layer * 6144 + j];
#pragma unroll
        for (int kc = 0; kc < 8; ++kc) s += modp[(size_t)kc * 2 * NB * 6144 + idx];
        mod[idx] = s;
    }
    if (blockIdx.x == 0 && C.wave == 0) {
        const float a = wave_sum(C.in[I_DA_LQ1][C.lane] * C.in[I_DA_LK1][C.lane]);
        const float b = wave_sum(C.in[I_DA_LQ2][C.lane] * C.in[I_DA_LK2][C.lane]);
        if (C.lane == 0) *(float*)(C.ws + WS_LAM) = expf(a) - expf(b) + 0.2f;
    }
}
__device__ __forceinline__ void ph_normmod0(const Ctx& C) {
    const float* x = C.in[I_X]; bf16* H = (bf16*)(C.ws + WS_H);
    for (int tok = C.gw; tok < NTOK; tok += C.ngw) {
        const int b = tok / SEQ; f32x4 v[4], h[4];
#pragma unroll
        for (int j = 0; j < 4; ++j) v[j] = *(const f32x4*)(x + (size_t)tok * D + 4 * C.lane + 256 * j);
        normmod_row(v, h, C.in[I_NMIX], C.mod(0, b, 0), C.mod(0, b, 1), C.lane);
        store_row_bf16(H + (size_t)tok * D, h, C.lane);
    }
}
__device__ __forceinline__ void ph_da_qkpost(const Ctx& C) {
    bf16* Q = (bf16*)(C.ws + WS_A); bf16* Kb = Q + (size_t)NTOK * D;
    const float* cosD = (const float*)(C.ws + WS_COSD); const float* sinD = (const float*)(C.ws + WS_SIND);
    const int lane = C.lane; const float gq = C.in[I_DA_QN][lane], gk = C.in[I_DA_KN][lane];
    for (int tok = C.gw; tok < NTOK; tok += C.ngw) {
        const float co = cosD[tok * 32 + (lane & 31)], si = sinD[tok * 32 + (lane & 31)];
        for (int which = 0; which < 2; ++which) {
            bf16* row = (which ? Kb : Q) + (size_t)tok * D; const float g = which ? gk : gq;
            for (int grp = 0; grp < 16; ++grp) {
                const float v = bf2f(row[grp * 64 + lane]);
                const float rstd = 1.0f / sqrtf(wave_sum(v * v) * (1.0f / 64.0f) + EPS);
                const float y = v * rstd * g; const float p = __shfl_xor(y, 32);
                const float o = (lane < 32) ? (y * co - p * si) : (y * co + p * si);
                row[grp * 64 + lane] = (bf16)f2bf(o);
            }
        }
    }
}

__device__ __forceinline__ void route_decide(const float (&lg)[36], const float* bg, const float* br, int& e0, int& e1, float& w0, float& w1) {
    const float gm = fmaxf(fmaxf(lg[0], lg[1]), fmaxf(lg[2], lg[3]));
    float gp[4]; float gs = 0.f;
#pragma unroll
    for (int g = 0; g < 4; ++g) { gp[g] = expf(lg[g] - gm); gs += gp[g]; }
    int gi = 0; float best = -1e30f, gate = 0.f;
#pragma unroll
    for (int g = 0; g < 4; ++g) { gp[g] /= gs; const float sv = gp[g] + bg[g]; if (sv > best) { best = sv; gi = g; gate = gp[g]; } }
    float el[8], bb[8];
#pragma unroll
    for (int e = 0; e < 8; ++e) { el[e] = 0.f; bb[e] = 0.f; }
#pragma unroll
    for (int g = 0; g < 4; ++g)
#pragma unroll
        for (int e = 0; e < 8; ++e) { if (g == gi) { el[e] = lg[4 + g * 8 + e]; bb[e] = br[g * 8 + e]; } }
    float em = el[0];
#pragma unroll
    for (int e = 1; e < 8; ++e) em = fmaxf(em, el[e]);
    float ep[8]; float es = 0.f;
#pragma unroll
    for (int e = 0; e < 8; ++e) { ep[e] = expf(el[e] - em); es += ep[e]; }
    int i0 = 0; float b0 = -1e30f, p0 = 0.f;
#pragma unroll
    for (int e = 0; e < 8; ++e) { ep[e] /= es; const float sv = ep[e] + bb[e]; if (sv > b0) { b0 = sv; i0 = e; p0 = ep[e]; } }
    int i1 = 0; float b1 = -1e30f, p1 = 0.f;
#pragma unroll
    for (int e = 0; e < 8; ++e) { const float sv = ep[e] + bb[e]; if (e != i0 && sv > b1) { b1 = sv; i1 = e; p1 = ep[e]; } }
    const float den = p0 + p1;
    e0 = gi * 8 + i0; e1 = gi * 8 + i1; w0 = p0 / den * gate; w1 = p1 / den * gate;
}

template <int MODE, bool ROUTE, bool FINAL>
__device__ __forceinline__ void ph_resid(const Ctx& C, const float* xin, const bf16* add, const float* gate_chunk_base  ,
                                         int nlayer, int nchunk_sh  , const float* gnorm, int moe_layer) {
    int* le0 = (int*)C.lds; int* le1 = le0 + 256; int* hist = le1 + 256; int* base = hist + 32; int* lp0 = base + 32; int* lp1 = lp0 + 256;
    bf16* H = (bf16*)(C.ws + WS_H); float* tokw = (float*)(C.ws + WS_TOKW); int* list = (int*)(C.ws + WS_LIST);
    unsigned* cnt = (unsigned*)(C.ws + WS_CTL) + CW_CNT + moe_layer * 32 * 64;
    const float* wg = C.in[I_E_WG] + (size_t)moe_layer * D * 4; const float* wr = C.in[I_E_WR] + (size_t)moe_layer * D * 32;
    const float* bg = C.in[I_E_BG] + moe_layer * 4; const float* br = C.in[I_E_BR] + moe_layer * 32;
    for (int chunk = blockIdx.x; chunk < NTOK / 256; chunk += gridDim.x) {
        if (ROUTE) { __syncthreads(); if (C.tid < 32) hist[C.tid] = 0; }
        for (int i = 0; i < 32; ++i) {
            const int tl = C.wave * 32 + i, tok = chunk * 256 + tl, b = tok / SEQ; const int lane = C.lane;
            f32x4 v[4], a[4];
#pragma unroll
            for (int j = 0; j < 4; ++j) v[j] = *(const f32x4*)(xin + (size_t)tok * D + 4 * lane + 256 * j);
            const float* gate = gate_chunk_base + (size_t)b * 6144;
            if (MODE == 0) { load_row_bf16(add + (size_t)tok * D, a, lane); }
            else { f32x4 a2[4]; load_row_bf16(add + (size_t)(2 * tok) * D, a, lane); load_row_bf16(add + (size_t)(2 * tok + 1) * D, a2, lane);
#pragma unroll
                for (int j = 0; j < 4; ++j) a[j] += a2[j]; }
#pragma unroll
            for (int j = 0; j < 4; ++j) { const f32x4 gg = *(const f32x4*)(gate + 4 * lane + 256 * j); v[j] += gg * a[j];
                *(f32x4*)(C.out + (size_t)tok * D + 4 * lane + 256 * j) = v[j]; }
            if (FINAL) continue;
            f32x4 h[4];
            normmod_row(v, h, gnorm, C.mod(nlayer, b, nchunk_sh), C.mod(nlayer, b, nchunk_sh + 1), lane);
            store_row_bf16(H + (size_t)tok * D, h, lane);
            if (ROUTE) {
                float lg[36];
#pragma unroll
                for (int q = 0; q < 36; ++q) lg[q] = 0.f;
#pragma unroll
                for (int j = 0; j < 4; ++j)
#pragma unroll
                    for (int u = 0; u < 4; ++u) {
                        const int k = 4 * lane + 256 * j + u; const float hv = h[j][u];
                        const f32x4 g4 = *(const f32x4*)(wg + (size_t)k * 4);
#pragma unroll
                        for (int q = 0; q < 4; ++q) lg[q] += hv * g4[q];
#pragma unroll
                        for (int q8 = 0; q8 < 8; ++q8) { const f32x4 r4 = *(const f32x4*)(wr + (size_t)k * 32 + q8 * 4);
#pragma unroll
                            for (int q = 0; q < 4; ++q) lg[4 + q8 * 4 + q] += hv * r4[q]; }
                    }
#pragma unroll
                for (int q = 0; q < 36; ++q) lg[q] = wave_sum(lg[q]);
                int e0, e1; float w0, w1;
                route_decide(lg, bg, br, e0, e1, w0, w1);
                if (lane == 0) { le0[tl] = e0; le1[tl] = e1; tokw[2 * tok] = w0; tokw[2 * tok + 1] = w1; }
            }
        }
        if (ROUTE) {
            __syncthreads();
            int e0 = 0, e1 = 0, p0 = 0, p1 = 0;
            if (C.tid < 256) { e0 = le0[C.tid]; e1 = le1[C.tid]; p0 = atomicAdd(&hist[e0], 1); p1 = atomicAdd(&hist[e1], 1); }
            __syncthreads();
            if (C.tid < 32) base[C.tid] = (int)__hip_atomic_fetch_add(cnt + C.tid * 64, (unsigned)hist[C.tid], __ATOMIC_RELAXED, __HIP_MEMORY_SCOPE_AGENT);
            __syncthreads();
            if (C.tid < 256) { const int tok = chunk * 256 + C.tid;
                list[(size_t)e0 * NTOK + base[e0] + p0] = 2 * tok; list[(size_t)e1 * NTOK + base[e1] + p1] = 2 * tok + 1; }
        }
    }
}

__device__ __forceinline__ void moe_prefix(const Ctx& C, int moe_layer, int* cntl, int* tpre) {
    const unsigned* cnt = (const unsigned*)(C.ws + WS_CTL) + CW_CNT + moe_layer * 32 * 64;
    __syncthreads();
    if (C.tid < 32) cntl[C.tid] = (int)__hip_atomic_load(cnt + C.tid * 64, __ATOMIC_RELAXED, __HIP_MEMORY_SCOPE_AGENT);
    __syncthreads();
    if (C.tid == 0) { int s = 0; for (int e = 0; e < 32; ++e) { tpre[e] = s; s += (cntl[e] + 127) >> 7; } tpre[32] = s; }
    __syncthreads();
}
__device__ __forceinline__ void ph_moe1(const Ctx& C, int moe_layer) {
    float* As = (float*)C.lds; float* Ws = As + 32 * 132; float* W2s = Ws + 32 * 64; int* rows = (int*)(W2s + 32 * 64); int* ent = rows + 128; int* cntl = ent + 128; int* tpre = cntl + 32;
    moe_prefix(C, moe_layer, cntl, tpre);
    const bf16* H = (const bf16*)(C.ws + WS_H); bf16* hid = (bf16*)(C.ws + WS_A); const int* list = (const int*)(C.ws + WS_LIST); const float* tokw = (const float*)(C.ws + WS_TOKW);
    const int ntiles = tpre[32] * 4;
    for (int t = blockIdx.x; t < ntiles; t += gridDim.x) {
        const int rt = t >> 2, ct = t & 3; int e = 0;
        for (int q = 1; q < 32; ++q) if (tpre[q] <= rt) e = q;
        const int r0 = (rt - tpre[e]) * 128, cnt = cntl[e];
        __syncthreads();
        if (C.tid < 128) { const int r = r0 + C.tid; const int en = (r < cnt) ? list[(size_t)e * NTOK + r] : list[(size_t)e * NTOK]; ent[C.tid] = (r < cnt) ? en : -1; rows[C.tid] = en >> 1; }
        __syncthreads();
        const float* w1 = C.in[I_E_W1] + (size_t)(moe_layer * 32 + e) * D * 256; const float* w3 = C.in[I_E_W3] + (size_t)(moe_layer * 32 + e) * D * 256;
        const size_t hrow0 = (size_t)tpre[e] * 128 + r0;
        auto epi = [&](int r, int c, f32x4 a, f32x4 b) {
            const int en = ent[r]; const float w = (en >= 0) ? tokw[en] : 0.f; f32x4 o;
#pragma unroll
            for (int q = 0; q < 4; ++q) o[q] = (a[q] / (1.0f + expf(-a[q]))) * b[q] * w;
            u32x2 pk; pk.x = pk2(o[0], o[1]); pk.y = pk2(o[2], o[3]);
            *(u32x2*)(hid + (hrow0 + r) * 256 + ct * 64 + c) = pk;
        };
        ngemm_tile<true>(As, Ws, W2s, H, D, rows, w1, w3, 256, D, ct * 64, epi, C.tid);
    }
}
__device__ __forceinline__ void ph_moe2(const Ctx& C, int moe_layer) {
    float* As = (float*)C.lds; float* Ws = As + 32 * 132; float* W2s = Ws + 32 * 64; int* rows = (int*)(W2s + 32 * 64); int* ent = rows + 128; int* cntl = ent + 128; int* tpre = cntl + 32;
    moe_prefix(C, moe_layer, cntl, tpre);
    const bf16* hid = (const bf16*)(C.ws + WS_A); bf16* y2 = (bf16*)(C.ws + WS_A + 128 * MiB); const int* list = (const int*)(C.ws + WS_LIST);
    const int ntiles = tpre[32] * 16;
    for (int t = blockIdx.x; t < ntiles; t += gridDim.x) {
        const int rt = t >> 4, ct = t & 15; int e = 0;
        for (int q = 1; q < 32; ++q) if (tpre[q] <= rt) e = q;
        const int r0 = (rt - tpre[e]) * 128, cnt = cntl[e];
        __syncthreads();
        if (C.tid < 128) { const int r = r0 + C.tid; ent[C.tid] = (r < cnt) ? list[(size_t)e * NTOK + r] : -1; rows[C.tid] = tpre[e] * 128 + r; }
        __syncthreads();
        const float* w2 = C.in[I_E_W2] + (size_t)(moe_layer * 32 + e) * 256 * D;
        auto epi = [&](int r, int c, f32x4 a, f32x4) {
            const int en = ent[r];
            if (en >= 0) { u32x2 pk; pk.x = pk2(a[0], a[1]); pk.y = pk2(a[2], a[3]); *(u32x2*)(y2 + (size_t)en * D + ct * 64 + c) = pk; }
        };
        ngemm_tile<false>(As, Ws, W2s, hid, 256, rows, w2, nullptr, D, 256, ct * 64, epi, C.tid);
    }
}

__device__ __forceinline__ void ph_mla_latpost(const Ctx& C) {
    const bf16* LAT = (const bf16*)(C.ws + WS_O); bf16* CQN = (bf16*)(C.ws + WS_S); bf16* CKVN = CQN + (size_t)NTOK * 384; bf16* KPE = CKVN + (size_t)NTOK * 256;
    const float* cosM = (const float*)(C.ws + WS_COSM); const float* sinM = (const float*)(C.ws + WS_SINM);
    const int lane = C.lane;
    for (int tok = C.gw; tok < NTOK; tok += C.ngw) {
        const bf16* row = LAT + (size_t)tok * 672;
        float q[6], s = 0.f;
#pragma unroll
        for (int j = 0; j < 6; ++j) { q[j] = bf2f(row[j * 64 + lane]); s += q[j] * q[j]; }
        float rstd = 1.0f / sqrtf(wave_sum(s) * (1.0f / 384.0f) + EPS);
#pragma unroll
        for (int j = 0; j < 6; ++j) CQN[(size_t)tok * 384 + j * 64 + lane] = (bf16)f2bf(q[j] * rstd * C.in[I_M_QAN][j * 64 + lane]);
        float kv[4]; s = 0.f;
#pragma unroll
        for (int j = 0; j < 4; ++j) { kv[j] = bf2f(row[384 + j * 64 + lane]); s += kv[j] * kv[j]; }
        rstd = 1.0f / sqrtf(wave_sum(s) * (1.0f / 256.0f) + EPS);
#pragma unroll
        for (int j = 0; j < 4; ++j) CKVN[(size_t)tok * 256 + j * 64 + lane] = (bf16)f2bf(kv[j] * rstd * C.in[I_M_KVAN][j * 64 + lane]);
        const float pe = (lane < 32) ? bf2f(row[640 + lane]) : 0.f;
        rstd = 1.0f / sqrtf(wave_sum(pe * pe) * (1.0f / 32.0f) + EPS);
        const float y = pe * rstd * C.in[I_M_KPN][lane & 31]; const float p = __shfl_xor(y, 16);
        const float co = cosM[tok * 16 + (lane & 15)], si = sinM[tok * 16 + (lane & 15)];
        const float o = ((lane & 16) == 0) ? (y * co - p * si) : (y * co + p * si);
        if (lane < 32) KPE[(size_t)tok * 32 + lane] = (bf16)f2bf(o);
    }
}
__device__ __forceinline__ void ph_mla_qkvpost(const Ctx& C) {
    bf16* Q2 = (bf16*)(C.ws + WS_A); bf16* KV2 = (bf16*)(C.ws + WS_A + 192 * MiB);
    const float* cosM = (const float*)(C.ws + WS_COSM); const float* sinM = (const float*)(C.ws + WS_SINM);
    const int lane = C.lane; const float gqn = C.in[I_M_QNN][lane], gqp = C.in[I_M_QPN][lane & 31], gkn = C.in[I_M_KNN][lane];
    for (int tok = C.gw; tok < NTOK; tok += C.ngw) {
        const float co = cosM[tok * 16 + (lane & 15)], si = sinM[tok * 16 + (lane & 15)];
        for (int h = 0; h < 16; ++h) {
            bf16* qrow = Q2 + (size_t)tok * 1536 + h * 96;
            const float v = bf2f(qrow[lane]);
            float rstd = 1.0f / sqrtf(wave_sum(v * v) * (1.0f / 64.0f) + EPS);
            qrow[lane] = (bf16)f2bf(v * rstd * gqn);
            const float pe = (lane < 32) ? bf2f(qrow[64 + lane]) : 0.f;
            rstd = 1.0f / sqrtf(wave_sum(pe * pe) * (1.0f / 32.0f) + EPS);
            const float y = pe * rstd * gqp; const float p = __shfl_xor(y, 16);
            const float o = ((lane & 16) == 0) ? (y * co - p * si) : (y * co + p * si);
            if (lane < 32) qrow[64 + lane] = (bf16)f2bf(o);
            bf16* krow = KV2 + (size_t)tok * 2048 + h * 128;
            const float kv = bf2f(krow[lane]);
            rstd = 1.0f / sqrtf(wave_sum(kv * kv) * (1.0f / 64.0f) + EPS);
            krow[lane] = (bf16)f2bf(kv * rstd * gkn);
        }
    }
}

__device__ __forceinline__ void ph_attn_da(const Ctx& C) {
    float* Ks = (float*)C.lds;
    float* Vs = Ks + 2 * 64 * 65;
    float* Ps = Vs + 64 * 128;
    float* Qs = Ps + 8 * 64;
    float* Oa = Qs + 8 * 8 * 64;
    float* Ms = Oa + 8 * 8 * 128;
    float* Ls = Ms + 64;
    float* Ox = Ks;
    const bf16* Q = (const bf16*)(C.ws + WS_A); const bf16* Kb = Q + (size_t)NTOK * D; const bf16* Vb = Kb + (size_t)NTOK * D; bf16* O = (bf16*)(C.ws + WS_O);
    const float lam = *(const float*)(C.ws + WS_LAM);
    const int tid = C.tid, lane = C.lane, w = C.wave, c = w >> 2, wq = w & 3;
    const float g0 = C.in[I_DA_SUBLN][lane], g1 = C.in[I_DA_SUBLN][lane + 64];
    const int nunits = NB * 8 * 64;
    for (int u = blockIdx.x; u < nunits; u += gridDim.x) {
        const int qb = 63 - (u >> 8), bh = u & 255, b = bh >> 3, h = bh & 7, q0 = qb * 32;
        const size_t rowb = (size_t)b * SEQ;
        __syncthreads();
#pragma unroll 1
        for (int i = 0; i < 8; ++i) {
            Qs[(w * 8 + i) * 64 + lane] = bf2f(Q[(rowb + q0 + wq * 8 + i) * D + (2 * h + c) * 64 + lane]) * 0.125f;
            Oa[(w * 8 + i) * 128 + lane] = 0.f; Oa[(w * 8 + i) * 128 + 64 + lane] = 0.f;
            if (lane == 0) { Ms[w * 8 + i] = -1e30f; Ls[w * 8 + i] = 0.f; }
        }
        const int nt = q0 / 64 + 1;
#pragma unroll 1
        for (int t = 0; t < nt; ++t) {
            __syncthreads();
#pragma unroll 1
            for (int idx = tid; idx < 1024; idx += NTHR) {
                const int cm = idx >> 9, j = (idx >> 3) & 63, d8 = idx & 7;
                const u32x4 kv = *(const u32x4*)(Kb + (rowb + t * 64 + j) * D + (2 * h + cm) * 64 + d8 * 8);
                float* dst = Ks + (cm * 64 + j) * 65 + d8 * 8;
#pragma unroll
                for (int q = 0; q < 4; ++q) { dst[2 * q] = bf2f(kv[q] & 0xffffu); dst[2 * q + 1] = bf2f(kv[q] >> 16); }
            }
#pragma unroll 1
            for (int idx = tid; idx < 1024; idx += NTHR) {
                const int j = idx >> 4, d8 = idx & 15;
                const u32x4 vv = *(const u32x4*)(Vb + (rowb + t * 64 + j) * D + h * 128 + d8 * 8);
                float* dst = Vs + j * 128 + d8 * 8;
#pragma unroll
                for (int q = 0; q < 4; ++q) { dst[2 * q] = bf2f(vv[q] & 0xffffu); dst[2 * q + 1] = bf2f(vv[q] >> 16); }
            }
            __syncthreads();
            float kreg[64];
#pragma unroll
            for (int d = 0; d < 64; ++d) kreg[d] = Ks[(c * 64 + lane) * 65 + d];
            const int key = t * 64 + lane;
#pragma unroll 1
            for (int i = 0; i < 8; ++i) {
                const float* qp = Qs + (w * 8 + i) * 64;
                float s = 0.f;
#pragma unroll
                for (int d4 = 0; d4 < 16; ++d4) { const f32x4 qv = *(const f32x4*)(qp + d4 * 4);
                    s += qv[0] * kreg[d4 * 4] + qv[1] * kreg[d4 * 4 + 1] + qv[2] * kreg[d4 * 4 + 2] + qv[3] * kreg[d4 * 4 + 3]; }
                const int qrow = q0 + wq * 8 + i;
                if (key > qrow) s = -1e30f;
                const float mo = Ms[w * 8 + i], lo_ = Ls[w * 8 + i];
                const float mn = fmaxf(mo, wave_max(s));
                const float p = (key > qrow) ? 0.f : expf(s - mn); const float al = expf(mo - mn);
                const float ln = lo_ * al + wave_sum(p);
                Ps[w * 64 + lane] = p;
                if (lane == 0) { Ms[w * 8 + i] = mn; Ls[w * 8 + i] = ln; }
                float a0 = 0.f, a1 = 0.f;
                const float* pp = Ps + w * 64;
#pragma unroll 4
                for (int j4 = 0; j4 < 16; ++j4) { const f32x4 pv = *(const f32x4*)(pp + j4 * 4);
#pragma unroll
                    for (int q = 0; q < 4; ++q) { a0 += pv[q] * Vs[(j4 * 4 + q) * 128 + lane]; a1 += pv[q] * Vs[(j4 * 4 + q) * 128 + 64 + lane]; } }
                float* op = Oa + (w * 8 + i) * 128;
                op[lane] = op[lane] * al + a0; op[64 + lane] = op[64 + lane] * al + a1;
            }
        }
        __syncthreads();
        if (c == 1) {
#pragma unroll 1
            for (int i = 0; i < 8; ++i) { const float il = 1.0f / Ls[w * 8 + i];
                Ox[(wq * 8 + i) * 128 + lane] = Oa[(w * 8 + i) * 128 + lane] * il; Ox[(wq * 8 + i) * 128 + 64 + lane] = Oa[(w * 8 + i) * 128 + 64 + lane] * il; }
        }
        __syncthreads();
        if (c == 0) {
#pragma unroll 1
            for (int i = 0; i < 8; ++i) {
                const float il = 1.0f / Ls[w * 8 + i];
                const float a0 = Oa[(w * 8 + i) * 128 + lane] * il - lam * Ox[(wq * 8 + i) * 128 + lane], a1 = Oa[(w * 8 + i) * 128 + 64 + lane] * il - lam * Ox[(wq * 8 + i) * 128 + 64 + lane];
                const float rstd = 1.0f / sqrtf(wave_sum(a0 * a0 + a1 * a1) * (1.0f / 128.0f) + EPS);
                bf16* orow = O + (rowb + q0 + wq * 8 + i) * D + h * 128;
                orow[lane] = (bf16)f2bf(a0 * rstd * g0 * 0.8f); orow[64 + lane] = (bf16)f2bf(a1 * rstd * g1 * 0.8f);
            }
        }
    }
}
__device__ __forceinline__ void ph_attn_mla(const Ctx& C) {
    float* Ks = (float*)C.lds;
    float* Vs = Ks + 64 * 97;
    float* Ps = Vs + 64 * 64;
    float* Qs = Ps + 8 * 64;
    float* Oa = Qs + 8 * 8 * 96;
    float* Ms = Oa + 8 * 8 * 64;
    float* Ls = Ms + 64;
    const bf16* Q2 = (const bf16*)(C.ws + WS_A); const bf16* KV2 = (const bf16*)(C.ws + WS_A + 192 * MiB);
    const bf16* KPE = (const bf16*)(C.ws + WS_S) + (size_t)NTOK * 640; bf16* O = (bf16*)(C.ws + WS_O);
    const int tid = C.tid, lane = C.lane, w = C.wave;
    const float scale = 0.10206207261596575f;
    const int nunits = NB * 16 * 32;
    for (int u = blockIdx.x; u < nunits; u += gridDim.x) {
        const int qb = 31 - (u >> 9), bh = u & 511, b = bh >> 4, h = bh & 15, q0 = qb * 64;
        const size_t rowb = (size_t)b * SEQ;
        __syncthreads();
#pragma unroll 1
        for (int i = 0; i < 8; ++i) { const bf16* qr = Q2 + (rowb + q0 + w * 8 + i) * 1536 + h * 96;
            Qs[(w * 8 + i) * 96 + lane] = bf2f(qr[lane]) * scale; if (lane < 32) Qs[(w * 8 + i) * 96 + 64 + lane] = bf2f(qr[64 + lane]) * scale;
            Oa[(w * 8 + i) * 64 + lane] = 0.f; if (lane == 0) { Ms[w * 8 + i] = -1e30f; Ls[w * 8 + i] = 0.f; } }
        const int nt = qb + 1;
#pragma unroll 1
        for (int t = 0; t < nt; ++t) {
            __syncthreads();
            {
                const int j = tid >> 3, d8 = tid & 7;
                const u32x4 kv = *(const u32x4*)(KV2 + (rowb + t * 64 + j) * 2048 + h * 128 + d8 * 8);
                float* dst = Ks + j * 97 + d8 * 8;
#pragma unroll
                for (int q = 0; q < 4; ++q) { dst[2 * q] = bf2f(kv[q] & 0xffffu); dst[2 * q + 1] = bf2f(kv[q] >> 16); }
                const u32x4 vv = *(const u32x4*)(KV2 + (rowb + t * 64 + j) * 2048 + h * 128 + 64 + d8 * 8);
                float* dv = Vs + j * 64 + d8 * 8;
#pragma unroll
                for (int q = 0; q < 4; ++q) { dv[2 * q] = bf2f(vv[q] & 0xffffu); dv[2 * q + 1] = bf2f(vv[q] >> 16); }
                if (tid < 256) { const int jj = tid >> 2, p8 = tid & 3;
                    const u32x4 pv = *(const u32x4*)(KPE + (rowb + t * 64 + jj) * 32 + p8 * 8); float* dp = Ks + jj * 97 + 64 + p8 * 8;
#pragma unroll
                    for (int q = 0; q < 4; ++q) { dp[2 * q] = bf2f(pv[q] & 0xffffu); dp[2 * q + 1] = bf2f(pv[q] >> 16); } }
            }
            __syncthreads();
            float kreg[96];
#pragma unroll
            for (int d = 0; d < 96; ++d) kreg[d] = Ks[lane * 97 + d];
            const int key = t * 64 + lane;
#pragma unroll 1
            for (int i = 0; i < 8; ++i) {
                const float* qp = Qs + (w * 8 + i) * 96;
                float s = 0.f;
#pragma unroll
                for (int d4 = 0; d4 < 24; ++d4) { const f32x4 qv = *(const f32x4*)(qp + d4 * 4);
                    s += qv[0] * kreg[d4 * 4] + qv[1] * kreg[d4 * 4 + 1] + qv[2] * kreg[d4 * 4 + 2] + qv[3] * kreg[d4 * 4 + 3]; }
                const int qrow = q0 + w * 8 + i;
                if (key > qrow) s = -1e30f;
                const float mo = Ms[w * 8 + i], lo_ = Ls[w * 8 + i];
                const float mn = fmaxf(mo, wave_max(s));
                const float p = (key > qrow) ? 0.f : expf(s - mn); const float al = expf(mo - mn);
                const float ln = lo_ * al + wave_sum(p);
                Ps[w * 64 + lane] = p;
                if (lane == 0) { Ms[w * 8 + i] = mn; Ls[w * 8 + i] = ln; }
                float a0 = 0.f;
                const float* pp = Ps + w * 64;
#pragma unroll 4
                for (int j4 = 0; j4 < 16; ++j4) { const f32x4 pv = *(const f32x4*)(pp + j4 * 4);
#pragma unroll
                    for (int q = 0; q < 4; ++q) a0 += pv[q] * Vs[(j4 * 4 + q) * 64 + lane]; }
                float* op = Oa + (w * 8 + i) * 64;
                op[lane] = op[lane] * al + a0;
            }
        }
#pragma unroll 1
        for (int i = 0; i < 8; ++i) O[(rowb + q0 + w * 8 + i) * D + h * 64 + lane] = (bf16)f2bf(Oa[(w * 8 + i) * 64 + lane] / Ls[w * 8 + i]);
    }
}

__global__ void __launch_bounds__(NTHR, 2) fwd(Args args) {
    extern __shared__ __attribute__((aligned(16))) unsigned char lds[];
    Ctx C; C.in = args.in; C.out = args.out; C.ws = args.ws; C.lds = lds;
    C.tid = threadIdx.x; C.lane = C.tid & 63; C.wave = __builtin_amdgcn_readfirstlane(C.tid >> 6);
    C.gw = blockIdx.x * NWAVES + C.wave; C.ngw = gridDim.x * NWAVES;
    volatile LAS unsigned* MISC = (volatile LAS unsigned*)((LAS unsigned char*)lds + MISC_OFF);
    if (C.tid < 32) MISC[C.tid] = 0u;
    __syncthreads();
    XcdBarrier bar; bar.bar = (unsigned*)(args.ws + WS_CTL) + CW_BAR; bar.x = 0; bar.st = nullptr;
    const int lo = args.ph_lo, hi = args.ph_hi;
    if (hi - lo > 1) bar = xcd_barrier_post((unsigned*)(args.ws + WS_CTL) + CW_BAR, MISC + 8);
#ifndef PHMASK
#define PHMASK 0xFFFFFFFFu
#endif
#define IN(k) (lo <= (k) && (k) < hi && ((PHMASK >> (k)) & 1u))
#define SEAM(k) do { if (IN(k) && IN((k) + 1)) xcd_barrier(bar); } while (0)
    unsigned char* ws = args.ws;
    bf16* H = (bf16*)(ws + WS_H); bf16* O = (bf16*)(ws + WS_O); bf16* A0 = (bf16*)(ws + WS_A);

    if (IN(0)) { ph_prologue(C); } SEAM(0);
    if (IN(1)) { ph_modreduce(C); } SEAM(1);
    if (IN(2)) { ph_normmod0(C); } SEAM(2);
    if (IN(3)) {
        for (int part = 0; part < 3; ++part)
            ngemm_phase(lds, H, D, args.in[I_DA_WQKV] + part * D, 3 * D, D, NTOK, D, A0 + (size_t)part * NTOK * D, D);
    } SEAM(3);
    if (IN(4)) { ph_da_qkpost(C); } SEAM(4);
    if (IN(5)) { ph_attn_da(C); } SEAM(5);
    if (IN(6)) { ngemm_phase(lds, O, D, args.in[I_DA_WO], D, D, NTOK, D, A0, D); } SEAM(6);
    if (IN(7)) { ph_resid<0, true, false>(C, args.in[I_X], A0, C.mod(0, 0, 2), 0, 3, args.in[I_NFFN], 0); } SEAM(7);
    if (IN(8)) { ph_moe1(C, 0); } SEAM(8);
    if (IN(9)) { ph_moe2(C, 0); } SEAM(9);
    if (IN(10)) { ph_resid<1, false, false>(C, args.out, (const bf16*)(ws + WS_A + 128 * MiB), C.mod(0, 0, 5), 1, 0, args.in[I_NMIX] + D, 0); } SEAM(10);
    if (IN(11)) { ngemm_phase(lds, H, D, args.in[I_M_WIN], 672, D, NTOK, 640, O, 672);
                  ngemm_phase(lds, H, D, args.in[I_M_WIN] + 608, 672, D, NTOK, 64, O + 608, 672); } SEAM(11);
    if (IN(12)) { ph_mla_latpost(C); } SEAM(12);
    if (IN(13)) { const bf16* CQN = (const bf16*)(ws + WS_S); const bf16* CKVN = CQN + (size_t)NTOK * 384;
                  ngemm_phase(lds, CQN, 384, args.in[I_M_WUQ], 1536, 384, NTOK, 1536, A0, 1536);
                  ngemm_phase(lds, CKVN, 256, args.in[I_M_WUKV], 2048, 256, NTOK, 2048, (bf16*)(ws + WS_A + 192 * MiB), 2048); } SEAM(13);
    if (IN(14)) { ph_mla_qkvpost(C); } SEAM(14);
    if (IN(15)) { ph_attn_mla(C); } SEAM(15);
    if (IN(16)) { ngemm_phase(lds, O, D, args.in[I_M_WO], D, D, NTOK, D, A0, D); } SEAM(16);
    if (IN(17)) { ph_resid<0, true, false>(C, args.out, A0, C.mod(1, 0, 2), 1, 3, args.in[I_NFFN] + D, 1); } SEAM(17);
    if (IN(18)) { ph_moe1(C, 1); } SEAM(18);
    if (IN(19)) { ph_moe2(C, 1); } SEAM(19);
    if (IN(20)) { ph_resid<1, false, true>(C, args.out, (const bf16*)(ws + WS_A + 128 * MiB), C.mod(1, 0, 5), 1, 0, args.in[I_NMIX], 0); }
#undef IN
#undef SEAM
}

extern "C" void kernel_launch(void* const* d_in, const int* in_sizes, int n_in, void* d_out, int out_size, void* d_ws, size_t ws_size, hipStream_t stream) {
    static int grid = 0;
    if (grid == 0) {
        if (n_in != 33 || out_size != NTOK * D || ws_size < WS_END) { fprintf(stderr, "kernel_launch: unexpected shapes n_in %d out %d ws %zu\n", n_in, out_size, ws_size); grid = -1; return; }
        int dev = 0, cus = 0;
        if (hipGetDevice(&dev) != hipSuccess || hipDeviceGetAttribute(&cus, hipDeviceAttributeMultiprocessorCount, dev) != hipSuccess) { grid = -1; return; }
        if (hipFuncSetAttribute((const void*)fwd, hipFuncAttributeMaxDynamicSharedMemorySize, LDS_BYTES) != hipSuccess) { fprintf(stderr, "hipFuncSetAttribute failed\n"); grid = -1; return; }
        (void)hipGetLastError();
        grid = cus;
    }
    if (grid < 0) return;
    (void)hipMemsetAsync((char*)d_ws + WS_CTL, 0, CTL_ZERO_BYTES, stream);
    Args a{};
    for (int i = 0; i < 33; ++i) a.in[i] = (const float*)d_in[i];
    a.out = (float*)d_out; a.ws = (unsigned char*)d_ws;
#if MK_ONE_LAUNCH
    a.ph_lo = 0; a.ph_hi = N_PHASES;
    hipLaunchKernelGGL(fwd, dim3(grid), dim3(NTHR), LDS_BYTES, stream, a);
#else
    for (int p = 0; p < 21; ++p) { a.ph_lo = p; a.ph_hi = p + 1; hipLaunchKernelGGL(fwd, dim3(grid), dim3(NTHR), LDS_BYTES, stream, a); }
#endif
}
```

```cpp
#include <hip/hip_runtime.h>
#include <cstdio>
#include <cstdint>

#define LAS __attribute__((address_space(3)))
typedef unsigned short bf16;
typedef float f32x4 __attribute__((ext_vector_type(4)));
typedef unsigned u32x4 __attribute__((ext_vector_type(4)));
typedef unsigned u32x2 __attribute__((ext_vector_type(2)));

constexpr int NB = 32, SEQ = 2048, D = 1024, NTOK = NB * SEQ;
constexpr float EPS = 1e-6f;
constexpr int NWAVES = 8, NTHR = 512;
constexpr int N_PHASES = 17;
#ifndef MK_ONE_LAUNCH
#define MK_ONE_LAUNCH 1
#endif

constexpr size_t MiB = 1u << 20;
constexpr size_t WS_CTL = 0, CTL_ZERO_BYTES = 1 * MiB;
constexpr size_t WS_MOD = 1 * MiB;
constexpr size_t WS_LAM = WS_MOD + 7 * MiB / 4;
constexpr size_t WS_SSQX = 4 * MiB;
constexpr size_t WS_SSQ = 8 * MiB;
constexpr size_t WS_WRT = 12 * MiB;
constexpr size_t WS_COSD = 16 * MiB, WS_SIND = 24 * MiB, WS_COSM = 32 * MiB, WS_SINM = 36 * MiB;
constexpr size_t WS_TOKW = 40 * MiB;
constexpr size_t WS_LIST = 42 * MiB;
constexpr size_t WS_WB = 50 * MiB;
constexpr size_t WB_QKV = WS_WB, WB_DAO = WB_QKV + 6 * MiB, WB_WIN = WB_DAO + 2 * MiB, WB_WUQ = WB_WIN + 3 * MiB / 2, WB_WUKV = WB_WUQ + 9 * MiB / 8, WB_MLO = WB_WUKV + 1 * MiB, WB_MOE = WB_MLO + 2 * MiB;
constexpr size_t WS_H = 176 * MiB;
constexpr size_t WS_O = 304 * MiB;
constexpr size_t WS_A = 432 * MiB;
constexpr size_t WS_LISTW = 160 * MiB;
constexpr size_t WS_KPE = 168 * MiB;
constexpr size_t WS_S = WS_O;
constexpr size_t WS_XB = 880 * MiB;
constexpr size_t WS_END = 1008 * MiB;
constexpr int CW_BAR = 4096;
constexpr int CW_CNT = 16384;
constexpr int HID_ROWS = 2 * NTOK + 32 * 128;

constexpr int LDS_BYTES = 147456;
constexpr int MISC_OFF = 131072 + 320;

__device__ __forceinline__ unsigned f2bf(float f) { unsigned u = __builtin_bit_cast(unsigned, f); return (u + 0x7fffu + ((u >> 16) & 1u)) >> 16; }
__device__ __forceinline__ float bf2f(unsigned h) { return __builtin_bit_cast(float, h << 16); }
__device__ __forceinline__ unsigned pk2(float lo, float hi) { return f2bf(lo) | (f2bf(hi) << 16); }
__device__ __forceinline__ float wave_sum(float v) {
#pragma unroll
    for (int o = 1; o < 64; o <<= 1) v += __shfl_xor(v, o);
    return v;
}
__device__ __forceinline__ float wave_max(float v) {
#pragma unroll
    for (int o = 1; o < 64; o <<= 1) v = fmaxf(v, __shfl_xor(v, o));
    return v;
}

#define XB_TMO      128
#define XB_XCNT(j)  (256  + 64 * (j))
#define XB_XSUB(j)  (1280 + 64 * (j))
#define XB_XGEN(j)  (2304 + 64 * (j))
#define XB_TOP      3328
#define XB_TOPGEN   3392
#define XCD_BAR_WORDS 3456
#define XB_SPIN_CAP (1u << 20)
__device__ __forceinline__ unsigned xb_ld(unsigned* p)              { return __hip_atomic_load(p, __ATOMIC_RELAXED, __HIP_MEMORY_SCOPE_AGENT); }
__device__ __forceinline__ unsigned xb_add(unsigned* p, unsigned v) { return __hip_atomic_fetch_add(p, v, __ATOMIC_RELAXED, __HIP_MEMORY_SCOPE_AGENT); }
__device__ __forceinline__ unsigned xb_xcc_id() { return (unsigned)__builtin_amdgcn_s_getreg((3 << 11) | 20) & 0xFu; }
#define XB_SPIN(cond, bar) do { unsigned _sp = 0; while (cond) { __builtin_amdgcn_s_sleep(1); \
    if ((++_sp & 255u) == 0u) { if (xb_ld(&(bar)[XB_TMO])) break; if (_sp > XB_SPIN_CAP) { atomicAdd(&(bar)[XB_TMO], 1u); break; } } } } while (0)
struct XcdBarrier { unsigned* bar; unsigned x; volatile LAS unsigned* st; };
__device__ __forceinline__ XcdBarrier xcd_barrier_post(unsigned* bar, volatile LAS unsigned* st) {
    XcdBarrier b; b.bar = bar; b.x = xb_xcc_id(); b.st = st;
    if (threadIdx.x == 0) (void)xb_add(&bar[XB_XCNT(b.x)], 1u);
    return b;
}
__device__ __forceinline__ void xcd_barrier_complete(unsigned* bar, unsigned x, unsigned& nloc, unsigned& nx) {
    const unsigned G = gridDim.x * gridDim.y * gridDim.z;
    unsigned sum, cnt, mine, sp = 0u;
    for (;;) {
        sum = 0u; cnt = 0u; mine = 0u;
#pragma unroll
        for (unsigned j = 0; j < 16; ++j) { const unsigned c = xb_ld(&bar[XB_XCNT(j)]); sum += c; cnt += (c > 0u) ? 1u : 0u; mine = (j == x) ? c : mine; }
        if (sum == G) break;
        __builtin_amdgcn_s_sleep(1);
        if ((++sp & 255u) == 0u) { if (xb_ld(&bar[XB_TMO])) break; if (sp > XB_SPIN_CAP) { atomicAdd(&bar[XB_TMO], 1u); break; } }
    }
    nloc = mine > 0u ? mine : 1u; nx = cnt > 0u ? cnt : 1u;
}
__device__ __forceinline__ void xcd_barrier(const XcdBarrier& b) {
    asm volatile("s_waitcnt vmcnt(0)" ::: "memory");
    __syncthreads();
    if (threadIdx.x == 0) {
        unsigned* bar = b.bar;
        __builtin_amdgcn_s_waitcnt(0);
        unsigned nloc = b.st[0], nx = b.st[1];
        if (nloc == 0u) { xcd_barrier_complete(bar, b.x, nloc, nx); b.st[0] = nloc; b.st[1] = nx; }
        const unsigned old = xb_add(&bar[XB_XSUB(b.x)], 1u);
        const unsigned gen = old / nloc;
        if (old + 1u == (gen + 1u) * nloc) {
            __builtin_amdgcn_fence(__ATOMIC_RELEASE, "agent");
            asm volatile("s_waitcnt vmcnt(0)" ::: "memory");
            const unsigned og = xb_add(&bar[XB_TOP], 1u);
            const unsigned tg = og / nx;
            if (og + 1u == (tg + 1u) * nx) xb_add(&bar[XB_TOPGEN], 1u);
            else XB_SPIN(xb_ld(&bar[XB_TOPGEN]) == tg, bar);
            __builtin_amdgcn_fence(__ATOMIC_ACQUIRE, "agent");
            xb_add(&bar[XB_XGEN(b.x)], 1u);
            asm volatile("s_waitcnt vmcnt(0)" ::: "memory");
        } else {
            XB_SPIN(xb_ld(&bar[XB_XGEN(b.x)]) == gen, bar);
            __builtin_amdgcn_fence(__ATOMIC_ACQUIRE, "agent");
            asm volatile("s_waitcnt vmcnt(0)" ::: "memory");
        }
    }
    __syncthreads();
}

namespace pg8 {
#define PG8_LAS __attribute__((address_space(3)))
typedef unsigned short bf16_t;
typedef short bf16x8 __attribute__((ext_vector_type(8)));
typedef float f32x4 __attribute__((ext_vector_type(4)));
typedef unsigned u32x4 __attribute__((ext_vector_type(4)));
constexpr int BM = 256, BK = 64, HALF = 128, HTB = HALF * BK * 2  , STAGE_BYTES = 8 * HTB, NXCD = 8, WGM = 8;

__host__ __device__ __forceinline__ int lds_byte(int r, int c) { const int st = (r >> 4) * 2 + (c >> 5), rr = r & 15, cc = c & 31, ob = rr * 64 + cc * 2; return st * 1024 + (ob ^ (((ob >> 9) & 1) << 5)); }
__host__ __device__ __forceinline__ void stage_rc(int b, int& R, int& C) { const int st = b / 1024, sb = b % 1024, swz = sb ^ (((sb >> 9) & 1) << 5); R = (st >> 1) * 16 + swz / 64; C = (st & 1) * 32 + (swz % 64) / 2; }
__host__ __device__ __forceinline__ int perm32(int rho) { const int n = rho >> 4, i = rho & 15; return 8 * (i >> 2) + 4 * n + (i & 3); }

struct Unit { int pm, pn; };
struct Gemm { const bf16_t* A; const bf16_t* Bt; int M, N, K; };

struct StaticOrder {
    typedef Unit UnitT;
    int nM, nN, nwg, G, c;
    __host__ __device__ void init(int M, int N, int G_, int c_) { nM = M / BM; nN = N / BM; nwg = nM * nN; G = G_; c = c_; }
    __host__ __device__ bool next(int i, Unit& u) const {
        const long L = (long)i * G + c; if (L >= nwg) return false;
        int wgid = (int)L; { const int q = nwg / NXCD, r = nwg % NXCD, xcd = wgid % NXCD, off = wgid / NXCD; wgid = (xcd < r ? xcd * (q + 1) : r * (q + 1) + (xcd - r) * q) + off; }
        const int nig = WGM * nN, gid = wgid / nig, fm = gid * WGM, gsz = (nM - fm) < WGM ? (nM - fm) : WGM;
        u.pm = fm + ((wgid % nig) % gsz); u.pn = (wgid % nig) / gsz; return true;
    }
    __device__ __forceinline__ void a_ready(const Unit&) const {}
    __device__ __forceinline__ void done(const Unit&) const {}
};

__device__ __forceinline__ unsigned cvt_pk_bf16(float lo, float hi) { unsigned r; asm volatile("v_cvt_pk_bf16_f32 %0, %1, %2" : "=v"(r) : "v"(lo), "v"(hi)); return r; }
typedef float f32x2 __attribute__((ext_vector_type(2)));
__device__ __forceinline__ f32x2 gelu_pk(f32x2 v) {
    const f32x2 av = __builtin_elementwise_abs(v), d = av * 0.2316418882f + 1.0f;
    f32x2 t; t.x = __builtin_amdgcn_rcpf(d.x); t.y = __builtin_amdgcn_rcpf(d.y);
    f32x2 q = t * 0.5307027145f + (-0.7265760135f); q = q * t + 0.7107068705f; q = q * t + (-0.142248368f); q = q * t + 0.127414796f; q = q * t;
    const f32x2 s = (v * v) * (-0.72134752044f);
    f32x2 e; e.x = __builtin_amdgcn_exp2f(s.x); e.y = __builtin_amdgcn_exp2f(s.y);
    const f32x2 m = v * (q * e), r = v - m;
    f32x2 o; o.x = v.x < 0.f ? m.x : r.x; o.y = v.y < 0.f ? m.y : r.y; return o;
}

template <int ACT  > struct EpiBf16 {
    static constexpr bool PERM = true, AFTER_DRAIN = false; static_assert(ACT == 0 || ACT == 1, "EpiBf16: ACT is 0 (none) or 1 (gelu_pk)");
    bf16_t* O; int ldc; const float* bias; int split_cols; size_t split_stride; float scale0;
    __device__ __forceinline__ void operator()(const f32x4 (&acc)[2][2][4][2], const Unit& u, int wr, int wc, int fr, int fq) const {
        const int row0 = u.pm * BM + wr * 64 + fr; int colt = u.pn * BM; bf16_t* base = O;
        float sc = 1.f; if (split_cols) { const int t = colt / split_cols; base += (size_t)t * split_stride; colt -= t * split_cols; if (t == 0) sc = scale0; }
        const int col0 = colt + wc * 32 + 8 * fq, bcol0 = u.pn * BM + wc * 32 + 8 * fq;
        f32x4 bv[2][2];
#pragma unroll
        for (int bj = 0; bj < 2; ++bj)
#pragma unroll
            for (int n = 0; n < 2; ++n) bv[bj][n] = bias ? *(const f32x4*)(bias + bcol0 + bj * HALF + 4 * n) : (f32x4){0.f, 0.f, 0.f, 0.f};
#pragma unroll
        for (int ai = 0; ai < 2; ++ai)
#pragma unroll
            for (int m = 0; m < 4; ++m) { bf16_t* rowp = base + (size_t)(row0 + ai * HALF + m * 16) * ldc + col0;
#pragma unroll
                for (int bj = 0; bj < 2; ++bj) { f32x4 v0 = acc[ai][bj][m][0] + bv[bj][0], v1 = acc[ai][bj][m][1] + bv[bj][1];
                    if (ACT == 1) { f32x2 a = gelu_pk((f32x2){v0[0], v0[1]}), b = gelu_pk((f32x2){v0[2], v0[3]}), c = gelu_pk((f32x2){v1[0], v1[1]}), d = gelu_pk((f32x2){v1[2], v1[3]});
                        v0 = (f32x4){a.x, a.y, b.x, b.y}; v1 = (f32x4){c.x, c.y, d.x, d.y}; }
                    v0 = v0 * sc; v1 = v1 * sc; u32x4 w; w.x = cvt_pk_bf16(v0[0], v0[1]); w.y = cvt_pk_bf16(v0[2], v0[3]); w.z = cvt_pk_bf16(v1[0], v1[1]); w.w = cvt_pk_bf16(v1[2], v1[3]);
                    *(u32x4*)(rowp + bj * HALF) = w; } }
    }
};

template <class Epi, class Sched, bool ALIGN_EPI = false, bool SP2 = false>
__device__ __forceinline__ void gemm_phase(PG8_LAS unsigned char* lds, const Gemm g, const Sched& S, const Epi& E) {
    int tid_ = threadIdx.x; asm volatile("" : "+v"(tid_));
    const int tid = tid_, wid = __builtin_amdgcn_readfirstlane(tid >> 6), lane = tid & 63, wr = wid >> 2, wc = wid & 3, fr = lane & 15, fq = lane >> 4;
    const int K = g.K, nt = K / BK;
    unsigned voffA[2], voffB[2];
#pragma unroll
    for (int i = 0; i < 2; ++i) { int R, C; stage_rc(tid * 16 + i * 8192, R, C); const int Rb = Epi::PERM ? ((R & ~31) + perm32(R & 31)) : R;
        voffA[i] = (unsigned)(R * K + C) * 2u; voffB[i] = (unsigned)(Rb * K + C) * 2u; }
    const size_t kstep = (size_t)(BK * 2);
    const size_t hstep = (size_t)HALF * K * 2;
    const size_t tstep = 2 * hstep;
    const unsigned ldsw = (unsigned)wid * 1024u;
    const int aoff = lds_byte(wr * 64 + fr, fq * 8), boff = lds_byte(wc * 32 + fr, fq * 8);
#define PG8_SA(b, h) (((b) * 2 + (h)) * HTB)
#define PG8_SB(b, h) ((4 + (b) * 2 + (h)) * HTB)
#define PG8_STAGE(bufoff, gbase, voff) do { _Pragma("unroll") for (int _i = 0; _i < 2; ++_i) \
        __builtin_amdgcn_global_load_lds((const unsigned*)((const char*)(gbase) + (voff)[_i]), (PG8_LAS unsigned*)(lds + (bufoff) + ldsw + _i * 8192), 16, 0, 0); } while (0)
#define PG8_LDA(dst, b, h) do { _Pragma("unroll") for (int m = 0; m < 4; ++m) _Pragma("unroll") for (int k = 0; k < 2; ++k) dst[m][k] = *(const PG8_LAS bf16x8*)(lds + PG8_SA(b, h) + aoff + m * 2048 + k * 1024); } while (0)
#define PG8_LDB(dst, b, h) do { _Pragma("unroll") for (int n = 0; n < 2; ++n) _Pragma("unroll") for (int k = 0; k < 2; ++k) dst[n][k] = *(const PG8_LAS bf16x8*)(lds + PG8_SB(b, h) + boff + n * 2048 + k * 1024); } while (0)
#define PG8_MMA(ai, bj, At, Bt) do { __builtin_amdgcn_s_setprio(1); _Pragma("unroll") for (int m = 0; m < 4; ++m) _Pragma("unroll") for (int n = 0; n < 2; ++n) _Pragma("unroll") for (int k = 0; k < 2; ++k) \
        acc[ai][bj][m][n] = __builtin_amdgcn_mfma_f32_16x16x32_bf16(Bt[n][k], At[m][k], acc[ai][bj][m][n], 0, 0, 0); __builtin_amdgcn_s_setprio(0); } while (0)
#define PG8_WAIT_V(n) asm volatile("s_waitcnt vmcnt(" #n ")" ::: "memory")
#define PG8_WAIT_L(n) asm volatile("s_waitcnt lgkmcnt(" #n ")" ::: "memory")
#define PG8_BAR __builtin_amdgcn_s_barrier()
#define PG8_SCHED __builtin_amdgcn_sched_barrier(0)
    typename Sched::UnitT cur, nxt; int ui = 0;
    if (!S.next(0, cur)) return;
    f32x4 acc[2][2][4][2];
#pragma unroll
    for (int a = 0; a < 2; ++a)
#pragma unroll
        for (int b = 0; b < 2; ++b)
#pragma unroll
            for (int m = 0; m < 4; ++m)
#pragma unroll
                for (int n = 0; n < 2; ++n) acc[a][b][m][n] = (f32x4){0.f, 0.f, 0.f, 0.f};
    bf16x8 At[4][2], B0[2][2], B1[2][2];
    const char* cA = (const char*)g.A + (size_t)cur.pm * tstep; const char* cB = (const char*)g.Bt + (size_t)cur.pn * tstep;
    S.a_ready(cur);
    if constexpr (SP2) {
        PG8_STAGE(PG8_SB(0, 0), cB, voffB); PG8_STAGE(PG8_SB(0, 1), cB + hstep, voffB); PG8_STAGE(PG8_SA(0, 0), cA, voffA); PG8_STAGE(PG8_SA(0, 1), cA + hstep, voffA);
        if (wr == 1) PG8_BAR;
        PG8_WAIT_V(2); PG8_BAR;
        PG8_STAGE(PG8_SB(1, 0), cB + kstep, voffB); PG8_STAGE(PG8_SA(1, 0), cA + kstep, voffA); PG8_STAGE(PG8_SB(1, 1), cB + hstep + kstep, voffB);
        PG8_WAIT_V(6); PG8_BAR;
    } else {
        PG8_STAGE(PG8_SB(0, 0), cB, voffB); PG8_STAGE(PG8_SA(0, 0), cA, voffA); PG8_STAGE(PG8_SB(0, 1), cB + hstep, voffB); PG8_STAGE(PG8_SA(0, 1), cA + hstep, voffA);
        if (wr == 1) PG8_BAR;
        PG8_WAIT_V(4); PG8_BAR;
        PG8_STAGE(PG8_SB(1, 0), cB + kstep, voffB); PG8_STAGE(PG8_SA(1, 0), cA + kstep, voffA); PG8_STAGE(PG8_SB(1, 1), cB + hstep + kstep, voffB);
        PG8_WAIT_V(6); PG8_BAR;
    }
    for (;;) {
        const bool has_next = S.next(ui + 1, nxt);
        const char* nA = has_next ? (const char*)g.A + (size_t)nxt.pm * tstep : cA; const char* nB = has_next ? (const char*)g.Bt + (size_t)nxt.pn * tstep : cB;
        for (int t = 0; t < nt; t += 2) {
            const bool last = (t == nt - 2);
            const char* a1 = cA + (size_t)(t + 1) * kstep;
            const char* a2 = last ? nA : cA + (size_t)(t + 2) * kstep; const char* b2 = last ? nB : cB + (size_t)(t + 2) * kstep;
            const char* a3 = a2 + kstep; const char* b3 = b2 + kstep;
            if (last && has_next) S.a_ready(nxt);
            if constexpr (SP2) {
            PG8_LDB(B0, 0, 0); PG8_LDB(B1, 0, 1); PG8_SCHED; PG8_LDA(At, 0, 0); PG8_STAGE(PG8_SA(1, 1), a1 + hstep, voffA);
            PG8_WAIT_V(8); PG8_WAIT_L(0); PG8_BAR; PG8_MMA(0, 0, At, B0); PG8_MMA(0, 1, At, B1); PG8_BAR; PG8_SCHED;
            PG8_LDA(At, 0, 1); PG8_STAGE(PG8_SB(0, 0), b2, voffB); PG8_STAGE(PG8_SB(0, 1), b2 + hstep, voffB); PG8_STAGE(PG8_SA(0, 0), a2, voffA);
            PG8_WAIT_V(8); PG8_WAIT_L(0); PG8_BAR; PG8_MMA(1, 0, At, B0); PG8_MMA(1, 1, At, B1); PG8_BAR; PG8_SCHED;
            PG8_LDB(B0, 1, 0); PG8_LDB(B1, 1, 1); PG8_SCHED; PG8_LDA(At, 1, 0); PG8_STAGE(PG8_SA(0, 1), a2 + hstep, voffA);
            PG8_WAIT_V(8); PG8_WAIT_L(0); PG8_BAR; PG8_MMA(0, 0, At, B0); PG8_MMA(0, 1, At, B1); PG8_BAR; PG8_SCHED;
            PG8_LDA(At, 1, 1); PG8_STAGE(PG8_SB(1, 0), b3, voffB); PG8_STAGE(PG8_SB(1, 1), b3 + hstep, voffB); PG8_STAGE(PG8_SA(1, 0), a3, voffA);
            PG8_WAIT_V(8); PG8_WAIT_L(0); PG8_BAR; PG8_MMA(1, 0, At, B0); PG8_MMA(1, 1, At, B1); PG8_BAR; PG8_SCHED;
            } else {
            PG8_LDB(B0, 0, 0); PG8_SCHED; PG8_LDA(At, 0, 0); PG8_STAGE(PG8_SA(1, 1), a1 + hstep, voffA);
            PG8_WAIT_L(8); PG8_BAR; PG8_WAIT_L(0); PG8_MMA(0, 0, At, B0); PG8_BAR; PG8_SCHED;
            PG8_LDB(B1, 0, 1); PG8_STAGE(PG8_SB(0, 0), b2, voffB);
            PG8_BAR; PG8_WAIT_L(0); PG8_MMA(0, 1, At, B1); PG8_BAR;
            PG8_LDA(At, 0, 1); PG8_STAGE(PG8_SA(0, 0), a2, voffA);
            PG8_BAR; PG8_WAIT_L(0); PG8_MMA(1, 0, At, B0); PG8_BAR; PG8_SCHED;
            PG8_STAGE(PG8_SB(0, 1), b2 + hstep, voffB);
            PG8_WAIT_V(6); PG8_BAR; PG8_MMA(1, 1, At, B1); PG8_BAR;
            PG8_LDB(B0, 1, 0); PG8_SCHED; PG8_LDA(At, 1, 0); PG8_STAGE(PG8_SA(0, 1), a2 + hstep, voffA);
            PG8_WAIT_L(8); PG8_BAR; PG8_WAIT_L(0); PG8_MMA(0, 0, At, B0); PG8_BAR; PG8_SCHED;
            PG8_LDB(B1, 1, 1); PG8_STAGE(PG8_SB(1, 0), b3, voffB);
            PG8_BAR; PG8_WAIT_L(0); PG8_MMA(0, 1, At, B1); PG8_BAR;
            PG8_LDA(At, 1, 1); PG8_STAGE(PG8_SA(1, 0), a3, voffA);
            PG8_BAR; PG8_WAIT_L(0); PG8_MMA(1, 0, At, B0); PG8_BAR; PG8_SCHED;
            PG8_STAGE(PG8_SB(1, 1), b3 + hstep, voffB);
            PG8_WAIT_V(6); PG8_BAR; PG8_MMA(1, 1, At, B1); PG8_BAR;
            }
        }
        if constexpr (ALIGN_EPI) { if (wr == 0) PG8_BAR; }
        if constexpr (!Epi::AFTER_DRAIN) { E(acc, cur, wr, wc, fr, fq); S.done(cur); }
        if (!has_next) break;
#pragma unroll
        for (int a = 0; a < 2; ++a)
#pragma unroll
            for (int b = 0; b < 2; ++b)
#pragma unroll
                for (int m = 0; m < 4; ++m)
#pragma unroll
                    for (int n = 0; n < 2; ++n) acc[a][b][m][n] = (f32x4){0.f, 0.f, 0.f, 0.f};
        cur = nxt; cA = nA; cB = nB; ++ui;
        if constexpr (ALIGN_EPI) { if (wr == 1) PG8_BAR; }
    }
    PG8_WAIT_V(0);
    if constexpr (!ALIGN_EPI) { if (wr == 0) PG8_BAR; }
    PG8_BAR;
    if constexpr (Epi::AFTER_DRAIN) { E.fused(acc, cur, wr, wc, fr, fq, lds, wid, lane); S.done(cur); }
#undef PG8_SA
#undef PG8_SB
#undef PG8_STAGE
#undef PG8_LDA
#undef PG8_LDB
#undef PG8_MMA
#undef PG8_WAIT_V
#undef PG8_WAIT_L
#undef PG8_BAR
#undef PG8_SCHED
}


__device__ __forceinline__ float quad_sum(float v) {
    auto a = __builtin_amdgcn_permlane16_swap(__float_as_uint(v), __float_as_uint(v), false, false); v = __uint_as_float(a[0]) + __uint_as_float(a[1]);
    auto b = __builtin_amdgcn_permlane32_swap(__float_as_uint(v), __float_as_uint(v), false, false); return __uint_as_float(b[0]) + __uint_as_float(b[1]);
}
__device__ __forceinline__ float sq4(const f32x4& v) { return (v[0] * v[0] + v[1] * v[1]) + (v[2] * v[2] + v[3] * v[3]); }
__device__ __forceinline__ u32x4 pack8(const f32x4& a, const f32x4& b) { u32x4 o; o.x = cvt_pk_bf16(a[0], a[1]); o.y = cvt_pk_bf16(a[2], a[3]); o.z = cvt_pk_bf16(b[0], b[1]); o.w = cvt_pk_bf16(b[2], b[3]); return o; }
struct EpiQKV {
    static constexpr bool PERM = true, AFTER_DRAIN = false;
    bf16_t* Q; bf16_t* K; bf16_t* V; const float* cosD; const float* sinD; const float* gq; const float* gk; float qscale; float eps;
    __device__ __forceinline__ void operator()(const f32x4 (&acc)[2][2][4][2], const Unit& u, int wr, int wc, int fr, int fq) const {
        asm volatile("" : "+v"(fr), "+v"(fq));
        const int tile = u.pn; const unsigned row0 = (unsigned)(u.pm * BM + wr * 64 + fr);
        if (tile >= 8) {
            bf16_t* vb = V + (tile - 8) * 256 + wc * 32 + fq * 8;
#pragma unroll
            for (int ai = 0; ai < 2; ++ai)
#pragma unroll
                for (int m = 0; m < 4; ++m) { const unsigned off = (row0 + ai * HALF + m * 16) * 1024u;
#pragma unroll
                    for (int bj = 0; bj < 2; ++bj) *(u32x4*)(vb + off + bj * HALF) = pack8(acc[ai][bj][m][0], acc[ai][bj][m][1]); }
        } else {
            const bool isk = tile >= 4; const int hm = (tile & 3) * 4 + wc; bf16_t* dst = (isk ? K : Q) + hm * 64 + 8 * fq; const float* g = isk ? gk : gq; const float sc = isk ? 1.0f : qscale;
            const f32x4 g0a = *(const f32x4*)(g + 8 * fq), g0b = *(const f32x4*)(g + 8 * fq + 4), g1a = *(const f32x4*)(g + 32 + 8 * fq), g1b = *(const f32x4*)(g + 36 + 8 * fq);
            const float* cb = cosD + 8 * fq; const float* sb = sinD + 8 * fq;
#pragma unroll
            for (int ai = 0; ai < 2; ++ai)
#pragma unroll
                for (int m = 0; m < 4; ++m) {
                    const unsigned row = row0 + ai * HALF + m * 16;
                    const f32x4 c0 = *(const f32x4*)(cb + row * 32u), c1 = *(const f32x4*)(cb + row * 32u + 4), s0 = *(const f32x4*)(sb + row * 32u), s1 = *(const f32x4*)(sb + row * 32u + 4);
                    const f32x4 a0 = acc[ai][0][m][0], a1 = acc[ai][0][m][1], b0 = acc[ai][1][m][0], b1 = acc[ai][1][m][1];
                    const float ss = quad_sum((sq4(a0) + sq4(a1)) + (sq4(b0) + sq4(b1)));
                    const float rs = __builtin_amdgcn_rsqf(ss * (1.0f / 64.0f) + eps) * sc;
                    const f32x4 x1a = a0 * (g0a * rs), x1b = a1 * (g0b * rs), x2a = b0 * (g1a * rs), x2b = b1 * (g1b * rs);
                    *(u32x4*)(dst + row * 1024u) = pack8(x1a * c0 - x2a * s0, x1b * c1 - x2b * s1);
                    *(u32x4*)(dst + row * 1024u + 32) = pack8(x2a * c0 + x1a * s0, x2b * c1 + x1b * s1);
                }
        }
    }
};
template <bool XF32>
struct EpiResid {
    static constexpr bool PERM = true, AFTER_DRAIN = false;
    const void* xin; bf16_t* xout; const float* gate; float* ssq;
    __device__ __forceinline__ void operator()(const f32x4 (&acc)[2][2][4][2], const Unit& u, int wr, int wc, int fr, int fq) const {
        asm volatile("" : "+v"(fr), "+v"(fq));
        const int b = (u.pm * BM) >> 11; const unsigned colb = (unsigned)(u.pn * BM + wc * 32 + 8 * fq); const unsigned row0 = (unsigned)(u.pm * BM + wr * 64 + fr);
        const float* gp = gate + (size_t)b * 6144 + colb;
        f32x4 g[2][2];
#pragma unroll
        for (int bj = 0; bj < 2; ++bj)
#pragma unroll
            for (int n = 0; n < 2; ++n) g[bj][n] = *(const f32x4*)(gp + bj * HALF + n * 4);
        bf16_t* xo = xout + colb; float* sq = ssq + u.pn * 4 + wc;
#pragma unroll
        for (int ai = 0; ai < 2; ++ai) {
            f32x4 xq[4][2][2];
#pragma unroll
            for (int m = 0; m < 4; ++m) { const unsigned off_ = (row0 + ai * HALF + m * 16) * 1024u + colb;
#pragma unroll
                for (int bj = 0; bj < 2; ++bj) {
                    if (XF32) { xq[m][bj][0] = *(const f32x4*)((const float*)xin + off_ + bj * HALF); xq[m][bj][1] = *(const f32x4*)((const float*)xin + off_ + bj * HALF + 4); }
                    else { const u32x4 w = *(const u32x4*)((const bf16_t*)xin + off_ + bj * HALF);
                        xq[m][bj][0] = (f32x4){__uint_as_float(w.x << 16), __uint_as_float(w.x & 0xffff0000u), __uint_as_float(w.y << 16), __uint_as_float(w.y & 0xffff0000u)};
                        xq[m][bj][1] = (f32x4){__uint_as_float(w.z << 16), __uint_as_float(w.z & 0xffff0000u), __uint_as_float(w.w << 16), __uint_as_float(w.w & 0xffff0000u)}; } } }
#pragma unroll
            for (int m = 0; m < 4; ++m) {
                const unsigned row = row0 + ai * HALF + m * 16; const unsigned off = row * 1024u; float ss = 0.f;
#pragma unroll
                for (int bj = 0; bj < 2; ++bj) { const f32x4 v0 = xq[m][bj][0] + g[bj][0] * acc[ai][bj][m][0], v1 = xq[m][bj][1] + g[bj][1] * acc[ai][bj][m][1];
                    *(u32x4*)(xo + off + bj * HALF) = pack8(v0, v1); ss += sq4(v0) + sq4(v1); }
                ss = quad_sum(ss);
                if (fq == 0) sq[row * 16u] = ss;
            }
        }
    }
};
struct EpiWin {
    static constexpr bool PERM = true, AFTER_DRAIN = false;
    bf16_t* CQ; bf16_t* CKV; bf16_t* KPE; float* ssq; const float* cosM; const float* sinM; const float* gkpe; float eps;
    __device__ __forceinline__ void operator()(const f32x4 (&acc)[2][2][4][2], const Unit& u, int wr, int wc, int fr, int fq) const {
        asm volatile("" : "+v"(fr), "+v"(fq));
        const int ws = u.pn * 4 + wc; const unsigned row0 = (unsigned)(u.pm * BM + wr * 64 + fr);
        if (ws < 10) {
            bf16_t* dst = ((ws < 6) ? CQ + 64 * ws : CKV + 64 * (ws - 6)) + 8 * fq; const unsigned ld = (ws < 6) ? 384u : 256u; float* sq = ssq + ws;
#pragma unroll
            for (int ai = 0; ai < 2; ++ai)
#pragma unroll
                for (int m = 0; m < 4; ++m) {
                    const unsigned row = row0 + ai * HALF + m * 16;
                    const f32x4 a0 = acc[ai][0][m][0], a1 = acc[ai][0][m][1], b0 = acc[ai][1][m][0], b1 = acc[ai][1][m][1];
                    *(u32x4*)(dst + row * ld) = pack8(a0, a1); *(u32x4*)(dst + row * ld + 32) = pack8(b0, b1);
                    const float ss = quad_sum((sq4(a0) + sq4(a1)) + (sq4(b0) + sq4(b1)));
                    if (fq == 0) sq[row * 16u] = ss;
                }
        } else if (ws == 10) {
            const f32x4 g0 = *(const f32x4*)(gkpe + 4 * fq), g1 = *(const f32x4*)(gkpe + 16 + 4 * fq);
#pragma unroll
            for (int ai = 0; ai < 2; ++ai)
#pragma unroll
                for (int m = 0; m < 4; ++m) {
                    const unsigned row = row0 + ai * HALF + m * 16;
                    const f32x4 c = *(const f32x4*)(cosM + row * 16u + 4 * fq), sn = *(const f32x4*)(sinM + row * 16u + 4 * fq);
                    const f32x4 y0 = acc[ai][0][m][0], y1 = acc[ai][0][m][1];
                    const float rs = __builtin_amdgcn_rsqf(quad_sum(sq4(y0) + sq4(y1)) * (1.0f / 32.0f) + eps);
                    const f32x4 x1 = y0 * (g0 * rs), x2 = y1 * (g1 * rs);
                    *(u32x4*)(KPE + row * 32u + 8 * fq) = pack8(x1 * c - x2 * sn, x2 * c + x1 * sn);
                }
        }
    }
};
struct EpiUQ {
    static constexpr bool PERM = true, AFTER_DRAIN = false;
    bf16_t* Q2; const float* ssq; const float* cosM; const float* sinM; const float* gqn; const float* gqp; float qscale; float eps;
    __device__ __forceinline__ void operator()(const f32x4 (&acc)[2][2][4][2], const Unit& u, int wr, int wc, int fr, int fq) const {
        asm volatile("" : "+v"(fr), "+v"(fq));
        const int tile = u.pn; const unsigned row0 = (unsigned)(u.pm * BM + wr * 64 + fr);
        if (tile < 4) {
            bf16_t* dst = Q2 + (tile * 4 + wc) * 96 + 8 * fq;
            const f32x4 g0a = *(const f32x4*)(gqn + 8 * fq) * qscale, g0b = *(const f32x4*)(gqn + 8 * fq + 4) * qscale, g1a = *(const f32x4*)(gqn + 32 + 8 * fq) * qscale, g1b = *(const f32x4*)(gqn + 36 + 8 * fq) * qscale;
#pragma unroll
            for (int ai = 0; ai < 2; ++ai) {
                f32x4 sA[4], sB[4];
#pragma unroll
                for (int m = 0; m < 4; ++m) { const unsigned row = row0 + ai * HALF + m * 16; sA[m] = *(const f32x4*)(ssq + row * 16u); sB[m] = *(const f32x4*)(ssq + row * 16u + 4); }
#pragma unroll
                for (int m = 0; m < 4; ++m) {
                    const unsigned row = row0 + ai * HALF + m * 16;
                    const f32x4 a0 = acc[ai][0][m][0], a1 = acc[ai][0][m][1], b0 = acc[ai][1][m][0], b1 = acc[ai][1][m][1];
                    const float ss = quad_sum((sq4(a0) + sq4(a1)) + (sq4(b0) + sq4(b1)));
                    const float em = eps * ((((sA[m][0] + sA[m][1]) + (sA[m][2] + sA[m][3])) + (sB[m][0] + sB[m][1])) * (1.0f / 384.0f) + eps);
                    const float rn = __builtin_amdgcn_rsqf(ss * (1.0f / 64.0f) + em);
                    *(u32x4*)(dst + row * 1536u) = pack8(a0 * (g0a * rn), a1 * (g0b * rn)); *(u32x4*)(dst + row * 1536u + 32) = pack8(b0 * (g1a * rn), b1 * (g1b * rn));
                }
            }
        } else {
            const f32x4 g0 = *(const f32x4*)(gqp + 4 * fq) * qscale, g1 = *(const f32x4*)(gqp + 16 + 4 * fq) * qscale;
            bf16_t* dst = Q2 + (((tile - 4) * 4 + wc) * 2) * 96 + 64 + 8 * fq;
#pragma unroll
            for (int ai = 0; ai < 2; ++ai) {
                f32x4 sA[4], sB[4], cc[4], sn[4];
#pragma unroll
                for (int m = 0; m < 4; ++m) { const unsigned row = row0 + ai * HALF + m * 16; sA[m] = *(const f32x4*)(ssq + row * 16u); sB[m] = *(const f32x4*)(ssq + row * 16u + 4);
                    cc[m] = *(const f32x4*)(cosM + row * 16u + 4 * fq); sn[m] = *(const f32x4*)(sinM + row * 16u + 4 * fq); }
#pragma unroll
                for (int m = 0; m < 4; ++m) {
                    const unsigned row = row0 + ai * HALF + m * 16;
                    const float em = eps * ((((sA[m][0] + sA[m][1]) + (sA[m][2] + sA[m][3])) + (sB[m][0] + sB[m][1])) * (1.0f / 384.0f) + eps);
#pragma unroll
                    for (int bj = 0; bj < 2; ++bj) {
                        const f32x4 y0 = acc[ai][bj][m][0], y1 = acc[ai][bj][m][1];
                        const float rn = __builtin_amdgcn_rsqf(quad_sum(sq4(y0) + sq4(y1)) * (1.0f / 32.0f) + em);
                        const f32x4 x1 = y0 * (g0 * rn), x2 = y1 * (g1 * rn);
                        *(u32x4*)(dst + row * 1536u + bj * 96) = pack8(x1 * cc[m] - x2 * sn[m], x2 * cc[m] + x1 * sn[m]);
                    }
                }
            }
        }
    }
};
struct EpiUKV {
    static constexpr bool PERM = true, AFTER_DRAIN = false;
    bf16_t* KV2; const float* ssq; const float* gkn; float eps;
    __device__ __forceinline__ void operator()(const f32x4 (&acc)[2][2][4][2], const Unit& u, int wr, int wc, int fr, int fq) const {
        asm volatile("" : "+v"(fr), "+v"(fq));
        const int tile = u.pn, head = (tile & 3) * 4 + wc; const unsigned row0 = (unsigned)(u.pm * BM + wr * 64 + fr);
        f32x4 sB[2][4], sC[2][4];
#pragma unroll
        for (int ai = 0; ai < 2; ++ai)
#pragma unroll
            for (int m = 0; m < 4; ++m) { const unsigned row = row0 + ai * HALF + m * 16; sB[ai][m] = *(const f32x4*)(ssq + row * 16u + 4); sC[ai][m] = *(const f32x4*)(ssq + row * 16u + 8); }
        if (tile < 4) {
            bf16_t* dst = KV2 + head * 128 + 8 * fq;
            const f32x4 g0a = *(const f32x4*)(gkn + 8 * fq), g0b = *(const f32x4*)(gkn + 8 * fq + 4), g1a = *(const f32x4*)(gkn + 32 + 8 * fq), g1b = *(const f32x4*)(gkn + 36 + 8 * fq);
#pragma unroll
            for (int ai = 0; ai < 2; ++ai)
#pragma unroll
                for (int m = 0; m < 4; ++m) {
                    const unsigned row = row0 + ai * HALF + m * 16;
                    const f32x4 a0 = acc[ai][0][m][0], a1 = acc[ai][0][m][1], b0 = acc[ai][1][m][0], b1 = acc[ai][1][m][1];
                    const float ss = quad_sum((sq4(a0) + sq4(a1)) + (sq4(b0) + sq4(b1)));
                    const float msq = ((sB[ai][m][2] + sB[ai][m][3]) + (sC[ai][m][0] + sC[ai][m][1])) * (1.0f / 256.0f) + eps;
                    const float rn = __builtin_amdgcn_rsqf(ss * (1.0f / 64.0f) + eps * msq);
                    *(u32x4*)(dst + row * 2048u) = pack8(a0 * (g0a * rn), a1 * (g0b * rn)); *(u32x4*)(dst + row * 2048u + 32) = pack8(b0 * (g1a * rn), b1 * (g1b * rn));
                }
        } else {
            bf16_t* dst = KV2 + head * 128 + 64 + 8 * fq;
#pragma unroll
            for (int ai = 0; ai < 2; ++ai)
#pragma unroll
                for (int m = 0; m < 4; ++m) {
                    const unsigned row = row0 + ai * HALF + m * 16;
                    const float rsq = __builtin_amdgcn_rsqf(((sB[ai][m][2] + sB[ai][m][3]) + (sC[ai][m][0] + sC[ai][m][1])) * (1.0f / 256.0f) + eps);
                    *(u32x4*)(dst + row * 2048u) = pack8(acc[ai][0][m][0] * rsq, acc[ai][0][m][1] * rsq); *(u32x4*)(dst + row * 2048u + 32) = pack8(acc[ai][1][m][0] * rsq, acc[ai][1][m][1] * rsq);
                }
        }
    }
};

struct MUnit { int pm, pn, e, r0; };
struct MoeOrder {
    typedef MUnit UnitT;
    const int* tpre; int ncol, G, c, total;
    __device__ __forceinline__ bool next(int i, MUnit& u) const {
        const int L = i * G + c; if (L >= total) return false;
        const int rt = L / ncol, ct = L - rt * ncol; const int e = tpre[33 + rt];
        u.e = e; u.pm = rt; u.r0 = (rt - tpre[e]) * 256; u.pn = e * ncol + ct; return true;
    }
    __device__ __forceinline__ void a_ready(const MUnit&) const {}
    __device__ __forceinline__ void done(const MUnit&) const {}
};
__device__ __forceinline__ float silu_f(float a) { return a * __builtin_amdgcn_rcpf(1.0f + __builtin_amdgcn_exp2f(-1.4426950408889634f * a)); }
struct EpiMoe1 {
    static constexpr bool PERM = true, AFTER_DRAIN = false;
    bf16_t* hid; const int* glist; const float* tokw; const int* cntl; int ntok;
    __device__ __forceinline__ void operator()(const f32x4 (&acc)[2][2][4][2], const MUnit& u, int wr, int wc, int fr, int fq) const {
        const int cnt = cntl[u.e], t = u.pn & 1;
        asm volatile("" : "+v"(fr), "+v"(fq));
#pragma unroll
        for (int ai = 0; ai < 2; ++ai)
#pragma unroll
            for (int m = 0; m < 4; ++m) {
                const int rl = ai * HALF + wr * 64 + m * 16 + fr, r = u.r0 + rl; float w = 0.f;
                if (r < cnt) w = tokw[(unsigned)(u.e * ntok + r)];
                const f32x4 a0 = acc[ai][0][m][0], a1 = acc[ai][0][m][1], b0 = acc[ai][1][m][0], b1 = acc[ai][1][m][1];
                u32x4 o;
                o.x = cvt_pk_bf16(silu_f(a0[0]) * b0[0] * w, silu_f(a0[1]) * b0[1] * w); o.y = cvt_pk_bf16(silu_f(a0[2]) * b0[2] * w, silu_f(a0[3]) * b0[3] * w);
                o.z = cvt_pk_bf16(silu_f(a1[0]) * b1[0] * w, silu_f(a1[1]) * b1[1] * w); o.w = cvt_pk_bf16(silu_f(a1[2]) * b1[2] * w, silu_f(a1[3]) * b1[3] * w);
                *(u32x4*)(hid + ((size_t)u.pm * BM + rl) * 256 + t * 128 + wc * 32 + fq * 8) = o;
                asm volatile("" ::: "memory");
            }
    }
};
struct EpiMoe2 {
    static constexpr bool PERM = true, AFTER_DRAIN = false;
    unsigned char* y2; const int* glist; const int* cntl; int ntok;
    __device__ __forceinline__ void operator()(const f32x4 (&acc)[2][2][4][2], const MUnit& u, int wr, int wc, int fr, int fq) const {
        const int cnt = cntl[u.e], ct = u.pn & 3;
        asm volatile("" : "+v"(fr), "+v"(fq));
#pragma unroll
        for (int ai = 0; ai < 2; ++ai)
#pragma unroll
            for (int m = 0; m < 4; ++m) {
                const int rl = ai * HALF + wr * 64 + m * 16 + fr, r = u.r0 + rl;
                int ent = glist[(unsigned)(u.e * ntok + (r < cnt ? r : 0))]; ent = (r < cnt) ? ent : 2 * ntok;
                unsigned char* rowp = y2 + (size_t)(unsigned)ent * 1024 + ct * 256 + wc * 32 + fq * 8;
#pragma unroll
                for (int bj = 0; bj < 2; ++bj) { const f32x4 v0 = acc[ai][bj][m][0] * 32.0f, v1 = acc[ai][bj][m][1] * 32.0f; u32x2 o;
                    int p = __builtin_amdgcn_cvt_pk_fp8_f32(v0[0], v0[1], 0, false); p = __builtin_amdgcn_cvt_pk_fp8_f32(v0[2], v0[3], p, true); o.x = (unsigned)p;
                    p = __builtin_amdgcn_cvt_pk_fp8_f32(v1[0], v1[1], 0, false); p = __builtin_amdgcn_cvt_pk_fp8_f32(v1[2], v1[3], p, true); o.y = (unsigned)p;
                    *(u32x2*)(rowp + bj * HALF) = o; }
                asm volatile("" ::: "memory");
            }
    }
};
template <class Epi, class Sched, bool FP8 = false>
__device__ __forceinline__ void gemm_phase_gather(PG8_LAS unsigned char* lds, const bf16_t* A, const bf16_t* Bt, int K, const int* glist, int ntok, const int* cntl, const Sched& S, const Epi& E) {
    int tid_ = threadIdx.x; asm volatile("" : "+v"(tid_));
    const int tid = tid_, wid = __builtin_amdgcn_readfirstlane(tid >> 6), lane = tid & 63, wr = wid >> 2, wc = wid & 3, fr = lane & 15, fq = lane >> 4;
    const int rowb = FP8 ? K : 2 * K, nt = FP8 ? K / (2 * BK) : K / BK;
    unsigned voffB[2];
#pragma unroll
    for (int i = 0; i < 2; ++i) { int R, C; stage_rc(tid * 16 + i * 8192, R, C); const int Rb = Epi::PERM ? ((R & ~31) + perm32(R & 31)) : R;
        voffB[i] = (unsigned)(Rb * rowb + C * 2); }
    const size_t kstep = (size_t)(BK * 2);
    const size_t hstep = (size_t)HALF * rowb;
    const size_t tstep = 2 * hstep;
    const unsigned ldsw = (unsigned)wid * 1024u;
    const int aoff = lds_byte(wr * 64 + fr, fq * 8), boff = lds_byte(wc * 32 + fr, fq * 8);
#define PG8_SA(b, h) (((b) * 2 + (h)) * HTB)
#define PG8_SB(b, h) ((4 + (b) * 2 + (h)) * HTB)
#define PG8_STAGE(bufoff, gbase, voff) do { _Pragma("unroll") for (int _i = 0; _i < 2; ++_i) \
        __builtin_amdgcn_global_load_lds((const unsigned*)((const char*)(gbase) + (voff)[_i]), (PG8_LAS unsigned*)(lds + (bufoff) + ldsw + _i * 8192), 16, 0, 0); } while (0)
    typedef int i32x4_ __attribute__((ext_vector_type(4))); typedef int i32x8_ __attribute__((ext_vector_type(8)));
#define PG8_LDA(dst, b, h) do { _Pragma("unroll") for (int m = 0; m < 4; ++m) { if constexpr (FP8) { const i32x4_ l0_ = *(const PG8_LAS i32x4_*)(lds + PG8_SA(b, h) + aoff + m * 2048), l1_ = *(const PG8_LAS i32x4_*)(lds + PG8_SA(b, h) + aoff + m * 2048 + 1024); \
            dst##8[m] = __builtin_shufflevector(l0_, l1_, 0, 1, 2, 3, 4, 5, 6, 7); } else { _Pragma("unroll") for (int k = 0; k < 2; ++k) dst[m][k] = *(const PG8_LAS bf16x8*)(lds + PG8_SA(b, h) + aoff + m * 2048 + k * 1024); } } } while (0)
#define PG8_LDB(dst, b, h) do { _Pragma("unroll") for (int n = 0; n < 2; ++n) { if constexpr (FP8) { const i32x4_ l0_ = *(const PG8_LAS i32x4_*)(lds + PG8_SB(b, h) + boff + n * 2048), l1_ = *(const PG8_LAS i32x4_*)(lds + PG8_SB(b, h) + boff + n * 2048 + 1024); \
            dst##8[n] = __builtin_shufflevector(l0_, l1_, 0, 1, 2, 3, 4, 5, 6, 7); } else { _Pragma("unroll") for (int k = 0; k < 2; ++k) dst[n][k] = *(const PG8_LAS bf16x8*)(lds + PG8_SB(b, h) + boff + n * 2048 + k * 1024); } } } while (0)
#define PG8_MMA(ai, bj, At, Bt) do { __builtin_amdgcn_s_setprio(1); _Pragma("unroll") for (int m = 0; m < 4; ++m) _Pragma("unroll") for (int n = 0; n < 2; ++n) { \
        if constexpr (FP8) acc[ai][bj][m][n] = __builtin_amdgcn_mfma_scale_f32_16x16x128_f8f6f4(Bt##8[n], At##8[m], acc[ai][bj][m][n], 0, 0, 0, 0x7a7a7a7a, 0, 0x7f7f7f7f); \
        else { _Pragma("unroll") for (int k = 0; k < 2; ++k) acc[ai][bj][m][n] = __builtin_amdgcn_mfma_f32_16x16x32_bf16(Bt[n][k], At[m][k], acc[ai][bj][m][n], 0, 0, 0); } } \
        __builtin_amdgcn_s_setprio(0); } while (0)
#define PG8_WAIT_V(n) asm volatile("s_waitcnt vmcnt(" #n ")" ::: "memory")
#define PG8_WAIT_L(n) asm volatile("s_waitcnt lgkmcnt(" #n ")" ::: "memory")
#define PG8_BAR __builtin_amdgcn_s_barrier()
#define PG8_SCHED __builtin_amdgcn_sched_barrier(0)
#define PG8_GOFF(u, off) do { const int _cnt = cntl[(u).e]; _Pragma("unroll") for (int _h = 0; _h < 2; ++_h) _Pragma("unroll") for (int _i = 0; _i < 2; ++_i) { \
        int _R, _C; stage_rc(tid * 16 + _i * 8192, _R, _C); const int _r = (u).r0 + _h * HALF + _R; const int _ent = glist[(unsigned)((u).e * ntok + (_r < _cnt ? _r : 0))]; \
        off[_h][_i] = (unsigned)(_ent >> 1) * (unsigned)rowb + (unsigned)(_C * 2); } } while (0)
    typename Sched::UnitT cur, nxt; int ui = 0;
    if (!S.next(0, cur)) return;
    f32x4 acc[2][2][4][2];
#pragma unroll
    for (int a = 0; a < 2; ++a)
#pragma unroll
        for (int b = 0; b < 2; ++b)
#pragma unroll
            for (int m = 0; m < 4; ++m)
#pragma unroll
                for (int n = 0; n < 2; ++n) acc[a][b][m][n] = (f32x4){0.f, 0.f, 0.f, 0.f};
    bf16x8 At[4][2], B0[2][2], B1[2][2]; i32x8_ At8[4], B08[2], B18[2];
    unsigned coff[2][2], noff[2][2];
    PG8_GOFF(cur, coff);
    const char* cA = (const char*)A; const char* cB = (const char*)Bt + (size_t)cur.pn * tstep;
    PG8_STAGE(PG8_SB(0, 0), cB, voffB); PG8_STAGE(PG8_SB(0, 1), cB + hstep, voffB); PG8_STAGE(PG8_SA(0, 0), cA, coff[0]); PG8_STAGE(PG8_SA(0, 1), cA, coff[1]);
    if (wr == 1) PG8_BAR;
    PG8_WAIT_V(2); PG8_BAR;
    PG8_STAGE(PG8_SB(1, 0), cB + kstep, voffB); PG8_STAGE(PG8_SA(1, 0), cA + kstep, coff[0]); PG8_STAGE(PG8_SB(1, 1), cB + hstep + kstep, voffB);
    PG8_WAIT_V(6); PG8_BAR;
    for (;;) {
        const bool has_next = S.next(ui + 1, nxt);
        if (has_next) { PG8_GOFF(nxt, noff); } else {
#pragma unroll
            for (int h = 0; h < 2; ++h)
#pragma unroll
                for (int i = 0; i < 2; ++i) noff[h][i] = coff[h][i]; }
        const char* nB = has_next ? (const char*)Bt + (size_t)nxt.pn * tstep : cB;
        for (int t = 0; t < nt; t += 2) {
            const bool last = (t == nt - 2);
            const char* a1 = cA + (size_t)(t + 1) * kstep;
            const char* a2 = last ? cA : cA + (size_t)(t + 2) * kstep; const char* b2 = last ? nB : cB + (size_t)(t + 2) * kstep;
            const char* a3 = a2 + kstep; const char* b3 = b2 + kstep;
            PG8_LDB(B0, 0, 0); PG8_LDB(B1, 0, 1); PG8_SCHED; PG8_LDA(At, 0, 0); PG8_STAGE(PG8_SA(1, 1), a1, coff[1]);
            if (last) {
#pragma unroll
                for (int h = 0; h < 2; ++h)
#pragma unroll
                    for (int i = 0; i < 2; ++i) coff[h][i] = noff[h][i]; }
            PG8_WAIT_V(8); PG8_WAIT_L(0); PG8_BAR; PG8_MMA(0, 0, At, B0); PG8_MMA(0, 1, At, B1); PG8_BAR; PG8_SCHED;
            PG8_LDA(At, 0, 1); PG8_STAGE(PG8_SB(0, 0), b2, voffB); PG8_STAGE(PG8_SB(0, 1), b2 + hstep, voffB); PG8_STAGE(PG8_SA(0, 0), a2, coff[0]);
            PG8_WAIT_V(8); PG8_WAIT_L(0); PG8_BAR; PG8_MMA(1, 0, At, B0); PG8_MMA(1, 1, At, B1); PG8_BAR; PG8_SCHED;
            PG8_LDB(B0, 1, 0); PG8_LDB(B1, 1, 1); PG8_SCHED; PG8_LDA(At, 1, 0); PG8_STAGE(PG8_SA(0, 1), a2, coff[1]);
            PG8_WAIT_V(8); PG8_WAIT_L(0); PG8_BAR; PG8_MMA(0, 0, At, B0); PG8_MMA(0, 1, At, B1); PG8_BAR; PG8_SCHED;
            PG8_LDA(At, 1, 1); PG8_STAGE(PG8_SB(1, 0), b3, voffB); PG8_STAGE(PG8_SB(1, 1), b3 + hstep, voffB); PG8_STAGE(PG8_SA(1, 0), a3, coff[0]);
            PG8_WAIT_V(8); PG8_WAIT_L(0); PG8_BAR; PG8_MMA(1, 0, At, B0); PG8_MMA(1, 1, At, B1); PG8_BAR; PG8_SCHED;
        }
        if (wr == 0) PG8_BAR;
        E(acc, cur, wr, wc, fr, fq);
        if (!has_next) break;
#pragma unroll
        for (int a = 0; a < 2; ++a)
#pragma unroll
            for (int b = 0; b < 2; ++b)
#pragma unroll
                for (int m = 0; m < 4; ++m)
#pragma unroll
                    for (int n = 0; n < 2; ++n) acc[a][b][m][n] = (f32x4){0.f, 0.f, 0.f, 0.f};
        cur = nxt; cB = nB; ++ui;
        if (wr == 1) PG8_BAR;
    }
    PG8_WAIT_V(0);
    PG8_BAR;
#undef PG8_SA
#undef PG8_SB
#undef PG8_STAGE
#undef PG8_LDA
#undef PG8_LDB
#undef PG8_MMA
#undef PG8_WAIT_V
#undef PG8_WAIT_L
#undef PG8_BAR
#undef PG8_SCHED
#undef PG8_GOFF
}
}

#define PG8_SP2 true
#define PG8_ALIGN true

struct Args { const float* in[33]; float* out; unsigned char* ws; int ph_lo, ph_hi; };
enum { I_X = 0, I_C, I_POS, I_ADAW, I_ADAB, I_NMIX, I_NFFN, I_DA_WQKV, I_DA_QN, I_DA_KN, I_DA_LQ1, I_DA_LK1, I_DA_LQ2, I_DA_LK2,
       I_DA_SUBLN, I_DA_WO, I_M_WIN, I_M_QAN, I_M_KVAN, I_M_WUQ, I_M_WUKV, I_M_QNN, I_M_QPN, I_M_KNN, I_M_KPN, I_M_WO,
       I_E_WG, I_E_BG, I_E_WR, I_E_BR, I_E_W1, I_E_W3, I_E_W2 };

struct Ctx {
    const float* const* in; float* out; unsigned char* ws; unsigned char* lds;
    int tid, lane, wave, gw, ngw;
    __device__ __forceinline__ const float* mod(int layer, int b, int chunk) const { return (const float*)(ws + WS_MOD) + ((size_t)(layer * NB + b) * 6144 + chunk * 1024); }
};

__device__ __forceinline__ void normmod_row(const f32x4 (&v)[4], f32x4 (&h)[4], const float* g, const float* sh, const float* sc, int lane) {
    float s = 0.f;
#pragma unroll
    for (int j = 0; j < 4; ++j) s += (v[j].x * v[j].x + v[j].y * v[j].y) + (v[j].z * v[j].z + v[j].w * v[j].w);
    const float rstd = 1.0f / sqrtf(wave_sum(s) * (1.0f / D) + EPS);
#pragma unroll
    for (int j = 0; j < 4; ++j) {
        const f32x4 gg = *(const f32x4*)(g + 4 * lane + 256 * j), ss = *(const f32x4*)(sh + 4 * lane + 256 * j), cc = *(const f32x4*)(sc + 4 * lane + 256 * j);
        h[j] = (v[j] * rstd) * gg * (cc + 1.0f) + ss;
    }
}
__device__ __forceinline__ void store_row_bf16(bf16* row, const f32x4 (&h)[4], int lane) {
#pragma unroll
    for (int j = 0; j < 4; ++j) { u32x2 o; o.x = pk2(h[j].x, h[j].y); o.y = pk2(h[j].z, h[j].w); *(u32x2*)(row + 4 * lane + 256 * j) = o; }
}
__device__ __forceinline__ void load_row_fp8(const unsigned char* row, f32x4 (&h)[4], int lane) {
#pragma unroll
    for (int j = 0; j < 4; ++j) { const int w = *(const int*)(row + 4 * lane + 256 * j); const auto lo = __builtin_amdgcn_cvt_pk_f32_fp8(w, false), hi = __builtin_amdgcn_cvt_pk_f32_fp8(w, true);
        h[j] = (f32x4){lo[0], lo[1], hi[0], hi[1]} * 0.03125f; }
}
__device__ __forceinline__ void load_row_bf16(const bf16* row, f32x4 (&h)[4], int lane) {
#pragma unroll
    for (int j = 0; j < 4; ++j) { const u32x2 o = *(const u32x2*)(row + 4 * lane + 256 * j);
        h[j] = (f32x4){bf2f(o.x & 0xffffu), bf2f(o.x >> 16), bf2f(o.y & 0xffffu), bf2f(o.y >> 16)}; }
}


struct TItem { const float* src; bf16* dst; const float* kg; int ldw, K, perm, f8; };
__device__ __forceinline__ void titem_load(const TItem& t, f32x4 (&v)[8], int lane) {
    const float* p = t.src + (size_t)(lane >> 3) * t.ldw + 4 * (lane & 7);
#pragma unroll
    for (int i = 0; i < 8; ++i) v[i] = *(const f32x4*)(p + (size_t)(8 * i) * t.ldw);
}
__device__ __forceinline__ void titem_finish(const TItem& t, const f32x4 (&v)[8], float* scr, int lane) {
    const int rr = lane >> 3, c4 = lane & 7;
#pragma unroll
    for (int i = 0; i < 8; ++i) { f32x4 x = v[i]; if (t.kg) x = x * t.kg[8 * i + rr]; float* d = scr + (8 * i + rr) * 33 + 4 * c4; d[0] = x[0]; d[1] = x[1]; d[2] = x[2]; d[3] = x[3]; }
    asm volatile("s_waitcnt lgkmcnt(0)" ::: "memory");
    const int c = lane & 7;
#pragma unroll
    for (int j = 0; j < 4; ++j) { const int n = (lane >> 3) + 8 * j; const int nl = t.perm ? (16 * ((n >> 2) & 1) + 4 * (n >> 3) + (n & 3)) : n;
        const float* sp = scr + (8 * c) * 33 + nl;
        if (t.f8) { int p0 = __builtin_amdgcn_cvt_pk_fp8_f32(sp[0 * 33] * 32.0f, sp[1 * 33] * 32.0f, 0, false); p0 = __builtin_amdgcn_cvt_pk_fp8_f32(sp[2 * 33] * 32.0f, sp[3 * 33] * 32.0f, p0, true);
            int p1 = __builtin_amdgcn_cvt_pk_fp8_f32(sp[4 * 33] * 32.0f, sp[5 * 33] * 32.0f, 0, false); p1 = __builtin_amdgcn_cvt_pk_fp8_f32(sp[6 * 33] * 32.0f, sp[7 * 33] * 32.0f, p1, true);
            u32x2 o; o.x = (unsigned)p0; o.y = (unsigned)p1; *(u32x2*)((unsigned char*)t.dst + (size_t)n * t.K + 8 * c) = o; }
        else { u32x4 o; o.x = pk2(sp[0 * 33], sp[1 * 33]); o.y = pk2(sp[2 * 33], sp[3 * 33]); o.z = pk2(sp[4 * 33], sp[5 * 33]); o.w = pk2(sp[6 * 33], sp[7 * 33]);
            *(u32x4*)(t.dst + (size_t)n * t.K + 8 * c) = o; } }
    asm volatile("s_waitcnt lgkmcnt(0)" ::: "memory");
}
__device__ __forceinline__ TItem titem_make(const float* W, int ldw, int K, bf16* WT, int k0, int n0, int prow0, const float* kgain, bool perm) {
    TItem t; t.src = W + (size_t)k0 * ldw + n0; t.dst = WT + (size_t)prow0 * K + k0; t.kg = kgain ? kgain + k0 : nullptr; t.ldw = ldw; t.K = K; t.perm = perm ? 1 : 0; t.f8 = 0; return t;
}
constexpr int TI_QKV = 16 * 96, TI_O = 16 * 32, TI_WIN = 16 * 21, TI_UQ = 6 * 48, TI_UKV = 4 * 64, TI_DENSE = TI_QKV + 2 * TI_O + TI_WIN + TI_UQ + TI_UKV, TI_ALL = TI_DENSE + 24576;
__device__ __forceinline__ TItem titem_decode(const Ctx& C, int it) {
    int r = it;
    if (r < TI_QKV) { const int kb = r / 96, lb = r % 96; int pb = lb;
        if (lb < 64) { const int sect = lb >> 5, hm = (lb & 31) >> 1, half = lb & 1; pb = (sect * 4 + (hm >> 2)) * 8 + half * 4 + (hm & 3); }
        return titem_make(C.in[I_DA_WQKV], 3072, 1024, (bf16*)(C.ws + WB_QKV), 64 * kb, 32 * lb, 32 * pb, nullptr, false); } r -= TI_QKV;
    if (r < TI_O) return titem_make(C.in[I_DA_WO], 1024, 1024, (bf16*)(C.ws + WB_DAO), 64 * (r / 32), 32 * (r % 32), 32 * (r % 32), nullptr, false); r -= TI_O;
    if (r < TI_O) return titem_make(C.in[I_M_WO], 1024, 1024, (bf16*)(C.ws + WB_MLO), 64 * (r / 32), 32 * (r % 32), 32 * (r % 32), nullptr, false); r -= TI_O;
    if (r < TI_WIN) { const int kb = r / 21, lb = r % 21; int pb = 18;
        if (lb < 20) { const int wsl = lb >> 1; pb = (wsl >> 2) * 8 + (lb & 1) * 4 + (wsl & 3); }
        return titem_make(C.in[I_M_WIN], 672, 1024, (bf16*)(C.ws + WB_WIN), 64 * kb, 32 * lb, 32 * pb, nullptr, lb == 20); } r -= TI_WIN;
    if (r < TI_UQ) { const int kb = r / 48, lb = r % 48, h = lb / 3, part = lb % 3; int pb;
        if (part < 2) pb = (h >> 2) * 8 + part * 4 + (h & 3); else { const int sl = h >> 1; pb = (4 + (sl >> 2)) * 8 + (h & 1) * 4 + (sl & 3); }
        return titem_make(C.in[I_M_WUQ], 1536, 384, (bf16*)(C.ws + WB_WUQ), 64 * kb, 32 * lb, 32 * pb, C.in[I_M_QAN], part == 2); } r -= TI_UQ;
    if (r < TI_UKV) { const int kb = r / 64, lb = r % 64, h = lb >> 2, part = lb & 3; const int pb = (((part < 2) ? 0 : 4) + (h >> 2)) * 8 + (part & 1) * 4 + (h & 3);
        return titem_make(C.in[I_M_WUKV], 2048, 256, (bf16*)(C.ws + WB_WUKV), 64 * kb, 32 * lb, 32 * pb, C.in[I_M_KVAN], false); } r -= TI_UKV;
    if (r < 16384) { const int item = r & 63, mat = (r >> 6) & 1, t = (r >> 7) & 1, e = (r >> 8) & 31, l = r >> 13; const int kb = item >> 2, nb = item & 3;
        const float* W = C.in[mat ? I_E_W3 : I_E_W1] + (size_t)(l * 32 + e) * 1024 * 256 + 128 * t;
        TItem ti = titem_make(W, 256, 1024, (bf16*)(C.ws + WB_MOE + (size_t)l * 48 * MiB), 64 * kb, 32 * nb, e * 512 + 256 * t + 128 * mat + 32 * nb, nullptr, false);
        ti.f8 = 1; ti.dst = (bf16*)((unsigned char*)(C.ws + WB_MOE + (size_t)l * 48 * MiB) + (size_t)(e * 512 + 256 * t + 128 * mat + 32 * nb) * 1024 + 64 * kb); return ti; }
    r -= 16384;
    { const int item = r & 127, e = (r >> 7) & 31, l = r >> 12; const int kb = item >> 5, nb = item & 31;
      const float* W = C.in[I_E_W2] + (size_t)(l * 32 + e) * 256 * 1024;
      return titem_make(W, 1024, 256, (bf16*)(C.ws + WB_MOE + (size_t)l * 48 * MiB + 32 * MiB), 64 * kb, 32 * nb, e * 1024 + 32 * nb, nullptr, false); }
}
__device__ __forceinline__ void ph_prologue(const Ctx& C) {
    {
        float* sc = (float*)C.lds;
        float* red = sc + 16384;
        const float* c = C.in[I_C]; const float* adaw = C.in[I_ADAW]; const float* adab = C.in[I_ADAB]; float* mod = (float*)(C.ws + WS_MOD);
        for (int item = blockIdx.x; item < 384; item += gridDim.x) {
            const int layer = item / 192, r = item % 192, cc = r >> 1, bhf = r & 1;
            __syncthreads();
            for (int idx = C.tid; idx < 16384; idx += NTHR) { const float v = c[(size_t)(bhf * 16) * D + idx]; sc[(idx & 1023) * 16 + (idx >> 10)] = v / (1.0f + expf(-v)); }
            __syncthreads();
            const int col = C.tid & 63, ks = C.tid >> 6;
            f32x4 acc[4];
#pragma unroll
            for (int i = 0; i < 4; ++i) acc[i] = (f32x4){0.f, 0.f, 0.f, 0.f};
            const float* wp = adaw + ((size_t)layer * D + ks * 128) * 6144 + cc * 64 + col;
#pragma unroll 8
            for (int kk = 0; kk < 128; ++kk) {
                const float w = wp[(size_t)kk * 6144]; const float* sp = sc + (ks * 128 + kk) * 16;
#pragma unroll
                for (int i = 0; i < 4; ++i) acc[i] += *(const f32x4*)(sp + 4 * i) * w;
            }
#pragma unroll
            for (int i = 0; i < 16; ++i) red[(ks * 16 + i) * 64 + col] = acc[i >> 2][i & 3];
            __syncthreads();
            for (int o = C.tid; o < 1024; o += NTHR) { const int i = o >> 6, cl = o & 63; float sm = adab[layer * 6144 + cc * 64 + cl];
#pragma unroll
                for (int k2 = 0; k2 < 8; ++k2) sm += red[(k2 * 16 + i) * 64 + cl];
                mod[(size_t)(layer * NB + bhf * 16 + i) * 6144 + cc * 64 + cl] = sm; }
        }
        if (blockIdx.x == 0 && C.wave == 0) {
            const float a = wave_sum(C.in[I_DA_LQ1][C.lane] * C.in[I_DA_LK1][C.lane]);
            const float b = wave_sum(C.in[I_DA_LQ2][C.lane] * C.in[I_DA_LK2][C.lane]);
            if (C.lane == 0) *(float*)(C.ws + WS_LAM) = expf(a) - expf(b) + 0.2f;
        }
    }
    __syncthreads();
    {
        float* ivf = (float*)C.lds;
        if (C.tid < 32) ivf[C.tid] = powf(10000.0f, -(float)(2 * C.tid) / 64.0f); else if (C.tid < 48) ivf[C.tid] = powf(10000.0f, -(float)(2 * (C.tid - 32)) / 32.0f);
        __syncthreads();
        const int* pos = (const int*)C.in[I_POS];
        float* cosD = (float*)(C.ws + WS_COSD); float* sinD = (float*)(C.ws + WS_SIND); float* cosM = (float*)(C.ws + WS_COSM); float* sinM = (float*)(C.ws + WS_SINM);
        const int gt = blockIdx.x * NTHR + C.tid, ngt = gridDim.x * NTHR;
        for (int idx = gt; idx < NTOK * 32; idx += ngt) {
            const float ang = (float)pos[idx >> 5] * ivf[idx & 31]; float rev = ang * 0.15915494309189535f; rev -= floorf(rev);
            cosD[idx] = __builtin_amdgcn_cosf(rev); sinD[idx] = __builtin_amdgcn_sinf(rev);
        }
        for (int idx = gt; idx < NTOK * 16; idx += ngt) {
            const float ang = (float)pos[idx >> 4] * ivf[32 + (idx & 15)]; float rev = ang * 0.15915494309189535f; rev -= floorf(rev);
            cosM[idx] = __builtin_amdgcn_cosf(rev); sinM[idx] = __builtin_amdgcn_sinf(rev);
        }
        float* wrt = (float*)(C.ws + WS_WRT); const float* wr = C.in[I_E_WR];
        for (int idx = gt; idx < 2 * 32 * 1024; idx += ngt) { const int l = idx >> 15, e = (idx >> 10) & 31, k = idx & 1023; wrt[idx] = wr[((size_t)l * 1024 + k) * 32 + e]; }
        for (int idx = gt; idx < 96 * 1024 / 8; idx += ngt) { const int blk = idx / 4096, rem = idx % 4096; const int pb = (blk == 0) ? 19 : 21 + blk;
            *(u32x4*)((bf16*)(C.ws + WB_WIN) + (size_t)pb * 32 * 1024 + (size_t)rem * 8) = (u32x4){0u, 0u, 0u, 0u}; }
    }
    __syncthreads();
    {
        float* scr = (float*)(C.lds + C.wave * 16384);
        f32x4 va[8], vb[8];
#pragma unroll 1
        for (int it = C.gw; it < TI_ALL; it += 2 * C.ngw) {
            const bool hasb = it + C.ngw < TI_ALL;
            const TItem ta = titem_decode(C, it), tb = titem_decode(C, hasb ? it + C.ngw : it);
            titem_load(ta, va, C.lane); if (hasb) titem_load(tb, vb, C.lane);
            titem_finish(ta, va, scr, C.lane); if (hasb) titem_finish(tb, vb, scr, C.lane);
        }
    }
}
__device__ __forceinline__ void ph_normmod0(const Ctx& C) {
    const float* x = C.in[I_X]; bf16* H = (bf16*)(C.ws + WS_H);
    for (int tok = C.gw; tok < NTOK; tok += C.ngw) {
        const int b = tok / SEQ; f32x4 v[4], h[4];
#pragma unroll
        for (int j = 0; j < 4; ++j) v[j] = *(const f32x4*)(x + (size_t)tok * D + 4 * C.lane + 256 * j);
        normmod_row(v, h, C.in[I_NMIX], C.mod(0, b, 0), C.mod(0, b, 1), C.lane);
        store_row_bf16(H + (size_t)tok * D, h, C.lane);
    }
}
template <bool FINAL>
__device__ __forceinline__ void ph_comb(const Ctx& C, const unsigned char* y2, const float* gate_chunk_base  , int nlayer, const float* gnorm) {
    bf16* H = (bf16*)(C.ws + WS_H); const int lane = C.lane;
    for (int chunk = blockIdx.x; chunk < NTOK / 256; chunk += gridDim.x) {
        for (int i = 0; i < 32; ++i) {
            const int tok = chunk * 256 + C.wave * 32 + i, b = tok / SEQ;
            f32x4 v[4], a[4], a2[4];
            load_row_bf16((const bf16*)(C.ws + WS_XB) + (size_t)tok * D, v, lane);
            const float* gate = gate_chunk_base + (size_t)b * 6144;
            load_row_fp8(y2 + (size_t)(2 * tok) * D, a, lane); load_row_fp8(y2 + (size_t)(2 * tok + 1) * D, a2, lane);
#pragma unroll
            for (int j = 0; j < 4; ++j) { const f32x4 gg = *(const f32x4*)(gate + 4 * lane + 256 * j); v[j] += gg * (a[j] + a2[j]);
                if (FINAL) *(f32x4*)(C.out + (size_t)tok * D + 4 * lane + 256 * j) = v[j]; }
            if (FINAL) continue;
            store_row_bf16((bf16*)(C.ws + WS_XB) + (size_t)tok * D, v, lane);
            f32x4 h[4];
            normmod_row(v, h, gnorm, C.mod(nlayer, b, 0), C.mod(nlayer, b, 1), lane);
            store_row_bf16(H + (size_t)tok * D, h, lane);
        }
    }
}

constexpr int MOE_TAB_OFF = 131072 + 512;
__device__ __forceinline__ void moe_prefix256(const Ctx& C, int moe_layer, int* cntl, int* tpre) {
    const unsigned* cnt = (const unsigned*)(C.ws + WS_CTL) + CW_CNT + moe_layer * 32 * 64;
    __syncthreads();
    if (C.tid < 32) cntl[C.tid] = (int)__hip_atomic_load(cnt + C.tid * 64, __ATOMIC_RELAXED, __HIP_MEMORY_SCOPE_AGENT);
    __syncthreads();
    if (C.tid == 0) { int s = 0; for (int e = 0; e < 32; ++e) { tpre[e] = s; s += (cntl[e] + 255) >> 8; } tpre[32] = s; }
    __syncthreads();
    if (C.tid < 32) { for (int rt = tpre[C.tid]; rt < tpre[C.tid + 1]; ++rt) tpre[33 + rt] = C.tid; }
    __syncthreads();
}
__device__ __forceinline__ void ph_moe1_mfma(const Ctx& C, int moe_layer) {
    int* cntl = (int*)(C.lds + MOE_TAB_OFF); int* tpre = cntl + 32;
    moe_prefix256(C, moe_layer, cntl, tpre);
    pg8::MoeOrder S{tpre, 2, (int)gridDim.x, (int)blockIdx.x, tpre[32] * 2};
    pg8::EpiMoe1 E{(bf16*)(C.ws + WS_A), (const int*)(C.ws + WS_LIST), (const float*)(C.ws + WS_LISTW), cntl, NTOK};
    int K1 = 1024; asm volatile("" : "+s"(K1));
    pg8::gemm_phase_gather<pg8::EpiMoe1, pg8::MoeOrder, true>((PG8_LAS unsigned char*)C.lds, (const bf16*)(C.ws + WS_H), (const bf16*)(C.ws + WB_MOE + (size_t)moe_layer * 48 * MiB), K1,
                                                        (const int*)(C.ws + WS_LIST), NTOK, cntl, S, E);
}
__device__ __forceinline__ void ph_moe2_mfma(const Ctx& C, int moe_layer) {
    int* cntl = (int*)(C.lds + MOE_TAB_OFF); int* tpre = cntl + 32;
    moe_prefix256(C, moe_layer, cntl, tpre);
    pg8::MoeOrder S{tpre, 4, (int)gridDim.x, (int)blockIdx.x, tpre[32] * 4};
    pg8::EpiMoe2 E{(unsigned char*)(C.ws + WS_A + 128 * MiB), (const int*)(C.ws + WS_LIST), cntl, NTOK};
    int K2 = 256; asm volatile("" : "+s"(K2));
    pg8::Gemm g{(const bf16*)(C.ws + WS_A), (const bf16*)(C.ws + WB_MOE + (size_t)moe_layer * 48 * MiB + 32 * MiB), 0, 0, K2};
    pg8::gemm_phase<pg8::EpiMoe2, pg8::MoeOrder, PG8_ALIGN, PG8_SP2>((PG8_LAS unsigned char*)C.lds, g, S, E);
}

namespace fa {
typedef short bf16x8 __attribute__((ext_vector_type(8)));
typedef short s16x4 __attribute__((ext_vector_type(4)));
typedef float f32x16 __attribute__((ext_vector_type(16)));
typedef __attribute__((address_space(3))) const char* lds_cptr;
__device__ __forceinline__ int crow(int r, int hi) { return (r & 3) + 8 * (r >> 2) + 4 * hi; }
__device__ __forceinline__ s16x4 vtr(lds_cptr p) { return __builtin_bit_cast(s16x4, __builtin_amdgcn_ds_read_tr16_b64_v4i16((__attribute__((address_space(3))) s16x4*)p)); }
typedef float f32x2_t __attribute__((ext_vector_type(2))); typedef __bf16 bf16x2_t __attribute__((ext_vector_type(2)));
__device__ __forceinline__ unsigned cvtpk(float lo, float hi) { f32x2_t v = {lo, hi}; bf16x2_t b = __builtin_convertvector(v, bf16x2_t); return __builtin_bit_cast(unsigned, b); }
__device__ __forceinline__ float half_swap_max(float v) { auto rr = __builtin_amdgcn_permlane32_swap(__float_as_uint(v), __float_as_uint(v), false, false); return fmaxf(__uint_as_float(rr[0]), __uint_as_float(rr[1])); }
__device__ __forceinline__ float half_swap_sum(float v) { auto rr = __builtin_amdgcn_permlane32_swap(__float_as_uint(v), __float_as_uint(v), false, false); return __uint_as_float(rr[0]) + __uint_as_float(rr[1]); }
__device__ __forceinline__ void dma16(const void* gsrc, LAS unsigned char* ldsdst) { unsigned keep; const unsigned dst = (unsigned)__builtin_amdgcn_readfirstlane((int)(unsigned)(uintptr_t)ldsdst);
    asm volatile("s_mov_b32 %0, m0\n\ts_mov_b32 m0, %2\n\ts_nop 0\n\tglobal_load_lds_dwordx4 %1, off\n\ts_mov_b32 m0, %0" : "=&s"(keep) : "v"(gsrc), "s"(dst) : "memory"); }
__device__ __forceinline__ void dma16s(const void* sbase_, unsigned voff, LAS unsigned char* ldsdst) { unsigned keep; const unsigned dst = (unsigned)__builtin_amdgcn_readfirstlane((int)(unsigned)(uintptr_t)ldsdst);
    const unsigned long long sb_ = (unsigned long long)(uintptr_t)sbase_; const unsigned lo_ = (unsigned)__builtin_amdgcn_readfirstlane((int)(unsigned)sb_), hi_ = (unsigned)__builtin_amdgcn_readfirstlane((int)(unsigned)(sb_ >> 32));
    const void* sbase = (const void*)(uintptr_t)(((unsigned long long)hi_ << 32) | lo_);
    asm volatile("s_mov_b32 %0, m0\n\ts_mov_b32 m0, %3\n\ts_nop 0\n\tglobal_load_lds_dwordx4 %1, %2\n\ts_mov_b32 m0, %0" : "=&s"(keep) : "v"(voff), "s"(sbase), "s"(dst) : "memory"); }

template <int ND0, int NDB>
__device__ __forceinline__ void tile(lds_cptr Kslot, lds_cptr Vslot, const bf16x8 (&qf)[ND0], f32x16 (&o)[NDB], f32x16& negm, float& m, float& l,
                                     LAS float* wsf, bool first, bool diag, int qloc, int lane) {
    const int r32 = lane & 31, hi = lane >> 5;
    lds_cptr kb = Kslot + hi * 1024 + r32 * 16;
    bf16x8 kf0[ND0], kf1[ND0];
#pragma unroll
    for (int d0 = 0; d0 < ND0; ++d0) {
        kf0[d0] = *(const __attribute__((address_space(3))) bf16x8*)(kb + d0 * 2048);
        kf1[d0] = *(const __attribute__((address_space(3))) bf16x8*)(kb + d0 * 2048 + 512);
    }
#pragma unroll
    for (int d0 = 0; d0 < ND0; ++d0) asm volatile("" : "+v"(kf0[d0]), "+v"(kf1[d0]));
    f32x16 p0 = __builtin_amdgcn_mfma_f32_32x32x16_bf16(kf0[0], qf[0], negm, 0, 0, 0);
    f32x16 p1 = __builtin_amdgcn_mfma_f32_32x32x16_bf16(kf1[0], qf[0], negm, 0, 0, 0);
#pragma unroll
    for (int d0 = 1; d0 < ND0; ++d0) {
        p0 = __builtin_amdgcn_mfma_f32_32x32x16_bf16(kf0[d0], qf[d0], p0, 0, 0, 0);
        p1 = __builtin_amdgcn_mfma_f32_32x32x16_bf16(kf1[d0], qf[d0], p1, 0, 0, 0);
    }
    __builtin_amdgcn_sched_barrier(0);
    lds_cptr vp = Vslot + ((lane >> 4) & 1) * 32 + (lane & 3) * 8 + (4 * hi + ((lane & 15) >> 2)) * 64;
    constexpr int NE = (NDB < 2 ? NDB : 2) * 4;
    s16x4 vlo[NDB * 4], vhi[NDB * 4];
#pragma unroll
    for (int i = 0; i < NE; ++i) { vlo[i] = vtr(vp + (i >> 2) * 4096 + (i & 3) * 1024); vhi[i] = vtr(vp + (i >> 2) * 4096 + (i & 3) * 1024 + 512); }
    __builtin_amdgcn_sched_barrier(0);
    if (diag) {
#pragma unroll
        for (int r = 0; r < 16; ++r) { const int kv = crow(r, hi); if (kv > qloc) p0[r] = -1e30f; if (kv + 32 > qloc) p1[r] = -1e30f; }
    }
    float mx = fmaxf(fmaxf(p0[0], p1[0]), p0[1]);
#pragma unroll
    for (int r = 1; r < 16; ++r) { if (r > 1) mx = fmaxf(fmaxf(mx, p0[r]), p1[r]); else mx = fmaxf(mx, p1[r]); }
    mx = half_swap_max(mx);
    const bool need = first || (__builtin_amdgcn_ballot_w64(mx > 8.0f) != 0ull);
    if (need) {
        const float dl = first ? mx : fmaxf(mx, 0.f);
        m += dl;
#pragma unroll
        for (int r = 0; r < 16; ++r) { p0[r] -= dl; p1[r] -= dl; negm[r] = -m; }
        if (!first) {
            const float al = __builtin_amdgcn_exp2f(-dl); l *= al;
            if (hi == 0) wsf[r32] = al;
            asm volatile("s_waitcnt lgkmcnt(0)" ::: "memory");
            f32x4 a4[4];
#pragma unroll
            for (int g = 0; g < 4; ++g) a4[g] = *(const LAS f32x4*)(wsf + 8 * g + 4 * hi);
#pragma unroll
            for (int db = 0; db < NDB; ++db)
#pragma unroll
                for (int r = 0; r < 16; ++r) o[db][r] *= a4[r >> 2][r & 3];
        }
    }
    float sum = 0.f;
#pragma unroll
    for (int ks = 0; ks < 4; ++ks) {
        float e[8];
#pragma unroll
        for (int j = 0; j < 8; ++j) { const float x = (ks < 2) ? p0[8 * ks + j] : p1[8 * (ks - 2) + j]; e[j] = __builtin_amdgcn_exp2f(x); }
        sum += ((e[0] + e[1]) + (e[2] + e[3])) + ((e[4] + e[5]) + (e[6] + e[7]));
        u32x4 w; w.x = cvtpk(e[0], e[1]); w.y = cvtpk(e[2], e[3]); w.z = cvtpk(e[4], e[5]); w.w = cvtpk(e[6], e[7]);
        const bf16x8 pa = __builtin_bit_cast(bf16x8, w);
        if (ks == 0 && NE < NDB * 4) {
#pragma unroll
            for (int i = NE; i < NDB * 4; ++i) { vlo[i] = vtr(vp + (i >> 2) * 4096 + (i & 3) * 1024); vhi[i] = vtr(vp + (i >> 2) * 4096 + (i & 3) * 1024 + 512); }
        }
        __builtin_amdgcn_s_setprio(1);
#pragma unroll
        for (int db = 0; db < NDB; ++db) {
            const s16x4 lo = vlo[db * 4 + ks], hh = vhi[db * 4 + ks];
            const bf16x8 vf = (bf16x8){lo[0], lo[1], lo[2], lo[3], hh[0], hh[1], hh[2], hh[3]};
            o[db] = __builtin_amdgcn_mfma_f32_32x32x16_bf16(pa, vf, o[db], 0, 0, 0);
        }
        __builtin_amdgcn_s_setprio(0);
    }
    l += sum;
}
}


__device__ __forceinline__ void ph_route(const Ctx& C, int layer) {
    typedef float f32x16 __attribute__((ext_vector_type(16)));
    LAS float* hT = (LAS float*)C.lds + C.wave * (32 * 68);
    LAS float* rsl = (LAS float*)C.lds + 8 * 32 * 68 + C.wave * 32;
    int* le0 = (int*)(C.lds + 73728); int* le1 = le0 + 256; int* hist = le1 + 256; int* base = hist + 32; float* lw0 = (float*)(base + 32); float* lw1 = lw0 + 256;
    const bf16* x1 = (const bf16*)(C.ws + WS_XB); unsigned char* H8 = C.ws + WS_H; float* listw = (float*)(C.ws + WS_LISTW); int* list = (int*)(C.ws + WS_LIST);
    unsigned* cnt = (unsigned*)(C.ws + WS_CTL) + CW_CNT + layer * 32 * 64;
    const float* ssqx = (const float*)(C.ws + WS_SSQX);
    const float* gn = C.in[I_NFFN] + layer * D;
    const float* WrT = (const float*)(C.ws + WS_WRT) + (size_t)layer * 32 * 1024; const float* wg = C.in[I_E_WG] + (size_t)layer * D * 4;
    const float* bg = C.in[I_E_BG] + layer * 4; const float* br = C.in[I_E_BR] + layer * 32;
    const int lane = C.lane, r32 = lane & 31, hi = lane >> 5, w = C.wave, kq = lane & 15, tsub = lane >> 4;
    LAS float* wgl = (LAS float*)(C.lds + 81920);
    __syncthreads();
    for (int idx = C.tid; idx < 1024; idx += NTHR) *(LAS f32x4*)(wgl + idx * 4) = *(const f32x4*)(wg + (size_t)idx * 4);
    for (int chunk = blockIdx.x; chunk < NTOK / 256; chunk += gridDim.x) {
        __syncthreads();
        if (C.tid < 32) hist[C.tid] = 0;
        const int tok0 = chunk * 256 + w * 32, b = tok0 >> 11;
        const float* shp = C.mod(layer, b, 3); const float* scp = C.mod(layer, b, 4);
        { const float* sp = ssqx + (size_t)(tok0 + r32) * 16; const f32x4 s0 = *(const f32x4*)sp, s1 = *(const f32x4*)(sp + 4), s2 = *(const f32x4*)(sp + 8), s3 = *(const f32x4*)(sp + 12);
          const float sm = ((s0[0] + s0[1]) + (s0[2] + s0[3])) + ((s1[0] + s1[1]) + (s1[2] + s1[3])) + ((s2[0] + s2[1]) + (s2[2] + s2[3])) + ((s3[0] + s3[1]) + (s3[2] + s3[3]));
          if (hi == 0) rsl[r32] = 1.0f / sqrtf(sm * (1.0f / D) + EPS); }
        f32x16 acc;
#pragma unroll
        for (int r = 0; r < 16; ++r) acc[r] = 0.f;
        float gl[4] = {0.f, 0.f, 0.f, 0.f};
        const unsigned xoff = (unsigned)(tok0 + tsub) * 1024u + 4u * kq;
        const unsigned woff = (unsigned)r32 * 1024u + 4u * hi;
        f32x4 X[8], Wa[8], Wb[8];
#define RT_LOADX(kc_) do { _Pragma("unroll") for (int i = 0; i < 8; ++i) { const u32x2 w_ = *(const u32x2*)(x1 + (xoff + 4096u * i + 64u * (kc_))); \
            X[i] = (f32x4){__uint_as_float(w_.x << 16), __uint_as_float(w_.x & 0xffff0000u), __uint_as_float(w_.y << 16), __uint_as_float(w_.y & 0xffff0000u)}; } } while (0)
#define RT_LOADW(W, kc_) do { _Pragma("unroll") for (int c = 0; c < 8; ++c) W[c] = *(const f32x4*)(WrT + (woff + 64u * (kc_) + 8u * c)); } while (0)
#define RT_STEP(W, WN, kc_) do { const unsigned k4 = 64u * (kc_) + 4u * kq; \
            const f32x4 g4 = *(const f32x4*)(gn + k4), sc4 = *(const f32x4*)(scp + k4), sh4 = *(const f32x4*)(shp + k4); const f32x4 gm4 = g4 * (sc4 + 1.0f); \
            _Pragma("unroll") for (int i = 0; i < 8; ++i) { const int tl = 4 * i + tsub; const float rsd = rsl[tl]; const f32x4 h4 = (X[i] * rsd) * gm4 + sh4; \
                int o8 = __builtin_amdgcn_cvt_pk_fp8_f32(h4[0], h4[1], 0, false); o8 = __builtin_amdgcn_cvt_pk_fp8_f32(h4[2], h4[3], o8, true); *(int*)(H8 + (xoff + 4096u * i + 64u * (kc_))) = o8; *(LAS f32x4*)(hT + tl * 68 + 4 * kq) = h4; } \
            if ((kc_) + 1 < 16) { RT_LOADX((kc_) + 1); RT_LOADW(WN, (kc_) + 1); } \
            _Pragma("unroll") for (int c = 0; c < 8; ++c) { const f32x4 b4 = *(const LAS f32x4*)(hT + r32 * 68 + 8 * c + 4 * hi); \
                _Pragma("unroll") for (int j = 0; j < 4; ++j) { acc = __builtin_amdgcn_mfma_f32_32x32x2f32(W[c][j], b4[j], acc, 0, 0, 0); \
                    const f32x4 w4 = *(const LAS f32x4*)(wgl + (64 * (kc_) + 8 * c + 4 * hi + j) * 4); \
                    _Pragma("unroll") for (int q = 0; q < 4; ++q) gl[q] += b4[j] * w4[q]; } asm volatile("" : "+v"(gl[0]), "+v"(gl[1]), "+v"(gl[2]), "+v"(gl[3])); } } while (0)
        RT_LOADX(0); RT_LOADW(Wa, 0);
#pragma unroll 1
        for (int kc = 0; kc < 16; kc += 2) {
            RT_STEP(Wa, Wb, kc);
            RT_STEP(Wb, Wa, kc + 1);
        }
#undef RT_LOADX
#undef RT_LOADW
#undef RT_STEP
#pragma unroll
        for (int q = 0; q < 4; ++q) gl[q] = fa::half_swap_sum(gl[q]);
        float gp[4]; { const float gm = fmaxf(fmaxf(gl[0], gl[1]), fmaxf(gl[2], gl[3])); float gs = 0.f;
#pragma unroll
            for (int g = 0; g < 4; ++g) { gp[g] = expf(gl[g] - gm); gs += gp[g]; }
#pragma unroll
            for (int g = 0; g < 4; ++g) gp[g] /= gs; }
        int gi = 0; float best = -1e30f, gate = 0.f;
#pragma unroll
        for (int g = 0; g < 4; ++g) { const float sv = gp[g] + bg[g]; if (sv > best) { best = sv; gi = g; gate = gp[g]; } }
        float el[8];
#pragma unroll
        for (int j = 0; j < 4; ++j) { const float own = (gi == 0) ? acc[j] : (gi == 1) ? acc[4 + j] : (gi == 2) ? acc[8 + j] : acc[12 + j];
            auto rr = __builtin_amdgcn_permlane32_swap(__float_as_uint(own), __float_as_uint(own), false, false);
            el[j] = __uint_as_float(rr[0]); el[4 + j] = __uint_as_float(rr[1]); }
        float em = el[0];
#pragma unroll
        for (int e = 1; e < 8; ++e) em = fmaxf(em, el[e]);
        float ep[8], es = 0.f;
#pragma unroll
        for (int e = 0; e < 8; ++e) { ep[e] = expf(el[e] - em); es += ep[e]; }
        int i0 = 0; float b0 = -1e30f, p0 = 0.f;
#pragma unroll
        for (int e = 0; e < 8; ++e) { ep[e] /= es; const float sv = ep[e] + br[gi * 8 + e]; if (sv > b0) { b0 = sv; i0 = e; p0 = ep[e]; } }
        int i1 = 0; float b1 = -1e30f, p1 = 0.f;
#pragma unroll
        for (int e = 0; e < 8; ++e) { const float sv = ep[e] + br[gi * 8 + e]; if (e != i0 && sv > b1) { b1 = sv; i1 = e; p1 = ep[e]; } }
        const float den = p0 + p1;
        if (hi == 0) { const int tl = w * 32 + r32; le0[tl] = gi * 8 + i0; le1[tl] = gi * 8 + i1; lw0[tl] = p0 / den * gate; lw1[tl] = p1 / den * gate; }
        __syncthreads();
        int e0 = 0, e1 = 0, q0 = 0, q1 = 0;
        if (C.tid < 256) { e0 = le0[C.tid]; e1 = le1[C.tid]; q0 = atomicAdd(&hist[e0], 1); q1 = atomicAdd(&hist[e1], 1); }
        __syncthreads();
        if (C.tid < 32) base[C.tid] = (int)__hip_atomic_fetch_add(cnt + C.tid * 64, (unsigned)hist[C.tid], __ATOMIC_RELAXED, __HIP_MEMORY_SCOPE_AGENT);
        __syncthreads();
        if (C.tid < 256) { const int tok = chunk * 256 + C.tid;
            const size_t i0_ = (size_t)e0 * NTOK + base[e0] + q0, i1_ = (size_t)e1 * NTOK + base[e1] + q1;
            list[i0_] = 2 * tok; list[i1_] = 2 * tok + 1; listw[i0_] = lw0[C.tid]; listw[i1_] = lw1[C.tid]; }
    }
}

__device__ __forceinline__ void ph_attn_da_mfma(const Ctx& C) {
    using namespace fa;
    LAS unsigned char* L = (LAS unsigned char*)C.lds;
    constexpr int STG = 32768;
    LAS float* wsf = (LAS float*)(L + 3 * STG) + C.wave * 32;
    const int vcu = ((int)blockIdx.x & 7) * 32 + ((int)blockIdx.x >> 3), xcd = vcu >> 5, grp = (vcu >> 4) & 1, jj = vcu & 15;
    const bf16* Q = (const bf16*)(C.ws + WS_A); const bf16* Kb = Q + (size_t)NTOK * D; const bf16* Vb = Kb + (size_t)NTOK * D; bf16* O = (bf16*)(C.ws + WS_O);
    const float lam = *(const float*)(C.ws + WS_LAM);
    const int lane = C.lane, w = C.wave, c = w >> 2, wq = w & 3, r32 = lane & 31, hi = lane >> 5;
    const float c2 = 0.125f * 1.4426950408889634f;
    for (int u = 0; u < 16; ++u) {
        const int bh = xcd * 32 + 2 * u + grp, b = bh >> 3, h = bh & 7, qb = (u & 1) ? 15 - jj : jj, q0 = qb * 128;
        const size_t rowb = (size_t)b * SEQ;
        const int NT = (q0 + 128) / 64, qw0 = q0 + 32 * wq, T = qw0 >> 6;
        const bf16* sbase = (w < 4 ? Kb : Vb) + rowb * D;
        unsigned soff[4]; int dsto[4];
#pragma unroll
        for (int i = 0; i < 4; ++i) {
            if (w < 4) { const int cm = w >> 1, ch = (w & 1) * 4 + i; soff[i] = (unsigned)((lane * D + (2 * h + cm) * 64 + ch * 8) * 2); dsto[i] = cm * 8192 + ch * 1024; }
            else { const int db = w - 4, rg = i; soff[i] = (unsigned)(((rg * 16 + (lane >> 2)) * D + h * 128 + db * 32 + (lane & 3) * 8) * 2); dsto[i] = 16384 + db * 4096 + rg * 1024; }
        }
        bf16x8 qf[4];
#pragma unroll
        for (int d0 = 0; d0 < 4; ++d0) qf[d0] = *(const bf16x8*)(Q + (rowb + qw0 + r32) * D + (2 * h + c) * 64 + d0 * 16 + hi * 8);
#pragma unroll
        for (int d0 = 0; d0 < 4; ++d0) asm volatile("" : "+v"(qf[d0]));
        f32x16 o[4];
#pragma unroll
        for (int db = 0; db < 4; ++db)
#pragma unroll
            for (int r = 0; r < 16; ++r) o[db][r] = 0.f;
        float m = 0.f, l = 0.f; f32x16 negm;
#pragma unroll
        for (int r = 0; r < 16; ++r) negm[r] = 0.f;
        asm volatile("s_waitcnt lgkmcnt(0)" ::: "memory"); __builtin_amdgcn_s_barrier();
#pragma unroll
        for (int i = 0; i < 4; ++i) dma16s(sbase, soff[i], L + dsto[i]);
#pragma unroll
        for (int i = 0; i < 4; ++i) dma16s(sbase + (size_t)64 * D, soff[i], L + STG + dsto[i]);
        int sc_ = 0, sn_ = 2;
        for (int t = 0; t < NT; ++t) {
            if (t + 1 < NT) asm volatile("s_waitcnt vmcnt(4) lgkmcnt(0)" ::: "memory"); else asm volatile("s_waitcnt vmcnt(0) lgkmcnt(0)" ::: "memory");
            __builtin_amdgcn_s_barrier();
            if (t + 2 < NT) {
#pragma unroll
                for (int i = 0; i < 4; ++i) dma16s(sbase + (size_t)(t + 2) * 64 * D, soff[i], L + sn_ * STG + dsto[i]);
            }
            if (t <= T) {
                lds_cptr stg = (lds_cptr)L + sc_ * STG;
                tile<4, 4>(stg + c * 8192, stg + 16384, qf, o, negm, m, l, wsf, t == 0, t == T, qw0 - 64 * T + r32, lane);
            }
            sc_ = (sc_ == 2) ? 0 : sc_ + 1; sn_ = (sn_ == 2) ? 0 : sn_ + 1;
        }
        l = half_swap_sum(l);
        if (hi == 0) wsf[r32] = 1.0f / l;
        asm volatile("s_waitcnt lgkmcnt(0)" ::: "memory");
        f32x4 a4[4];
#pragma unroll
        for (int g = 0; g < 4; ++g) a4[g] = *(const LAS f32x4*)(wsf + 8 * g + 4 * hi);
#pragma unroll
        for (int db = 0; db < 4; ++db)
#pragma unroll
            for (int r = 0; r < 16; ++r) o[db][r] *= a4[r >> 2][r & 3];
        asm volatile("s_waitcnt lgkmcnt(0)" ::: "memory"); __builtin_amdgcn_s_barrier();
        LAS float* X = (LAS float*)L + wq * 4096;
        if (c == 1) {
#pragma unroll
            for (int db = 0; db < 4; ++db)
#pragma unroll
                for (int r = 0; r < 16; ++r) X[(db * 16 + r) * 64 + lane] = o[db][r];
        }
        asm volatile("s_waitcnt lgkmcnt(0)" ::: "memory"); __builtin_amdgcn_s_barrier();
        if (c == 0) {
            float gsub[4];
#pragma unroll
            for (int db = 0; db < 4; ++db) gsub[db] = C.in[I_DA_SUBLN][db * 32 + r32] * 0.8f;
#pragma unroll
            for (int r = 0; r < 16; ++r) {
                float v[4], ss = 0.f;
#pragma unroll
                for (int db = 0; db < 4; ++db) { v[db] = o[db][r] - lam * X[(db * 16 + r) * 64 + lane]; ss += v[db] * v[db]; }
#pragma unroll
                for (int off = 1; off < 32; off <<= 1) ss += __shfl_xor(ss, off);
                const float rstd = 1.0f / sqrtf(ss * (1.0f / 128.0f) + EPS);
                bf16* orow = O + (rowb + qw0 + crow(r, hi)) * D + h * 128 + r32;
#pragma unroll
                for (int db = 0; db < 4; ++db) orow[db * 32] = (bf16)f2bf(v[db] * rstd * gsub[db]);
            }
        }
    }
}
__device__ __forceinline__ void ph_attn_mla_mfma(const Ctx& C) {
    using namespace fa;
    LAS unsigned char* L = (LAS unsigned char*)C.lds;
    constexpr int STG = 20480;
    LAS float* wsf = (LAS float*)(L + 3 * STG) + C.wave * 32;
    const int vcu = ((int)blockIdx.x & 7) * 32 + ((int)blockIdx.x >> 3), xcd = vcu >> 5, grp = (vcu >> 3) & 3, jj = vcu & 7;
    const bf16* Q2 = (const bf16*)(C.ws + WS_A); const bf16* KV2 = (const bf16*)(C.ws + WS_A + 192 * MiB);
    const bf16* KPE = (const bf16*)(C.ws + WS_KPE); bf16* O = (bf16*)(C.ws + WS_O);
    const int lane = C.lane, w = C.wave, r32 = lane & 31, hi = lane >> 5;
    const float c2 = 0.10206207261596575f * 1.4426950408889634f;
    for (int u = 0; u < 16; ++u) {
        const int bh = xcd * 64 + 4 * u + grp, b = bh >> 4, h = bh & 15, qb = (u & 1) ? 7 - jj : jj, q0 = qb * 256;
        const size_t rowb = (size_t)b * SEQ;
        const int NT = (q0 + 256) / 64, qw0 = q0 + 32 * w, T = qw0 >> 6;
        const bf16* src[3]; int dsto[3]; size_t sstep[3];
#pragma unroll
        for (int i = 0; i < 3; ++i) {
            const int pi = w + 8 * i;
            if (pi < 8) { src[i] = KV2 + (rowb + lane) * 2048 + h * 128 + pi * 8; dsto[i] = pi * 1024; sstep[i] = (size_t)64 * 2048; }
            else if (pi < 12) { src[i] = KPE + (rowb + lane) * 32 + (pi - 8) * 8; dsto[i] = pi * 1024; sstep[i] = (size_t)64 * 32; }
            else { const int db = (pi - 12) >> 2, rg = (pi - 12) & 3; src[i] = KV2 + (rowb + rg * 16 + (lane >> 2)) * 2048 + h * 128 + 64 + db * 32 + (lane & 3) * 8; dsto[i] = 12288 + db * 4096 + rg * 1024; sstep[i] = (size_t)64 * 2048; }
        }
        const bool has3 = (w + 16) < 20;
        bf16x8 qf[6];
#pragma unroll
        for (int d0 = 0; d0 < 6; ++d0) qf[d0] = *(const bf16x8*)(Q2 + (rowb + qw0 + r32) * 1536 + h * 96 + d0 * 16 + hi * 8);
#pragma unroll
        for (int d0 = 0; d0 < 6; ++d0) asm volatile("" : "+v"(qf[d0]));
        f32x16 o[2];
#pragma unroll
        for (int db = 0; db < 2; ++db)
#pragma unroll
            for (int r = 0; r < 16; ++r) o[db][r] = 0.f;
        float m = 0.f, l = 0.f; f32x16 negm;
#pragma unroll
        for (int r = 0; r < 16; ++r) negm[r] = 0.f;
        asm volatile("s_waitcnt lgkmcnt(0)" ::: "memory"); __builtin_amdgcn_s_barrier();
        dma16(src[0], L + dsto[0]); dma16(src[1], L + dsto[1]); if (has3) dma16(src[2], L + dsto[2]);
        dma16(src[0] + sstep[0], L + STG + dsto[0]); dma16(src[1] + sstep[1], L + STG + dsto[1]); if (has3) dma16(src[2] + sstep[2], L + STG + dsto[2]);
        int sc_ = 0, sn_ = 2;
        for (int t = 0; t < NT; ++t) {
            if (t + 1 < NT) { if (has3) asm volatile("s_waitcnt vmcnt(3) lgkmcnt(0)" ::: "memory"); else asm volatile("s_waitcnt vmcnt(2) lgkmcnt(0)" ::: "memory"); }
            else asm volatile("s_waitcnt vmcnt(0) lgkmcnt(0)" ::: "memory");
            __builtin_amdgcn_s_barrier();
            if (t + 2 < NT) {
                LAS unsigned char* nb = L + sn_ * STG;
                dma16(src[0] + (t + 2) * sstep[0], nb + dsto[0]); dma16(src[1] + (t + 2) * sstep[1], nb + dsto[1]); if (has3) dma16(src[2] + (t + 2) * sstep[2], nb + dsto[2]);
            }
            if (t <= T) {
                lds_cptr stg = (lds_cptr)L + sc_ * STG;
                tile<6, 2>(stg, stg + 12288, qf, o, negm, m, l, wsf, t == 0, t == T, qw0 - 64 * T + r32, lane);
            }
            sc_ = (sc_ == 2) ? 0 : sc_ + 1; sn_ = (sn_ == 2) ? 0 : sn_ + 1;
        }
        l = half_swap_sum(l);
        if (hi == 0) wsf[r32] = 1.0f / l;
        asm volatile("s_waitcnt lgkmcnt(0)" ::: "memory");
        f32x4 a4[4];
#pragma unroll
        for (int g = 0; g < 4; ++g) a4[g] = *(const LAS f32x4*)(wsf + 8 * g + 4 * hi);
#pragma unroll
        for (int r = 0; r < 16; ++r) {
            bf16* orow = O + (rowb + qw0 + crow(r, hi)) * D + h * 64 + r32;
#pragma unroll
            for (int db = 0; db < 2; ++db) orow[db * 32] = (bf16)f2bf(o[db][r] * a4[r >> 2][r & 3]);
        }
    }
}

__global__ void __launch_bounds__(NTHR, 2) fwd(Args args) {
    extern __shared__ __attribute__((aligned(16))) unsigned char lds[];
    Ctx C; C.in = args.in; C.out = args.out; C.ws = args.ws; C.lds = lds;
    C.tid = threadIdx.x; C.lane = C.tid & 63; C.wave = __builtin_amdgcn_readfirstlane(C.tid >> 6);
    C.gw = blockIdx.x * NWAVES + C.wave; C.ngw = gridDim.x * NWAVES;
    const Ctx C0 = C;
    volatile LAS unsigned* MISC = (volatile LAS unsigned*)((LAS unsigned char*)lds + MISC_OFF);
    if (C.tid < 32) MISC[C.tid] = 0u;
    __syncthreads();
    XcdBarrier bar; bar.bar = (unsigned*)(args.ws + WS_CTL) + CW_BAR; bar.x = 0; bar.st = nullptr;
    const int lo = args.ph_lo, hi = args.ph_hi;
    if (hi - lo > 1) bar = xcd_barrier_post((unsigned*)(args.ws + WS_CTL) + CW_BAR, MISC + 8);
#ifndef REPMASK
#define REPMASK 0u
#endif
#ifndef PHMASK
#define PHMASK 0xFFFFFFFFu
#endif
#define IN(k) (lo <= (k) && (k) < hi && ((PHMASK >> (k)) & 1u))
#define SEAM(k) do { if (IN(k) && IN((k) + 1)) xcd_barrier(bar); } while (0)
#define PHLOCAL unsigned char* ws = args.ws; asm volatile("" : "+s"(ws)); int t_ = threadIdx.x; asm volatile("" : "+v"(t_)); Ctx C = C0; C.ws = ws; C.tid = t_; C.lane = t_ & 63; \
        bf16* H = (bf16*)(ws + WS_H); bf16* O = (bf16*)(ws + WS_O); bf16* A0 = (bf16*)(ws + WS_A); (void)H; (void)O; (void)A0;

    if (IN(0)) { PHLOCAL ph_prologue(C); } SEAM(0);
    if (IN(1)) { PHLOCAL ph_normmod0(C); } SEAM(1);
    if (IN(2)) { PHLOCAL
        pg8::Gemm g{H, (const bf16*)(ws + WB_QKV), NTOK, 3 * D, D}; pg8::StaticOrder S; S.init(NTOK, 3 * D, (int)gridDim.x, (int)blockIdx.x);
        pg8::EpiQKV E{A0, A0 + (size_t)NTOK * D, A0 + (size_t)2 * NTOK * D, (const float*)(ws + WS_COSD), (const float*)(ws + WS_SIND), args.in[I_DA_QN], args.in[I_DA_KN], 0.125f * 1.4426950408889634f, EPS};
        pg8::gemm_phase<pg8::EpiQKV, pg8::StaticOrder, PG8_ALIGN, PG8_SP2>((PG8_LAS unsigned char*)lds, g, S, E);
    } SEAM(2);
    if (IN(3)) { PHLOCAL ph_attn_da_mfma(C); } SEAM(3);
    if (IN(4)) { PHLOCAL
        pg8::Gemm g{O, (const bf16*)(ws + WB_DAO), NTOK, D, D}; pg8::StaticOrder S; S.init(NTOK, D, (int)gridDim.x, (int)blockIdx.x);
        pg8::EpiResid<true> E{args.in[I_X], (bf16*)(ws + WS_XB), C.mod(0, 0, 2), (float*)(ws + WS_SSQX)};
        pg8::gemm_phase<pg8::EpiResid<true>, pg8::StaticOrder, PG8_ALIGN, PG8_SP2>((PG8_LAS unsigned char*)lds, g, S, E);
    } SEAM(4);
    if (IN(5)) { PHLOCAL ph_route(C, 0); } SEAM(5);
    if (IN(6)) { PHLOCAL ph_moe1_mfma(C, 0); } SEAM(6);
    if (IN(7)) { PHLOCAL ph_moe2_mfma(C, 0); } SEAM(7);
    if (IN(8)) { PHLOCAL ph_comb<false>(C, ws + WS_A + 128 * MiB, C.mod(0, 0, 5), 1, args.in[I_NMIX] + D); } SEAM(8);
    if (IN(9)) { PHLOCAL
        bf16* CQ = (bf16*)(ws + WS_S); bf16* CKV = CQ + (size_t)NTOK * 384; bf16* KPE = (bf16*)(ws + WS_KPE);
        pg8::Gemm g{H, (const bf16*)(ws + WB_WIN), NTOK, 768, D}; pg8::StaticOrder S; S.init(NTOK, 768, (int)gridDim.x, (int)blockIdx.x);
        pg8::EpiWin E{CQ, CKV, KPE, (float*)(ws + WS_SSQ), (const float*)(ws + WS_COSM), (const float*)(ws + WS_SINM), args.in[I_M_KPN], EPS};
        pg8::gemm_phase<pg8::EpiWin, pg8::StaticOrder, PG8_ALIGN, PG8_SP2>((PG8_LAS unsigned char*)lds, g, S, E);
    } SEAM(9);
    if (IN(10)) { PHLOCAL
        const bf16* CQ = (const bf16*)(ws + WS_S); const bf16* CKV = CQ + (size_t)NTOK * 384;
        int Kq = 384, Kkv = 256; asm volatile("" : "+s"(Kq), "+s"(Kkv));
        { pg8::Gemm g{CQ, (const bf16*)(ws + WB_WUQ), NTOK, 1536, Kq}; pg8::StaticOrder S; S.init(NTOK, 1536, (int)gridDim.x, (int)blockIdx.x);
          pg8::EpiUQ E{A0, (const float*)(ws + WS_SSQ), (const float*)(ws + WS_COSM), (const float*)(ws + WS_SINM), args.in[I_M_QNN], args.in[I_M_QPN], 0.10206207261596575f * 1.4426950408889634f, EPS};
          pg8::gemm_phase<pg8::EpiUQ, pg8::StaticOrder, PG8_ALIGN, PG8_SP2>((PG8_LAS unsigned char*)lds, g, S, E); }
        { pg8::Gemm g{CKV, (const bf16*)(ws + WB_WUKV), NTOK, 2048, Kkv}; pg8::StaticOrder S; S.init(NTOK, 2048, (int)gridDim.x, (int)blockIdx.x);
          pg8::EpiUKV E{(bf16*)(ws + WS_A + 192 * MiB), (const float*)(ws + WS_SSQ), args.in[I_M_KNN], EPS};
          pg8::gemm_phase<pg8::EpiUKV, pg8::StaticOrder, PG8_ALIGN, PG8_SP2>((PG8_LAS unsigned char*)lds, g, S, E); }
    } SEAM(10);
    if (IN(11)) { PHLOCAL ph_attn_mla_mfma(C); } SEAM(11);
    if (IN(12)) { PHLOCAL
        pg8::Gemm g{O, (const bf16*)(ws + WB_MLO), NTOK, D, D}; pg8::StaticOrder S; S.init(NTOK, D, (int)gridDim.x, (int)blockIdx.x);
        pg8::EpiResid<false> E{ws + WS_XB, (bf16*)(ws + WS_XB), C.mod(1, 0, 2), (float*)(ws + WS_SSQX)};
        pg8::gemm_phase<pg8::EpiResid<false>, pg8::StaticOrder, PG8_ALIGN, PG8_SP2>((PG8_LAS unsigned char*)lds, g, S, E);
    } SEAM(12);
    if (IN(13)) { PHLOCAL ph_route(C, 1); } SEAM(13);
    if (IN(14)) { PHLOCAL ph_moe1_mfma(C, 1); } SEAM(14);
    if (IN(15)) { PHLOCAL ph_moe2_mfma(C, 1); } SEAM(15);
    if (IN(16)) { PHLOCAL ph_comb<true>(C, ws + WS_A + 128 * MiB, C.mod(1, 0, 5), 1, args.in[I_NMIX]); }
#undef IN
#undef SEAM
}

extern "C" void kernel_launch(void* const* d_in, const int* in_sizes, int n_in, void* d_out, int out_size, void* d_ws, size_t ws_size, hipStream_t stream) {
    static int grid = 0;
    if (grid == 0) {
        if (n_in != 33 || out_size != NTOK * D || ws_size < WS_END) { fprintf(stderr, "kernel_launch: unexpected shapes n_in %d out %d ws %zu\n", n_in, out_size, ws_size); grid = -1; return; }
        int dev = 0, cus = 0;
        if (hipGetDevice(&dev) != hipSuccess || hipDeviceGetAttribute(&cus, hipDeviceAttributeMultiprocessorCount, dev) != hipSuccess) { grid = -1; return; }
        if (hipFuncSetAttribute((const void*)fwd, hipFuncAttributeMaxDynamicSharedMemorySize, LDS_BYTES) != hipSuccess) { fprintf(stderr, "hipFuncSetAttribute failed\n"); grid = -1; return; }
        (void)hipGetLastError();
        grid = cus;
        if (grid != 256) { fprintf(stderr, "kernel_launch: built for 256 CUs, device reports %d\n", cus); grid = -1; return; }
    }
    if (grid < 0) return;
    (void)hipMemsetAsync((char*)d_ws + WS_CTL, 0, CTL_ZERO_BYTES, stream);
    Args a{};
    for (int i = 0; i < 33; ++i) a.in[i] = (const float*)d_in[i];
    a.out = (float*)d_out; a.ws = (unsigned char*)d_ws;
#if MK_ONE_LAUNCH
    a.ph_lo = 0; a.ph_hi = N_PHASES;
    hipLaunchKernelGGL(fwd, dim3(grid), dim3(NTHR), LDS_BYTES, stream, a);
#else
    for (int p = 0; p < N_PHASES; ++p) { a.ph_lo = p; a.ph_hi = p + 1; hipLaunchKernelGGL(fwd, dim3(grid), dim3(NTHR), LDS_BYTES, stream, a); }
#endif
}
```

```cpp
#include <hip/hip_runtime.h>
#include <cstdio>
#include <cstdint>

#define LAS __attribute__((address_space(3)))
#define GAS __attribute__((address_space(1)))
template <class T> __device__ __forceinline__ T* as_global(T* p) { GAS T* g = (GAS T*)p; asm("" : "+s"(g)); return (T*)g; }
typedef unsigned short bf16;
typedef float f32x4 __attribute__((ext_vector_type(4)));
typedef unsigned u32x4 __attribute__((ext_vector_type(4)));
typedef unsigned u32x2 __attribute__((ext_vector_type(2)));

constexpr int NB = 32, SEQ = 2048, D = 1024, NTOK = NB * SEQ;
constexpr float EPS = 1e-6f;
constexpr int NWAVES = 8, NTHR = 512;
constexpr int N_PHASES = 17;
#ifndef MK_ONE_LAUNCH
#define MK_ONE_LAUNCH 1
#endif

constexpr size_t MiB = 1u << 20;
constexpr size_t WS_CTL = 0, CTL_ZERO_BYTES = 1 * MiB;
constexpr size_t WS_MOD = 1 * MiB;
constexpr size_t WS_LAM = WS_MOD + 7 * MiB / 4;
constexpr size_t WS_SSQX = 4 * MiB;
constexpr size_t WS_SSQ = 8 * MiB;
constexpr size_t WS_WRT = 12 * MiB;
constexpr size_t WS_COSD = 16 * MiB, WS_SIND = 24 * MiB, WS_COSM = 32 * MiB, WS_SINM = 36 * MiB;
constexpr size_t WS_TOKW = 40 * MiB;
constexpr size_t WS_LIST = 42 * MiB;
constexpr size_t WS_WB = 50 * MiB;
constexpr size_t WB_QKV = WS_WB, WB_DAO = WB_QKV + 6 * MiB, WB_WIN = WB_DAO + 2 * MiB, WB_WUQ = WB_WIN + 3 * MiB / 2, WB_WUKV = WB_WUQ + 9 * MiB / 8, WB_MLO = WB_WUKV + 1 * MiB, WB_MOE = WB_MLO + 2 * MiB;
constexpr size_t WS_H = 176 * MiB;
constexpr size_t WS_O = 304 * MiB;
constexpr size_t WS_A = 432 * MiB;
constexpr size_t WS_LISTW = 160 * MiB;
constexpr size_t WS_KPE = 168 * MiB;
constexpr size_t WS_S = WS_O;
constexpr size_t WS_XB = 880 * MiB;
constexpr size_t WS_END = 1008 * MiB;
constexpr int CW_BAR = 4096;
constexpr int CW_CNT = 16384;
constexpr int HID_ROWS = 2 * NTOK + 32 * 128;

constexpr int LDS_BYTES = 147456;
constexpr int MISC_OFF = 131072 + 320;

__device__ __forceinline__ unsigned f2bf(float f) { unsigned u = __builtin_bit_cast(unsigned, f); return (u + 0x7fffu + ((u >> 16) & 1u)) >> 16; }
__device__ __forceinline__ float bf2f(unsigned h) { return __builtin_bit_cast(float, h << 16); }
__device__ __forceinline__ unsigned pk2(float lo, float hi) { return f2bf(lo) | (f2bf(hi) << 16); }
__device__ __forceinline__ float wave_sum(float v) {
#pragma unroll
    for (int o = 1; o < 64; o <<= 1) v += __shfl_xor(v, o);
    return v;
}
__device__ __forceinline__ float wave_max(float v) {
#pragma unroll
    for (int o = 1; o < 64; o <<= 1) v = fmaxf(v, __shfl_xor(v, o));
    return v;
}

#define XB_TMO      128
#define XB_XCNT(j)  (256  + 64 * (j))
#define XB_XSUB(j)  (1280 + 64 * (j))
#define XB_XGEN(j)  (2304 + 64 * (j))
#define XB_TOP      3328
#define XB_TOPGEN   3392
#define XCD_BAR_WORDS 3456
#define XB_SPIN_CAP (1u << 20)
__device__ __forceinline__ unsigned xb_ld(unsigned* p)              { return __hip_atomic_load(p, __ATOMIC_RELAXED, __HIP_MEMORY_SCOPE_AGENT); }
__device__ __forceinline__ unsigned xb_add(unsigned* p, unsigned v) { return __hip_atomic_fetch_add(p, v, __ATOMIC_RELAXED, __HIP_MEMORY_SCOPE_AGENT); }
__device__ __forceinline__ unsigned xb_xcc_id() { return (unsigned)__builtin_amdgcn_s_getreg((3 << 11) | 20) & 0xFu; }
#define XB_SPIN(cond, bar) do { unsigned _sp = 0; while (cond) { __builtin_amdgcn_s_sleep(1); \
    if ((++_sp & 255u) == 0u) { if (xb_ld(&(bar)[XB_TMO])) break; if (_sp > XB_SPIN_CAP) { atomicAdd(&(bar)[XB_TMO], 1u); break; } } } } while (0)
struct XcdBarrier { unsigned* bar; unsigned x; volatile LAS unsigned* st; };
__device__ __forceinline__ XcdBarrier xcd_barrier_post(unsigned* bar, volatile LAS unsigned* st) {
    XcdBarrier b; b.bar = bar; b.x = xb_xcc_id(); b.st = st;
    if (threadIdx.x == 0) (void)xb_add(&bar[XB_XCNT(b.x)], 1u);
    return b;
}
__device__ __forceinline__ void xcd_barrier_complete(unsigned* bar, unsigned x, unsigned& nloc, unsigned& nx) {
    const unsigned G = gridDim.x * gridDim.y * gridDim.z;
    unsigned sum, cnt, mine, sp = 0u;
    for (;;) {
        sum = 0u; cnt = 0u; mine = 0u;
#pragma unroll
        for (unsigned j = 0; j < 16; ++j) { const unsigned c = xb_ld(&bar[XB_XCNT(j)]); sum += c; cnt += (c > 0u) ? 1u : 0u; mine = (j == x) ? c : mine; }
        if (sum == G) break;
        __builtin_amdgcn_s_sleep(1);
        if ((++sp & 255u) == 0u) { if (xb_ld(&bar[XB_TMO])) break; if (sp > XB_SPIN_CAP) { atomicAdd(&bar[XB_TMO], 1u); break; } }
    }
    nloc = mine > 0u ? mine : 1u; nx = cnt > 0u ? cnt : 1u;
}
__device__ __forceinline__ void xcd_barrier(const XcdBarrier& b) {
    asm volatile("s_waitcnt vmcnt(0)" ::: "memory");
    __syncthreads();
    if (threadIdx.x == 0) {
        unsigned* bar = b.bar;
        __builtin_amdgcn_s_waitcnt(0);
        unsigned nloc = b.st[0], nx = b.st[1];
        if (nloc == 0u) { xcd_barrier_complete(bar, b.x, nloc, nx); b.st[0] = nloc; b.st[1] = nx; }
        const unsigned old = xb_add(&bar[XB_XSUB(b.x)], 1u);
        const unsigned gen = old / nloc;
        if (old + 1u == (gen + 1u) * nloc) {
            __builtin_amdgcn_fence(__ATOMIC_RELEASE, "agent");
            asm volatile("s_waitcnt vmcnt(0)" ::: "memory");
            const unsigned og = xb_add(&bar[XB_TOP], 1u);
            const unsigned tg = og / nx;
            if (og + 1u == (tg + 1u) * nx) xb_add(&bar[XB_TOPGEN], 1u);
            else XB_SPIN(xb_ld(&bar[XB_TOPGEN]) == tg, bar);
            __builtin_amdgcn_fence(__ATOMIC_ACQUIRE, "agent");
            xb_add(&bar[XB_XGEN(b.x)], 1u);
            asm volatile("s_waitcnt vmcnt(0)" ::: "memory");
        } else {
            XB_SPIN(xb_ld(&bar[XB_XGEN(b.x)]) == gen, bar);
            __builtin_amdgcn_fence(__ATOMIC_ACQUIRE, "agent");
            asm volatile("s_waitcnt vmcnt(0)" ::: "memory");
        }
    }
    __syncthreads();
}

namespace pg8 {
#define PG8_LAS __attribute__((address_space(3)))
typedef unsigned short bf16_t;
typedef short bf16x8 __attribute__((ext_vector_type(8)));
typedef float f32x4 __attribute__((ext_vector_type(4)));
typedef unsigned u32x4 __attribute__((ext_vector_type(4)));
constexpr int BM = 256, BK = 64, HALF = 128, HTB = HALF * BK * 2  , STAGE_BYTES = 8 * HTB, NXCD = 8, WGM = 8;

__host__ __device__ __forceinline__ int lds_byte(int r, int c) { const int st = (r >> 4) * 2 + (c >> 5), rr = r & 15, cc = c & 31, ob = rr * 64 + cc * 2; return st * 1024 + (ob ^ (((ob >> 9) & 1) << 5)); }
__host__ __device__ __forceinline__ void stage_rc(int b, int& R, int& C) { const int st = b / 1024, sb = b % 1024, swz = sb ^ (((sb >> 9) & 1) << 5); R = (st >> 1) * 16 + swz / 64; C = (st & 1) * 32 + (swz % 64) / 2; }
__host__ __device__ __forceinline__ int perm32(int rho) { const int n = rho >> 4, i = rho & 15; return 8 * (i >> 2) + 4 * n + (i & 3); }

struct Unit { int pm, pn; };
struct Gemm { const bf16_t* A; const bf16_t* Bt; int M, N, K; };

struct StaticOrder {
    typedef Unit UnitT;
    int nM, nN, nwg, G, c;
    __host__ __device__ void init(int M, int N, int G_, int c_) { nM = M / BM; nN = N / BM; nwg = nM * nN; G = G_; c = c_; }
    __host__ __device__ bool next(int i, Unit& u) const {
        const long L = (long)i * G + c; if (L >= nwg) return false;
        int wgid = (int)L; { const int q = nwg / NXCD, r = nwg % NXCD, xcd = wgid % NXCD, off = wgid / NXCD; wgid = (xcd < r ? xcd * (q + 1) : r * (q + 1) + (xcd - r) * q) + off; }
        const int nig = WGM * nN, gid = wgid / nig, fm = gid * WGM, gsz = (nM - fm) < WGM ? (nM - fm) : WGM;
        u.pm = fm + ((wgid % nig) % gsz); u.pn = (wgid % nig) / gsz; return true;
    }
    __device__ __forceinline__ void a_ready(const Unit&) const {}
    __device__ __forceinline__ void done(const Unit&) const {}
};

__device__ __forceinline__ unsigned cvt_pk_bf16(float lo, float hi) { unsigned r; asm volatile("v_cvt_pk_bf16_f32 %0, %1, %2" : "=v"(r) : "v"(lo), "v"(hi)); return r; }
typedef float f32x2 __attribute__((ext_vector_type(2)));
__device__ __forceinline__ f32x2 gelu_pk(f32x2 v) {
    const f32x2 av = __builtin_elementwise_abs(v), d = av * 0.2316418882f + 1.0f;
    f32x2 t; t.x = __builtin_amdgcn_rcpf(d.x); t.y = __builtin_amdgcn_rcpf(d.y);
    f32x2 q = t * 0.5307027145f + (-0.7265760135f); q = q * t + 0.7107068705f; q = q * t + (-0.142248368f); q = q * t + 0.127414796f; q = q * t;
    const f32x2 s = (v * v) * (-0.72134752044f);
    f32x2 e; e.x = __builtin_amdgcn_exp2f(s.x); e.y = __builtin_amdgcn_exp2f(s.y);
    const f32x2 m = v * (q * e), r = v - m;
    f32x2 o; o.x = v.x < 0.f ? m.x : r.x; o.y = v.y < 0.f ? m.y : r.y; return o;
}

template <int ACT  > struct EpiBf16 {
    static constexpr bool PERM = true, AFTER_DRAIN = false; static_assert(ACT == 0 || ACT == 1, "EpiBf16: ACT is 0 (none) or 1 (gelu_pk)");
    bf16_t* O; int ldc; const float* bias; int split_cols; size_t split_stride; float scale0;
    __device__ __forceinline__ void operator()(const f32x4 (&acc)[2][2][4][2], const Unit& u, int wr, int wc, int fr, int fq) const {
        const int row0 = u.pm * BM + wr * 64 + fr; int colt = u.pn * BM; bf16_t* base = O;
        float sc = 1.f; if (split_cols) { const int t = colt / split_cols; base += (size_t)t * split_stride; colt -= t * split_cols; if (t == 0) sc = scale0; }
        const int col0 = colt + wc * 32 + 8 * fq, bcol0 = u.pn * BM + wc * 32 + 8 * fq;
        f32x4 bv[2][2];
#pragma unroll
        for (int bj = 0; bj < 2; ++bj)
#pragma unroll
            for (int n = 0; n < 2; ++n) bv[bj][n] = bias ? *(const f32x4*)(bias + bcol0 + bj * HALF + 4 * n) : (f32x4){0.f, 0.f, 0.f, 0.f};
#pragma unroll
        for (int ai = 0; ai < 2; ++ai)
#pragma unroll
            for (int m = 0; m < 4; ++m) { bf16_t* rowp = base + (size_t)(row0 + ai * HALF + m * 16) * ldc + col0;
#pragma unroll
                for (int bj = 0; bj < 2; ++bj) { f32x4 v0 = acc[ai][bj][m][0] + bv[bj][0], v1 = acc[ai][bj][m][1] + bv[bj][1];
                    if (ACT == 1) { f32x2 a = gelu_pk((f32x2){v0[0], v0[1]}), b = gelu_pk((f32x2){v0[2], v0[3]}), c = gelu_pk((f32x2){v1[0], v1[1]}), d = gelu_pk((f32x2){v1[2], v1[3]});
                        v0 = (f32x4){a.x, a.y, b.x, b.y}; v1 = (f32x4){c.x, c.y, d.x, d.y}; }
                    v0 = v0 * sc; v1 = v1 * sc; u32x4 w; w.x = cvt_pk_bf16(v0[0], v0[1]); w.y = cvt_pk_bf16(v0[2], v0[3]); w.z = cvt_pk_bf16(v1[0], v1[1]); w.w = cvt_pk_bf16(v1[2], v1[3]);
                    *(u32x4*)(rowp + bj * HALF) = w; } }
    }
};

template <class Epi, class Sched, bool ALIGN_EPI = false, bool SP2 = false>
__device__ __forceinline__ void gemm_phase(PG8_LAS unsigned char* lds, const Gemm g, const Sched& S, const Epi& E) {
    int tid_ = threadIdx.x; asm volatile("" : "+v"(tid_));
    const int tid = tid_, wid = __builtin_amdgcn_readfirstlane(tid >> 6), lane = tid & 63, wr = wid >> 2, wc = wid & 3, fr = lane & 15, fq = lane >> 4;
    const int K = g.K, nt = K / BK;
    unsigned voffA[2], voffB[2];
#pragma unroll
    for (int i = 0; i < 2; ++i) { int R, C; stage_rc(tid * 16 + i * 8192, R, C); const int Rb = Epi::PERM ? ((R & ~31) + perm32(R & 31)) : R;
        voffA[i] = (unsigned)(R * K + C) * 2u; voffB[i] = (unsigned)(Rb * K + C) * 2u; }
    const size_t kstep = (size_t)(BK * 2);
    const size_t hstep = (size_t)HALF * K * 2;
    const size_t tstep = 2 * hstep;
    const unsigned ldsw = (unsigned)wid * 1024u;
    const int aoff = lds_byte(wr * 64 + fr, fq * 8), boff = lds_byte(wc * 32 + fr, fq * 8);
#define PG8_SA(b, h) (((b) * 2 + (h)) * HTB)
#define PG8_SB(b, h) ((4 + (b) * 2 + (h)) * HTB)
#define PG8_STAGE(bufoff, gbase, voff) do { _Pragma("unroll") for (int _i = 0; _i < 2; ++_i) \
        __builtin_amdgcn_global_load_lds((const unsigned*)((const char*)(gbase) + (voff)[_i]), (PG8_LAS unsigned*)(lds + (bufoff) + ldsw + _i * 8192), 16, 0, 0); } while (0)
#define PG8_LDA(dst, b, h) do { _Pragma("unroll") for (int m = 0; m < 4; ++m) _Pragma("unroll") for (int k = 0; k < 2; ++k) dst[m][k] = *(const PG8_LAS bf16x8*)(lds + PG8_SA(b, h) + aoff + m * 2048 + k * 1024); } while (0)
#define PG8_LDB(dst, b, h) do { _Pragma("unroll") for (int n = 0; n < 2; ++n) _Pragma("unroll") for (int k = 0; k < 2; ++k) dst[n][k] = *(const PG8_LAS bf16x8*)(lds + PG8_SB(b, h) + boff + n * 2048 + k * 1024); } while (0)
#define PG8_MMA(ai, bj, At, Bt) do { __builtin_amdgcn_s_setprio(1); _Pragma("unroll") for (int m = 0; m < 4; ++m) _Pragma("unroll") for (int n = 0; n < 2; ++n) _Pragma("unroll") for (int k = 0; k < 2; ++k) \
        acc[ai][bj][m][n] = __builtin_amdgcn_mfma_f32_16x16x32_bf16(Bt[n][k], At[m][k], acc[ai][bj][m][n], 0, 0, 0); __builtin_amdgcn_s_setprio(0); } while (0)
#define PG8_WAIT_V(n) asm volatile("s_waitcnt vmcnt(" #n ")" ::: "memory")
#define PG8_WAIT_L(n) asm volatile("s_waitcnt lgkmcnt(" #n ")" ::: "memory")
#define PG8_BAR __builtin_amdgcn_s_barrier()
#define PG8_SCHED __builtin_amdgcn_sched_barrier(0)
    typename Sched::UnitT cur, nxt; int ui = 0;
    if (!S.next(0, cur)) return;
    f32x4 acc[2][2][4][2];
#pragma unroll
    for (int a = 0; a < 2; ++a)
#pragma unroll
        for (int b = 0; b < 2; ++b)
#pragma unroll
            for (int m = 0; m < 4; ++m)
#pragma unroll
                for (int n = 0; n < 2; ++n) acc[a][b][m][n] = (f32x4){0.f, 0.f, 0.f, 0.f};
    bf16x8 At[4][2], B0[2][2], B1[2][2];
    const char* cA = (const char*)g.A + (size_t)cur.pm * tstep; const char* cB = (const char*)g.Bt + (size_t)cur.pn * tstep;
    S.a_ready(cur);
    if constexpr (SP2) {
        PG8_STAGE(PG8_SB(0, 0), cB, voffB); PG8_STAGE(PG8_SB(0, 1), cB + hstep, voffB); PG8_STAGE(PG8_SA(0, 0), cA, voffA); PG8_STAGE(PG8_SA(0, 1), cA + hstep, voffA);
        if (wr == 1) PG8_BAR;
        PG8_WAIT_V(2); PG8_BAR;
        PG8_STAGE(PG8_SB(1, 0), cB + kstep, voffB); PG8_STAGE(PG8_SA(1, 0), cA + kstep, voffA); PG8_STAGE(PG8_SB(1, 1), cB + hstep + kstep, voffB);
        PG8_WAIT_V(6); PG8_BAR;
    } else {
        PG8_STAGE(PG8_SB(0, 0), cB, voffB); PG8_STAGE(PG8_SA(0, 0), cA, voffA); PG8_STAGE(PG8_SB(0, 1), cB + hstep, voffB); PG8_STAGE(PG8_SA(0, 1), cA + hstep, voffA);
        if (wr == 1) PG8_BAR;
        PG8_WAIT_V(4); PG8_BAR;
        PG8_STAGE(PG8_SB(1, 0), cB + kstep, voffB); PG8_STAGE(PG8_SA(1, 0), cA + kstep, voffA); PG8_STAGE(PG8_SB(1, 1), cB + hstep + kstep, voffB);
        PG8_WAIT_V(6); PG8_BAR;
    }
    for (;;) {
        const bool has_next = S.next(ui + 1, nxt);
        const char* nA = has_next ? (const char*)g.A + (size_t)nxt.pm * tstep : cA; const char* nB = has_next ? (const char*)g.Bt + (size_t)nxt.pn * tstep : cB;
        for (int t = 0; t < nt; t += 2) {
            const bool last = (t == nt - 2);
            const char* a1 = cA + (size_t)(t + 1) * kstep;
            const char* a2 = last ? nA : cA + (size_t)(t + 2) * kstep; const char* b2 = last ? nB : cB + (size_t)(t + 2) * kstep;
            const char* a3 = a2 + kstep; const char* b3 = b2 + kstep;
            if (last && has_next) S.a_ready(nxt);
            if constexpr (SP2) {
            PG8_LDB(B0, 0, 0); PG8_LDB(B1, 0, 1); PG8_SCHED; PG8_LDA(At, 0, 0); PG8_STAGE(PG8_SA(1, 1), a1 + hstep, voffA);
            PG8_WAIT_V(8); PG8_WAIT_L(0); PG8_BAR; PG8_MMA(0, 0, At, B0); PG8_MMA(0, 1, At, B1); PG8_BAR; PG8_SCHED;
            PG8_LDA(At, 0, 1); PG8_STAGE(PG8_SB(0, 0), b2, voffB); PG8_STAGE(PG8_SB(0, 1), b2 + hstep, voffB); PG8_STAGE(PG8_SA(0, 0), a2, voffA);
            PG8_WAIT_V(8); PG8_WAIT_L(0); PG8_BAR; PG8_MMA(1, 0, At, B0); PG8_MMA(1, 1, At, B1); PG8_BAR; PG8_SCHED;
            PG8_LDB(B0, 1, 0); PG8_LDB(B1, 1, 1); PG8_SCHED; PG8_LDA(At, 1, 0); PG8_STAGE(PG8_SA(0, 1), a2 + hstep, voffA);
            PG8_WAIT_V(8); PG8_WAIT_L(0); PG8_BAR; PG8_MMA(0, 0, At, B0); PG8_MMA(0, 1, At, B1); PG8_BAR; PG8_SCHED;
            PG8_LDA(At, 1, 1); PG8_STAGE(PG8_SB(1, 0), b3, voffB); PG8_STAGE(PG8_SB(1, 1), b3 + hstep, voffB); PG8_STAGE(PG8_SA(1, 0), a3, voffA);
            PG8_WAIT_V(8); PG8_WAIT_L(0); PG8_BAR; PG8_MMA(1, 0, At, B0); PG8_MMA(1, 1, At, B1); PG8_BAR; PG8_SCHED;
            } else {
            PG8_LDB(B0, 0, 0); PG8_SCHED; PG8_LDA(At, 0, 0); PG8_STAGE(PG8_SA(1, 1), a1 + hstep, voffA);
            PG8_WAIT_L(8); PG8_BAR; PG8_WAIT_L(0); PG8_MMA(0, 0, At, B0); PG8_BAR; PG8_SCHED;
            PG8_LDB(B1, 0, 1); PG8_STAGE(PG8_SB(0, 0), b2, voffB);
            PG8_BAR; PG8_WAIT_L(0); PG8_MMA(0, 1, At, B1); PG8_BAR;
            PG8_LDA(At, 0, 1); PG8_STAGE(PG8_SA(0, 0), a2, voffA);
            PG8_BAR; PG8_WAIT_L(0); PG8_MMA(1, 0, At, B0); PG8_BAR; PG8_SCHED;
            PG8_STAGE(PG8_SB(0, 1), b2 + hstep, voffB);
            PG8_WAIT_V(6); PG8_BAR; PG8_MMA(1, 1, At, B1); PG8_BAR;
            PG8_LDB(B0, 1, 0); PG8_SCHED; PG8_LDA(At, 1, 0); PG8_STAGE(PG8_SA(0, 1), a2 + hstep, voffA);
            PG8_WAIT_L(8); PG8_BAR; PG8_WAIT_L(0); PG8_MMA(0, 0, At, B0); PG8_BAR; PG8_SCHED;
            PG8_LDB(B1, 1, 1); PG8_STAGE(PG8_SB(1, 0), b3, voffB);
            PG8_BAR; PG8_WAIT_L(0); PG8_MMA(0, 1, At, B1); PG8_BAR;
            PG8_LDA(At, 1, 1); PG8_STAGE(PG8_SA(1, 0), a3, voffA);
            PG8_BAR; PG8_WAIT_L(0); PG8_MMA(1, 0, At, B0); PG8_BAR; PG8_SCHED;
            PG8_STAGE(PG8_SB(1, 1), b3 + hstep, voffB);
            PG8_WAIT_V(6); PG8_BAR; PG8_MMA(1, 1, At, B1); PG8_BAR;
            }
        }
        if constexpr (ALIGN_EPI) { if (wr == 0) PG8_BAR; }
        if constexpr (!Epi::AFTER_DRAIN) { E(acc, cur, wr, wc, fr, fq); S.done(cur); }
        if (!has_next) break;
#pragma unroll
        for (int a = 0; a < 2; ++a)
#pragma unroll
            for (int b = 0; b < 2; ++b)
#pragma unroll
                for (int m = 0; m < 4; ++m)
#pragma unroll
                    for (int n = 0; n < 2; ++n) acc[a][b][m][n] = (f32x4){0.f, 0.f, 0.f, 0.f};
        cur = nxt; cA = nA; cB = nB; ++ui;
        if constexpr (ALIGN_EPI) { if (wr == 1) PG8_BAR; }
    }
    PG8_WAIT_V(0);
    if constexpr (!ALIGN_EPI) { if (wr == 0) PG8_BAR; }
    PG8_BAR;
    if constexpr (Epi::AFTER_DRAIN) { E.fused(acc, cur, wr, wc, fr, fq, lds, wid, lane); S.done(cur); }
#undef PG8_SA
#undef PG8_SB
#undef PG8_STAGE
#undef PG8_LDA
#undef PG8_LDB
#undef PG8_MMA
#undef PG8_WAIT_V
#undef PG8_WAIT_L
#undef PG8_BAR
#undef PG8_SCHED
}


__device__ __forceinline__ float quad_sum(float v) {
    auto a = __builtin_amdgcn_permlane16_swap(__float_as_uint(v), __float_as_uint(v), false, false); v = __uint_as_float(a[0]) + __uint_as_float(a[1]);
    auto b = __builtin_amdgcn_permlane32_swap(__float_as_uint(v), __float_as_uint(v), false, false); return __uint_as_float(b[0]) + __uint_as_float(b[1]);
}
__device__ __forceinline__ float sq4(const f32x4& v) { return (v[0] * v[0] + v[1] * v[1]) + (v[2] * v[2] + v[3] * v[3]); }
__device__ __forceinline__ u32x4 pack8(const f32x4& a, const f32x4& b) { u32x4 o; o.x = cvt_pk_bf16(a[0], a[1]); o.y = cvt_pk_bf16(a[2], a[3]); o.z = cvt_pk_bf16(b[0], b[1]); o.w = cvt_pk_bf16(b[2], b[3]); return o; }
struct EpiQKV {
    static constexpr bool PERM = true, AFTER_DRAIN = false;
    bf16_t* Q; bf16_t* K; bf16_t* V; const float* cosD; const float* sinD; const float* gq; const float* gk; float qscale; float eps;
    __device__ __forceinline__ void operator()(const f32x4 (&acc)[2][2][4][2], const Unit& u, int wr, int wc, int fr, int fq) const {
        asm volatile("" : "+v"(fr), "+v"(fq));
        const int tile = u.pn; const unsigned row0 = (unsigned)(u.pm * BM + wr * 64 + fr);
        if (tile >= 8) {
            bf16_t* vb = V + (tile - 8) * 256 + wc * 32 + fq * 8;
#pragma unroll
            for (int ai = 0; ai < 2; ++ai)
#pragma unroll
                for (int m = 0; m < 4; ++m) { const unsigned off = (row0 + ai * HALF + m * 16) * 1024u;
#pragma unroll
                    for (int bj = 0; bj < 2; ++bj) *(u32x4*)(vb + off + bj * HALF) = pack8(acc[ai][bj][m][0], acc[ai][bj][m][1]); }
        } else {
            const bool isk = tile >= 4; const int hm = (tile & 3) * 4 + wc; bf16_t* dst = (isk ? K : Q) + hm * 64 + 8 * fq; const float* g = isk ? gk : gq; const float sc = isk ? 1.0f : qscale;
            const f32x4 g0a = *(const f32x4*)(g + 8 * fq), g0b = *(const f32x4*)(g + 8 * fq + 4), g1a = *(const f32x4*)(g + 32 + 8 * fq), g1b = *(const f32x4*)(g + 36 + 8 * fq);
            const float* cb = cosD + 8 * fq; const float* sb = sinD + 8 * fq;
#pragma unroll
            for (int ai = 0; ai < 2; ++ai)
#pragma unroll
                for (int m = 0; m < 4; ++m) {
                    const unsigned row = row0 + ai * HALF + m * 16;
                    const f32x4 c0 = *(const f32x4*)(cb + row * 32u), c1 = *(const f32x4*)(cb + row * 32u + 4), s0 = *(const f32x4*)(sb + row * 32u), s1 = *(const f32x4*)(sb + row * 32u + 4);
                    const f32x4 a0 = acc[ai][0][m][0], a1 = acc[ai][0][m][1], b0 = acc[ai][1][m][0], b1 = acc[ai][1][m][1];
                    const float ss = quad_sum((sq4(a0) + sq4(a1)) + (sq4(b0) + sq4(b1)));
                    const float rs = __builtin_amdgcn_rsqf(ss * (1.0f / 64.0f) + eps) * sc;
                    const f32x4 x1a = a0 * (g0a * rs), x1b = a1 * (g0b * rs), x2a = b0 * (g1a * rs), x2b = b1 * (g1b * rs);
                    *(u32x4*)(dst + row * 1024u) = pack8(x1a * c0 - x2a * s0, x1b * c1 - x2b * s1);
                    *(u32x4*)(dst + row * 1024u + 32) = pack8(x2a * c0 + x1a * s0, x2b * c1 + x1b * s1);
                }
        }
    }
};
template <bool XF32>
struct EpiResid {
    static constexpr bool PERM = true, AFTER_DRAIN = false;
    const void* xin; bf16_t* xout; const float* gate; float* ssq;
    __device__ __forceinline__ void operator()(const f32x4 (&acc)[2][2][4][2], const Unit& u, int wr, int wc, int fr, int fq) const {
        asm volatile("" : "+v"(fr), "+v"(fq));
        const int b = (u.pm * BM) >> 11; const unsigned colb = (unsigned)(u.pn * BM + wc * 32 + 8 * fq); const unsigned row0 = (unsigned)(u.pm * BM + wr * 64 + fr);
        const float* gp = gate + (size_t)b * 6144 + colb;
        f32x4 g[2][2];
#pragma unroll
        for (int bj = 0; bj < 2; ++bj)
#pragma unroll
            for (int n = 0; n < 2; ++n) g[bj][n] = *(const f32x4*)(gp + bj * HALF + n * 4);
        bf16_t* xo = xout + colb; float* sq = ssq + u.pn * 4 + wc;
#pragma unroll
        for (int ai = 0; ai < 2; ++ai) {
            f32x4 xq[4][2][2];
#pragma unroll
            for (int m = 0; m < 4; ++m) { const unsigned off_ = (row0 + ai * HALF + m * 16) * 1024u + colb;
#pragma unroll
                for (int bj = 0; bj < 2; ++bj) {
                    if (XF32) { xq[m][bj][0] = *(const f32x4*)((const float*)xin + off_ + bj * HALF); xq[m][bj][1] = *(const f32x4*)((const float*)xin + off_ + bj * HALF + 4); }
                    else { const u32x4 w = *(const u32x4*)((const bf16_t*)xin + off_ + bj * HALF);
                        xq[m][bj][0] = (f32x4){__uint_as_float(w.x << 16), __uint_as_float(w.x & 0xffff0000u), __uint_as_float(w.y << 16), __uint_as_float(w.y & 0xffff0000u)};
                        xq[m][bj][1] = (f32x4){__uint_as_float(w.z << 16), __uint_as_float(w.z & 0xffff0000u), __uint_as_float(w.w << 16), __uint_as_float(w.w & 0xffff0000u)}; } } }
#pragma unroll
            for (int m = 0; m < 4; ++m) {
                const unsigned row = row0 + ai * HALF + m * 16; const unsigned off = row * 1024u; float ss = 0.f;
#pragma unroll
                for (int bj = 0; bj < 2; ++bj) { const f32x4 v0 = xq[m][bj][0] + g[bj][0] * acc[ai][bj][m][0], v1 = xq[m][bj][1] + g[bj][1] * acc[ai][bj][m][1];
                    *(u32x4*)(xo + off + bj * HALF) = pack8(v0, v1); ss += sq4(v0) + sq4(v1); }
                ss = quad_sum(ss);
                if (fq == 0) sq[row * 16u] = ss;
            }
        }
    }
};
struct EpiWin {
    static constexpr bool PERM = true, AFTER_DRAIN = false;
    bf16_t* CQ; bf16_t* CKV; bf16_t* KPE; float* ssq; const float* cosM; const float* sinM; const float* gkpe; float eps;
    __device__ __forceinline__ void operator()(const f32x4 (&acc)[2][2][4][2], const Unit& u, int wr, int wc, int fr, int fq) const {
        asm volatile("" : "+v"(fr), "+v"(fq));
        const int ws = u.pn * 4 + wc; const unsigned row0 = (unsigned)(u.pm * BM + wr * 64 + fr);
        if (ws < 10) {
            bf16_t* dst = ((ws < 6) ? CQ + 64 * ws : CKV + 64 * (ws - 6)) + 8 * fq; const unsigned ld = (ws < 6) ? 384u : 256u; float* sq = ssq + ws;
#pragma unroll
            for (int ai = 0; ai < 2; ++ai)
#pragma unroll
                for (int m = 0; m < 4; ++m) {
                    const unsigned row = row0 + ai * HALF + m * 16;
                    const f32x4 a0 = acc[ai][0][m][0], a1 = acc[ai][0][m][1], b0 = acc[ai][1][m][0], b1 = acc[ai][1][m][1];
                    *(u32x4*)(dst + row * ld) = pack8(a0, a1); *(u32x4*)(dst + row * ld + 32) = pack8(b0, b1);
                    const float ss = quad_sum((sq4(a0) + sq4(a1)) + (sq4(b0) + sq4(b1)));
                    if (fq == 0) sq[row * 16u] = ss;
                }
        } else if (ws == 10) {
            const f32x4 g0 = *(const f32x4*)(gkpe + 4 * fq), g1 = *(const f32x4*)(gkpe + 16 + 4 * fq);
#pragma unroll
            for (int ai = 0; ai < 2; ++ai)
#pragma unroll
                for (int m = 0; m < 4; ++m) {
                    const unsigned row = row0 + ai * HALF + m * 16;
                    const f32x4 c = *(const f32x4*)(cosM + row * 16u + 4 * fq), sn = *(const f32x4*)(sinM + row * 16u + 4 * fq);
                    const f32x4 y0 = acc[ai][0][m][0], y1 = acc[ai][0][m][1];
                    const float rs = __builtin_amdgcn_rsqf(quad_sum(sq4(y0) + sq4(y1)) * (1.0f / 32.0f) + eps);
                    const f32x4 x1 = y0 * (g0 * rs), x2 = y1 * (g1 * rs);
                    *(u32x4*)(KPE + row * 32u + 8 * fq) = pack8(x1 * c - x2 * sn, x2 * c + x1 * sn);
                }
        }
    }
};
struct EpiUQ {
    static constexpr bool PERM = true, AFTER_DRAIN = false;
    bf16_t* Q2; const float* ssq; const float* cosM; const float* sinM; const float* gqn; const float* gqp; float qscale; float eps;
    __device__ __forceinline__ void operator()(const f32x4 (&acc)[2][2][4][2], const Unit& u, int wr, int wc, int fr, int fq) const {
        asm volatile("" : "+v"(fr), "+v"(fq));
        const int tile = u.pn; const unsigned row0 = (unsigned)(u.pm * BM + wr * 64 + fr);
        if (tile < 4) {
            bf16_t* dst = Q2 + (tile * 4 + wc) * 96 + 8 * fq;
            const f32x4 g0a = *(const f32x4*)(gqn + 8 * fq) * qscale, g0b = *(const f32x4*)(gqn + 8 * fq + 4) * qscale, g1a = *(const f32x4*)(gqn + 32 + 8 * fq) * qscale, g1b = *(const f32x4*)(gqn + 36 + 8 * fq) * qscale;
#pragma unroll
            for (int ai = 0; ai < 2; ++ai) {
                f32x4 sA[4], sB[4];
#pragma unroll
                for (int m = 0; m < 4; ++m) { const unsigned row = row0 + ai * HALF + m * 16; sA[m] = *(const f32x4*)(ssq + row * 16u); sB[m] = *(const f32x4*)(ssq + row * 16u + 4); }
#pragma unroll
                for (int m = 0; m < 4; ++m) {
                    const unsigned row = row0 + ai * HALF + m * 16;
                    const f32x4 a0 = acc[ai][0][m][0], a1 = acc[ai][0][m][1], b0 = acc[ai][1][m][0], b1 = acc[ai][1][m][1];
                    const float ss = quad_sum((sq4(a0) + sq4(a1)) + (sq4(b0) + sq4(b1)));
                    const float em = eps * ((((sA[m][0] + sA[m][1]) + (sA[m][2] + sA[m][3])) + (sB[m][0] + sB[m][1])) * (1.0f / 384.0f) + eps);
                    const float rn = __builtin_amdgcn_rsqf(ss * (1.0f / 64.0f) + em);
                    *(u32x4*)(dst + row * 1536u) = pack8(a0 * (g0a * rn), a1 * (g0b * rn)); *(u32x4*)(dst + row * 1536u + 32) = pack8(b0 * (g1a * rn), b1 * (g1b * rn));
                }
            }
        } else {
            const f32x4 g0 = *(const f32x4*)(gqp + 4 * fq) * qscale, g1 = *(const f32x4*)(gqp + 16 + 4 * fq) * qscale;
            bf16_t* dst = Q2 + (((tile - 4) * 4 + wc) * 2) * 96 + 64 + 8 * fq;
#pragma unroll
            for (int ai = 0; ai < 2; ++ai) {
                f32x4 sA[4], sB[4], cc[4], sn[4];
#pragma unroll
                for (int m = 0; m < 4; ++m) { const unsigned row = row0 + ai * HALF + m * 16; sA[m] = *(const f32x4*)(ssq + row * 16u); sB[m] = *(const f32x4*)(ssq + row * 16u + 4);
                    cc[m] = *(const f32x4*)(cosM + row * 16u + 4 * fq); sn[m] = *(const f32x4*)(sinM + row * 16u + 4 * fq); }
#pragma unroll
                for (int m = 0; m < 4; ++m) {
                    const unsigned row = row0 + ai * HALF + m * 16;
                    const float em = eps * ((((sA[m][0] + sA[m][1]) + (sA[m][2] + sA[m][3])) + (sB[m][0] + sB[m][1])) * (1.0f / 384.0f) + eps);
#pragma unroll
                    for (int bj = 0; bj < 2; ++bj) {
                        const f32x4 y0 = acc[ai][bj][m][0], y1 = acc[ai][bj][m][1];
                        const float rn = __builtin_amdgcn_rsqf(quad_sum(sq4(y0) + sq4(y1)) * (1.0f / 32.0f) + em);
                        const f32x4 x1 = y0 * (g0 * rn), x2 = y1 * (g1 * rn);
                        *(u32x4*)(dst + row * 1536u + bj * 96) = pack8(x1 * cc[m] - x2 * sn[m], x2 * cc[m] + x1 * sn[m]);
                    }
                }
            }
        }
    }
};
struct EpiUKV {
    static constexpr bool PERM = true, AFTER_DRAIN = false;
    bf16_t* KV2; const float* ssq; const float* gkn; float eps;
    __device__ __forceinline__ void operator()(const f32x4 (&acc)[2][2][4][2], const Unit& u, int wr, int wc, int fr, int fq) const {
        asm volatile("" : "+v"(fr), "+v"(fq));
        const int tile = u.pn, head = (tile & 3) * 4 + wc; const unsigned row0 = (unsigned)(u.pm * BM + wr * 64 + fr);
        f32x4 sB[2][4], sC[2][4];
#pragma unroll
        for (int ai = 0; ai < 2; ++ai)
#pragma unroll
            for (int m = 0; m < 4; ++m) { const unsigned row = row0 + ai * HALF + m * 16; sB[ai][m] = *(const f32x4*)(ssq + row * 16u + 4); sC[ai][m] = *(const f32x4*)(ssq + row * 16u + 8); }
        if (tile < 4) {
            bf16_t* dst = KV2 + head * 128 + 8 * fq;
            const f32x4 g0a = *(const f32x4*)(gkn + 8 * fq), g0b = *(const f32x4*)(gkn + 8 * fq + 4), g1a = *(const f32x4*)(gkn + 32 + 8 * fq), g1b = *(const f32x4*)(gkn + 36 + 8 * fq);
#pragma unroll
            for (int ai = 0; ai < 2; ++ai)
#pragma unroll
                for (int m = 0; m < 4; ++m) {
                    const unsigned row = row0 + ai * HALF + m * 16;
                    const f32x4 a0 = acc[ai][0][m][0], a1 = acc[ai][0][m][1], b0 = acc[ai][1][m][0], b1 = acc[ai][1][m][1];
                    const float ss = quad_sum((sq4(a0) + sq4(a1)) + (sq4(b0) + sq4(b1)));
                    const float msq = ((sB[ai][m][2] + sB[ai][m][3]) + (sC[ai][m][0] + sC[ai][m][1])) * (1.0f / 256.0f) + eps;
                    const float rn = __builtin_amdgcn_rsqf(ss * (1.0f / 64.0f) + eps * msq);
                    *(u32x4*)(dst + row * 2048u) = pack8(a0 * (g0a * rn), a1 * (g0b * rn)); *(u32x4*)(dst + row * 2048u + 32) = pack8(b0 * (g1a * rn), b1 * (g1b * rn));
                }
        } else {
            bf16_t* dst = KV2 + head * 128 + 64 + 8 * fq;
#pragma unroll
            for (int ai = 0; ai < 2; ++ai)
#pragma unroll
                for (int m = 0; m < 4; ++m) {
                    const unsigned row = row0 + ai * HALF + m * 16;
                    const float rsq = __builtin_amdgcn_rsqf(((sB[ai][m][2] + sB[ai][m][3]) + (sC[ai][m][0] + sC[ai][m][1])) * (1.0f / 256.0f) + eps);
                    *(u32x4*)(dst + row * 2048u) = pack8(acc[ai][0][m][0] * rsq, acc[ai][0][m][1] * rsq); *(u32x4*)(dst + row * 2048u + 32) = pack8(acc[ai][1][m][0] * rsq, acc[ai][1][m][1] * rsq);
                }
        }
    }
};

struct MUnit { int pm, pn, e, r0; };
struct MoeOrder {
    typedef MUnit UnitT;
    const int* tpre; int ncol, G, c, total;
    __device__ __forceinline__ bool next(int i, MUnit& u) const {
        const int L = i * G + c; if (L >= total) return false;
        const int rt = L / ncol, ct = L - rt * ncol; const int e = tpre[33 + rt];
        u.e = e; u.pm = rt; u.r0 = (rt - tpre[e]) * 256; u.pn = e * ncol + ct; return true;
    }
    __device__ __forceinline__ void a_ready(const MUnit&) const {}
    __device__ __forceinline__ void done(const MUnit&) const {}
};
__device__ __forceinline__ float silu_f(float a) { return a * __builtin_amdgcn_rcpf(1.0f + __builtin_amdgcn_exp2f(-1.4426950408889634f * a)); }
struct EpiMoe1 {
    static constexpr bool PERM = true, AFTER_DRAIN = false;
    bf16_t* hid; const int* glist; const float* tokw; const int* cntl; int ntok;
    __device__ __forceinline__ void operator()(const f32x4 (&acc)[2][2][4][2], const MUnit& u, int wr, int wc, int fr, int fq) const {
        const int cnt = cntl[u.e], t = u.pn & 1;
        asm volatile("" : "+v"(fr), "+v"(fq));
#pragma unroll
        for (int ai = 0; ai < 2; ++ai)
#pragma unroll
            for (int m = 0; m < 4; ++m) {
                const int rl = ai * HALF + wr * 64 + m * 16 + fr, r = u.r0 + rl; float w = 0.f;
                if (r < cnt) w = tokw[(unsigned)(u.e * ntok + r)];
                const f32x4 a0 = acc[ai][0][m][0], a1 = acc[ai][0][m][1], b0 = acc[ai][1][m][0], b1 = acc[ai][1][m][1];
                u32x4 o;
                o.x = cvt_pk_bf16(silu_f(a0[0]) * b0[0] * w, silu_f(a0[1]) * b0[1] * w); o.y = cvt_pk_bf16(silu_f(a0[2]) * b0[2] * w, silu_f(a0[3]) * b0[3] * w);
                o.z = cvt_pk_bf16(silu_f(a1[0]) * b1[0] * w, silu_f(a1[1]) * b1[1] * w); o.w = cvt_pk_bf16(silu_f(a1[2]) * b1[2] * w, silu_f(a1[3]) * b1[3] * w);
                *(u32x4*)(hid + ((size_t)u.pm * BM + rl) * 256 + t * 128 + wc * 32 + fq * 8) = o;
                asm volatile("" ::: "memory");
            }
    }
};
struct EpiMoe2 {
    static constexpr bool PERM = true, AFTER_DRAIN = false;
    unsigned char* y2; const int* glist; const int* cntl; int ntok;
    __device__ __forceinline__ void operator()(const f32x4 (&acc)[2][2][4][2], const MUnit& u, int wr, int wc, int fr, int fq) const {
        const int cnt = cntl[u.e], ct = u.pn & 3;
        asm volatile("" : "+v"(fr), "+v"(fq));
#pragma unroll
        for (int ai = 0; ai < 2; ++ai)
#pragma unroll
            for (int m = 0; m < 4; ++m) {
                const int rl = ai * HALF + wr * 64 + m * 16 + fr, r = u.r0 + rl;
                int ent = glist[(unsigned)(u.e * ntok + (r < cnt ? r : 0))]; ent = (r < cnt) ? ent : 2 * ntok;
                unsigned char* rowp = y2 + (size_t)(unsigned)ent * 1024 + ct * 256 + wc * 32 + fq * 8;
#pragma unroll
                for (int bj = 0; bj < 2; ++bj) { const f32x4 v0 = acc[ai][bj][m][0] * 32.0f, v1 = acc[ai][bj][m][1] * 32.0f; u32x2 o;
                    int p = __builtin_amdgcn_cvt_pk_fp8_f32(v0[0], v0[1], 0, false); p = __builtin_amdgcn_cvt_pk_fp8_f32(v0[2], v0[3], p, true); o.x = (unsigned)p;
                    p = __builtin_amdgcn_cvt_pk_fp8_f32(v1[0], v1[1], 0, false); p = __builtin_amdgcn_cvt_pk_fp8_f32(v1[2], v1[3], p, true); o.y = (unsigned)p;
                    *(u32x2*)(rowp + bj * HALF) = o; }
                asm volatile("" ::: "memory");
            }
    }
};
template <class Epi, class Sched, bool FP8 = false>
__device__ __forceinline__ void gemm_phase_gather(PG8_LAS unsigned char* lds, const bf16_t* A, const bf16_t* Bt, int K, const int* glist, int ntok, const int* cntl, const Sched& S, const Epi& E) {
    int tid_ = threadIdx.x; asm volatile("" : "+v"(tid_));
    const int tid = tid_, wid = __builtin_amdgcn_readfirstlane(tid >> 6), lane = tid & 63, wr = wid >> 2, wc = wid & 3, fr = lane & 15, fq = lane >> 4;
    const int rowb = FP8 ? K : 2 * K, nt = FP8 ? K / (2 * BK) : K / BK;
    unsigned voffB[2];
#pragma unroll
    for (int i = 0; i < 2; ++i) { int R, C; stage_rc(tid * 16 + i * 8192, R, C); const int Rb = Epi::PERM ? ((R & ~31) + perm32(R & 31)) : R;
        voffB[i] = (unsigned)(Rb * rowb + C * 2); }
    const size_t kstep = (size_t)(BK * 2);
    const size_t hstep = (size_t)HALF * rowb;
    const size_t tstep = 2 * hstep;
    const unsigned ldsw = (unsigned)wid * 1024u;
    const int aoff = lds_byte(wr * 64 + fr, fq * 8), boff = lds_byte(wc * 32 + fr, fq * 8);
#define PG8_SA(b, h) (((b) * 2 + (h)) * HTB)
#define PG8_SB(b, h) ((4 + (b) * 2 + (h)) * HTB)
#define PG8_STAGE(bufoff, gbase, voff) do { _Pragma("unroll") for (int _i = 0; _i < 2; ++_i) \
        __builtin_amdgcn_global_load_lds((const unsigned*)((const char*)(gbase) + (voff)[_i]), (PG8_LAS unsigned*)(lds + (bufoff) + ldsw + _i * 8192), 16, 0, 0); } while (0)
    typedef int i32x4_ __attribute__((ext_vector_type(4))); typedef int i32x8_ __attribute__((ext_vector_type(8)));
#define PG8_LDA(dst, b, h) do { _Pragma("unroll") for (int m = 0; m < 4; ++m) { if constexpr (FP8) { const i32x4_ l0_ = *(const PG8_LAS i32x4_*)(lds + PG8_SA(b, h) + aoff + m * 2048), l1_ = *(const PG8_LAS i32x4_*)(lds + PG8_SA(b, h) + aoff + m * 2048 + 1024); \
            dst##8[m] = __builtin_shufflevector(l0_, l1_, 0, 1, 2, 3, 4, 5, 6, 7); } else { _Pragma("unroll") for (int k = 0; k < 2; ++k) dst[m][k] = *(const PG8_LAS bf16x8*)(lds + PG8_SA(b, h) + aoff + m * 2048 + k * 1024); } } } while (0)
#define PG8_LDB(dst, b, h) do { _Pragma("unroll") for (int n = 0; n < 2; ++n) { if constexpr (FP8) { const i32x4_ l0_ = *(const PG8_LAS i32x4_*)(lds + PG8_SB(b, h) + boff + n * 2048), l1_ = *(const PG8_LAS i32x4_*)(lds + PG8_SB(b, h) + boff + n * 2048 + 1024); \
            dst##8[n] = __builtin_shufflevector(l0_, l1_, 0, 1, 2, 3, 4, 5, 6, 7); } else { _Pragma("unroll") for (int k = 0; k < 2; ++k) dst[n][k] = *(const PG8_LAS bf16x8*)(lds + PG8_SB(b, h) + boff + n * 2048 + k * 1024); } } } while (0)
#define PG8_MMA(ai, bj, At, Bt) do { __builtin_amdgcn_s_setprio(1); _Pragma("unroll") for (int m = 0; m < 4; ++m) _Pragma("unroll") for (int n = 0; n < 2; ++n) { \
        if constexpr (FP8) acc[ai][bj][m][n] = __builtin_amdgcn_mfma_scale_f32_16x16x128_f8f6f4(Bt##8[n], At##8[m], acc[ai][bj][m][n], 0, 0, 0, 0x7a7a7a7a, 0, 0x7f7f7f7f); \
        else { _Pragma("unroll") for (int k = 0; k < 2; ++k) acc[ai][bj][m][n] = __builtin_amdgcn_mfma_f32_16x16x32_bf16(Bt[n][k], At[m][k], acc[ai][bj][m][n], 0, 0, 0); } } \
        __builtin_amdgcn_s_setprio(0); } while (0)
#define PG8_WAIT_V(n) asm volatile("s_waitcnt vmcnt(" #n ")" ::: "memory")
#define PG8_WAIT_L(n) asm volatile("s_waitcnt lgkmcnt(" #n ")" ::: "memory")
#define PG8_BAR __builtin_amdgcn_s_barrier()
#define PG8_SCHED __builtin_amdgcn_sched_barrier(0)
#define PG8_GOFF(u, off) do { const int _cnt = cntl[(u).e]; _Pragma("unroll") for (int _h = 0; _h < 2; ++_h) _Pragma("unroll") for (int _i = 0; _i < 2; ++_i) { \
        int _R, _C; stage_rc(tid * 16 + _i * 8192, _R, _C); const int _r = (u).r0 + _h * HALF + _R; const int _ent = glist[(unsigned)((u).e * ntok + (_r < _cnt ? _r : 0))]; \
        off[_h][_i] = (unsigned)(_ent >> 1) * (unsigned)rowb + (unsigned)(_C * 2); } } while (0)
    typename Sched::UnitT cur, nxt; int ui = 0;
    if (!S.next(0, cur)) return;
    f32x4 acc[2][2][4][2];
#pragma unroll
    for (int a = 0; a < 2; ++a)
#pragma unroll
        for (int b = 0; b < 2; ++b)
#pragma unroll
            for (int m = 0; m < 4; ++m)
#pragma unroll
                for (int n = 0; n < 2; ++n) acc[a][b][m][n] = (f32x4){0.f, 0.f, 0.f, 0.f};
    bf16x8 At[4][2], B0[2][2], B1[2][2]; i32x8_ At8[4], B08[2], B18[2];
    unsigned coff[2][2], noff[2][2];
    PG8_GOFF(cur, coff);
    const char* cA = (const char*)A; const char* cB = (const char*)Bt + (size_t)cur.pn * tstep;
    PG8_STAGE(PG8_SB(0, 0), cB, voffB); PG8_STAGE(PG8_SB(0, 1), cB + hstep, voffB); PG8_STAGE(PG8_SA(0, 0), cA, coff[0]); PG8_STAGE(PG8_SA(0, 1), cA, coff[1]);
    if (wr == 1) PG8_BAR;
    PG8_WAIT_V(2); PG8_BAR;
    PG8_STAGE(PG8_SB(1, 0), cB + kstep, voffB); PG8_STAGE(PG8_SA(1, 0), cA + kstep, coff[0]); PG8_STAGE(PG8_SB(1, 1), cB + hstep + kstep, voffB);
    PG8_WAIT_V(6); PG8_BAR;
    for (;;) {
        const bool has_next = S.next(ui + 1, nxt);
        if (has_next) { PG8_GOFF(nxt, noff); } else {
#pragma unroll
            for (int h = 0; h < 2; ++h)
#pragma unroll
                for (int i = 0; i < 2; ++i) noff[h][i] = coff[h][i]; }
        const char* nB = has_next ? (const char*)Bt + (size_t)nxt.pn * tstep : cB;
        for (int t = 0; t < nt; t += 2) {
            const bool last = (t == nt - 2);
            const char* a1 = cA + (size_t)(t + 1) * kstep;
            const char* a2 = last ? cA : cA + (size_t)(t + 2) * kstep; const char* b2 = last ? nB : cB + (size_t)(t + 2) * kstep;
            const char* a3 = a2 + kstep; const char* b3 = b2 + kstep;
            PG8_LDB(B0, 0, 0); PG8_LDB(B1, 0, 1); PG8_SCHED; PG8_LDA(At, 0, 0); PG8_STAGE(PG8_SA(1, 1), a1, coff[1]);
            if (last) {
#pragma unroll
                for (int h = 0; h < 2; ++h)
#pragma unroll
                    for (int i = 0; i < 2; ++i) coff[h][i] = noff[h][i]; }
            PG8_WAIT_V(8); PG8_WAIT_L(0); PG8_BAR; PG8_MMA(0, 0, At, B0); PG8_MMA(0, 1, At, B1); PG8_BAR; PG8_SCHED;
            PG8_LDA(At, 0, 1); PG8_STAGE(PG8_SB(0, 0), b2, voffB); PG8_STAGE(PG8_SB(0, 1), b2 + hstep, voffB); PG8_STAGE(PG8_SA(0, 0), a2, coff[0]);
            PG8_WAIT_V(8); PG8_WAIT_L(0); PG8_BAR; PG8_MMA(1, 0, At, B0); PG8_MMA(1, 1, At, B1); PG8_BAR; PG8_SCHED;
            PG8_LDB(B0, 1, 0); PG8_LDB(B1, 1, 1); PG8_SCHED; PG8_LDA(At, 1, 0); PG8_STAGE(PG8_SA(0, 1), a2, coff[1]);
            PG8_WAIT_V(8); PG8_WAIT_L(0); PG8_BAR; PG8_MMA(0, 0, At, B0); PG8_MMA(0, 1, At, B1); PG8_BAR; PG8_SCHED;
            PG8_LDA(At, 1, 1); PG8_STAGE(PG8_SB(1, 0), b3, voffB); PG8_STAGE(PG8_SB(1, 1), b3 + hstep, voffB); PG8_STAGE(PG8_SA(1, 0), a3, coff[0]);
            PG8_WAIT_V(8); PG8_WAIT_L(0); PG8_BAR; PG8_MMA(1, 0, At, B0); PG8_MMA(1, 1, At, B1); PG8_BAR; PG8_SCHED;
        }
        if (wr == 0) PG8_BAR;
        E(acc, cur, wr, wc, fr, fq);
        if (!has_next) break;
#pragma unroll
        for (int a = 0; a < 2; ++a)
#pragma unroll
            for (int b = 0; b < 2; ++b)
#pragma unroll
                for (int m = 0; m < 4; ++m)
#pragma unroll
                    for (int n = 0; n < 2; ++n) acc[a][b][m][n] = (f32x4){0.f, 0.f, 0.f, 0.f};
        cur = nxt; cB = nB; ++ui;
        if (wr == 1) PG8_BAR;
    }
    PG8_WAIT_V(0);
    PG8_BAR;
#undef PG8_SA
#undef PG8_SB
#undef PG8_STAGE
#undef PG8_LDA
#undef PG8_LDB
#undef PG8_MMA
#undef PG8_WAIT_V
#undef PG8_WAIT_L
#undef PG8_BAR
#undef PG8_SCHED
#undef PG8_GOFF
}
}

#define PG8_SP2 true
#define PG8_ALIGN true

struct Args { const float* in[33]; float* out; unsigned char* ws; int ph_lo, ph_hi; };
enum { I_X = 0, I_C, I_POS, I_ADAW, I_ADAB, I_NMIX, I_NFFN, I_DA_WQKV, I_DA_QN, I_DA_KN, I_DA_LQ1, I_DA_LK1, I_DA_LQ2, I_DA_LK2,
       I_DA_SUBLN, I_DA_WO, I_M_WIN, I_M_QAN, I_M_KVAN, I_M_WUQ, I_M_WUKV, I_M_QNN, I_M_QPN, I_M_KNN, I_M_KPN, I_M_WO,
       I_E_WG, I_E_BG, I_E_WR, I_E_BR, I_E_W1, I_E_W3, I_E_W2 };

struct Ctx {
    const float* const* in; float* out; unsigned char* ws; unsigned char* lds;
    int tid, lane, wave, gw, ngw;
    __device__ __forceinline__ const float* mod(int layer, int b, int chunk) const { return (const float*)(ws + WS_MOD) + ((size_t)(layer * NB + b) * 6144 + chunk * 1024); }
};

__device__ __forceinline__ void normmod_row(const f32x4 (&v)[4], f32x4 (&h)[4], const float* g, const float* sh, const float* sc, int lane) {
    float s = 0.f;
#pragma unroll
    for (int j = 0; j < 4; ++j) s += (v[j].x * v[j].x + v[j].y * v[j].y) + (v[j].z * v[j].z + v[j].w * v[j].w);
    const float rstd = 1.0f / sqrtf(wave_sum(s) * (1.0f / D) + EPS);
#pragma unroll
    for (int j = 0; j < 4; ++j) {
        const f32x4 gg = *(const f32x4*)(g + 4 * lane + 256 * j), ss = *(const f32x4*)(sh + 4 * lane + 256 * j), cc = *(const f32x4*)(sc + 4 * lane + 256 * j);
        h[j] = (v[j] * rstd) * gg * (cc + 1.0f) + ss;
    }
}
__device__ __forceinline__ void store_row_bf16(bf16* row, const f32x4 (&h)[4], int lane) {
#pragma unroll
    for (int j = 0; j < 4; ++j) { u32x2 o; o.x = pk2(h[j].x, h[j].y); o.y = pk2(h[j].z, h[j].w); *(u32x2*)(row + 4 * lane + 256 * j) = o; }
}
__device__ __forceinline__ void load_row_fp8(const unsigned char* row, f32x4 (&h)[4], int lane) {
#pragma unroll
    for (int j = 0; j < 4; ++j) { const int w = *(const int*)(row + 4 * lane + 256 * j); const auto lo = __builtin_amdgcn_cvt_pk_f32_fp8(w, false), hi = __builtin_amdgcn_cvt_pk_f32_fp8(w, true);
        h[j] = (f32x4){lo[0], lo[1], hi[0], hi[1]} * 0.03125f; }
}
__device__ __forceinline__ void load_row_bf16(const bf16* row, f32x4 (&h)[4], int lane) {
#pragma unroll
    for (int j = 0; j < 4; ++j) { const u32x2 o = *(const u32x2*)(row + 4 * lane + 256 * j);
        h[j] = (f32x4){bf2f(o.x & 0xffffu), bf2f(o.x >> 16), bf2f(o.y & 0xffffu), bf2f(o.y >> 16)}; }
}


struct TItem { const float* src; bf16* dst; const float* kg; int ldw, K, perm, f8; };
__device__ __forceinline__ void titem_load(const TItem& t, f32x4 (&v)[8], int lane) {
    const float* p = t.src + (size_t)(lane >> 3) * t.ldw + 4 * (lane & 7);
#pragma unroll
    for (int i = 0; i < 8; ++i) v[i] = *(const f32x4*)(p + (size_t)(8 * i) * t.ldw);
}
__device__ __forceinline__ void titem_finish(const TItem& t, const f32x4 (&v)[8], float* scr, int lane) {
    const int rr = lane >> 3, c4 = lane & 7;
#pragma unroll
    for (int i = 0; i < 8; ++i) { f32x4 x = v[i]; if (t.kg) x = x * t.kg[8 * i + rr]; float* d = scr + (8 * i + rr) * 33 + 4 * c4; d[0] = x[0]; d[1] = x[1]; d[2] = x[2]; d[3] = x[3]; }
    asm volatile("s_waitcnt lgkmcnt(0)" ::: "memory");
    const int c = lane & 7;
#pragma unroll
    for (int j = 0; j < 4; ++j) { const int n = (lane >> 3) + 8 * j; const int nl = t.perm ? (16 * ((n >> 2) & 1) + 4 * (n >> 3) + (n & 3)) : n;
        const float* sp = scr + (8 * c) * 33 + nl;
        if (t.f8) { int p0 = __builtin_amdgcn_cvt_pk_fp8_f32(sp[0 * 33] * 32.0f, sp[1 * 33] * 32.0f, 0, false); p0 = __builtin_amdgcn_cvt_pk_fp8_f32(sp[2 * 33] * 32.0f, sp[3 * 33] * 32.0f, p0, true);
            int p1 = __builtin_amdgcn_cvt_pk_fp8_f32(sp[4 * 33] * 32.0f, sp[5 * 33] * 32.0f, 0, false); p1 = __builtin_amdgcn_cvt_pk_fp8_f32(sp[6 * 33] * 32.0f, sp[7 * 33] * 32.0f, p1, true);
            u32x2 o; o.x = (unsigned)p0; o.y = (unsigned)p1; *(u32x2*)((unsigned char*)t.dst + (size_t)n * t.K + 8 * c) = o; }
        else { u32x4 o; o.x = pk2(sp[0 * 33], sp[1 * 33]); o.y = pk2(sp[2 * 33], sp[3 * 33]); o.z = pk2(sp[4 * 33], sp[5 * 33]); o.w = pk2(sp[6 * 33], sp[7 * 33]);
            *(u32x4*)(t.dst + (size_t)n * t.K + 8 * c) = o; } }
    asm volatile("s_waitcnt lgkmcnt(0)" ::: "memory");
}
__device__ __forceinline__ TItem titem_make(const float* W, int ldw, int K, bf16* WT, int k0, int n0, int prow0, const float* kgain, bool perm) {
    TItem t; t.src = W + (size_t)k0 * ldw + n0; t.dst = WT + (size_t)prow0 * K + k0; t.kg = kgain ? kgain + k0 : nullptr; t.ldw = ldw; t.K = K; t.perm = perm ? 1 : 0; t.f8 = 0; return t;
}
constexpr int TI_QKV = 16 * 96, TI_O = 16 * 32, TI_WIN = 16 * 21, TI_UQ = 6 * 48, TI_UKV = 4 * 64, TI_DENSE = TI_QKV + 2 * TI_O + TI_WIN + TI_UQ + TI_UKV, TI_ALL = TI_DENSE + 24576;
__device__ __forceinline__ TItem titem_decode(const Ctx& C, int it) {
    int r = it;
    if (r < TI_QKV) { const int kb = r / 96, lb = r % 96; int pb = lb;
        if (lb < 64) { const int sect = lb >> 5, hm = (lb & 31) >> 1, half = lb & 1; pb = (sect * 4 + (hm >> 2)) * 8 + half * 4 + (hm & 3); }
        return titem_make(as_global(C.in[I_DA_WQKV]), 3072, 1024, (bf16*)(C.ws + WB_QKV), 64 * kb, 32 * lb, 32 * pb, nullptr, false); } r -= TI_QKV;
    if (r < TI_O) return titem_make(as_global(C.in[I_DA_WO]), 1024, 1024, (bf16*)(C.ws + WB_DAO), 64 * (r / 32), 32 * (r % 32), 32 * (r % 32), nullptr, false); r -= TI_O;
    if (r < TI_O) return titem_make(as_global(C.in[I_M_WO]), 1024, 1024, (bf16*)(C.ws + WB_MLO), 64 * (r / 32), 32 * (r % 32), 32 * (r % 32), nullptr, false); r -= TI_O;
    if (r < TI_WIN) { const int kb = r / 21, lb = r % 21; int pb = 18;
        if (lb < 20) { const int wsl = lb >> 1; pb = (wsl >> 2) * 8 + (lb & 1) * 4 + (wsl & 3); }
        return titem_make(as_global(C.in[I_M_WIN]), 672, 1024, (bf16*)(C.ws + WB_WIN), 64 * kb, 32 * lb, 32 * pb, nullptr, lb == 20); } r -= TI_WIN;
    if (r < TI_UQ) { const int kb = r / 48, lb = r % 48, h = lb / 3, part = lb % 3; int pb;
        if (part < 2) pb = (h >> 2) * 8 + part * 4 + (h & 3); else { const int sl = h >> 1; pb = (4 + (sl >> 2)) * 8 + (h & 1) * 4 + (sl & 3); }
        return titem_make(as_global(C.in[I_M_WUQ]), 1536, 384, (bf16*)(C.ws + WB_WUQ), 64 * kb, 32 * lb, 32 * pb, as_global(C.in[I_M_QAN]), part == 2); } r -= TI_UQ;
    if (r < TI_UKV) { const int kb = r / 64, lb = r % 64, h = lb >> 2, part = lb & 3; const int pb = (((part < 2) ? 0 : 4) + (h >> 2)) * 8 + (part & 1) * 4 + (h & 3);
        return titem_make(as_global(C.in[I_M_WUKV]), 2048, 256, (bf16*)(C.ws + WB_WUKV), 64 * kb, 32 * lb, 32 * pb, as_global(C.in[I_M_KVAN]), false); } r -= TI_UKV;
    if (r < 16384) { const int item = r & 63, mat = (r >> 6) & 1, t = (r >> 7) & 1, e = (r >> 8) & 31, l = r >> 13; const int kb = item >> 2, nb = item & 3;
        const float* W = as_global(C.in[mat ? I_E_W3 : I_E_W1]) + (size_t)(l * 32 + e) * 1024 * 256 + 128 * t;
        TItem ti = titem_make(W, 256, 1024, (bf16*)(C.ws + WB_MOE + (size_t)l * 48 * MiB), 64 * kb, 32 * nb, e * 512 + 256 * t + 128 * mat + 32 * nb, nullptr, false);
        ti.f8 = 1; ti.dst = (bf16*)((unsigned char*)(C.ws + WB_MOE + (size_t)l * 48 * MiB) + (size_t)(e * 512 + 256 * t + 128 * mat + 32 * nb) * 1024 + 64 * kb); return ti; }
    r -= 16384;
    { const int item = r & 127, e = (r >> 7) & 31, l = r >> 12; const int kb = item >> 5, nb = item & 31;
      const float* W = as_global(C.in[I_E_W2]) + (size_t)(l * 32 + e) * 256 * 1024;
      return titem_make(W, 1024, 256, (bf16*)(C.ws + WB_MOE + (size_t)l * 48 * MiB + 32 * MiB), 64 * kb, 32 * nb, e * 1024 + 32 * nb, nullptr, false); }
}
__device__ __forceinline__ void ph_prologue(const Ctx& C) {
    {
        float* sc = (float*)C.lds;
        float* red = sc + 16384;
        const float* c = as_global(C.in[I_C]); const float* adaw = as_global(C.in[I_ADAW]); const float* adab = as_global(C.in[I_ADAB]); float* mod = (float*)(C.ws + WS_MOD);
        for (int item = blockIdx.x; item < 384; item += gridDim.x) {
            const int layer = item / 192, r = item % 192, cc = r >> 1, bhf = r & 1;
            __syncthreads();
            for (int idx = C.tid; idx < 16384; idx += NTHR) { const float v = c[(size_t)(bhf * 16) * D + idx]; sc[(idx & 1023) * 16 + (idx >> 10)] = v / (1.0f + expf(-v)); }
            __syncthreads();
            const int col = C.tid & 63, ks = C.tid >> 6;
            f32x4 acc[4];
#pragma unroll
            for (int i = 0; i < 4; ++i) acc[i] = (f32x4){0.f, 0.f, 0.f, 0.f};
            const float* wp = adaw + ((size_t)layer * D + ks * 128) * 6144 + cc * 64 + col;
#pragma unroll 8
            for (int kk = 0; kk < 128; ++kk) {
                const float w = wp[(size_t)kk * 6144]; const float* sp = sc + (ks * 128 + kk) * 16;
#pragma unroll
                for (int i = 0; i < 4; ++i) acc[i] += *(const f32x4*)(sp + 4 * i) * w;
            }
#pragma unroll
            for (int i = 0; i < 16; ++i) red[(ks * 16 + i) * 64 + col] = acc[i >> 2][i & 3];
            __syncthreads();
            for (int o = C.tid; o < 1024; o += NTHR) { const int i = o >> 6, cl = o & 63; float sm = adab[layer * 6144 + cc * 64 + cl];
#pragma unroll
                for (int k2 = 0; k2 < 8; ++k2) sm += red[(k2 * 16 + i) * 64 + cl];
                mod[(size_t)(layer * NB + bhf * 16 + i) * 6144 + cc * 64 + cl] = sm; }
        }
        if (blockIdx.x == 0 && C.wave == 0) {
            const float a = wave_sum(as_global(C.in[I_DA_LQ1])[C.lane] * as_global(C.in[I_DA_LK1])[C.lane]);
            const float b = wave_sum(as_global(C.in[I_DA_LQ2])[C.lane] * as_global(C.in[I_DA_LK2])[C.lane]);
            if (C.lane == 0) *(float*)(C.ws + WS_LAM) = expf(a) - expf(b) + 0.2f;
        }
    }
    __syncthreads();
    {
        float* ivf = (float*)C.lds;
        if (C.tid < 32) ivf[C.tid] = powf(10000.0f, -(float)(2 * C.tid) / 64.0f); else if (C.tid < 48) ivf[C.tid] = powf(10000.0f, -(float)(2 * (C.tid - 32)) / 32.0f);
        __syncthreads();
        const int* pos = (const int*)as_global(C.in[I_POS]);
        float* cosD = (float*)(C.ws + WS_COSD); float* sinD = (float*)(C.ws + WS_SIND); float* cosM = (float*)(C.ws + WS_COSM); float* sinM = (float*)(C.ws + WS_SINM);
        const int gt = blockIdx.x * NTHR + C.tid, ngt = gridDim.x * NTHR;
        for (int idx = gt; idx < NTOK * 32; idx += ngt) {
            const float ang = (float)pos[idx >> 5] * ivf[idx & 31]; float rev = ang * 0.15915494309189535f; rev -= floorf(rev);
            cosD[idx] = __builtin_amdgcn_cosf(rev); sinD[idx] = __builtin_amdgcn_sinf(rev);
        }
        for (int idx = gt; idx < NTOK * 16; idx += ngt) {
            const float ang = (float)pos[idx >> 4] * ivf[32 + (idx & 15)]; float rev = ang * 0.15915494309189535f; rev -= floorf(rev);
            cosM[idx] = __builtin_amdgcn_cosf(rev); sinM[idx] = __builtin_amdgcn_sinf(rev);
        }
        float* wrt = (float*)(C.ws + WS_WRT); const float* wr = as_global(C.in[I_E_WR]);
        for (int idx = gt; idx < 2 * 32 * 1024; idx += ngt) { const int l = idx >> 15, e = (idx >> 10) & 31, k = idx & 1023; wrt[idx] = wr[((size_t)l * 1024 + k) * 32 + e]; }
        for (int idx = gt; idx < 96 * 1024 / 8; idx += ngt) { const int blk = idx / 4096, rem = idx % 4096; const int pb = (blk == 0) ? 19 : 21 + blk;
            *(u32x4*)((bf16*)(C.ws + WB_WIN) + (size_t)pb * 32 * 1024 + (size_t)rem * 8) = (u32x4){0u, 0u, 0u, 0u}; }
    }
    __syncthreads();
    {
        float* scr = (float*)(C.lds + C.wave * 16384);
        f32x4 va[8], vb[8];
#pragma unroll 1
        for (int it = C.gw; it < TI_ALL; it += 2 * C.ngw) {
            const bool hasb = it + C.ngw < TI_ALL;
            const TItem ta = titem_decode(C, it), tb = titem_decode(C, hasb ? it + C.ngw : it);
            titem_load(ta, va, C.lane); if (hasb) titem_load(tb, vb, C.lane);
            titem_finish(ta, va, scr, C.lane); if (hasb) titem_finish(tb, vb, scr, C.lane);
        }
    }
}
__device__ __forceinline__ void ph_normmod0(const Ctx& C) {
    const float* x = as_global(C.in[I_X]); bf16* H = (bf16*)(C.ws + WS_H);
    for (int tok = C.gw; tok < NTOK; tok += C.ngw) {
        const int b = tok / SEQ; f32x4 v[4], h[4];
#pragma unroll
        for (int j = 0; j < 4; ++j) v[j] = *(const f32x4*)(x + (size_t)tok * D + 4 * C.lane + 256 * j);
        normmod_row(v, h, as_global(C.in[I_NMIX]), C.mod(0, b, 0), C.mod(0, b, 1), C.lane);
        store_row_bf16(H + (size_t)tok * D, h, C.lane);
    }
}
template <bool FINAL>
__device__ __forceinline__ void ph_comb(const Ctx& C, const unsigned char* y2, const float* gate_chunk_base  , int nlayer, const float* gnorm) {
    bf16* H = (bf16*)(C.ws + WS_H); const int lane = C.lane;
    for (int chunk = blockIdx.x; chunk < NTOK / 256; chunk += gridDim.x) {
        for (int i = 0; i < 32; ++i) {
            const int tok = chunk * 256 + C.wave * 32 + i, b = tok / SEQ;
            f32x4 v[4], a[4], a2[4];
            load_row_bf16((const bf16*)(C.ws + WS_XB) + (size_t)tok * D, v, lane);
            const float* gate = gate_chunk_base + (size_t)b * 6144;
            load_row_fp8(y2 + (size_t)(2 * tok) * D, a, lane); load_row_fp8(y2 + (size_t)(2 * tok + 1) * D, a2, lane);
#pragma unroll
            for (int j = 0; j < 4; ++j) { const f32x4 gg = *(const f32x4*)(gate + 4 * lane + 256 * j); v[j] += gg * (a[j] + a2[j]);
                if (FINAL) *(f32x4*)(as_global(C.out) + (size_t)tok * D + 4 * lane + 256 * j) = v[j]; }
            if (FINAL) continue;
            store_row_bf16((bf16*)(C.ws + WS_XB) + (size_t)tok * D, v, lane);
            f32x4 h[4];
            normmod_row(v, h, gnorm, C.mod(nlayer, b, 0), C.mod(nlayer, b, 1), lane);
            store_row_bf16(H + (size_t)tok * D, h, lane);
        }
    }
}

constexpr int MOE_TAB_OFF = 131072 + 512;
__device__ __forceinline__ void moe_prefix256(const Ctx& C, int moe_layer, int* cntl, int* tpre) {
    const unsigned* cnt = (const unsigned*)(C.ws + WS_CTL) + CW_CNT + moe_layer * 32 * 64;
    __syncthreads();
    if (C.tid < 32) cntl[C.tid] = (int)__hip_atomic_load(cnt + C.tid * 64, __ATOMIC_RELAXED, __HIP_MEMORY_SCOPE_AGENT);
    __syncthreads();
    if (C.tid == 0) { int s = 0; for (int e = 0; e < 32; ++e) { tpre[e] = s; s += (cntl[e] + 255) >> 8; } tpre[32] = s; }
    __syncthreads();
    if (C.tid < 32) { for (int rt = tpre[C.tid]; rt < tpre[C.tid + 1]; ++rt) tpre[33 + rt] = C.tid; }
    __syncthreads();
}
__device__ __forceinline__ void ph_moe1_mfma(const Ctx& C, int moe_layer) {
    int* cntl = (int*)(C.lds + MOE_TAB_OFF); int* tpre = cntl + 32;
    moe_prefix256(C, moe_layer, cntl, tpre);
    pg8::MoeOrder S{tpre, 2, (int)gridDim.x, (int)blockIdx.x, tpre[32] * 2};
    pg8::EpiMoe1 E{(bf16*)(C.ws + WS_A), (const int*)(C.ws + WS_LIST), (const float*)(C.ws + WS_LISTW), cntl, NTOK};
    int K1 = 1024; asm volatile("" : "+s"(K1));
    pg8::gemm_phase_gather<pg8::EpiMoe1, pg8::MoeOrder, true>((PG8_LAS unsigned char*)C.lds, (const bf16*)(C.ws + WS_H), (const bf16*)(C.ws + WB_MOE + (size_t)moe_layer * 48 * MiB), K1,
                                                        (const int*)(C.ws + WS_LIST), NTOK, cntl, S, E);
}
__device__ __forceinline__ void ph_moe2_mfma(const Ctx& C, int moe_layer) {
    int* cntl = (int*)(C.lds + MOE_TAB_OFF); int* tpre = cntl + 32;
    moe_prefix256(C, moe_layer, cntl, tpre);
    pg8::MoeOrder S{tpre, 4, (int)gridDim.x, (int)blockIdx.x, tpre[32] * 4};
    pg8::EpiMoe2 E{(unsigned char*)(C.ws + WS_A + 128 * MiB), (const int*)(C.ws + WS_LIST), cntl, NTOK};
    int K2 = 256; asm volatile("" : "+s"(K2));
    pg8::Gemm g{(const bf16*)(C.ws + WS_A), (const bf16*)(C.ws + WB_MOE + (size_t)moe_layer * 48 * MiB + 32 * MiB), 0, 0, K2};
    pg8::gemm_phase<pg8::EpiMoe2, pg8::MoeOrder, PG8_ALIGN, PG8_SP2>((PG8_LAS unsigned char*)C.lds, g, S, E);
}

namespace fa {
typedef short bf16x8 __attribute__((ext_vector_type(8)));
typedef short s16x4 __attribute__((ext_vector_type(4)));
typedef float f32x16 __attribute__((ext_vector_type(16)));
typedef __attribute__((address_space(3))) const char* lds_cptr;
__device__ __forceinline__ int crow(int r, int hi) { return (r & 3) + 8 * (r >> 2) + 4 * hi; }
__device__ __forceinline__ s16x4 vtr(lds_cptr p) { return __builtin_bit_cast(s16x4, __builtin_amdgcn_ds_read_tr16_b64_v4i16((__attribute__((address_space(3))) s16x4*)p)); }
typedef float f32x2_t __attribute__((ext_vector_type(2))); typedef __bf16 bf16x2_t __attribute__((ext_vector_type(2)));
__device__ __forceinline__ unsigned cvtpk(float lo, float hi) { f32x2_t v = {lo, hi}; bf16x2_t b = __builtin_convertvector(v, bf16x2_t); return __builtin_bit_cast(unsigned, b); }
__device__ __forceinline__ float half_swap_max(float v) { auto rr = __builtin_amdgcn_permlane32_swap(__float_as_uint(v), __float_as_uint(v), false, false); return fmaxf(__uint_as_float(rr[0]), __uint_as_float(rr[1])); }
__device__ __forceinline__ float half_swap_sum(float v) { auto rr = __builtin_amdgcn_permlane32_swap(__float_as_uint(v), __float_as_uint(v), false, false); return __uint_as_float(rr[0]) + __uint_as_float(rr[1]); }
__device__ __forceinline__ void dma16(const void* gsrc, LAS unsigned char* ldsdst) { unsigned keep; const unsigned dst = (unsigned)__builtin_amdgcn_readfirstlane((int)(unsigned)(uintptr_t)ldsdst);
    asm volatile("s_mov_b32 %0, m0\n\ts_mov_b32 m0, %2\n\ts_nop 0\n\tglobal_load_lds_dwordx4 %1, off\n\ts_mov_b32 m0, %0" : "=&s"(keep) : "v"(gsrc), "s"(dst) : "memory"); }
__device__ __forceinline__ void dma16s(const void* sbase_, unsigned voff, LAS unsigned char* ldsdst) { unsigned keep; const unsigned dst = (unsigned)__builtin_amdgcn_readfirstlane((int)(unsigned)(uintptr_t)ldsdst);
    const unsigned long long sb_ = (unsigned long long)(uintptr_t)sbase_; const unsigned lo_ = (unsigned)__builtin_amdgcn_readfirstlane((int)(unsigned)sb_), hi_ = (unsigned)__builtin_amdgcn_readfirstlane((int)(unsigned)(sb_ >> 32));
    const void* sbase = (const void*)(uintptr_t)(((unsigned long long)hi_ << 32) | lo_);
    asm volatile("s_mov_b32 %0, m0\n\ts_mov_b32 m0, %3\n\ts_nop 0\n\tglobal_load_lds_dwordx4 %1, %2\n\ts_mov_b32 m0, %0" : "=&s"(keep) : "v"(voff), "s"(sbase), "s"(dst) : "memory"); }

template <int ND0, int NDB>
__device__ __forceinline__ void tile(lds_cptr Kslot, lds_cptr Vslot, const bf16x8 (&qf)[ND0], f32x16 (&o)[NDB], f32x16& negm, float& m, float& l,
                                     LAS float* wsf, bool first, bool diag, int qloc, int lane) {
    const int r32 = lane & 31, hi = lane >> 5;
    lds_cptr kb = Kslot + hi * 1024 + r32 * 16;
    bf16x8 kf0[ND0], kf1[ND0];
#pragma unroll
    for (int d0 = 0; d0 < ND0; ++d0) {
        kf0[d0] = *(const __attribute__((address_space(3))) bf16x8*)(kb + d0 * 2048);
        kf1[d0] = *(const __attribute__((address_space(3))) bf16x8*)(kb + d0 * 2048 + 512);
    }
#pragma unroll
    for (int d0 = 0; d0 < ND0; ++d0) asm volatile("" : "+v"(kf0[d0]), "+v"(kf1[d0]));
    f32x16 p0 = __builtin_amdgcn_mfma_f32_32x32x16_bf16(kf0[0], qf[0], negm, 0, 0, 0);
    f32x16 p1 = __builtin_amdgcn_mfma_f32_32x32x16_bf16(kf1[0], qf[0], negm, 0, 0, 0);
#pragma unroll
    for (int d0 = 1; d0 < ND0; ++d0) {
        p0 = __builtin_amdgcn_mfma_f32_32x32x16_bf16(kf0[d0], qf[d0], p0, 0, 0, 0);
        p1 = __builtin_amdgcn_mfma_f32_32x32x16_bf16(kf1[d0], qf[d0], p1, 0, 0, 0);
    }
    __builtin_amdgcn_sched_barrier(0);
    lds_cptr vp = Vslot + ((lane >> 4) & 1) * 32 + (lane & 3) * 8 + (4 * hi + ((lane & 15) >> 2)) * 64;
    constexpr int NE = (NDB < 2 ? NDB : 2) * 4;
    s16x4 vlo[NDB * 4], vhi[NDB * 4];
#pragma unroll
    for (int i = 0; i < NE; ++i) { vlo[i] = vtr(vp + (i >> 2) * 4096 + (i & 3) * 1024); vhi[i] = vtr(vp + (i >> 2) * 4096 + (i & 3) * 1024 + 512); }
    __builtin_amdgcn_sched_barrier(0);
    if (diag) {
#pragma unroll
        for (int r = 0; r < 16; ++r) { const int kv = crow(r, hi); if (kv > qloc) p0[r] = -1e30f; if (kv + 32 > qloc) p1[r] = -1e30f; }
    }
    float mx = fmaxf(fmaxf(p0[0], p1[0]), p0[1]);
#pragma unroll
    for (int r = 1; r < 16; ++r) { if (r > 1) mx = fmaxf(fmaxf(mx, p0[r]), p1[r]); else mx = fmaxf(mx, p1[r]); }
    mx = half_swap_max(mx);
    const bool need = first || (__builtin_amdgcn_ballot_w64(mx > 8.0f) != 0ull);
    if (need) {
        const float dl = first ? mx : fmaxf(mx, 0.f);
        m += dl;
#pragma unroll
        for (int r = 0; r < 16; ++r) { p0[r] -= dl; p1[r] -= dl; negm[r] = -m; }
        if (!first) {
            const float al = __builtin_amdgcn_exp2f(-dl); l *= al;
            if (hi == 0) wsf[r32] = al;
            asm volatile("s_waitcnt lgkmcnt(0)" ::: "memory");
            f32x4 a4[4];
#pragma unroll
            for (int g = 0; g < 4; ++g) a4[g] = *(const LAS f32x4*)(wsf + 8 * g + 4 * hi);
#pragma unroll
            for (int db = 0; db < NDB; ++db)
#pragma unroll
                for (int r = 0; r < 16; ++r) o[db][r] *= a4[r >> 2][r & 3];
        }
    }
    float sum = 0.f;
#pragma unroll
    for (int ks = 0; ks < 4; ++ks) {
        float e[8];
#pragma unroll
        for (int j = 0; j < 8; ++j) { const float x = (ks < 2) ? p0[8 * ks + j] : p1[8 * (ks - 2) + j]; e[j] = __builtin_amdgcn_exp2f(x); }
        sum += ((e[0] + e[1]) + (e[2] + e[3])) + ((e[4] + e[5]) + (e[6] + e[7]));
        u32x4 w; w.x = cvtpk(e[0], e[1]); w.y = cvtpk(e[2], e[3]); w.z = cvtpk(e[4], e[5]); w.w = cvtpk(e[6], e[7]);
        const bf16x8 pa = __builtin_bit_cast(bf16x8, w);
        if (ks == 0 && NE < NDB * 4) {
#pragma unroll
            for (int i = NE; i < NDB * 4; ++i) { vlo[i] = vtr(vp + (i >> 2) * 4096 + (i & 3) * 1024); vhi[i] = vtr(vp + (i >> 2) * 4096 + (i & 3) * 1024 + 512); }
        }
        __builtin_amdgcn_s_setprio(1);
#pragma unroll
        for (int db = 0; db < NDB; ++db) {
            const s16x4 lo = vlo[db * 4 + ks], hh = vhi[db * 4 + ks];
            const bf16x8 vf = (bf16x8){lo[0], lo[1], lo[2], lo[3], hh[0], hh[1], hh[2], hh[3]};
            o[db] = __builtin_amdgcn_mfma_f32_32x32x16_bf16(pa, vf, o[db], 0, 0, 0);
        }
        __builtin_amdgcn_s_setprio(0);
    }
    l += sum;
}
}


__device__ __forceinline__ void ph_route(const Ctx& C, int layer) {
    typedef float f32x16 __attribute__((ext_vector_type(16)));
    LAS float* hT = (LAS float*)C.lds + C.wave * (32 * 68);
    LAS float* rsl = (LAS float*)C.lds + 8 * 32 * 68 + C.wave * 32;
    int* le0 = (int*)(C.lds + 73728); int* le1 = le0 + 256; int* hist = le1 + 256; int* base = hist + 32; float* lw0 = (float*)(base + 32); float* lw1 = lw0 + 256;
    const bf16* x1 = (const bf16*)(C.ws + WS_XB); unsigned char* H8 = C.ws + WS_H; float* listw = (float*)(C.ws + WS_LISTW); int* list = (int*)(C.ws + WS_LIST);
    unsigned* cnt = (unsigned*)(C.ws + WS_CTL) + CW_CNT + layer * 32 * 64;
    const float* ssqx = (const float*)(C.ws + WS_SSQX);
    const float* gn = as_global(C.in[I_NFFN]) + layer * D;
    const float* WrT = (const float*)(C.ws + WS_WRT) + (size_t)layer * 32 * 1024; const float* wg = as_global(C.in[I_E_WG]) + (size_t)layer * D * 4;
    const float* bg = as_global(C.in[I_E_BG]) + layer * 4; const float* br = as_global(C.in[I_E_BR]) + layer * 32;
    const int lane = C.lane, r32 = lane & 31, hi = lane >> 5, w = C.wave, kq = lane & 15, tsub = lane >> 4;
    LAS float* wgl = (LAS float*)(C.lds + 81920);
    __syncthreads();
    for (int idx = C.tid; idx < 1024; idx += NTHR) *(LAS f32x4*)(wgl + idx * 4) = *(const f32x4*)(wg + (size_t)idx * 4);
    for (int chunk = blockIdx.x; chunk < NTOK / 256; chunk += gridDim.x) {
        __syncthreads();
        if (C.tid < 32) hist[C.tid] = 0;
        const int tok0 = chunk * 256 + w * 32, b = tok0 >> 11;
        const float* shp = C.mod(layer, b, 3); const float* scp = C.mod(layer, b, 4);
        { const float* sp = ssqx + (size_t)(tok0 + r32) * 16; const f32x4 s0 = *(const f32x4*)sp, s1 = *(const f32x4*)(sp + 4), s2 = *(const f32x4*)(sp + 8), s3 = *(const f32x4*)(sp + 12);
          const float sm = ((s0[0] + s0[1]) + (s0[2] + s0[3])) + ((s1[0] + s1[1]) + (s1[2] + s1[3])) + ((s2[0] + s2[1]) + (s2[2] + s2[3])) + ((s3[0] + s3[1]) + (s3[2] + s3[3]));
          if (hi == 0) rsl[r32] = 1.0f / sqrtf(sm * (1.0f / D) + EPS); }
        f32x16 acc;
#pragma unroll
        for (int r = 0; r < 16; ++r) acc[r] = 0.f;
        float gl[4] = {0.f, 0.f, 0.f, 0.f};
        const unsigned xoff = (unsigned)(tok0 + tsub) * 1024u + 4u * kq;
        const unsigned woff = (unsigned)r32 * 1024u + 4u * hi;
        f32x4 X[8], Wa[8], Wb[8];
#define RT_LOADX(kc_) do { _Pragma("unroll") for (int i = 0; i < 8; ++i) { const u32x2 w_ = *(const u32x2*)(x1 + (xoff + 4096u * i + 64u * (kc_))); \
            X[i] = (f32x4){__uint_as_float(w_.x << 16), __uint_as_float(w_.x & 0xffff0000u), __uint_as_float(w_.y << 16), __uint_as_float(w_.y & 0xffff0000u)}; } } while (0)
#define RT_LOADW(W, kc_) do { _Pragma("unroll") for (int c = 0; c < 8; ++c) W[c] = *(const f32x4*)(WrT + (woff + 64u * (kc_) + 8u * c)); } while (0)
#define RT_STEP(W, WN, kc_) do { const unsigned k4 = 64u * (kc_) + 4u * kq; \
            const f32x4 g4 = *(const f32x4*)(gn + k4), sc4 = *(const f32x4*)(scp + k4), sh4 = *(const f32x4*)(shp + k4); const f32x4 gm4 = g4 * (sc4 + 1.0f); \
            _Pragma("unroll") for (int i = 0; i < 8; ++i) { const int tl = 4 * i + tsub; const float rsd = rsl[tl]; const f32x4 h4 = (X[i] * rsd) * gm4 + sh4; \
                int o8 = __builtin_amdgcn_cvt_pk_fp8_f32(h4[0], h4[1], 0, false); o8 = __builtin_amdgcn_cvt_pk_fp8_f32(h4[2], h4[3], o8, true); *(int*)(H8 + (xoff + 4096u * i + 64u * (kc_))) = o8; *(LAS f32x4*)(hT + tl * 68 + 4 * kq) = h4; } \
            if ((kc_) + 1 < 16) { RT_LOADX((kc_) + 1); RT_LOADW(WN, (kc_) + 1); } \
            _Pragma("unroll") for (int c = 0; c < 8; ++c) { const f32x4 b4 = *(const LAS f32x4*)(hT + r32 * 68 + 8 * c + 4 * hi); \
                _Pragma("unroll") for (int j = 0; j < 4; ++j) { acc = __builtin_amdgcn_mfma_f32_32x32x2f32(W[c][j], b4[j], acc, 0, 0, 0); \
                    const f32x4 w4 = *(const LAS f32x4*)(wgl + (64 * (kc_) + 8 * c + 4 * hi + j) * 4); \
                    _Pragma("unroll") for (int q = 0; q < 4; ++q) gl[q] += b4[j] * w4[q]; } asm volatile("" : "+v"(gl[0]), "+v"(gl[1]), "+v"(gl[2]), "+v"(gl[3])); } } while (0)
        RT_LOADX(0); RT_LOADW(Wa, 0);
#pragma unroll 1
        for (int kc = 0; kc < 16; kc += 2) {
            RT_STEP(Wa, Wb, kc);
            RT_STEP(Wb, Wa, kc + 1);
        }
#undef RT_LOADX
#undef RT_LOADW
#undef RT_STEP
#pragma unroll
        for (int q = 0; q < 4; ++q) gl[q] = fa::half_swap_sum(gl[q]);
        float gp[4]; { const float gm = fmaxf(fmaxf(gl[0], gl[1]), fmaxf(gl[2], gl[3])); float gs = 0.f;
#pragma unroll
            for (int g = 0; g < 4; ++g) { gp[g] = expf(gl[g] - gm); gs += gp[g]; }
#pragma unroll
            for (int g = 0; g < 4; ++g) gp[g] /= gs; }
        int gi = 0; float best = -1e30f, gate = 0.f;
#pragma unroll
        for (int g = 0; g < 4; ++g) { const float sv = gp[g] + bg[g]; if (sv > best) { best = sv; gi = g; gate = gp[g]; } }
        float el[8];
#pragma unroll
        for (int j = 0; j < 4; ++j) { const float own = (gi == 0) ? acc[j] : (gi == 1) ? acc[4 + j] : (gi == 2) ? acc[8 + j] : acc[12 + j];
            auto rr = __builtin_amdgcn_permlane32_swap(__float_as_uint(own), __float_as_uint(own), false, false);
            el[j] = __uint_as_float(rr[0]); el[4 + j] = __uint_as_float(rr[1]); }
        float em = el[0];
#pragma unroll
        for (int e = 1; e < 8; ++e) em = fmaxf(em, el[e]);
        float ep[8], es = 0.f;
#pragma unroll
        for (int e = 0; e < 8; ++e) { ep[e] = expf(el[e] - em); es += ep[e]; }
        int i0 = 0; float b0 = -1e30f, p0 = 0.f;
#pragma unroll
        for (int e = 0; e < 8; ++e) { ep[e] /= es; const float sv = ep[e] + br[gi * 8 + e]; if (sv > b0) { b0 = sv; i0 = e; p0 = ep[e]; } }
        int i1 = 0; float b1 = -1e30f, p1 = 0.f;
#pragma unroll
        for (int e = 0; e < 8; ++e) { const float sv = ep[e] + br[gi * 8 + e]; if (e != i0 && sv > b1) { b1 = sv; i1 = e; p1 = ep[e]; } }
        const float den = p0 + p1;
        if (hi == 0) { const int tl = w * 32 + r32; le0[tl] = gi * 8 + i0; le1[tl] = gi * 8 + i1; lw0[tl] = p0 / den * gate; lw1[tl] = p1 / den * gate; }
        __syncthreads();
        int e0 = 0, e1 = 0, q0 = 0, q1 = 0;
        if (C.tid < 256) { e0 = le0[C.tid]; e1 = le1[C.tid]; q0 = atomicAdd(&hist[e0], 1); q1 = atomicAdd(&hist[e1], 1); }
        __syncthreads();
        if (C.tid < 32) base[C.tid] = (int)__hip_atomic_fetch_add(cnt + C.tid * 64, (unsigned)hist[C.tid], __ATOMIC_RELAXED, __HIP_MEMORY_SCOPE_AGENT);
        __syncthreads();
        if (C.tid < 256) { const int tok = chunk * 256 + C.tid;
            const size_t i0_ = (size_t)e0 * NTOK + base[e0] + q0, i1_ = (size_t)e1 * NTOK + base[e1] + q1;
            list[i0_] = 2 * tok; list[i1_] = 2 * tok + 1; listw[i0_] = lw0[C.tid]; listw[i1_] = lw1[C.tid]; }
    }
}

__device__ __forceinline__ void ph_attn_da_mfma(const Ctx& C) {
    using namespace fa;
    LAS unsigned char* L = (LAS unsigned char*)C.lds;
    constexpr int STG = 32768;
    LAS float* wsf = (LAS float*)(L + 3 * STG) + C.wave * 32;
    const int vcu = ((int)blockIdx.x & 7) * 32 + ((int)blockIdx.x >> 3), xcd = vcu >> 5, grp = (vcu >> 4) & 1, jj = vcu & 15;
    const bf16* Q = (const bf16*)(C.ws + WS_A); const bf16* Kb = Q + (size_t)NTOK * D; const bf16* Vb = Kb + (size_t)NTOK * D; bf16* O = (bf16*)(C.ws + WS_O);
    const float lam = *(const float*)(C.ws + WS_LAM);
    const int lane = C.lane, w = C.wave, c = w >> 2, wq = w & 3, r32 = lane & 31, hi = lane >> 5;
    const float c2 = 0.125f * 1.4426950408889634f;
    for (int u = 0; u < 16; ++u) {
        const int bh = xcd * 32 + 2 * u + grp, b = bh >> 3, h = bh & 7, qb = (u & 1) ? 15 - jj : jj, q0 = qb * 128;
        const size_t rowb = (size_t)b * SEQ;
        const int NT = (q0 + 128) / 64, qw0 = q0 + 32 * wq, T = qw0 >> 6;
        const bf16* sbase = (w < 4 ? Kb : Vb) + rowb * D;
        unsigned soff[4]; int dsto[4];
#pragma unroll
        for (int i = 0; i < 4; ++i) {
            if (w < 4) { const int cm = w >> 1, ch = (w & 1) * 4 + i; soff[i] = (unsigned)((lane * D + (2 * h + cm) * 64 + ch * 8) * 2); dsto[i] = cm * 8192 + ch * 1024; }
            else { const int db = w - 4, rg = i; soff[i] = (unsigned)(((rg * 16 + (lane >> 2)) * D + h * 128 + db * 32 + (lane & 3) * 8) * 2); dsto[i] = 16384 + db * 4096 + rg * 1024; }
        }
        bf16x8 qf[4];
#pragma unroll
        for (int d0 = 0; d0 < 4; ++d0) qf[d0] = *(const bf16x8*)(Q + (rowb + qw0 + r32) * D + (2 * h + c) * 64 + d0 * 16 + hi * 8);
#pragma unroll
        for (int d0 = 0; d0 < 4; ++d0) asm volatile("" : "+v"(qf[d0]));
        f32x16 o[4];
#pragma unroll
        for (int db = 0; db < 4; ++db)
#pragma unroll
            for (int r = 0; r < 16; ++r) o[db][r] = 0.f;
        float m = 0.f, l = 0.f; f32x16 negm;
#pragma unroll
        for (int r = 0; r < 16; ++r) negm[r] = 0.f;
        asm volatile("s_waitcnt lgkmcnt(0)" ::: "memory"); __builtin_amdgcn_s_barrier();
#pragma unroll
        for (int i = 0; i < 4; ++i) dma16s(sbase, soff[i], L + dsto[i]);
#pragma unroll
        for (int i = 0; i < 4; ++i) dma16s(sbase + (size_t)64 * D, soff[i], L + STG + dsto[i]);
        int sc_ = 0, sn_ = 2;
        for (int t = 0; t < NT; ++t) {
            if (t + 1 < NT) asm volatile("s_waitcnt vmcnt(4) lgkmcnt(0)" ::: "memory"); else asm volatile("s_waitcnt vmcnt(0) lgkmcnt(0)" ::: "memory");
            __builtin_amdgcn_s_barrier();
            if (t + 2 < NT) {
#pragma unroll
                for (int i = 0; i < 4; ++i) dma16s(sbase + (size_t)(t + 2) * 64 * D, soff[i], L + sn_ * STG + dsto[i]);
            }
            if (t <= T) {
                lds_cptr stg = (lds_cptr)L + sc_ * STG;
                tile<4, 4>(stg + c * 8192, stg + 16384, qf, o, negm, m, l, wsf, t == 0, t == T, qw0 - 64 * T + r32, lane);
            }
            sc_ = (sc_ == 2) ? 0 : sc_ + 1; sn_ = (sn_ == 2) ? 0 : sn_ + 1;
        }
        l = half_swap_sum(l);
        if (hi == 0) wsf[r32] = 1.0f / l;
        asm volatile("s_waitcnt lgkmcnt(0)" ::: "memory");
        f32x4 a4[4];
#pragma unroll
        for (int g = 0; g < 4; ++g) a4[g] = *(const LAS f32x4*)(wsf + 8 * g + 4 * hi);
#pragma unroll
        for (int db = 0; db < 4; ++db)
#pragma unroll
            for (int r = 0; r < 16; ++r) o[db][r] *= a4[r >> 2][r & 3];
        asm volatile("s_waitcnt lgkmcnt(0)" ::: "memory"); __builtin_amdgcn_s_barrier();
        LAS float* X = (LAS float*)L + wq * 4096;
        if (c == 1) {
#pragma unroll
            for (int db = 0; db < 4; ++db)
#pragma unroll
                for (int r = 0; r < 16; ++r) X[(db * 16 + r) * 64 + lane] = o[db][r];
        }
        asm volatile("s_waitcnt lgkmcnt(0)" ::: "memory"); __builtin_amdgcn_s_barrier();
        if (c == 0) {
            float gsub[4];
#pragma unroll
            for (int db = 0; db < 4; ++db) gsub[db] = as_global(C.in[I_DA_SUBLN])[db * 32 + r32] * 0.8f;
#pragma unroll
            for (int r = 0; r < 16; ++r) {
                float v[4], ss = 0.f;
#pragma unroll
                for (int db = 0; db < 4; ++db) { v[db] = o[db][r] - lam * X[(db * 16 + r) * 64 + lane]; ss += v[db] * v[db]; }
#pragma unroll
                for (int off = 1; off < 32; off <<= 1) ss += __shfl_xor(ss, off);
                const float rstd = 1.0f / sqrtf(ss * (1.0f / 128.0f) + EPS);
                bf16* orow = O + (rowb + qw0 + crow(r, hi)) * D + h * 128 + r32;
#pragma unroll
                for (int db = 0; db < 4; ++db) orow[db * 32] = (bf16)f2bf(v[db] * rstd * gsub[db]);
            }
        }
    }
}
__device__ __forceinline__ void ph_attn_mla_mfma(const Ctx& C) {
    using namespace fa;
    LAS unsigned char* L = (LAS unsigned char*)C.lds;
    constexpr int STG = 20480;
    LAS float* wsf = (LAS float*)(L + 3 * STG) + C.wave * 32;
    const int vcu = ((int)blockIdx.x & 7) * 32 + ((int)blockIdx.x >> 3), xcd = vcu >> 5, grp = (vcu >> 3) & 3, jj = vcu & 7;
    const bf16* Q2 = (const bf16*)(C.ws + WS_A); const bf16* KV2 = (const bf16*)(C.ws + WS_A + 192 * MiB);
    const bf16* KPE = (const bf16*)(C.ws + WS_KPE); bf16* O = (bf16*)(C.ws + WS_O);
    const int lane = C.lane, w = C.wave, r32 = lane & 31, hi = lane >> 5;
    const float c2 = 0.10206207261596575f * 1.4426950408889634f;
    for (int u = 0; u < 16; ++u) {
        const int bh = xcd * 64 + 4 * u + grp, b = bh >> 4, h = bh & 15, qb = (u & 1) ? 7 - jj : jj, q0 = qb * 256;
        const size_t rowb = (size_t)b * SEQ;
        const int NT = (q0 + 256) / 64, qw0 = q0 + 32 * w, T = qw0 >> 6;
        const bf16* src[3]; int dsto[3]; size_t sstep[3];
#pragma unroll
        for (int i = 0; i < 3; ++i) {
            const int pi = w + 8 * i;
            if (pi < 8) { src[i] = KV2 + (rowb + lane) * 2048 + h * 128 + pi * 8; dsto[i] = pi * 1024; sstep[i] = (size_t)64 * 2048; }
            else if (pi < 12) { src[i] = KPE + (rowb + lane) * 32 + (pi - 8) * 8; dsto[i] = pi * 1024; sstep[i] = (size_t)64 * 32; }
            else { const int db = (pi - 12) >> 2, rg = (pi - 12) & 3; src[i] = KV2 + (rowb + rg * 16 + (lane >> 2)) * 2048 + h * 128 + 64 + db * 32 + (lane & 3) * 8; dsto[i] = 12288 + db * 4096 + rg * 1024; sstep[i] = (size_t)64 * 2048; }
        }
        const bool has3 = (w + 16) < 20;
        bf16x8 qf[6];
#pragma unroll
        for (int d0 = 0; d0 < 6; ++d0) qf[d0] = *(const bf16x8*)(Q2 + (rowb + qw0 + r32) * 1536 + h * 96 + d0 * 16 + hi * 8);
#pragma unroll
        for (int d0 = 0; d0 < 6; ++d0) asm volatile("" : "+v"(qf[d0]));
        f32x16 o[2];
#pragma unroll
        for (int db = 0; db < 2; ++db)
#pragma unroll
            for (int r = 0; r < 16; ++r) o[db][r] = 0.f;
        float m = 0.f, l = 0.f; f32x16 negm;
#pragma unroll
        for (int r = 0; r < 16; ++r) negm[r] = 0.f;
        asm volatile("s_waitcnt lgkmcnt(0)" ::: "memory"); __builtin_amdgcn_s_barrier();
        dma16(src[0], L + dsto[0]); dma16(src[1], L + dsto[1]); if (has3) dma16(src[2], L + dsto[2]);
        dma16(src[0] + sstep[0], L + STG + dsto[0]); dma16(src[1] + sstep[1], L + STG + dsto[1]); if (has3) dma16(src[2] + sstep[2], L + STG + dsto[2]);
        int sc_ = 0, sn_ = 2;
        for (int t = 0; t < NT; ++t) {
            if (t + 1 < NT) { if (has3) asm volatile("s_waitcnt vmcnt(3) lgkmcnt(0)" ::: "memory"); else asm volatile("s_waitcnt vmcnt(2) lgkmcnt(0)" ::: "memory"); }
            else asm volatile("s_waitcnt vmcnt(0) lgkmcnt(0)" ::: "memory");
            __builtin_amdgcn_s_barrier();
            if (t + 2 < NT) {
                LAS unsigned char* nb = L + sn_ * STG;
                dma16(src[0] + (t + 2) * sstep[0], nb + dsto[0]); dma16(src[1] + (t + 2) * sstep[1], nb + dsto[1]); if (has3) dma16(src[2] + (t + 2) * sstep[2], nb + dsto[2]);
            }
            if (t <= T) {
                lds_cptr stg = (lds_cptr)L + sc_ * STG;
                tile<6, 2>(stg, stg + 12288, qf, o, negm, m, l, wsf, t == 0, t == T, qw0 - 64 * T + r32, lane);
            }
            sc_ = (sc_ == 2) ? 0 : sc_ + 1; sn_ = (sn_ == 2) ? 0 : sn_ + 1;
        }
        l = half_swap_sum(l);
        if (hi == 0) wsf[r32] = 1.0f / l;
        asm volatile("s_waitcnt lgkmcnt(0)" ::: "memory");
        f32x4 a4[4];
#pragma unroll
        for (int g = 0; g < 4; ++g) a4[g] = *(const LAS f32x4*)(wsf + 8 * g + 4 * hi);
#pragma unroll
        for (int r = 0; r < 16; ++r) {
            bf16* orow = O + (rowb + qw0 + crow(r, hi)) * D + h * 64 + r32;
#pragma unroll
            for (int db = 0; db < 2; ++db) orow[db * 32] = (bf16)f2bf(o[db][r] * a4[r >> 2][r & 3]);
        }
    }
}

__global__ void __launch_bounds__(NTHR, 2) fwd(Args args) {
    extern __shared__ __attribute__((aligned(16))) unsigned char lds[];
    Ctx C; C.in = args.in; C.out = args.out; C.ws = args.ws; C.lds = lds;
    C.tid = threadIdx.x; C.lane = C.tid & 63; C.wave = __builtin_amdgcn_readfirstlane(C.tid >> 6);
    C.gw = blockIdx.x * NWAVES + C.wave; C.ngw = gridDim.x * NWAVES;
    const Ctx C0 = C;
    volatile LAS unsigned* MISC = (volatile LAS unsigned*)((LAS unsigned char*)lds + MISC_OFF);
    if (C.tid < 32) MISC[C.tid] = 0u;
    __syncthreads();
    XcdBarrier bar; bar.bar = (unsigned*)(args.ws + WS_CTL) + CW_BAR; bar.x = 0; bar.st = nullptr;
    const int lo = args.ph_lo, hi = args.ph_hi;
    if (hi - lo > 1) bar = xcd_barrier_post((unsigned*)(args.ws + WS_CTL) + CW_BAR, MISC + 8);
#ifndef REPMASK
#define REPMASK 0u
#endif
#ifndef PHMASK
#define PHMASK 0xFFFFFFFFu
#endif
#define IN(k) (lo <= (k) && (k) < hi && ((PHMASK >> (k)) & 1u))
#define SEAM(k) do { if (IN(k) && IN((k) + 1)) xcd_barrier(bar); } while (0)
#define PHLOCAL unsigned char* ws = args.ws; asm volatile("" : "+s"(ws)); ws = as_global(ws); int t_ = threadIdx.x; asm volatile("" : "+v"(t_)); Ctx C = C0; C.ws = ws; C.tid = t_; C.lane = t_ & 63; \
        bf16* H = (bf16*)(ws + WS_H); bf16* O = (bf16*)(ws + WS_O); bf16* A0 = (bf16*)(ws + WS_A); (void)H; (void)O; (void)A0;

    if (IN(0)) { PHLOCAL ph_prologue(C); } SEAM(0);
    if (IN(1)) { PHLOCAL ph_normmod0(C); } SEAM(1);
    if (IN(2)) { PHLOCAL
        pg8::Gemm g{H, (const bf16*)(ws + WB_QKV), NTOK, 3 * D, D}; pg8::StaticOrder S; S.init(NTOK, 3 * D, (int)gridDim.x, (int)blockIdx.x);
        pg8::EpiQKV E{A0, A0 + (size_t)NTOK * D, A0 + (size_t)2 * NTOK * D, (const float*)(ws + WS_COSD), (const float*)(ws + WS_SIND), as_global(args.in[I_DA_QN]), as_global(args.in[I_DA_KN]), 0.125f * 1.4426950408889634f, EPS};
        pg8::gemm_phase<pg8::EpiQKV, pg8::StaticOrder, PG8_ALIGN, PG8_SP2>((PG8_LAS unsigned char*)lds, g, S, E);
    } SEAM(2);
    if (IN(3)) { PHLOCAL ph_attn_da_mfma(C); } SEAM(3);
    if (IN(4)) { PHLOCAL
        pg8::Gemm g{O, (const bf16*)(ws + WB_DAO), NTOK, D, D}; pg8::StaticOrder S; S.init(NTOK, D, (int)gridDim.x, (int)blockIdx.x);
        pg8::EpiResid<true> E{as_global(args.in[I_X]), (bf16*)(ws + WS_XB), C.mod(0, 0, 2), (float*)(ws + WS_SSQX)};
        pg8::gemm_phase<pg8::EpiResid<true>, pg8::StaticOrder, PG8_ALIGN, PG8_SP2>((PG8_LAS unsigned char*)lds, g, S, E);
    } SEAM(4);
    if (IN(5)) { PHLOCAL ph_route(C, 0); } SEAM(5);
    if (IN(6)) { PHLOCAL ph_moe1_mfma(C, 0); } SEAM(6);
    if (IN(7)) { PHLOCAL ph_moe2_mfma(C, 0); } SEAM(7);
    if (IN(8)) { PHLOCAL ph_comb<false>(C, ws + WS_A + 128 * MiB, C.mod(0, 0, 5), 1, as_global(args.in[I_NMIX]) + D); } SEAM(8);
    if (IN(9)) { PHLOCAL
        bf16* CQ = (bf16*)(ws + WS_S); bf16* CKV = CQ + (size_t)NTOK * 384; bf16* KPE = (bf16*)(ws + WS_KPE);
        pg8::Gemm g{H, (const bf16*)(ws + WB_WIN), NTOK, 768, D}; pg8::StaticOrder S; S.init(NTOK, 768, (int)gridDim.x, (int)blockIdx.x);
        pg8::EpiWin E{CQ, CKV, KPE, (float*)(ws + WS_SSQ), (const float*)(ws + WS_COSM), (const float*)(ws + WS_SINM), as_global(args.in[I_M_KPN]), EPS};
        pg8::gemm_phase<pg8::EpiWin, pg8::StaticOrder, PG8_ALIGN, PG8_SP2>((PG8_LAS unsigned char*)lds, g, S, E);
    } SEAM(9);
    if (IN(10)) { PHLOCAL
        const bf16* CQ = (const bf16*)(ws + WS_S); const bf16* CKV = CQ + (size_t)NTOK * 384;
        int Kq = 384, Kkv = 256; asm volatile("" : "+s"(Kq), "+s"(Kkv));
        { pg8::Gemm g{CQ, (const bf16*)(ws + WB_WUQ), NTOK, 1536, Kq}; pg8::StaticOrder S; S.init(NTOK, 1536, (int)gridDim.x, (int)blockIdx.x);
          pg8::EpiUQ E{A0, (const float*)(ws + WS_SSQ), (const float*)(ws + WS_COSM), (const float*)(ws + WS_SINM), as_global(args.in[I_M_QNN]), as_global(args.in[I_M_QPN]), 0.10206207261596575f * 1.4426950408889634f, EPS};
          pg8::gemm_phase<pg8::EpiUQ, pg8::StaticOrder, PG8_ALIGN, PG8_SP2>((PG8_LAS unsigned char*)lds, g, S, E); }
        { pg8::Gemm g{CKV, (const bf16*)(ws + WB_WUKV), NTOK, 2048, Kkv}; pg8::StaticOrder S; S.init(NTOK, 2048, (int)gridDim.x, (int)blockIdx.x);
          pg8::EpiUKV E{(bf16*)(ws + WS_A + 192 * MiB), (const float*)(ws + WS_SSQ), as_global(args.in[I_M_KNN]), EPS};
          pg8::gemm_phase<pg8::EpiUKV, pg8::StaticOrder, PG8_ALIGN, PG8_SP2>((PG8_LAS unsigned char*)lds, g, S, E); }
    } SEAM(10);
    if (IN(11)) { PHLOCAL ph_attn_mla_mfma(C); } SEAM(11);
    if (IN(12)) { PHLOCAL
        pg8::Gemm g{O, (const bf16*)(ws + WB_MLO), NTOK, D, D}; pg8::StaticOrder S; S.init(NTOK, D, (int)gridDim.x, (int)blockIdx.x);
        pg8::EpiResid<false> E{ws + WS_XB, (bf16*)(ws + WS_XB), C.mod(1, 0, 2), (float*)(ws + WS_SSQX)};
        pg8::gemm_phase<pg8::EpiResid<false>, pg8::StaticOrder, PG8_ALIGN, PG8_SP2>((PG8_LAS unsigned char*)lds, g, S, E);
    } SEAM(12);
    if (IN(13)) { PHLOCAL ph_route(C, 1); } SEAM(13);
    if (IN(14)) { PHLOCAL ph_moe1_mfma(C, 1); } SEAM(14);
    if (IN(15)) { PHLOCAL ph_moe2_mfma(C, 1); } SEAM(15);
    if (IN(16)) { PHLOCAL ph_comb<true>(C, ws + WS_A + 128 * MiB, C.mod(1, 0, 5), 1, as_global(args.in[I_NMIX])); }
#undef IN
#undef SEAM
}

extern "C" void kernel_launch(void* const* d_in, const int* in_sizes, int n_in, void* d_out, int out_size, void* d_ws, size_t ws_size, hipStream_t stream) {
    static int grid = 0;
    if (grid == 0) {
        if (n_in != 33 || out_size != NTOK * D || ws_size < WS_END) { fprintf(stderr, "kernel_launch: unexpected shapes n_in %d out %d ws %zu\n", n_in, out_size, ws_size); grid = -1; return; }
        int dev = 0, cus = 0;
        if (hipGetDevice(&dev) != hipSuccess || hipDeviceGetAttribute(&cus, hipDeviceAttributeMultiprocessorCount, dev) != hipSuccess) { grid = -1; return; }
        if (hipFuncSetAttribute((const void*)fwd, hipFuncAttributeMaxDynamicSharedMemorySize, LDS_BYTES) != hipSuccess) { fprintf(stderr, "hipFuncSetAttribute failed\n"); grid = -1; return; }
        (void)hipGetLastError();
        grid = cus;
        if (grid != 256) { fprintf(stderr, "kernel_launch: built for 256 CUs, device reports %d\n", cus); grid = -1; return; }
    }
    if (grid < 0) return;
    (void)hipMemsetAsync((char*)d_ws + WS_CTL, 0, CTL_ZERO_BYTES, stream);
    Args a{};
    for (int i = 0; i < 33; ++i) a.in[i] = (const float*)d_in[i];
    a.out = (float*)d_out; a.ws = (unsigned char*)d_ws;
#if MK_ONE_LAUNCH
    a.ph_lo = 0; a.ph_hi = N_PHASES;
    hipLaunchKernelGGL(fwd, dim3(grid), dim3(NTHR), LDS_BYTES, stream, a);
#else
    for (int p = 0; p < N_PHASES; ++p) { a.ph_lo = p; a.ph_hi = p + 1; hipLaunchKernelGGL(fwd, dim3(grid), dim3(NTHR), LDS_BYTES, stream, a); }
#endif
}
```

```cpp
#include <hip/hip_runtime.h>
#include <cstdio>
#include <cstdint>

#define LAS __attribute__((address_space(3)))
#define GAS __attribute__((address_space(1)))
template <class T> __device__ __forceinline__ T* as_global(T* p) { GAS T* g = (GAS T*)p; asm("" : "+s"(g)); return (T*)g; }
typedef unsigned short bf16;
typedef float f32x4 __attribute__((ext_vector_type(4)));
typedef unsigned u32x4 __attribute__((ext_vector_type(4)));
typedef unsigned u32x2 __attribute__((ext_vector_type(2)));

constexpr int NB = 32, SEQ = 2048, D = 1024, NTOK = NB * SEQ;
constexpr float EPS = 1e-6f;
constexpr int NWAVES = 8, NTHR = 512;
constexpr int N_PHASES = 17;
#ifndef MK_ONE_LAUNCH
#define MK_ONE_LAUNCH 1
#endif

constexpr size_t MiB = 1u << 20;
constexpr size_t WS_CTL = 0, CTL_ZERO_BYTES = 1 * MiB;
constexpr size_t WS_MOD = 1 * MiB;
constexpr size_t WS_LAM = WS_MOD + 7 * MiB / 4;
constexpr size_t WS_SSQX = 4 * MiB;
constexpr size_t WS_SSQ = 8 * MiB;
constexpr size_t WS_WRT = 12 * MiB;
constexpr size_t WS_COSD = 16 * MiB, WS_SIND = 24 * MiB, WS_COSM = 32 * MiB, WS_SINM = 36 * MiB;
constexpr size_t WS_TOKW = 40 * MiB;
constexpr size_t WS_LIST = 42 * MiB;
constexpr size_t WS_WB = 50 * MiB;
constexpr size_t WB_QKV = WS_WB, WB_DAO = WB_QKV + 6 * MiB, WB_WIN = WB_DAO + 2 * MiB, WB_WUQ = WB_WIN + 3 * MiB / 2, WB_WUKV = WB_WUQ + 9 * MiB / 8, WB_MLO = WB_WUKV + 1 * MiB, WB_MOE = WB_MLO + 2 * MiB;
constexpr size_t WS_H = 176 * MiB;
constexpr size_t WS_O = 304 * MiB;
constexpr size_t WS_A = 432 * MiB;
constexpr size_t WS_LISTW = 160 * MiB;
constexpr size_t WS_KPE = 168 * MiB;
constexpr size_t WS_S = WS_O;
constexpr size_t WS_XB = 880 * MiB;
constexpr size_t WS_END = 1008 * MiB;
constexpr int CW_BAR = 4096;
constexpr int CW_CNT = 16384;
constexpr int HID_ROWS = 2 * NTOK + 32 * 128;

constexpr int LDS_BYTES = 147456;
constexpr int MISC_OFF = 131072 + 320;

__device__ __forceinline__ unsigned f2bf(float f) { unsigned u = __builtin_bit_cast(unsigned, f); return (u + 0x7fffu + ((u >> 16) & 1u)) >> 16; }
__device__ __forceinline__ float bf2f(unsigned h) { return __builtin_bit_cast(float, h << 16); }
__device__ __forceinline__ unsigned pk2(float lo, float hi) { return f2bf(lo) | (f2bf(hi) << 16); }
__device__ __forceinline__ float wave_sum(float v) {
#pragma unroll
    for (int o = 1; o < 64; o <<= 1) v += __shfl_xor(v, o);
    return v;
}
__device__ __forceinline__ float wave_max(float v) {
#pragma unroll
    for (int o = 1; o < 64; o <<= 1) v = fmaxf(v, __shfl_xor(v, o));
    return v;
}

#define XB_TMO      128
#define XB_XCNT(j)  (256  + 64 * (j))
#define XB_XSUB(j)  (1280 + 64 * (j))
#define XB_XGEN(j)  (2304 + 64 * (j))
#define XB_TOP      3328
#define XB_TOPGEN   3392
#define XCD_BAR_WORDS 3456
#define XB_SPIN_CAP (1u << 20)
__device__ __forceinline__ unsigned xb_ld(unsigned* p)              { return __hip_atomic_load(p, __ATOMIC_RELAXED, __HIP_MEMORY_SCOPE_AGENT); }
__device__ __forceinline__ unsigned xb_add(unsigned* p, unsigned v) { return __hip_atomic_fetch_add(p, v, __ATOMIC_RELAXED, __HIP_MEMORY_SCOPE_AGENT); }
__device__ __forceinline__ unsigned xb_xcc_id() { return (unsigned)__builtin_amdgcn_s_getreg((3 << 11) | 20) & 0xFu; }
#define XB_SPIN(cond, bar) do { unsigned _sp = 0; while (cond) { __builtin_amdgcn_s_sleep(1); \
    if ((++_sp & 255u) == 0u) { if (xb_ld(&(bar)[XB_TMO])) break; if (_sp > XB_SPIN_CAP) { atomicAdd(&(bar)[XB_TMO], 1u); break; } } } } while (0)
struct XcdBarrier { unsigned* bar; unsigned x; volatile LAS unsigned* st; };
__device__ __forceinline__ XcdBarrier xcd_barrier_post(unsigned* bar, volatile LAS unsigned* st) {
    XcdBarrier b; b.bar = bar; b.x = xb_xcc_id(); b.st = st;
    if (threadIdx.x == 0) (void)xb_add(&bar[XB_XCNT(b.x)], 1u);
    return b;
}
__device__ __forceinline__ void xcd_barrier_complete(unsigned* bar, unsigned x, unsigned& nloc, unsigned& nx) {
    const unsigned G = gridDim.x * gridDim.y * gridDim.z;
    unsigned sum, cnt, mine, sp = 0u;
    for (;;) {
        sum = 0u; cnt = 0u; mine = 0u;
#pragma unroll
        for (unsigned j = 0; j < 16; ++j) { const unsigned c = xb_ld(&bar[XB_XCNT(j)]); sum += c; cnt += (c > 0u) ? 1u : 0u; mine = (j == x) ? c : mine; }
        if (sum == G) break;
        __builtin_amdgcn_s_sleep(1);
        if ((++sp & 255u) == 0u) { if (xb_ld(&bar[XB_TMO])) break; if (sp > XB_SPIN_CAP) { atomicAdd(&bar[XB_TMO], 1u); break; } }
    }
    nloc = mine > 0u ? mine : 1u; nx = cnt > 0u ? cnt : 1u;
}
__device__ __forceinline__ void xcd_barrier(const XcdBarrier& b) {
    asm volatile("s_waitcnt vmcnt(0)" ::: "memory");
    __syncthreads();
    if (threadIdx.x == 0) {
        unsigned* bar = b.bar;
        __builtin_amdgcn_s_waitcnt(0);
        unsigned nloc = b.st[0], nx = b.st[1];
        if (nloc == 0u) { xcd_barrier_complete(bar, b.x, nloc, nx); b.st[0] = nloc; b.st[1] = nx; }
        const unsigned old = xb_add(&bar[XB_XSUB(b.x)], 1u);
        const unsigned gen = old / nloc;
        if (old + 1u == (gen + 1u) * nloc) {
            __builtin_amdgcn_fence(__ATOMIC_RELEASE, "agent");
            asm volatile("s_waitcnt vmcnt(0)" ::: "memory");
            const unsigned og = xb_add(&bar[XB_TOP], 1u);
            const unsigned tg = og / nx;
            if (og + 1u == (tg + 1u) * nx) xb_add(&bar[XB_TOPGEN], 1u);
            else XB_SPIN(xb_ld(&bar[XB_TOPGEN]) == tg, bar);
            __builtin_amdgcn_fence(__ATOMIC_ACQUIRE, "agent");
            xb_add(&bar[XB_XGEN(b.x)], 1u);
            asm volatile("s_waitcnt vmcnt(0)" ::: "memory");
        } else {
            XB_SPIN(xb_ld(&bar[XB_XGEN(b.x)]) == gen, bar);
            __builtin_amdgcn_fence(__ATOMIC_ACQUIRE, "agent");
            asm volatile("s_waitcnt vmcnt(0)" ::: "memory");
        }
    }
    __syncthreads();
}

namespace pg8 {
#define PG8_LAS __attribute__((address_space(3)))
typedef unsigned short bf16_t;
typedef short bf16x8 __attribute__((ext_vector_type(8)));
typedef float f32x4 __attribute__((ext_vector_type(4)));
typedef unsigned u32x4 __attribute__((ext_vector_type(4)));
constexpr int BM = 256, BK = 64, HALF = 128, HTB = HALF * BK * 2  , STAGE_BYTES = 8 * HTB, NXCD = 8, WGM = 8;

__host__ __device__ __forceinline__ int lds_byte(int r, int c) { const int st = (r >> 4) * 2 + (c >> 5), rr = r & 15, cc = c & 31, ob = rr * 64 + cc * 2; return st * 1024 + (ob ^ (((ob >> 9) & 1) << 5)); }
__host__ __device__ __forceinline__ void stage_rc(int b, int& R, int& C) { const int st = b / 1024, sb = b % 1024, swz = sb ^ (((sb >> 9) & 1) << 5); R = (st >> 1) * 16 + swz / 64; C = (st & 1) * 32 + (swz % 64) / 2; }
__host__ __device__ __forceinline__ int perm32(int rho) { const int n = rho >> 4, i = rho & 15; return 8 * (i >> 2) + 4 * n + (i & 3); }

struct Unit { int pm, pn; };
struct Gemm { const bf16_t* A; const bf16_t* Bt; int M, N, K; };

struct StaticOrder {
    typedef Unit UnitT;
    int nM, nN, nwg, G, c;
    __host__ __device__ void init(int M, int N, int G_, int c_) { nM = M / BM; nN = N / BM; nwg = nM * nN; G = G_; c = c_; }
    __host__ __device__ bool next(int i, Unit& u) const {
        const long L = (long)i * G + c; if (L >= nwg) return false;
        int wgid = (int)L; { const int q = nwg / NXCD, r = nwg % NXCD, xcd = wgid % NXCD, off = wgid / NXCD; wgid = (xcd < r ? xcd * (q + 1) : r * (q + 1) + (xcd - r) * q) + off; }
        const int nig = WGM * nN, gid = wgid / nig, fm = gid * WGM, gsz = (nM - fm) < WGM ? (nM - fm) : WGM;
        u.pm = fm + ((wgid % nig) % gsz); u.pn = (wgid % nig) / gsz; return true;
    }
    __device__ __forceinline__ void a_ready(const Unit&) const {}
    __device__ __forceinline__ void done(const Unit&) const {}
};

__device__ __forceinline__ unsigned cvt_pk_bf16(float lo, float hi) { unsigned r; asm volatile("v_cvt_pk_bf16_f32 %0, %1, %2" : "=v"(r) : "v"(lo), "v"(hi)); return r; }
typedef float f32x2 __attribute__((ext_vector_type(2)));
__device__ __forceinline__ f32x2 gelu_pk(f32x2 v) {
    const f32x2 av = __builtin_elementwise_abs(v), d = av * 0.2316418882f + 1.0f;
    f32x2 t; t.x = __builtin_amdgcn_rcpf(d.x); t.y = __builtin_amdgcn_rcpf(d.y);
    f32x2 q = t * 0.5307027145f + (-0.7265760135f); q = q * t + 0.7107068705f; q = q * t + (-0.142248368f); q = q * t + 0.127414796f; q = q * t;
    const f32x2 s = (v * v) * (-0.72134752044f);
    f32x2 e; e.x = __builtin_amdgcn_exp2f(s.x); e.y = __builtin_amdgcn_exp2f(s.y);
    const f32x2 m = v * (q * e), r = v - m;
    f32x2 o; o.x = v.x < 0.f ? m.x : r.x; o.y = v.y < 0.f ? m.y : r.y; return o;
}

template <int ACT  > struct EpiBf16 {
    static constexpr bool PERM = true, AFTER_DRAIN = false; static_assert(ACT == 0 || ACT == 1, "EpiBf16: ACT is 0 (none) or 1 (gelu_pk)");
    bf16_t* O; int ldc; const float* bias; int split_cols; size_t split_stride; float scale0;
    __device__ __forceinline__ void operator()(const f32x4 (&acc)[2][2][4][2], const Unit& u, int wr, int wc, int fr, int fq) const {
        const int row0 = u.pm * BM + wr * 64 + fr; int colt = u.pn * BM; bf16_t* base = O;
        float sc = 1.f; if (split_cols) { const int t = colt / split_cols; base += (size_t)t * split_stride; colt -= t * split_cols; if (t == 0) sc = scale0; }
        const int col0 = colt + wc * 32 + 8 * fq, bcol0 = u.pn * BM + wc * 32 + 8 * fq;
        f32x4 bv[2][2];
#pragma unroll
        for (int bj = 0; bj < 2; ++bj)
#pragma unroll
            for (int n = 0; n < 2; ++n) bv[bj][n] = bias ? *(const f32x4*)(bias + bcol0 + bj * HALF + 4 * n) : (f32x4){0.f, 0.f, 0.f, 0.f};
#pragma unroll
        for (int ai = 0; ai < 2; ++ai)
#pragma unroll
            for (int m = 0; m < 4; ++m) { bf16_t* rowp = base + (size_t)(row0 + ai * HALF + m * 16) * ldc + col0;
#pragma unroll
                for (int bj = 0; bj < 2; ++bj) { f32x4 v0 = acc[ai][bj][m][0] + bv[bj][0], v1 = acc[ai][bj][m][1] + bv[bj][1];
                    if (ACT == 1) { f32x2 a = gelu_pk((f32x2){v0[0], v0[1]}), b = gelu_pk((f32x2){v0[2], v0[3]}), c = gelu_pk((f32x2){v1[0], v1[1]}), d = gelu_pk((f32x2){v1[2], v1[3]});
                        v0 = (f32x4){a.x, a.y, b.x, b.y}; v1 = (f32x4){c.x, c.y, d.x, d.y}; }
                    v0 = v0 * sc; v1 = v1 * sc; u32x4 w; w.x = cvt_pk_bf16(v0[0], v0[1]); w.y = cvt_pk_bf16(v0[2], v0[3]); w.z = cvt_pk_bf16(v1[0], v1[1]); w.w = cvt_pk_bf16(v1[2], v1[3]);
                    *(u32x4*)(rowp + bj * HALF) = w; } }
    }
};

template <class Epi, class Sched, bool ALIGN_EPI = false, bool SP2 = false>
__device__ __forceinline__ void gemm_phase(PG8_LAS unsigned char* lds, const Gemm g, const Sched& S, const Epi& E) {
    int tid_ = threadIdx.x; asm volatile("" : "+v"(tid_));
    const int tid = tid_, wid = __builtin_amdgcn_readfirstlane(tid >> 6), lane = tid & 63, wr = wid >> 2, wc = wid & 3, fr = lane & 15, fq = lane >> 4;
    const int K = g.K, nt = K / BK;
    unsigned voffA[2], voffB[2];
#pragma unroll
    for (int i = 0; i < 2; ++i) { int R, C; stage_rc(tid * 16 + i * 8192, R, C); const int Rb = Epi::PERM ? ((R & ~31) + perm32(R & 31)) : R;
        voffA[i] = (unsigned)(R * K + C) * 2u; voffB[i] = (unsigned)(Rb * K + C) * 2u; }
    const size_t kstep = (size_t)(BK * 2);
    const size_t hstep = (size_t)HALF * K * 2;
    const size_t tstep = 2 * hstep;
    const unsigned ldsw = (unsigned)wid * 1024u;
    const int aoff = lds_byte(wr * 64 + fr, fq * 8), boff = lds_byte(wc * 32 + fr, fq * 8);
#define PG8_SA(b, h) (((b) * 2 + (h)) * HTB)
#define PG8_SB(b, h) ((4 + (b) * 2 + (h)) * HTB)
#define PG8_STAGE(bufoff, gbase, voff) do { _Pragma("unroll") for (int _i = 0; _i < 2; ++_i) \
        __builtin_amdgcn_global_load_lds((const unsigned*)((const char*)(gbase) + (voff)[_i]), (PG8_LAS unsigned*)(lds + (bufoff) + ldsw + _i * 8192), 16, 0, 0); } while (0)
#define PG8_LDA(dst, b, h) do { _Pragma("unroll") for (int m = 0; m < 4; ++m) _Pragma("unroll") for (int k = 0; k < 2; ++k) dst[m][k] = *(const PG8_LAS bf16x8*)(lds + PG8_SA(b, h) + aoff + m * 2048 + k * 1024); } while (0)
#define PG8_LDB(dst, b, h) do { _Pragma("unroll") for (int n = 0; n < 2; ++n) _Pragma("unroll") for (int k = 0; k < 2; ++k) dst[n][k] = *(const PG8_LAS bf16x8*)(lds + PG8_SB(b, h) + boff + n * 2048 + k * 1024); } while (0)
#define PG8_MMA(ai, bj, At, Bt) do { __builtin_amdgcn_s_setprio(1); _Pragma("unroll") for (int m = 0; m < 4; ++m) _Pragma("unroll") for (int n = 0; n < 2; ++n) _Pragma("unroll") for (int k = 0; k < 2; ++k) \
        acc[ai][bj][m][n] = __builtin_amdgcn_mfma_f32_16x16x32_bf16(Bt[n][k], At[m][k], acc[ai][bj][m][n], 0, 0, 0); __builtin_amdgcn_s_setprio(0); } while (0)
#define PG8_WAIT_V(n) asm volatile("s_waitcnt vmcnt(" #n ")" ::: "memory")
#define PG8_WAIT_L(n) asm volatile("s_waitcnt lgkmcnt(" #n ")" ::: "memory")
#define PG8_BAR __builtin_amdgcn_s_barrier()
#define PG8_SCHED __builtin_amdgcn_sched_barrier(0)
    typename Sched::UnitT cur, nxt; int ui = 0;
    if (!S.next(0, cur)) return;
    f32x4 acc[2][2][4][2];
#pragma unroll
    for (int a = 0; a < 2; ++a)
#pragma unroll
        for (int b = 0; b < 2; ++b)
#pragma unroll
            for (int m = 0; m < 4; ++m)
#pragma unroll
                for (int n = 0; n < 2; ++n) acc[a][b][m][n] = (f32x4){0.f, 0.f, 0.f, 0.f};
    bf16x8 At[4][2], B0[2][2], B1[2][2];
    const char* cA = (const char*)g.A + (size_t)cur.pm * tstep; const char* cB = (const char*)g.Bt + (size_t)cur.pn * tstep;
    S.a_ready(cur);
    if constexpr (SP2) {
        PG8_STAGE(PG8_SB(0, 0), cB, voffB); PG8_STAGE(PG8_SB(0, 1), cB + hstep, voffB); PG8_STAGE(PG8_SA(0, 0), cA, voffA); PG8_STAGE(PG8_SA(0, 1), cA + hstep, voffA);
        if (wr == 1) PG8_BAR;
        PG8_WAIT_V(2); PG8_BAR;
        PG8_STAGE(PG8_SB(1, 0), cB + kstep, voffB); PG8_STAGE(PG8_SA(1, 0), cA + kstep, voffA); PG8_STAGE(PG8_SB(1, 1), cB + hstep + kstep, voffB);
        PG8_WAIT_V(6); PG8_BAR;
    } else {
        PG8_STAGE(PG8_SB(0, 0), cB, voffB); PG8_STAGE(PG8_SA(0, 0), cA, voffA); PG8_STAGE(PG8_SB(0, 1), cB + hstep, voffB); PG8_STAGE(PG8_SA(0, 1), cA + hstep, voffA);
        if (wr == 1) PG8_BAR;
        PG8_WAIT_V(4); PG8_BAR;
        PG8_STAGE(PG8_SB(1, 0), cB + kstep, voffB); PG8_STAGE(PG8_SA(1, 0), cA + kstep, voffA); PG8_STAGE(PG8_SB(1, 1), cB + hstep + kstep, voffB);
        PG8_WAIT_V(6); PG8_BAR;
    }
    for (;;) {
        const bool has_next = S.next(ui + 1, nxt);
        const char* nA = has_next ? (const char*)g.A + (size_t)nxt.pm * tstep : cA; const char* nB = has_next ? (const char*)g.Bt + (size_t)nxt.pn * tstep : cB;
        for (int t = 0; t < nt; t += 2) {
            const bool last = (t == nt - 2);
            const char* a1 = cA + (size_t)(t + 1) * kstep;
            const char* a2 = last ? nA : cA + (size_t)(t + 2) * kstep; const char* b2 = last ? nB : cB + (size_t)(t + 2) * kstep;
            const char* a3 = a2 + kstep; const char* b3 = b2 + kstep;
            if (last && has_next) S.a_ready(nxt);
            if constexpr (SP2) {
            PG8_LDB(B0, 0, 0); PG8_LDB(B1, 0, 1); PG8_SCHED; PG8_LDA(At, 0, 0); PG8_STAGE(PG8_SA(1, 1), a1 + hstep, voffA);
            PG8_WAIT_V(8); PG8_WAIT_L(0); PG8_BAR; PG8_MMA(0, 0, At, B0); PG8_MMA(0, 1, At, B1); PG8_BAR; PG8_SCHED;
            PG8_LDA(At, 0, 1); PG8_STAGE(PG8_SB(0, 0), b2, voffB); PG8_STAGE(PG8_SB(0, 1), b2 + hstep, voffB); PG8_STAGE(PG8_SA(0, 0), a2, voffA);
            PG8_WAIT_V(8); PG8_WAIT_L(0); PG8_BAR; PG8_MMA(1, 0, At, B0); PG8_MMA(1, 1, At, B1); PG8_BAR; PG8_SCHED;
            PG8_LDB(B0, 1, 0); PG8_LDB(B1, 1, 1); PG8_SCHED; PG8_LDA(At, 1, 0); PG8_STAGE(PG8_SA(0, 1), a2 + hstep, voffA);
            PG8_WAIT_V(8); PG8_WAIT_L(0); PG8_BAR; PG8_MMA(0, 0, At, B0); PG8_MMA(0, 1, At, B1); PG8_BAR; PG8_SCHED;
            PG8_LDA(At, 1, 1); PG8_STAGE(PG8_SB(1, 0), b3, voffB); PG8_STAGE(PG8_SB(1, 1), b3 + hstep, voffB); PG8_STAGE(PG8_SA(1, 0), a3, voffA);
            PG8_WAIT_V(8); PG8_WAIT_L(0); PG8_BAR; PG8_MMA(1, 0, At, B0); PG8_MMA(1, 1, At, B1); PG8_BAR; PG8_SCHED;
            } else {
            PG8_LDB(B0, 0, 0); PG8_SCHED; PG8_LDA(At, 0, 0); PG8_STAGE(PG8_SA(1, 1), a1 + hstep, voffA);
            PG8_WAIT_L(8); PG8_BAR; PG8_WAIT_L(0); PG8_MMA(0, 0, At, B0); PG8_BAR; PG8_SCHED;
            PG8_LDB(B1, 0, 1); PG8_STAGE(PG8_SB(0, 0), b2, voffB);
            PG8_BAR; PG8_WAIT_L(0); PG8_MMA(0, 1, At, B1); PG8_BAR;
            PG8_LDA(At, 0, 1); PG8_STAGE(PG8_SA(0, 0), a2, voffA);
            PG8_BAR; PG8_WAIT_L(0); PG8_MMA(1, 0, At, B0); PG8_BAR; PG8_SCHED;
            PG8_STAGE(PG8_SB(0, 1), b2 + hstep, voffB);
            PG8_WAIT_V(6); PG8_BAR; PG8_MMA(1, 1, At, B1); PG8_BAR;
            PG8_LDB(B0, 1, 0); PG8_SCHED; PG8_LDA(At, 1, 0); PG8_STAGE(PG8_SA(0, 1), a2 + hstep, voffA);
            PG8_WAIT_L(8); PG8_BAR; PG8_WAIT_L(0); PG8_MMA(0, 0, At, B0); PG8_BAR; PG8_SCHED;
            PG8_LDB(B1, 1, 1); PG8_STAGE(PG8_SB(1, 0), b3, voffB);
            PG8_BAR; PG8_WAIT_L(0); PG8_MMA(0, 1, At, B1); PG8_BAR;
            PG8_LDA(At, 1, 1); PG8_STAGE(PG8_SA(1, 0), a3, voffA);
            PG8_BAR; PG8_WAIT_L(0); PG8_MMA(1, 0, At, B0); PG8_BAR; PG8_SCHED;
            PG8_STAGE(PG8_SB(1, 1), b3 + hstep, voffB);
            PG8_WAIT_V(6); PG8_BAR; PG8_MMA(1, 1, At, B1); PG8_BAR;
            }
        }
        if constexpr (ALIGN_EPI) { if (wr == 0) PG8_BAR; }
        if constexpr (!Epi::AFTER_DRAIN) { E(acc, cur, wr, wc, fr, fq); S.done(cur); }
        if (!has_next) break;
#pragma unroll
        for (int a = 0; a < 2; ++a)
#pragma unroll
            for (int b = 0; b < 2; ++b)
#pragma unroll
                for (int m = 0; m < 4; ++m)
#pragma unroll
                    for (int n = 0; n < 2; ++n) acc[a][b][m][n] = (f32x4){0.f, 0.f, 0.f, 0.f};
        cur = nxt; cA = nA; cB = nB; ++ui;
        if constexpr (ALIGN_EPI) { if (wr == 1) PG8_BAR; }
    }
    PG8_WAIT_V(0);
    if constexpr (!ALIGN_EPI) { if (wr == 0) PG8_BAR; }
    PG8_BAR;
    if constexpr (Epi::AFTER_DRAIN) { E.fused(acc, cur, wr, wc, fr, fq, lds, wid, lane); S.done(cur); }
#undef PG8_SA
#undef PG8_SB
#undef PG8_STAGE
#undef PG8_LDA
#undef PG8_LDB
#undef PG8_MMA
#undef PG8_WAIT_V
#undef PG8_WAIT_L
#undef PG8_BAR
#undef PG8_SCHED
}


__device__ __forceinline__ float quad_sum(float v) {
    auto a = __builtin_amdgcn_permlane16_swap(__float_as_uint(v), __float_as_uint(v), false, false); v = __uint_as_float(a[0]) + __uint_as_float(a[1]);
    auto b = __builtin_amdgcn_permlane32_swap(__float_as_uint(v), __float_as_uint(v), false, false); return __uint_as_float(b[0]) + __uint_as_float(b[1]);
}
__device__ __forceinline__ float sq4(const f32x4& v) { return (v[0] * v[0] + v[1] * v[1]) + (v[2] * v[2] + v[3] * v[3]); }
__device__ __forceinline__ u32x4 pack8(const f32x4& a, const f32x4& b) { u32x4 o; o.x = cvt_pk_bf16(a[0], a[1]); o.y = cvt_pk_bf16(a[2], a[3]); o.z = cvt_pk_bf16(b[0], b[1]); o.w = cvt_pk_bf16(b[2], b[3]); return o; }
__device__ __forceinline__ void store_rows8(bf16_t* base, unsigned rowA, unsigned pitch, const u32x4& x0, const u32x4& x1) {
    u32x4 a, b;
#pragma unroll
    for (int c = 0; c < 4; ++c) { a[c] = (unsigned)__builtin_amdgcn_update_dpp((int)x0[c], (int)x1[c], 0x128, 0xF, 0xC, false); b[c] = (unsigned)__builtin_amdgcn_update_dpp((int)x1[c], (int)x0[c], 0x128, 0xF, 0x3, false); }
    *(u32x4*)(base + rowA * pitch) = a; *(u32x4*)(base + (rowA + 8u) * pitch) = b;
}
struct EpiQKV {
    static constexpr bool PERM = true, AFTER_DRAIN = false;
    bf16_t* Q; bf16_t* K; bf16_t* V; const float* cosD; const float* sinD; const float* gq; const float* gk; float qscale; float eps;
    __device__ __forceinline__ void operator()(const f32x4 (&acc)[2][2][4][2], const Unit& u, int wr, int wc, int fr, int fq) const {
        asm volatile("" : "+v"(fr), "+v"(fq));
        const int tile = u.pn; const unsigned row0 = (unsigned)(u.pm * BM + wr * 64 + fr);
        if (tile >= 8) {
            bf16_t* vb = V + (tile - 8) * 256 + wc * 32 + fq * 8;
#pragma unroll
            for (int ai = 0; ai < 2; ++ai)
#pragma unroll
                for (int m = 0; m < 4; ++m) { const unsigned off = (row0 + ai * HALF + m * 16) * 1024u;
#pragma unroll
                    for (int bj = 0; bj < 2; ++bj) *(u32x4*)(vb + off + bj * HALF) = pack8(acc[ai][bj][m][0], acc[ai][bj][m][1]); }
        } else {
            const bool isk = tile >= 4; const int hm = (tile & 3) * 4 + wc; bf16_t* dst = (isk ? K : Q) + hm * 64 + 32 * (fr >> 3) + 8 * fq; const unsigned rowA0 = (unsigned)(u.pm * BM + wr * 64 + (fr & 7)); const float* g = isk ? gk : gq; const float sc = isk ? 1.0f : qscale;
            const f32x4 g0a = *(const f32x4*)(g + 8 * fq), g0b = *(const f32x4*)(g + 8 * fq + 4), g1a = *(const f32x4*)(g + 32 + 8 * fq), g1b = *(const f32x4*)(g + 36 + 8 * fq);
            const float* cb = cosD + 8 * fq; const float* sb = sinD + 8 * fq;
#pragma unroll
            for (int ai = 0; ai < 2; ++ai)
#pragma unroll
                for (int m = 0; m < 4; ++m) {
                    const unsigned row = row0 + ai * HALF + m * 16;
                    const f32x4 c0 = *(const f32x4*)(cb + row * 32u), c1 = *(const f32x4*)(cb + row * 32u + 4), s0 = *(const f32x4*)(sb + row * 32u), s1 = *(const f32x4*)(sb + row * 32u + 4);
                    const f32x4 a0 = acc[ai][0][m][0], a1 = acc[ai][0][m][1], b0 = acc[ai][1][m][0], b1 = acc[ai][1][m][1];
                    const float ss = quad_sum((sq4(a0) + sq4(a1)) + (sq4(b0) + sq4(b1)));
                    const float rs = __builtin_amdgcn_rsqf(ss * (1.0f / 64.0f) + eps) * sc;
                    const f32x4 x1a = a0 * (g0a * rs), x1b = a1 * (g0b * rs), x2a = b0 * (g1a * rs), x2b = b1 * (g1b * rs);
                    store_rows8(dst, rowA0 + ai * HALF + m * 16, 1024u, pack8(x1a * c0 - x2a * s0, x1b * c1 - x2b * s1), pack8(x2a * c0 + x1a * s0, x2b * c1 + x1b * s1));
                }
        }
    }
};
template <bool XF32>
struct EpiResid {
    static constexpr bool PERM = true, AFTER_DRAIN = false;
    const void* xin; bf16_t* xout; const float* gate; float* ssq;
    __device__ __forceinline__ void operator()(const f32x4 (&acc)[2][2][4][2], const Unit& u, int wr, int wc, int fr, int fq) const {
        asm volatile("" : "+v"(fr), "+v"(fq));
        const int b = (u.pm * BM) >> 11; const unsigned colb = (unsigned)(u.pn * BM + wc * 32 + 8 * fq); const unsigned row0 = (unsigned)(u.pm * BM + wr * 64 + fr);
        const float* gp = gate + (size_t)b * 6144 + colb;
        f32x4 g[2][2];
#pragma unroll
        for (int bj = 0; bj < 2; ++bj)
#pragma unroll
            for (int n = 0; n < 2; ++n) g[bj][n] = *(const f32x4*)(gp + bj * HALF + n * 4);
        bf16_t* xo = xout + colb; float* sq = ssq + u.pn * 4 + wc;
#pragma unroll
        for (int ai = 0; ai < 2; ++ai) {
            f32x4 xq[4][2][2];
#pragma unroll
            for (int m = 0; m < 4; ++m) { const unsigned off_ = (row0 + ai * HALF + m * 16) * 1024u + colb;
#pragma unroll
                for (int bj = 0; bj < 2; ++bj) {
                    if (XF32) { xq[m][bj][0] = *(const f32x4*)((const float*)xin + off_ + bj * HALF); xq[m][bj][1] = *(const f32x4*)((const float*)xin + off_ + bj * HALF + 4); }
                    else { const u32x4 w = *(const u32x4*)((const bf16_t*)xin + off_ + bj * HALF);
                        xq[m][bj][0] = (f32x4){__uint_as_float(w.x << 16), __uint_as_float(w.x & 0xffff0000u), __uint_as_float(w.y << 16), __uint_as_float(w.y & 0xffff0000u)};
                        xq[m][bj][1] = (f32x4){__uint_as_float(w.z << 16), __uint_as_float(w.z & 0xffff0000u), __uint_as_float(w.w << 16), __uint_as_float(w.w & 0xffff0000u)}; } } }
#pragma unroll
            for (int m = 0; m < 4; ++m) {
                const unsigned row = row0 + ai * HALF + m * 16; const unsigned off = row * 1024u; float ss = 0.f;
#pragma unroll
                for (int bj = 0; bj < 2; ++bj) { const f32x4 v0 = xq[m][bj][0] + g[bj][0] * acc[ai][bj][m][0], v1 = xq[m][bj][1] + g[bj][1] * acc[ai][bj][m][1];
                    *(u32x4*)(xo + off + bj * HALF) = pack8(v0, v1); ss += sq4(v0) + sq4(v1); }
                ss = quad_sum(ss);
                if (fq == 0) sq[row * 16u] = ss;
            }
        }
    }
};
struct EpiWin {
    static constexpr bool PERM = true, AFTER_DRAIN = false;
    bf16_t* CQ; bf16_t* CKV; bf16_t* KPE; float* ssq; const float* cosM; const float* sinM; const float* gkpe; float eps;
    __device__ __forceinline__ void operator()(const f32x4 (&acc)[2][2][4][2], const Unit& u, int wr, int wc, int fr, int fq) const {
        asm volatile("" : "+v"(fr), "+v"(fq));
        const int ws = u.pn * 4 + wc; const unsigned row0 = (unsigned)(u.pm * BM + wr * 64 + fr);
        if (ws < 10) {
            bf16_t* dst = ((ws < 6) ? CQ + 64 * ws : CKV + 64 * (ws - 6)) + 32 * (fr >> 3) + 8 * fq; const unsigned ld = (ws < 6) ? 384u : 256u; float* sq = ssq + ws; const unsigned rowA0 = (unsigned)(u.pm * BM + wr * 64 + (fr & 7));
#pragma unroll
            for (int ai = 0; ai < 2; ++ai)
#pragma unroll
                for (int m = 0; m < 4; ++m) {
                    const unsigned row = row0 + ai * HALF + m * 16;
                    const f32x4 a0 = acc[ai][0][m][0], a1 = acc[ai][0][m][1], b0 = acc[ai][1][m][0], b1 = acc[ai][1][m][1];
                    store_rows8(dst, rowA0 + ai * HALF + m * 16, ld, pack8(a0, a1), pack8(b0, b1));
                    const float ss = quad_sum((sq4(a0) + sq4(a1)) + (sq4(b0) + sq4(b1)));
                    if (fq == 0) sq[row * 16u] = ss;
                }
        } else if (ws == 10) {
            const f32x4 g0 = *(const f32x4*)(gkpe + 4 * fq), g1 = *(const f32x4*)(gkpe + 16 + 4 * fq);
#pragma unroll
            for (int ai = 0; ai < 2; ++ai)
#pragma unroll
                for (int m = 0; m < 4; ++m) {
                    const unsigned row = row0 + ai * HALF + m * 16;
                    const f32x4 c = *(const f32x4*)(cosM + row * 16u + 4 * fq), sn = *(const f32x4*)(sinM + row * 16u + 4 * fq);
                    const f32x4 y0 = acc[ai][0][m][0], y1 = acc[ai][0][m][1];
                    const float rs = __builtin_amdgcn_rsqf(quad_sum(sq4(y0) + sq4(y1)) * (1.0f / 32.0f) + eps);
                    const f32x4 x1 = y0 * (g0 * rs), x2 = y1 * (g1 * rs);
                    *(u32x4*)(KPE + row * 32u + 8 * fq) = pack8(x1 * c - x2 * sn, x2 * c + x1 * sn);
                }
        }
    }
};
struct EpiUQ {
    static constexpr bool PERM = true, AFTER_DRAIN = false;
    bf16_t* Q2; const float* ssq; const float* cosM; const float* sinM; const float* gqn; const float* gqp; float qscale; float eps;
    __device__ __forceinline__ void operator()(const f32x4 (&acc)[2][2][4][2], const Unit& u, int wr, int wc, int fr, int fq) const {
        asm volatile("" : "+v"(fr), "+v"(fq));
        const int tile = u.pn; const unsigned row0 = (unsigned)(u.pm * BM + wr * 64 + fr);
        if (tile < 4) {
            bf16_t* dst = Q2 + (tile * 4 + wc) * 96 + 32 * (fr >> 3) + 8 * fq; const unsigned rowA0 = (unsigned)(u.pm * BM + wr * 64 + (fr & 7));
            const f32x4 g0a = *(const f32x4*)(gqn + 8 * fq) * qscale, g0b = *(const f32x4*)(gqn + 8 * fq + 4) * qscale, g1a = *(const f32x4*)(gqn + 32 + 8 * fq) * qscale, g1b = *(const f32x4*)(gqn + 36 + 8 * fq) * qscale;
#pragma unroll
            for (int ai = 0; ai < 2; ++ai) {
                f32x4 sA[4], sB[4];
#pragma unroll
                for (int m = 0; m < 4; ++m) { const unsigned row = row0 + ai * HALF + m * 16; sA[m] = *(const f32x4*)(ssq + row * 16u); sB[m] = *(const f32x4*)(ssq + row * 16u + 4); }
#pragma unroll
                for (int m = 0; m < 4; ++m) {
                    const unsigned row = row0 + ai * HALF + m * 16;
                    const f32x4 a0 = acc[ai][0][m][0], a1 = acc[ai][0][m][1], b0 = acc[ai][1][m][0], b1 = acc[ai][1][m][1];
                    const float ss = quad_sum((sq4(a0) + sq4(a1)) + (sq4(b0) + sq4(b1)));
                    const float em = eps * ((((sA[m][0] + sA[m][1]) + (sA[m][2] + sA[m][3])) + (sB[m][0] + sB[m][1])) * (1.0f / 384.0f) + eps);
                    const float rn = __builtin_amdgcn_rsqf(ss * (1.0f / 64.0f) + em);
                    store_rows8(dst, rowA0 + ai * HALF + m * 16, 1536u, pack8(a0 * (g0a * rn), a1 * (g0b * rn)), pack8(b0 * (g1a * rn), b1 * (g1b * rn)));
                }
            }
        } else {
            const f32x4 g0 = *(const f32x4*)(gqp + 4 * fq) * qscale, g1 = *(const f32x4*)(gqp + 16 + 4 * fq) * qscale;
            bf16_t* dst = Q2 + (((tile - 4) * 4 + wc) * 2) * 96 + 64 + 8 * fq;
#pragma unroll
            for (int ai = 0; ai < 2; ++ai) {
                f32x4 sA[4], sB[4], cc[4], sn[4];
#pragma unroll
                for (int m = 0; m < 4; ++m) { const unsigned row = row0 + ai * HALF + m * 16; sA[m] = *(const f32x4*)(ssq + row * 16u); sB[m] = *(const f32x4*)(ssq + row * 16u + 4);
                    cc[m] = *(const f32x4*)(cosM + row * 16u + 4 * fq); sn[m] = *(const f32x4*)(sinM + row * 16u + 4 * fq); }
#pragma unroll
                for (int m = 0; m < 4; ++m) {
                    const unsigned row = row0 + ai * HALF + m * 16;
                    const float em = eps * ((((sA[m][0] + sA[m][1]) + (sA[m][2] + sA[m][3])) + (sB[m][0] + sB[m][1])) * (1.0f / 384.0f) + eps);
#pragma unroll
                    for (int bj = 0; bj < 2; ++bj) {
                        const f32x4 y0 = acc[ai][bj][m][0], y1 = acc[ai][bj][m][1];
                        const float rn = __builtin_amdgcn_rsqf(quad_sum(sq4(y0) + sq4(y1)) * (1.0f / 32.0f) + em);
                        const f32x4 x1 = y0 * (g0 * rn), x2 = y1 * (g1 * rn);
                        *(u32x4*)(dst + row * 1536u + bj * 96) = pack8(x1 * cc[m] - x2 * sn[m], x2 * cc[m] + x1 * sn[m]);
                    }
                }
            }
        }
    }
};
struct EpiUKV {
    static constexpr bool PERM = true, AFTER_DRAIN = false;
    bf16_t* KV2; const float* ssq; const float* gkn; float eps;
    __device__ __forceinline__ void operator()(const f32x4 (&acc)[2][2][4][2], const Unit& u, int wr, int wc, int fr, int fq) const {
        asm volatile("" : "+v"(fr), "+v"(fq));
        const int tile = u.pn, head = (tile & 3) * 4 + wc; const unsigned row0 = (unsigned)(u.pm * BM + wr * 64 + fr), rowA0 = (unsigned)(u.pm * BM + wr * 64 + (fr & 7)); const int hcol = 32 * (fr >> 3) + 8 * fq;
        f32x4 sB[2][4], sC[2][4];
#pragma unroll
        for (int ai = 0; ai < 2; ++ai)
#pragma unroll
            for (int m = 0; m < 4; ++m) { const unsigned row = row0 + ai * HALF + m * 16; sB[ai][m] = *(const f32x4*)(ssq + row * 16u + 4); sC[ai][m] = *(const f32x4*)(ssq + row * 16u + 8); }
        if (tile < 4) {
            bf16_t* dst = KV2 + head * 128 + hcol;
            const f32x4 g0a = *(const f32x4*)(gkn + 8 * fq), g0b = *(const f32x4*)(gkn + 8 * fq + 4), g1a = *(const f32x4*)(gkn + 32 + 8 * fq), g1b = *(const f32x4*)(gkn + 36 + 8 * fq);
#pragma unroll
            for (int ai = 0; ai < 2; ++ai)
#pragma unroll
                for (int m = 0; m < 4; ++m) {
                    const unsigned row = row0 + ai * HALF + m * 16;
                    const f32x4 a0 = acc[ai][0][m][0], a1 = acc[ai][0][m][1], b0 = acc[ai][1][m][0], b1 = acc[ai][1][m][1];
                    const float ss = quad_sum((sq4(a0) + sq4(a1)) + (sq4(b0) + sq4(b1)));
                    const float msq = ((sB[ai][m][2] + sB[ai][m][3]) + (sC[ai][m][0] + sC[ai][m][1])) * (1.0f / 256.0f) + eps;
                    const float rn = __builtin_amdgcn_rsqf(ss * (1.0f / 64.0f) + eps * msq);
                    store_rows8(dst, rowA0 + ai * HALF + m * 16, 2048u, pack8(a0 * (g0a * rn), a1 * (g0b * rn)), pack8(b0 * (g1a * rn), b1 * (g1b * rn)));
                }
        } else {
            bf16_t* dst = KV2 + head * 128 + 64 + hcol;
#pragma unroll
            for (int ai = 0; ai < 2; ++ai)
#pragma unroll
                for (int m = 0; m < 4; ++m) {
                    const unsigned row = row0 + ai * HALF + m * 16;
                    const float rsq = __builtin_amdgcn_rsqf(((sB[ai][m][2] + sB[ai][m][3]) + (sC[ai][m][0] + sC[ai][m][1])) * (1.0f / 256.0f) + eps);
                    store_rows8(dst, rowA0 + ai * HALF + m * 16, 2048u, pack8(acc[ai][0][m][0] * rsq, acc[ai][0][m][1] * rsq), pack8(acc[ai][1][m][0] * rsq, acc[ai][1][m][1] * rsq));
                }
        }
    }
};

struct MUnit { int pm, pn, e, r0; };
struct MoeOrder {
    typedef MUnit UnitT;
    const int* tpre; int ncol, G, c, total;
    __device__ __forceinline__ bool next(int i, MUnit& u) const {
        const int L = i * G + c; if (L >= total) return false;
        const int rt = L / ncol, ct = L - rt * ncol; const int e = tpre[33 + rt];
        u.e = e; u.pm = rt; u.r0 = (rt - tpre[e]) * 256; u.pn = e * ncol + ct; return true;
    }
    __device__ __forceinline__ void a_ready(const MUnit&) const {}
    __device__ __forceinline__ void done(const MUnit&) const {}
};
__device__ __forceinline__ float silu_f(float a) { return a * __builtin_amdgcn_rcpf(1.0f + __builtin_amdgcn_exp2f(-1.4426950408889634f * a)); }
struct EpiMoe1 {
    static constexpr bool PERM = true, AFTER_DRAIN = false;
    bf16_t* hid; const int* glist; const float* tokw; const int* cntl; int ntok;
    __device__ __forceinline__ void operator()(const f32x4 (&acc)[2][2][4][2], const MUnit& u, int wr, int wc, int fr, int fq) const {
        const int cnt = cntl[u.e], t = u.pn & 1;
        asm volatile("" : "+v"(fr), "+v"(fq));
#pragma unroll
        for (int ai = 0; ai < 2; ++ai)
#pragma unroll
            for (int m = 0; m < 4; ++m) {
                const int rl = ai * HALF + wr * 64 + m * 16 + fr, r = u.r0 + rl; float w = 0.f;
                if (r < cnt) w = tokw[(unsigned)(u.e * ntok + r)];
                const f32x4 a0 = acc[ai][0][m][0], a1 = acc[ai][0][m][1], b0 = acc[ai][1][m][0], b1 = acc[ai][1][m][1];
                u32x4 o;
                o.x = cvt_pk_bf16(silu_f(a0[0]) * b0[0] * w, silu_f(a0[1]) * b0[1] * w); o.y = cvt_pk_bf16(silu_f(a0[2]) * b0[2] * w, silu_f(a0[3]) * b0[3] * w);
                o.z = cvt_pk_bf16(silu_f(a1[0]) * b1[0] * w, silu_f(a1[1]) * b1[1] * w); o.w = cvt_pk_bf16(silu_f(a1[2]) * b1[2] * w, silu_f(a1[3]) * b1[3] * w);
                *(u32x4*)(hid + ((size_t)u.pm * BM + rl) * 256 + t * 128 + wc * 32 + fq * 8) = o;
                asm volatile("" ::: "memory");
            }
    }
};
struct EpiMoe2 {
    static constexpr bool PERM = true, AFTER_DRAIN = false;
    unsigned char* y2; const int* glist; const int* cntl; int ntok;
    __device__ __forceinline__ void operator()(const f32x4 (&acc)[2][2][4][2], const MUnit& u, int wr, int wc, int fr, int fq) const {
        const int cnt = cntl[u.e], ct = u.pn & 3;
        asm volatile("" : "+v"(fr), "+v"(fq));
#pragma unroll
        for (int ai = 0; ai < 2; ++ai)
#pragma unroll
            for (int m = 0; m < 4; ++m) {
                const int rl = ai * HALF + wr * 64 + m * 16 + fr, r = u.r0 + rl;
                int ent = glist[(unsigned)(u.e * ntok + (r < cnt ? r : 0))]; ent = (r < cnt) ? ent : 2 * ntok;
                unsigned char* rowp = y2 + (size_t)(unsigned)ent * 1024 + ct * 256 + wc * 32 + fq * 8;
#pragma unroll
                for (int bj = 0; bj < 2; ++bj) { const f32x4 v0 = acc[ai][bj][m][0] * 32.0f, v1 = acc[ai][bj][m][1] * 32.0f; u32x2 o;
                    int p = __builtin_amdgcn_cvt_pk_fp8_f32(v0[0], v0[1], 0, false); p = __builtin_amdgcn_cvt_pk_fp8_f32(v0[2], v0[3], p, true); o.x = (unsigned)p;
                    p = __builtin_amdgcn_cvt_pk_fp8_f32(v1[0], v1[1], 0, false); p = __builtin_amdgcn_cvt_pk_fp8_f32(v1[2], v1[3], p, true); o.y = (unsigned)p;
                    *(u32x2*)(rowp + bj * HALF) = o; }
                asm volatile("" ::: "memory");
            }
    }
};
template <class Epi, class Sched, bool FP8 = false>
__device__ __forceinline__ void gemm_phase_gather(PG8_LAS unsigned char* lds, const bf16_t* A, const bf16_t* Bt, int K, const int* glist, int ntok, const int* cntl, const Sched& S, const Epi& E) {
    int tid_ = threadIdx.x; asm volatile("" : "+v"(tid_));
    const int tid = tid_, wid = __builtin_amdgcn_readfirstlane(tid >> 6), lane = tid & 63, wr = wid >> 2, wc = wid & 3, fr = lane & 15, fq = lane >> 4;
    const int rowb = FP8 ? K : 2 * K, nt = FP8 ? K / (2 * BK) : K / BK;
    unsigned voffB[2];
#pragma unroll
    for (int i = 0; i < 2; ++i) { int R, C; stage_rc(tid * 16 + i * 8192, R, C); const int Rb = Epi::PERM ? ((R & ~31) + perm32(R & 31)) : R;
        voffB[i] = (unsigned)(Rb * rowb + C * 2); }
    const size_t kstep = (size_t)(BK * 2);
    const size_t hstep = (size_t)HALF * rowb;
    const size_t tstep = 2 * hstep;
    const unsigned ldsw = (unsigned)wid * 1024u;
    const int aoff = lds_byte(wr * 64 + fr, fq * 8), boff = lds_byte(wc * 32 + fr, fq * 8);
#define PG8_SA(b, h) (((b) * 2 + (h)) * HTB)
#define PG8_SB(b, h) ((4 + (b) * 2 + (h)) * HTB)
#define PG8_STAGE(bufoff, gbase, voff) do { _Pragma("unroll") for (int _i = 0; _i < 2; ++_i) \
        __builtin_amdgcn_global_load_lds((const unsigned*)((const char*)(gbase) + (voff)[_i]), (PG8_LAS unsigned*)(lds + (bufoff) + ldsw + _i * 8192), 16, 0, 0); } while (0)
    typedef int i32x4_ __attribute__((ext_vector_type(4))); typedef int i32x8_ __attribute__((ext_vector_type(8)));
#define PG8_LDA(dst, b, h) do { _Pragma("unroll") for (int m = 0; m < 4; ++m) { if constexpr (FP8) { const i32x4_ l0_ = *(const PG8_LAS i32x4_*)(lds + PG8_SA(b, h) + aoff + m * 2048), l1_ = *(const PG8_LAS i32x4_*)(lds + PG8_SA(b, h) + aoff + m * 2048 + 1024); \
            dst##8[m] = __builtin_shufflevector(l0_, l1_, 0, 1, 2, 3, 4, 5, 6, 7); } else { _Pragma("unroll") for (int k = 0; k < 2; ++k) dst[m][k] = *(const PG8_LAS bf16x8*)(lds + PG8_SA(b, h) + aoff + m * 2048 + k * 1024); } } } while (0)
#define PG8_LDB(dst, b, h) do { _Pragma("unroll") for (int n = 0; n < 2; ++n) { if constexpr (FP8) { const i32x4_ l0_ = *(const PG8_LAS i32x4_*)(lds + PG8_SB(b, h) + boff + n * 2048), l1_ = *(const PG8_LAS i32x4_*)(lds + PG8_SB(b, h) + boff + n * 2048 + 1024); \
            dst##8[n] = __builtin_shufflevector(l0_, l1_, 0, 1, 2, 3, 4, 5, 6, 7); } else { _Pragma("unroll") for (int k = 0; k < 2; ++k) dst[n][k] = *(const PG8_LAS bf16x8*)(lds + PG8_SB(b, h) + boff + n * 2048 + k * 1024); } } } while (0)
#define PG8_MMA(ai, bj, At, Bt) do { __builtin_amdgcn_s_setprio(1); _Pragma("unroll") for (int m = 0; m < 4; ++m) _Pragma("unroll") for (int n = 0; n < 2; ++n) { \
        if constexpr (FP8) acc[ai][bj][m][n] = __builtin_amdgcn_mfma_scale_f32_16x16x128_f8f6f4(Bt##8[n], At##8[m], acc[ai][bj][m][n], 0, 0, 0, 0x7a7a7a7a, 0, 0x7f7f7f7f); \
        else { _Pragma("unroll") for (int k = 0; k < 2; ++k) acc[ai][bj][m][n] = __builtin_amdgcn_mfma_f32_16x16x32_bf16(Bt[n][k], At[m][k], acc[ai][bj][m][n], 0, 0, 0); } } \
        __builtin_amdgcn_s_setprio(0); } while (0)
#define PG8_WAIT_V(n) asm volatile("s_waitcnt vmcnt(" #n ")" ::: "memory")
#define PG8_WAIT_L(n) asm volatile("s_waitcnt lgkmcnt(" #n ")" ::: "memory")
#define PG8_BAR __builtin_amdgcn_s_barrier()
#define PG8_SCHED __builtin_amdgcn_sched_barrier(0)
#define PG8_GOFF(u, off) do { const int _cnt = cntl[(u).e]; _Pragma("unroll") for (int _h = 0; _h < 2; ++_h) _Pragma("unroll") for (int _i = 0; _i < 2; ++_i) { \
        int _R, _C; stage_rc(tid * 16 + _i * 8192, _R, _C); const int _r = (u).r0 + _h * HALF + _R; const int _ent = glist[(unsigned)((u).e * ntok + (_r < _cnt ? _r : 0))]; \
        off[_h][_i] = (unsigned)(_ent >> 1) * (unsigned)rowb + (unsigned)(_C * 2); } } while (0)
    typename Sched::UnitT cur, nxt; int ui = 0;
    if (!S.next(0, cur)) return;
    f32x4 acc[2][2][4][2];
#pragma unroll
    for (int a = 0; a < 2; ++a)
#pragma unroll
        for (int b = 0; b < 2; ++b)
#pragma unroll
            for (int m = 0; m < 4; ++m)
#pragma unroll
                for (int n = 0; n < 2; ++n) acc[a][b][m][n] = (f32x4){0.f, 0.f, 0.f, 0.f};
    bf16x8 At[4][2], B0[2][2], B1[2][2]; i32x8_ At8[4], B08[2], B18[2];
    unsigned coff[2][2], noff[2][2];
    PG8_GOFF(cur, coff);
    const char* cA = (const char*)A; const char* cB = (const char*)Bt + (size_t)cur.pn * tstep;
    PG8_STAGE(PG8_SB(0, 0), cB, voffB); PG8_STAGE(PG8_SB(0, 1), cB + hstep, voffB); PG8_STAGE(PG8_SA(0, 0), cA, coff[0]); PG8_STAGE(PG8_SA(0, 1), cA, coff[1]);
    if (wr == 1) PG8_BAR;
    PG8_WAIT_V(2); PG8_BAR;
    PG8_STAGE(PG8_SB(1, 0), cB + kstep, voffB); PG8_STAGE(PG8_SA(1, 0), cA + kstep, coff[0]); PG8_STAGE(PG8_SB(1, 1), cB + hstep + kstep, voffB);
    PG8_WAIT_V(6); PG8_BAR;
    for (;;) {
        const bool has_next = S.next(ui + 1, nxt);
        if (has_next) { PG8_GOFF(nxt, noff); } else {
#pragma unroll
            for (int h = 0; h < 2; ++h)
#pragma unroll
                for (int i = 0; i < 2; ++i) noff[h][i] = coff[h][i]; }
        const char* nB = has_next ? (const char*)Bt + (size_t)nxt.pn * tstep : cB;
        for (int t = 0; t < nt; t += 2) {
            const bool last = (t == nt - 2);
            const char* a1 = cA + (size_t)(t + 1) * kstep;
            const char* a2 = last ? cA : cA + (size_t)(t + 2) * kstep; const char* b2 = last ? nB : cB + (size_t)(t + 2) * kstep;
            const char* a3 = a2 + kstep; const char* b3 = b2 + kstep;
            PG8_LDB(B0, 0, 0); PG8_LDB(B1, 0, 1); PG8_SCHED; PG8_LDA(At, 0, 0); PG8_STAGE(PG8_SA(1, 1), a1, coff[1]);
            if (last) {
#pragma unroll
                for (int h = 0; h < 2; ++h)
#pragma unroll
                    for (int i = 0; i < 2; ++i) coff[h][i] = noff[h][i]; }
            PG8_WAIT_V(8); PG8_WAIT_L(0); PG8_BAR; PG8_MMA(0, 0, At, B0); PG8_MMA(0, 1, At, B1); PG8_BAR; PG8_SCHED;
            PG8_LDA(At, 0, 1); PG8_STAGE(PG8_SB(0, 0), b2, voffB); PG8_STAGE(PG8_SB(0, 1), b2 + hstep, voffB); PG8_STAGE(PG8_SA(0, 0), a2, coff[0]);
            PG8_WAIT_V(8); PG8_WAIT_L(0); PG8_BAR; PG8_MMA(1, 0, At, B0); PG8_MMA(1, 1, At, B1); PG8_BAR; PG8_SCHED;
            PG8_LDB(B0, 1, 0); PG8_LDB(B1, 1, 1); PG8_SCHED; PG8_LDA(At, 1, 0); PG8_STAGE(PG8_SA(0, 1), a2, coff[1]);
            PG8_WAIT_V(8); PG8_WAIT_L(0); PG8_BAR; PG8_MMA(0, 0, At, B0); PG8_MMA(0, 1, At, B1); PG8_BAR; PG8_SCHED;
            PG8_LDA(At, 1, 1); PG8_STAGE(PG8_SB(1, 0), b3, voffB); PG8_STAGE(PG8_SB(1, 1), b3 + hstep, voffB); PG8_STAGE(PG8_SA(1, 0), a3, coff[0]);
            PG8_WAIT_V(8); PG8_WAIT_L(0); PG8_BAR; PG8_MMA(1, 0, At, B0); PG8_MMA(1, 1, At, B1); PG8_BAR; PG8_SCHED;
        }
        if (wr == 0) PG8_BAR;
        E(acc, cur, wr, wc, fr, fq);
        if (!has_next) break;
#pragma unroll
        for (int a = 0; a < 2; ++a)
#pragma unroll
            for (int b = 0; b < 2; ++b)
#pragma unroll
                for (int m = 0; m < 4; ++m)
#pragma unroll
                    for (int n = 0; n < 2; ++n) acc[a][b][m][n] = (f32x4){0.f, 0.f, 0.f, 0.f};
        cur = nxt; cB = nB; ++ui;
        if (wr == 1) PG8_BAR;
    }
    PG8_WAIT_V(0);
    PG8_BAR;
#undef PG8_SA
#undef PG8_SB
#undef PG8_STAGE
#undef PG8_LDA
#undef PG8_LDB
#undef PG8_MMA
#undef PG8_WAIT_V
#undef PG8_WAIT_L
#undef PG8_BAR
#undef PG8_SCHED
#undef PG8_GOFF
}
}

#define PG8_SP2 true
#define PG8_ALIGN true

struct Args { const float* in[33]; float* out; unsigned char* ws; int ph_lo, ph_hi; };
enum { I_X = 0, I_C, I_POS, I_ADAW, I_ADAB, I_NMIX, I_NFFN, I_DA_WQKV, I_DA_QN, I_DA_KN, I_DA_LQ1, I_DA_LK1, I_DA_LQ2, I_DA_LK2,
       I_DA_SUBLN, I_DA_WO, I_M_WIN, I_M_QAN, I_M_KVAN, I_M_WUQ, I_M_WUKV, I_M_QNN, I_M_QPN, I_M_KNN, I_M_KPN, I_M_WO,
       I_E_WG, I_E_BG, I_E_WR, I_E_BR, I_E_W1, I_E_W3, I_E_W2 };

struct Ctx {
    const float* const* in; float* out; unsigned char* ws; unsigned char* lds;
    int tid, lane, wave, gw, ngw;
    __device__ __forceinline__ const float* mod(int layer, int b, int chunk) const { return (const float*)(ws + WS_MOD) + ((size_t)(layer * NB + b) * 6144 + chunk * 1024); }
};

__device__ __forceinline__ void normmod_row(const f32x4 (&v)[4], f32x4 (&h)[4], const float* g, const float* sh, const float* sc, int lane) {
    float s = 0.f;
#pragma unroll
    for (int j = 0; j < 4; ++j) s += (v[j].x * v[j].x + v[j].y * v[j].y) + (v[j].z * v[j].z + v[j].w * v[j].w);
    const float rstd = 1.0f / sqrtf(wave_sum(s) * (1.0f / D) + EPS);
#pragma unroll
    for (int j = 0; j < 4; ++j) {
        const f32x4 gg = *(const f32x4*)(g + 4 * lane + 256 * j), ss = *(const f32x4*)(sh + 4 * lane + 256 * j), cc = *(const f32x4*)(sc + 4 * lane + 256 * j);
        h[j] = (v[j] * rstd) * gg * (cc + 1.0f) + ss;
    }
}
__device__ __forceinline__ void store_row_bf16(bf16* row, const f32x4 (&h)[4], int lane) {
#pragma unroll
    for (int j = 0; j < 4; ++j) { u32x2 o; o.x = pk2(h[j].x, h[j].y); o.y = pk2(h[j].z, h[j].w); *(u32x2*)(row + 4 * lane + 256 * j) = o; }
}
__device__ __forceinline__ void load_row_fp8(const unsigned char* row, f32x4 (&h)[4], int lane) {
#pragma unroll
    for (int j = 0; j < 4; ++j) { const int w = *(const int*)(row + 4 * lane + 256 * j); const auto lo = __builtin_amdgcn_cvt_pk_f32_fp8(w, false), hi = __builtin_amdgcn_cvt_pk_f32_fp8(w, true);
        h[j] = (f32x4){lo[0], lo[1], hi[0], hi[1]} * 0.03125f; }
}
__device__ __forceinline__ void load_row_bf16(const bf16* row, f32x4 (&h)[4], int lane) {
#pragma unroll
    for (int j = 0; j < 4; ++j) { const u32x2 o = *(const u32x2*)(row + 4 * lane + 256 * j);
        h[j] = (f32x4){bf2f(o.x & 0xffffu), bf2f(o.x >> 16), bf2f(o.y & 0xffffu), bf2f(o.y >> 16)}; }
}


struct TItem { const float* src; bf16* dst; const float* kg; int ldw, K, perm, f8; };
__device__ __forceinline__ void titem_load(const TItem& t, f32x4 (&v)[8], int lane) {
    const float* p = t.src + (size_t)(lane >> 3) * t.ldw + 4 * (lane & 7);
#pragma unroll
    for (int i = 0; i < 8; ++i) v[i] = *(const f32x4*)(p + (size_t)(8 * i) * t.ldw);
}
__device__ __forceinline__ void titem_finish(const TItem& t, const f32x4 (&v)[8], float* scr, int lane) {
    const int rr = lane >> 3, c4 = lane & 7;
#pragma unroll
    for (int i = 0; i < 8; ++i) { f32x4 x = v[i]; if (t.kg) x = x * t.kg[8 * i + rr]; float* d = scr + (8 * i + rr) * 33 + 4 * c4; d[0] = x[0]; d[1] = x[1]; d[2] = x[2]; d[3] = x[3]; }
    asm volatile("s_waitcnt lgkmcnt(0)" ::: "memory");
    const int c = lane & 7;
#pragma unroll
    for (int j = 0; j < 4; ++j) { const int n = (lane >> 3) + 8 * j; const int nl = t.perm ? (16 * ((n >> 2) & 1) + 4 * (n >> 3) + (n & 3)) : n;
        const float* sp = scr + (8 * c) * 33 + nl;
        if (t.f8) { int p0 = __builtin_amdgcn_cvt_pk_fp8_f32(sp[0 * 33] * 32.0f, sp[1 * 33] * 32.0f, 0, false); p0 = __builtin_amdgcn_cvt_pk_fp8_f32(sp[2 * 33] * 32.0f, sp[3 * 33] * 32.0f, p0, true);
            int p1 = __builtin_amdgcn_cvt_pk_fp8_f32(sp[4 * 33] * 32.0f, sp[5 * 33] * 32.0f, 0, false); p1 = __builtin_amdgcn_cvt_pk_fp8_f32(sp[6 * 33] * 32.0f, sp[7 * 33] * 32.0f, p1, true);
            u32x2 o; o.x = (unsigned)p0; o.y = (unsigned)p1; *(u32x2*)((unsigned char*)t.dst + (size_t)n * t.K + 8 * c) = o; }
        else { u32x4 o; o.x = pk2(sp[0 * 33], sp[1 * 33]); o.y = pk2(sp[2 * 33], sp[3 * 33]); o.z = pk2(sp[4 * 33], sp[5 * 33]); o.w = pk2(sp[6 * 33], sp[7 * 33]);
            *(u32x4*)(t.dst + (size_t)n * t.K + 8 * c) = o; } }
    asm volatile("s_waitcnt lgkmcnt(0)" ::: "memory");
}
__device__ __forceinline__ TItem titem_make(const float* W, int ldw, int K, bf16* WT, int k0, int n0, int prow0, const float* kgain, bool perm) {
    TItem t; t.src = W + (size_t)k0 * ldw + n0; t.dst = WT + (size_t)prow0 * K + k0; t.kg = kgain ? kgain + k0 : nullptr; t.ldw = ldw; t.K = K; t.perm = perm ? 1 : 0; t.f8 = 0; return t;
}
constexpr int TI_QKV = 16 * 96, TI_O = 16 * 32, TI_WIN = 16 * 21, TI_UQ = 6 * 48, TI_UKV = 4 * 64, TI_DENSE = TI_QKV + 2 * TI_O + TI_WIN + TI_UQ + TI_UKV, TI_ALL = TI_DENSE + 24576;
__device__ __forceinline__ TItem titem_decode(const Ctx& C, int it) {
    int r = it;
    if (r < TI_QKV) { const int kb = r / 96, lb = r % 96; int pb = lb;
        if (lb < 64) { const int sect = lb >> 5, hm = (lb & 31) >> 1, half = lb & 1; pb = (sect * 4 + (hm >> 2)) * 8 + half * 4 + (hm & 3); }
        return titem_make(as_global(C.in[I_DA_WQKV]), 3072, 1024, (bf16*)(C.ws + WB_QKV), 64 * kb, 32 * lb, 32 * pb, nullptr, false); } r -= TI_QKV;
    if (r < TI_O) return titem_make(as_global(C.in[I_DA_WO]), 1024, 1024, (bf16*)(C.ws + WB_DAO), 64 * (r / 32), 32 * (r % 32), 32 * (r % 32), nullptr, false); r -= TI_O;
    if (r < TI_O) return titem_make(as_global(C.in[I_M_WO]), 1024, 1024, (bf16*)(C.ws + WB_MLO), 64 * (r / 32), 32 * (r % 32), 32 * (r % 32), nullptr, false); r -= TI_O;
    if (r < TI_WIN) { const int kb = r / 21, lb = r % 21; int pb = 18;
        if (lb < 20) { const int wsl = lb >> 1; pb = (wsl >> 2) * 8 + (lb & 1) * 4 + (wsl & 3); }
        return titem_make(as_global(C.in[I_M_WIN]), 672, 1024, (bf16*)(C.ws + WB_WIN), 64 * kb, 32 * lb, 32 * pb, nullptr, lb == 20); } r -= TI_WIN;
    if (r < TI_UQ) { const int kb = r / 48, lb = r % 48, h = lb / 3, part = lb % 3; int pb;
        if (part < 2) pb = (h >> 2) * 8 + part * 4 + (h & 3); else { const int sl = h >> 1; pb = (4 + (sl >> 2)) * 8 + (h & 1) * 4 + (sl & 3); }
        return titem_make(as_global(C.in[I_M_WUQ]), 1536, 384, (bf16*)(C.ws + WB_WUQ), 64 * kb, 32 * lb, 32 * pb, as_global(C.in[I_M_QAN]), part == 2); } r -= TI_UQ;
    if (r < TI_UKV) { const int kb = r / 64, lb = r % 64, h = lb >> 2, part = lb & 3; const int pb = (((part < 2) ? 0 : 4) + (h >> 2)) * 8 + (part & 1) * 4 + (h & 3);
        return titem_make(as_global(C.in[I_M_WUKV]), 2048, 256, (bf16*)(C.ws + WB_WUKV), 64 * kb, 32 * lb, 32 * pb, as_global(C.in[I_M_KVAN]), false); } r -= TI_UKV;
    if (r < 16384) { const int item = r & 63, mat = (r >> 6) & 1, t = (r >> 7) & 1, e = (r >> 8) & 31, l = r >> 13; const int kb = item >> 2, nb = item & 3;
        const float* W = as_global(C.in[mat ? I_E_W3 : I_E_W1]) + (size_t)(l * 32 + e) * 1024 * 256 + 128 * t;
        TItem ti = titem_make(W, 256, 1024, (bf16*)(C.ws + WB_MOE + (size_t)l * 48 * MiB), 64 * kb, 32 * nb, e * 512 + 256 * t + 128 * mat + 32 * nb, nullptr, false);
        ti.f8 = 1; ti.dst = (bf16*)((unsigned char*)(C.ws + WB_MOE + (size_t)l * 48 * MiB) + (size_t)(e * 512 + 256 * t + 128 * mat + 32 * nb) * 1024 + 64 * kb); return ti; }
    r -= 16384;
    { const int item = r & 127, e = (r >> 7) & 31, l = r >> 12; const int kb = item >> 5, nb = item & 31;
      const float* W = as_global(C.in[I_E_W2]) + (size_t)(l * 32 + e) * 256 * 1024;
      return titem_make(W, 1024, 256, (bf16*)(C.ws + WB_MOE + (size_t)l * 48 * MiB + 32 * MiB), 64 * kb, 32 * nb, e * 1024 + 32 * nb, nullptr, false); }
}
__device__ __forceinline__ void ph_prologue(const Ctx& C) {
    {
        float* sc = (float*)C.lds;
        float* red = sc + 16384;
        const float* c = as_global(C.in[I_C]); const float* adaw = as_global(C.in[I_ADAW]); const float* adab = as_global(C.in[I_ADAB]); float* mod = (float*)(C.ws + WS_MOD);
        for (int item = blockIdx.x; item < 384; item += gridDim.x) {
            const int layer = item / 192, r = item % 192, cc = r >> 1, bhf = r & 1;
            __syncthreads();
            for (int idx = C.tid; idx < 16384; idx += NTHR) { const float v = c[(size_t)(bhf * 16) * D + idx]; sc[(idx & 1023) * 16 + (idx >> 10)] = v / (1.0f + expf(-v)); }
            __syncthreads();
            const int col = C.tid & 63, ks = C.tid >> 6;
            f32x4 acc[4];
#pragma unroll
            for (int i = 0; i < 4; ++i) acc[i] = (f32x4){0.f, 0.f, 0.f, 0.f};
            const float* wp = adaw + ((size_t)layer * D + ks * 128) * 6144 + cc * 64 + col;
#pragma unroll 8
            for (int kk = 0; kk < 128; ++kk) {
                const float w = wp[(size_t)kk * 6144]; const float* sp = sc + (ks * 128 + kk) * 16;
#pragma unroll
                for (int i = 0; i < 4; ++i) acc[i] += *(const f32x4*)(sp + 4 * i) * w;
            }
#pragma unroll
            for (int i = 0; i < 16; ++i) red[(ks * 16 + i) * 64 + col] = acc[i >> 2][i & 3];
            __syncthreads();
            for (int o = C.tid; o < 1024; o += NTHR) { const int i = o >> 6, cl = o & 63; float sm = adab[layer * 6144 + cc * 64 + cl];
#pragma unroll
                for (int k2 = 0; k2 < 8; ++k2) sm += red[(k2 * 16 + i) * 64 + cl];
                mod[(size_t)(layer * NB + bhf * 16 + i) * 6144 + cc * 64 + cl] = sm; }
        }
        if (blockIdx.x == 0 && C.wave == 0) {
            const float a = wave_sum(as_global(C.in[I_DA_LQ1])[C.lane] * as_global(C.in[I_DA_LK1])[C.lane]);
            const float b = wave_sum(as_global(C.in[I_DA_LQ2])[C.lane] * as_global(C.in[I_DA_LK2])[C.lane]);
            if (C.lane == 0) *(float*)(C.ws + WS_LAM) = expf(a) - expf(b) + 0.2f;
        }
    }
    __syncthreads();
    {
        float* ivf = (float*)C.lds;
        if (C.tid < 32) ivf[C.tid] = powf(10000.0f, -(float)(2 * C.tid) / 64.0f); else if (C.tid < 48) ivf[C.tid] = powf(10000.0f, -(float)(2 * (C.tid - 32)) / 32.0f);
        __syncthreads();
        const int* pos = (const int*)as_global(C.in[I_POS]);
        float* cosD = (float*)(C.ws + WS_COSD); float* sinD = (float*)(C.ws + WS_SIND); float* cosM = (float*)(C.ws + WS_COSM); float* sinM = (float*)(C.ws + WS_SINM);
        const int gt = blockIdx.x * NTHR + C.tid, ngt = gridDim.x * NTHR;
        for (int idx = gt; idx < NTOK * 32; idx += ngt) {
            const float ang = (float)pos[idx >> 5] * ivf[idx & 31]; float rev = ang * 0.15915494309189535f; rev -= floorf(rev);
            cosD[idx] = __builtin_amdgcn_cosf(rev); sinD[idx] = __builtin_amdgcn_sinf(rev);
        }
        for (int idx = gt; idx < NTOK * 16; idx += ngt) {
            const float ang = (float)pos[idx >> 4] * ivf[32 + (idx & 15)]; float rev = ang * 0.15915494309189535f; rev -= floorf(rev);
            cosM[idx] = __builtin_amdgcn_cosf(rev); sinM[idx] = __builtin_amdgcn_sinf(rev);
        }
        float* wrt = (float*)(C.ws + WS_WRT); const float* wr = as_global(C.in[I_E_WR]);
        for (int idx = gt; idx < 2 * 32 * 1024; idx += ngt) { const int l = idx >> 15, e = (idx >> 10) & 31, k = idx & 1023; wrt[idx] = wr[((size_t)l * 1024 + k) * 32 + e]; }
        for (int idx = gt; idx < 96 * 1024 / 8; idx += ngt) { const int blk = idx / 4096, rem = idx % 4096; const int pb = (blk == 0) ? 19 : 21 + blk;
            *(u32x4*)((bf16*)(C.ws + WB_WIN) + (size_t)pb * 32 * 1024 + (size_t)rem * 8) = (u32x4){0u, 0u, 0u, 0u}; }
    }
    __syncthreads();
    {
        float* scr = (float*)(C.lds + C.wave * 16384);
        f32x4 va[8], vb[8];
#pragma unroll 1
        for (int it = C.gw; it < TI_ALL; it += 2 * C.ngw) {
            const bool hasb = it + C.ngw < TI_ALL;
            const TItem ta = titem_decode(C, it), tb = titem_decode(C, hasb ? it + C.ngw : it);
            titem_load(ta, va, C.lane); if (hasb) titem_load(tb, vb, C.lane);
            titem_finish(ta, va, scr, C.lane); if (hasb) titem_finish(tb, vb, scr, C.lane);
        }
    }
}
__device__ __forceinline__ void ph_normmod0(const Ctx& C) {
    const float* x = as_global(C.in[I_X]); bf16* H = (bf16*)(C.ws + WS_H);
    for (int tok = C.gw; tok < NTOK; tok += C.ngw) {
        const int b = tok / SEQ; f32x4 v[4], h[4];
#pragma unroll
        for (int j = 0; j < 4; ++j) v[j] = *(const f32x4*)(x + (size_t)tok * D + 4 * C.lane + 256 * j);
        normmod_row(v, h, as_global(C.in[I_NMIX]), C.mod(0, b, 0), C.mod(0, b, 1), C.lane);
        store_row_bf16(H + (size_t)tok * D, h, C.lane);
    }
}
template <bool FINAL>
__device__ __forceinline__ void ph_comb(const Ctx& C, const unsigned char* y2, const float* gate_chunk_base  , int nlayer, const float* gnorm) {
    bf16* H = (bf16*)(C.ws + WS_H); const int lane = C.lane;
    for (int chunk = blockIdx.x; chunk < NTOK / 256; chunk += gridDim.x) {
        for (int i = 0; i < 32; ++i) {
            const int tok = chunk * 256 + C.wave * 32 + i, b = tok / SEQ;
            f32x4 v[4], a[4], a2[4];
            load_row_bf16((const bf16*)(C.ws + WS_XB) + (size_t)tok * D, v, lane);
            const float* gate = gate_chunk_base + (size_t)b * 6144;
            load_row_fp8(y2 + (size_t)(2 * tok) * D, a, lane); load_row_fp8(y2 + (size_t)(2 * tok + 1) * D, a2, lane);
#pragma unroll
            for (int j = 0; j < 4; ++j) { const f32x4 gg = *(const f32x4*)(gate + 4 * lane + 256 * j); v[j] += gg * (a[j] + a2[j]);
                if (FINAL) *(f32x4*)(as_global(C.out) + (size_t)tok * D + 4 * lane + 256 * j) = v[j]; }
            if (FINAL) continue;
            store_row_bf16((bf16*)(C.ws + WS_XB) + (size_t)tok * D, v, lane);
            f32x4 h[4];
            normmod_row(v, h, gnorm, C.mod(nlayer, b, 0), C.mod(nlayer, b, 1), lane);
            store_row_bf16(H + (size_t)tok * D, h, lane);
        }
    }
}

constexpr int MOE_TAB_OFF = 131072 + 512;
__device__ __forceinline__ void moe_prefix256(const Ctx& C, int moe_layer, int* cntl, int* tpre) {
    const unsigned* cnt = (const unsigned*)(C.ws + WS_CTL) + CW_CNT + moe_layer * 32 * 64;
    __syncthreads();
    if (C.tid < 32) cntl[C.tid] = (int)__hip_atomic_load(cnt + C.tid * 64, __ATOMIC_RELAXED, __HIP_MEMORY_SCOPE_AGENT);
    __syncthreads();
    if (C.tid == 0) { int s = 0; for (int e = 0; e < 32; ++e) { tpre[e] = s; s += (cntl[e] + 255) >> 8; } tpre[32] = s; }
    __syncthreads();
    if (C.tid < 32) { for (int rt = tpre[C.tid]; rt < tpre[C.tid + 1]; ++rt) tpre[33 + rt] = C.tid; }
    __syncthreads();
}
__device__ __forceinline__ void ph_moe1_mfma(const Ctx& C, int moe_layer) {
    int* cntl = (int*)(C.lds + MOE_TAB_OFF); int* tpre = cntl + 32;
    moe_prefix256(C, moe_layer, cntl, tpre);
    pg8::MoeOrder S{tpre, 2, (int)gridDim.x, (int)blockIdx.x, tpre[32] * 2};
    pg8::EpiMoe1 E{(bf16*)(C.ws + WS_A), (const int*)(C.ws + WS_LIST), (const float*)(C.ws + WS_LISTW), cntl, NTOK};
    int K1 = 1024; asm volatile("" : "+s"(K1));
    pg8::gemm_phase_gather<pg8::EpiMoe1, pg8::MoeOrder, true>((PG8_LAS unsigned char*)C.lds, (const bf16*)(C.ws + WS_H), (const bf16*)(C.ws + WB_MOE + (size_t)moe_layer * 48 * MiB), K1,
                                                        (const int*)(C.ws + WS_LIST), NTOK, cntl, S, E);
}
__device__ __forceinline__ void ph_moe2_mfma(const Ctx& C, int moe_layer) {
    int* cntl = (int*)(C.lds + MOE_TAB_OFF); int* tpre = cntl + 32;
    moe_prefix256(C, moe_layer, cntl, tpre);
    pg8::MoeOrder S{tpre, 4, (int)gridDim.x, (int)blockIdx.x, tpre[32] * 4};
    pg8::EpiMoe2 E{(unsigned char*)(C.ws + WS_A + 128 * MiB), (const int*)(C.ws + WS_LIST), cntl, NTOK};
    int K2 = 256; asm volatile("" : "+s"(K2));
    pg8::Gemm g{(const bf16*)(C.ws + WS_A), (const bf16*)(C.ws + WB_MOE + (size_t)moe_layer * 48 * MiB + 32 * MiB), 0, 0, K2};
    pg8::gemm_phase<pg8::EpiMoe2, pg8::MoeOrder, PG8_ALIGN, PG8_SP2>((PG8_LAS unsigned char*)C.lds, g, S, E);
}

namespace fa {
typedef short bf16x8 __attribute__((ext_vector_type(8)));
typedef short s16x4 __attribute__((ext_vector_type(4)));
typedef float f32x16 __attribute__((ext_vector_type(16)));
typedef __attribute__((address_space(3))) const char* lds_cptr;
__device__ __forceinline__ int crow(int r, int hi) { return (r & 3) + 8 * (r >> 2) + 4 * hi; }
__device__ __forceinline__ s16x4 vtr(lds_cptr p) { return __builtin_bit_cast(s16x4, __builtin_amdgcn_ds_read_tr16_b64_v4i16((__attribute__((address_space(3))) s16x4*)p)); }
typedef float f32x2_t __attribute__((ext_vector_type(2))); typedef __bf16 bf16x2_t __attribute__((ext_vector_type(2)));
__device__ __forceinline__ unsigned cvtpk(float lo, float hi) { f32x2_t v = {lo, hi}; bf16x2_t b = __builtin_convertvector(v, bf16x2_t); return __builtin_bit_cast(unsigned, b); }
__device__ __forceinline__ float half_swap_max(float v) { auto rr = __builtin_amdgcn_permlane32_swap(__float_as_uint(v), __float_as_uint(v), false, false); return fmaxf(__uint_as_float(rr[0]), __uint_as_float(rr[1])); }
__device__ __forceinline__ float half_swap_sum(float v) { auto rr = __builtin_amdgcn_permlane32_swap(__float_as_uint(v), __float_as_uint(v), false, false); return __uint_as_float(rr[0]) + __uint_as_float(rr[1]); }
__device__ __forceinline__ void dma16(const void* gsrc, LAS unsigned char* ldsdst) { unsigned keep; const unsigned dst = (unsigned)__builtin_amdgcn_readfirstlane((int)(unsigned)(uintptr_t)ldsdst);
    asm volatile("s_mov_b32 %0, m0\n\ts_mov_b32 m0, %2\n\ts_nop 0\n\tglobal_load_lds_dwordx4 %1, off\n\ts_mov_b32 m0, %0" : "=&s"(keep) : "v"(gsrc), "s"(dst) : "memory"); }
__device__ __forceinline__ void dma16s(const void* sbase_, unsigned voff, LAS unsigned char* ldsdst) { unsigned keep; const unsigned dst = (unsigned)__builtin_amdgcn_readfirstlane((int)(unsigned)(uintptr_t)ldsdst);
    const unsigned long long sb_ = (unsigned long long)(uintptr_t)sbase_; const unsigned lo_ = (unsigned)__builtin_amdgcn_readfirstlane((int)(unsigned)sb_), hi_ = (unsigned)__builtin_amdgcn_readfirstlane((int)(unsigned)(sb_ >> 32));
    const void* sbase = (const void*)(uintptr_t)(((unsigned long long)hi_ << 32) | lo_);
    asm volatile("s_mov_b32 %0, m0\n\ts_mov_b32 m0, %3\n\ts_nop 0\n\tglobal_load_lds_dwordx4 %1, %2\n\ts_mov_b32 m0, %0" : "=&s"(keep) : "v"(voff), "s"(sbase), "s"(dst) : "memory"); }

template <int ND0, int NDB>
__device__ __forceinline__ void tile(lds_cptr Kslot, lds_cptr Vslot, const bf16x8 (&qf)[ND0], f32x16 (&o)[NDB], f32x16& negm, float& m, float& l,
                                     LAS float* wsf, bool first, bool diag, int qloc, int lane) {
    const int r32 = lane & 31, hi = lane >> 5;
    lds_cptr kb = Kslot + hi * 1024 + r32 * 16;
    bf16x8 kf0[ND0], kf1[ND0];
#pragma unroll
    for (int d0 = 0; d0 < ND0; ++d0) {
        kf0[d0] = *(const __attribute__((address_space(3))) bf16x8*)(kb + d0 * 2048);
        kf1[d0] = *(const __attribute__((address_space(3))) bf16x8*)(kb + d0 * 2048 + 512);
    }
#pragma unroll
    for (int d0 = 0; d0 < ND0; ++d0) asm volatile("" : "+v"(kf0[d0]), "+v"(kf1[d0]));
    f32x16 p0 = __builtin_amdgcn_mfma_f32_32x32x16_bf16(kf0[0], qf[0], negm, 0, 0, 0);
    f32x16 p1 = __builtin_amdgcn_mfma_f32_32x32x16_bf16(kf1[0], qf[0], negm, 0, 0, 0);
#pragma unroll
    for (int d0 = 1; d0 < ND0; ++d0) {
        p0 = __builtin_amdgcn_mfma_f32_32x32x16_bf16(kf0[d0], qf[d0], p0, 0, 0, 0);
        p1 = __builtin_amdgcn_mfma_f32_32x32x16_bf16(kf1[d0], qf[d0], p1, 0, 0, 0);
    }
    __builtin_amdgcn_sched_barrier(0);
    lds_cptr vp = Vslot + ((lane >> 4) & 1) * 32 + (lane & 3) * 8 + (4 * hi + ((lane & 15) >> 2)) * 64;
    constexpr int NE = (NDB < 2 ? NDB : 2) * 4;
    s16x4 vlo[NDB * 4], vhi[NDB * 4];
#pragma unroll
    for (int i = 0; i < NE; ++i) { vlo[i] = vtr(vp + (i >> 2) * 4096 + (i & 3) * 1024); vhi[i] = vtr(vp + (i >> 2) * 4096 + (i & 3) * 1024 + 512); }
    __builtin_amdgcn_sched_barrier(0);
    if (diag) {
#pragma unroll
        for (int r = 0; r < 16; ++r) { const int kv = crow(r, hi); if (kv > qloc) p0[r] = -1e30f; if (kv + 32 > qloc) p1[r] = -1e30f; }
    }
    float mx = fmaxf(fmaxf(p0[0], p1[0]), p0[1]);
#pragma unroll
    for (int r = 1; r < 16; ++r) { if (r > 1) mx = fmaxf(fmaxf(mx, p0[r]), p1[r]); else mx = fmaxf(mx, p1[r]); }
    mx = half_swap_max(mx);
    const bool need = first || (__builtin_amdgcn_ballot_w64(mx > 8.0f) != 0ull);
    if (need) {
        const float dl = first ? mx : fmaxf(mx, 0.f);
        m += dl;
#pragma unroll
        for (int r = 0; r < 16; ++r) { p0[r] -= dl; p1[r] -= dl; negm[r] = -m; }
        if (!first) {
            const float al = __builtin_amdgcn_exp2f(-dl); l *= al;
            if (hi == 0) wsf[r32] = al;
            asm volatile("s_waitcnt lgkmcnt(0)" ::: "memory");
            f32x4 a4[4];
#pragma unroll
            for (int g = 0; g < 4; ++g) a4[g] = *(const LAS f32x4*)(wsf + 8 * g + 4 * hi);
#pragma unroll
            for (int db = 0; db < NDB; ++db)
#pragma unroll
                for (int r = 0; r < 16; ++r) o[db][r] *= a4[r >> 2][r & 3];
        }
    }
    float sum = 0.f;
#pragma unroll
    for (int ks = 0; ks < 4; ++ks) {
        float e[8];
#pragma unroll
        for (int j = 0; j < 8; ++j) { const float x = (ks < 2) ? p0[8 * ks + j] : p1[8 * (ks - 2) + j]; e[j] = __builtin_amdgcn_exp2f(x); }
        sum += ((e[0] + e[1]) + (e[2] + e[3])) + ((e[4] + e[5]) + (e[6] + e[7]));
        u32x4 w; w.x = cvtpk(e[0], e[1]); w.y = cvtpk(e[2], e[3]); w.z = cvtpk(e[4], e[5]); w.w = cvtpk(e[6], e[7]);
        const bf16x8 pa = __builtin_bit_cast(bf16x8, w);
        if (ks == 0 && NE < NDB * 4) {
#pragma unroll
            for (int i = NE; i < NDB * 4; ++i) { vlo[i] = vtr(vp + (i >> 2) * 4096 + (i & 3) * 1024); vhi[i] = vtr(vp + (i >> 2) * 4096 + (i & 3) * 1024 + 512); }
        }
        __builtin_amdgcn_s_setprio(1);
#pragma unroll
        for (int db = 0; db < NDB; ++db) {
            const s16x4 lo = vlo[db * 4 + ks], hh = vhi[db * 4 + ks];
            const bf16x8 vf = (bf16x8){lo[0], lo[1], lo[2], lo[3], hh[0], hh[1], hh[2], hh[3]};
            o[db] = __builtin_amdgcn_mfma_f32_32x32x16_bf16(pa, vf, o[db], 0, 0, 0);
        }
        __builtin_amdgcn_s_setprio(0);
    }
    l += sum;
}
}


__device__ __forceinline__ void ph_route(const Ctx& C, int layer) {
    typedef float f32x16 __attribute__((ext_vector_type(16)));
    LAS float* hT = (LAS float*)C.lds + C.wave * (32 * 68);
    LAS float* rsl = (LAS float*)C.lds + 8 * 32 * 68 + C.wave * 32;
    int* le0 = (int*)(C.lds + 73728); int* le1 = le0 + 256; int* hist = le1 + 256; int* base = hist + 32; float* lw0 = (float*)(base + 32); float* lw1 = lw0 + 256;
    const bf16* x1 = (const bf16*)(C.ws + WS_XB); unsigned char* H8 = C.ws + WS_H; float* listw = (float*)(C.ws + WS_LISTW); int* list = (int*)(C.ws + WS_LIST);
    unsigned* cnt = (unsigned*)(C.ws + WS_CTL) + CW_CNT + layer * 32 * 64;
    const float* ssqx = (const float*)(C.ws + WS_SSQX);
    const float* gn = as_global(C.in[I_NFFN]) + layer * D;
    const float* WrT = (const float*)(C.ws + WS_WRT) + (size_t)layer * 32 * 1024; const float* wg = as_global(C.in[I_E_WG]) + (size_t)layer * D * 4;
    const float* bg = as_global(C.in[I_E_BG]) + layer * 4; const float* br = as_global(C.in[I_E_BR]) + layer * 32;
    const int lane = C.lane, r32 = lane & 31, hi = lane >> 5, w = C.wave, kq = lane & 15, tsub = lane >> 4;
    LAS float* wgl = (LAS float*)(C.lds + 81920);
    __syncthreads();
    for (int idx = C.tid; idx < 1024; idx += NTHR) *(LAS f32x4*)(wgl + idx * 4) = *(const f32x4*)(wg + (size_t)idx * 4);
    for (int chunk = blockIdx.x; chunk < NTOK / 256; chunk += gridDim.x) {
        __syncthreads();
        if (C.tid < 32) hist[C.tid] = 0;
        const int tok0 = chunk * 256 + w * 32, b = tok0 >> 11;
        const float* shp = C.mod(layer, b, 3); const float* scp = C.mod(layer, b, 4);
        { const float* sp = ssqx + (size_t)(tok0 + r32) * 16; const f32x4 s0 = *(const f32x4*)sp, s1 = *(const f32x4*)(sp + 4), s2 = *(const f32x4*)(sp + 8), s3 = *(const f32x4*)(sp + 12);
          const float sm = ((s0[0] + s0[1]) + (s0[2] + s0[3])) + ((s1[0] + s1[1]) + (s1[2] + s1[3])) + ((s2[0] + s2[1]) + (s2[2] + s2[3])) + ((s3[0] + s3[1]) + (s3[2] + s3[3]));
          if (hi == 0) rsl[r32] = 1.0f / sqrtf(sm * (1.0f / D) + EPS); }
        f32x16 acc;
#pragma unroll
        for (int r = 0; r < 16; ++r) acc[r] = 0.f;
        float gl[4] = {0.f, 0.f, 0.f, 0.f};
        const unsigned xoff = (unsigned)(tok0 + tsub) * 1024u + 4u * kq;
        const unsigned woff = (unsigned)r32 * 1024u + 4u * hi;
        f32x4 X[8], Wa[8], Wb[8];
#define RT_LOADX(kc_) do { _Pragma("unroll") for (int i = 0; i < 8; ++i) { const u32x2 w_ = *(const u32x2*)(x1 + (xoff + 4096u * i + 64u * (kc_))); \
            X[i] = (f32x4){__uint_as_float(w_.x << 16), __uint_as_float(w_.x & 0xffff0000u), __uint_as_float(w_.y << 16), __uint_as_float(w_.y & 0xffff0000u)}; } } while (0)
#define RT_LOADW(W, kc_) do { _Pragma("unroll") for (int c = 0; c < 8; ++c) W[c] = *(const f32x4*)(WrT + (woff + 64u * (kc_) + 8u * c)); } while (0)
#define RT_STEP(W, WN, kc_) do { const unsigned k4 = 64u * (kc_) + 4u * kq; \
            const f32x4 g4 = *(const f32x4*)(gn + k4), sc4 = *(const f32x4*)(scp + k4), sh4 = *(const f32x4*)(shp + k4); const f32x4 gm4 = g4 * (sc4 + 1.0f); \
            _Pragma("unroll") for (int i = 0; i < 8; ++i) { const int tl = 4 * i + tsub; const float rsd = rsl[tl]; const f32x4 h4 = (X[i] * rsd) * gm4 + sh4; \
                int o8 = __builtin_amdgcn_cvt_pk_fp8_f32(h4[0], h4[1], 0, false); o8 = __builtin_amdgcn_cvt_pk_fp8_f32(h4[2], h4[3], o8, true); *(int*)(H8 + (xoff + 4096u * i + 64u * (kc_))) = o8; *(LAS f32x4*)(hT + tl * 68 + 4 * kq) = h4; } \
            if ((kc_) + 1 < 16) { RT_LOADX((kc_) + 1); RT_LOADW(WN, (kc_) + 1); } \
            _Pragma("unroll") for (int c = 0; c < 8; ++c) { const f32x4 b4 = *(const LAS f32x4*)(hT + r32 * 68 + 8 * c + 4 * hi); \
                _Pragma("unroll") for (int j = 0; j < 4; ++j) { acc = __builtin_amdgcn_mfma_f32_32x32x2f32(W[c][j], b4[j], acc, 0, 0, 0); \
                    const f32x4 w4 = *(const LAS f32x4*)(wgl + (64 * (kc_) + 8 * c + 4 * hi + j) * 4); \
                    _Pragma("unroll") for (int q = 0; q < 4; ++q) gl[q] += b4[j] * w4[q]; } asm volatile("" : "+v"(gl[0]), "+v"(gl[1]), "+v"(gl[2]), "+v"(gl[3])); } } while (0)
        RT_LOADX(0); RT_LOADW(Wa, 0);
#pragma unroll 1
        for (int kc = 0; kc < 16; kc += 2) {
            RT_STEP(Wa, Wb, kc);
            RT_STEP(Wb, Wa, kc + 1);
        }
#undef RT_LOADX
#undef RT_LOADW
#undef RT_STEP
#pragma unroll
        for (int q = 0; q < 4; ++q) gl[q] = fa::half_swap_sum(gl[q]);
        float gp[4]; { const float gm = fmaxf(fmaxf(gl[0], gl[1]), fmaxf(gl[2], gl[3])); float gs = 0.f;
#pragma unroll
            for (int g = 0; g < 4; ++g) { gp[g] = expf(gl[g] - gm); gs += gp[g]; }
#pragma unroll
            for (int g = 0; g < 4; ++g) gp[g] /= gs; }
        int gi = 0; float best = -1e30f, gate = 0.f;
#pragma unroll
        for (int g = 0; g < 4; ++g) { const float sv = gp[g] + bg[g]; if (sv > best) { best = sv; gi = g; gate = gp[g]; } }
        float el[8];
#pragma unroll
        for (int j = 0; j < 4; ++j) { const float own = (gi == 0) ? acc[j] : (gi == 1) ? acc[4 + j] : (gi == 2) ? acc[8 + j] : acc[12 + j];
            auto rr = __builtin_amdgcn_permlane32_swap(__float_as_uint(own), __float_as_uint(own), false, false);
            el[j] = __uint_as_float(rr[0]); el[4 + j] = __uint_as_float(rr[1]); }
        float em = el[0];
#pragma unroll
        for (int e = 1; e < 8; ++e) em = fmaxf(em, el[e]);
        float ep[8], es = 0.f;
#pragma unroll
        for (int e = 0; e < 8; ++e) { ep[e] = expf(el[e] - em); es += ep[e]; }
        int i0 = 0; float b0 = -1e30f, p0 = 0.f;
#pragma unroll
        for (int e = 0; e < 8; ++e) { ep[e] /= es; const float sv = ep[e] + br[gi * 8 + e]; if (sv > b0) { b0 = sv; i0 = e; p0 = ep[e]; } }
        int i1 = 0; float b1 = -1e30f, p1 = 0.f;
#pragma unroll
        for (int e = 0; e < 8; ++e) { const float sv = ep[e] + br[gi * 8 + e]; if (e != i0 && sv > b1) { b1 = sv; i1 = e; p1 = ep[e]; } }
        const float den = p0 + p1;
        if (hi == 0) { const int tl = w * 32 + r32; le0[tl] = gi * 8 + i0; le1[tl] = gi * 8 + i1; lw0[tl] = p0 / den * gate; lw1[tl] = p1 / den * gate; }
        __syncthreads();
        int e0 = 0, e1 = 0, q0 = 0, q1 = 0;
        if (C.tid < 256) { e0 = le0[C.tid]; e1 = le1[C.tid]; q0 = atomicAdd(&hist[e0], 1); q1 = atomicAdd(&hist[e1], 1); }
        __syncthreads();
        if (C.tid < 32) base[C.tid] = (int)__hip_atomic_fetch_add(cnt + C.tid * 64, (unsigned)hist[C.tid], __ATOMIC_RELAXED, __HIP_MEMORY_SCOPE_AGENT);
        __syncthreads();
        if (C.tid < 256) { const int tok = chunk * 256 + C.tid;
            const size_t i0_ = (size_t)e0 * NTOK + base[e0] + q0, i1_ = (size_t)e1 * NTOK + base[e1] + q1;
            list[i0_] = 2 * tok; list[i1_] = 2 * tok + 1; listw[i0_] = lw0[C.tid]; listw[i1_] = lw1[C.tid]; }
    }
}

__device__ __forceinline__ void ph_attn_da_mfma(const Ctx& C) {
    using namespace fa;
    LAS unsigned char* L = (LAS unsigned char*)C.lds;
    constexpr int STG = 32768;
    LAS float* wsf = (LAS float*)(L + 3 * STG) + C.wave * 32;
    const int vcu = ((int)blockIdx.x & 7) * 32 + ((int)blockIdx.x >> 3), xcd = vcu >> 5, grp = (vcu >> 4) & 1, jj = vcu & 15;
    const bf16* Q = (const bf16*)(C.ws + WS_A); const bf16* Kb = Q + (size_t)NTOK * D; const bf16* Vb = Kb + (size_t)NTOK * D; bf16* O = (bf16*)(C.ws + WS_O);
    const float lam = *(const float*)(C.ws + WS_LAM);
    const int lane = C.lane, w = C.wave, c = w >> 2, wq = w & 3, r32 = lane & 31, hi = lane >> 5;
    const float c2 = 0.125f * 1.4426950408889634f;
    for (int u = 0; u < 16; ++u) {
        const int bh = xcd * 32 + 2 * u + grp, b = bh >> 3, h = bh & 7, qb = (u & 1) ? 15 - jj : jj, q0 = qb * 128;
        const size_t rowb = (size_t)b * SEQ;
        const int NT = (q0 + 128) / 64, qw0 = q0 + 32 * wq, T = qw0 >> 6;
        const bf16* sbase = (w < 4 ? Kb : Vb) + rowb * D;
        unsigned soff[4]; int dsto[4];
#pragma unroll
        for (int i = 0; i < 4; ++i) {
            if (w < 4) { const int cm = w >> 1, ch = (w & 1) * 4 + i; soff[i] = (unsigned)((lane * D + (2 * h + cm) * 64 + ch * 8) * 2); dsto[i] = cm * 8192 + ch * 1024; }
            else { const int db = w - 4, rg = i; soff[i] = (unsigned)(((rg * 16 + (lane >> 2)) * D + h * 128 + db * 32 + (lane & 3) * 8) * 2); dsto[i] = 16384 + db * 4096 + rg * 1024; }
        }
        bf16x8 qf[4];
#pragma unroll
        for (int d0 = 0; d0 < 4; ++d0) qf[d0] = *(const bf16x8*)(Q + (rowb + qw0 + r32) * D + (2 * h + c) * 64 + d0 * 16 + hi * 8);
#pragma unroll
        for (int d0 = 0; d0 < 4; ++d0) asm volatile("" : "+v"(qf[d0]));
        f32x16 o[4];
#pragma unroll
        for (int db = 0; db < 4; ++db)
#pragma unroll
            for (int r = 0; r < 16; ++r) o[db][r] = 0.f;
        float m = 0.f, l = 0.f; f32x16 negm;
#pragma unroll
        for (int r = 0; r < 16; ++r) negm[r] = 0.f;
        asm volatile("s_waitcnt lgkmcnt(0)" ::: "memory"); __builtin_amdgcn_s_barrier();
#pragma unroll
        for (int i = 0; i < 4; ++i) dma16s(sbase, soff[i], L + dsto[i]);
#pragma unroll
        for (int i = 0; i < 4; ++i) dma16s(sbase + (size_t)64 * D, soff[i], L + STG + dsto[i]);
        int sc_ = 0, sn_ = 2;
        for (int t = 0; t < NT; ++t) {
            if (t + 1 < NT) asm volatile("s_waitcnt vmcnt(4) lgkmcnt(0)" ::: "memory"); else asm volatile("s_waitcnt vmcnt(0) lgkmcnt(0)" ::: "memory");
            __builtin_amdgcn_s_barrier();
            if (t + 2 < NT) {
#pragma unroll
                for (int i = 0; i < 4; ++i) dma16s(sbase + (size_t)(t + 2) * 64 * D, soff[i], L + sn_ * STG + dsto[i]);
            }
            if (t <= T) {
                lds_cptr stg = (lds_cptr)L + sc_ * STG;
                tile<4, 4>(stg + c * 8192, stg + 16384, qf, o, negm, m, l, wsf, t == 0, t == T, qw0 - 64 * T + r32, lane);
            }
            sc_ = (sc_ == 2) ? 0 : sc_ + 1; sn_ = (sn_ == 2) ? 0 : sn_ + 1;
        }
        l = half_swap_sum(l);
        if (hi == 0) wsf[r32] = 1.0f / l;
        asm volatile("s_waitcnt lgkmcnt(0)" ::: "memory");
        f32x4 a4[4];
#pragma unroll
        for (int g = 0; g < 4; ++g) a4[g] = *(const LAS f32x4*)(wsf + 8 * g + 4 * hi);
#pragma unroll
        for (int db = 0; db < 4; ++db)
#pragma unroll
            for (int r = 0; r < 16; ++r) o[db][r] *= a4[r >> 2][r & 3];
        asm volatile("s_waitcnt lgkmcnt(0)" ::: "memory"); __builtin_amdgcn_s_barrier();
        LAS float* X = (LAS float*)L + wq * 4096;
        if (c == 1) {
#pragma unroll
            for (int db = 0; db < 4; ++db)
#pragma unroll
                for (int r = 0; r < 16; ++r) X[(db * 16 + r) * 64 + lane] = o[db][r];
        }
        asm volatile("s_waitcnt lgkmcnt(0)" ::: "memory"); __builtin_amdgcn_s_barrier();
        if (c == 0) {
            float gsub[4];
#pragma unroll
            for (int db = 0; db < 4; ++db) gsub[db] = as_global(C.in[I_DA_SUBLN])[db * 32 + r32] * 0.8f;
#pragma unroll
            for (int r = 0; r < 16; ++r) {
                float v[4], ss = 0.f;
#pragma unroll
                for (int db = 0; db < 4; ++db) { v[db] = o[db][r] - lam * X[(db * 16 + r) * 64 + lane]; ss += v[db] * v[db]; }
#pragma unroll
                for (int off = 1; off < 32; off <<= 1) ss += __shfl_xor(ss, off);
                const float rstd = 1.0f / sqrtf(ss * (1.0f / 128.0f) + EPS);
                bf16* orow = O + (rowb + qw0 + crow(r, hi)) * D + h * 128 + r32;
#pragma unroll
                for (int db = 0; db < 4; ++db) orow[db * 32] = (bf16)f2bf(v[db] * rstd * gsub[db]);
            }
        }
    }
}
__device__ __forceinline__ void ph_attn_mla_mfma(const Ctx& C) {
    using namespace fa;
    LAS unsigned char* L = (LAS unsigned char*)C.lds;
    constexpr int STG = 20480;
    LAS float* wsf = (LAS float*)(L + 3 * STG) + C.wave * 32;
    const int vcu = ((int)blockIdx.x & 7) * 32 + ((int)blockIdx.x >> 3), xcd = vcu >> 5, grp = (vcu >> 3) & 3, jj = vcu & 7;
    const bf16* Q2 = (const bf16*)(C.ws + WS_A); const bf16* KV2 = (const bf16*)(C.ws + WS_A + 192 * MiB);
    const bf16* KPE = (const bf16*)(C.ws + WS_KPE); bf16* O = (bf16*)(C.ws + WS_O);
    const int lane = C.lane, w = C.wave, r32 = lane & 31, hi = lane >> 5;
    const float c2 = 0.10206207261596575f * 1.4426950408889634f;
    for (int u = 0; u < 16; ++u) {
        const int bh = xcd * 64 + 4 * u + grp, b = bh >> 4, h = bh & 15, qb = (u & 1) ? 7 - jj : jj, q0 = qb * 256;
        const size_t rowb = (size_t)b * SEQ;
        const int NT = (q0 + 256) / 64, qw0 = q0 + 32 * w, T = qw0 >> 6;
        const bf16* src[3]; int dsto[3]; size_t sstep[3];
#pragma unroll
        for (int i = 0; i < 3; ++i) {
            const int pi = w + 8 * i;
            if (pi < 8) { src[i] = KV2 + (rowb + lane) * 2048 + h * 128 + pi * 8; dsto[i] = pi * 1024; sstep[i] = (size_t)64 * 2048; }
            else if (pi < 12) { src[i] = KPE + (rowb + lane) * 32 + (pi - 8) * 8; dsto[i] = pi * 1024; sstep[i] = (size_t)64 * 32; }
            else { const int db = (pi - 12) >> 2, rg = (pi - 12) & 3; src[i] = KV2 + (rowb + rg * 16 + (lane >> 2)) * 2048 + h * 128 + 64 + db * 32 + (lane & 3) * 8; dsto[i] = 12288 + db * 4096 + rg * 1024; sstep[i] = (size_t)64 * 2048; }
        }
        const bool has3 = (w + 16) < 20;
        bf16x8 qf[6];
#pragma unroll
        for (int d0 = 0; d0 < 6; ++d0) qf[d0] = *(const bf16x8*)(Q2 + (rowb + qw0 + r32) * 1536 + h * 96 + d0 * 16 + hi * 8);
#pragma unroll
        for (int d0 = 0; d0 < 6; ++d0) asm volatile("" : "+v"(qf[d0]));
        f32x16 o[2];
#pragma unroll
        for (int db = 0; db < 2; ++db)
#pragma unroll
            for (int r = 0; r < 16; ++r) o[db][r] = 0.f;
        float m = 0.f, l = 0.f; f32x16 negm;
#pragma unroll
        for (int r = 0; r < 16; ++r) negm[r] = 0.f;
        asm volatile("s_waitcnt lgkmcnt(0)" ::: "memory"); __builtin_amdgcn_s_barrier();
        dma16(src[0], L + dsto[0]); dma16(src[1], L + dsto[1]); if (has3) dma16(src[2], L + dsto[2]);
        dma16(src[0] + sstep[0], L + STG + dsto[0]); dma16(src[1] + sstep[1], L + STG + dsto[1]); if (has3) dma16(src[2] + sstep[2], L + STG + dsto[2]);
        int sc_ = 0, sn_ = 2;
        for (int t = 0; t < NT; ++t) {
            if (t + 1 < NT) { if (has3) asm volatile("s_waitcnt vmcnt(3) lgkmcnt(0)" ::: "memory"); else asm volatile("s_waitcnt vmcnt(2) lgkmcnt(0)" ::: "memory"); }
            else asm volatile("s_waitcnt vmcnt(0) lgkmcnt(0)" ::: "memory");
            __builtin_amdgcn_s_barrier();
            if (t + 2 < NT) {
                LAS unsigned char* nb = L + sn_ * STG;
                dma16(src[0] + (t + 2) * sstep[0], nb + dsto[0]); dma16(src[1] + (t + 2) * sstep[1], nb + dsto[1]); if (has3) dma16(src[2] + (t + 2) * sstep[2], nb + dsto[2]);
            }
            if (t <= T) {
                lds_cptr stg = (lds_cptr)L + sc_ * STG;
                tile<6, 2>(stg, stg + 12288, qf, o, negm, m, l, wsf, t == 0, t == T, qw0 - 64 * T + r32, lane);
            }
            sc_ = (sc_ == 2) ? 0 : sc_ + 1; sn_ = (sn_ == 2) ? 0 : sn_ + 1;
        }
        l = half_swap_sum(l);
        if (hi == 0) wsf[r32] = 1.0f / l;
        asm volatile("s_waitcnt lgkmcnt(0)" ::: "memory");
        f32x4 a4[4];
#pragma unroll
        for (int g = 0; g < 4; ++g) a4[g] = *(const LAS f32x4*)(wsf + 8 * g + 4 * hi);
#pragma unroll
        for (int r = 0; r < 16; ++r) {
            bf16* orow = O + (rowb + qw0 + crow(r, hi)) * D + h * 64 + r32;
#pragma unroll
            for (int db = 0; db < 2; ++db) orow[db * 32] = (bf16)f2bf(o[db][r] * a4[r >> 2][r & 3]);
        }
    }
}

__global__ void __launch_bounds__(NTHR, 2) fwd(Args args) {
    extern __shared__ __attribute__((aligned(16))) unsigned char lds[];
    Ctx C; C.in = args.in; C.out = args.out; C.ws = args.ws; C.lds = lds;
    C.tid = threadIdx.x; C.lane = C.tid & 63; C.wave = __builtin_amdgcn_readfirstlane(C.tid >> 6);
    C.gw = blockIdx.x * NWAVES + C.wave; C.ngw = gridDim.x * NWAVES;
    const Ctx C0 = C;
    volatile LAS unsigned* MISC = (volatile LAS unsigned*)((LAS unsigned char*)lds + MISC_OFF);
    if (C.tid < 32) MISC[C.tid] = 0u;
    __syncthreads();
    XcdBarrier bar; bar.bar = (unsigned*)(args.ws + WS_CTL) + CW_BAR; bar.x = 0; bar.st = nullptr;
    const int lo = args.ph_lo, hi = args.ph_hi;
    if (hi - lo > 1) bar = xcd_barrier_post((unsigned*)(args.ws + WS_CTL) + CW_BAR, MISC + 8);
#ifndef REPMASK
#define REPMASK 0u
#endif
#ifndef PHMASK
#define PHMASK 0xFFFFFFFFu
#endif
#define IN(k) (lo <= (k) && (k) < hi && ((PHMASK >> (k)) & 1u))
#define SEAM(k) do { if (IN(k) && IN((k) + 1)) xcd_barrier(bar); } while (0)
#define PHLOCAL unsigned char* ws = args.ws; asm volatile("" : "+s"(ws)); ws = as_global(ws); int t_ = threadIdx.x; asm volatile("" : "+v"(t_)); Ctx C = C0; C.ws = ws; C.tid = t_; C.lane = t_ & 63; \
        bf16* H = (bf16*)(ws + WS_H); bf16* O = (bf16*)(ws + WS_O); bf16* A0 = (bf16*)(ws + WS_A); (void)H; (void)O; (void)A0;

    if (IN(0)) { PHLOCAL ph_prologue(C); } SEAM(0);
    if (IN(1)) { PHLOCAL ph_normmod0(C); } SEAM(1);
    if (IN(2)) { PHLOCAL
        pg8::Gemm g{H, (const bf16*)(ws + WB_QKV), NTOK, 3 * D, D}; pg8::StaticOrder S; S.init(NTOK, 3 * D, (int)gridDim.x, (int)blockIdx.x);
        pg8::EpiQKV E{A0, A0 + (size_t)NTOK * D, A0 + (size_t)2 * NTOK * D, (const float*)(ws + WS_COSD), (const float*)(ws + WS_SIND), as_global(args.in[I_DA_QN]), as_global(args.in[I_DA_KN]), 0.125f * 1.4426950408889634f, EPS};
        pg8::gemm_phase<pg8::EpiQKV, pg8::StaticOrder, PG8_ALIGN, PG8_SP2>((PG8_LAS unsigned char*)lds, g, S, E);
    } SEAM(2);
    if (IN(3)) { PHLOCAL ph_attn_da_mfma(C); } SEAM(3);
    if (IN(4)) { PHLOCAL
        pg8::Gemm g{O, (const bf16*)(ws + WB_DAO), NTOK, D, D}; pg8::StaticOrder S; S.init(NTOK, D, (int)gridDim.x, (int)blockIdx.x);
        pg8::EpiResid<true> E{as_global(args.in[I_X]), (bf16*)(ws + WS_XB), C.mod(0, 0, 2), (float*)(ws + WS_SSQX)};
        pg8::gemm_phase<pg8::EpiResid<true>, pg8::StaticOrder, PG8_ALIGN, PG8_SP2>((PG8_LAS unsigned char*)lds, g, S, E);
    } SEAM(4);
    if (IN(5)) { PHLOCAL ph_route(C, 0); } SEAM(5);
    if (IN(6)) { PHLOCAL ph_moe1_mfma(C, 0); } SEAM(6);
    if (IN(7)) { PHLOCAL ph_moe2_mfma(C, 0); } SEAM(7);
    if (IN(8)) { PHLOCAL ph_comb<false>(C, ws + WS_A + 128 * MiB, C.mod(0, 0, 5), 1, as_global(args.in[I_NMIX]) + D); } SEAM(8);
    if (IN(9)) { PHLOCAL
        bf16* CQ = (bf16*)(ws + WS_S); bf16* CKV = CQ + (size_t)NTOK * 384; bf16* KPE = (bf16*)(ws + WS_KPE);
        pg8::Gemm g{H, (const bf16*)(ws + WB_WIN), NTOK, 768, D}; pg8::StaticOrder S; S.init(NTOK, 768, (int)gridDim.x, (int)blockIdx.x);
        pg8::EpiWin E{CQ, CKV, KPE, (float*)(ws + WS_SSQ), (const float*)(ws + WS_COSM), (const float*)(ws + WS_SINM), as_global(args.in[I_M_KPN]), EPS};
        pg8::gemm_phase<pg8::EpiWin, pg8::StaticOrder, PG8_ALIGN, PG8_SP2>((PG8_LAS unsigned char*)lds, g, S, E);
    } SEAM(9);
    if (IN(10)) { PHLOCAL
        const bf16* CQ = (const bf16*)(ws + WS_S); const bf16* CKV = CQ + (size_t)NTOK * 384;
        int Kq = 384, Kkv = 256; asm volatile("" : "+s"(Kq), "+s"(Kkv));
        { pg8::Gemm g{CQ, (const bf16*)(ws + WB_WUQ), NTOK, 1536, Kq}; pg8::StaticOrder S; S.init(NTOK, 1536, (int)gridDim.x, (int)blockIdx.x);
          pg8::EpiUQ E{A0, (const float*)(ws + WS_SSQ), (const float*)(ws + WS_COSM), (const float*)(ws + WS_SINM), as_global(args.in[I_M_QNN]), as_global(args.in[I_M_QPN]), 0.10206207261596575f * 1.4426950408889634f, EPS};
          pg8::gemm_phase<pg8::EpiUQ, pg8::StaticOrder, PG8_ALIGN, PG8_SP2>((PG8_LAS unsigned char*)lds, g, S, E); }
        { pg8::Gemm g{CKV, (const bf16*)(ws + WB_WUKV), NTOK, 2048, Kkv}; pg8::StaticOrder S; S.init(NTOK, 2048, (int)gridDim.x, (int)blockIdx.x);
          pg8::EpiUKV E{(bf16*)(ws + WS_A + 192 * MiB), (const float*)(ws + WS_SSQ), as_global(args.in[I_M_KNN]), EPS};
          pg8::gemm_phase<pg8::EpiUKV, pg8::StaticOrder, PG8_ALIGN, PG8_SP2>((PG8_LAS unsigned char*)lds, g, S, E); }
    } SEAM(10);
    if (IN(11)) { PHLOCAL ph_attn_mla_mfma(C); } SEAM(11);
    if (IN(12)) { PHLOCAL
        pg8::Gemm g{O, (const bf16*)(ws + WB_MLO), NTOK, D, D}; pg8::StaticOrder S; S.init(NTOK, D, (int)gridDim.x, (int)blockIdx.x);
        pg8::EpiResid<false> E{ws + WS_XB, (bf16*)(ws + WS_XB), C.mod(1, 0, 2), (float*)(ws + WS_SSQX)};
        pg8::gemm_phase<pg8::EpiResid<false>, pg8::StaticOrder, PG8_ALIGN, PG8_SP2>((PG8_LAS unsigned char*)lds, g, S, E);
    } SEAM(12);
    if (IN(13)) { PHLOCAL ph_route(C, 1); } SEAM(13);
    if (IN(14)) { PHLOCAL ph_moe1_mfma(C, 1); } SEAM(14);
    if (IN(15)) { PHLOCAL ph_moe2_mfma(C, 1); } SEAM(15);
    if (IN(16)) { PHLOCAL ph_comb<true>(C, ws + WS_A + 128 * MiB, C.mod(1, 0, 5), 1, as_global(args.in[I_NMIX])); }
#undef IN
#undef SEAM
}

extern "C" void kernel_launch(void* const* d_in, const int* in_sizes, int n_in, void* d_out, int out_size, void* d_ws, size_t ws_size, hipStream_t stream) {
    static int grid = 0;
    if (grid == 0) {
        if (n_in != 33 || out_size != NTOK * D || ws_size < WS_END) { fprintf(stderr, "kernel_launch: unexpected shapes n_in %d out %d ws %zu\n", n_in, out_size, ws_size); grid = -1; return; }
        int dev = 0, cus = 0;
        if (hipGetDevice(&dev) != hipSuccess || hipDeviceGetAttribute(&cus, hipDeviceAttributeMultiprocessorCount, dev) != hipSuccess) { grid = -1; return; }
        if (hipFuncSetAttribute((const void*)fwd, hipFuncAttributeMaxDynamicSharedMemorySize, LDS_BYTES) != hipSuccess) { fprintf(stderr, "hipFuncSetAttribute failed\n"); grid = -1; return; }
        (void)hipGetLastError();
        grid = cus;
        if (grid != 256) { fprintf(stderr, "kernel_launch: built for 256 CUs, device reports %d\n", cus); grid = -1; return; }
    }
    if (grid < 0) return;
    (void)hipMemsetAsync((char*)d_ws + WS_CTL, 0, CTL_ZERO_BYTES, stream);
    Args a{};
    for (int i = 0; i < 33; ++i) a.in[i] = (const float*)d_in[i];
    a.out = (float*)d_out; a.ws = (unsigned char*)d_ws;
#if MK_ONE_LAUNCH
    a.ph_lo = 0; a.ph_hi = N_PHASES;
    hipLaunchKernelGGL(fwd, dim3(grid), dim3(NTHR), LDS_BYTES, stream, a);
#else
    for (int p = 0; p < N_PHASES; ++p) { a.ph_lo = p; a.ph_hi = p + 1; hipLaunchKernelGGL(fwd, dim3(grid), dim3(NTHR), LDS_BYTES, stream, a); }
#endif
}
```

```cpp
#include <hip/hip_runtime.h>
#include <cstdio>
#include <cstdint>

#define LAS __attribute__((address_space(3)))
#define GAS __attribute__((address_space(1)))
template <class T> __device__ __forceinline__ T* as_global(T* p) { GAS T* g = (GAS T*)p; asm("" : "+s"(g)); return (T*)g; }
typedef unsigned short bf16;
typedef float f32x4 __attribute__((ext_vector_type(4)));
typedef unsigned u32x4 __attribute__((ext_vector_type(4)));
typedef unsigned u32x2 __attribute__((ext_vector_type(2)));

constexpr int NB = 32, SEQ = 2048, D = 1024, NTOK = NB * SEQ;
constexpr float EPS = 1e-6f;
constexpr int NWAVES = 8, NTHR = 512;
constexpr int N_PHASES = 17;
#ifndef MK_ONE_LAUNCH
#define MK_ONE_LAUNCH 1
#endif

constexpr size_t MiB = 1u << 20;
constexpr size_t WS_CTL = 0, CTL_ZERO_BYTES = 1 * MiB;
constexpr size_t WS_MOD = 1 * MiB;
constexpr size_t WS_LAM = WS_MOD + 7 * MiB / 4;
constexpr size_t WS_SSQX = 4 * MiB;
constexpr size_t WS_SSQ = 8 * MiB;
constexpr size_t WS_WRT = 12 * MiB;
constexpr size_t WS_COSD = 16 * MiB, WS_SIND = 24 * MiB, WS_COSM = 32 * MiB, WS_SINM = 36 * MiB;
constexpr size_t WS_TOKW = 40 * MiB;
constexpr size_t WS_LIST = 42 * MiB;
constexpr size_t WS_WB = 50 * MiB;
constexpr size_t WB_QKV = WS_WB, WB_DAO = WB_QKV + 6 * MiB, WB_WIN = WB_DAO + 2 * MiB, WB_WUQ = WB_WIN + 3 * MiB / 2, WB_WUKV = WB_WUQ + 9 * MiB / 8, WB_MLO = WB_WUKV + 1 * MiB, WB_MOE = WB_MLO + 2 * MiB;
constexpr size_t WS_H = 176 * MiB;
constexpr size_t WS_O = 304 * MiB;
constexpr size_t WS_A = 432 * MiB;
constexpr size_t WS_LISTW = 160 * MiB;
constexpr size_t WS_KPE = 168 * MiB;
constexpr size_t WS_S = WS_O;
constexpr size_t WS_XB = 880 * MiB;
constexpr size_t WS_END = 1008 * MiB;
constexpr int CW_BAR = 4096;
constexpr int CW_CNT = 16384;
constexpr int HID_ROWS = 2 * NTOK + 32 * 128;

constexpr int LDS_BYTES = 147456;
constexpr int MISC_OFF = 131072 + 320;

__device__ __forceinline__ unsigned f2bf(float f) { unsigned u = __builtin_bit_cast(unsigned, f); return (u + 0x7fffu + ((u >> 16) & 1u)) >> 16; }
__device__ __forceinline__ float bf2f(unsigned h) { return __builtin_bit_cast(float, h << 16); }
__device__ __forceinline__ unsigned pk2(float lo, float hi) { return f2bf(lo) | (f2bf(hi) << 16); }
__device__ __forceinline__ float wave_sum(float v) {
#pragma unroll
    for (int o = 1; o < 64; o <<= 1) v += __shfl_xor(v, o);
    return v;
}
__device__ __forceinline__ float wave_max(float v) {
#pragma unroll
    for (int o = 1; o < 64; o <<= 1) v = fmaxf(v, __shfl_xor(v, o));
    return v;
}

#define XB_TMO      128
#define XB_XCNT(j)  (256  + 64 * (j))
#define XB_XSUB(j)  (1280 + 64 * (j))
#define XB_XGEN(j)  (2304 + 64 * (j))
#define XB_TOP      3328
#define XB_TOPGEN   3392
#define XCD_BAR_WORDS 3456
#define XB_SPIN_CAP (1u << 20)
__device__ __forceinline__ unsigned xb_ld(unsigned* p)              { return __hip_atomic_load(p, __ATOMIC_RELAXED, __HIP_MEMORY_SCOPE_AGENT); }
__device__ __forceinline__ unsigned xb_add(unsigned* p, unsigned v) { return __hip_atomic_fetch_add(p, v, __ATOMIC_RELAXED, __HIP_MEMORY_SCOPE_AGENT); }
__device__ __forceinline__ unsigned xb_xcc_id() { return (unsigned)__builtin_amdgcn_s_getreg((3 << 11) | 20) & 0xFu; }
#define XB_SPIN(cond, bar) do { unsigned _sp = 0; while (cond) { __builtin_amdgcn_s_sleep(1); \
    if ((++_sp & 255u) == 0u) { if (xb_ld(&(bar)[XB_TMO])) break; if (_sp > XB_SPIN_CAP) { atomicAdd(&(bar)[XB_TMO], 1u); break; } } } } while (0)
struct XcdBarrier { unsigned* bar; unsigned x; volatile LAS unsigned* st; };
__device__ __forceinline__ XcdBarrier xcd_barrier_post(unsigned* bar, volatile LAS unsigned* st) {
    XcdBarrier b; b.bar = bar; b.x = xb_xcc_id(); b.st = st;
    if (threadIdx.x == 0) (void)xb_add(&bar[XB_XCNT(b.x)], 1u);
    return b;
}
__device__ __forceinline__ void xcd_barrier_complete(unsigned* bar, unsigned x, unsigned& nloc, unsigned& nx) {
    const unsigned G = gridDim.x * gridDim.y * gridDim.z;
    unsigned sum, cnt, mine, sp = 0u;
    for (;;) {
        sum = 0u; cnt = 0u; mine = 0u;
#pragma unroll
        for (unsigned j = 0; j < 16; ++j) { const unsigned c = xb_ld(&bar[XB_XCNT(j)]); sum += c; cnt += (c > 0u) ? 1u : 0u; mine = (j == x) ? c : mine; }
        if (sum == G) break;
        __builtin_amdgcn_s_sleep(1);
        if ((++sp & 255u) == 0u) { if (xb_ld(&bar[XB_TMO])) break; if (sp > XB_SPIN_CAP) { atomicAdd(&bar[XB_TMO], 1u); break; } }
    }
    nloc = mine > 0u ? mine : 1u; nx = cnt > 0u ? cnt : 1u;
}
__device__ __forceinline__ void xcd_barrier(const XcdBarrier& b) {
    asm volatile("s_waitcnt vmcnt(0)" ::: "memory");
    __syncthreads();
    if (threadIdx.x == 0) {
        unsigned* bar = b.bar;
        __builtin_amdgcn_s_waitcnt(0);
        unsigned nloc = b.st[0], nx = b.st[1];
        if (nloc == 0u) { xcd_barrier_complete(bar, b.x, nloc, nx); b.st[0] = nloc; b.st[1] = nx; }
        const unsigned old = xb_add(&bar[XB_XSUB(b.x)], 1u);
        const unsigned gen = old / nloc;
        if (old + 1u == (gen + 1u) * nloc) {
            __builtin_amdgcn_fence(__ATOMIC_RELEASE, "agent");
            asm volatile("s_waitcnt vmcnt(0)" ::: "memory");
            const unsigned og = xb_add(&bar[XB_TOP], 1u);
            const unsigned tg = og / nx;
            if (og + 1u == (tg + 1u) * nx) xb_add(&bar[XB_TOPGEN], 1u);
            else XB_SPIN(xb_ld(&bar[XB_TOPGEN]) == tg, bar);
            __builtin_amdgcn_fence(__ATOMIC_ACQUIRE, "agent");
            xb_add(&bar[XB_XGEN(b.x)], 1u);
            asm volatile("s_waitcnt vmcnt(0)" ::: "memory");
        } else {
            XB_SPIN(xb_ld(&bar[XB_XGEN(b.x)]) == gen, bar);
            __builtin_amdgcn_fence(__ATOMIC_ACQUIRE, "agent");
            asm volatile("s_waitcnt vmcnt(0)" ::: "memory");
        }
    }
    __syncthreads();
}

namespace pg8 {
#define PG8_LAS __attribute__((address_space(3)))
typedef unsigned short bf16_t;
typedef short bf16x8 __attribute__((ext_vector_type(8)));
typedef float f32x4 __attribute__((ext_vector_type(4)));
typedef unsigned u32x4 __attribute__((ext_vector_type(4)));
constexpr int BM = 256, BK = 64, HALF = 128, HTB = HALF * BK * 2  , STAGE_BYTES = 8 * HTB, NXCD = 8, WGM = 8;

__host__ __device__ __forceinline__ int lds_byte(int r, int c) { const int st = (r >> 4) * 2 + (c >> 5), rr = r & 15, cc = c & 31, ob = rr * 64 + cc * 2; return st * 1024 + (ob ^ (((ob >> 9) & 1) << 5)); }
__host__ __device__ __forceinline__ void stage_rc(int b, int& R, int& C) { const int st = b / 1024, sb = b % 1024, swz = sb ^ (((sb >> 9) & 1) << 5); R = (st >> 1) * 16 + swz / 64; C = (st & 1) * 32 + (swz % 64) / 2; }
__host__ __device__ __forceinline__ int perm32(int rho) { const int n = rho >> 4, i = rho & 15; return 8 * (i >> 2) + 4 * n + (i & 3); }

struct Unit { int pm, pn; };
struct Gemm { const bf16_t* A; const bf16_t* Bt; int M, N, K; };

struct StaticOrder {
    typedef Unit UnitT;
    int nM, nN, nwg, G, c;
    __host__ __device__ void init(int M, int N, int G_, int c_) { nM = M / BM; nN = N / BM; nwg = nM * nN; G = G_; c = c_; }
    __host__ __device__ bool next(int i, Unit& u) const {
        const long L = (long)i * G + c; if (L >= nwg) return false;
        int wgid = (int)L; { const int q = nwg / NXCD, r = nwg % NXCD, xcd = wgid % NXCD, off = wgid / NXCD; wgid = (xcd < r ? xcd * (q + 1) : r * (q + 1) + (xcd - r) * q) + off; }
        const int nig = WGM * nN, gid = wgid / nig, fm = gid * WGM, gsz = (nM - fm) < WGM ? (nM - fm) : WGM;
        u.pm = fm + ((wgid % nig) % gsz); u.pn = (wgid % nig) / gsz; return true;
    }
    __device__ __forceinline__ void a_ready(const Unit&) const {}
    __device__ __forceinline__ void done(const Unit&) const {}
};

__device__ __forceinline__ unsigned cvt_pk_bf16(float lo, float hi) { unsigned r; asm volatile("v_cvt_pk_bf16_f32 %0, %1, %2" : "=v"(r) : "v"(lo), "v"(hi)); return r; }
typedef float f32x2 __attribute__((ext_vector_type(2)));
__device__ __forceinline__ f32x2 gelu_pk(f32x2 v) {
    const f32x2 av = __builtin_elementwise_abs(v), d = av * 0.2316418882f + 1.0f;
    f32x2 t; t.x = __builtin_amdgcn_rcpf(d.x); t.y = __builtin_amdgcn_rcpf(d.y);
    f32x2 q = t * 0.5307027145f + (-0.7265760135f); q = q * t + 0.7107068705f; q = q * t + (-0.142248368f); q = q * t + 0.127414796f; q = q * t;
    const f32x2 s = (v * v) * (-0.72134752044f);
    f32x2 e; e.x = __builtin_amdgcn_exp2f(s.x); e.y = __builtin_amdgcn_exp2f(s.y);
    const f32x2 m = v * (q * e), r = v - m;
    f32x2 o; o.x = v.x < 0.f ? m.x : r.x; o.y = v.y < 0.f ? m.y : r.y; return o;
}

template <int ACT  > struct EpiBf16 {
    static constexpr bool PERM = true, AFTER_DRAIN = false; static_assert(ACT == 0 || ACT == 1, "EpiBf16: ACT is 0 (none) or 1 (gelu_pk)");
    bf16_t* O; int ldc; const float* bias; int split_cols; size_t split_stride; float scale0;
    __device__ __forceinline__ void operator()(const f32x4 (&acc)[2][2][4][2], const Unit& u, int wr, int wc, int fr, int fq) const {
        const int row0 = u.pm * BM + wr * 64 + fr; int colt = u.pn * BM; bf16_t* base = O;
        float sc = 1.f; if (split_cols) { const int t = colt / split_cols; base += (size_t)t * split_stride; colt -= t * split_cols; if (t == 0) sc = scale0; }
        const int col0 = colt + wc * 32 + 8 * fq, bcol0 = u.pn * BM + wc * 32 + 8 * fq;
        f32x4 bv[2][2];
#pragma unroll
        for (int bj = 0; bj < 2; ++bj)
#pragma unroll
            for (int n = 0; n < 2; ++n) bv[bj][n] = bias ? *(const f32x4*)(bias + bcol0 + bj * HALF + 4 * n) : (f32x4){0.f, 0.f, 0.f, 0.f};
#pragma unroll
        for (int ai = 0; ai < 2; ++ai)
#pragma unroll
            for (int m = 0; m < 4; ++m) { bf16_t* rowp = base + (size_t)(row0 + ai * HALF + m * 16) * ldc + col0;
#pragma unroll
                for (int bj = 0; bj < 2; ++bj) { f32x4 v0 = acc[ai][bj][m][0] + bv[bj][0], v1 = acc[ai][bj][m][1] + bv[bj][1];
                    if (ACT == 1) { f32x2 a = gelu_pk((f32x2){v0[0], v0[1]}), b = gelu_pk((f32x2){v0[2], v0[3]}), c = gelu_pk((f32x2){v1[0], v1[1]}), d = gelu_pk((f32x2){v1[2], v1[3]});
                        v0 = (f32x4){a.x, a.y, b.x, b.y}; v1 = (f32x4){c.x, c.y, d.x, d.y}; }
                    v0 = v0 * sc; v1 = v1 * sc; u32x4 w; w.x = cvt_pk_bf16(v0[0], v0[1]); w.y = cvt_pk_bf16(v0[2], v0[3]); w.z = cvt_pk_bf16(v1[0], v1[1]); w.w = cvt_pk_bf16(v1[2], v1[3]);
                    *(u32x4*)(rowp + bj * HALF) = w; } }
    }
};

template <class Epi, class Sched, bool ALIGN_EPI = false, bool SP2 = false>
__device__ __forceinline__ void gemm_phase(PG8_LAS unsigned char* lds, const Gemm g, const Sched& S, const Epi& E) {
    int tid_ = threadIdx.x; asm volatile("" : "+v"(tid_));
    const int tid = tid_, wid = __builtin_amdgcn_readfirstlane(tid >> 6), lane = tid & 63, wr = wid >> 2, wc = wid & 3, fr = lane & 15, fq = lane >> 4;
    const int K = g.K, nt = K / BK;
    unsigned voffA[2], voffB[2];
#pragma unroll
    for (int i = 0; i < 2; ++i) { int R, C; stage_rc(tid * 16 + i * 8192, R, C); const int Rb = Epi::PERM ? ((R & ~31) + perm32(R & 31)) : R;
        voffA[i] = (unsigned)(R * K + C) * 2u; voffB[i] = (unsigned)(Rb * K + C) * 2u; }
    const size_t kstep = (size_t)(BK * 2);
    const size_t hstep = (size_t)HALF * K * 2;
    const size_t tstep = 2 * hstep;
    const unsigned ldsw = (unsigned)wid * 1024u;
    const int aoff = lds_byte(wr * 64 + fr, fq * 8), boff = lds_byte(wc * 32 + fr, fq * 8);
#define PG8_SA(b, h) (((b) * 2 + (h)) * HTB)
#define PG8_SB(b, h) ((4 + (b) * 2 + (h)) * HTB)
#define PG8_STAGE(bufoff, gbase, voff) do { _Pragma("unroll") for (int _i = 0; _i < 2; ++_i) \
        __builtin_amdgcn_global_load_lds((const unsigned*)((const char*)(gbase) + (voff)[_i]), (PG8_LAS unsigned*)(lds + (bufoff) + ldsw + _i * 8192), 16, 0, 0); } while (0)
#define PG8_LDA(dst, b, h) do { _Pragma("unroll") for (int m = 0; m < 4; ++m) _Pragma("unroll") for (int k = 0; k < 2; ++k) dst[m][k] = *(const PG8_LAS bf16x8*)(lds + PG8_SA(b, h) + aoff + m * 2048 + k * 1024); } while (0)
#define PG8_LDB(dst, b, h) do { _Pragma("unroll") for (int n = 0; n < 2; ++n) _Pragma("unroll") for (int k = 0; k < 2; ++k) dst[n][k] = *(const PG8_LAS bf16x8*)(lds + PG8_SB(b, h) + boff + n * 2048 + k * 1024); } while (0)
#define PG8_MMA(ai, bj, At, Bt) do { __builtin_amdgcn_s_setprio(1); _Pragma("unroll") for (int m = 0; m < 4; ++m) _Pragma("unroll") for (int n = 0; n < 2; ++n) _Pragma("unroll") for (int k = 0; k < 2; ++k) \
        acc[ai][bj][m][n] = __builtin_amdgcn_mfma_f32_16x16x32_bf16(Bt[n][k], At[m][k], acc[ai][bj][m][n], 0, 0, 0); __builtin_amdgcn_s_setprio(0); } while (0)
#define PG8_WAIT_V(n) asm volatile("s_waitcnt vmcnt(" #n ")" ::: "memory")
#define PG8_WAIT_L(n) asm volatile("s_waitcnt lgkmcnt(" #n ")" ::: "memory")
#define PG8_BAR __builtin_amdgcn_s_barrier()
#define PG8_SCHED __builtin_amdgcn_sched_barrier(0)
    typename Sched::UnitT cur, nxt; int ui = 0;
    if (!S.next(0, cur)) return;
    f32x4 acc[2][2][4][2];
#pragma unroll
    for (int a = 0; a < 2; ++a)
#pragma unroll
        for (int b = 0; b < 2; ++b)
#pragma unroll
            for (int m = 0; m < 4; ++m)
#pragma unroll
                for (int n = 0; n < 2; ++n) acc[a][b][m][n] = (f32x4){0.f, 0.f, 0.f, 0.f};
    bf16x8 At[4][2], B0[2][2], B1[2][2];
    const char* cA = (const char*)g.A + (size_t)cur.pm * tstep; const char* cB = (const char*)g.Bt + (size_t)cur.pn * tstep;
    S.a_ready(cur);
    if constexpr (SP2) {
        PG8_STAGE(PG8_SB(0, 0), cB, voffB); PG8_STAGE(PG8_SB(0, 1), cB + hstep, voffB); PG8_STAGE(PG8_SA(0, 0), cA, voffA); PG8_STAGE(PG8_SA(0, 1), cA + hstep, voffA);
        if (wr == 1) PG8_BAR;
        PG8_WAIT_V(2); PG8_BAR;
        PG8_STAGE(PG8_SB(1, 0), cB + kstep, voffB); PG8_STAGE(PG8_SA(1, 0), cA + kstep, voffA); PG8_STAGE(PG8_SB(1, 1), cB + hstep + kstep, voffB);
        PG8_WAIT_V(6); PG8_BAR;
    } else {
        PG8_STAGE(PG8_SB(0, 0), cB, voffB); PG8_STAGE(PG8_SA(0, 0), cA, voffA); PG8_STAGE(PG8_SB(0, 1), cB + hstep, voffB); PG8_STAGE(PG8_SA(0, 1), cA + hstep, voffA);
        if (wr == 1) PG8_BAR;
        PG8_WAIT_V(4); PG8_BAR;
        PG8_STAGE(PG8_SB(1, 0), cB + kstep, voffB); PG8_STAGE(PG8_SA(1, 0), cA + kstep, voffA); PG8_STAGE(PG8_SB(1, 1), cB + hstep + kstep, voffB);
        PG8_WAIT_V(6); PG8_BAR;
    }
    for (;;) {
        const bool has_next = S.next(ui + 1, nxt);
        const char* nA = has_next ? (const char*)g.A + (size_t)nxt.pm * tstep : cA; const char* nB = has_next ? (const char*)g.Bt + (size_t)nxt.pn * tstep : cB;
        for (int t = 0; t < nt; t += 2) {
            const bool last = (t == nt - 2);
            const char* a1 = cA + (size_t)(t + 1) * kstep;
            const char* a2 = last ? nA : cA + (size_t)(t + 2) * kstep; const char* b2 = last ? nB : cB + (size_t)(t + 2) * kstep;
            const char* a3 = a2 + kstep; const char* b3 = b2 + kstep;
            if (last && has_next) S.a_ready(nxt);
            if constexpr (SP2) {
            PG8_LDB(B0, 0, 0); PG8_LDB(B1, 0, 1); PG8_SCHED; PG8_LDA(At, 0, 0); PG8_STAGE(PG8_SA(1, 1), a1 + hstep, voffA);
            PG8_WAIT_V(8); PG8_WAIT_L(0); PG8_BAR; PG8_MMA(0, 0, At, B0); PG8_MMA(0, 1, At, B1); PG8_BAR; PG8_SCHED;
            PG8_LDA(At, 0, 1); PG8_STAGE(PG8_SB(0, 0), b2, voffB); PG8_STAGE(PG8_SB(0, 1), b2 + hstep, voffB); PG8_STAGE(PG8_SA(0, 0), a2, voffA);
            PG8_WAIT_V(8); PG8_WAIT_L(0); PG8_BAR; PG8_MMA(1, 0, At, B0); PG8_MMA(1, 1, At, B1); PG8_BAR; PG8_SCHED;
            PG8_LDB(B0, 1, 0); PG8_LDB(B1, 1, 1); PG8_SCHED; PG8_LDA(At, 1, 0); PG8_STAGE(PG8_SA(0, 1), a2 + hstep, voffA);
            PG8_WAIT_V(8); PG8_WAIT_L(0); PG8_BAR; PG8_MMA(0, 0, At, B0); PG8_MMA(0, 1, At, B1); PG8_BAR; PG8_SCHED;
            PG8_LDA(At, 1, 1); PG8_STAGE(PG8_SB(1, 0), b3, voffB); PG8_STAGE(PG8_SB(1, 1), b3 + hstep, voffB); PG8_STAGE(PG8_SA(1, 0), a3, voffA);
            PG8_WAIT_V(8); PG8_WAIT_L(0); PG8_BAR; PG8_MMA(1, 0, At, B0); PG8_MMA(1, 1, At, B1); PG8_BAR; PG8_SCHED;
            } else {
            PG8_LDB(B0, 0, 0); PG8_SCHED; PG8_LDA(At, 0, 0); PG8_STAGE(PG8_SA(1, 1), a1 + hstep, voffA);
            PG8_WAIT_L(8); PG8_BAR; PG8_WAIT_L(0); PG8_MMA(0, 0, At, B0); PG8_BAR; PG8_SCHED;
            PG8_LDB(B1, 0, 1); PG8_STAGE(PG8_SB(0, 0), b2, voffB);
            PG8_BAR; PG8_WAIT_L(0); PG8_MMA(0, 1, At, B1); PG8_BAR;
            PG8_LDA(At, 0, 1); PG8_STAGE(PG8_SA(0, 0), a2, voffA);
            PG8_BAR; PG8_WAIT_L(0); PG8_MMA(1, 0, At, B0); PG8_BAR; PG8_SCHED;
            PG8_STAGE(PG8_SB(0, 1), b2 + hstep, voffB);
            PG8_WAIT_V(6); PG8_BAR; PG8_MMA(1, 1, At, B1); PG8_BAR;
            PG8_LDB(B0, 1, 0); PG8_SCHED; PG8_LDA(At, 1, 0); PG8_STAGE(PG8_SA(0, 1), a2 + hstep, voffA);
            PG8_WAIT_L(8); PG8_BAR; PG8_WAIT_L(0); PG8_MMA(0, 0, At, B0); PG8_BAR; PG8_SCHED;
            PG8_LDB(B1, 1, 1); PG8_STAGE(PG8_SB(1, 0), b3, voffB);
            PG8_BAR; PG8_WAIT_L(0); PG8_MMA(0, 1, At, B1); PG8_BAR;
            PG8_LDA(At, 1, 1); PG8_STAGE(PG8_SA(1, 0), a3, voffA);
            PG8_BAR; PG8_WAIT_L(0); PG8_MMA(1, 0, At, B0); PG8_BAR; PG8_SCHED;
            PG8_STAGE(PG8_SB(1, 1), b3 + hstep, voffB);
            PG8_WAIT_V(6); PG8_BAR; PG8_MMA(1, 1, At, B1); PG8_BAR;
            }
        }
        if constexpr (ALIGN_EPI) { if (wr == 0) PG8_BAR; }
        if constexpr (!Epi::AFTER_DRAIN) { E(acc, cur, wr, wc, fr, fq); S.done(cur); }
        if (!has_next) break;
#pragma unroll
        for (int a = 0; a < 2; ++a)
#pragma unroll
            for (int b = 0; b < 2; ++b)
#pragma unroll
                for (int m = 0; m < 4; ++m)
#pragma unroll
                    for (int n = 0; n < 2; ++n) acc[a][b][m][n] = (f32x4){0.f, 0.f, 0.f, 0.f};
        cur = nxt; cA = nA; cB = nB; ++ui;
        if constexpr (ALIGN_EPI) { if (wr == 1) PG8_BAR; }
    }
    PG8_WAIT_V(0);
    if constexpr (!ALIGN_EPI) { if (wr == 0) PG8_BAR; }
    PG8_BAR;
    if constexpr (Epi::AFTER_DRAIN) { E.fused(acc, cur, wr, wc, fr, fq, lds, wid, lane); S.done(cur); }
#undef PG8_SA
#undef PG8_SB
#undef PG8_STAGE
#undef PG8_LDA
#undef PG8_LDB
#undef PG8_MMA
#undef PG8_WAIT_V
#undef PG8_WAIT_L
#undef PG8_BAR
#undef PG8_SCHED
}


__device__ __forceinline__ float quad_sum(float v) {
    auto a = __builtin_amdgcn_permlane16_swap(__float_as_uint(v), __float_as_uint(v), false, false); v = __uint_as_float(a[0]) + __uint_as_float(a[1]);
    auto b = __builtin_amdgcn_permlane32_swap(__float_as_uint(v), __float_as_uint(v), false, false); return __uint_as_float(b[0]) + __uint_as_float(b[1]);
}
__device__ __forceinline__ float sq4(const f32x4& v) { return (v[0] * v[0] + v[1] * v[1]) + (v[2] * v[2] + v[3] * v[3]); }
__device__ __forceinline__ u32x4 pack8(const f32x4& a, const f32x4& b) { u32x4 o; o.x = cvt_pk_bf16(a[0], a[1]); o.y = cvt_pk_bf16(a[2], a[3]); o.z = cvt_pk_bf16(b[0], b[1]); o.w = cvt_pk_bf16(b[2], b[3]); return o; }
__device__ __forceinline__ void store_rows8(bf16_t* base, unsigned rowA, unsigned pitch, const u32x4& x0, const u32x4& x1) {
    u32x4 a, b;
#pragma unroll
    for (int c = 0; c < 4; ++c) { a[c] = (unsigned)__builtin_amdgcn_update_dpp((int)x0[c], (int)x1[c], 0x128, 0xF, 0xC, false); b[c] = (unsigned)__builtin_amdgcn_update_dpp((int)x1[c], (int)x0[c], 0x128, 0xF, 0x3, false); }
    *(u32x4*)(base + rowA * pitch) = a; *(u32x4*)(base + (rowA + 8u) * pitch) = b;
}
struct EpiQKV {
    static constexpr bool PERM = true, AFTER_DRAIN = false;
    bf16_t* Q; bf16_t* K; bf16_t* V; const float* cosD; const float* sinD; const float* gq; const float* gk; float qscale; float eps;
    __device__ __forceinline__ void operator()(const f32x4 (&acc)[2][2][4][2], const Unit& u, int wr, int wc, int fr, int fq) const {
        asm volatile("" : "+v"(fr), "+v"(fq));
        const int tile = u.pn; const unsigned row0 = (unsigned)(u.pm * BM + wr * 64 + fr);
        if (tile >= 8) {
            bf16_t* vb = V + (tile - 8) * 256 + wc * 32 + fq * 8;
#pragma unroll
            for (int ai = 0; ai < 2; ++ai)
#pragma unroll
                for (int m = 0; m < 4; ++m) { const unsigned off = (row0 + ai * HALF + m * 16) * 1024u;
#pragma unroll
                    for (int bj = 0; bj < 2; ++bj) *(u32x4*)(vb + off + bj * HALF) = pack8(acc[ai][bj][m][0], acc[ai][bj][m][1]); }
        } else {
            const bool isk = tile >= 4; const int hm = (tile & 3) * 4 + wc; bf16_t* dst = (isk ? K : Q) + hm * 64 + 32 * (fr >> 3) + 8 * fq; const unsigned rowA0 = (unsigned)(u.pm * BM + wr * 64 + (fr & 7)); const float* g = isk ? gk : gq; const float sc = isk ? 1.0f : qscale;
            const f32x4 g0a = *(const f32x4*)(g + 8 * fq), g0b = *(const f32x4*)(g + 8 * fq + 4), g1a = *(const f32x4*)(g + 32 + 8 * fq), g1b = *(const f32x4*)(g + 36 + 8 * fq);
            const float* cb = cosD + 8 * fq; const float* sb = sinD + 8 * fq;
#pragma unroll
            for (int ai = 0; ai < 2; ++ai)
#pragma unroll
                for (int m = 0; m < 4; ++m) {
                    const unsigned row = row0 + ai * HALF + m * 16;
                    const f32x4 c0 = *(const f32x4*)(cb + row * 32u), c1 = *(const f32x4*)(cb + row * 32u + 4), s0 = *(const f32x4*)(sb + row * 32u), s1 = *(const f32x4*)(sb + row * 32u + 4);
                    const f32x4 a0 = acc[ai][0][m][0], a1 = acc[ai][0][m][1], b0 = acc[ai][1][m][0], b1 = acc[ai][1][m][1];
                    const float ss = quad_sum((sq4(a0) + sq4(a1)) + (sq4(b0) + sq4(b1)));
                    const float rs = __builtin_amdgcn_rsqf(ss * (1.0f / 64.0f) + eps) * sc;
                    const f32x4 x1a = a0 * (g0a * rs), x1b = a1 * (g0b * rs), x2a = b0 * (g1a * rs), x2b = b1 * (g1b * rs);
                    store_rows8(dst, rowA0 + ai * HALF + m * 16, 1024u, pack8(x1a * c0 - x2a * s0, x1b * c1 - x2b * s1), pack8(x2a * c0 + x1a * s0, x2b * c1 + x1b * s1));
                }
        }
    }
};
template <bool XF32>
struct EpiResid {
    static constexpr bool PERM = true, AFTER_DRAIN = false;
    const void* xin; bf16_t* xout; const float* gate; float* ssq;
    __device__ __forceinline__ void operator()(const f32x4 (&acc)[2][2][4][2], const Unit& u, int wr, int wc, int fr, int fq) const {
        asm volatile("" : "+v"(fr), "+v"(fq));
        const int b = (u.pm * BM) >> 11; const unsigned colb = (unsigned)(u.pn * BM + wc * 32 + 8 * fq); const unsigned row0 = (unsigned)(u.pm * BM + wr * 64 + fr);
        const float* gp = gate + (size_t)b * 6144 + colb;
        f32x4 g[2][2];
#pragma unroll
        for (int bj = 0; bj < 2; ++bj)
#pragma unroll
            for (int n = 0; n < 2; ++n) g[bj][n] = *(const f32x4*)(gp + bj * HALF + n * 4);
        bf16_t* xo = xout + colb; float* sq = ssq + u.pn * 4 + wc;
#pragma unroll
        for (int ai = 0; ai < 2; ++ai) {
            f32x4 xq[4][2][2];
#pragma unroll
            for (int m = 0; m < 4; ++m) { const unsigned off_ = (row0 + ai * HALF + m * 16) * 1024u + colb;
#pragma unroll
                for (int bj = 0; bj < 2; ++bj) {
                    if (XF32) { xq[m][bj][0] = *(const f32x4*)((const float*)xin + off_ + bj * HALF); xq[m][bj][1] = *(const f32x4*)((const float*)xin + off_ + bj * HALF + 4); }
                    else { const u32x4 w = *(const u32x4*)((const bf16_t*)xin + off_ + bj * HALF);
                        xq[m][bj][0] = (f32x4){__uint_as_float(w.x << 16), __uint_as_float(w.x & 0xffff0000u), __uint_as_float(w.y << 16), __uint_as_float(w.y & 0xffff0000u)};
                        xq[m][bj][1] = (f32x4){__uint_as_float(w.z << 16), __uint_as_float(w.z & 0xffff0000u), __uint_as_float(w.w << 16), __uint_as_float(w.w & 0xffff0000u)}; } } }
#pragma unroll
            for (int m = 0; m < 4; ++m) {
                const unsigned row = row0 + ai * HALF + m * 16; const unsigned off = row * 1024u; float ss = 0.f;
#pragma unroll
                for (int bj = 0; bj < 2; ++bj) { const f32x4 v0 = xq[m][bj][0] + g[bj][0] * acc[ai][bj][m][0], v1 = xq[m][bj][1] + g[bj][1] * acc[ai][bj][m][1];
                    *(u32x4*)(xo + off + bj * HALF) = pack8(v0, v1); ss += sq4(v0) + sq4(v1); }
                ss = quad_sum(ss);
                if (fq == 0) sq[row * 16u] = ss;
            }
        }
    }
};
struct EpiWin {
    static constexpr bool PERM = true, AFTER_DRAIN = false;
    bf16_t* CQ; bf16_t* CKV; bf16_t* KPE; float* ssq; const float* cosM; const float* sinM; const float* gkpe; float eps;
    __device__ __forceinline__ void operator()(const f32x4 (&acc)[2][2][4][2], const Unit& u, int wr, int wc, int fr, int fq) const {
        asm volatile("" : "+v"(fr), "+v"(fq));
        const int ws = u.pn * 4 + wc; const unsigned row0 = (unsigned)(u.pm * BM + wr * 64 + fr);
        if (ws < 10) {
            bf16_t* dst = ((ws < 6) ? CQ + 64 * ws : CKV + 64 * (ws - 6)) + 32 * (fr >> 3) + 8 * fq; const unsigned ld = (ws < 6) ? 384u : 256u; float* sq = ssq + ws; const unsigned rowA0 = (unsigned)(u.pm * BM + wr * 64 + (fr & 7));
#pragma unroll
            for (int ai = 0; ai < 2; ++ai)
#pragma unroll
                for (int m = 0; m < 4; ++m) {
                    const unsigned row = row0 + ai * HALF + m * 16;
                    const f32x4 a0 = acc[ai][0][m][0], a1 = acc[ai][0][m][1], b0 = acc[ai][1][m][0], b1 = acc[ai][1][m][1];
                    store_rows8(dst, rowA0 + ai * HALF + m * 16, ld, pack8(a0, a1), pack8(b0, b1));
                    const float ss = quad_sum((sq4(a0) + sq4(a1)) + (sq4(b0) + sq4(b1)));
                    if (fq == 0) sq[row * 16u] = ss;
                }
        } else if (ws == 10) {
            const f32x4 g0 = *(const f32x4*)(gkpe + 4 * fq), g1 = *(const f32x4*)(gkpe + 16 + 4 * fq);
#pragma unroll
            for (int ai = 0; ai < 2; ++ai)
#pragma unroll
                for (int m = 0; m < 4; ++m) {
                    const unsigned row = row0 + ai * HALF + m * 16;
                    const f32x4 c = *(const f32x4*)(cosM + row * 16u + 4 * fq), sn = *(const f32x4*)(sinM + row * 16u + 4 * fq);
                    const f32x4 y0 = acc[ai][0][m][0], y1 = acc[ai][0][m][1];
                    const float rs = __builtin_amdgcn_rsqf(quad_sum(sq4(y0) + sq4(y1)) * (1.0f / 32.0f) + eps);
                    const f32x4 x1 = y0 * (g0 * rs), x2 = y1 * (g1 * rs);
                    *(u32x4*)(KPE + row * 32u + 8 * fq) = pack8(x1 * c - x2 * sn, x2 * c + x1 * sn);
                }
        }
    }
};
struct EpiUQ {
    static constexpr bool PERM = true, AFTER_DRAIN = false;
    bf16_t* Q2; const float* ssq; const float* cosM; const float* sinM; const float* gqn; const float* gqp; float qscale; float eps;
    __device__ __forceinline__ void operator()(const f32x4 (&acc)[2][2][4][2], const Unit& u, int wr, int wc, int fr, int fq) const {
        asm volatile("" : "+v"(fr), "+v"(fq));
        const int tile = u.pn; const unsigned row0 = (unsigned)(u.pm * BM + wr * 64 + fr);
        if (tile < 4) {
            bf16_t* dst = Q2 + (tile * 4 + wc) * 96 + 32 * (fr >> 3) + 8 * fq; const unsigned rowA0 = (unsigned)(u.pm * BM + wr * 64 + (fr & 7));
            const f32x4 g0a = *(const f32x4*)(gqn + 8 * fq) * qscale, g0b = *(const f32x4*)(gqn + 8 * fq + 4) * qscale, g1a = *(const f32x4*)(gqn + 32 + 8 * fq) * qscale, g1b = *(const f32x4*)(gqn + 36 + 8 * fq) * qscale;
#pragma unroll
            for (int ai = 0; ai < 2; ++ai) {
                f32x4 sA[4], sB[4];
#pragma unroll
                for (int m = 0; m < 4; ++m) { const unsigned row = row0 + ai * HALF + m * 16; sA[m] = *(const f32x4*)(ssq + row * 16u); sB[m] = *(const f32x4*)(ssq + row * 16u + 4); }
#pragma unroll
                for (int m = 0; m < 4; ++m) {
                    const unsigned row = row0 + ai * HALF + m * 16;
                    const f32x4 a0 = acc[ai][0][m][0], a1 = acc[ai][0][m][1], b0 = acc[ai][1][m][0], b1 = acc[ai][1][m][1];
                    const float ss = quad_sum((sq4(a0) + sq4(a1)) + (sq4(b0) + sq4(b1)));
                    const float em = eps * ((((sA[m][0] + sA[m][1]) + (sA[m][2] + sA[m][3])) + (sB[m][0] + sB[m][1])) * (1.0f / 384.0f) + eps);
                    const float rn = __builtin_amdgcn_rsqf(ss * (1.0f / 64.0f) + em);
                    store_rows8(dst, rowA0 + ai * HALF + m * 16, 1536u, pack8(a0 * (g0a * rn), a1 * (g0b * rn)), pack8(b0 * (g1a * rn), b1 * (g1b * rn)));
                }
            }
        } else {
            const f32x4 g0 = *(const f32x4*)(gqp + 4 * fq) * qscale, g1 = *(const f32x4*)(gqp + 16 + 4 * fq) * qscale;
            bf16_t* dst = Q2 + (((tile - 4) * 4 + wc) * 2) * 96 + 64 + 8 * fq;
#pragma unroll
            for (int ai = 0; ai < 2; ++ai) {
                f32x4 sA[4], sB[4], cc[4], sn[4];
#pragma unroll
                for (int m = 0; m < 4; ++m) { const unsigned row = row0 + ai * HALF + m * 16; sA[m] = *(const f32x4*)(ssq + row * 16u); sB[m] = *(const f32x4*)(ssq + row * 16u + 4);
                    cc[m] = *(const f32x4*)(cosM + row * 16u + 4 * fq); sn[m] = *(const f32x4*)(sinM + row * 16u + 4 * fq); }
#pragma unroll
                for (int m = 0; m < 4; ++m) {
                    const unsigned row = row0 + ai * HALF + m * 16;
                    const float em = eps * ((((sA[m][0] + sA[m][1]) + (sA[m][2] + sA[m][3])) + (sB[m][0] + sB[m][1])) * (1.0f / 384.0f) + eps);
#pragma unroll
                    for (int bj = 0; bj < 2; ++bj) {
                        const f32x4 y0 = acc[ai][bj][m][0], y1 = acc[ai][bj][m][1];
                        const float rn = __builtin_amdgcn_rsqf(quad_sum(sq4(y0) + sq4(y1)) * (1.0f / 32.0f) + em);
                        const f32x4 x1 = y0 * (g0 * rn), x2 = y1 * (g1 * rn);
                        *(u32x4*)(dst + row * 1536u + bj * 96) = pack8(x1 * cc[m] - x2 * sn[m], x2 * cc[m] + x1 * sn[m]);
                    }
                }
            }
        }
    }
};
struct EpiUKV {
    static constexpr bool PERM = true, AFTER_DRAIN = false;
    bf16_t* KV2; const float* ssq; const float* gkn; float eps;
    __device__ __forceinline__ void operator()(const f32x4 (&acc)[2][2][4][2], const Unit& u, int wr, int wc, int fr, int fq) const {
        asm volatile("" : "+v"(fr), "+v"(fq));
        const int tile = u.pn, head = (tile & 3) * 4 + wc; const unsigned row0 = (unsigned)(u.pm * BM + wr * 64 + fr), rowA0 = (unsigned)(u.pm * BM + wr * 64 + (fr & 7)); const int hcol = 32 * (fr >> 3) + 8 * fq;
        f32x4 sB[2][4], sC[2][4];
#pragma unroll
        for (int ai = 0; ai < 2; ++ai)
#pragma unroll
            for (int m = 0; m < 4; ++m) { const unsigned row = row0 + ai * HALF + m * 16; sB[ai][m] = *(const f32x4*)(ssq + row * 16u + 4); sC[ai][m] = *(const f32x4*)(ssq + row * 16u + 8); }
        if (tile < 4) {
            bf16_t* dst = KV2 + head * 128 + hcol;
            const f32x4 g0a = *(const f32x4*)(gkn + 8 * fq), g0b = *(const f32x4*)(gkn + 8 * fq + 4), g1a = *(const f32x4*)(gkn + 32 + 8 * fq), g1b = *(const f32x4*)(gkn + 36 + 8 * fq);
#pragma unroll
            for (int ai = 0; ai < 2; ++ai)
#pragma unroll
                for (int m = 0; m < 4; ++m) {
                    const unsigned row = row0 + ai * HALF + m * 16;
                    const f32x4 a0 = acc[ai][0][m][0], a1 = acc[ai][0][m][1], b0 = acc[ai][1][m][0], b1 = acc[ai][1][m][1];
                    const float ss = quad_sum((sq4(a0) + sq4(a1)) + (sq4(b0) + sq4(b1)));
                    const float msq = ((sB[ai][m][2] + sB[ai][m][3]) + (sC[ai][m][0] + sC[ai][m][1])) * (1.0f / 256.0f) + eps;
                    const float rn = __builtin_amdgcn_rsqf(ss * (1.0f / 64.0f) + eps * msq);
                    store_rows8(dst, rowA0 + ai * HALF + m * 16, 2048u, pack8(a0 * (g0a * rn), a1 * (g0b * rn)), pack8(b0 * (g1a * rn), b1 * (g1b * rn)));
                }
        } else {
            bf16_t* dst = KV2 + head * 128 + 64 + hcol;
#pragma unroll
            for (int ai = 0; ai < 2; ++ai)
#pragma unroll
                for (int m = 0; m < 4; ++m) {
                    const unsigned row = row0 + ai * HALF + m * 16;
                    const float rsq = __builtin_amdgcn_rsqf(((sB[ai][m][2] + sB[ai][m][3]) + (sC[ai][m][0] + sC[ai][m][1])) * (1.0f / 256.0f) + eps);
                    store_rows8(dst, rowA0 + ai * HALF + m * 16, 2048u, pack8(acc[ai][0][m][0] * rsq, acc[ai][0][m][1] * rsq), pack8(acc[ai][1][m][0] * rsq, acc[ai][1][m][1] * rsq));
                }
        }
    }
};

struct MUnit { int pm, pn, e, r0; };
struct MoeOrder {
    typedef MUnit UnitT;
    const int* tpre; int ncol, G, c, total;
    __device__ __forceinline__ bool next(int i, MUnit& u) const {
        const int L = i * G + c; if (L >= total) return false;
        const int rt = L / ncol, ct = L - rt * ncol; const int e = tpre[33 + rt];
        u.e = e; u.pm = rt; u.r0 = (rt - tpre[e]) * 256; u.pn = e * ncol + ct; return true;
    }
    __device__ __forceinline__ void a_ready(const MUnit&) const {}
    __device__ __forceinline__ void done(const MUnit&) const {}
};
__device__ __forceinline__ float silu_f(float a) { return a * __builtin_amdgcn_rcpf(1.0f + __builtin_amdgcn_exp2f(-1.4426950408889634f * a)); }
struct EpiMoe1 {
    static constexpr bool PERM = true, AFTER_DRAIN = false;
    bf16_t* hid; const int* glist; const float* tokw; const int* cntl; int ntok;
    __device__ __forceinline__ void operator()(const f32x4 (&acc)[2][2][4][2], const MUnit& u, int wr, int wc, int fr, int fq) const {
        const int cnt = cntl[u.e], t = u.pn & 1;
        asm volatile("" : "+v"(fr), "+v"(fq));
#pragma unroll
        for (int ai = 0; ai < 2; ++ai)
#pragma unroll
            for (int m = 0; m < 4; ++m) {
                const int rl = ai * HALF + wr * 64 + m * 16 + fr, r = u.r0 + rl; float w = 0.f;
                if (r < cnt) w = tokw[(unsigned)(u.e * ntok + r)];
                const f32x4 a0 = acc[ai][0][m][0], a1 = acc[ai][0][m][1], b0 = acc[ai][1][m][0], b1 = acc[ai][1][m][1];
                u32x4 o;
                o.x = cvt_pk_bf16(silu_f(a0[0]) * b0[0] * w, silu_f(a0[1]) * b0[1] * w); o.y = cvt_pk_bf16(silu_f(a0[2]) * b0[2] * w, silu_f(a0[3]) * b0[3] * w);
                o.z = cvt_pk_bf16(silu_f(a1[0]) * b1[0] * w, silu_f(a1[1]) * b1[1] * w); o.w = cvt_pk_bf16(silu_f(a1[2]) * b1[2] * w, silu_f(a1[3]) * b1[3] * w);
                *(u32x4*)(hid + ((size_t)u.pm * BM + rl) * 256 + t * 128 + wc * 32 + fq * 8) = o;
                asm volatile("" ::: "memory");
            }
    }
};
struct EpiMoe2 {
    static constexpr bool PERM = true, AFTER_DRAIN = false;
    unsigned char* y2; const int* glist; const int* cntl; int ntok;
    __device__ __forceinline__ void operator()(const f32x4 (&acc)[2][2][4][2], const MUnit& u, int wr, int wc, int fr, int fq) const {
        const int cnt = cntl[u.e], ct = u.pn & 3;
        asm volatile("" : "+v"(fr), "+v"(fq));
#pragma unroll
        for (int ai = 0; ai < 2; ++ai)
#pragma unroll
            for (int m = 0; m < 4; ++m) {
                const int rl = ai * HALF + wr * 64 + m * 16 + fr, r = u.r0 + rl;
                int ent = glist[(unsigned)(u.e * ntok + (r < cnt ? r : 0))]; ent = (r < cnt) ? ent : 2 * ntok;
                unsigned char* rowp = y2 + (size_t)(unsigned)ent * 1024 + ct * 256 + wc * 32 + fq * 8;
#pragma unroll
                for (int bj = 0; bj < 2; ++bj) { const f32x4 v0 = acc[ai][bj][m][0] * 32.0f, v1 = acc[ai][bj][m][1] * 32.0f; u32x2 o;
                    int p = __builtin_amdgcn_cvt_pk_fp8_f32(v0[0], v0[1], 0, false); p = __builtin_amdgcn_cvt_pk_fp8_f32(v0[2], v0[3], p, true); o.x = (unsigned)p;
                    p = __builtin_amdgcn_cvt_pk_fp8_f32(v1[0], v1[1], 0, false); p = __builtin_amdgcn_cvt_pk_fp8_f32(v1[2], v1[3], p, true); o.y = (unsigned)p;
                    *(u32x2*)(rowp + bj * HALF) = o; }
                asm volatile("" ::: "memory");
            }
    }
};
template <class Epi, class Sched, bool FP8 = false>
__device__ __forceinline__ void gemm_phase_gather(PG8_LAS unsigned char* lds, const bf16_t* A, const bf16_t* Bt, int K, const int* glist, int ntok, const int* cntl, const Sched& S, const Epi& E) {
    int tid_ = threadIdx.x; asm volatile("" : "+v"(tid_));
    const int tid = tid_, wid = __builtin_amdgcn_readfirstlane(tid >> 6), lane = tid & 63, wr = wid >> 2, wc = wid & 3, fr = lane & 15, fq = lane >> 4;
    const int rowb = FP8 ? K : 2 * K, nt = FP8 ? K / (2 * BK) : K / BK;
    unsigned voffB[2];
#pragma unroll
    for (int i = 0; i < 2; ++i) { int R, C; stage_rc(tid * 16 + i * 8192, R, C); const int Rb = Epi::PERM ? ((R & ~31) + perm32(R & 31)) : R;
        voffB[i] = (unsigned)(Rb * rowb + C * 2); }
    const size_t kstep = (size_t)(BK * 2);
    const size_t hstep = (size_t)HALF * rowb;
    const size_t tstep = 2 * hstep;
    const unsigned ldsw = (unsigned)wid * 1024u;
    const int aoff = lds_byte(wr * 64 + fr, fq * 8), boff = lds_byte(wc * 32 + fr, fq * 8);
#define PG8_SA(b, h) (((b) * 2 + (h)) * HTB)
#define PG8_SB(b, h) ((4 + (b) * 2 + (h)) * HTB)
#define PG8_STAGE(bufoff, gbase, voff) do { _Pragma("unroll") for (int _i = 0; _i < 2; ++_i) \
        __builtin_amdgcn_global_load_lds((const unsigned*)((const char*)(gbase) + (voff)[_i]), (PG8_LAS unsigned*)(lds + (bufoff) + ldsw + _i * 8192), 16, 0, 0); } while (0)
    typedef int i32x4_ __attribute__((ext_vector_type(4))); typedef int i32x8_ __attribute__((ext_vector_type(8)));
#define PG8_LDA(dst, b, h) do { _Pragma("unroll") for (int m = 0; m < 4; ++m) { if constexpr (FP8) { const i32x4_ l0_ = *(const PG8_LAS i32x4_*)(lds + PG8_SA(b, h) + aoff + m * 2048), l1_ = *(const PG8_LAS i32x4_*)(lds + PG8_SA(b, h) + aoff + m * 2048 + 1024); \
            dst##8[m] = __builtin_shufflevector(l0_, l1_, 0, 1, 2, 3, 4, 5, 6, 7); } else { _Pragma("unroll") for (int k = 0; k < 2; ++k) dst[m][k] = *(const PG8_LAS bf16x8*)(lds + PG8_SA(b, h) + aoff + m * 2048 + k * 1024); } } } while (0)
#define PG8_LDB(dst, b, h) do { _Pragma("unroll") for (int n = 0; n < 2; ++n) { if constexpr (FP8) { const i32x4_ l0_ = *(const PG8_LAS i32x4_*)(lds + PG8_SB(b, h) + boff + n * 2048), l1_ = *(const PG8_LAS i32x4_*)(lds + PG8_SB(b, h) + boff + n * 2048 + 1024); \
            dst##8[n] = __builtin_shufflevector(l0_, l1_, 0, 1, 2, 3, 4, 5, 6, 7); } else { _Pragma("unroll") for (int k = 0; k < 2; ++k) dst[n][k] = *(const PG8_LAS bf16x8*)(lds + PG8_SB(b, h) + boff + n * 2048 + k * 1024); } } } while (0)
#define PG8_MMA(ai, bj, At, Bt) do { __builtin_amdgcn_s_setprio(1); _Pragma("unroll") for (int m = 0; m < 4; ++m) _Pragma("unroll") for (int n = 0; n < 2; ++n) { \
        if constexpr (FP8) acc[ai][bj][m][n] = __builtin_amdgcn_mfma_scale_f32_16x16x128_f8f6f4(Bt##8[n], At##8[m], acc[ai][bj][m][n], 0, 0, 0, 0x7a7a7a7a, 0, 0x7f7f7f7f); \
        else { _Pragma("unroll") for (int k = 0; k < 2; ++k) acc[ai][bj][m][n] = __builtin_amdgcn_mfma_f32_16x16x32_bf16(Bt[n][k], At[m][k], acc[ai][bj][m][n], 0, 0, 0); } } \
        __builtin_amdgcn_s_setprio(0); } while (0)
#define PG8_WAIT_V(n) asm volatile("s_waitcnt vmcnt(" #n ")" ::: "memory")
#define PG8_WAIT_L(n) asm volatile("s_waitcnt lgkmcnt(" #n ")" ::: "memory")
#define PG8_BAR __builtin_amdgcn_s_barrier()
#define PG8_SCHED __builtin_amdgcn_sched_barrier(0)
#define PG8_GOFF(u, off) do { const int _cnt = cntl[(u).e]; _Pragma("unroll") for (int _h = 0; _h < 2; ++_h) _Pragma("unroll") for (int _i = 0; _i < 2; ++_i) { \
        int _R, _C; stage_rc(tid * 16 + _i * 8192, _R, _C); const int _r = (u).r0 + _h * HALF + _R; const int _ent = glist[(unsigned)((u).e * ntok + (_r < _cnt ? _r : 0))]; \
        off[_h][_i] = (unsigned)(_ent >> 1) * (unsigned)rowb + (unsigned)(_C * 2); } } while (0)
    typename Sched::UnitT cur, nxt; int ui = 0;
    if (!S.next(0, cur)) return;
    f32x4 acc[2][2][4][2];
#pragma unroll
    for (int a = 0; a < 2; ++a)
#pragma unroll
        for (int b = 0; b < 2; ++b)
#pragma unroll
            for (int m = 0; m < 4; ++m)
#pragma unroll
                for (int n = 0; n < 2; ++n) acc[a][b][m][n] = (f32x4){0.f, 0.f, 0.f, 0.f};
    bf16x8 At[4][2], B0[2][2], B1[2][2]; i32x8_ At8[4], B08[2], B18[2];
    unsigned coff[2][2], noff[2][2];
    PG8_GOFF(cur, coff);
    const char* cA = (const char*)A; const char* cB = (const char*)Bt + (size_t)cur.pn * tstep;
    PG8_STAGE(PG8_SB(0, 0), cB, voffB); PG8_STAGE(PG8_SB(0, 1), cB + hstep, voffB); PG8_STAGE(PG8_SA(0, 0), cA, coff[0]); PG8_STAGE(PG8_SA(0, 1), cA, coff[1]);
    if (wr == 1) PG8_BAR;
    PG8_WAIT_V(2); PG8_BAR;
    PG8_STAGE(PG8_SB(1, 0), cB + kstep, voffB); PG8_STAGE(PG8_SA(1, 0), cA + kstep, coff[0]); PG8_STAGE(PG8_SB(1, 1), cB + hstep + kstep, voffB);
    PG8_WAIT_V(6); PG8_BAR;
    for (;;) {
        const bool has_next = S.next(ui + 1, nxt);
        if (has_next) { PG8_GOFF(nxt, noff); } else {
#pragma unroll
            for (int h = 0; h < 2; ++h)
#pragma unroll
                for (int i = 0; i < 2; ++i) noff[h][i] = coff[h][i]; }
        const char* nB = has_next ? (const char*)Bt + (size_t)nxt.pn * tstep : cB;
        for (int t = 0; t < nt; t += 2) {
            const bool last = (t == nt - 2);
            const char* a1 = cA + (size_t)(t + 1) * kstep;
            const char* a2 = last ? cA : cA + (size_t)(t + 2) * kstep; const char* b2 = last ? nB : cB + (size_t)(t + 2) * kstep;
            const char* a3 = a2 + kstep; const char* b3 = b2 + kstep;
            PG8_LDB(B0, 0, 0); PG8_LDB(B1, 0, 1); PG8_SCHED; PG8_LDA(At, 0, 0); PG8_STAGE(PG8_SA(1, 1), a1, coff[1]);
            if (last) {
#pragma unroll
                for (int h = 0; h < 2; ++h)
#pragma unroll
                    for (int i = 0; i < 2; ++i) coff[h][i] = noff[h][i]; }
            PG8_WAIT_V(8); PG8_WAIT_L(0); PG8_BAR; PG8_MMA(0, 0, At, B0); PG8_MMA(0, 1, At, B1); PG8_BAR; PG8_SCHED;
            PG8_LDA(At, 0, 1); PG8_STAGE(PG8_SB(0, 0), b2, voffB); PG8_STAGE(PG8_SB(0, 1), b2 + hstep, voffB); PG8_STAGE(PG8_SA(0, 0), a2, coff[0]);
            PG8_WAIT_V(8); PG8_WAIT_L(0); PG8_BAR; PG8_MMA(1, 0, At, B0); PG8_MMA(1, 1, At, B1); PG8_BAR; PG8_SCHED;
            PG8_LDB(B0, 1, 0); PG8_LDB(B1, 1, 1); PG8_SCHED; PG8_LDA(At, 1, 0); PG8_STAGE(PG8_SA(0, 1), a2, coff[1]);
            PG8_WAIT_V(8); PG8_WAIT_L(0); PG8_BAR; PG8_MMA(0, 0, At, B0); PG8_MMA(0, 1, At, B1); PG8_BAR; PG8_SCHED;
            PG8_LDA(At, 1, 1); PG8_STAGE(PG8_SB(1, 0), b3, voffB); PG8_STAGE(PG8_SB(1, 1), b3 + hstep, voffB); PG8_STAGE(PG8_SA(1, 0), a3, coff[0]);
            PG8_WAIT_V(8); PG8_WAIT_L(0); PG8_BAR; PG8_MMA(1, 0, At, B0); PG8_MMA(1, 1, At, B1); PG8_BAR; PG8_SCHED;
        }
        if (wr == 0) PG8_BAR;
        E(acc, cur, wr, wc, fr, fq);
        if (!has_next) break;
#pragma unroll
        for (int a = 0; a < 2; ++a)
#pragma unroll
            for (int b = 0; b < 2; ++b)
#pragma unroll
                for (int m = 0; m < 4; ++m)
#pragma unroll
                    for (int n = 0; n < 2; ++n) acc[a][b][m][n] = (f32x4){0.f, 0.f, 0.f, 0.f};
        cur = nxt; cB = nB; ++ui;
        if (wr == 1) PG8_BAR;
    }
    PG8_WAIT_V(0);
    PG8_BAR;
#undef PG8_SA
#undef PG8_SB
#undef PG8_STAGE
#undef PG8_LDA
#undef PG8_LDB
#undef PG8_MMA
#undef PG8_WAIT_V
#undef PG8_WAIT_L
#undef PG8_BAR
#undef PG8_SCHED
#undef PG8_GOFF
}
}

#define PG8_SP2 true
#define PG8_ALIGN true

struct Args { const float* in[33]; float* out; unsigned char* ws; int ph_lo, ph_hi; };
enum { I_X = 0, I_C, I_POS, I_ADAW, I_ADAB, I_NMIX, I_NFFN, I_DA_WQKV, I_DA_QN, I_DA_KN, I_DA_LQ1, I_DA_LK1, I_DA_LQ2, I_DA_LK2,
       I_DA_SUBLN, I_DA_WO, I_M_WIN, I_M_QAN, I_M_KVAN, I_M_WUQ, I_M_WUKV, I_M_QNN, I_M_QPN, I_M_KNN, I_M_KPN, I_M_WO,
       I_E_WG, I_E_BG, I_E_WR, I_E_BR, I_E_W1, I_E_W3, I_E_W2 };

struct Ctx {
    const float* const* in; float* out; unsigned char* ws; unsigned char* lds;
    int tid, lane, wave, gw, ngw;
    __device__ __forceinline__ const float* mod(int layer, int b, int chunk) const { return (const float*)(ws + WS_MOD) + ((size_t)(layer * NB + b) * 6144 + chunk * 1024); }
};

__device__ __forceinline__ void normmod_row(const f32x4 (&v)[4], f32x4 (&h)[4], const float* g, const float* sh, const float* sc, int lane) {
    float s = 0.f;
#pragma unroll
    for (int j = 0; j < 4; ++j) s += (v[j].x * v[j].x + v[j].y * v[j].y) + (v[j].z * v[j].z + v[j].w * v[j].w);
    const float rstd = 1.0f / sqrtf(wave_sum(s) * (1.0f / D) + EPS);
#pragma unroll
    for (int j = 0; j < 4; ++j) {
        const f32x4 gg = *(const f32x4*)(g + 4 * lane + 256 * j), ss = *(const f32x4*)(sh + 4 * lane + 256 * j), cc = *(const f32x4*)(sc + 4 * lane + 256 * j);
        h[j] = (v[j] * rstd) * gg * (cc + 1.0f) + ss;
    }
}
__device__ __forceinline__ void store_row_bf16(bf16* row, const f32x4 (&h)[4], int lane) {
#pragma unroll
    for (int j = 0; j < 4; ++j) { u32x2 o; o.x = pk2(h[j].x, h[j].y); o.y = pk2(h[j].z, h[j].w); *(u32x2*)(row + 4 * lane + 256 * j) = o; }
}
__device__ __forceinline__ void load_row_fp8(const unsigned char* row, f32x4 (&h)[4], int lane) {
#pragma unroll
    for (int j = 0; j < 4; ++j) { const int w = *(const int*)(row + 4 * lane + 256 * j); const auto lo = __builtin_amdgcn_cvt_pk_f32_fp8(w, false), hi = __builtin_amdgcn_cvt_pk_f32_fp8(w, true);
        h[j] = (f32x4){lo[0], lo[1], hi[0], hi[1]} * 0.03125f; }
}
__device__ __forceinline__ void load_row_bf16(const bf16* row, f32x4 (&h)[4], int lane) {
#pragma unroll
    for (int j = 0; j < 4; ++j) { const u32x2 o = *(const u32x2*)(row + 4 * lane + 256 * j);
        h[j] = (f32x4){bf2f(o.x & 0xffffu), bf2f(o.x >> 16), bf2f(o.y & 0xffffu), bf2f(o.y >> 16)}; }
}


struct TItem { const float* src; bf16* dst; const float* kg; int ldw, K, perm, f8; };
__device__ __forceinline__ void titem_load(const TItem& t, f32x4 (&v)[8], int lane) {
    const float* p = t.src + (size_t)(lane >> 3) * t.ldw + 4 * (lane & 7);
#pragma unroll
    for (int i = 0; i < 8; ++i) v[i] = *(const f32x4*)(p + (size_t)(8 * i) * t.ldw);
}
__device__ __forceinline__ void titem_finish(const TItem& t, const f32x4 (&v)[8], float* scr, int lane) {
    const int rr = lane >> 3, c4 = lane & 7;
#pragma unroll
    for (int i = 0; i < 8; ++i) { f32x4 x = v[i]; if (t.kg) x = x * t.kg[8 * i + rr]; float* d = scr + (8 * i + rr) * 33 + 4 * c4; d[0] = x[0]; d[1] = x[1]; d[2] = x[2]; d[3] = x[3]; }
    asm volatile("s_waitcnt lgkmcnt(0)" ::: "memory");
    const int c = lane & 7;
#pragma unroll
    for (int j = 0; j < 4; ++j) { const int n = (lane >> 3) + 8 * j; const int nl = t.perm ? (16 * ((n >> 2) & 1) + 4 * (n >> 3) + (n & 3)) : n;
        const float* sp = scr + (8 * c) * 33 + nl;
        if (t.f8) { int p0 = __builtin_amdgcn_cvt_pk_fp8_f32(sp[0 * 33] * 32.0f, sp[1 * 33] * 32.0f, 0, false); p0 = __builtin_amdgcn_cvt_pk_fp8_f32(sp[2 * 33] * 32.0f, sp[3 * 33] * 32.0f, p0, true);
            int p1 = __builtin_amdgcn_cvt_pk_fp8_f32(sp[4 * 33] * 32.0f, sp[5 * 33] * 32.0f, 0, false); p1 = __builtin_amdgcn_cvt_pk_fp8_f32(sp[6 * 33] * 32.0f, sp[7 * 33] * 32.0f, p1, true);
            u32x2 o; o.x = (unsigned)p0; o.y = (unsigned)p1; *(u32x2*)((unsigned char*)t.dst + (size_t)n * t.K + 8 * c) = o; }
        else { u32x4 o; o.x = pk2(sp[0 * 33], sp[1 * 33]); o.y = pk2(sp[2 * 33], sp[3 * 33]); o.z = pk2(sp[4 * 33], sp[5 * 33]); o.w = pk2(sp[6 * 33], sp[7 * 33]);
            *(u32x4*)(t.dst + (size_t)n * t.K + 8 * c) = o; } }
    asm volatile("s_waitcnt lgkmcnt(0)" ::: "memory");
}
__device__ __forceinline__ TItem titem_make(const float* W, int ldw, int K, bf16* WT, int k0, int n0, int prow0, const float* kgain, bool perm) {
    TItem t; t.src = W + (size_t)k0 * ldw + n0; t.dst = WT + (size_t)prow0 * K + k0; t.kg = kgain ? kgain + k0 : nullptr; t.ldw = ldw; t.K = K; t.perm = perm ? 1 : 0; t.f8 = 0; return t;
}
constexpr int TI_QKV = 16 * 96, TI_O = 16 * 32, TI_WIN = 16 * 21, TI_UQ = 6 * 48, TI_UKV = 4 * 64, TI_DENSE = TI_QKV + 2 * TI_O + TI_WIN + TI_UQ + TI_UKV, TI_ALL = TI_DENSE + 24576;
__device__ __forceinline__ TItem titem_decode(const Ctx& C, int it) {
    int r = it;
    if (r < TI_QKV) { const int kb = r / 96, lb = r % 96; int pb = lb;
        if (lb < 64) { const int sect = lb >> 5, hm = (lb & 31) >> 1, half = lb & 1; pb = (sect * 4 + (hm >> 2)) * 8 + half * 4 + (hm & 3); }
        return titem_make(as_global(C.in[I_DA_WQKV]), 3072, 1024, (bf16*)(C.ws + WB_QKV), 64 * kb, 32 * lb, 32 * pb, nullptr, false); } r -= TI_QKV;
    if (r < TI_O) return titem_make(as_global(C.in[I_DA_WO]), 1024, 1024, (bf16*)(C.ws + WB_DAO), 64 * (r / 32), 32 * (r % 32), 32 * (r % 32), nullptr, false); r -= TI_O;
    if (r < TI_O) return titem_make(as_global(C.in[I_M_WO]), 1024, 1024, (bf16*)(C.ws + WB_MLO), 64 * (r / 32), 32 * (r % 32), 32 * (r % 32), nullptr, false); r -= TI_O;
    if (r < TI_WIN) { const int kb = r / 21, lb = r % 21; int pb = 18;
        if (lb < 20) { const int wsl = lb >> 1; pb = (wsl >> 2) * 8 + (lb & 1) * 4 + (wsl & 3); }
        return titem_make(as_global(C.in[I_M_WIN]), 672, 1024, (bf16*)(C.ws + WB_WIN), 64 * kb, 32 * lb, 32 * pb, nullptr, lb == 20); } r -= TI_WIN;
    if (r < TI_UQ) { const int kb = r / 48, lb = r % 48, h = lb / 3, part = lb % 3; int pb;
        if (part < 2) pb = (h >> 2) * 8 + part * 4 + (h & 3); else { const int sl = h >> 1; pb = (4 + (sl >> 2)) * 8 + (h & 1) * 4 + (sl & 3); }
        return titem_make(as_global(C.in[I_M_WUQ]), 1536, 384, (bf16*)(C.ws + WB_WUQ), 64 * kb, 32 * lb, 32 * pb, as_global(C.in[I_M_QAN]), part == 2); } r -= TI_UQ;
    if (r < TI_UKV) { const int kb = r / 64, lb = r % 64, h = lb >> 2, part = lb & 3; const int pb = (((part < 2) ? 0 : 4) + (h >> 2)) * 8 + (part & 1) * 4 + (h & 3);
        return titem_make(as_global(C.in[I_M_WUKV]), 2048, 256, (bf16*)(C.ws + WB_WUKV), 64 * kb, 32 * lb, 32 * pb, as_global(C.in[I_M_KVAN]), false); } r -= TI_UKV;
    if (r < 16384) { const int item = r & 63, mat = (r >> 6) & 1, t = (r >> 7) & 1, e = (r >> 8) & 31, l = r >> 13; const int kb = item >> 2, nb = item & 3;
        const float* W = as_global(C.in[mat ? I_E_W3 : I_E_W1]) + (size_t)(l * 32 + e) * 1024 * 256 + 128 * t;
        TItem ti = titem_make(W, 256, 1024, (bf16*)(C.ws + WB_MOE + (size_t)l * 48 * MiB), 64 * kb, 32 * nb, e * 512 + 256 * t + 128 * mat + 32 * nb, nullptr, false);
        ti.f8 = 1; ti.dst = (bf16*)((unsigned char*)(C.ws + WB_MOE + (size_t)l * 48 * MiB) + (size_t)(e * 512 + 256 * t + 128 * mat + 32 * nb) * 1024 + 64 * kb); return ti; }
    r -= 16384;
    { const int item = r & 127, e = (r >> 7) & 31, l = r >> 12; const int kb = item >> 5, nb = item & 31;
      const float* W = as_global(C.in[I_E_W2]) + (size_t)(l * 32 + e) * 256 * 1024;
      return titem_make(W, 1024, 256, (bf16*)(C.ws + WB_MOE + (size_t)l * 48 * MiB + 32 * MiB), 64 * kb, 32 * nb, e * 1024 + 32 * nb, nullptr, false); }
}
__device__ __forceinline__ void ph_prologue(const Ctx& C) {
    {
        float* sc = (float*)C.lds;
        float* red = sc + 16384;
        const float* c = as_global(C.in[I_C]); const float* adaw = as_global(C.in[I_ADAW]); const float* adab = as_global(C.in[I_ADAB]); float* mod = (float*)(C.ws + WS_MOD);
        for (int item = blockIdx.x; item < 384; item += gridDim.x) {
            const int layer = item / 192, r = item % 192, cc = r >> 1, bhf = r & 1;
            __syncthreads();
            for (int idx = C.tid; idx < 16384; idx += NTHR) { const float v = c[(size_t)(bhf * 16) * D + idx]; sc[(idx & 1023) * 16 + (idx >> 10)] = v / (1.0f + expf(-v)); }
            __syncthreads();
            const int col = C.tid & 63, ks = C.tid >> 6;
            f32x4 acc[4];
#pragma unroll
            for (int i = 0; i < 4; ++i) acc[i] = (f32x4){0.f, 0.f, 0.f, 0.f};
            const float* wp = adaw + ((size_t)layer * D + ks * 128) * 6144 + cc * 64 + col;
#pragma unroll 8
            for (int kk = 0; kk < 128; ++kk) {
                const float w = wp[(size_t)kk * 6144]; const float* sp = sc + (ks * 128 + kk) * 16;
#pragma unroll
                for (int i = 0; i < 4; ++i) acc[i] += *(const f32x4*)(sp + 4 * i) * w;
            }
#pragma unroll
            for (int i = 0; i < 16; ++i) red[(ks * 16 + i) * 64 + col] = acc[i >> 2][i & 3];
            __syncthreads();
            for (int o = C.tid; o < 1024; o += NTHR) { const int i = o >> 6, cl = o & 63; float sm = adab[layer * 6144 + cc * 64 + cl];
#pragma unroll
                for (int k2 = 0; k2 < 8; ++k2) sm += red[(k2 * 16 + i) * 64 + cl];
                mod[(size_t)(layer * NB + bhf * 16 + i) * 6144 + cc * 64 + cl] = sm; }
        }
        if (blockIdx.x == 0 && C.wave == 0) {
            const float a = wave_sum(as_global(C.in[I_DA_LQ1])[C.lane] * as_global(C.in[I_DA_LK1])[C.lane]);
            const float b = wave_sum(as_global(C.in[I_DA_LQ2])[C.lane] * as_global(C.in[I_DA_LK2])[C.lane]);
            if (C.lane == 0) *(float*)(C.ws + WS_LAM) = expf(a) - expf(b) + 0.2f;
        }
    }
    __syncthreads();
    {
        float* ivf = (float*)C.lds;
        if (C.tid < 32) ivf[C.tid] = powf(10000.0f, -(float)(2 * C.tid) / 64.0f); else if (C.tid < 48) ivf[C.tid] = powf(10000.0f, -(float)(2 * (C.tid - 32)) / 32.0f);
        __syncthreads();
        const int* pos = (const int*)as_global(C.in[I_POS]);
        float* cosD = (float*)(C.ws + WS_COSD); float* sinD = (float*)(C.ws + WS_SIND); float* cosM = (float*)(C.ws + WS_COSM); float* sinM = (float*)(C.ws + WS_SINM);
        const int gt = blockIdx.x * NTHR + C.tid, ngt = gridDim.x * NTHR;
        for (int idx = gt; idx < NTOK * 32; idx += ngt) {
            const float ang = (float)pos[idx >> 5] * ivf[idx & 31]; float rev = ang * 0.15915494309189535f; rev -= floorf(rev);
            cosD[idx] = __builtin_amdgcn_cosf(rev); sinD[idx] = __builtin_amdgcn_sinf(rev);
        }
        for (int idx = gt; idx < NTOK * 16; idx += ngt) {
            const float ang = (float)pos[idx >> 4] * ivf[32 + (idx & 15)]; float rev = ang * 0.15915494309189535f; rev -= floorf(rev);
            cosM[idx] = __builtin_amdgcn_cosf(rev); sinM[idx] = __builtin_amdgcn_sinf(rev);
        }
        float* wrt = (float*)(C.ws + WS_WRT); const float* wr = as_global(C.in[I_E_WR]);
        for (int idx = gt; idx < 2 * 32 * 1024; idx += ngt) { const int l = idx >> 15, e = (idx >> 10) & 31, k = idx & 1023; wrt[idx] = wr[((size_t)l * 1024 + k) * 32 + e]; }
        for (int idx = gt; idx < 96 * 1024 / 8; idx += ngt) { const int blk = idx / 4096, rem = idx % 4096; const int pb = (blk == 0) ? 19 : 21 + blk;
            *(u32x4*)((bf16*)(C.ws + WB_WIN) + (size_t)pb * 32 * 1024 + (size_t)rem * 8) = (u32x4){0u, 0u, 0u, 0u}; }
    }
    __syncthreads();
    {
        float* scr = (float*)(C.lds + C.wave * 16384);
        f32x4 va[8], vb[8];
#pragma unroll 1
        for (int it = C.gw; it < TI_ALL; it += 2 * C.ngw) {
            const bool hasb = it + C.ngw < TI_ALL;
            const TItem ta = titem_decode(C, it), tb = titem_decode(C, hasb ? it + C.ngw : it);
            titem_load(ta, va, C.lane); if (hasb) titem_load(tb, vb, C.lane);
            titem_finish(ta, va, scr, C.lane); if (hasb) titem_finish(tb, vb, scr, C.lane);
        }
    }
}
__device__ __forceinline__ void ph_normmod0(const Ctx& C) {
    const float* x = as_global(C.in[I_X]); bf16* H = (bf16*)(C.ws + WS_H);
    for (int tok = C.gw; tok < NTOK; tok += C.ngw) {
        const int b = tok / SEQ; f32x4 v[4], h[4];
#pragma unroll
        for (int j = 0; j < 4; ++j) v[j] = *(const f32x4*)(x + (size_t)tok * D + 4 * C.lane + 256 * j);
        normmod_row(v, h, as_global(C.in[I_NMIX]), C.mod(0, b, 0), C.mod(0, b, 1), C.lane);
        store_row_bf16(H + (size_t)tok * D, h, C.lane);
    }
}
template <bool FINAL>
__device__ __forceinline__ void ph_comb(const Ctx& C, const unsigned char* y2, const float* gate_chunk_base  , int nlayer, const float* gnorm) {
    bf16* H = (bf16*)(C.ws + WS_H); const int lane = C.lane;
    for (int chunk = blockIdx.x; chunk < NTOK / 256; chunk += gridDim.x) {
        for (int i = 0; i < 32; ++i) {
            const int tok = chunk * 256 + C.wave * 32 + i, b = tok / SEQ;
            f32x4 v[4], a[4], a2[4];
            load_row_bf16((const bf16*)(C.ws + WS_XB) + (size_t)tok * D, v, lane);
            const float* gate = gate_chunk_base + (size_t)b * 6144;
            load_row_fp8(y2 + (size_t)(2 * tok) * D, a, lane); load_row_fp8(y2 + (size_t)(2 * tok + 1) * D, a2, lane);
#pragma unroll
            for (int j = 0; j < 4; ++j) { const f32x4 gg = *(const f32x4*)(gate + 4 * lane + 256 * j); v[j] += gg * (a[j] + a2[j]);
                if (FINAL) *(f32x4*)(as_global(C.out) + (size_t)tok * D + 4 * lane + 256 * j) = v[j]; }
            if (FINAL) continue;
            store_row_bf16((bf16*)(C.ws + WS_XB) + (size_t)tok * D, v, lane);
            f32x4 h[4];
            normmod_row(v, h, gnorm, C.mod(nlayer, b, 0), C.mod(nlayer, b, 1), lane);
            store_row_bf16(H + (size_t)tok * D, h, lane);
        }
    }
}

constexpr int MOE_TAB_OFF = 131072 + 512;
__device__ __forceinline__ void moe_prefix256(const Ctx& C, int moe_layer, int* cntl, int* tpre) {
    const unsigned* cnt = (const unsigned*)(C.ws + WS_CTL) + CW_CNT + moe_layer * 32 * 64;
    __syncthreads();
    if (C.tid < 32) cntl[C.tid] = (int)__hip_atomic_load(cnt + C.tid * 64, __ATOMIC_RELAXED, __HIP_MEMORY_SCOPE_AGENT);
    __syncthreads();
    if (C.tid == 0) { int s = 0; for (int e = 0; e < 32; ++e) { tpre[e] = s; s += (cntl[e] + 255) >> 8; } tpre[32] = s; }
    __syncthreads();
    if (C.tid < 32) { for (int rt = tpre[C.tid]; rt < tpre[C.tid + 1]; ++rt) tpre[33 + rt] = C.tid; }
    __syncthreads();
}
__device__ __forceinline__ void ph_moe1_mfma(const Ctx& C, int moe_layer) {
    int* cntl = (int*)(C.lds + MOE_TAB_OFF); int* tpre = cntl + 32;
    moe_prefix256(C, moe_layer, cntl, tpre);
    pg8::MoeOrder S{tpre, 2, (int)gridDim.x, (int)blockIdx.x, tpre[32] * 2};
    pg8::EpiMoe1 E{(bf16*)(C.ws + WS_A), (const int*)(C.ws + WS_LIST), (const float*)(C.ws + WS_LISTW), cntl, NTOK};
    int K1 = 1024; asm volatile("" : "+s"(K1));
    pg8::gemm_phase_gather<pg8::EpiMoe1, pg8::MoeOrder, true>((PG8_LAS unsigned char*)C.lds, (const bf16*)(C.ws + WS_H), (const bf16*)(C.ws + WB_MOE + (size_t)moe_layer * 48 * MiB), K1,
                                                        (const int*)(C.ws + WS_LIST), NTOK, cntl, S, E);
}
__device__ __forceinline__ void ph_moe2_mfma(const Ctx& C, int moe_layer) {
    int* cntl = (int*)(C.lds + MOE_TAB_OFF); int* tpre = cntl + 32;
    moe_prefix256(C, moe_layer, cntl, tpre);
    pg8::MoeOrder S{tpre, 4, (int)gridDim.x, (int)blockIdx.x, tpre[32] * 4};
    pg8::EpiMoe2 E{(unsigned char*)(C.ws + WS_A + 128 * MiB), (const int*)(C.ws + WS_LIST), cntl, NTOK};
    int K2 = 256; asm volatile("" : "+s"(K2));
    pg8::Gemm g{(const bf16*)(C.ws + WS_A), (const bf16*)(C.ws + WB_MOE + (size_t)moe_layer * 48 * MiB + 32 * MiB), 0, 0, K2};
    pg8::gemm_phase<pg8::EpiMoe2, pg8::MoeOrder, PG8_ALIGN, PG8_SP2>((PG8_LAS unsigned char*)C.lds, g, S, E);
}

namespace fa {
typedef short bf16x8 __attribute__((ext_vector_type(8)));
typedef short s16x4 __attribute__((ext_vector_type(4)));
typedef float f32x16 __attribute__((ext_vector_type(16)));
typedef __attribute__((address_space(3))) const char* lds_cptr;
__device__ __forceinline__ int crow(int r, int hi) { return (r & 3) + 8 * (r >> 2) + 4 * hi; }
__device__ __forceinline__ s16x4 vtr(lds_cptr p) { return __builtin_bit_cast(s16x4, __builtin_amdgcn_ds_read_tr16_b64_v4i16((__attribute__((address_space(3))) s16x4*)p)); }
typedef float f32x2_t __attribute__((ext_vector_type(2))); typedef __bf16 bf16x2_t __attribute__((ext_vector_type(2)));
__device__ __forceinline__ unsigned cvtpk(float lo, float hi) { f32x2_t v = {lo, hi}; bf16x2_t b = __builtin_convertvector(v, bf16x2_t); return __builtin_bit_cast(unsigned, b); }
__device__ __forceinline__ float half_swap_max(float v) { auto rr = __builtin_amdgcn_permlane32_swap(__float_as_uint(v), __float_as_uint(v), false, false); return fmaxf(__uint_as_float(rr[0]), __uint_as_float(rr[1])); }
__device__ __forceinline__ float half_swap_sum(float v) { auto rr = __builtin_amdgcn_permlane32_swap(__float_as_uint(v), __float_as_uint(v), false, false); return __uint_as_float(rr[0]) + __uint_as_float(rr[1]); }
__device__ __forceinline__ void dma16(const void* gsrc, LAS unsigned char* ldsdst) { unsigned keep; const unsigned dst = (unsigned)__builtin_amdgcn_readfirstlane((int)(unsigned)(uintptr_t)ldsdst);
    asm volatile("s_mov_b32 %0, m0\n\ts_mov_b32 m0, %2\n\ts_nop 0\n\tglobal_load_lds_dwordx4 %1, off\n\ts_mov_b32 m0, %0" : "=&s"(keep) : "v"(gsrc), "s"(dst) : "memory"); }
__device__ __forceinline__ void dma16s(const void* sbase_, unsigned voff, LAS unsigned char* ldsdst) { unsigned keep; const unsigned dst = (unsigned)__builtin_amdgcn_readfirstlane((int)(unsigned)(uintptr_t)ldsdst);
    const unsigned long long sb_ = (unsigned long long)(uintptr_t)sbase_; const unsigned lo_ = (unsigned)__builtin_amdgcn_readfirstlane((int)(unsigned)sb_), hi_ = (unsigned)__builtin_amdgcn_readfirstlane((int)(unsigned)(sb_ >> 32));
    const void* sbase = (const void*)(uintptr_t)(((unsigned long long)hi_ << 32) | lo_);
    asm volatile("s_mov_b32 %0, m0\n\ts_mov_b32 m0, %3\n\ts_nop 0\n\tglobal_load_lds_dwordx4 %1, %2\n\ts_mov_b32 m0, %0" : "=&s"(keep) : "v"(voff), "s"(sbase), "s"(dst) : "memory"); }

template <int ND0, int NDB>
__device__ __forceinline__ void tile(lds_cptr Kslot, lds_cptr Vslot, const bf16x8 (&qf)[ND0], f32x16 (&o)[NDB], f32x16& negm, float& m, float& l,
                                     LAS float* wsf, bool first, bool diag, int qloc, int lane) {
    const int r32 = lane & 31, hi = lane >> 5;
    lds_cptr kb = Kslot + hi * 1024 + r32 * 16;
    bf16x8 kf0[ND0], kf1[ND0];
#pragma unroll
    for (int d0 = 0; d0 < ND0; ++d0) {
        kf0[d0] = *(const __attribute__((address_space(3))) bf16x8*)(kb + d0 * 2048);
        kf1[d0] = *(const __attribute__((address_space(3))) bf16x8*)(kb + d0 * 2048 + 512);
    }
#pragma unroll
    for (int d0 = 0; d0 < ND0; ++d0) asm volatile("" : "+v"(kf0[d0]), "+v"(kf1[d0]));
    f32x16 p0 = __builtin_amdgcn_mfma_f32_32x32x16_bf16(kf0[0], qf[0], negm, 0, 0, 0);
    f32x16 p1 = __builtin_amdgcn_mfma_f32_32x32x16_bf16(kf1[0], qf[0], negm, 0, 0, 0);
#pragma unroll
    for (int d0 = 1; d0 < ND0; ++d0) {
        p0 = __builtin_amdgcn_mfma_f32_32x32x16_bf16(kf0[d0], qf[d0], p0, 0, 0, 0);
        p1 = __builtin_amdgcn_mfma_f32_32x32x16_bf16(kf1[d0], qf[d0], p1, 0, 0, 0);
    }
    __builtin_amdgcn_sched_barrier(0);
    lds_cptr vp = Vslot + ((lane >> 4) & 1) * 32 + (lane & 3) * 8 + (4 * hi + ((lane & 15) >> 2)) * 64;
    constexpr int NE = (NDB < 2 ? NDB : 2) * 4;
    s16x4 vlo[NDB * 4], vhi[NDB * 4];
#pragma unroll
    for (int i = 0; i < NE; ++i) { vlo[i] = vtr(vp + (i >> 2) * 4096 + (i & 3) * 1024); vhi[i] = vtr(vp + (i >> 2) * 4096 + (i & 3) * 1024 + 512); }
    __builtin_amdgcn_sched_barrier(0);
    if (diag) {
#pragma unroll
        for (int r = 0; r < 16; ++r) { const int kv = crow(r, hi); if (kv > qloc) p0[r] = -1e30f; if (kv + 32 > qloc) p1[r] = -1e30f; }
    }
    float mx = fmaxf(fmaxf(p0[0], p1[0]), p0[1]);
#pragma unroll
    for (int r = 1; r < 16; ++r) { if (r > 1) mx = fmaxf(fmaxf(mx, p0[r]), p1[r]); else mx = fmaxf(mx, p1[r]); }
    mx = half_swap_max(mx);
    const bool need = first || (__builtin_amdgcn_ballot_w64(mx > 8.0f) != 0ull);
    if (need) {
        const float dl = first ? mx : fmaxf(mx, 0.f);
        m += dl;
#pragma unroll
        for (int r = 0; r < 16; ++r) { p0[r] -= dl; p1[r] -= dl; negm[r] = -m; }
        if (!first) {
            const float al = __builtin_amdgcn_exp2f(-dl); l *= al;
            if (hi == 0) wsf[r32] = al;
            asm volatile("s_waitcnt lgkmcnt(0)" ::: "memory");
            f32x4 a4[4];
#pragma unroll
            for (int g = 0; g < 4; ++g) a4[g] = *(const LAS f32x4*)(wsf + 8 * g + 4 * hi);
#pragma unroll
            for (int db = 0; db < NDB; ++db)
#pragma unroll
                for (int r = 0; r < 16; ++r) o[db][r] *= a4[r >> 2][r & 3];
        }
    }
    float sum = 0.f;
#pragma unroll
    for (int ks = 0; ks < 4; ++ks) {
        float e[8];
#pragma unroll
        for (int j = 0; j < 8; ++j) { const float x = (ks < 2) ? p0[8 * ks + j] : p1[8 * (ks - 2) + j]; e[j] = __builtin_amdgcn_exp2f(x); }
        sum += ((e[0] + e[1]) + (e[2] + e[3])) + ((e[4] + e[5]) + (e[6] + e[7]));
        u32x4 w; w.x = cvtpk(e[0], e[1]); w.y = cvtpk(e[2], e[3]); w.z = cvtpk(e[4], e[5]); w.w = cvtpk(e[6], e[7]);
        const bf16x8 pa = __builtin_bit_cast(bf16x8, w);
        if (ks == 0 && NE < NDB * 4) {
#pragma unroll
            for (int i = NE; i < NDB * 4; ++i) { vlo[i] = vtr(vp + (i >> 2) * 4096 + (i & 3) * 1024); vhi[i] = vtr(vp + (i >> 2) * 4096 + (i & 3) * 1024 + 512); }
        }
        __builtin_amdgcn_s_setprio(1);
#pragma unroll
        for (int db = 0; db < NDB; ++db) {
            const s16x4 lo = vlo[db * 4 + ks], hh = vhi[db * 4 + ks];
            const bf16x8 vf = (bf16x8){lo[0], lo[1], lo[2], lo[3], hh[0], hh[1], hh[2], hh[3]};
            o[db] = __builtin_amdgcn_mfma_f32_32x32x16_bf16(pa, vf, o[db], 0, 0, 0);
        }
        __builtin_amdgcn_s_setprio(0);
    }
    l += sum;
}
}


__device__ __forceinline__ void ph_route(const Ctx& C, int layer) {
    typedef float f32x16 __attribute__((ext_vector_type(16)));
    LAS float* hT = (LAS float*)C.lds + C.wave * (32 * 68);
    LAS float* rsl = (LAS float*)C.lds + 8 * 32 * 68 + C.wave * 32;
    int* le0 = (int*)(C.lds + 73728); int* le1 = le0 + 256; int* hist = le1 + 256; int* base = hist + 32; float* lw0 = (float*)(base + 32); float* lw1 = lw0 + 256;
    const bf16* x1 = (const bf16*)(C.ws + WS_XB); unsigned char* H8 = C.ws + WS_H; float* listw = (float*)(C.ws + WS_LISTW); int* list = (int*)(C.ws + WS_LIST);
    unsigned* cnt = (unsigned*)(C.ws + WS_CTL) + CW_CNT + layer * 32 * 64;
    const float* ssqx = (const float*)(C.ws + WS_SSQX);
    const float* gn = as_global(C.in[I_NFFN]) + layer * D;
    const float* WrT = (const float*)(C.ws + WS_WRT) + (size_t)layer * 32 * 1024; const float* wg = as_global(C.in[I_E_WG]) + (size_t)layer * D * 4;
    const float* bg = as_global(C.in[I_E_BG]) + layer * 4; const float* br = as_global(C.in[I_E_BR]) + layer * 32;
    const int lane = C.lane, r32 = lane & 31, hi = lane >> 5, w = C.wave, kq = lane & 15, tsub = lane >> 4;
    LAS float* wgl = (LAS float*)(C.lds + 81920);
    __syncthreads();
    for (int idx = C.tid; idx < 1024; idx += NTHR) *(LAS f32x4*)(wgl + idx * 4) = *(const f32x4*)(wg + (size_t)idx * 4);
    for (int chunk = blockIdx.x; chunk < NTOK / 256; chunk += gridDim.x) {
        __syncthreads();
        if (C.tid < 32) hist[C.tid] = 0;
        const int tok0 = chunk * 256 + w * 32, b = tok0 >> 11;
        const float* shp = C.mod(layer, b, 3); const float* scp = C.mod(layer, b, 4);
        { const float* sp = ssqx + (size_t)(tok0 + r32) * 16; const f32x4 s0 = *(const f32x4*)sp, s1 = *(const f32x4*)(sp + 4), s2 = *(const f32x4*)(sp + 8), s3 = *(const f32x4*)(sp + 12);
          const float sm = ((s0[0] + s0[1]) + (s0[2] + s0[3])) + ((s1[0] + s1[1]) + (s1[2] + s1[3])) + ((s2[0] + s2[1]) + (s2[2] + s2[3])) + ((s3[0] + s3[1]) + (s3[2] + s3[3]));
          if (hi == 0) rsl[r32] = 1.0f / sqrtf(sm * (1.0f / D) + EPS); }
        f32x16 acc;
#pragma unroll
        for (int r = 0; r < 16; ++r) acc[r] = 0.f;
        float gl[4] = {0.f, 0.f, 0.f, 0.f};
        const unsigned xoff = (unsigned)(tok0 + tsub) * 1024u + 4u * kq;
        const unsigned woff = (unsigned)r32 * 1024u + 4u * hi;
        f32x4 X[8], Wa[8], Wb[8];
#define RT_LOADX(kc_) do { _Pragma("unroll") for (int i = 0; i < 8; ++i) { const u32x2 w_ = *(const u32x2*)(x1 + (xoff + 4096u * i + 64u * (kc_))); \
            X[i] = (f32x4){__uint_as_float(w_.x << 16), __uint_as_float(w_.x & 0xffff0000u), __uint_as_float(w_.y << 16), __uint_as_float(w_.y & 0xffff0000u)}; } } while (0)
#define RT_LOADW(W, kc_) do { _Pragma("unroll") for (int c = 0; c < 8; ++c) W[c] = *(const f32x4*)(WrT + (woff + 64u * (kc_) + 8u * c)); } while (0)
#define RT_STEP(W, WN, kc_) do { const unsigned k4 = 64u * (kc_) + 4u * kq; \
            const f32x4 g4 = *(const f32x4*)(gn + k4), sc4 = *(const f32x4*)(scp + k4), sh4 = *(const f32x4*)(shp + k4); const f32x4 gm4 = g4 * (sc4 + 1.0f); \
            _Pragma("unroll") for (int i = 0; i < 8; ++i) { const int tl = 4 * i + tsub; const float rsd = rsl[tl]; const f32x4 h4 = (X[i] * rsd) * gm4 + sh4; \
                int o8 = __builtin_amdgcn_cvt_pk_fp8_f32(h4[0], h4[1], 0, false); o8 = __builtin_amdgcn_cvt_pk_fp8_f32(h4[2], h4[3], o8, true); *(int*)(H8 + (xoff + 4096u * i + 64u * (kc_))) = o8; *(LAS f32x4*)(hT + tl * 68 + 4 * kq) = h4; } \
            if ((kc_) + 1 < 16) { RT_LOADX((kc_) + 1); RT_LOADW(WN, (kc_) + 1); } \
            _Pragma("unroll") for (int c = 0; c < 8; ++c) { const f32x4 b4 = *(const LAS f32x4*)(hT + r32 * 68 + 8 * c + 4 * hi); \
                _Pragma("unroll") for (int j = 0; j < 4; ++j) { acc = __builtin_amdgcn_mfma_f32_32x32x2f32(W[c][j], b4[j], acc, 0, 0, 0); \
                    const f32x4 w4 = *(const LAS f32x4*)(wgl + (64 * (kc_) + 8 * c + 4 * hi + j) * 4); \
                    _Pragma("unroll") for (int q = 0; q < 4; ++q) gl[q] += b4[j] * w4[q]; } asm volatile("" : "+v"(gl[0]), "+v"(gl[1]), "+v"(gl[2]), "+v"(gl[3])); } } while (0)
        RT_LOADX(0); RT_LOADW(Wa, 0);
#pragma unroll 1
        for (int kc = 0; kc < 16; kc += 2) {
            RT_STEP(Wa, Wb, kc);
            RT_STEP(Wb, Wa, kc + 1);
        }
#undef RT_LOADX
#undef RT_LOADW
#undef RT_STEP
#pragma unroll
        for (int q = 0; q < 4; ++q) gl[q] = fa::half_swap_sum(gl[q]);
        float gp[4]; { const float gm = fmaxf(fmaxf(gl[0], gl[1]), fmaxf(gl[2], gl[3])); float gs = 0.f;
#pragma unroll
            for (int g = 0; g < 4; ++g) { gp[g] = expf(gl[g] - gm); gs += gp[g]; }
#pragma unroll
            for (int g = 0; g < 4; ++g) gp[g] /= gs; }
        int gi = 0; float best = -1e30f, gate = 0.f;
#pragma unroll
        for (int g = 0; g < 4; ++g) { const float sv = gp[g] + bg[g]; if (sv > best) { best = sv; gi = g; gate = gp[g]; } }
        float el[8];
#pragma unroll
        for (int j = 0; j < 4; ++j) { const float own = (gi == 0) ? acc[j] : (gi == 1) ? acc[4 + j] : (gi == 2) ? acc[8 + j] : acc[12 + j];
            auto rr = __builtin_amdgcn_permlane32_swap(__float_as_uint(own), __float_as_uint(own), false, false);
            el[j] = __uint_as_float(rr[0]); el[4 + j] = __uint_as_float(rr[1]); }
        float em = el[0];
#pragma unroll
        for (int e = 1; e < 8; ++e) em = fmaxf(em, el[e]);
        float ep[8], es = 0.f;
#pragma unroll
        for (int e = 0; e < 8; ++e) { ep[e] = expf(el[e] - em); es += ep[e]; }
        int i0 = 0; float b0 = -1e30f, p0 = 0.f;
#pragma unroll
        for (int e = 0; e < 8; ++e) { ep[e] /= es; const float sv = ep[e] + br[gi * 8 + e]; if (sv > b0) { b0 = sv; i0 = e; p0 = ep[e]; } }
        int i1 = 0; float b1 = -1e30f, p1 = 0.f;
#pragma unroll
        for (int e = 0; e < 8; ++e) { const float sv = ep[e] + br[gi * 8 + e]; if (e != i0 && sv > b1) { b1 = sv; i1 = e; p1 = ep[e]; } }
        const float den = p0 + p1;
        if (hi == 0) { const int tl = w * 32 + r32; le0[tl] = gi * 8 + i0; le1[tl] = gi * 8 + i1; lw0[tl] = p0 / den * gate; lw1[tl] = p1 / den * gate; }
        __syncthreads();
        int e0 = 0, e1 = 0, q0 = 0, q1 = 0;
        if (C.tid < 256) { e0 = le0[C.tid]; e1 = le1[C.tid]; q0 = atomicAdd(&hist[e0], 1); q1 = atomicAdd(&hist[e1], 1); }
        __syncthreads();
        if (C.tid < 32) base[C.tid] = (int)__hip_atomic_fetch_add(cnt + C.tid * 64, (unsigned)hist[C.tid], __ATOMIC_RELAXED, __HIP_MEMORY_SCOPE_AGENT);
        __syncthreads();
        if (C.tid < 256) { const int tok = chunk * 256 + C.tid;
            const size_t i0_ = (size_t)e0 * NTOK + base[e0] + q0, i1_ = (size_t)e1 * NTOK + base[e1] + q1;
            list[i0_] = 2 * tok; list[i1_] = 2 * tok + 1; listw[i0_] = lw0[C.tid]; listw[i1_] = lw1[C.tid]; }
    }
}

__device__ __forceinline__ void ph_attn_da_mfma(const Ctx& C) {
    using namespace fa;
    LAS unsigned char* L = (LAS unsigned char*)C.lds;
    constexpr int STG = 32768;
    LAS float* wsf = (LAS float*)(L + 3 * STG) + C.wave * 32;
    const int vcu = ((int)blockIdx.x & 7) * 32 + ((int)blockIdx.x >> 3), xcd = vcu >> 5, grp = (vcu >> 4) & 1, jj = vcu & 15;
    const bf16* Q = (const bf16*)(C.ws + WS_A); const bf16* Kb = Q + (size_t)NTOK * D; const bf16* Vb = Kb + (size_t)NTOK * D; bf16* O = (bf16*)(C.ws + WS_O);
    const float lam = *(const float*)(C.ws + WS_LAM);
    const int lane = C.lane, w = C.wave, c = w >> 2, wq = w & 3, r32 = lane & 31, hi = lane >> 5;
    const float c2 = 0.125f * 1.4426950408889634f;
    for (int u = 0; u < 16; ++u) {
        const int bh = xcd * 32 + 2 * u + grp, b = bh >> 3, h = bh & 7, qb = (u & 1) ? 15 - jj : jj, q0 = qb * 128;
        const size_t rowb = (size_t)b * SEQ;
        const int NT = (q0 + 128) / 64, qw0 = q0 + 32 * wq, T = qw0 >> 6;
        const bf16* sbase = (w < 4 ? Kb : Vb) + rowb * D;
        unsigned soff[4]; int dsto[4];
#pragma unroll
        for (int i = 0; i < 4; ++i) {
            if (w < 4) { const int cm = w >> 1, ch = (w & 1) * 4 + i; soff[i] = (unsigned)((lane * D + (2 * h + cm) * 64 + ch * 8) * 2); dsto[i] = cm * 8192 + ch * 1024; }
            else { const int db = w - 4, rg = i; soff[i] = (unsigned)(((rg * 16 + (lane >> 2)) * D + h * 128 + db * 32 + (lane & 3) * 8) * 2); dsto[i] = 16384 + db * 4096 + rg * 1024; }
        }
        bf16x8 qf[4];
#pragma unroll
        for (int d0 = 0; d0 < 4; ++d0) qf[d0] = *(const bf16x8*)(Q + (rowb + qw0 + r32) * D + (2 * h + c) * 64 + d0 * 16 + hi * 8);
#pragma unroll
        for (int d0 = 0; d0 < 4; ++d0) asm volatile("" : "+v"(qf[d0]));
        f32x16 o[4];
#pragma unroll
        for (int db = 0; db < 4; ++db)
#pragma unroll
            for (int r = 0; r < 16; ++r) o[db][r] = 0.f;
        float m = 0.f, l = 0.f; f32x16 negm;
#pragma unroll
        for (int r = 0; r < 16; ++r) negm[r] = 0.f;
        asm volatile("s_waitcnt lgkmcnt(0)" ::: "memory"); __builtin_amdgcn_s_barrier();
#pragma unroll
        for (int i = 0; i < 4; ++i) dma16s(sbase, soff[i], L + dsto[i]);
#pragma unroll
        for (int i = 0; i < 4; ++i) dma16s(sbase + (size_t)64 * D, soff[i], L + STG + dsto[i]);
        int sc_ = 0, sn_ = 2;
        for (int t = 0; t < NT; ++t) {
            if (t + 1 < NT) asm volatile("s_waitcnt vmcnt(4) lgkmcnt(0)" ::: "memory"); else asm volatile("s_waitcnt vmcnt(0) lgkmcnt(0)" ::: "memory");
            __builtin_amdgcn_s_barrier();
            if (t + 2 < NT) {
#pragma unroll
                for (int i = 0; i < 4; ++i) dma16s(sbase + (size_t)(t + 2) * 64 * D, soff[i], L + sn_ * STG + dsto[i]);
            }
            if (t <= T) {
                lds_cptr stg = (lds_cptr)L + sc_ * STG;
                tile<4, 4>(stg + c * 8192, stg + 16384, qf, o, negm, m, l, wsf, t == 0, t == T, qw0 - 64 * T + r32, lane);
            }
            sc_ = (sc_ == 2) ? 0 : sc_ + 1; sn_ = (sn_ == 2) ? 0 : sn_ + 1;
        }
        l = half_swap_sum(l);
        if (hi == 0) wsf[r32] = 1.0f / l;
        asm volatile("s_waitcnt lgkmcnt(0)" ::: "memory");
        f32x4 a4[4];
#pragma unroll
        for (int g = 0; g < 4; ++g) a4[g] = *(const LAS f32x4*)(wsf + 8 * g + 4 * hi);
#pragma unroll
        for (int db = 0; db < 4; ++db)
#pragma unroll
            for (int r = 0; r < 16; ++r) o[db][r] *= a4[r >> 2][r & 3];
        asm volatile("s_waitcnt lgkmcnt(0)" ::: "memory"); __builtin_amdgcn_s_barrier();
        LAS float* X = (LAS float*)L + wq * 4352 + lane * 68;
        if (c == 1) {
#pragma unroll
            for (int db = 0; db < 4; ++db)
#pragma unroll
                for (int g = 0; g < 4; ++g) *(LAS f32x4*)(X + db * 16 + 4 * g) = (f32x4){o[db][4 * g], o[db][4 * g + 1], o[db][4 * g + 2], o[db][4 * g + 3]};
        }
        asm volatile("s_waitcnt lgkmcnt(0)" ::: "memory"); __builtin_amdgcn_s_barrier();
        if (c == 0) {
            float gsub[4];
#pragma unroll
            for (int db = 0; db < 4; ++db) gsub[db] = as_global(C.in[I_DA_SUBLN])[db * 32 + r32] * 0.8f;
#pragma unroll
            for (int db = 0; db < 4; ++db)
#pragma unroll
                for (int g = 0; g < 4; ++g) { const f32x4 x = *(const LAS f32x4*)(X + db * 16 + 4 * g);
#pragma unroll
                    for (int j2 = 0; j2 < 4; ++j2) o[db][4 * g + j2] -= lam * x[j2]; }
            float uu[8];
#pragma unroll
            for (int r = 0; r < 8; ++r) {
                const float sa = (o[0][r] * o[0][r] + o[1][r] * o[1][r]) + (o[2][r] * o[2][r] + o[3][r] * o[3][r]);
                const float sb = (o[0][r + 8] * o[0][r + 8] + o[1][r + 8] * o[1][r + 8]) + (o[2][r + 8] * o[2][r + 8] + o[3][r + 8] * o[3][r + 8]);
                auto sw = __builtin_amdgcn_permlane16_swap(__float_as_uint(sa), __float_as_uint(sb), false, false);
                uu[r] = __uint_as_float(sw[0]) + __uint_as_float(sw[1]);
            }
#pragma unroll
            for (int r = 0; r < 8; ++r) {
                uu[r] += __uint_as_float((unsigned)__builtin_amdgcn_update_dpp(0, (int)__float_as_uint(uu[r]), 0x128, 0xF, 0xF, true));
                uu[r] += __uint_as_float((unsigned)__builtin_amdgcn_update_dpp(0, (int)__float_as_uint(uu[r]), 0x124, 0xF, 0xF, true));
                uu[r] += __uint_as_float((unsigned)__builtin_amdgcn_update_dpp(0, (int)__float_as_uint(uu[r]), 0x122, 0xF, 0xF, true));
                uu[r] += __uint_as_float((unsigned)__builtin_amdgcn_update_dpp(0, (int)__float_as_uint(uu[r]), 0x121, 0xF, 0xF, true));
                uu[r] = __builtin_amdgcn_rsqf(uu[r] * (1.0f / 128.0f) + EPS);
            }
            float rs[16];
#pragma unroll
            for (int r = 0; r < 8; ++r) { auto sw = __builtin_amdgcn_permlane16_swap(__float_as_uint(uu[r]), __float_as_uint(uu[r]), false, false); rs[r] = __uint_as_float(sw[0]); rs[r + 8] = __uint_as_float(sw[1]); }
            asm volatile("s_waitcnt lgkmcnt(0)" ::: "memory");
            LAS unsigned char* TT = (LAS unsigned char*)((LAS float*)L + wq * 4352);
#pragma unroll
            for (int r = 0; r < 16; ++r) {
                const unsigned p01 = cvtpk(o[0][r] * (rs[r] * gsub[0]), o[1][r] * (rs[r] * gsub[1])), p23 = cvtpk(o[2][r] * (rs[r] * gsub[2]), o[3][r] * (rs[r] * gsub[3]));
                LAS unsigned short* tp = (LAS unsigned short*)(TT + crow(r, hi) * 272 + r32 * 2);
                tp[0] = (unsigned short)p01; tp[32] = (unsigned short)(p01 >> 16); tp[64] = (unsigned short)p23; tp[96] = (unsigned short)(p23 >> 16);
            }
            asm volatile("s_waitcnt lgkmcnt(0)" ::: "memory");
#pragma unroll
            for (int i = 0; i < 8; ++i) {
                const int row = 4 * i + (lane >> 4);
                const u32x4 v = *(const LAS u32x4*)(TT + row * 272 + (lane & 15) * 16);
                *(u32x4*)(O + (rowb + qw0 + row) * D + h * 128 + (lane & 15) * 8) = v;
            }
        }
    }
}
__device__ __forceinline__ void ph_attn_mla_mfma(const Ctx& C) {
    using namespace fa;
    LAS unsigned char* L = (LAS unsigned char*)C.lds;
    constexpr int STG = 20480;
    LAS float* wsf = (LAS float*)(L + 3 * STG) + C.wave * 32;
    const int vcu = ((int)blockIdx.x & 7) * 32 + ((int)blockIdx.x >> 3), xcd = vcu >> 5, grp = (vcu >> 3) & 3, jj = vcu & 7;
    const bf16* Q2 = (const bf16*)(C.ws + WS_A); const bf16* KV2 = (const bf16*)(C.ws + WS_A + 192 * MiB);
    const bf16* KPE = (const bf16*)(C.ws + WS_KPE); bf16* O = (bf16*)(C.ws + WS_O);
    const int lane = C.lane, w = C.wave, r32 = lane & 31, hi = lane >> 5;
    const float c2 = 0.10206207261596575f * 1.4426950408889634f;
    for (int u = 0; u < 16; ++u) {
        const int bh = xcd * 64 + 4 * u + grp, b = bh >> 4, h = bh & 15, qb = (u & 1) ? 7 - jj : jj, q0 = qb * 256;
        const size_t rowb = (size_t)b * SEQ;
        const int NT = (q0 + 256) / 64, qw0 = q0 + 32 * w, T = qw0 >> 6;
        const bf16* src[3]; int dsto[3]; size_t sstep[3];
#pragma unroll
        for (int i = 0; i < 3; ++i) {
            const int pi = w + 8 * i;
            if (pi < 8) { src[i] = KV2 + (rowb + lane) * 2048 + h * 128 + pi * 8; dsto[i] = pi * 1024; sstep[i] = (size_t)64 * 2048; }
            else if (pi < 12) { src[i] = KPE + (rowb + lane) * 32 + (pi - 8) * 8; dsto[i] = pi * 1024; sstep[i] = (size_t)64 * 32; }
            else { const int db = (pi - 12) >> 2, rg = (pi - 12) & 3; src[i] = KV2 + (rowb + rg * 16 + (lane >> 2)) * 2048 + h * 128 + 64 + db * 32 + (lane & 3) * 8; dsto[i] = 12288 + db * 4096 + rg * 1024; sstep[i] = (size_t)64 * 2048; }
        }
        const bool has3 = (w + 16) < 20;
        bf16x8 qf[6];
#pragma unroll
        for (int d0 = 0; d0 < 6; ++d0) qf[d0] = *(const bf16x8*)(Q2 + (rowb + qw0 + r32) * 1536 + h * 96 + d0 * 16 + hi * 8);
#pragma unroll
        for (int d0 = 0; d0 < 6; ++d0) asm volatile("" : "+v"(qf[d0]));
        f32x16 o[2];
#pragma unroll
        for (int db = 0; db < 2; ++db)
#pragma unroll
            for (int r = 0; r < 16; ++r) o[db][r] = 0.f;
        float m = 0.f, l = 0.f; f32x16 negm;
#pragma unroll
        for (int r = 0; r < 16; ++r) negm[r] = 0.f;
        asm volatile("s_waitcnt lgkmcnt(0)" ::: "memory"); __builtin_amdgcn_s_barrier();
        dma16(src[0], L + dsto[0]); dma16(src[1], L + dsto[1]); if (has3) dma16(src[2], L + dsto[2]);
        dma16(src[0] + sstep[0], L + STG + dsto[0]); dma16(src[1] + sstep[1], L + STG + dsto[1]); if (has3) dma16(src[2] + sstep[2], L + STG + dsto[2]);
        int sc_ = 0, sn_ = 2;
        for (int t = 0; t < NT; ++t) {
            if (t + 1 < NT) { if (has3) asm volatile("s_waitcnt vmcnt(3) lgkmcnt(0)" ::: "memory"); else asm volatile("s_waitcnt vmcnt(2) lgkmcnt(0)" ::: "memory"); }
            else asm volatile("s_waitcnt vmcnt(0) lgkmcnt(0)" ::: "memory");
            __builtin_amdgcn_s_barrier();
            if (t + 2 < NT) {
                LAS unsigned char* nb = L + sn_ * STG;
                dma16(src[0] + (t + 2) * sstep[0], nb + dsto[0]); dma16(src[1] + (t + 2) * sstep[1], nb + dsto[1]); if (has3) dma16(src[2] + (t + 2) * sstep[2], nb + dsto[2]);
            }
            if (t <= T) {
                lds_cptr stg = (lds_cptr)L + sc_ * STG;
                tile<6, 2>(stg, stg + 12288, qf, o, negm, m, l, wsf, t == 0, t == T, qw0 - 64 * T + r32, lane);
            }
            sc_ = (sc_ == 2) ? 0 : sc_ + 1; sn_ = (sn_ == 2) ? 0 : sn_ + 1;
        }
        l = half_swap_sum(l);
        if (hi == 0) wsf[r32] = 1.0f / l;
        asm volatile("s_waitcnt lgkmcnt(0)" ::: "memory");
        f32x4 a4[4];
#pragma unroll
        for (int g = 0; g < 4; ++g) a4[g] = *(const LAS f32x4*)(wsf + 8 * g + 4 * hi);
        LAS unsigned char* TT = L + 65536 + w * 4608;
#pragma unroll
        for (int r = 0; r < 16; ++r) {
            const unsigned pk = cvtpk(o[0][r] * a4[r >> 2][r & 3], o[1][r] * a4[r >> 2][r & 3]);
            LAS unsigned short* tp = (LAS unsigned short*)(TT + crow(r, hi) * 144 + r32 * 2);
            tp[0] = (unsigned short)pk; tp[32] = (unsigned short)(pk >> 16);
        }
        asm volatile("s_waitcnt lgkmcnt(0)" ::: "memory");
#pragma unroll
        for (int i = 0; i < 4; ++i) {
            const int row = 8 * i + (lane >> 3);
            const u32x4 v = *(const LAS u32x4*)(TT + row * 144 + (lane & 7) * 16);
            *(u32x4*)(O + (rowb + qw0 + row) * D + h * 64 + (lane & 7) * 8) = v;
        }
    }
}

__global__ void __launch_bounds__(NTHR, 2) fwd(Args args) {
    extern __shared__ __attribute__((aligned(16))) unsigned char lds[];
    Ctx C; C.in = args.in; C.out = args.out; C.ws = args.ws; C.lds = lds;
    C.tid = threadIdx.x; C.lane = C.tid & 63; C.wave = __builtin_amdgcn_readfirstlane(C.tid >> 6);
    C.gw = blockIdx.x * NWAVES + C.wave; C.ngw = gridDim.x * NWAVES;
    const Ctx C0 = C;
    volatile LAS unsigned* MISC = (volatile LAS unsigned*)((LAS unsigned char*)lds + MISC_OFF);
    if (C.tid < 32) MISC[C.tid] = 0u;
    __syncthreads();
    XcdBarrier bar; bar.bar = (unsigned*)(args.ws + WS_CTL) + CW_BAR; bar.x = 0; bar.st = nullptr;
    const int lo = args.ph_lo, hi = args.ph_hi;
    if (hi - lo > 1) bar = xcd_barrier_post((unsigned*)(args.ws + WS_CTL) + CW_BAR, MISC + 8);
#ifndef REPMASK
#define REPMASK 0u
#endif
#ifndef PHMASK
#define PHMASK 0xFFFFFFFFu
#endif
#define IN(k) (lo <= (k) && (k) < hi && ((PHMASK >> (k)) & 1u))
#define SEAM(k) do { if (IN(k) && IN((k) + 1)) xcd_barrier(bar); } while (0)
#define PHLOCAL unsigned char* ws = args.ws; asm volatile("" : "+s"(ws)); ws = as_global(ws); int t_ = threadIdx.x; asm volatile("" : "+v"(t_)); Ctx C = C0; C.ws = ws; C.tid = t_; C.lane = t_ & 63; \
        bf16* H = (bf16*)(ws + WS_H); bf16* O = (bf16*)(ws + WS_O); bf16* A0 = (bf16*)(ws + WS_A); (void)H; (void)O; (void)A0;

    if (IN(0)) { PHLOCAL ph_prologue(C); } SEAM(0);
    if (IN(1)) { PHLOCAL ph_normmod0(C); } SEAM(1);
    if (IN(2)) { PHLOCAL
        pg8::Gemm g{H, (const bf16*)(ws + WB_QKV), NTOK, 3 * D, D}; pg8::StaticOrder S; S.init(NTOK, 3 * D, (int)gridDim.x, (int)blockIdx.x);
        pg8::EpiQKV E{A0, A0 + (size_t)NTOK * D, A0 + (size_t)2 * NTOK * D, (const float*)(ws + WS_COSD), (const float*)(ws + WS_SIND), as_global(args.in[I_DA_QN]), as_global(args.in[I_DA_KN]), 0.125f * 1.4426950408889634f, EPS};
        pg8::gemm_phase<pg8::EpiQKV, pg8::StaticOrder, PG8_ALIGN, PG8_SP2>((PG8_LAS unsigned char*)lds, g, S, E);
    } SEAM(2);
    if (IN(3)) { PHLOCAL ph_attn_da_mfma(C); } SEAM(3);
    if (IN(4)) { PHLOCAL
        pg8::Gemm g{O, (const bf16*)(ws + WB_DAO), NTOK, D, D}; pg8::StaticOrder S; S.init(NTOK, D, (int)gridDim.x, (int)blockIdx.x);
        pg8::EpiResid<true> E{as_global(args.in[I_X]), (bf16*)(ws + WS_XB), C.mod(0, 0, 2), (float*)(ws + WS_SSQX)};
        pg8::gemm_phase<pg8::EpiResid<true>, pg8::StaticOrder, PG8_ALIGN, PG8_SP2>((PG8_LAS unsigned char*)lds, g, S, E);
    } SEAM(4);
    if (IN(5)) { PHLOCAL ph_route(C, 0); } SEAM(5);
    if (IN(6)) { PHLOCAL ph_moe1_mfma(C, 0); } SEAM(6);
    if (IN(7)) { PHLOCAL ph_moe2_mfma(C, 0); } SEAM(7);
    if (IN(8)) { PHLOCAL ph_comb<false>(C, ws + WS_A + 128 * MiB, C.mod(0, 0, 5), 1, as_global(args.in[I_NMIX]) + D); } SEAM(8);
    if (IN(9)) { PHLOCAL
        bf16* CQ = (bf16*)(ws + WS_S); bf16* CKV = CQ + (size_t)NTOK * 384; bf16* KPE = (bf16*)(ws + WS_KPE);
        pg8::Gemm g{H, (const bf16*)(ws + WB_WIN), NTOK, 768, D}; pg8::StaticOrder S; S.init(NTOK, 768, (int)gridDim.x, (int)blockIdx.x);
        pg8::EpiWin E{CQ, CKV, KPE, (float*)(ws + WS_SSQ), (const float*)(ws + WS_COSM), (const float*)(ws + WS_SINM), as_global(args.in[I_M_KPN]), EPS};
        pg8::gemm_phase<pg8::EpiWin, pg8::StaticOrder, PG8_ALIGN, PG8_SP2>((PG8_LAS unsigned char*)lds, g, S, E);
    } SEAM(9);
    if (IN(10)) { PHLOCAL
        const bf16* CQ = (const bf16*)(ws + WS_S); const bf16* CKV = CQ + (size_t)NTOK * 384;
        int Kq = 384, Kkv = 256; asm volatile("" : "+s"(Kq), "+s"(Kkv));
        { pg8::Gemm g{CQ, (const bf16*)(ws + WB_WUQ), NTOK, 1536, Kq}; pg8::StaticOrder S; S.init(NTOK, 1536, (int)gridDim.x, (int)blockIdx.x);
          pg8::EpiUQ E{A0, (const float*)(ws + WS_SSQ), (const float*)(ws + WS_COSM), (const float*)(ws + WS_SINM), as_global(args.in[I_M_QNN]), as_global(args.in[I_M_QPN]), 0.10206207261596575f * 1.4426950408889634f, EPS};
          pg8::gemm_phase<pg8::EpiUQ, pg8::StaticOrder, PG8_ALIGN, PG8_SP2>((PG8_LAS unsigned char*)lds, g, S, E); }
        { pg8::Gemm g{CKV, (const bf16*)(ws + WB_WUKV), NTOK, 2048, Kkv}; pg8::StaticOrder S; S.init(NTOK, 2048, (int)gridDim.x, (int)blockIdx.x);
          pg8::EpiUKV E{(bf16*)(ws + WS_A + 192 * MiB), (const float*)(ws + WS_SSQ), as_global(args.in[I_M_KNN]), EPS};
          pg8::gemm_phase<pg8::EpiUKV, pg8::StaticOrder, PG8_ALIGN, PG8_SP2>((PG8_LAS unsigned char*)lds, g, S, E); }
    } SEAM(10);
    if (IN(11)) { PHLOCAL ph_attn_mla_mfma(C); } SEAM(11);
    if (IN(12)) { PHLOCAL
        pg8::Gemm g{O, (const bf16*)(ws + WB_MLO), NTOK, D, D}; pg8::StaticOrder S; S.init(NTOK, D, (int)gridDim.x, (int)blockIdx.x);
        pg8::EpiResid<false> E{ws + WS_XB, (bf16*)(ws + WS_XB), C.mod(1, 0, 2), (float*)(ws + WS_SSQX)};
        pg8::gemm_phase<pg8::EpiResid<false>, pg8::StaticOrder, PG8_ALIGN, PG8_SP2>((PG8_LAS unsigned char*)lds, g, S, E);
    } SEAM(12);
    if (IN(13)) { PHLOCAL ph_route(C, 1); } SEAM(13);
    if (IN(14)) { PHLOCAL ph_moe1_mfma(C, 1); } SEAM(14);
    if (IN(15)) { PHLOCAL ph_moe2_mfma(C, 1); } SEAM(15);
    if (IN(16)) { PHLOCAL ph_comb<true>(C, ws + WS_A + 128 * MiB, C.mod(1, 0, 5), 1, as_global(args.in[I_NMIX])); }
#undef IN
#undef SEAM
}

extern "C" void kernel_launch(void* const* d_in, const int* in_sizes, int n_in, void* d_out, int out_size, void* d_ws, size_t ws_size, hipStream_t stream) {
    static int grid = 0;
    if (grid == 0) {
        if (n_in != 33 || out_size != NTOK * D || ws_size < WS_END) { fprintf(stderr, "kernel_launch: unexpected shapes n_in %d out %d ws %zu\n", n_in, out_size, ws_size); grid = -1; return; }
        int dev = 0, cus = 0;
        if (hipGetDevice(&dev) != hipSuccess || hipDeviceGetAttribute(&cus, hipDeviceAttributeMultiprocessorCount, dev) != hipSuccess) { grid = -1; return; }
        if (hipFuncSetAttribute((const void*)fwd, hipFuncAttributeMaxDynamicSharedMemorySize, LDS_BYTES) != hipSuccess) { fprintf(stderr, "hipFuncSetAttribute failed\n"); grid = -1; return; }
        (void)hipGetLastError();
        grid = cus;
        if (grid != 256) { fprintf(stderr, "kernel_launch: built for 256 CUs, device reports %d\n", cus); grid = -1; return; }
    }
    if (grid < 0) return;
    (void)hipMemsetAsync((char*)d_ws + WS_CTL, 0, CTL_ZERO_BYTES, stream);
    Args a{};
    for (int i = 0; i < 33; ++i) a.in[i] = (const float*)d_in[i];
    a.out = (float*)d_out; a.ws = (unsigned char*)d_ws;
#if MK_ONE_LAUNCH
    a.ph_lo = 0; a.ph_hi = N_PHASES;
    hipLaunchKernelGGL(fwd, dim3(grid), dim3(NTHR), LDS_BYTES, stream, a);
#else
    for (int p = 0; p < N_PHASES; ++p) { a.ph_lo = p; a.ph_hi = p + 1; hipLaunchKernelGGL(fwd, dim3(grid), dim3(NTHR), LDS_BYTES, stream, a); }
#endif
}
```

```cpp
#include <hip/hip_runtime.h>
#include <cstdio>
#include <cstdint>

#define LAS __attribute__((address_space(3)))
#define GAS __attribute__((address_space(1)))
template <class T> __device__ __forceinline__ T* as_global(T* p) { GAS T* g = (GAS T*)p; asm("" : "+s"(g)); return (T*)g; }
typedef unsigned short bf16;
typedef float f32x4 __attribute__((ext_vector_type(4)));
typedef unsigned u32x4 __attribute__((ext_vector_type(4)));
typedef unsigned u32x2 __attribute__((ext_vector_type(2)));

constexpr int NB = 32, SEQ = 2048, D = 1024, NTOK = NB * SEQ;
constexpr float EPS = 1e-6f;
constexpr int NWAVES = 8, NTHR = 512;
constexpr int N_PHASES = 17;
#ifndef MK_ONE_LAUNCH
#define MK_ONE_LAUNCH 1
#endif

constexpr size_t MiB = 1u << 20;
constexpr size_t WS_CTL = 0, CTL_ZERO_BYTES = 1 * MiB;
constexpr size_t WS_MOD = 1 * MiB;
constexpr size_t WS_LAM = WS_MOD + 7 * MiB / 4;
constexpr size_t WS_SSQX = 4 * MiB;
constexpr size_t WS_SSQ = 8 * MiB;
constexpr size_t WS_WRT = 12 * MiB;
constexpr size_t WS_COSD = 16 * MiB, WS_SIND = 24 * MiB, WS_COSM = 32 * MiB, WS_SINM = 36 * MiB;
constexpr size_t WS_TOKW = 40 * MiB;
constexpr size_t WS_LIST = 42 * MiB;
constexpr size_t WS_WB = 50 * MiB;
constexpr size_t WB_QKV = WS_WB, WB_DAO = WB_QKV + 6 * MiB, WB_WIN = WB_DAO + 2 * MiB, WB_WUQ = WB_WIN + 3 * MiB / 2, WB_WUKV = WB_WUQ + 9 * MiB / 8, WB_MLO = WB_WUKV + 1 * MiB, WB_MOE = WB_MLO + 2 * MiB;
constexpr size_t WS_H = 176 * MiB;
constexpr size_t WS_O = 304 * MiB;
constexpr size_t WS_A = 432 * MiB;
constexpr size_t WS_LISTW = 160 * MiB;
constexpr size_t WS_KPE = 168 * MiB;
constexpr size_t WS_S = WS_O;
constexpr size_t WS_XB = 880 * MiB;
constexpr size_t WS_END = 1008 * MiB;
constexpr int CW_BAR = 4096;
constexpr int CW_CNT = 16384;
constexpr int HID_ROWS = 2 * NTOK + 32 * 128;

constexpr int LDS_BYTES = 147456;
constexpr int MISC_OFF = 131072 + 320;

__device__ __forceinline__ unsigned f2bf(float f) { unsigned u = __builtin_bit_cast(unsigned, f); return (u + 0x7fffu + ((u >> 16) & 1u)) >> 16; }
__device__ __forceinline__ float bf2f(unsigned h) { return __builtin_bit_cast(float, h << 16); }
__device__ __forceinline__ unsigned pk2(float lo, float hi) { return f2bf(lo) | (f2bf(hi) << 16); }
__device__ __forceinline__ float wave_sum(float v) {
#pragma unroll
    for (int o = 1; o < 64; o <<= 1) v += __shfl_xor(v, o);
    return v;
}
__device__ __forceinline__ float wave_max(float v) {
#pragma unroll
    for (int o = 1; o < 64; o <<= 1) v = fmaxf(v, __shfl_xor(v, o));
    return v;
}

#define XB_TMO      128
#define XB_XCNT(j)  (256  + 64 * (j))
#define XB_XSUB(j)  (1280 + 64 * (j))
#define XB_XGEN(j)  (2304 + 64 * (j))
#define XB_TOP      3328
#define XB_TOPGEN   3392
#define XCD_BAR_WORDS 3456
#define XB_SPIN_CAP (1u << 20)
__device__ __forceinline__ unsigned xb_ld(unsigned* p)              { return __hip_atomic_load(p, __ATOMIC_RELAXED, __HIP_MEMORY_SCOPE_AGENT); }
__device__ __forceinline__ unsigned xb_add(unsigned* p, unsigned v) { return __hip_atomic_fetch_add(p, v, __ATOMIC_RELAXED, __HIP_MEMORY_SCOPE_AGENT); }
__device__ __forceinline__ unsigned xb_xcc_id() { return (unsigned)__builtin_amdgcn_s_getreg((3 << 11) | 20) & 0xFu; }
#define XB_SPIN(cond, bar) do { unsigned _sp = 0; while (cond) { __builtin_amdgcn_s_sleep(1); \
    if ((++_sp & 255u) == 0u) { if (xb_ld(&(bar)[XB_TMO])) break; if (_sp > XB_SPIN_CAP) { atomicAdd(&(bar)[XB_TMO], 1u); break; } } } } while (0)
struct XcdBarrier { unsigned* bar; unsigned x; volatile LAS unsigned* st; };
__device__ __forceinline__ XcdBarrier xcd_barrier_post(unsigned* bar, volatile LAS unsigned* st) {
    XcdBarrier b; b.bar = bar; b.x = xb_xcc_id(); b.st = st;
    if (threadIdx.x == 0) (void)xb_add(&bar[XB_XCNT(b.x)], 1u);
    return b;
}
__device__ __forceinline__ void xcd_barrier_complete(unsigned* bar, unsigned x, unsigned& nloc, unsigned& nx) {
    const unsigned G = gridDim.x * gridDim.y * gridDim.z;
    unsigned sum, cnt, mine, sp = 0u;
    for (;;) {
        sum = 0u; cnt = 0u; mine = 0u;
#pragma unroll
        for (unsigned j = 0; j < 16; ++j) { const unsigned c = xb_ld(&bar[XB_XCNT(j)]); sum += c; cnt += (c > 0u) ? 1u : 0u; mine = (j == x) ? c : mine; }
        if (sum == G) break;
        __builtin_amdgcn_s_sleep(1);
        if ((++sp & 255u) == 0u) { if (xb_ld(&bar[XB_TMO])) break; if (sp > XB_SPIN_CAP) { atomicAdd(&bar[XB_TMO], 1u); break; } }
    }
    nloc = mine > 0u ? mine : 1u; nx = cnt > 0u ? cnt : 1u;
}
__device__ __forceinline__ void xcd_barrier(const XcdBarrier& b) {
    asm volatile("s_waitcnt vmcnt(0)" ::: "memory");
    __syncthreads();
    if (threadIdx.x == 0) {
        unsigned* bar = b.bar;
        __builtin_amdgcn_s_waitcnt(0);
        unsigned nloc = b.st[0], nx = b.st[1];
        if (nloc == 0u) { xcd_barrier_complete(bar, b.x, nloc, nx); b.st[0] = nloc; b.st[1] = nx; }
        const unsigned old = xb_add(&bar[XB_XSUB(b.x)], 1u);
        const unsigned gen = old / nloc;
        if (old + 1u == (gen + 1u) * nloc) {
            __builtin_amdgcn_fence(__ATOMIC_RELEASE, "agent");
            asm volatile("s_waitcnt vmcnt(0)" ::: "memory");
            const unsigned og = xb_add(&bar[XB_TOP], 1u);
            const unsigned tg = og / nx;
            if (og + 1u == (tg + 1u) * nx) xb_add(&bar[XB_TOPGEN], 1u);
            else XB_SPIN(xb_ld(&bar[XB_TOPGEN]) == tg, bar);
            __builtin_amdgcn_fence(__ATOMIC_ACQUIRE, "agent");
            xb_add(&bar[XB_XGEN(b.x)], 1u);
            asm volatile("s_waitcnt vmcnt(0)" ::: "memory");
        } else {
            XB_SPIN(xb_ld(&bar[XB_XGEN(b.x)]) == gen, bar);
            __builtin_amdgcn_fence(__ATOMIC_ACQUIRE, "agent");
            asm volatile("s_waitcnt vmcnt(0)" ::: "memory");
        }
    }
    __syncthreads();
}

namespace pg8 {
#define PG8_LAS __attribute__((address_space(3)))
typedef unsigned short bf16_t;
typedef short bf16x8 __attribute__((ext_vector_type(8)));
typedef float f32x4 __attribute__((ext_vector_type(4)));
typedef unsigned u32x4 __attribute__((ext_vector_type(4)));
constexpr int BM = 256, BK = 64, HALF = 128, HTB = HALF * BK * 2  , STAGE_BYTES = 8 * HTB, NXCD = 8, WGM = 8;

__host__ __device__ __forceinline__ int lds_byte(int r, int c) { const int st = (r >> 4) * 2 + (c >> 5), rr = r & 15, cc = c & 31, ob = rr * 64 + cc * 2; return st * 1024 + (ob ^ (((ob >> 9) & 1) << 5)); }
__host__ __device__ __forceinline__ void stage_rc(int b, int& R, int& C) { const int st = b / 1024, sb = b % 1024, swz = sb ^ (((sb >> 9) & 1) << 5); R = (st >> 1) * 16 + swz / 64; C = (st & 1) * 32 + (swz % 64) / 2; }
__host__ __device__ __forceinline__ int perm32(int rho) { const int n = rho >> 4, i = rho & 15; return 8 * (i >> 2) + 4 * n + (i & 3); }

struct Unit { int pm, pn; };
struct Gemm { const bf16_t* A; const bf16_t* Bt; int M, N, K; };

struct StaticOrder {
    typedef Unit UnitT;
    int nM, nN, nwg, G, c;
    __host__ __device__ void init(int M, int N, int G_, int c_) { nM = M / BM; nN = N / BM; nwg = nM * nN; G = G_; c = c_; }
    __host__ __device__ bool next(int i, Unit& u) const {
        const long L = (long)i * G + c; if (L >= nwg) return false;
        int wgid = (int)L; { const int q = nwg / NXCD, r = nwg % NXCD, xcd = wgid % NXCD, off = wgid / NXCD; wgid = (xcd < r ? xcd * (q + 1) : r * (q + 1) + (xcd - r) * q) + off; }
        const int nig = WGM * nN, gid = wgid / nig, fm = gid * WGM, gsz = (nM - fm) < WGM ? (nM - fm) : WGM;
        u.pm = fm + ((wgid % nig) % gsz); u.pn = (wgid % nig) / gsz; return true;
    }
    __device__ __forceinline__ void a_ready(const Unit&) const {}
    __device__ __forceinline__ void done(const Unit&) const {}
};

__device__ __forceinline__ unsigned cvt_pk_bf16(float lo, float hi) { unsigned r; asm volatile("v_cvt_pk_bf16_f32 %0, %1, %2" : "=v"(r) : "v"(lo), "v"(hi)); return r; }
typedef float f32x2 __attribute__((ext_vector_type(2)));
__device__ __forceinline__ f32x2 gelu_pk(f32x2 v) {
    const f32x2 av = __builtin_elementwise_abs(v), d = av * 0.2316418882f + 1.0f;
    f32x2 t; t.x = __builtin_amdgcn_rcpf(d.x); t.y = __builtin_amdgcn_rcpf(d.y);
    f32x2 q = t * 0.5307027145f + (-0.7265760135f); q = q * t + 0.7107068705f; q = q * t + (-0.142248368f); q = q * t + 0.127414796f; q = q * t;
    const f32x2 s = (v * v) * (-0.72134752044f);
    f32x2 e; e.x = __builtin_amdgcn_exp2f(s.x); e.y = __builtin_amdgcn_exp2f(s.y);
    const f32x2 m = v * (q * e), r = v - m;
    f32x2 o; o.x = v.x < 0.f ? m.x : r.x; o.y = v.y < 0.f ? m.y : r.y; return o;
}

template <int ACT  > struct EpiBf16 {
    static constexpr bool PERM = true, AFTER_DRAIN = false; static_assert(ACT == 0 || ACT == 1, "EpiBf16: ACT is 0 (none) or 1 (gelu_pk)");
    bf16_t* O; int ldc; const float* bias; int split_cols; size_t split_stride; float scale0;
    __device__ __forceinline__ void operator()(const f32x4 (&acc)[2][2][4][2], const Unit& u, int wr, int wc, int fr, int fq) const {
        const int row0 = u.pm * BM + wr * 64 + fr; int colt = u.pn * BM; bf16_t* base = O;
        float sc = 1.f; if (split_cols) { const int t = colt / split_cols; base += (size_t)t * split_stride; colt -= t * split_cols; if (t == 0) sc = scale0; }
        const int col0 = colt + wc * 32 + 8 * fq, bcol0 = u.pn * BM + wc * 32 + 8 * fq;
        f32x4 bv[2][2];
#pragma unroll
        for (int bj = 0; bj < 2; ++bj)
#pragma unroll
            for (int n = 0; n < 2; ++n) bv[bj][n] = bias ? *(const f32x4*)(bias + bcol0 + bj * HALF + 4 * n) : (f32x4){0.f, 0.f, 0.f, 0.f};
#pragma unroll
        for (int ai = 0; ai < 2; ++ai)
#pragma unroll
            for (int m = 0; m < 4; ++m) { bf16_t* rowp = base + (size_t)(row0 + ai * HALF + m * 16) * ldc + col0;
#pragma unroll
                for (int bj = 0; bj < 2; ++bj) { f32x4 v0 = acc[ai][bj][m][0] + bv[bj][0], v1 = acc[ai][bj][m][1] + bv[bj][1];
                    if (ACT == 1) { f32x2 a = gelu_pk((f32x2){v0[0], v0[1]}), b = gelu_pk((f32x2){v0[2], v0[3]}), c = gelu_pk((f32x2){v1[0], v1[1]}), d = gelu_pk((f32x2){v1[2], v1[3]});
                        v0 = (f32x4){a.x, a.y, b.x, b.y}; v1 = (f32x4){c.x, c.y, d.x, d.y}; }
                    v0 = v0 * sc; v1 = v1 * sc; u32x4 w; w.x = cvt_pk_bf16(v0[0], v0[1]); w.y = cvt_pk_bf16(v0[2], v0[3]); w.z = cvt_pk_bf16(v1[0], v1[1]); w.w = cvt_pk_bf16(v1[2], v1[3]);
                    *(u32x4*)(rowp + bj * HALF) = w; } }
    }
};

template <class Epi, class Sched, bool ALIGN_EPI = false, bool SP2 = false>
__device__ __forceinline__ void gemm_phase(PG8_LAS unsigned char* lds, const Gemm g, const Sched& S, const Epi& E) {
    int tid_ = threadIdx.x; asm volatile("" : "+v"(tid_));
    const int tid = tid_, wid = __builtin_amdgcn_readfirstlane(tid >> 6), lane = tid & 63, wr = wid >> 2, wc = wid & 3, fr = lane & 15, fq = lane >> 4;
    const int K = g.K, nt = K / BK;
    unsigned voffA[2], voffB[2];
#pragma unroll
    for (int i = 0; i < 2; ++i) { int R, C; stage_rc(tid * 16 + i * 8192, R, C); const int Rb = Epi::PERM ? ((R & ~31) + perm32(R & 31)) : R;
        voffA[i] = (unsigned)(R * K + C) * 2u; voffB[i] = (unsigned)(Rb * K + C) * 2u; }
    const size_t kstep = (size_t)(BK * 2);
    const size_t hstep = (size_t)HALF * K * 2;
    const size_t tstep = 2 * hstep;
    const unsigned ldsw = (unsigned)wid * 1024u;
    const int aoff = lds_byte(wr * 64 + fr, fq * 8), boff = lds_byte(wc * 32 + fr, fq * 8);
#define PG8_SA(b, h) (((b) * 2 + (h)) * HTB)
#define PG8_SB(b, h) ((4 + (b) * 2 + (h)) * HTB)
#define PG8_STAGE(bufoff, gbase, voff) do { _Pragma("unroll") for (int _i = 0; _i < 2; ++_i) \
        __builtin_amdgcn_global_load_lds((const unsigned*)((const char*)(gbase) + (voff)[_i]), (PG8_LAS unsigned*)(lds + (bufoff) + ldsw + _i * 8192), 16, 0, 0); } while (0)
#define PG8_LDA(dst, b, h) do { _Pragma("unroll") for (int m = 0; m < 4; ++m) _Pragma("unroll") for (int k = 0; k < 2; ++k) dst[m][k] = *(const PG8_LAS bf16x8*)(lds + PG8_SA(b, h) + aoff + m * 2048 + k * 1024); } while (0)
#define PG8_LDB(dst, b, h) do { _Pragma("unroll") for (int n = 0; n < 2; ++n) _Pragma("unroll") for (int k = 0; k < 2; ++k) dst[n][k] = *(const PG8_LAS bf16x8*)(lds + PG8_SB(b, h) + boff + n * 2048 + k * 1024); } while (0)
#define PG8_MMA(ai, bj, At, Bt) do { __builtin_amdgcn_s_setprio(1); _Pragma("unroll") for (int m = 0; m < 4; ++m) _Pragma("unroll") for (int n = 0; n < 2; ++n) _Pragma("unroll") for (int k = 0; k < 2; ++k) \
        acc[ai][bj][m][n] = __builtin_amdgcn_mfma_f32_16x16x32_bf16(Bt[n][k], At[m][k], acc[ai][bj][m][n], 0, 0, 0); __builtin_amdgcn_s_setprio(0); } while (0)
#define PG8_WAIT_V(n) asm volatile("s_waitcnt vmcnt(" #n ")" ::: "memory")
#define PG8_WAIT_L(n) asm volatile("s_waitcnt lgkmcnt(" #n ")" ::: "memory")
#define PG8_BAR __builtin_amdgcn_s_barrier()
#define PG8_SCHED __builtin_amdgcn_sched_barrier(0)
    typename Sched::UnitT cur, nxt; int ui = 0;
    if (!S.next(0, cur)) return;
    f32x4 acc[2][2][4][2];
#pragma unroll
    for (int a = 0; a < 2; ++a)
#pragma unroll
        for (int b = 0; b < 2; ++b)
#pragma unroll
            for (int m = 0; m < 4; ++m)
#pragma unroll
                for (int n = 0; n < 2; ++n) acc[a][b][m][n] = (f32x4){0.f, 0.f, 0.f, 0.f};
    bf16x8 At[4][2], B0[2][2], B1[2][2];
    const char* cA = (const char*)g.A + (size_t)cur.pm * tstep; const char* cB = (const char*)g.Bt + (size_t)cur.pn * tstep;
    S.a_ready(cur);
    if constexpr (SP2) {
        PG8_STAGE(PG8_SB(0, 0), cB, voffB); PG8_STAGE(PG8_SB(0, 1), cB + hstep, voffB); PG8_STAGE(PG8_SA(0, 0), cA, voffA); PG8_STAGE(PG8_SA(0, 1), cA + hstep, voffA);
        if (wr == 1) PG8_BAR;
        PG8_WAIT_V(2); PG8_BAR;
        PG8_STAGE(PG8_SB(1, 0), cB + kstep, voffB); PG8_STAGE(PG8_SA(1, 0), cA + kstep, voffA); PG8_STAGE(PG8_SB(1, 1), cB + hstep + kstep, voffB);
        PG8_WAIT_V(6); PG8_BAR;
    } else {
        PG8_STAGE(PG8_SB(0, 0), cB, voffB); PG8_STAGE(PG8_SA(0, 0), cA, voffA); PG8_STAGE(PG8_SB(0, 1), cB + hstep, voffB); PG8_STAGE(PG8_SA(0, 1), cA + hstep, voffA);
        if (wr == 1) PG8_BAR;
        PG8_WAIT_V(4); PG8_BAR;
        PG8_STAGE(PG8_SB(1, 0), cB + kstep, voffB); PG8_STAGE(PG8_SA(1, 0), cA + kstep, voffA); PG8_STAGE(PG8_SB(1, 1), cB + hstep + kstep, voffB);
        PG8_WAIT_V(6); PG8_BAR;
    }
    for (;;) {
        const bool has_next = S.next(ui + 1, nxt);
        const char* nA = has_next ? (const char*)g.A + (size_t)nxt.pm * tstep : cA; const char* nB = has_next ? (const char*)g.Bt + (size_t)nxt.pn * tstep : cB;
        for (int t = 0; t < nt; t += 2) {
            const bool last = (t == nt - 2);
            const char* a1 = cA + (size_t)(t + 1) * kstep;
            const char* a2 = last ? nA : cA + (size_t)(t + 2) * kstep; const char* b2 = last ? nB : cB + (size_t)(t + 2) * kstep;
            const char* a3 = a2 + kstep; const char* b3 = b2 + kstep;
            if (last && has_next) S.a_ready(nxt);
            if constexpr (SP2) {
            PG8_LDB(B0, 0, 0); PG8_LDB(B1, 0, 1); PG8_SCHED; PG8_LDA(At, 0, 0); PG8_STAGE(PG8_SA(1, 1), a1 + hstep, voffA);
            PG8_WAIT_V(8); PG8_WAIT_L(0); PG8_BAR; PG8_MMA(0, 0, At, B0); PG8_MMA(0, 1, At, B1); PG8_BAR; PG8_SCHED;
            PG8_LDA(At, 0, 1); PG8_STAGE(PG8_SB(0, 0), b2, voffB); PG8_STAGE(PG8_SB(0, 1), b2 + hstep, voffB); PG8_STAGE(PG8_SA(0, 0), a2, voffA);
            PG8_WAIT_V(8); PG8_WAIT_L(0); PG8_BAR; PG8_MMA(1, 0, At, B0); PG8_MMA(1, 1, At, B1); PG8_BAR; PG8_SCHED;
            PG8_LDB(B0, 1, 0); PG8_LDB(B1, 1, 1); PG8_SCHED; PG8_LDA(At, 1, 0); PG8_STAGE(PG8_SA(0, 1), a2 + hstep, voffA);
            PG8_WAIT_V(8); PG8_WAIT_L(0); PG8_BAR; PG8_MMA(0, 0, At, B0); PG8_MMA(0, 1, At, B1); PG8_BAR; PG8_SCHED;
            PG8_LDA(At, 1, 1); PG8_STAGE(PG8_SB(1, 0), b3, voffB); PG8_STAGE(PG8_SB(1, 1), b3 + hstep, voffB); PG8_STAGE(PG8_SA(1, 0), a3, voffA);
            PG8_WAIT_V(8); PG8_WAIT_L(0); PG8_BAR; PG8_MMA(1, 0, At, B0); PG8_MMA(1, 1, At, B1); PG8_BAR; PG8_SCHED;
            } else {
            PG8_LDB(B0, 0, 0); PG8_SCHED; PG8_LDA(At, 0, 0); PG8_STAGE(PG8_SA(1, 1), a1 + hstep, voffA);
            PG8_WAIT_L(8); PG8_BAR; PG8_WAIT_L(0); PG8_MMA(0, 0, At, B0); PG8_BAR; PG8_SCHED;
            PG8_LDB(B1, 0, 1); PG8_STAGE(PG8_SB(0, 0), b2, voffB);
            PG8_BAR; PG8_WAIT_L(0); PG8_MMA(0, 1, At, B1); PG8_BAR;
            PG8_LDA(At, 0, 1); PG8_STAGE(PG8_SA(0, 0), a2, voffA);
            PG8_BAR; PG8_WAIT_L(0); PG8_MMA(1, 0, At, B0); PG8_BAR; PG8_SCHED;
            PG8_STAGE(PG8_SB(0, 1), b2 + hstep, voffB);
            PG8_WAIT_V(6); PG8_BAR; PG8_MMA(1, 1, At, B1); PG8_BAR;
            PG8_LDB(B0, 1, 0); PG8_SCHED; PG8_LDA(At, 1, 0); PG8_STAGE(PG8_SA(0, 1), a2 + hstep, voffA);
            PG8_WAIT_L(8); PG8_BAR; PG8_WAIT_L(0); PG8_MMA(0, 0, At, B0); PG8_BAR; PG8_SCHED;
            PG8_LDB(B1, 1, 1); PG8_STAGE(PG8_SB(1, 0), b3, voffB);
            PG8_BAR; PG8_WAIT_L(0); PG8_MMA(0, 1, At, B1); PG8_BAR;
            PG8_LDA(At, 1, 1); PG8_STAGE(PG8_SA(1, 0), a3, voffA);
            PG8_BAR; PG8_WAIT_L(0); PG8_MMA(1, 0, At, B0); PG8_BAR; PG8_SCHED;
            PG8_STAGE(PG8_SB(1, 1), b3 + hstep, voffB);
            PG8_WAIT_V(6); PG8_BAR; PG8_MMA(1, 1, At, B1); PG8_BAR;
            }
        }
        if constexpr (ALIGN_EPI) { if (wr == 0) PG8_BAR; }
        if constexpr (!Epi::AFTER_DRAIN) { E(acc, cur, wr, wc, fr, fq); S.done(cur); }
        if (!has_next) break;
#pragma unroll
        for (int a = 0; a < 2; ++a)
#pragma unroll
            for (int b = 0; b < 2; ++b)
#pragma unroll
                for (int m = 0; m < 4; ++m)
#pragma unroll
                    for (int n = 0; n < 2; ++n) acc[a][b][m][n] = (f32x4){0.f, 0.f, 0.f, 0.f};
        cur = nxt; cA = nA; cB = nB; ++ui;
        if constexpr (ALIGN_EPI) { if (wr == 1) PG8_BAR; }
    }
    PG8_WAIT_V(0);
    if constexpr (!ALIGN_EPI) { if (wr == 0) PG8_BAR; }
    PG8_BAR;
    if constexpr (Epi::AFTER_DRAIN) { E.fused(acc, cur, wr, wc, fr, fq, lds, wid, lane); S.done(cur); }
#undef PG8_SA
#undef PG8_SB
#undef PG8_STAGE
#undef PG8_LDA
#undef PG8_LDB
#undef PG8_MMA
#undef PG8_WAIT_V
#undef PG8_WAIT_L
#undef PG8_BAR
#undef PG8_SCHED
}


__device__ __forceinline__ float quad_sum(float v) {
    auto a = __builtin_amdgcn_permlane16_swap(__float_as_uint(v), __float_as_uint(v), false, false); v = __uint_as_float(a[0]) + __uint_as_float(a[1]);
    auto b = __builtin_amdgcn_permlane32_swap(__float_as_uint(v), __float_as_uint(v), false, false); return __uint_as_float(b[0]) + __uint_as_float(b[1]);
}
__device__ __forceinline__ float sq4(const f32x4& v) { return (v[0] * v[0] + v[1] * v[1]) + (v[2] * v[2] + v[3] * v[3]); }
__device__ __forceinline__ u32x4 pack8(const f32x4& a, const f32x4& b) { u32x4 o; o.x = cvt_pk_bf16(a[0], a[1]); o.y = cvt_pk_bf16(a[2], a[3]); o.z = cvt_pk_bf16(b[0], b[1]); o.w = cvt_pk_bf16(b[2], b[3]); return o; }
__device__ __forceinline__ void store_rows8(bf16_t* base, unsigned rowA, unsigned pitch, const u32x4& x0, const u32x4& x1) {
    u32x4 a, b;
#pragma unroll
    for (int c = 0; c < 4; ++c) { a[c] = (unsigned)__builtin_amdgcn_update_dpp((int)x0[c], (int)x1[c], 0x128, 0xF, 0xC, false); b[c] = (unsigned)__builtin_amdgcn_update_dpp((int)x1[c], (int)x0[c], 0x128, 0xF, 0x3, false); }
    *(u32x4*)(base + rowA * pitch) = a; *(u32x4*)(base + (rowA + 8u) * pitch) = b;
}
struct EpiQKV {
    static constexpr bool PERM = true, AFTER_DRAIN = false;
    bf16_t* Q; bf16_t* K; bf16_t* V; const float* cosD; const float* sinD; const float* gq; const float* gk; float qscale; float eps;
    __device__ __forceinline__ void operator()(const f32x4 (&acc)[2][2][4][2], const Unit& u, int wr, int wc, int fr, int fq) const {
        asm volatile("" : "+v"(fr), "+v"(fq));
        const int tile = u.pn; const unsigned row0 = (unsigned)(u.pm * BM + wr * 64 + fr);
        if (tile >= 8) {
            bf16_t* vb = V + (tile - 8) * 256 + wc * 64 + 32 * (fr >> 3) + fq * 8; const unsigned rowA0 = (unsigned)(u.pm * BM + wr * 64 + (fr & 7));
#pragma unroll
            for (int ai = 0; ai < 2; ++ai)
#pragma unroll
                for (int m = 0; m < 4; ++m) store_rows8(vb, rowA0 + ai * HALF + m * 16, 1024u, pack8(acc[ai][0][m][0], acc[ai][0][m][1]), pack8(acc[ai][1][m][0], acc[ai][1][m][1]));
        } else {
            const bool isk = tile >= 4; const int hm = (tile & 3) * 4 + wc; bf16_t* dst = (isk ? K : Q) + hm * 64 + 32 * (fr >> 3) + 8 * fq; const unsigned rowA0 = (unsigned)(u.pm * BM + wr * 64 + (fr & 7)); const float* g = isk ? gk : gq; const float sc = isk ? 1.0f : qscale;
            const f32x4 g0a = *(const f32x4*)(g + 8 * fq), g0b = *(const f32x4*)(g + 8 * fq + 4), g1a = *(const f32x4*)(g + 32 + 8 * fq), g1b = *(const f32x4*)(g + 36 + 8 * fq);
            const float* cb = cosD + 8 * fq; const float* sb = sinD + 8 * fq;
#pragma unroll
            for (int ai = 0; ai < 2; ++ai)
#pragma unroll
                for (int m = 0; m < 4; ++m) {
                    const unsigned row = row0 + ai * HALF + m * 16;
                    const f32x4 c0 = *(const f32x4*)(cb + row * 32u), c1 = *(const f32x4*)(cb + row * 32u + 4), s0 = *(const f32x4*)(sb + row * 32u), s1 = *(const f32x4*)(sb + row * 32u + 4);
                    const f32x4 a0 = acc[ai][0][m][0], a1 = acc[ai][0][m][1], b0 = acc[ai][1][m][0], b1 = acc[ai][1][m][1];
                    const float ss = quad_sum((sq4(a0) + sq4(a1)) + (sq4(b0) + sq4(b1)));
                    const float rs = __builtin_amdgcn_rsqf(ss * (1.0f / 64.0f) + eps) * sc;
                    const f32x4 x1a = a0 * (g0a * rs), x1b = a1 * (g0b * rs), x2a = b0 * (g1a * rs), x2b = b1 * (g1b * rs);
                    store_rows8(dst, rowA0 + ai * HALF + m * 16, 1024u, pack8(x1a * c0 - x2a * s0, x1b * c1 - x2b * s1), pack8(x2a * c0 + x1a * s0, x2b * c1 + x1b * s1));
                }
        }
    }
};
template <bool XF32>
struct EpiResid {
    static constexpr bool PERM = true, AFTER_DRAIN = false;
    const void* xin; bf16_t* xout; const float* gate; float* ssq;
    __device__ __forceinline__ void operator()(const f32x4 (&acc)[2][2][4][2], const Unit& u, int wr, int wc, int fr, int fq) const {
        asm volatile("" : "+v"(fr), "+v"(fq));
        const int b = (u.pm * BM) >> 11; const unsigned colb = (unsigned)(u.pn * BM + wc * 64 + 8 * fq); const unsigned row0 = (unsigned)(u.pm * BM + wr * 64 + fr);
        const float* gp = gate + (size_t)b * 6144 + colb;
        f32x4 g[2][2];
#pragma unroll
        for (int bj = 0; bj < 2; ++bj)
#pragma unroll
            for (int n = 0; n < 2; ++n) g[bj][n] = *(const f32x4*)(gp + bj * 32 + n * 4);
        bf16_t* xo = xout + u.pn * BM + wc * 64 + 32 * (fr >> 3) + 8 * fq; float* sq = ssq + u.pn * 4 + wc; const unsigned rowA0 = (unsigned)(u.pm * BM + wr * 64 + (fr & 7));
#pragma unroll
        for (int ai = 0; ai < 2; ++ai) {
            f32x4 xq[4][2][2];
#pragma unroll
            for (int m = 0; m < 4; ++m) { const unsigned off_ = (row0 + ai * HALF + m * 16) * 1024u + colb;
#pragma unroll
                for (int bj = 0; bj < 2; ++bj) {
                    if (XF32) { xq[m][bj][0] = *(const f32x4*)((const float*)xin + off_ + bj * 32); xq[m][bj][1] = *(const f32x4*)((const float*)xin + off_ + bj * 32 + 4); }
                    else { const u32x4 w = *(const u32x4*)((const bf16_t*)xin + off_ + bj * 32);
                        xq[m][bj][0] = (f32x4){__uint_as_float(w.x << 16), __uint_as_float(w.x & 0xffff0000u), __uint_as_float(w.y << 16), __uint_as_float(w.y & 0xffff0000u)};
                        xq[m][bj][1] = (f32x4){__uint_as_float(w.z << 16), __uint_as_float(w.z & 0xffff0000u), __uint_as_float(w.w << 16), __uint_as_float(w.w & 0xffff0000u)}; } } }
#pragma unroll
            for (int m = 0; m < 4; ++m) {
                const unsigned row = row0 + ai * HALF + m * 16; float ss = 0.f; u32x4 pk[2];
#pragma unroll
                for (int bj = 0; bj < 2; ++bj) { const f32x4 v0 = xq[m][bj][0] + g[bj][0] * acc[ai][bj][m][0], v1 = xq[m][bj][1] + g[bj][1] * acc[ai][bj][m][1];
                    pk[bj] = pack8(v0, v1); ss += sq4(v0) + sq4(v1); }
                store_rows8(xo, rowA0 + ai * HALF + m * 16, 1024u, pk[0], pk[1]);
                ss = quad_sum(ss);
                if (fq == 0) sq[row * 16u] = ss;
            }
        }
    }
};
struct EpiWin {
    static constexpr bool PERM = true, AFTER_DRAIN = false;
    bf16_t* CQ; bf16_t* CKV; bf16_t* KPE; float* ssq; const float* cosM; const float* sinM; const float* gkpe; float eps;
    __device__ __forceinline__ void operator()(const f32x4 (&acc)[2][2][4][2], const Unit& u, int wr, int wc, int fr, int fq) const {
        asm volatile("" : "+v"(fr), "+v"(fq));
        const int ws = u.pn * 4 + wc; const unsigned row0 = (unsigned)(u.pm * BM + wr * 64 + fr);
        if (ws < 10) {
            bf16_t* dst = ((ws < 6) ? CQ + 64 * ws : CKV + 64 * (ws - 6)) + 32 * (fr >> 3) + 8 * fq; const unsigned ld = (ws < 6) ? 384u : 256u; float* sq = ssq + ws; const unsigned rowA0 = (unsigned)(u.pm * BM + wr * 64 + (fr & 7));
#pragma unroll
            for (int ai = 0; ai < 2; ++ai)
#pragma unroll
                for (int m = 0; m < 4; ++m) {
                    const unsigned row = row0 + ai * HALF + m * 16;
                    const f32x4 a0 = acc[ai][0][m][0], a1 = acc[ai][0][m][1], b0 = acc[ai][1][m][0], b1 = acc[ai][1][m][1];
                    store_rows8(dst, rowA0 + ai * HALF + m * 16, ld, pack8(a0, a1), pack8(b0, b1));
                    const float ss = quad_sum((sq4(a0) + sq4(a1)) + (sq4(b0) + sq4(b1)));
                    if (fq == 0) sq[row * 16u] = ss;
                }
        } else if (ws == 10) {
            const f32x4 g0 = *(const f32x4*)(gkpe + 4 * fq), g1 = *(const f32x4*)(gkpe + 16 + 4 * fq);
#pragma unroll
            for (int ai = 0; ai < 2; ++ai)
#pragma unroll
                for (int m = 0; m < 4; ++m) {
                    const unsigned row = row0 + ai * HALF + m * 16;
                    const f32x4 c = *(const f32x4*)(cosM + row * 16u + 4 * fq), sn = *(const f32x4*)(sinM + row * 16u + 4 * fq);
                    const f32x4 y0 = acc[ai][0][m][0], y1 = acc[ai][0][m][1];
                    const float rs = __builtin_amdgcn_rsqf(quad_sum(sq4(y0) + sq4(y1)) * (1.0f / 32.0f) + eps);
                    const f32x4 x1 = y0 * (g0 * rs), x2 = y1 * (g1 * rs);
                    *(u32x4*)(KPE + row * 32u + 8 * fq) = pack8(x1 * c - x2 * sn, x2 * c + x1 * sn);
                }
        }
    }
};
struct EpiUQ {
    static constexpr bool PERM = true, AFTER_DRAIN = false;
    bf16_t* Q2; const float* ssq; const float* cosM; const float* sinM; const float* gqn; const float* gqp; float qscale; float eps;
    __device__ __forceinline__ void operator()(const f32x4 (&acc)[2][2][4][2], const Unit& u, int wr, int wc, int fr, int fq) const {
        asm volatile("" : "+v"(fr), "+v"(fq));
        const int tile = u.pn; const unsigned row0 = (unsigned)(u.pm * BM + wr * 64 + fr);
        if (tile < 4) {
            bf16_t* dst = Q2 + (tile * 4 + wc) * 96 + 32 * (fr >> 3) + 8 * fq; const unsigned rowA0 = (unsigned)(u.pm * BM + wr * 64 + (fr & 7));
            const f32x4 g0a = *(const f32x4*)(gqn + 8 * fq) * qscale, g0b = *(const f32x4*)(gqn + 8 * fq + 4) * qscale, g1a = *(const f32x4*)(gqn + 32 + 8 * fq) * qscale, g1b = *(const f32x4*)(gqn + 36 + 8 * fq) * qscale;
#pragma unroll
            for (int ai = 0; ai < 2; ++ai) {
                f32x4 sA[4], sB[4];
#pragma unroll
                for (int m = 0; m < 4; ++m) { const unsigned row = row0 + ai * HALF + m * 16; sA[m] = *(const f32x4*)(ssq + row * 16u); sB[m] = *(const f32x4*)(ssq + row * 16u + 4); }
#pragma unroll
                for (int m = 0; m < 4; ++m) {
                    const unsigned row = row0 + ai * HALF + m * 16;
                    const f32x4 a0 = acc[ai][0][m][0], a1 = acc[ai][0][m][1], b0 = acc[ai][1][m][0], b1 = acc[ai][1][m][1];
                    const float ss = quad_sum((sq4(a0) + sq4(a1)) + (sq4(b0) + sq4(b1)));
                    const float em = eps * ((((sA[m][0] + sA[m][1]) + (sA[m][2] + sA[m][3])) + (sB[m][0] + sB[m][1])) * (1.0f / 384.0f) + eps);
                    const float rn = __builtin_amdgcn_rsqf(ss * (1.0f / 64.0f) + em);
                    store_rows8(dst, rowA0 + ai * HALF + m * 16, 1536u, pack8(a0 * (g0a * rn), a1 * (g0b * rn)), pack8(b0 * (g1a * rn), b1 * (g1b * rn)));
                }
            }
        } else {
            const f32x4 g0 = *(const f32x4*)(gqp + 4 * fq) * qscale, g1 = *(const f32x4*)(gqp + 16 + 4 * fq) * qscale;
            bf16_t* dst = Q2 + (((tile - 4) * 4 + wc) * 2) * 96 + 64 + 8 * fq;
#pragma unroll
            for (int ai = 0; ai < 2; ++ai) {
                f32x4 sA[4], sB[4], cc[4], sn[4];
#pragma unroll
                for (int m = 0; m < 4; ++m) { const unsigned row = row0 + ai * HALF + m * 16; sA[m] = *(const f32x4*)(ssq + row * 16u); sB[m] = *(const f32x4*)(ssq + row * 16u + 4);
                    cc[m] = *(const f32x4*)(cosM + row * 16u + 4 * fq); sn[m] = *(const f32x4*)(sinM + row * 16u + 4 * fq); }
#pragma unroll
                for (int m = 0; m < 4; ++m) {
                    const unsigned row = row0 + ai * HALF + m * 16;
                    const float em = eps * ((((sA[m][0] + sA[m][1]) + (sA[m][2] + sA[m][3])) + (sB[m][0] + sB[m][1])) * (1.0f / 384.0f) + eps);
#pragma unroll
                    for (int bj = 0; bj < 2; ++bj) {
                        const f32x4 y0 = acc[ai][bj][m][0], y1 = acc[ai][bj][m][1];
                        const float rn = __builtin_amdgcn_rsqf(quad_sum(sq4(y0) + sq4(y1)) * (1.0f / 32.0f) + em);
                        const f32x4 x1 = y0 * (g0 * rn), x2 = y1 * (g1 * rn);
                        *(u32x4*)(dst + row * 1536u + bj * 96) = pack8(x1 * cc[m] - x2 * sn[m], x2 * cc[m] + x1 * sn[m]);
                    }
                }
            }
        }
    }
};
struct EpiUKV {
    static constexpr bool PERM = true, AFTER_DRAIN = false;
    bf16_t* KV2; const float* ssq; const float* gkn; float eps;
    __device__ __forceinline__ void operator()(const f32x4 (&acc)[2][2][4][2], const Unit& u, int wr, int wc, int fr, int fq) const {
        asm volatile("" : "+v"(fr), "+v"(fq));
        const int tile = u.pn, head = (tile & 3) * 4 + wc; const unsigned row0 = (unsigned)(u.pm * BM + wr * 64 + fr), rowA0 = (unsigned)(u.pm * BM + wr * 64 + (fr & 7)); const int hcol = 32 * (fr >> 3) + 8 * fq;
        f32x4 sB[2][4], sC[2][4];
#pragma unroll
        for (int ai = 0; ai < 2; ++ai)
#pragma unroll
            for (int m = 0; m < 4; ++m) { const unsigned row = row0 + ai * HALF + m * 16; sB[ai][m] = *(const f32x4*)(ssq + row * 16u + 4); sC[ai][m] = *(const f32x4*)(ssq + row * 16u + 8); }
        if (tile < 4) {
            bf16_t* dst = KV2 + head * 128 + hcol;
            const f32x4 g0a = *(const f32x4*)(gkn + 8 * fq), g0b = *(const f32x4*)(gkn + 8 * fq + 4), g1a = *(const f32x4*)(gkn + 32 + 8 * fq), g1b = *(const f32x4*)(gkn + 36 + 8 * fq);
#pragma unroll
            for (int ai = 0; ai < 2; ++ai)
#pragma unroll
                for (int m = 0; m < 4; ++m) {
                    const unsigned row = row0 + ai * HALF + m * 16;
                    const f32x4 a0 = acc[ai][0][m][0], a1 = acc[ai][0][m][1], b0 = acc[ai][1][m][0], b1 = acc[ai][1][m][1];
                    const float ss = quad_sum((sq4(a0) + sq4(a1)) + (sq4(b0) + sq4(b1)));
                    const float msq = ((sB[ai][m][2] + sB[ai][m][3]) + (sC[ai][m][0] + sC[ai][m][1])) * (1.0f / 256.0f) + eps;
                    const float rn = __builtin_amdgcn_rsqf(ss * (1.0f / 64.0f) + eps * msq);
                    store_rows8(dst, rowA0 + ai * HALF + m * 16, 2048u, pack8(a0 * (g0a * rn), a1 * (g0b * rn)), pack8(b0 * (g1a * rn), b1 * (g1b * rn)));
                }
        } else {
            bf16_t* dst = KV2 + head * 128 + 64 + hcol;
#pragma unroll
            for (int ai = 0; ai < 2; ++ai)
#pragma unroll
                for (int m = 0; m < 4; ++m) {
                    const unsigned row = row0 + ai * HALF + m * 16;
                    const float rsq = __builtin_amdgcn_rsqf(((sB[ai][m][2] + sB[ai][m][3]) + (sC[ai][m][0] + sC[ai][m][1])) * (1.0f / 256.0f) + eps);
                    store_rows8(dst, rowA0 + ai * HALF + m * 16, 2048u, pack8(acc[ai][0][m][0] * rsq, acc[ai][0][m][1] * rsq), pack8(acc[ai][1][m][0] * rsq, acc[ai][1][m][1] * rsq));
                }
        }
    }
};

struct MUnit { int pm, pn, e, r0; };
struct MoeOrder {
    typedef MUnit UnitT;
    const int* tpre; int ncol, G, c, total;
    __device__ __forceinline__ bool next(int i, MUnit& u) const {
        const int L = i * G + c; if (L >= total) return false;
        const int rt = L / ncol, ct = L - rt * ncol; const int e = tpre[33 + rt];
        u.e = e; u.pm = rt; u.r0 = (rt - tpre[e]) * 256; u.pn = e * ncol + ct; return true;
    }
    __device__ __forceinline__ void a_ready(const MUnit&) const {}
    __device__ __forceinline__ void done(const MUnit&) const {}
};
__device__ __forceinline__ float silu_f(float a) { return a * __builtin_amdgcn_rcpf(1.0f + __builtin_amdgcn_exp2f(-1.4426950408889634f * a)); }
struct EpiMoe1 {
    static constexpr bool PERM = true, AFTER_DRAIN = false;
    bf16_t* hid; const int* glist; const float* tokw; const int* cntl; int ntok;
    __device__ __forceinline__ void operator()(const f32x4 (&acc)[2][2][4][2], const MUnit& u, int wr, int wc, int fr, int fq) const {
        const int cnt = cntl[u.e], t = u.pn & 1;
        asm volatile("" : "+v"(fr), "+v"(fq));
#pragma unroll
        for (int ai = 0; ai < 2; ++ai)
#pragma unroll
            for (int m = 0; m < 4; ++m) {
                const int rl = ai * HALF + wr * 64 + m * 16 + fr, r = u.r0 + rl; float w = 0.f;
                if (r < cnt) w = tokw[(unsigned)(u.e * ntok + r)];
                const f32x4 a0 = acc[ai][0][m][0], a1 = acc[ai][0][m][1], b0 = acc[ai][1][m][0], b1 = acc[ai][1][m][1];
                u32x4 o;
                o.x = cvt_pk_bf16(silu_f(a0[0]) * b0[0] * w, silu_f(a0[1]) * b0[1] * w); o.y = cvt_pk_bf16(silu_f(a0[2]) * b0[2] * w, silu_f(a0[3]) * b0[3] * w);
                o.z = cvt_pk_bf16(silu_f(a1[0]) * b1[0] * w, silu_f(a1[1]) * b1[1] * w); o.w = cvt_pk_bf16(silu_f(a1[2]) * b1[2] * w, silu_f(a1[3]) * b1[3] * w);
                *(u32x4*)(hid + ((size_t)u.pm * BM + rl) * 256 + t * 128 + wc * 32 + fq * 8) = o;
                asm volatile("" ::: "memory");
            }
    }
};
struct EpiMoe2 {
    static constexpr bool PERM = true, AFTER_DRAIN = false;
    unsigned char* y2; const int* glist; const int* cntl; int ntok;
    __device__ __forceinline__ void operator()(const f32x4 (&acc)[2][2][4][2], const MUnit& u, int wr, int wc, int fr, int fq) const {
        const int cnt = cntl[u.e], ct = u.pn & 3;
        asm volatile("" : "+v"(fr), "+v"(fq));
#pragma unroll
        for (int ai = 0; ai < 2; ++ai)
#pragma unroll
            for (int m = 0; m < 4; ++m) {
                const int rl = ai * HALF + wr * 64 + m * 16 + fr, r = u.r0 + rl;
                int ent = glist[(unsigned)(u.e * ntok + (r < cnt ? r : 0))]; ent = (r < cnt) ? ent : 2 * ntok;
                unsigned char* rowp = y2 + (size_t)(unsigned)ent * 1024 + ct * 256 + wc * 32 + fq * 8;
#pragma unroll
                for (int bj = 0; bj < 2; ++bj) { const f32x4 v0 = acc[ai][bj][m][0] * 32.0f, v1 = acc[ai][bj][m][1] * 32.0f; u32x2 o;
                    int p = __builtin_amdgcn_cvt_pk_fp8_f32(v0[0], v0[1], 0, false); p = __builtin_amdgcn_cvt_pk_fp8_f32(v0[2], v0[3], p, true); o.x = (unsigned)p;
                    p = __builtin_amdgcn_cvt_pk_fp8_f32(v1[0], v1[1], 0, false); p = __builtin_amdgcn_cvt_pk_fp8_f32(v1[2], v1[3], p, true); o.y = (unsigned)p;
                    *(u32x2*)(rowp + bj * HALF) = o; }
                asm volatile("" ::: "memory");
            }
    }
};
template <class Epi, class Sched, bool FP8 = false>
__device__ __forceinline__ void gemm_phase_gather(PG8_LAS unsigned char* lds, const bf16_t* A, const bf16_t* Bt, int K, const int* glist, int ntok, const int* cntl, const Sched& S, const Epi& E) {
    int tid_ = threadIdx.x; asm volatile("" : "+v"(tid_));
    const int tid = tid_, wid = __builtin_amdgcn_readfirstlane(tid >> 6), lane = tid & 63, wr = wid >> 2, wc = wid & 3, fr = lane & 15, fq = lane >> 4;
    const int rowb = FP8 ? K : 2 * K, nt = FP8 ? K / (2 * BK) : K / BK;
    unsigned voffB[2];
#pragma unroll
    for (int i = 0; i < 2; ++i) { int R, C; stage_rc(tid * 16 + i * 8192, R, C); const int Rb = Epi::PERM ? ((R & ~31) + perm32(R & 31)) : R;
        voffB[i] = (unsigned)(Rb * rowb + C * 2); }
    const size_t kstep = (size_t)(BK * 2);
    const size_t hstep = (size_t)HALF * rowb;
    const size_t tstep = 2 * hstep;
    const unsigned ldsw = (unsigned)wid * 1024u;
    const int aoff = lds_byte(wr * 64 + fr, fq * 8), boff = lds_byte(wc * 32 + fr, fq * 8);
#define PG8_SA(b, h) (((b) * 2 + (h)) * HTB)
#define PG8_SB(b, h) ((4 + (b) * 2 + (h)) * HTB)
#define PG8_STAGE(bufoff, gbase, voff) do { _Pragma("unroll") for (int _i = 0; _i < 2; ++_i) \
        __builtin_amdgcn_global_load_lds((const unsigned*)((const char*)(gbase) + (voff)[_i]), (PG8_LAS unsigned*)(lds + (bufoff) + ldsw + _i * 8192), 16, 0, 0); } while (0)
    typedef int i32x4_ __attribute__((ext_vector_type(4))); typedef int i32x8_ __attribute__((ext_vector_type(8)));
#define PG8_LDA(dst, b, h) do { _Pragma("unroll") for (int m = 0; m < 4; ++m) { if constexpr (FP8) { const i32x4_ l0_ = *(const PG8_LAS i32x4_*)(lds + PG8_SA(b, h) + aoff + m * 2048), l1_ = *(const PG8_LAS i32x4_*)(lds + PG8_SA(b, h) + aoff + m * 2048 + 1024); \
            dst##8[m] = __builtin_shufflevector(l0_, l1_, 0, 1, 2, 3, 4, 5, 6, 7); } else { _Pragma("unroll") for (int k = 0; k < 2; ++k) dst[m][k] = *(const PG8_LAS bf16x8*)(lds + PG8_SA(b, h) + aoff + m * 2048 + k * 1024); } } } while (0)
#define PG8_LDB(dst, b, h) do { _Pragma("unroll") for (int n = 0; n < 2; ++n) { if constexpr (FP8) { const i32x4_ l0_ = *(const PG8_LAS i32x4_*)(lds + PG8_SB(b, h) + boff + n * 2048), l1_ = *(const PG8_LAS i32x4_*)(lds + PG8_SB(b, h) + boff + n * 2048 + 1024); \
            dst##8[n] = __builtin_shufflevector(l0_, l1_, 0, 1, 2, 3, 4, 5, 6, 7); } else { _Pragma("unroll") for (int k = 0; k < 2; ++k) dst[n][k] = *(const PG8_LAS bf16x8*)(lds + PG8_SB(b, h) + boff + n * 2048 + k * 1024); } } } while (0)
#define PG8_MMA(ai, bj, At, Bt) do { __builtin_amdgcn_s_setprio(1); _Pragma("unroll") for (int m = 0; m < 4; ++m) _Pragma("unroll") for (int n = 0; n < 2; ++n) { \
        if constexpr (FP8) acc[ai][bj][m][n] = __builtin_amdgcn_mfma_scale_f32_16x16x128_f8f6f4(Bt##8[n], At##8[m], acc[ai][bj][m][n], 0, 0, 0, 0x7a7a7a7a, 0, 0x7f7f7f7f); \
        else { _Pragma("unroll") for (int k = 0; k < 2; ++k) acc[ai][bj][m][n] = __builtin_amdgcn_mfma_f32_16x16x32_bf16(Bt[n][k], At[m][k], acc[ai][bj][m][n], 0, 0, 0); } } \
        __builtin_amdgcn_s_setprio(0); } while (0)
#define PG8_WAIT_V(n) asm volatile("s_waitcnt vmcnt(" #n ")" ::: "memory")
#define PG8_WAIT_L(n) asm volatile("s_waitcnt lgkmcnt(" #n ")" ::: "memory")
#define PG8_BAR __builtin_amdgcn_s_barrier()
#define PG8_SCHED __builtin_amdgcn_sched_barrier(0)
#define PG8_GOFF(u, off) do { const int _cnt = cntl[(u).e]; _Pragma("unroll") for (int _h = 0; _h < 2; ++_h) _Pragma("unroll") for (int _i = 0; _i < 2; ++_i) { \
        int _R, _C; stage_rc(tid * 16 + _i * 8192, _R, _C); const int _r = (u).r0 + _h * HALF + _R; const int _ent = glist[(unsigned)((u).e * ntok + (_r < _cnt ? _r : 0))]; \
        off[_h][_i] = (unsigned)(_ent >> 1) * (unsigned)rowb + (unsigned)(_C * 2); } } while (0)
    typename Sched::UnitT cur, nxt; int ui = 0;
    if (!S.next(0, cur)) return;
    f32x4 acc[2][2][4][2];
#pragma unroll
    for (int a = 0; a < 2; ++a)
#pragma unroll
        for (int b = 0; b < 2; ++b)
#pragma unroll
            for (int m = 0; m < 4; ++m)
#pragma unroll
                for (int n = 0; n < 2; ++n) acc[a][b][m][n] = (f32x4){0.f, 0.f, 0.f, 0.f};
    bf16x8 At[4][2], B0[2][2], B1[2][2]; i32x8_ At8[4], B08[2], B18[2];
    unsigned coff[2][2], noff[2][2];
    PG8_GOFF(cur, coff);
    const char* cA = (const char*)A; const char* cB = (const char*)Bt + (size_t)cur.pn * tstep;
    PG8_STAGE(PG8_SB(0, 0), cB, voffB); PG8_STAGE(PG8_SB(0, 1), cB + hstep, voffB); PG8_STAGE(PG8_SA(0, 0), cA, coff[0]); PG8_STAGE(PG8_SA(0, 1), cA, coff[1]);
    if (wr == 1) PG8_BAR;
    PG8_WAIT_V(2); PG8_BAR;
    PG8_STAGE(PG8_SB(1, 0), cB + kstep, voffB); PG8_STAGE(PG8_SA(1, 0), cA + kstep, coff[0]); PG8_STAGE(PG8_SB(1, 1), cB + hstep + kstep, voffB);
    PG8_WAIT_V(6); PG8_BAR;
    for (;;) {
        const bool has_next = S.next(ui + 1, nxt);
        if (has_next) { PG8_GOFF(nxt, noff); } else {
#pragma unroll
            for (int h = 0; h < 2; ++h)
#pragma unroll
                for (int i = 0; i < 2; ++i) noff[h][i] = coff[h][i]; }
        const char* nB = has_next ? (const char*)Bt + (size_t)nxt.pn * tstep : cB;
        for (int t = 0; t < nt; t += 2) {
            const bool last = (t == nt - 2);
            const char* a1 = cA + (size_t)(t + 1) * kstep;
            const char* a2 = last ? cA : cA + (size_t)(t + 2) * kstep; const char* b2 = last ? nB : cB + (size_t)(t + 2) * kstep;
            const char* a3 = a2 + kstep; const char* b3 = b2 + kstep;
            PG8_LDB(B0, 0, 0); PG8_LDB(B1, 0, 1); PG8_SCHED; PG8_LDA(At, 0, 0); PG8_STAGE(PG8_SA(1, 1), a1, coff[1]);
            if (last) {
#pragma unroll
                for (int h = 0; h < 2; ++h)
#pragma unroll
                    for (int i = 0; i < 2; ++i) coff[h][i] = noff[h][i]; }
            PG8_WAIT_V(8); PG8_WAIT_L(0); PG8_BAR; PG8_MMA(0, 0, At, B0); PG8_MMA(0, 1, At, B1); PG8_BAR; PG8_SCHED;
            PG8_LDA(At, 0, 1); PG8_STAGE(PG8_SB(0, 0), b2, voffB); PG8_STAGE(PG8_SB(0, 1), b2 + hstep, voffB); PG8_STAGE(PG8_SA(0, 0), a2, coff[0]);
            PG8_WAIT_V(8); PG8_WAIT_L(0); PG8_BAR; PG8_MMA(1, 0, At, B0); PG8_MMA(1, 1, At, B1); PG8_BAR; PG8_SCHED;
            PG8_LDB(B0, 1, 0); PG8_LDB(B1, 1, 1); PG8_SCHED; PG8_LDA(At, 1, 0); PG8_STAGE(PG8_SA(0, 1), a2, coff[1]);
            PG8_WAIT_V(8); PG8_WAIT_L(0); PG8_BAR; PG8_MMA(0, 0, At, B0); PG8_MMA(0, 1, At, B1); PG8_BAR; PG8_SCHED;
            PG8_LDA(At, 1, 1); PG8_STAGE(PG8_SB(1, 0), b3, voffB); PG8_STAGE(PG8_SB(1, 1), b3 + hstep, voffB); PG8_STAGE(PG8_SA(1, 0), a3, coff[0]);
            PG8_WAIT_V(8); PG8_WAIT_L(0); PG8_BAR; PG8_MMA(1, 0, At, B0); PG8_MMA(1, 1, At, B1); PG8_BAR; PG8_SCHED;
        }
        if (wr == 0) PG8_BAR;
        E(acc, cur, wr, wc, fr, fq);
        if (!has_next) break;
#pragma unroll
        for (int a = 0; a < 2; ++a)
#pragma unroll
            for (int b = 0; b < 2; ++b)
#pragma unroll
                for (int m = 0; m < 4; ++m)
#pragma unroll
                    for (int n = 0; n < 2; ++n) acc[a][b][m][n] = (f32x4){0.f, 0.f, 0.f, 0.f};
        cur = nxt; cB = nB; ++ui;
        if (wr == 1) PG8_BAR;
    }
    PG8_WAIT_V(0);
    PG8_BAR;
#undef PG8_SA
#undef PG8_SB
#undef PG8_STAGE
#undef PG8_LDA
#undef PG8_LDB
#undef PG8_MMA
#undef PG8_WAIT_V
#undef PG8_WAIT_L
#undef PG8_BAR
#undef PG8_SCHED
#undef PG8_GOFF
}
}

#define PG8_SP2 true
#define PG8_ALIGN true

struct Args { const float* in[33]; float* out; unsigned char* ws; int ph_lo, ph_hi; };
enum { I_X = 0, I_C, I_POS, I_ADAW, I_ADAB, I_NMIX, I_NFFN, I_DA_WQKV, I_DA_QN, I_DA_KN, I_DA_LQ1, I_DA_LK1, I_DA_LQ2, I_DA_LK2,
       I_DA_SUBLN, I_DA_WO, I_M_WIN, I_M_QAN, I_M_KVAN, I_M_WUQ, I_M_WUKV, I_M_QNN, I_M_QPN, I_M_KNN, I_M_KPN, I_M_WO,
       I_E_WG, I_E_BG, I_E_WR, I_E_BR, I_E_W1, I_E_W3, I_E_W2 };

struct Ctx {
    const float* const* in; float* out; unsigned char* ws; unsigned char* lds;
    int tid, lane, wave, gw, ngw;
    __device__ __forceinline__ const float* mod(int layer, int b, int chunk) const { return (const float*)(ws + WS_MOD) + ((size_t)(layer * NB + b) * 6144 + chunk * 1024); }
};

__device__ __forceinline__ void normmod_row(const f32x4 (&v)[4], f32x4 (&h)[4], const float* g, const float* sh, const float* sc, int lane) {
    float s = 0.f;
#pragma unroll
    for (int j = 0; j < 4; ++j) s += (v[j].x * v[j].x + v[j].y * v[j].y) + (v[j].z * v[j].z + v[j].w * v[j].w);
    const float rstd = 1.0f / sqrtf(wave_sum(s) * (1.0f / D) + EPS);
#pragma unroll
    for (int j = 0; j < 4; ++j) {
        const f32x4 gg = *(const f32x4*)(g + 4 * lane + 256 * j), ss = *(const f32x4*)(sh + 4 * lane + 256 * j), cc = *(const f32x4*)(sc + 4 * lane + 256 * j);
        h[j] = (v[j] * rstd) * gg * (cc + 1.0f) + ss;
    }
}
__device__ __forceinline__ void store_row_bf16(bf16* row, const f32x4 (&h)[4], int lane) {
#pragma unroll
    for (int j = 0; j < 4; ++j) { u32x2 o; o.x = pk2(h[j].x, h[j].y); o.y = pk2(h[j].z, h[j].w); *(u32x2*)(row + 4 * lane + 256 * j) = o; }
}
__device__ __forceinline__ void load_row_fp8(const unsigned char* row, f32x4 (&h)[4], int lane) {
#pragma unroll
    for (int j = 0; j < 4; ++j) { const int w = *(const int*)(row + 4 * lane + 256 * j); const auto lo = __builtin_amdgcn_cvt_pk_f32_fp8(w, false), hi = __builtin_amdgcn_cvt_pk_f32_fp8(w, true);
        h[j] = (f32x4){lo[0], lo[1], hi[0], hi[1]} * 0.03125f; }
}
__device__ __forceinline__ void load_row_bf16(const bf16* row, f32x4 (&h)[4], int lane) {
#pragma unroll
    for (int j = 0; j < 4; ++j) { const u32x2 o = *(const u32x2*)(row + 4 * lane + 256 * j);
        h[j] = (f32x4){bf2f(o.x & 0xffffu), bf2f(o.x >> 16), bf2f(o.y & 0xffffu), bf2f(o.y >> 16)}; }
}


struct TItem { const float* src; bf16* dst; const float* kg; int ldw, K, perm, f8; };
__device__ __forceinline__ void titem_load(const TItem& t, f32x4 (&v)[8], int lane) {
    const float* p = t.src + (size_t)(lane >> 3) * t.ldw + 4 * (lane & 7);
#pragma unroll
    for (int i = 0; i < 8; ++i) v[i] = *(const f32x4*)(p + (size_t)(8 * i) * t.ldw);
}
__device__ __forceinline__ void titem_finish(const TItem& t, const f32x4 (&v)[8], float* scr, int lane) {
    const int rr = lane >> 3, c4 = lane & 7;
#pragma unroll
    for (int i = 0; i < 8; ++i) { f32x4 x = v[i]; if (t.kg) x = x * t.kg[8 * i + rr]; float* d = scr + (8 * i + rr) * 33 + 4 * c4; d[0] = x[0]; d[1] = x[1]; d[2] = x[2]; d[3] = x[3]; }
    asm volatile("s_waitcnt lgkmcnt(0)" ::: "memory");
    const int c = lane & 7;
#pragma unroll
    for (int j = 0; j < 4; ++j) { const int n = (lane >> 3) + 8 * j; const int nl = t.perm ? (16 * ((n >> 2) & 1) + 4 * (n >> 3) + (n & 3)) : n;
        const float* sp = scr + (8 * c) * 33 + nl;
        if (t.f8) { int p0 = __builtin_amdgcn_cvt_pk_fp8_f32(sp[0 * 33] * 32.0f, sp[1 * 33] * 32.0f, 0, false); p0 = __builtin_amdgcn_cvt_pk_fp8_f32(sp[2 * 33] * 32.0f, sp[3 * 33] * 32.0f, p0, true);
            int p1 = __builtin_amdgcn_cvt_pk_fp8_f32(sp[4 * 33] * 32.0f, sp[5 * 33] * 32.0f, 0, false); p1 = __builtin_amdgcn_cvt_pk_fp8_f32(sp[6 * 33] * 32.0f, sp[7 * 33] * 32.0f, p1, true);
            u32x2 o; o.x = (unsigned)p0; o.y = (unsigned)p1; *(u32x2*)((unsigned char*)t.dst + (size_t)n * t.K + 8 * c) = o; }
        else { u32x4 o; o.x = pk2(sp[0 * 33], sp[1 * 33]); o.y = pk2(sp[2 * 33], sp[3 * 33]); o.z = pk2(sp[4 * 33], sp[5 * 33]); o.w = pk2(sp[6 * 33], sp[7 * 33]);
            *(u32x4*)(t.dst + (size_t)n * t.K + 8 * c) = o; } }
    asm volatile("s_waitcnt lgkmcnt(0)" ::: "memory");
}
__device__ __forceinline__ TItem titem_make(const float* W, int ldw, int K, bf16* WT, int k0, int n0, int prow0, const float* kgain, bool perm) {
    TItem t; t.src = W + (size_t)k0 * ldw + n0; t.dst = WT + (size_t)prow0 * K + k0; t.kg = kgain ? kgain + k0 : nullptr; t.ldw = ldw; t.K = K; t.perm = perm ? 1 : 0; t.f8 = 0; return t;
}
constexpr int TI_QKV = 16 * 96, TI_O = 16 * 32, TI_WIN = 16 * 21, TI_UQ = 6 * 48, TI_UKV = 4 * 64, TI_DENSE = TI_QKV + 2 * TI_O + TI_WIN + TI_UQ + TI_UKV, TI_ALL = TI_DENSE + 24576;
__device__ __forceinline__ TItem titem_decode(const Ctx& C, int it) {
    int r = it;
    if (r < TI_QKV) { const int kb = r / 96, lb = r % 96; int pb = lb;
        if (lb < 64) { const int sect = lb >> 5, hm = (lb & 31) >> 1, half = lb & 1; pb = (sect * 4 + (hm >> 2)) * 8 + half * 4 + (hm & 3); }
        else pb = (lb & ~7) + 4 * (lb & 1) + ((lb & 7) >> 1);
        return titem_make(as_global(C.in[I_DA_WQKV]), 3072, 1024, (bf16*)(C.ws + WB_QKV), 64 * kb, 32 * lb, 32 * pb, nullptr, false); } r -= TI_QKV;
    if (r < TI_O) { const int cb = r % 32; return titem_make(as_global(C.in[I_DA_WO]), 1024, 1024, (bf16*)(C.ws + WB_DAO), 64 * (r / 32), 32 * cb, 32 * ((cb & ~7) + 4 * (cb & 1) + ((cb & 7) >> 1)), nullptr, false); } r -= TI_O;
    if (r < TI_O) { const int cb = r % 32; return titem_make(as_global(C.in[I_M_WO]), 1024, 1024, (bf16*)(C.ws + WB_MLO), 64 * (r / 32), 32 * cb, 32 * ((cb & ~7) + 4 * (cb & 1) + ((cb & 7) >> 1)), nullptr, false); } r -= TI_O;
    if (r < TI_WIN) { const int kb = r / 21, lb = r % 21; int pb = 18;
        if (lb < 20) { const int wsl = lb >> 1; pb = (wsl >> 2) * 8 + (lb & 1) * 4 + (wsl & 3); }
        return titem_make(as_global(C.in[I_M_WIN]), 672, 1024, (bf16*)(C.ws + WB_WIN), 64 * kb, 32 * lb, 32 * pb, nullptr, lb == 20); } r -= TI_WIN;
    if (r < TI_UQ) { const int kb = r / 48, lb = r % 48, h = lb / 3, part = lb % 3; int pb;
        if (part < 2) pb = (h >> 2) * 8 + part * 4 + (h & 3); else { const int sl = h >> 1; pb = (4 + (sl >> 2)) * 8 + (h & 1) * 4 + (sl & 3); }
        return titem_make(as_global(C.in[I_M_WUQ]), 1536, 384, (bf16*)(C.ws + WB_WUQ), 64 * kb, 32 * lb, 32 * pb, as_global(C.in[I_M_QAN]), part == 2); } r -= TI_UQ;
    if (r < TI_UKV) { const int kb = r / 64, lb = r % 64, h = lb >> 2, part = lb & 3; const int pb = (((part < 2) ? 0 : 4) + (h >> 2)) * 8 + (part & 1) * 4 + (h & 3);
        return titem_make(as_global(C.in[I_M_WUKV]), 2048, 256, (bf16*)(C.ws + WB_WUKV), 64 * kb, 32 * lb, 32 * pb, as_global(C.in[I_M_KVAN]), false); } r -= TI_UKV;
    if (r < 16384) { const int item = r & 63, mat = (r >> 6) & 1, t = (r >> 7) & 1, e = (r >> 8) & 31, l = r >> 13; const int kb = item >> 2, nb = item & 3;
        const float* W = as_global(C.in[mat ? I_E_W3 : I_E_W1]) + (size_t)(l * 32 + e) * 1024 * 256 + 128 * t;
        TItem ti = titem_make(W, 256, 1024, (bf16*)(C.ws + WB_MOE + (size_t)l * 48 * MiB), 64 * kb, 32 * nb, e * 512 + 256 * t + 128 * mat + 32 * nb, nullptr, false);
        ti.f8 = 1; ti.dst = (bf16*)((unsigned char*)(C.ws + WB_MOE + (size_t)l * 48 * MiB) + (size_t)(e * 512 + 256 * t + 128 * mat + 32 * nb) * 1024 + 64 * kb); return ti; }
    r -= 16384;
    { const int item = r & 127, e = (r >> 7) & 31, l = r >> 12; const int kb = item >> 5, nb = item & 31;
      const float* W = as_global(C.in[I_E_W2]) + (size_t)(l * 32 + e) * 256 * 1024;
      return titem_make(W, 1024, 256, (bf16*)(C.ws + WB_MOE + (size_t)l * 48 * MiB + 32 * MiB), 64 * kb, 32 * nb, e * 1024 + 32 * nb, nullptr, false); }
}
__device__ __forceinline__ void ph_prologue(const Ctx& C) {
    {
        float* sc = (float*)C.lds;
        float* red = sc + 16384;
        const float* c = as_global(C.in[I_C]); const float* adaw = as_global(C.in[I_ADAW]); const float* adab = as_global(C.in[I_ADAB]); float* mod = (float*)(C.ws + WS_MOD);
        for (int item = blockIdx.x; item < 384; item += gridDim.x) {
            const int layer = item / 192, r = item % 192, cc = r >> 1, bhf = r & 1;
            __syncthreads();
            for (int idx = C.tid; idx < 16384; idx += NTHR) { const float v = c[(size_t)(bhf * 16) * D + idx]; sc[(idx & 1023) * 16 + (idx >> 10)] = v / (1.0f + expf(-v)); }
            __syncthreads();
            const int col = C.tid & 63, ks = C.tid >> 6;
            f32x4 acc[4];
#pragma unroll
            for (int i = 0; i < 4; ++i) acc[i] = (f32x4){0.f, 0.f, 0.f, 0.f};
            const float* wp = adaw + ((size_t)layer * D + ks * 128) * 6144 + cc * 64 + col;
#pragma unroll 8
            for (int kk = 0; kk < 128; ++kk) {
                const float w = wp[(size_t)kk * 6144]; const float* sp = sc + (ks * 128 + kk) * 16;
#pragma unroll
                for (int i = 0; i < 4; ++i) acc[i] += *(const f32x4*)(sp + 4 * i) * w;
            }
#pragma unroll
            for (int i = 0; i < 16; ++i) red[(ks * 16 + i) * 64 + col] = acc[i >> 2][i & 3];
            __syncthreads();
            for (int o = C.tid; o < 1024; o += NTHR) { const int i = o >> 6, cl = o & 63; float sm = adab[layer * 6144 + cc * 64 + cl];
#pragma unroll
                for (int k2 = 0; k2 < 8; ++k2) sm += red[(k2 * 16 + i) * 64 + cl];
                mod[(size_t)(layer * NB + bhf * 16 + i) * 6144 + cc * 64 + cl] = sm; }
        }
        if (blockIdx.x == 0 && C.wave == 0) {
            const float a = wave_sum(as_global(C.in[I_DA_LQ1])[C.lane] * as_global(C.in[I_DA_LK1])[C.lane]);
            const float b = wave_sum(as_global(C.in[I_DA_LQ2])[C.lane] * as_global(C.in[I_DA_LK2])[C.lane]);
            if (C.lane == 0) *(float*)(C.ws + WS_LAM) = expf(a) - expf(b) + 0.2f;
        }
    }
    __syncthreads();
    {
        float* ivf = (float*)C.lds;
        if (C.tid < 32) ivf[C.tid] = powf(10000.0f, -(float)(2 * C.tid) / 64.0f); else if (C.tid < 48) ivf[C.tid] = powf(10000.0f, -(float)(2 * (C.tid - 32)) / 32.0f);
        __syncthreads();
        const int* pos = (const int*)as_global(C.in[I_POS]);
        float* cosD = (float*)(C.ws + WS_COSD); float* sinD = (float*)(C.ws + WS_SIND); float* cosM = (float*)(C.ws + WS_COSM); float* sinM = (float*)(C.ws + WS_SINM);
        const int gt = blockIdx.x * NTHR + C.tid, ngt = gridDim.x * NTHR;
        for (int idx = gt; idx < NTOK * 32; idx += ngt) {
            const float ang = (float)pos[idx >> 5] * ivf[idx & 31]; float rev = ang * 0.15915494309189535f; rev -= floorf(rev);
            cosD[idx] = __builtin_amdgcn_cosf(rev); sinD[idx] = __builtin_amdgcn_sinf(rev);
        }
        for (int idx = gt; idx < NTOK * 16; idx += ngt) {
            const float ang = (float)pos[idx >> 4] * ivf[32 + (idx & 15)]; float rev = ang * 0.15915494309189535f; rev -= floorf(rev);
            cosM[idx] = __builtin_amdgcn_cosf(rev); sinM[idx] = __builtin_amdgcn_sinf(rev);
        }
        float* wrt = (float*)(C.ws + WS_WRT); const float* wr = as_global(C.in[I_E_WR]);
        for (int idx = gt; idx < 2 * 32 * 1024; idx += ngt) { const int l = idx >> 15, e = (idx >> 10) & 31, k = idx & 1023; wrt[idx] = wr[((size_t)l * 1024 + k) * 32 + e]; }
        for (int idx = gt; idx < 96 * 1024 / 8; idx += ngt) { const int blk = idx / 4096, rem = idx % 4096; const int pb = (blk == 0) ? 19 : 21 + blk;
            *(u32x4*)((bf16*)(C.ws + WB_WIN) + (size_t)pb * 32 * 1024 + (size_t)rem * 8) = (u32x4){0u, 0u, 0u, 0u}; }
    }
    __syncthreads();
    {
        float* scr = (float*)(C.lds + C.wave * 16384);
        f32x4 va[8], vb[8];
#pragma unroll 1
        for (int it = C.gw; it < TI_ALL; it += 2 * C.ngw) {
            const bool hasb = it + C.ngw < TI_ALL;
            const TItem ta = titem_decode(C, it), tb = titem_decode(C, hasb ? it + C.ngw : it);
            titem_load(ta, va, C.lane); if (hasb) titem_load(tb, vb, C.lane);
            titem_finish(ta, va, scr, C.lane); if (hasb) titem_finish(tb, vb, scr, C.lane);
        }
    }
}
__device__ __forceinline__ void ph_normmod0(const Ctx& C) {
    const float* x = as_global(C.in[I_X]); bf16* H = (bf16*)(C.ws + WS_H);
    for (int tok = C.gw; tok < NTOK; tok += C.ngw) {
        const int b = tok / SEQ; f32x4 v[4], h[4];
#pragma unroll
        for (int j = 0; j < 4; ++j) v[j] = *(const f32x4*)(x + (size_t)tok * D + 4 * C.lane + 256 * j);
        normmod_row(v, h, as_global(C.in[I_NMIX]), C.mod(0, b, 0), C.mod(0, b, 1), C.lane);
        store_row_bf16(H + (size_t)tok * D, h, C.lane);
    }
}
template <bool FINAL>
__device__ __forceinline__ void ph_comb(const Ctx& C, const unsigned char* y2, const float* gate_chunk_base  , int nlayer, const float* gnorm) {
    bf16* H = (bf16*)(C.ws + WS_H); const int lane = C.lane;
    for (int chunk = blockIdx.x; chunk < NTOK / 256; chunk += gridDim.x) {
        for (int i = 0; i < 32; ++i) {
            const int tok = chunk * 256 + C.wave * 32 + i, b = tok / SEQ;
            f32x4 v[4], a[4], a2[4];
            load_row_bf16((const bf16*)(C.ws + WS_XB) + (size_t)tok * D, v, lane);
            const float* gate = gate_chunk_base + (size_t)b * 6144;
            load_row_fp8(y2 + (size_t)(2 * tok) * D, a, lane); load_row_fp8(y2 + (size_t)(2 * tok + 1) * D, a2, lane);
#pragma unroll
            for (int j = 0; j < 4; ++j) { const f32x4 gg = *(const f32x4*)(gate + 4 * lane + 256 * j); v[j] += gg * (a[j] + a2[j]);
                if (FINAL) *(f32x4*)(as_global(C.out) + (size_t)tok * D + 4 * lane + 256 * j) = v[j]; }
            if (FINAL) continue;
            store_row_bf16((bf16*)(C.ws + WS_XB) + (size_t)tok * D, v, lane);
            f32x4 h[4];
            normmod_row(v, h, gnorm, C.mod(nlayer, b, 0), C.mod(nlayer, b, 1), lane);
            store_row_bf16(H + (size_t)tok * D, h, lane);
        }
    }
}

constexpr int MOE_TAB_OFF = 131072 + 512;
__device__ __forceinline__ void moe_prefix256(const Ctx& C, int moe_layer, int* cntl, int* tpre) {
    const unsigned* cnt = (const unsigned*)(C.ws + WS_CTL) + CW_CNT + moe_layer * 32 * 64;
    __syncthreads();
    if (C.tid < 32) cntl[C.tid] = (int)__hip_atomic_load(cnt + C.tid * 64, __ATOMIC_RELAXED, __HIP_MEMORY_SCOPE_AGENT);
    __syncthreads();
    if (C.tid == 0) { int s = 0; for (int e = 0; e < 32; ++e) { tpre[e] = s; s += (cntl[e] + 255) >> 8; } tpre[32] = s; }
    __syncthreads();
    if (C.tid < 32) { for (int rt = tpre[C.tid]; rt < tpre[C.tid + 1]; ++rt) tpre[33 + rt] = C.tid; }
    __syncthreads();
}
__device__ __forceinline__ void ph_moe1_mfma(const Ctx& C, int moe_layer) {
    int* cntl = (int*)(C.lds + MOE_TAB_OFF); int* tpre = cntl + 32;
    moe_prefix256(C, moe_layer, cntl, tpre);
    pg8::MoeOrder S{tpre, 2, (int)gridDim.x, (int)blockIdx.x, tpre[32] * 2};
    pg8::EpiMoe1 E{(bf16*)(C.ws + WS_A), (const int*)(C.ws + WS_LIST), (const float*)(C.ws + WS_LISTW), cntl, NTOK};
    int K1 = 1024; asm volatile("" : "+s"(K1));
    pg8::gemm_phase_gather<pg8::EpiMoe1, pg8::MoeOrder, true>((PG8_LAS unsigned char*)C.lds, (const bf16*)(C.ws + WS_H), (const bf16*)(C.ws + WB_MOE + (size_t)moe_layer * 48 * MiB), K1,
                                                        (const int*)(C.ws + WS_LIST), NTOK, cntl, S, E);
}
__device__ __forceinline__ void ph_moe2_mfma(const Ctx& C, int moe_layer) {
    int* cntl = (int*)(C.lds + MOE_TAB_OFF); int* tpre = cntl + 32;
    moe_prefix256(C, moe_layer, cntl, tpre);
    pg8::MoeOrder S{tpre, 4, (int)gridDim.x, (int)blockIdx.x, tpre[32] * 4};
    pg8::EpiMoe2 E{(unsigned char*)(C.ws + WS_A + 128 * MiB), (const int*)(C.ws + WS_LIST), cntl, NTOK};
    int K2 = 256; asm volatile("" : "+s"(K2));
    pg8::Gemm g{(const bf16*)(C.ws + WS_A), (const bf16*)(C.ws + WB_MOE + (size_t)moe_layer * 48 * MiB + 32 * MiB), 0, 0, K2};
    pg8::gemm_phase<pg8::EpiMoe2, pg8::MoeOrder, PG8_ALIGN, PG8_SP2>((PG8_LAS unsigned char*)C.lds, g, S, E);
}

namespace fa {
typedef short bf16x8 __attribute__((ext_vector_type(8)));
typedef short s16x4 __attribute__((ext_vector_type(4)));
typedef float f32x16 __attribute__((ext_vector_type(16)));
typedef __attribute__((address_space(3))) const char* lds_cptr;
__device__ __forceinline__ int crow(int r, int hi) { return (r & 3) + 8 * (r >> 2) + 4 * hi; }
__device__ __forceinline__ s16x4 vtr(lds_cptr p) { return __builtin_bit_cast(s16x4, __builtin_amdgcn_ds_read_tr16_b64_v4i16((__attribute__((address_space(3))) s16x4*)p)); }
typedef float f32x2_t __attribute__((ext_vector_type(2))); typedef __bf16 bf16x2_t __attribute__((ext_vector_type(2)));
__device__ __forceinline__ unsigned cvtpk(float lo, float hi) { f32x2_t v = {lo, hi}; bf16x2_t b = __builtin_convertvector(v, bf16x2_t); return __builtin_bit_cast(unsigned, b); }
__device__ __forceinline__ float half_swap_max(float v) { auto rr = __builtin_amdgcn_permlane32_swap(__float_as_uint(v), __float_as_uint(v), false, false); return fmaxf(__uint_as_float(rr[0]), __uint_as_float(rr[1])); }
__device__ __forceinline__ float half_swap_sum(float v) { auto rr = __builtin_amdgcn_permlane32_swap(__float_as_uint(v), __float_as_uint(v), false, false); return __uint_as_float(rr[0]) + __uint_as_float(rr[1]); }
__device__ __forceinline__ void dma16(const void* gsrc, LAS unsigned char* ldsdst) { unsigned keep; const unsigned dst = (unsigned)__builtin_amdgcn_readfirstlane((int)(unsigned)(uintptr_t)ldsdst);
    asm volatile("s_mov_b32 %0, m0\n\ts_mov_b32 m0, %2\n\ts_nop 0\n\tglobal_load_lds_dwordx4 %1, off\n\ts_mov_b32 m0, %0" : "=&s"(keep) : "v"(gsrc), "s"(dst) : "memory"); }
__device__ __forceinline__ void dma16s(const void* sbase_, unsigned voff, LAS unsigned char* ldsdst) { unsigned keep; const unsigned dst = (unsigned)__builtin_amdgcn_readfirstlane((int)(unsigned)(uintptr_t)ldsdst);
    const unsigned long long sb_ = (unsigned long long)(uintptr_t)sbase_; const unsigned lo_ = (unsigned)__builtin_amdgcn_readfirstlane((int)(unsigned)sb_), hi_ = (unsigned)__builtin_amdgcn_readfirstlane((int)(unsigned)(sb_ >> 32));
    const void* sbase = (const void*)(uintptr_t)(((unsigned long long)hi_ << 32) | lo_);
    asm volatile("s_mov_b32 %0, m0\n\ts_mov_b32 m0, %3\n\ts_nop 0\n\tglobal_load_lds_dwordx4 %1, %2\n\ts_mov_b32 m0, %0" : "=&s"(keep) : "v"(voff), "s"(sbase), "s"(dst) : "memory"); }

template <int ND0, int NDB>
__device__ __forceinline__ void tile(lds_cptr Kslot, lds_cptr Vslot, const bf16x8 (&qf)[ND0], f32x16 (&o)[NDB], f32x16& negm, float& m, float& l,
                                     LAS float* wsf, bool first, bool diag, int qloc, int lane) {
    const int r32 = lane & 31, hi = lane >> 5;
    lds_cptr kb = Kslot + hi * 1024 + r32 * 16;
    bf16x8 kf0[ND0], kf1[ND0];
#pragma unroll
    for (int d0 = 0; d0 < ND0; ++d0) {
        kf0[d0] = *(const __attribute__((address_space(3))) bf16x8*)(kb + d0 * 2048);
        kf1[d0] = *(const __attribute__((address_space(3))) bf16x8*)(kb + d0 * 2048 + 512);
    }
#pragma unroll
    for (int d0 = 0; d0 < ND0; ++d0) asm volatile("" : "+v"(kf0[d0]), "+v"(kf1[d0]));
    f32x16 p0 = __builtin_amdgcn_mfma_f32_32x32x16_bf16(kf0[0], qf[0], negm, 0, 0, 0);
    f32x16 p1 = __builtin_amdgcn_mfma_f32_32x32x16_bf16(kf1[0], qf[0], negm, 0, 0, 0);
#pragma unroll
    for (int d0 = 1; d0 < ND0; ++d0) {
        p0 = __builtin_amdgcn_mfma_f32_32x32x16_bf16(kf0[d0], qf[d0], p0, 0, 0, 0);
        p1 = __builtin_amdgcn_mfma_f32_32x32x16_bf16(kf1[d0], qf[d0], p1, 0, 0, 0);
    }
    __builtin_amdgcn_sched_barrier(0);
    lds_cptr vp = Vslot + ((lane >> 4) & 1) * 32 + (lane & 3) * 8 + (4 * hi + ((lane & 15) >> 2)) * 64;
    constexpr int NE = (NDB < 2 ? NDB : 2) * 4;
    s16x4 vlo[NDB * 4], vhi[NDB * 4];
#pragma unroll
    for (int i = 0; i < NE; ++i) { vlo[i] = vtr(vp + (i >> 2) * 4096 + (i & 3) * 1024); vhi[i] = vtr(vp + (i >> 2) * 4096 + (i & 3) * 1024 + 512); }
    __builtin_amdgcn_sched_barrier(0);
    if (diag) {
#pragma unroll
        for (int r = 0; r < 16; ++r) { const int kv = crow(r, hi); if (kv > qloc) p0[r] = -1e30f; if (kv + 32 > qloc) p1[r] = -1e30f; }
    }
    float mx = fmaxf(fmaxf(p0[0], p1[0]), p0[1]);
#pragma unroll
    for (int r = 1; r < 16; ++r) { if (r > 1) mx = fmaxf(fmaxf(mx, p0[r]), p1[r]); else mx = fmaxf(mx, p1[r]); }
    mx = half_swap_max(mx);
    const bool need = first || (__builtin_amdgcn_ballot_w64(mx > 8.0f) != 0ull);
    if (need) {
        const float dl = first ? mx : fmaxf(mx, 0.f);
        m += dl;
#pragma unroll
        for (int r = 0; r < 16; ++r) { p0[r] -= dl; p1[r] -= dl; negm[r] = -m; }
        if (!first) {
            const float al = __builtin_amdgcn_exp2f(-dl); l *= al;
            if (hi == 0) wsf[r32] = al;
            asm volatile("s_waitcnt lgkmcnt(0)" ::: "memory");
            f32x4 a4[4];
#pragma unroll
            for (int g = 0; g < 4; ++g) a4[g] = *(const LAS f32x4*)(wsf + 8 * g + 4 * hi);
#pragma unroll
            for (int db = 0; db < NDB; ++db)
#pragma unroll
                for (int r = 0; r < 16; ++r) o[db][r] *= a4[r >> 2][r & 3];
        }
    }
    float sum = 0.f;
#pragma unroll
    for (int ks = 0; ks < 4; ++ks) {
        float e[8];
#pragma unroll
        for (int j = 0; j < 8; ++j) { const float x = (ks < 2) ? p0[8 * ks + j] : p1[8 * (ks - 2) + j]; e[j] = __builtin_amdgcn_exp2f(x); }
        sum += ((e[0] + e[1]) + (e[2] + e[3])) + ((e[4] + e[5]) + (e[6] + e[7]));
        u32x4 w; w.x = cvtpk(e[0], e[1]); w.y = cvtpk(e[2], e[3]); w.z = cvtpk(e[4], e[5]); w.w = cvtpk(e[6], e[7]);
        const bf16x8 pa = __builtin_bit_cast(bf16x8, w);
        if (ks == 0 && NE < NDB * 4) {
#pragma unroll
            for (int i = NE; i < NDB * 4; ++i) { vlo[i] = vtr(vp + (i >> 2) * 4096 + (i & 3) * 1024); vhi[i] = vtr(vp + (i >> 2) * 4096 + (i & 3) * 1024 + 512); }
        }
        __builtin_amdgcn_s_setprio(1);
#pragma unroll
        for (int db = 0; db < NDB; ++db) {
            const s16x4 lo = vlo[db * 4 + ks], hh = vhi[db * 4 + ks];
            const bf16x8 vf = (bf16x8){lo[0], lo[1], lo[2], lo[3], hh[0], hh[1], hh[2], hh[3]};
            o[db] = __builtin_amdgcn_mfma_f32_32x32x16_bf16(pa, vf, o[db], 0, 0, 0);
        }
        __builtin_amdgcn_s_setprio(0);
    }
    l += sum;
}
}


__device__ __forceinline__ void ph_route(const Ctx& C, int layer) {
    typedef float f32x16 __attribute__((ext_vector_type(16)));
    LAS float* hT = (LAS float*)C.lds + C.wave * (32 * 68);
    LAS float* rsl = (LAS float*)C.lds + 8 * 32 * 68 + C.wave * 32;
    int* le0 = (int*)(C.lds + 73728); int* le1 = le0 + 256; int* hist = le1 + 256; int* base = hist + 32; float* lw0 = (float*)(base + 32); float* lw1 = lw0 + 256;
    const bf16* x1 = (const bf16*)(C.ws + WS_XB); unsigned char* H8 = C.ws + WS_H; float* listw = (float*)(C.ws + WS_LISTW); int* list = (int*)(C.ws + WS_LIST);
    unsigned* cnt = (unsigned*)(C.ws + WS_CTL) + CW_CNT + layer * 32 * 64;
    const float* ssqx = (const float*)(C.ws + WS_SSQX);
    const float* gn = as_global(C.in[I_NFFN]) + layer * D;
    const float* WrT = (const float*)(C.ws + WS_WRT) + (size_t)layer * 32 * 1024; const float* wg = as_global(C.in[I_E_WG]) + (size_t)layer * D * 4;
    const float* bg = as_global(C.in[I_E_BG]) + layer * 4; const float* br = as_global(C.in[I_E_BR]) + layer * 32;
    const int lane = C.lane, r32 = lane & 31, hi = lane >> 5, w = C.wave, kq = lane & 15, tsub = lane >> 4;
    LAS float* wgl = (LAS float*)(C.lds + 81920);
    __syncthreads();
    for (int idx = C.tid; idx < 1024; idx += NTHR) *(LAS f32x4*)(wgl + idx * 4) = *(const f32x4*)(wg + (size_t)idx * 4);
    for (int chunk = blockIdx.x; chunk < NTOK / 256; chunk += gridDim.x) {
        __syncthreads();
        if (C.tid < 32) hist[C.tid] = 0;
        const int tok0 = chunk * 256 + w * 32, b = tok0 >> 11;
        const float* shp = C.mod(layer, b, 3); const float* scp = C.mod(layer, b, 4);
        { const float* sp = ssqx + (size_t)(tok0 + r32) * 16; const f32x4 s0 = *(const f32x4*)sp, s1 = *(const f32x4*)(sp + 4), s2 = *(const f32x4*)(sp + 8), s3 = *(const f32x4*)(sp + 12);
          const float sm = ((s0[0] + s0[1]) + (s0[2] + s0[3])) + ((s1[0] + s1[1]) + (s1[2] + s1[3])) + ((s2[0] + s2[1]) + (s2[2] + s2[3])) + ((s3[0] + s3[1]) + (s3[2] + s3[3]));
          if (hi == 0) rsl[r32] = 1.0f / sqrtf(sm * (1.0f / D) + EPS); }
        f32x16 acc;
#pragma unroll
        for (int r = 0; r < 16; ++r) acc[r] = 0.f;
        float gl[4] = {0.f, 0.f, 0.f, 0.f};
        const unsigned xoff = (unsigned)(tok0 + tsub) * 1024u + 4u * kq;
        const unsigned woff = (unsigned)r32 * 1024u + 4u * hi;
        f32x4 X[8], Wa[8], Wb[8];
#define RT_LOADX(kc_) do { _Pragma("unroll") for (int i = 0; i < 8; ++i) { const u32x2 w_ = *(const u32x2*)(x1 + (xoff + 4096u * i + 64u * (kc_))); \
            X[i] = (f32x4){__uint_as_float(w_.x << 16), __uint_as_float(w_.x & 0xffff0000u), __uint_as_float(w_.y << 16), __uint_as_float(w_.y & 0xffff0000u)}; } } while (0)
#define RT_LOADW(W, kc_) do { _Pragma("unroll") for (int c = 0; c < 8; ++c) W[c] = *(const f32x4*)(WrT + (woff + 64u * (kc_) + 8u * c)); } while (0)
#define RT_STEP(W, WN, kc_) do { const unsigned k4 = 64u * (kc_) + 4u * kq; \
            const f32x4 g4 = *(const f32x4*)(gn + k4), sc4 = *(const f32x4*)(scp + k4), sh4 = *(const f32x4*)(shp + k4); const f32x4 gm4 = g4 * (sc4 + 1.0f); \
            _Pragma("unroll") for (int i = 0; i < 8; ++i) { const int tl = 4 * i + tsub; const float rsd = rsl[tl]; const f32x4 h4 = (X[i] * rsd) * gm4 + sh4; \
                int o8 = __builtin_amdgcn_cvt_pk_fp8_f32(h4[0], h4[1], 0, false); o8 = __builtin_amdgcn_cvt_pk_fp8_f32(h4[2], h4[3], o8, true); *(int*)(H8 + (xoff + 4096u * i + 64u * (kc_))) = o8; *(LAS f32x4*)(hT + tl * 68 + 4 * kq) = h4; } \
            if ((kc_) + 1 < 16) { RT_LOADX((kc_) + 1); RT_LOADW(WN, (kc_) + 1); } \
            _Pragma("unroll") for (int c = 0; c < 8; ++c) { const f32x4 b4 = *(const LAS f32x4*)(hT + r32 * 68 + 8 * c + 4 * hi); \
                _Pragma("unroll") for (int j = 0; j < 4; ++j) { acc = __builtin_amdgcn_mfma_f32_32x32x2f32(W[c][j], b4[j], acc, 0, 0, 0); \
                    const f32x4 w4 = *(const LAS f32x4*)(wgl + (64 * (kc_) + 8 * c + 4 * hi + j) * 4); \
                    _Pragma("unroll") for (int q = 0; q < 4; ++q) gl[q] += b4[j] * w4[q]; } asm volatile("" : "+v"(gl[0]), "+v"(gl[1]), "+v"(gl[2]), "+v"(gl[3])); } } while (0)
        RT_LOADX(0); RT_LOADW(Wa, 0);
#pragma unroll 1
        for (int kc = 0; kc < 16; kc += 2) {
            RT_STEP(Wa, Wb, kc);
            RT_STEP(Wb, Wa, kc + 1);
        }
#undef RT_LOADX
#undef RT_LOADW
#undef RT_STEP
#pragma unroll
        for (int q = 0; q < 4; ++q) gl[q] = fa::half_swap_sum(gl[q]);
        float gp[4]; { const float gm = fmaxf(fmaxf(gl[0], gl[1]), fmaxf(gl[2], gl[3])); float gs = 0.f;
#pragma unroll
            for (int g = 0; g < 4; ++g) { gp[g] = expf(gl[g] - gm); gs += gp[g]; }
#pragma unroll
            for (int g = 0; g < 4; ++g) gp[g] /= gs; }
        int gi = 0; float best = -1e30f, gate = 0.f;
#pragma unroll
        for (int g = 0; g < 4; ++g) { const float sv = gp[g] + bg[g]; if (sv > best) { best = sv; gi = g; gate = gp[g]; } }
        float el[8];
#pragma unroll
        for (int j = 0; j < 4; ++j) { const float own = (gi == 0) ? acc[j] : (gi == 1) ? acc[4 + j] : (gi == 2) ? acc[8 + j] : acc[12 + j];
            auto rr = __builtin_amdgcn_permlane32_swap(__float_as_uint(own), __float_as_uint(own), false, false);
            el[j] = __uint_as_float(rr[0]); el[4 + j] = __uint_as_float(rr[1]); }
        float em = el[0];
#pragma unroll
        for (int e = 1; e < 8; ++e) em = fmaxf(em, el[e]);
        float ep[8], es = 0.f;
#pragma unroll
        for (int e = 0; e < 8; ++e) { ep[e] = expf(el[e] - em); es += ep[e]; }
        int i0 = 0; float b0 = -1e30f, p0 = 0.f;
#pragma unroll
        for (int e = 0; e < 8; ++e) { ep[e] /= es; const float sv = ep[e] + br[gi * 8 + e]; if (sv > b0) { b0 = sv; i0 = e; p0 = ep[e]; } }
        int i1 = 0; float b1 = -1e30f, p1 = 0.f;
#pragma unroll
        for (int e = 0; e < 8; ++e) { const float sv = ep[e] + br[gi * 8 + e]; if (e != i0 && sv > b1) { b1 = sv; i1 = e; p1 = ep[e]; } }
        const float den = p0 + p1;
        if (hi == 0) { const int tl = w * 32 + r32; le0[tl] = gi * 8 + i0; le1[tl] = gi * 8 + i1; lw0[tl] = p0 / den * gate; lw1[tl] = p1 / den * gate; }
        __syncthreads();
        int e0 = 0, e1 = 0, q0 = 0, q1 = 0;
        if (C.tid < 256) { e0 = le0[C.tid]; e1 = le1[C.tid]; q0 = atomicAdd(&hist[e0], 1); q1 = atomicAdd(&hist[e1], 1); }
        __syncthreads();
        if (C.tid < 32) base[C.tid] = (int)__hip_atomic_fetch_add(cnt + C.tid * 64, (unsigned)hist[C.tid], __ATOMIC_RELAXED, __HIP_MEMORY_SCOPE_AGENT);
        __syncthreads();
        if (C.tid < 256) { const int tok = chunk * 256 + C.tid;
            const size_t i0_ = (size_t)e0 * NTOK + base[e0] + q0, i1_ = (size_t)e1 * NTOK + base[e1] + q1;
            list[i0_] = 2 * tok; list[i1_] = 2 * tok + 1; listw[i0_] = lw0[C.tid]; listw[i1_] = lw1[C.tid]; }
    }
}

__device__ __forceinline__ void ph_attn_da_mfma(const Ctx& C) {
    using namespace fa;
    LAS unsigned char* L = (LAS unsigned char*)C.lds;
    constexpr int STG = 32768;
    LAS float* wsf = (LAS float*)(L + 3 * STG) + C.wave * 32;
    const int vcu = ((int)blockIdx.x & 7) * 32 + ((int)blockIdx.x >> 3), xcd = vcu >> 5, grp = (vcu >> 4) & 1, jj = vcu & 15;
    const bf16* Q = (const bf16*)(C.ws + WS_A); const bf16* Kb = Q + (size_t)NTOK * D; const bf16* Vb = Kb + (size_t)NTOK * D; bf16* O = (bf16*)(C.ws + WS_O);
    const float lam = *(const float*)(C.ws + WS_LAM);
    const int lane = C.lane, w = C.wave, c = w >> 2, wq = w & 3, r32 = lane & 31, hi = lane >> 5;
    const float c2 = 0.125f * 1.4426950408889634f;
    for (int u = 0; u < 16; ++u) {
        const int bh = xcd * 32 + 2 * u + grp, b = bh >> 3, h = bh & 7, qb = (u & 1) ? 15 - jj : jj, q0 = qb * 128;
        const size_t rowb = (size_t)b * SEQ;
        const int NT = (q0 + 128) / 64, qw0 = q0 + 32 * wq, T = qw0 >> 6;
        const bf16* sbase = (w < 4 ? Kb : Vb) + rowb * D;
        unsigned soff[4]; int dsto[4];
#pragma unroll
        for (int i = 0; i < 4; ++i) {
            if (w < 4) { const int cm = w >> 1, ch = (w & 1) * 4 + i; soff[i] = (unsigned)((lane * D + (2 * h + cm) * 64 + ch * 8) * 2); dsto[i] = cm * 8192 + ch * 1024; }
            else { const int db = w - 4, rg = i; soff[i] = (unsigned)(((rg * 16 + (lane >> 2)) * D + h * 128 + db * 32 + (lane & 3) * 8) * 2); dsto[i] = 16384 + db * 4096 + rg * 1024; }
        }
        bf16x8 qf[4];
#pragma unroll
        for (int d0 = 0; d0 < 4; ++d0) qf[d0] = *(const bf16x8*)(Q + (rowb + qw0 + r32) * D + (2 * h + c) * 64 + d0 * 16 + hi * 8);
#pragma unroll
        for (int d0 = 0; d0 < 4; ++d0) asm volatile("" : "+v"(qf[d0]));
        f32x16 o[4];
#pragma unroll
        for (int db = 0; db < 4; ++db)
#pragma unroll
            for (int r = 0; r < 16; ++r) o[db][r] = 0.f;
        float m = 0.f, l = 0.f; f32x16 negm;
#pragma unroll
        for (int r = 0; r < 16; ++r) negm[r] = 0.f;
        asm volatile("s_waitcnt lgkmcnt(0)" ::: "memory"); __builtin_amdgcn_s_barrier();
#pragma unroll
        for (int i = 0; i < 4; ++i) dma16s(sbase, soff[i], L + dsto[i]);
#pragma unroll
        for (int i = 0; i < 4; ++i) dma16s(sbase + (size_t)64 * D, soff[i], L + STG + dsto[i]);
        int sc_ = 0, sn_ = 2;
        for (int t = 0; t < NT; ++t) {
            if (t + 1 < NT) asm volatile("s_waitcnt vmcnt(4) lgkmcnt(0)" ::: "memory"); else asm volatile("s_waitcnt vmcnt(0) lgkmcnt(0)" ::: "memory");
            __builtin_amdgcn_s_barrier();
            if (t + 2 < NT) {
#pragma unroll
                for (int i = 0; i < 4; ++i) dma16s(sbase + (size_t)(t + 2) * 64 * D, soff[i], L + sn_ * STG + dsto[i]);
            }
            if (t <= T) {
                lds_cptr stg = (lds_cptr)L + sc_ * STG;
                tile<4, 4>(stg + c * 8192, stg + 16384, qf, o, negm, m, l, wsf, t == 0, t == T, qw0 - 64 * T + r32, lane);
            }
            sc_ = (sc_ == 2) ? 0 : sc_ + 1; sn_ = (sn_ == 2) ? 0 : sn_ + 1;
        }
        l = half_swap_sum(l);
        if (hi == 0) wsf[r32] = 1.0f / l;
        asm volatile("s_waitcnt lgkmcnt(0)" ::: "memory");
        f32x4 a4[4];
#pragma unroll
        for (int g = 0; g < 4; ++g) a4[g] = *(const LAS f32x4*)(wsf + 8 * g + 4 * hi);
#pragma unroll
        for (int db = 0; db < 4; ++db)
#pragma unroll
            for (int r = 0; r < 16; ++r) o[db][r] *= a4[r >> 2][r & 3];
        asm volatile("s_waitcnt lgkmcnt(0)" ::: "memory"); __builtin_amdgcn_s_barrier();
        LAS float* X = (LAS float*)L + wq * 4352 + lane * 68;
        if (c == 1) {
#pragma unroll
            for (int db = 0; db < 4; ++db)
#pragma unroll
                for (int g = 0; g < 4; ++g) *(LAS f32x4*)(X + db * 16 + 4 * g) = (f32x4){o[db][4 * g], o[db][4 * g + 1], o[db][4 * g + 2], o[db][4 * g + 3]};
        }
        asm volatile("s_waitcnt lgkmcnt(0)" ::: "memory"); __builtin_amdgcn_s_barrier();
        if (c == 0) {
            float gsub[4];
#pragma unroll
            for (int db = 0; db < 4; ++db) gsub[db] = as_global(C.in[I_DA_SUBLN])[db * 32 + r32] * 0.8f;
#pragma unroll
            for (int db = 0; db < 4; ++db)
#pragma unroll
                for (int g = 0; g < 4; ++g) { const f32x4 x = *(const LAS f32x4*)(X + db * 16 + 4 * g);
#pragma unroll
                    for (int j2 = 0; j2 < 4; ++j2) o[db][4 * g + j2] -= lam * x[j2]; }
            float uu[8];
#pragma unroll
            for (int r = 0; r < 8; ++r) {
                const float sa = (o[0][r] * o[0][r] + o[1][r] * o[1][r]) + (o[2][r] * o[2][r] + o[3][r] * o[3][r]);
                const float sb = (o[0][r + 8] * o[0][r + 8] + o[1][r + 8] * o[1][r + 8]) + (o[2][r + 8] * o[2][r + 8] + o[3][r + 8] * o[3][r + 8]);
                auto sw = __builtin_amdgcn_permlane16_swap(__float_as_uint(sa), __float_as_uint(sb), false, false);
                uu[r] = __uint_as_float(sw[0]) + __uint_as_float(sw[1]);
            }
#pragma unroll
            for (int r = 0; r < 8; ++r) {
                uu[r] += __uint_as_float((unsigned)__builtin_amdgcn_update_dpp(0, (int)__float_as_uint(uu[r]), 0x128, 0xF, 0xF, true));
                uu[r] += __uint_as_float((unsigned)__builtin_amdgcn_update_dpp(0, (int)__float_as_uint(uu[r]), 0x124, 0xF, 0xF, true));
                uu[r] += __uint_as_float((unsigned)__builtin_amdgcn_update_dpp(0, (int)__float_as_uint(uu[r]), 0x122, 0xF, 0xF, true));
                uu[r] += __uint_as_float((unsigned)__builtin_amdgcn_update_dpp(0, (int)__float_as_uint(uu[r]), 0x121, 0xF, 0xF, true));
                uu[r] = __builtin_amdgcn_rsqf(uu[r] * (1.0f / 128.0f) + EPS);
            }
            float rs[16];
#pragma unroll
            for (int r = 0; r < 8; ++r) { auto sw = __builtin_amdgcn_permlane16_swap(__float_as_uint(uu[r]), __float_as_uint(uu[r]), false, false); rs[r] = __uint_as_float(sw[0]); rs[r + 8] = __uint_as_float(sw[1]); }
            asm volatile("s_waitcnt lgkmcnt(0)" ::: "memory");
            LAS unsigned char* TT = (LAS unsigned char*)((LAS float*)L + wq * 4352);
#pragma unroll
            for (int r = 0; r < 16; ++r) {
                const unsigned p01 = cvtpk(o[0][r] * (rs[r] * gsub[0]), o[1][r] * (rs[r] * gsub[1])), p23 = cvtpk(o[2][r] * (rs[r] * gsub[2]), o[3][r] * (rs[r] * gsub[3]));
                LAS unsigned short* tp = (LAS unsigned short*)(TT + crow(r, hi) * 272 + r32 * 2);
                tp[0] = (unsigned short)p01; tp[32] = (unsigned short)(p01 >> 16); tp[64] = (unsigned short)p23; tp[96] = (unsigned short)(p23 >> 16);
            }
            asm volatile("s_waitcnt lgkmcnt(0)" ::: "memory");
#pragma unroll
            for (int i = 0; i < 8; ++i) {
                const int row = 4 * i + (lane >> 4);
                const u32x4 v = *(const LAS u32x4*)(TT + row * 272 + (lane & 15) * 16);
                *(u32x4*)(O + (rowb + qw0 + row) * D + h * 128 + (lane & 15) * 8) = v;
            }
        }
    }
}
__device__ __forceinline__ void ph_attn_mla_mfma(const Ctx& C) {
    using namespace fa;
    LAS unsigned char* L = (LAS unsigned char*)C.lds;
    constexpr int STG = 20480;
    LAS float* wsf = (LAS float*)(L + 3 * STG) + C.wave * 32;
    const int vcu = ((int)blockIdx.x & 7) * 32 + ((int)blockIdx.x >> 3), xcd = vcu >> 5, grp = (vcu >> 3) & 3, jj = vcu & 7;
    const bf16* Q2 = (const bf16*)(C.ws + WS_A); const bf16* KV2 = (const bf16*)(C.ws + WS_A + 192 * MiB);
    const bf16* KPE = (const bf16*)(C.ws + WS_KPE); bf16* O = (bf16*)(C.ws + WS_O);
    const int lane = C.lane, w = C.wave, r32 = lane & 31, hi = lane >> 5;
    const float c2 = 0.10206207261596575f * 1.4426950408889634f;
    for (int u = 0; u < 16; ++u) {
        const int bh = xcd * 64 + 4 * u + grp, b = bh >> 4, h = bh & 15, qb = (u & 1) ? 7 - jj : jj, q0 = qb * 256;
        const size_t rowb = (size_t)b * SEQ;
        const int NT = (q0 + 256) / 64, qw0 = q0 + 32 * w, T = qw0 >> 6;
        const bf16* src[3]; int dsto[3]; size_t sstep[3];
#pragma unroll
        for (int i = 0; i < 3; ++i) {
            const int pi = w + 8 * i;
            if (pi < 8) { src[i] = KV2 + (rowb + lane) * 2048 + h * 128 + pi * 8; dsto[i] = pi * 1024; sstep[i] = (size_t)64 * 2048; }
            else if (pi < 12) { src[i] = KPE + (rowb + lane) * 32 + (pi - 8) * 8; dsto[i] = pi * 1024; sstep[i] = (size_t)64 * 32; }
            else { const int db = (pi - 12) >> 2, rg = (pi - 12) & 3; src[i] = KV2 + (rowb + rg * 16 + (lane >> 2)) * 2048 + h * 128 + 64 + db * 32 + (lane & 3) * 8; dsto[i] = 12288 + db * 4096 + rg * 1024; sstep[i] = (size_t)64 * 2048; }
        }
        const bool has3 = (w + 16) < 20;
        bf16x8 qf[6];
#pragma unroll
        for (int d0 = 0; d0 < 6; ++d0) qf[d0] = *(const bf16x8*)(Q2 + (rowb + qw0 + r32) * 1536 + h * 96 + d0 * 16 + hi * 8);
#pragma unroll
        for (int d0 = 0; d0 < 6; ++d0) asm volatile("" : "+v"(qf[d0]));
        f32x16 o[2];
#pragma unroll
        for (int db = 0; db < 2; ++db)
#pragma unroll
            for (int r = 0; r < 16; ++r) o[db][r] = 0.f;
        float m = 0.f, l = 0.f; f32x16 negm;
#pragma unroll
        for (int r = 0; r < 16; ++r) negm[r] = 0.f;
        asm volatile("s_waitcnt lgkmcnt(0)" ::: "memory"); __builtin_amdgcn_s_barrier();
        dma16(src[0], L + dsto[0]); dma16(src[1], L + dsto[1]); if (has3) dma16(src[2], L + dsto[2]);
        dma16(src[0] + sstep[0], L + STG + dsto[0]); dma16(src[1] + sstep[1], L + STG + dsto[1]); if (has3) dma16(src[2] + sstep[2], L + STG + dsto[2]);
        int sc_ = 0, sn_ = 2;
        for (int t = 0; t < NT; ++t) {
            if (t + 1 < NT) { if (has3) asm volatile("s_waitcnt vmcnt(3) lgkmcnt(0)" ::: "memory"); else asm volatile("s_waitcnt vmcnt(2) lgkmcnt(0)" ::: "memory"); }
            else asm volatile("s_waitcnt vmcnt(0) lgkmcnt(0)" ::: "memory");
            __builtin_amdgcn_s_barrier();
            if (t + 2 < NT) {
                LAS unsigned char* nb = L + sn_ * STG;
                dma16(src[0] + (t + 2) * sstep[0], nb + dsto[0]); dma16(src[1] + (t + 2) * sstep[1], nb + dsto[1]); if (has3) dma16(src[2] + (t + 2) * sstep[2], nb + dsto[2]);
            }
            if (t <= T) {
                lds_cptr stg = (lds_cptr)L + sc_ * STG;
                tile<6, 2>(stg, stg + 12288, qf, o, negm, m, l, wsf, t == 0, t == T, qw0 - 64 * T + r32, lane);
            }
            sc_ = (sc_ == 2) ? 0 : sc_ + 1; sn_ = (sn_ == 2) ? 0 : sn_ + 1;
        }
        l = half_swap_sum(l);
        if (hi == 0) wsf[r32] = 1.0f / l;
        asm volatile("s_waitcnt lgkmcnt(0)" ::: "memory");
        f32x4 a4[4];
#pragma unroll
        for (int g = 0; g < 4; ++g) a4[g] = *(const LAS f32x4*)(wsf + 8 * g + 4 * hi);
        LAS unsigned char* TT = L + 65536 + w * 4608;
#pragma unroll
        for (int r = 0; r < 16; ++r) {
            const unsigned pk = cvtpk(o[0][r] * a4[r >> 2][r & 3], o[1][r] * a4[r >> 2][r & 3]);
            LAS unsigned short* tp = (LAS unsigned short*)(TT + crow(r, hi) * 144 + r32 * 2);
            tp[0] = (unsigned short)pk; tp[32] = (unsigned short)(pk >> 16);
        }
        asm volatile("s_waitcnt lgkmcnt(0)" ::: "memory");
#pragma unroll
        for (int i = 0; i < 4; ++i) {
            const int row = 8 * i + (lane >> 3);
            const u32x4 v = *(const LAS u32x4*)(TT + row * 144 + (lane & 7) * 16);
            *(u32x4*)(O + (rowb + qw0 + row) * D + h * 64 + (lane & 7) * 8) = v;
        }
    }
}

__global__ void __launch_bounds__(NTHR, 2) fwd(Args args) {
    extern __shared__ __attribute__((aligned(16))) unsigned char lds[];
    Ctx C; C.in = args.in; C.out = args.out; C.ws = args.ws; C.lds = lds;
    C.tid = threadIdx.x; C.lane = C.tid & 63; C.wave = __builtin_amdgcn_readfirstlane(C.tid >> 6);
    C.gw = blockIdx.x * NWAVES + C.wave; C.ngw = gridDim.x * NWAVES;
    const Ctx C0 = C;
    volatile LAS unsigned* MISC = (volatile LAS unsigned*)((LAS unsigned char*)lds + MISC_OFF);
    if (C.tid < 32) MISC[C.tid] = 0u;
    __syncthreads();
    XcdBarrier bar; bar.bar = (unsigned*)(args.ws + WS_CTL) + CW_BAR; bar.x = 0; bar.st = nullptr;
    const int lo = args.ph_lo, hi = args.ph_hi;
    if (hi - lo > 1) bar = xcd_barrier_post((unsigned*)(args.ws + WS_CTL) + CW_BAR, MISC + 8);
#ifndef REPMASK
#define REPMASK 0u
#endif
#ifndef PHMASK
#define PHMASK 0xFFFFFFFFu
#endif
#define IN(k) (lo <= (k) && (k) < hi && ((PHMASK >> (k)) & 1u))
#define SEAM(k) do { if (IN(k) && IN((k) + 1)) xcd_barrier(bar); } while (0)
#define PHLOCAL unsigned char* ws = args.ws; asm volatile("" : "+s"(ws)); ws = as_global(ws); int t_ = threadIdx.x; asm volatile("" : "+v"(t_)); Ctx C = C0; C.ws = ws; C.tid = t_; C.lane = t_ & 63; \
        bf16* H = (bf16*)(ws + WS_H); bf16* O = (bf16*)(ws + WS_O); bf16* A0 = (bf16*)(ws + WS_A); (void)H; (void)O; (void)A0;

    if (IN(0)) { PHLOCAL ph_prologue(C); } SEAM(0);
    if (IN(1)) { PHLOCAL ph_normmod0(C); } SEAM(1);
    if (IN(2)) { PHLOCAL
        pg8::Gemm g{H, (const bf16*)(ws + WB_QKV), NTOK, 3 * D, D}; pg8::StaticOrder S; S.init(NTOK, 3 * D, (int)gridDim.x, (int)blockIdx.x);
        pg8::EpiQKV E{A0, A0 + (size_t)NTOK * D, A0 + (size_t)2 * NTOK * D, (const float*)(ws + WS_COSD), (const float*)(ws + WS_SIND), as_global(args.in[I_DA_QN]), as_global(args.in[I_DA_KN]), 0.125f * 1.4426950408889634f, EPS};
        pg8::gemm_phase<pg8::EpiQKV, pg8::StaticOrder, PG8_ALIGN, PG8_SP2>((PG8_LAS unsigned char*)lds, g, S, E);
    } SEAM(2);
    if (IN(3)) { PHLOCAL ph_attn_da_mfma(C); } SEAM(3);
    if (IN(4)) { PHLOCAL
        pg8::Gemm g{O, (const bf16*)(ws + WB_DAO), NTOK, D, D}; pg8::StaticOrder S; S.init(NTOK, D, (int)gridDim.x, (int)blockIdx.x);
        pg8::EpiResid<true> E{as_global(args.in[I_X]), (bf16*)(ws + WS_XB), C.mod(0, 0, 2), (float*)(ws + WS_SSQX)};
        pg8::gemm_phase<pg8::EpiResid<true>, pg8::StaticOrder, PG8_ALIGN, PG8_SP2>((PG8_LAS unsigned char*)lds, g, S, E);
    } SEAM(4);
    if (IN(5)) { PHLOCAL ph_route(C, 0); } SEAM(5);
    if (IN(6)) { PHLOCAL ph_moe1_mfma(C, 0); } SEAM(6);
    if (IN(7)) { PHLOCAL ph_moe2_mfma(C, 0); } SEAM(7);
    if (IN(8)) { PHLOCAL ph_comb<false>(C, ws + WS_A + 128 * MiB, C.mod(0, 0, 5), 1, as_global(args.in[I_NMIX]) + D); } SEAM(8);
    if (IN(9)) { PHLOCAL
        bf16* CQ = (bf16*)(ws + WS_S); bf16* CKV = CQ + (size_t)NTOK * 384; bf16* KPE = (bf16*)(ws + WS_KPE);
        pg8::Gemm g{H, (const bf16*)(ws + WB_WIN), NTOK, 768, D}; pg8::StaticOrder S; S.init(NTOK, 768, (int)gridDim.x, (int)blockIdx.x);
        pg8::EpiWin E{CQ, CKV, KPE, (float*)(ws + WS_SSQ), (const float*)(ws + WS_COSM), (const float*)(ws + WS_SINM), as_global(args.in[I_M_KPN]), EPS};
        pg8::gemm_phase<pg8::EpiWin, pg8::StaticOrder, PG8_ALIGN, PG8_SP2>((PG8_LAS unsigned char*)lds, g, S, E);
    } SEAM(9);
    if (IN(10)) { PHLOCAL
        const bf16* CQ = (const bf16*)(ws + WS_S); const bf16* CKV = CQ + (size_t)NTOK * 384;
        int Kq = 384, Kkv = 256; asm volatile("" : "+s"(Kq), "+s"(Kkv));
        { pg8::Gemm g{CQ, (const bf16*)(ws + WB_WUQ), NTOK, 1536, Kq}; pg8::StaticOrder S; S.init(NTOK, 1536, (int)gridDim.x, (int)blockIdx.x);
          pg8::EpiUQ E{A0, (const float*)(ws + WS_SSQ), (const float*)(ws + WS_COSM), (const float*)(ws + WS_SINM), as_global(args.in[I_M_QNN]), as_global(args.in[I_M_QPN]), 0.10206207261596575f * 1.4426950408889634f, EPS};
          pg8::gemm_phase<pg8::EpiUQ, pg8::StaticOrder, PG8_ALIGN, PG8_SP2>((PG8_LAS unsigned char*)lds, g, S, E); }
        { pg8::Gemm g{CKV, (const bf16*)(ws + WB_WUKV), NTOK, 2048, Kkv}; pg8::StaticOrder S; S.init(NTOK, 2048, (int)gridDim.x, (int)blockIdx.x);
          pg8::EpiUKV E{(bf16*)(ws + WS_A + 192 * MiB), (const float*)(ws + WS_SSQ), as_global(args.in[I_M_KNN]), EPS};
          pg8::gemm_phase<pg8::EpiUKV, pg8::StaticOrder, PG8_ALIGN, PG8_SP2>((PG8_LAS unsigned char*)lds, g, S, E); }
    } SEAM(10);
    if (IN(11)) { PHLOCAL ph_attn_mla_mfma(C); } SEAM(11);
    if (IN(12)) { PHLOCAL
        pg8::Gemm g{O, (const bf16*)(ws + WB_MLO), NTOK, D, D}; pg8::StaticOrder S; S.init(NTOK, D, (int)gridDim.x, (int)blockIdx.x);
        pg8::EpiResid<false> E{ws + WS_XB, (bf16*)(ws + WS_XB), C.mod(1, 0, 2), (float*)(ws + WS_SSQX)};
        pg8::gemm_phase<pg8::EpiResid<false>, pg8::StaticOrder, PG8_ALIGN, PG8_SP2>((PG8_LAS unsigned char*)lds, g, S, E);
    } SEAM(12);
    if (IN(13)) { PHLOCAL ph_route(C, 1); } SEAM(13);
    if (IN(14)) { PHLOCAL ph_moe1_mfma(C, 1); } SEAM(14);
    if (IN(15)) { PHLOCAL ph_moe2_mfma(C, 1); } SEAM(15);
    if (IN(16)) { PHLOCAL ph_comb<true>(C, ws + WS_A + 128 * MiB, C.mod(1, 0, 5), 1, as_global(args.in[I_NMIX])); }
#undef IN
#undef SEAM
}

extern "C" void kernel_launch(void* const* d_in, const int* in_sizes, int n_in, void* d_out, int out_size, void* d_ws, size_t ws_size, hipStream_t stream) {
    static int grid = 0;
    if (grid == 0) {
        if (n_in != 33 || out_size != NTOK * D || ws_size < WS_END) { fprintf(stderr, "kernel_launch: unexpected shapes n_in %d out %d ws %zu\n", n_in, out_size, ws_size); grid = -1; return; }
        int dev = 0, cus = 0;
        if (hipGetDevice(&dev) != hipSuccess || hipDeviceGetAttribute(&cus, hipDeviceAttributeMultiprocessorCount, dev) != hipSuccess) { grid = -1; return; }
        if (hipFuncSetAttribute((const void*)fwd, hipFuncAttributeMaxDynamicSharedMemorySize, LDS_BYTES) != hipSuccess) { fprintf(stderr, "hipFuncSetAttribute failed\n"); grid = -1; return; }
        (void)hipGetLastError();
        grid = cus;
        if (grid != 256) { fprintf(stderr, "kernel_launch: built for 256 CUs, device reports %d\n", cus); grid = -1; return; }
    }
    if (grid < 0) return;
    (void)hipMemsetAsync((char*)d_ws + WS_CTL, 0, CTL_ZERO_BYTES, stream);
    Args a{};
    for (int i = 0; i < 33; ++i) a.in[i] = (const float*)d_in[i];
    a.out = (float*)d_out; a.ws = (unsigned char*)d_ws;
#if MK_ONE_LAUNCH
    a.ph_lo = 0; a.ph_hi = N_PHASES;
    hipLaunchKernelGGL(fwd, dim3(grid), dim3(NTHR), LDS_BYTES, stream, a);
#else
    for (int p = 0; p < N_PHASES; ++p) { a.ph_lo = p; a.ph_hi = p + 1; hipLaunchKernelGGL(fwd, dim3(grid), dim3(NTHR), LDS_BYTES, stream, a); }
#endif
}
```

```cpp
#include <hip/hip_runtime.h>
#include <cstdio>
#include <cstdint>

#define LAS __attribute__((address_space(3)))
#define GAS __attribute__((address_space(1)))
template <class T> __device__ __forceinline__ T* as_global(T* p) { GAS T* g = (GAS T*)p; asm("" : "+s"(g)); return (T*)g; }
typedef unsigned short bf16;
typedef float f32x4 __attribute__((ext_vector_type(4)));
typedef unsigned u32x4 __attribute__((ext_vector_type(4)));
typedef unsigned u32x2 __attribute__((ext_vector_type(2)));

constexpr int NB = 32, SEQ = 2048, D = 1024, NTOK = NB * SEQ;
constexpr float EPS = 1e-6f;
constexpr int NWAVES = 8, NTHR = 512;
constexpr int N_PHASES = 17;
#ifndef MK_ONE_LAUNCH
#define MK_ONE_LAUNCH 1
#endif

constexpr size_t MiB = 1u << 20;
constexpr size_t WS_CTL = 0, CTL_ZERO_BYTES = 1 * MiB;
constexpr size_t WS_MOD = 1 * MiB;
constexpr size_t WS_LAM = WS_MOD + 7 * MiB / 4;
constexpr size_t WS_SSQX = 4 * MiB;
constexpr size_t WS_SSQ = 8 * MiB;
constexpr size_t WS_WRT = 12 * MiB;
constexpr size_t WS_COSD = 16 * MiB, WS_SIND = 24 * MiB, WS_COSM = 32 * MiB, WS_SINM = 36 * MiB;
constexpr size_t WS_TOKW = 40 * MiB;
constexpr size_t WS_LIST = 42 * MiB;
constexpr size_t WS_WB = 50 * MiB;
constexpr size_t WB_QKV = WS_WB, WB_DAO = WB_QKV + 6 * MiB, WB_WIN = WB_DAO + 2 * MiB, WB_WUQ = WB_WIN + 3 * MiB / 2, WB_WUKV = WB_WUQ + 9 * MiB / 8, WB_MLO = WB_WUKV + 1 * MiB, WB_MOE = WB_MLO + 2 * MiB;
constexpr size_t WS_H = 176 * MiB;
constexpr size_t WS_O = 304 * MiB;
constexpr size_t WS_A = 432 * MiB;
constexpr size_t WS_LISTW = 160 * MiB;
constexpr size_t WS_KPE = 168 * MiB;
constexpr size_t WS_S = WS_O;
constexpr size_t WS_XB = 880 * MiB;
constexpr size_t WS_END = 1008 * MiB;
constexpr int CW_BAR = 4096;
constexpr int CW_CNT = 16384;
constexpr int HID_ROWS = 2 * NTOK + 32 * 128;

constexpr int LDS_BYTES = 147456;
constexpr int MISC_OFF = 131072 + 320;

__device__ __forceinline__ unsigned f2bf(float f) { unsigned u = __builtin_bit_cast(unsigned, f); return (u + 0x7fffu + ((u >> 16) & 1u)) >> 16; }
__device__ __forceinline__ float bf2f(unsigned h) { return __builtin_bit_cast(float, h << 16); }
__device__ __forceinline__ unsigned pk2(float lo, float hi) { return f2bf(lo) | (f2bf(hi) << 16); }
__device__ __forceinline__ float wave_sum(float v) {
#pragma unroll
    for (int o = 1; o < 64; o <<= 1) v += __shfl_xor(v, o);
    return v;
}
__device__ __forceinline__ float wave_max(float v) {
#pragma unroll
    for (int o = 1; o < 64; o <<= 1) v = fmaxf(v, __shfl_xor(v, o));
    return v;
}

#define XB_TMO      128
#define XB_XCNT(j)  (256  + 64 * (j))
#define XB_XSUB(j)  (1280 + 64 * (j))
#define XB_XGEN(j)  (2304 + 64 * (j))
#define XB_TOP      3328
#define XB_TOPGEN   3392
#define XCD_BAR_WORDS 3456
#define XB_SPIN_CAP (1u << 20)
__device__ __forceinline__ unsigned xb_ld(unsigned* p)              { return __hip_atomic_load(p, __ATOMIC_RELAXED, __HIP_MEMORY_SCOPE_AGENT); }
__device__ __forceinline__ unsigned xb_add(unsigned* p, unsigned v) { return __hip_atomic_fetch_add(p, v, __ATOMIC_RELAXED, __HIP_MEMORY_SCOPE_AGENT); }
__device__ __forceinline__ unsigned xb_xcc_id() { return (unsigned)__builtin_amdgcn_s_getreg((3 << 11) | 20) & 0xFu; }
#define XB_SPIN(cond, bar) do { unsigned _sp = 0; while (cond) { __builtin_amdgcn_s_sleep(1); \
    if ((++_sp & 255u) == 0u) { if (xb_ld(&(bar)[XB_TMO])) break; if (_sp > XB_SPIN_CAP) { atomicAdd(&(bar)[XB_TMO], 1u); break; } } } } while (0)
struct XcdBarrier { unsigned* bar; unsigned x; volatile LAS unsigned* st; };
__device__ __forceinline__ XcdBarrier xcd_barrier_post(unsigned* bar, volatile LAS unsigned* st) {
    XcdBarrier b; b.bar = bar; b.x = xb_xcc_id(); b.st = st;
    if (threadIdx.x == 0) (void)xb_add(&bar[XB_XCNT(b.x)], 1u);
    return b;
}
__device__ __forceinline__ void xcd_barrier_complete(unsigned* bar, unsigned x, unsigned& nloc, unsigned& nx) {
    const unsigned G = gridDim.x * gridDim.y * gridDim.z;
    unsigned sum, cnt, mine, sp = 0u;
    for (;;) {
        sum = 0u; cnt = 0u; mine = 0u;
#pragma unroll
        for (unsigned j = 0; j < 16; ++j) { const unsigned c = xb_ld(&bar[XB_XCNT(j)]); sum += c; cnt += (c > 0u) ? 1u : 0u; mine = (j == x) ? c : mine; }
        if (sum == G) break;
        __builtin_amdgcn_s_sleep(1);
        if ((++sp & 255u) == 0u) { if (xb_ld(&bar[XB_TMO])) break; if (sp > XB_SPIN_CAP) { atomicAdd(&bar[XB_TMO], 1u); break; } }
    }
    nloc = mine > 0u ? mine : 1u; nx = cnt > 0u ? cnt : 1u;
}
__device__ __forceinline__ void xcd_barrier(const XcdBarrier& b) {
    asm volatile("s_waitcnt vmcnt(0)" ::: "memory");
    __syncthreads();
    if (threadIdx.x == 0) {
        unsigned* bar = b.bar;
        __builtin_amdgcn_s_waitcnt(0);
        unsigned nloc = b.st[0], nx = b.st[1];
        if (nloc == 0u) { xcd_barrier_complete(bar, b.x, nloc, nx); b.st[0] = nloc; b.st[1] = nx; }
        const unsigned old = xb_add(&bar[XB_XSUB(b.x)], 1u);
        const unsigned gen = old / nloc;
        if (old + 1u == (gen + 1u) * nloc) {
            __builtin_amdgcn_fence(__ATOMIC_RELEASE, "agent");
            asm volatile("s_waitcnt vmcnt(0)" ::: "memory");
            const unsigned og = xb_add(&bar[XB_TOP], 1u);
            const unsigned tg = og / nx;
            if (og + 1u == (tg + 1u) * nx) xb_add(&bar[XB_TOPGEN], 1u);
            else XB_SPIN(xb_ld(&bar[XB_TOPGEN]) == tg, bar);
            __builtin_amdgcn_fence(__ATOMIC_ACQUIRE, "agent");
            xb_add(&bar[XB_XGEN(b.x)], 1u);
            asm volatile("s_waitcnt vmcnt(0)" ::: "memory");
        } else {
            XB_SPIN(xb_ld(&bar[XB_XGEN(b.x)]) == gen, bar);
            __builtin_amdgcn_fence(__ATOMIC_ACQUIRE, "agent");
            asm volatile("s_waitcnt vmcnt(0)" ::: "memory");
        }
    }
    __syncthreads();
}

namespace pg8 {
#define PG8_LAS __attribute__((address_space(3)))
typedef unsigned short bf16_t;
typedef short bf16x8 __attribute__((ext_vector_type(8)));
typedef float f32x4 __attribute__((ext_vector_type(4)));
typedef unsigned u32x4 __attribute__((ext_vector_type(4)));
constexpr int BM = 256, BK = 64, HALF = 128, HTB = HALF * BK * 2  , STAGE_BYTES = 8 * HTB, NXCD = 8, WGM = 8;

__host__ __device__ __forceinline__ int lds_byte(int r, int c) { const int st = (r >> 4) * 2 + (c >> 5), rr = r & 15, cc = c & 31, ob = rr * 64 + cc * 2; return st * 1024 + (ob ^ (((ob >> 9) & 1) << 5)); }
__host__ __device__ __forceinline__ void stage_rc(int b, int& R, int& C) { const int st = b / 1024, sb = b % 1024, swz = sb ^ (((sb >> 9) & 1) << 5); R = (st >> 1) * 16 + swz / 64; C = (st & 1) * 32 + (swz % 64) / 2; }
__host__ __device__ __forceinline__ int perm32(int rho) { const int n = rho >> 4, i = rho & 15; return 8 * (i >> 2) + 4 * n + (i & 3); }

struct Unit { int pm, pn; };
struct Gemm { const bf16_t* A; const bf16_t* Bt; int M, N, K; };

struct StaticOrder {
    typedef Unit UnitT;
    int nM, nN, nwg, G, c;
    __host__ __device__ void init(int M, int N, int G_, int c_) { nM = M / BM; nN = N / BM; nwg = nM * nN; G = G_; c = c_; }
    __host__ __device__ bool next(int i, Unit& u) const {
        const long L = (long)i * G + c; if (L >= nwg) return false;
        int wgid = (int)L; { const int q = nwg / NXCD, r = nwg % NXCD, xcd = wgid % NXCD, off = wgid / NXCD; wgid = (xcd < r ? xcd * (q + 1) : r * (q + 1) + (xcd - r) * q) + off; }
        const int nig = WGM * nN, gid = wgid / nig, fm = gid * WGM, gsz = (nM - fm) < WGM ? (nM - fm) : WGM;
        u.pm = fm + ((wgid % nig) % gsz); u.pn = (wgid % nig) / gsz; return true;
    }
    __device__ __forceinline__ void a_ready(const Unit&) const {}
    __device__ __forceinline__ void done(const Unit&) const {}
};

__device__ __forceinline__ unsigned cvt_pk_bf16(float lo, float hi) { unsigned r; asm volatile("v_cvt_pk_bf16_f32 %0, %1, %2" : "=v"(r) : "v"(lo), "v"(hi)); return r; }
typedef float f32x2 __attribute__((ext_vector_type(2)));
__device__ __forceinline__ f32x2 gelu_pk(f32x2 v) {
    const f32x2 av = __builtin_elementwise_abs(v), d = av * 0.2316418882f + 1.0f;
    f32x2 t; t.x = __builtin_amdgcn_rcpf(d.x); t.y = __builtin_amdgcn_rcpf(d.y);
    f32x2 q = t * 0.5307027145f + (-0.7265760135f); q = q * t + 0.7107068705f; q = q * t + (-0.142248368f); q = q * t + 0.127414796f; q = q * t;
    const f32x2 s = (v * v) * (-0.72134752044f);
    f32x2 e; e.x = __builtin_amdgcn_exp2f(s.x); e.y = __builtin_amdgcn_exp2f(s.y);
    const f32x2 m = v * (q * e), r = v - m;
    f32x2 o; o.x = v.x < 0.f ? m.x : r.x; o.y = v.y < 0.f ? m.y : r.y; return o;
}

template <int ACT  > struct EpiBf16 {
    static constexpr bool PERM = true, AFTER_DRAIN = false; static_assert(ACT == 0 || ACT == 1, "EpiBf16: ACT is 0 (none) or 1 (gelu_pk)");
    bf16_t* O; int ldc; const float* bias; int split_cols; size_t split_stride; float scale0;
    __device__ __forceinline__ void operator()(const f32x4 (&acc)[2][2][4][2], const Unit& u, int wr, int wc, int fr, int fq) const {
        const int row0 = u.pm * BM + wr * 64 + fr; int colt = u.pn * BM; bf16_t* base = O;
        float sc = 1.f; if (split_cols) { const int t = colt / split_cols; base += (size_t)t * split_stride; colt -= t * split_cols; if (t == 0) sc = scale0; }
        const int col0 = colt + wc * 32 + 8 * fq, bcol0 = u.pn * BM + wc * 32 + 8 * fq;
        f32x4 bv[2][2];
#pragma unroll
        for (int bj = 0; bj < 2; ++bj)
#pragma unroll
            for (int n = 0; n < 2; ++n) bv[bj][n] = bias ? *(const f32x4*)(bias + bcol0 + bj * HALF + 4 * n) : (f32x4){0.f, 0.f, 0.f, 0.f};
#pragma unroll
        for (int ai = 0; ai < 2; ++ai)
#pragma unroll
            for (int m = 0; m < 4; ++m) { bf16_t* rowp = base + (size_t)(row0 + ai * HALF + m * 16) * ldc + col0;
#pragma unroll
                for (int bj = 0; bj < 2; ++bj) { f32x4 v0 = acc[ai][bj][m][0] + bv[bj][0], v1 = acc[ai][bj][m][1] + bv[bj][1];
                    if (ACT == 1) { f32x2 a = gelu_pk((f32x2){v0[0], v0[1]}), b = gelu_pk((f32x2){v0[2], v0[3]}), c = gelu_pk((f32x2){v1[0], v1[1]}), d = gelu_pk((f32x2){v1[2], v1[3]});
                        v0 = (f32x4){a.x, a.y, b.x, b.y}; v1 = (f32x4){c.x, c.y, d.x, d.y}; }
                    v0 = v0 * sc; v1 = v1 * sc; u32x4 w; w.x = cvt_pk_bf16(v0[0], v0[1]); w.y = cvt_pk_bf16(v0[2], v0[3]); w.z = cvt_pk_bf16(v1[0], v1[1]); w.w = cvt_pk_bf16(v1[2], v1[3]);
                    *(u32x4*)(rowp + bj * HALF) = w; } }
    }
};

template <class Epi, class Sched, bool ALIGN_EPI = false, bool SP2 = false>
__device__ __forceinline__ void gemm_phase(PG8_LAS unsigned char* lds, const Gemm g, const Sched& S, const Epi& E) {
    int tid_ = threadIdx.x; asm volatile("" : "+v"(tid_));
    const int tid = tid_, wid = __builtin_amdgcn_readfirstlane(tid >> 6), lane = tid & 63, wr = wid >> 2, wc = wid & 3, fr = lane & 15, fq = lane >> 4;
    const int K = g.K, nt = K / BK;
    unsigned voffA[2], voffB[2];
#pragma unroll
    for (int i = 0; i < 2; ++i) { int R, C; stage_rc(tid * 16 + i * 8192, R, C); const int Rb = Epi::PERM ? ((R & ~31) + perm32(R & 31)) : R;
        voffA[i] = (unsigned)(R * K + C) * 2u; voffB[i] = (unsigned)(Rb * K + C) * 2u; }
    const size_t kstep = (size_t)(BK * 2);
    const size_t hstep = (size_t)HALF * K * 2;
    const size_t tstep = 2 * hstep;
    const unsigned ldsw = (unsigned)wid * 1024u;
    const int aoff = lds_byte(wr * 64 + fr, fq * 8), boff = lds_byte(wc * 32 + fr, fq * 8);
#define PG8_SA(b, h) (((b) * 2 + (h)) * HTB)
#define PG8_SB(b, h) ((4 + (b) * 2 + (h)) * HTB)
#define PG8_STAGE(bufoff, gbase, voff) do { _Pragma("unroll") for (int _i = 0; _i < 2; ++_i) \
        __builtin_amdgcn_global_load_lds((const unsigned*)((const char*)(gbase) + (voff)[_i]), (PG8_LAS unsigned*)(lds + (bufoff) + ldsw + _i * 8192), 16, 0, 0); } while (0)
#define PG8_LDA(dst, b, h) do { _Pragma("unroll") for (int m = 0; m < 4; ++m) _Pragma("unroll") for (int k = 0; k < 2; ++k) dst[m][k] = *(const PG8_LAS bf16x8*)(lds + PG8_SA(b, h) + aoff + m * 2048 + k * 1024); } while (0)
#define PG8_LDB(dst, b, h) do { _Pragma("unroll") for (int n = 0; n < 2; ++n) _Pragma("unroll") for (int k = 0; k < 2; ++k) dst[n][k] = *(const PG8_LAS bf16x8*)(lds + PG8_SB(b, h) + boff + n * 2048 + k * 1024); } while (0)
#define PG8_MMA(ai, bj, At, Bt) do { __builtin_amdgcn_s_setprio(1); _Pragma("unroll") for (int m = 0; m < 4; ++m) _Pragma("unroll") for (int n = 0; n < 2; ++n) _Pragma("unroll") for (int k = 0; k < 2; ++k) \
        acc[ai][bj][m][n] = __builtin_amdgcn_mfma_f32_16x16x32_bf16(Bt[n][k], At[m][k], acc[ai][bj][m][n], 0, 0, 0); __builtin_amdgcn_s_setprio(0); } while (0)
#define PG8_WAIT_V(n) asm volatile("s_waitcnt vmcnt(" #n ")" ::: "memory")
#define PG8_WAIT_L(n) asm volatile("s_waitcnt lgkmcnt(" #n ")" ::: "memory")
#define PG8_BAR __builtin_amdgcn_s_barrier()
#define PG8_SCHED __builtin_amdgcn_sched_barrier(0)
    typename Sched::UnitT cur, nxt; int ui = 0;
    if (!S.next(0, cur)) return;
    f32x4 acc[2][2][4][2];
#pragma unroll
    for (int a = 0; a < 2; ++a)
#pragma unroll
        for (int b = 0; b < 2; ++b)
#pragma unroll
            for (int m = 0; m < 4; ++m)
#pragma unroll
                for (int n = 0; n < 2; ++n) acc[a][b][m][n] = (f32x4){0.f, 0.f, 0.f, 0.f};
    bf16x8 At[4][2], B0[2][2], B1[2][2];
    const char* cA = (const char*)g.A + (size_t)cur.pm * tstep; const char* cB = (const char*)g.Bt + (size_t)cur.pn * tstep;
    S.a_ready(cur);
    if constexpr (SP2) {
        PG8_STAGE(PG8_SB(0, 0), cB, voffB); PG8_STAGE(PG8_SB(0, 1), cB + hstep, voffB); PG8_STAGE(PG8_SA(0, 0), cA, voffA); PG8_STAGE(PG8_SA(0, 1), cA + hstep, voffA);
        if (wr == 1) PG8_BAR;
        PG8_WAIT_V(2); PG8_BAR;
        PG8_STAGE(PG8_SB(1, 0), cB + kstep, voffB); PG8_STAGE(PG8_SA(1, 0), cA + kstep, voffA); PG8_STAGE(PG8_SB(1, 1), cB + hstep + kstep, voffB);
        PG8_WAIT_V(6); PG8_BAR;
    } else {
        PG8_STAGE(PG8_SB(0, 0), cB, voffB); PG8_STAGE(PG8_SA(0, 0), cA, voffA); PG8_STAGE(PG8_SB(0, 1), cB + hstep, voffB); PG8_STAGE(PG8_SA(0, 1), cA + hstep, voffA);
        if (wr == 1) PG8_BAR;
        PG8_WAIT_V(4); PG8_BAR;
        PG8_STAGE(PG8_SB(1, 0), cB + kstep, voffB); PG8_STAGE(PG8_SA(1, 0), cA + kstep, voffA); PG8_STAGE(PG8_SB(1, 1), cB + hstep + kstep, voffB);
        PG8_WAIT_V(6); PG8_BAR;
    }
    for (;;) {
        const bool has_next = S.next(ui + 1, nxt);
        const char* nA = has_next ? (const char*)g.A + (size_t)nxt.pm * tstep : cA; const char* nB = has_next ? (const char*)g.Bt + (size_t)nxt.pn * tstep : cB;
        for (int t = 0; t < nt; t += 2) {
            const bool last = (t == nt - 2);
            const char* a1 = cA + (size_t)(t + 1) * kstep;
            const char* a2 = last ? nA : cA + (size_t)(t + 2) * kstep; const char* b2 = last ? nB : cB + (size_t)(t + 2) * kstep;
            const char* a3 = a2 + kstep; const char* b3 = b2 + kstep;
            if (last && has_next) S.a_ready(nxt);
            if constexpr (SP2) {
            PG8_LDB(B0, 0, 0); PG8_LDB(B1, 0, 1); PG8_SCHED; PG8_LDA(At, 0, 0); PG8_STAGE(PG8_SA(1, 1), a1 + hstep, voffA);
            PG8_WAIT_V(8); PG8_WAIT_L(0); PG8_BAR; PG8_MMA(0, 0, At, B0); PG8_MMA(0, 1, At, B1); PG8_BAR; PG8_SCHED;
            PG8_LDA(At, 0, 1); PG8_STAGE(PG8_SB(0, 0), b2, voffB); PG8_STAGE(PG8_SB(0, 1), b2 + hstep, voffB); PG8_STAGE(PG8_SA(0, 0), a2, voffA);
            PG8_WAIT_V(8); PG8_WAIT_L(0); PG8_BAR; PG8_MMA(1, 0, At, B0); PG8_MMA(1, 1, At, B1); PG8_BAR; PG8_SCHED;
            PG8_LDB(B0, 1, 0); PG8_LDB(B1, 1, 1); PG8_SCHED; PG8_LDA(At, 1, 0); PG8_STAGE(PG8_SA(0, 1), a2 + hstep, voffA);
            PG8_WAIT_V(8); PG8_WAIT_L(0); PG8_BAR; PG8_MMA(0, 0, At, B0); PG8_MMA(0, 1, At, B1); PG8_BAR; PG8_SCHED;
            PG8_LDA(At, 1, 1); PG8_STAGE(PG8_SB(1, 0), b3, voffB); PG8_STAGE(PG8_SB(1, 1), b3 + hstep, voffB); PG8_STAGE(PG8_SA(1, 0), a3, voffA);
            PG8_WAIT_V(8); PG8_WAIT_L(0); PG8_BAR; PG8_MMA(1, 0, At, B0); PG8_MMA(1, 1, At, B1); PG8_BAR; PG8_SCHED;
            } else {
            PG8_LDB(B0, 0, 0); PG8_SCHED; PG8_LDA(At, 0, 0); PG8_STAGE(PG8_SA(1, 1), a1 + hstep, voffA);
            PG8_WAIT_L(8); PG8_BAR; PG8_WAIT_L(0); PG8_MMA(0, 0, At, B0); PG8_BAR; PG8_SCHED;
            PG8_LDB(B1, 0, 1); PG8_STAGE(PG8_SB(0, 0), b2, voffB);
            PG8_BAR; PG8_WAIT_L(0); PG8_MMA(0, 1, At, B1); PG8_BAR;
            PG8_LDA(At, 0, 1); PG8_STAGE(PG8_SA(0, 0), a2, voffA);
            PG8_BAR; PG8_WAIT_L(0); PG8_MMA(1, 0, At, B0); PG8_BAR; PG8_SCHED;
            PG8_STAGE(PG8_SB(0, 1), b2 + hstep, voffB);
            PG8_WAIT_V(6); PG8_BAR; PG8_MMA(1, 1, At, B1); PG8_BAR;
            PG8_LDB(B0, 1, 0); PG8_SCHED; PG8_LDA(At, 1, 0); PG8_STAGE(PG8_SA(0, 1), a2 + hstep, voffA);
            PG8_WAIT_L(8); PG8_BAR; PG8_WAIT_L(0); PG8_MMA(0, 0, At, B0); PG8_BAR; PG8_SCHED;
            PG8_LDB(B1, 1, 1); PG8_STAGE(PG8_SB(1, 0), b3, voffB);
            PG8_BAR; PG8_WAIT_L(0); PG8_MMA(0, 1, At, B1); PG8_BAR;
            PG8_LDA(At, 1, 1); PG8_STAGE(PG8_SA(1, 0), a3, voffA);
            PG8_BAR; PG8_WAIT_L(0); PG8_MMA(1, 0, At, B0); PG8_BAR; PG8_SCHED;
            PG8_STAGE(PG8_SB(1, 1), b3 + hstep, voffB);
            PG8_WAIT_V(6); PG8_BAR; PG8_MMA(1, 1, At, B1); PG8_BAR;
            }
        }
        if constexpr (ALIGN_EPI) { if (wr == 0) PG8_BAR; }
        if constexpr (!Epi::AFTER_DRAIN) { E(acc, cur, wr, wc, fr, fq); S.done(cur); }
        if (!has_next) break;
#pragma unroll
        for (int a = 0; a < 2; ++a)
#pragma unroll
            for (int b = 0; b < 2; ++b)
#pragma unroll
                for (int m = 0; m < 4; ++m)
#pragma unroll
                    for (int n = 0; n < 2; ++n) acc[a][b][m][n] = (f32x4){0.f, 0.f, 0.f, 0.f};
        cur = nxt; cA = nA; cB = nB; ++ui;
        if constexpr (ALIGN_EPI) { if (wr == 1) PG8_BAR; }
    }
    PG8_WAIT_V(0);
    if constexpr (!ALIGN_EPI) { if (wr == 0) PG8_BAR; }
    PG8_BAR;
    if constexpr (Epi::AFTER_DRAIN) { E.fused(acc, cur, wr, wc, fr, fq, lds, wid, lane); S.done(cur); }
#undef PG8_SA
#undef PG8_SB
#undef PG8_STAGE
#undef PG8_LDA
#undef PG8_LDB
#undef PG8_MMA
#undef PG8_WAIT_V
#undef PG8_WAIT_L
#undef PG8_BAR
#undef PG8_SCHED
}


__device__ __forceinline__ float quad_sum(float v) {
    auto a = __builtin_amdgcn_permlane16_swap(__float_as_uint(v), __float_as_uint(v), false, false); v = __uint_as_float(a[0]) + __uint_as_float(a[1]);
    auto b = __builtin_amdgcn_permlane32_swap(__float_as_uint(v), __float_as_uint(v), false, false); return __uint_as_float(b[0]) + __uint_as_float(b[1]);
}
__device__ __forceinline__ float sq4(const f32x4& v) { return (v[0] * v[0] + v[1] * v[1]) + (v[2] * v[2] + v[3] * v[3]); }
__device__ __forceinline__ u32x4 pack8(const f32x4& a, const f32x4& b) { u32x4 o; o.x = cvt_pk_bf16(a[0], a[1]); o.y = cvt_pk_bf16(a[2], a[3]); o.z = cvt_pk_bf16(b[0], b[1]); o.w = cvt_pk_bf16(b[2], b[3]); return o; }
__device__ __forceinline__ void store_rows8(bf16_t* base, unsigned rowA, unsigned pitch, const u32x4& x0, const u32x4& x1) {
    u32x4 a, b;
#pragma unroll
    for (int c = 0; c < 4; ++c) { a[c] = (unsigned)__builtin_amdgcn_update_dpp((int)x0[c], (int)x1[c], 0x128, 0xF, 0xC, false); b[c] = (unsigned)__builtin_amdgcn_update_dpp((int)x1[c], (int)x0[c], 0x128, 0xF, 0x3, false); }
    *(u32x4*)(base + rowA * pitch) = a; *(u32x4*)(base + (rowA + 8u) * pitch) = b;
}
struct EpiQKV {
    static constexpr bool PERM = true, AFTER_DRAIN = false;
    bf16_t* Q; bf16_t* K; bf16_t* V; const float* cosD; const float* sinD; const float* gq; const float* gk; float qscale; float eps;
    __device__ __forceinline__ void operator()(const f32x4 (&acc)[2][2][4][2], const Unit& u, int wr, int wc, int fr, int fq) const {
        asm volatile("" : "+v"(fr), "+v"(fq));
        const int tile = u.pn; const unsigned row0 = (unsigned)(u.pm * BM + wr * 64 + fr);
        if (tile >= 8) {
            bf16_t* vb = V + (tile - 8) * 256 + wc * 64 + 32 * (fr >> 3) + fq * 8; const unsigned rowA0 = (unsigned)(u.pm * BM + wr * 64 + (fr & 7));
#pragma unroll
            for (int ai = 0; ai < 2; ++ai)
#pragma unroll
                for (int m = 0; m < 4; ++m) store_rows8(vb, rowA0 + ai * HALF + m * 16, 1024u, pack8(acc[ai][0][m][0], acc[ai][0][m][1]), pack8(acc[ai][1][m][0], acc[ai][1][m][1]));
        } else {
            const bool isk = tile >= 4; const int hm = (tile & 3) * 4 + wc; bf16_t* dst = (isk ? K : Q) + hm * 64 + 32 * (fr >> 3) + 8 * fq; const unsigned rowA0 = (unsigned)(u.pm * BM + wr * 64 + (fr & 7)); const float* g = isk ? gk : gq; const float sc = isk ? 1.0f : qscale;
            const f32x4 g0a = *(const f32x4*)(g + 8 * fq), g0b = *(const f32x4*)(g + 8 * fq + 4), g1a = *(const f32x4*)(g + 32 + 8 * fq), g1b = *(const f32x4*)(g + 36 + 8 * fq);
            const float* cb = cosD + 8 * fq; const float* sb = sinD + 8 * fq;
#pragma unroll
            for (int ai = 0; ai < 2; ++ai)
#pragma unroll
                for (int m = 0; m < 4; ++m) {
                    const unsigned row = row0 + ai * HALF + m * 16;
                    const f32x4 c0 = *(const f32x4*)(cb + row * 32u), c1 = *(const f32x4*)(cb + row * 32u + 4), s0 = *(const f32x4*)(sb + row * 32u), s1 = *(const f32x4*)(sb + row * 32u + 4);
                    const f32x4 a0 = acc[ai][0][m][0], a1 = acc[ai][0][m][1], b0 = acc[ai][1][m][0], b1 = acc[ai][1][m][1];
                    const float ss = quad_sum((sq4(a0) + sq4(a1)) + (sq4(b0) + sq4(b1)));
                    const float rs = __builtin_amdgcn_rsqf(ss * (1.0f / 64.0f) + eps) * sc;
                    const f32x4 x1a = a0 * (g0a * rs), x1b = a1 * (g0b * rs), x2a = b0 * (g1a * rs), x2b = b1 * (g1b * rs);
                    store_rows8(dst, rowA0 + ai * HALF + m * 16, 1024u, pack8(x1a * c0 - x2a * s0, x1b * c1 - x2b * s1), pack8(x2a * c0 + x1a * s0, x2b * c1 + x1b * s1));
                }
        }
    }
};
template <bool XF32>
struct EpiResid {
    static constexpr bool PERM = true, AFTER_DRAIN = false;
    const void* xin; bf16_t* xout; const float* gate; float* ssq;
    __device__ __forceinline__ void operator()(const f32x4 (&acc)[2][2][4][2], const Unit& u, int wr, int wc, int fr, int fq) const {
        asm volatile("" : "+v"(fr), "+v"(fq));
        const int b = (u.pm * BM) >> 11; const unsigned colb = (unsigned)(u.pn * BM + wc * 64 + 8 * fq); const unsigned row0 = (unsigned)(u.pm * BM + wr * 64 + fr);
        const float* gp = gate + (size_t)b * 6144 + colb;
        f32x4 g[2][2];
#pragma unroll
        for (int bj = 0; bj < 2; ++bj)
#pragma unroll
            for (int n = 0; n < 2; ++n) g[bj][n] = *(const f32x4*)(gp + bj * 32 + n * 4);
        bf16_t* xo = xout + u.pn * BM + wc * 64 + 32 * (fr >> 3) + 8 * fq; float* sq = ssq + u.pn * 4 + wc; const unsigned rowA0 = (unsigned)(u.pm * BM + wr * 64 + (fr & 7));
#pragma unroll
        for (int ai = 0; ai < 2; ++ai) {
            f32x4 xq[4][2][2];
#pragma unroll
            for (int m = 0; m < 4; ++m) { const unsigned off_ = (row0 + ai * HALF + m * 16) * 1024u + colb;
#pragma unroll
                for (int bj = 0; bj < 2; ++bj) {
                    if (XF32) { xq[m][bj][0] = *(const f32x4*)((const float*)xin + off_ + bj * 32); xq[m][bj][1] = *(const f32x4*)((const float*)xin + off_ + bj * 32 + 4); }
                    else { const u32x4 w = *(const u32x4*)((const bf16_t*)xin + off_ + bj * 32);
                        xq[m][bj][0] = (f32x4){__uint_as_float(w.x << 16), __uint_as_float(w.x & 0xffff0000u), __uint_as_float(w.y << 16), __uint_as_float(w.y & 0xffff0000u)};
                        xq[m][bj][1] = (f32x4){__uint_as_float(w.z << 16), __uint_as_float(w.z & 0xffff0000u), __uint_as_float(w.w << 16), __uint_as_float(w.w & 0xffff0000u)}; } } }
#pragma unroll
            for (int m = 0; m < 4; ++m) {
                const unsigned row = row0 + ai * HALF + m * 16; float ss = 0.f; u32x4 pk[2];
#pragma unroll
                for (int bj = 0; bj < 2; ++bj) { const f32x4 v0 = xq[m][bj][0] + g[bj][0] * acc[ai][bj][m][0], v1 = xq[m][bj][1] + g[bj][1] * acc[ai][bj][m][1];
                    pk[bj] = pack8(v0, v1); ss += sq4(v0) + sq4(v1); }
                store_rows8(xo, rowA0 + ai * HALF + m * 16, 1024u, pk[0], pk[1]);
                ss = quad_sum(ss);
                if (fq == 0) sq[row * 16u] = ss;
            }
        }
    }
};
struct EpiWin {
    static constexpr bool PERM = true, AFTER_DRAIN = false;
    bf16_t* CQ; bf16_t* CKV; bf16_t* KPE; float* ssq; const float* cosM; const float* sinM; const float* gkpe; float eps;
    __device__ __forceinline__ void operator()(const f32x4 (&acc)[2][2][4][2], const Unit& u, int wr, int wc, int fr, int fq) const {
        asm volatile("" : "+v"(fr), "+v"(fq));
        const int ws = u.pn * 4 + wc; const unsigned row0 = (unsigned)(u.pm * BM + wr * 64 + fr);
        if (ws < 10) {
            bf16_t* dst = ((ws < 6) ? CQ + 64 * ws : CKV + 64 * (ws - 6)) + 32 * (fr >> 3) + 8 * fq; const unsigned ld = (ws < 6) ? 384u : 256u; float* sq = ssq + ws; const unsigned rowA0 = (unsigned)(u.pm * BM + wr * 64 + (fr & 7));
#pragma unroll
            for (int ai = 0; ai < 2; ++ai)
#pragma unroll
                for (int m = 0; m < 4; ++m) {
                    const unsigned row = row0 + ai * HALF + m * 16;
                    const f32x4 a0 = acc[ai][0][m][0], a1 = acc[ai][0][m][1], b0 = acc[ai][1][m][0], b1 = acc[ai][1][m][1];
                    store_rows8(dst, rowA0 + ai * HALF + m * 16, ld, pack8(a0, a1), pack8(b0, b1));
                    const float ss = quad_sum((sq4(a0) + sq4(a1)) + (sq4(b0) + sq4(b1)));
                    if (fq == 0) sq[row * 16u] = ss;
                }
        } else if (ws == 10) {
            const f32x4 g0 = *(const f32x4*)(gkpe + 4 * fq), g1 = *(const f32x4*)(gkpe + 16 + 4 * fq);
#pragma unroll
            for (int ai = 0; ai < 2; ++ai)
#pragma unroll
                for (int m = 0; m < 4; ++m) {
                    const unsigned row = row0 + ai * HALF + m * 16;
                    const f32x4 c = *(const f32x4*)(cosM + row * 16u + 4 * fq), sn = *(const f32x4*)(sinM + row * 16u + 4 * fq);
                    const f32x4 y0 = acc[ai][0][m][0], y1 = acc[ai][0][m][1];
                    const float rs = __builtin_amdgcn_rsqf(quad_sum(sq4(y0) + sq4(y1)) * (1.0f / 32.0f) + eps);
                    const f32x4 x1 = y0 * (g0 * rs), x2 = y1 * (g1 * rs);
                    *(u32x4*)(KPE + row * 32u + 8 * fq) = pack8(x1 * c - x2 * sn, x2 * c + x1 * sn);
                }
        }
    }
};
struct EpiUQ {
    static constexpr bool PERM = true, AFTER_DRAIN = false;
    bf16_t* Q2; const float* ssq; const float* cosM; const float* sinM; const float* gqn; const float* gqp; float qscale; float eps;
    __device__ __forceinline__ void operator()(const f32x4 (&acc)[2][2][4][2], const Unit& u, int wr, int wc, int fr, int fq) const {
        asm volatile("" : "+v"(fr), "+v"(fq));
        const int tile = u.pn; const unsigned row0 = (unsigned)(u.pm * BM + wr * 64 + fr);
        if (tile < 4) {
            bf16_t* dst = Q2 + (tile * 4 + wc) * 64 + 32 * (fr >> 3) + 8 * fq; const unsigned rowA0 = (unsigned)(u.pm * BM + wr * 64 + (fr & 7));
            const f32x4 g0a = *(const f32x4*)(gqn + 8 * fq) * qscale, g0b = *(const f32x4*)(gqn + 8 * fq + 4) * qscale, g1a = *(const f32x4*)(gqn + 32 + 8 * fq) * qscale, g1b = *(const f32x4*)(gqn + 36 + 8 * fq) * qscale;
#pragma unroll
            for (int ai = 0; ai < 2; ++ai) {
                f32x4 sA[4], sB[4];
#pragma unroll
                for (int m = 0; m < 4; ++m) { const unsigned row = row0 + ai * HALF + m * 16; sA[m] = *(const f32x4*)(ssq + row * 16u); sB[m] = *(const f32x4*)(ssq + row * 16u + 4); }
#pragma unroll
                for (int m = 0; m < 4; ++m) {
                    const unsigned row = row0 + ai * HALF + m * 16;
                    const f32x4 a0 = acc[ai][0][m][0], a1 = acc[ai][0][m][1], b0 = acc[ai][1][m][0], b1 = acc[ai][1][m][1];
                    const float ss = quad_sum((sq4(a0) + sq4(a1)) + (sq4(b0) + sq4(b1)));
                    const float em = eps * ((((sA[m][0] + sA[m][1]) + (sA[m][2] + sA[m][3])) + (sB[m][0] + sB[m][1])) * (1.0f / 384.0f) + eps);
                    const float rn = __builtin_amdgcn_rsqf(ss * (1.0f / 64.0f) + em);
                    store_rows8(dst, rowA0 + ai * HALF + m * 16, 1536u, pack8(a0 * (g0a * rn), a1 * (g0b * rn)), pack8(b0 * (g1a * rn), b1 * (g1b * rn)));
                }
            }
        } else {
            const f32x4 g0 = *(const f32x4*)(gqp + 4 * fq) * qscale, g1 = *(const f32x4*)(gqp + 16 + 4 * fq) * qscale;
            bf16_t* dst = Q2 + 1024 + ((tile - 4) * 4 + wc) * 64 + 32 * (fr >> 3) + 8 * fq; const unsigned rowA0 = (unsigned)(u.pm * BM + wr * 64 + (fr & 7));
#pragma unroll
            for (int ai = 0; ai < 2; ++ai) {
                f32x4 sA[4], sB[4], cc[4], sn[4];
#pragma unroll
                for (int m = 0; m < 4; ++m) { const unsigned row = row0 + ai * HALF + m * 16; sA[m] = *(const f32x4*)(ssq + row * 16u); sB[m] = *(const f32x4*)(ssq + row * 16u + 4);
                    cc[m] = *(const f32x4*)(cosM + row * 16u + 4 * fq); sn[m] = *(const f32x4*)(sinM + row * 16u + 4 * fq); }
#pragma unroll
                for (int m = 0; m < 4; ++m) {
                    const unsigned row = row0 + ai * HALF + m * 16;
                    const float em = eps * ((((sA[m][0] + sA[m][1]) + (sA[m][2] + sA[m][3])) + (sB[m][0] + sB[m][1])) * (1.0f / 384.0f) + eps);
                    u32x4 pk[2];
#pragma unroll
                    for (int bj = 0; bj < 2; ++bj) {
                        const f32x4 y0 = acc[ai][bj][m][0], y1 = acc[ai][bj][m][1];
                        const float rn = __builtin_amdgcn_rsqf(quad_sum(sq4(y0) + sq4(y1)) * (1.0f / 32.0f) + em);
                        const f32x4 x1 = y0 * (g0 * rn), x2 = y1 * (g1 * rn);
                        pk[bj] = pack8(x1 * cc[m] - x2 * sn[m], x2 * cc[m] + x1 * sn[m]);
                    }
                    store_rows8(dst, rowA0 + ai * HALF + m * 16, 1536u, pk[0], pk[1]);
                }
            }
        }
    }
};
struct EpiUKV {
    static constexpr bool PERM = true, AFTER_DRAIN = false;
    bf16_t* KV2; const float* ssq; const float* gkn; float eps;
    __device__ __forceinline__ void operator()(const f32x4 (&acc)[2][2][4][2], const Unit& u, int wr, int wc, int fr, int fq) const {
        asm volatile("" : "+v"(fr), "+v"(fq));
        const int tile = u.pn, head = (tile & 3) * 4 + wc; const unsigned row0 = (unsigned)(u.pm * BM + wr * 64 + fr), rowA0 = (unsigned)(u.pm * BM + wr * 64 + (fr & 7)); const int hcol = 32 * (fr >> 3) + 8 * fq;
        f32x4 sB[2][4], sC[2][4];
#pragma unroll
        for (int ai = 0; ai < 2; ++ai)
#pragma unroll
            for (int m = 0; m < 4; ++m) { const unsigned row = row0 + ai * HALF + m * 16; sB[ai][m] = *(const f32x4*)(ssq + row * 16u + 4); sC[ai][m] = *(const f32x4*)(ssq + row * 16u + 8); }
        if (tile < 4) {
            bf16_t* dst = KV2 + head * 128 + hcol;
            const f32x4 g0a = *(const f32x4*)(gkn + 8 * fq), g0b = *(const f32x4*)(gkn + 8 * fq + 4), g1a = *(const f32x4*)(gkn + 32 + 8 * fq), g1b = *(const f32x4*)(gkn + 36 + 8 * fq);
#pragma unroll
            for (int ai = 0; ai < 2; ++ai)
#pragma unroll
                for (int m = 0; m < 4; ++m) {
                    const unsigned row = row0 + ai * HALF + m * 16;
                    const f32x4 a0 = acc[ai][0][m][0], a1 = acc[ai][0][m][1], b0 = acc[ai][1][m][0], b1 = acc[ai][1][m][1];
                    const float ss = quad_sum((sq4(a0) + sq4(a1)) + (sq4(b0) + sq4(b1)));
                    const float msq = ((sB[ai][m][2] + sB[ai][m][3]) + (sC[ai][m][0] + sC[ai][m][1])) * (1.0f / 256.0f) + eps;
                    const float rn = __builtin_amdgcn_rsqf(ss * (1.0f / 64.0f) + eps * msq);
                    store_rows8(dst, rowA0 + ai * HALF + m * 16, 2048u, pack8(a0 * (g0a * rn), a1 * (g0b * rn)), pack8(b0 * (g1a * rn), b1 * (g1b * rn)));
                }
        } else {
            bf16_t* dst = KV2 + head * 128 + 64 + hcol;
#pragma unroll
            for (int ai = 0; ai < 2; ++ai)
#pragma unroll
                for (int m = 0; m < 4; ++m) {
                    const unsigned row = row0 + ai * HALF + m * 16;
                    const float rsq = __builtin_amdgcn_rsqf(((sB[ai][m][2] + sB[ai][m][3]) + (sC[ai][m][0] + sC[ai][m][1])) * (1.0f / 256.0f) + eps);
                    store_rows8(dst, rowA0 + ai * HALF + m * 16, 2048u, pack8(acc[ai][0][m][0] * rsq, acc[ai][0][m][1] * rsq), pack8(acc[ai][1][m][0] * rsq, acc[ai][1][m][1] * rsq));
                }
        }
    }
};

struct MUnit { int pm, pn, e, r0; };
struct MoeOrder {
    typedef MUnit UnitT;
    const int* tpre; int ncol, G, c, total;
    __device__ __forceinline__ bool next(int i, MUnit& u) const {
        const int L = i * G + c; if (L >= total) return false;
        const int rt = L / ncol, ct = L - rt * ncol; const int e = tpre[33 + rt];
        u.e = e; u.pm = rt; u.r0 = (rt - tpre[e]) * 256; u.pn = e * ncol + ct; return true;
    }
    __device__ __forceinline__ void a_ready(const MUnit&) const {}
    __device__ __forceinline__ void done(const MUnit&) const {}
};
__device__ __forceinline__ float silu_f(float a) { return a * __builtin_amdgcn_rcpf(1.0f + __builtin_amdgcn_exp2f(-1.4426950408889634f * a)); }
struct EpiMoe1 {
    static constexpr bool PERM = true, AFTER_DRAIN = false;
    bf16_t* hid; const int* glist; const float* tokw; const int* cntl; int ntok;
    __device__ __forceinline__ void operator()(const f32x4 (&acc)[2][2][4][2], const MUnit& u, int wr, int wc, int fr, int fq) const {
        const int cnt = cntl[u.e], t = u.pn & 1;
        asm volatile("" : "+v"(fr), "+v"(fq));
#pragma unroll
        for (int ai = 0; ai < 2; ++ai)
#pragma unroll
            for (int m = 0; m < 4; ++m) {
                const int rl = ai * HALF + wr * 64 + m * 16 + fr, r = u.r0 + rl; float w = 0.f;
                if (r < cnt) w = tokw[(unsigned)(u.e * ntok + r)];
                const f32x4 a0 = acc[ai][0][m][0], a1 = acc[ai][0][m][1], b0 = acc[ai][1][m][0], b1 = acc[ai][1][m][1];
                u32x4 o;
                o.x = cvt_pk_bf16(silu_f(a0[0]) * b0[0] * w, silu_f(a0[1]) * b0[1] * w); o.y = cvt_pk_bf16(silu_f(a0[2]) * b0[2] * w, silu_f(a0[3]) * b0[3] * w);
                o.z = cvt_pk_bf16(silu_f(a1[0]) * b1[0] * w, silu_f(a1[1]) * b1[1] * w); o.w = cvt_pk_bf16(silu_f(a1[2]) * b1[2] * w, silu_f(a1[3]) * b1[3] * w);
                *(u32x4*)(hid + ((size_t)u.pm * BM + rl) * 256 + t * 128 + wc * 32 + fq * 8) = o;
                asm volatile("" ::: "memory");
            }
    }
};
struct EpiMoe2 {
    static constexpr bool PERM = true, AFTER_DRAIN = false;
    unsigned char* y2; const int* glist; const int* cntl; int ntok;
    __device__ __forceinline__ void operator()(const f32x4 (&acc)[2][2][4][2], const MUnit& u, int wr, int wc, int fr, int fq) const {
        const int cnt = cntl[u.e], ct = u.pn & 3;
        asm volatile("" : "+v"(fr), "+v"(fq));
#pragma unroll
        for (int ai = 0; ai < 2; ++ai)
#pragma unroll
            for (int m = 0; m < 4; ++m) {
                const int rl = ai * HALF + wr * 64 + m * 16 + fr, r = u.r0 + rl;
                int ent = glist[(unsigned)(u.e * ntok + (r < cnt ? r : 0))]; ent = (r < cnt) ? ent : 2 * ntok;
                unsigned char* rowp = y2 + (size_t)(unsigned)ent * 1024 + ct * 256 + wc * 64 + fq * 16;
                unsigned q[2][2];
#pragma unroll
                for (int bj = 0; bj < 2; ++bj) { const f32x4 v0 = acc[ai][bj][m][0] * 32.0f, v1 = acc[ai][bj][m][1] * 32.0f;
                    int p = __builtin_amdgcn_cvt_pk_fp8_f32(v0[0], v0[1], 0, false); p = __builtin_amdgcn_cvt_pk_fp8_f32(v0[2], v0[3], p, true); q[bj][0] = (unsigned)p;
                    p = __builtin_amdgcn_cvt_pk_fp8_f32(v1[0], v1[1], 0, false); p = __builtin_amdgcn_cvt_pk_fp8_f32(v1[2], v1[3], p, true); q[bj][1] = (unsigned)p; }
#pragma unroll
                for (int d = 0; d < 2; ++d) { auto s1 = __builtin_amdgcn_permlane32_swap(q[0][d], q[1][d], false, false); auto s2 = __builtin_amdgcn_permlane16_swap(s1[0], s1[1], false, false); q[0][d] = s2[0]; q[1][d] = s2[1]; }
                *(u32x4*)rowp = (u32x4){q[0][0], q[0][1], q[1][0], q[1][1]};
                asm volatile("" ::: "memory");
            }
    }
};
template <class Epi, class Sched, bool FP8 = false>
__device__ __forceinline__ void gemm_phase_gather(PG8_LAS unsigned char* lds, const bf16_t* A, const bf16_t* Bt, int K, const int* glist, int ntok, const int* cntl, const Sched& S, const Epi& E) {
    int tid_ = threadIdx.x; asm volatile("" : "+v"(tid_));
    const int tid = tid_, wid = __builtin_amdgcn_readfirstlane(tid >> 6), lane = tid & 63, wr = wid >> 2, wc = wid & 3, fr = lane & 15, fq = lane >> 4;
    const int rowb = FP8 ? K : 2 * K, nt = FP8 ? K / (2 * BK) : K / BK;
    unsigned voffB[2];
#pragma unroll
    for (int i = 0; i < 2; ++i) { int R, C; stage_rc(tid * 16 + i * 8192, R, C); const int Rb = Epi::PERM ? ((R & ~31) + perm32(R & 31)) : R;
        voffB[i] = (unsigned)(Rb * rowb + C * 2); }
    const size_t kstep = (size_t)(BK * 2);
    const size_t hstep = (size_t)HALF * rowb;
    const size_t tstep = 2 * hstep;
    const unsigned ldsw = (unsigned)wid * 1024u;
    const int aoff = lds_byte(wr * 64 + fr, fq * 8), boff = lds_byte(wc * 32 + fr, fq * 8);
#define PG8_SA(b, h) (((b) * 2 + (h)) * HTB)
#define PG8_SB(b, h) ((4 + (b) * 2 + (h)) * HTB)
#define PG8_STAGE(bufoff, gbase, voff) do { _Pragma("unroll") for (int _i = 0; _i < 2; ++_i) \
        __builtin_amdgcn_global_load_lds((const unsigned*)((const char*)(gbase) + (voff)[_i]), (PG8_LAS unsigned*)(lds + (bufoff) + ldsw + _i * 8192), 16, 0, 0); } while (0)
    typedef int i32x4_ __attribute__((ext_vector_type(4))); typedef int i32x8_ __attribute__((ext_vector_type(8)));
#define PG8_LDA(dst, b, h) do { _Pragma("unroll") for (int m = 0; m < 4; ++m) { if constexpr (FP8) { const i32x4_ l0_ = *(const PG8_LAS i32x4_*)(lds + PG8_SA(b, h) + aoff + m * 2048), l1_ = *(const PG8_LAS i32x4_*)(lds + PG8_SA(b, h) + aoff + m * 2048 + 1024); \
            dst##8[m] = __builtin_shufflevector(l0_, l1_, 0, 1, 2, 3, 4, 5, 6, 7); } else { _Pragma("unroll") for (int k = 0; k < 2; ++k) dst[m][k] = *(const PG8_LAS bf16x8*)(lds + PG8_SA(b, h) + aoff + m * 2048 + k * 1024); } } } while (0)
#define PG8_LDB(dst, b, h) do { _Pragma("unroll") for (int n = 0; n < 2; ++n) { if constexpr (FP8) { const i32x4_ l0_ = *(const PG8_LAS i32x4_*)(lds + PG8_SB(b, h) + boff + n * 2048), l1_ = *(const PG8_LAS i32x4_*)(lds + PG8_SB(b, h) + boff + n * 2048 + 1024); \
            dst##8[n] = __builtin_shufflevector(l0_, l1_, 0, 1, 2, 3, 4, 5, 6, 7); } else { _Pragma("unroll") for (int k = 0; k < 2; ++k) dst[n][k] = *(const PG8_LAS bf16x8*)(lds + PG8_SB(b, h) + boff + n * 2048 + k * 1024); } } } while (0)
#define PG8_MMA(ai, bj, At, Bt) do { __builtin_amdgcn_s_setprio(1); _Pragma("unroll") for (int m = 0; m < 4; ++m) _Pragma("unroll") for (int n = 0; n < 2; ++n) { \
        if constexpr (FP8) acc[ai][bj][m][n] = __builtin_amdgcn_mfma_scale_f32_16x16x128_f8f6f4(Bt##8[n], At##8[m], acc[ai][bj][m][n], 0, 0, 0, 0x7a7a7a7a, 0, 0x7f7f7f7f); \
        else { _Pragma("unroll") for (int k = 0; k < 2; ++k) acc[ai][bj][m][n] = __builtin_amdgcn_mfma_f32_16x16x32_bf16(Bt[n][k], At[m][k], acc[ai][bj][m][n], 0, 0, 0); } } \
        __builtin_amdgcn_s_setprio(0); } while (0)
#define PG8_WAIT_V(n) asm volatile("s_waitcnt vmcnt(" #n ")" ::: "memory")
#define PG8_WAIT_L(n) asm volatile("s_waitcnt lgkmcnt(" #n ")" ::: "memory")
#define PG8_BAR __builtin_amdgcn_s_barrier()
#define PG8_SCHED __builtin_amdgcn_sched_barrier(0)
#define PG8_GOFF(u, off) do { const int _cnt = cntl[(u).e]; _Pragma("unroll") for (int _h = 0; _h < 2; ++_h) _Pragma("unroll") for (int _i = 0; _i < 2; ++_i) { \
        int _R, _C; stage_rc(tid * 16 + _i * 8192, _R, _C); const int _r = (u).r0 + _h * HALF + _R; const int _ent = glist[(unsigned)((u).e * ntok + (_r < _cnt ? _r : 0))]; \
        off[_h][_i] = (unsigned)(_ent >> 1) * (unsigned)rowb + (unsigned)(_C * 2); } } while (0)
    typename Sched::UnitT cur, nxt; int ui = 0;
    if (!S.next(0, cur)) return;
    f32x4 acc[2][2][4][2];
#pragma unroll
    for (int a = 0; a < 2; ++a)
#pragma unroll
        for (int b = 0; b < 2; ++b)
#pragma unroll
            for (int m = 0; m < 4; ++m)
#pragma unroll
                for (int n = 0; n < 2; ++n) acc[a][b][m][n] = (f32x4){0.f, 0.f, 0.f, 0.f};
    bf16x8 At[4][2], B0[2][2], B1[2][2]; i32x8_ At8[4], B08[2], B18[2];
    unsigned coff[2][2], noff[2][2];
    PG8_GOFF(cur, coff);
    const char* cA = (const char*)A; const char* cB = (const char*)Bt + (size_t)cur.pn * tstep;
    PG8_STAGE(PG8_SB(0, 0), cB, voffB); PG8_STAGE(PG8_SB(0, 1), cB + hstep, voffB); PG8_STAGE(PG8_SA(0, 0), cA, coff[0]); PG8_STAGE(PG8_SA(0, 1), cA, coff[1]);
    if (wr == 1) PG8_BAR;
    PG8_WAIT_V(2); PG8_BAR;
    PG8_STAGE(PG8_SB(1, 0), cB + kstep, voffB); PG8_STAGE(PG8_SA(1, 0), cA + kstep, coff[0]); PG8_STAGE(PG8_SB(1, 1), cB + hstep + kstep, voffB);
    PG8_WAIT_V(6); PG8_BAR;
    for (;;) {
        const bool has_next = S.next(ui + 1, nxt);
        if (has_next) { PG8_GOFF(nxt, noff); } else {
#pragma unroll
            for (int h = 0; h < 2; ++h)
#pragma unroll
                for (int i = 0; i < 2; ++i) noff[h][i] = coff[h][i]; }
        const char* nB = has_next ? (const char*)Bt + (size_t)nxt.pn * tstep : cB;
        for (int t = 0; t < nt; t += 2) {
            const bool last = (t == nt - 2);
            const char* a1 = cA + (size_t)(t + 1) * kstep;
            const char* a2 = last ? cA : cA + (size_t)(t + 2) * kstep; const char* b2 = last ? nB : cB + (size_t)(t + 2) * kstep;
            const char* a3 = a2 + kstep; const char* b3 = b2 + kstep;
            PG8_LDB(B0, 0, 0); PG8_LDB(B1, 0, 1); PG8_SCHED; PG8_LDA(At, 0, 0); PG8_STAGE(PG8_SA(1, 1), a1, coff[1]);
            if (last) {
#pragma unroll
                for (int h = 0; h < 2; ++h)
#pragma unroll
                    for (int i = 0; i < 2; ++i) coff[h][i] = noff[h][i]; }
            PG8_WAIT_V(8); PG8_WAIT_L(0); PG8_BAR; PG8_MMA(0, 0, At, B0); PG8_MMA(0, 1, At, B1); PG8_BAR; PG8_SCHED;
            PG8_LDA(At, 0, 1); PG8_STAGE(PG8_SB(0, 0), b2, voffB); PG8_STAGE(PG8_SB(0, 1), b2 + hstep, voffB); PG8_STAGE(PG8_SA(0, 0), a2, coff[0]);
            PG8_WAIT_V(8); PG8_WAIT_L(0); PG8_BAR; PG8_MMA(1, 0, At, B0); PG8_MMA(1, 1, At, B1); PG8_BAR; PG8_SCHED;
            PG8_LDB(B0, 1, 0); PG8_LDB(B1, 1, 1); PG8_SCHED; PG8_LDA(At, 1, 0); PG8_STAGE(PG8_SA(0, 1), a2, coff[1]);
            PG8_WAIT_V(8); PG8_WAIT_L(0); PG8_BAR; PG8_MMA(0, 0, At, B0); PG8_MMA(0, 1, At, B1); PG8_BAR; PG8_SCHED;
            PG8_LDA(At, 1, 1); PG8_STAGE(PG8_SB(1, 0), b3, voffB); PG8_STAGE(PG8_SB(1, 1), b3 + hstep, voffB); PG8_STAGE(PG8_SA(1, 0), a3, coff[0]);
            PG8_WAIT_V(8); PG8_WAIT_L(0); PG8_BAR; PG8_MMA(1, 0, At, B0); PG8_MMA(1, 1, At, B1); PG8_BAR; PG8_SCHED;
        }
        if (wr == 0) PG8_BAR;
        E(acc, cur, wr, wc, fr, fq);
        if (!has_next) break;
#pragma unroll
        for (int a = 0; a < 2; ++a)
#pragma unroll
            for (int b = 0; b < 2; ++b)
#pragma unroll
                for (int m = 0; m < 4; ++m)
#pragma unroll
                    for (int n = 0; n < 2; ++n) acc[a][b][m][n] = (f32x4){0.f, 0.f, 0.f, 0.f};
        cur = nxt; cB = nB; ++ui;
        if (wr == 1) PG8_BAR;
    }
    PG8_WAIT_V(0);
    PG8_BAR;
#undef PG8_SA
#undef PG8_SB
#undef PG8_STAGE
#undef PG8_LDA
#undef PG8_LDB
#undef PG8_MMA
#undef PG8_WAIT_V
#undef PG8_WAIT_L
#undef PG8_BAR
#undef PG8_SCHED
#undef PG8_GOFF
}
}

#define PG8_SP2 true
#define PG8_ALIGN true

struct Args { const float* in[33]; float* out; unsigned char* ws; int ph_lo, ph_hi; };
enum { I_X = 0, I_C, I_POS, I_ADAW, I_ADAB, I_NMIX, I_NFFN, I_DA_WQKV, I_DA_QN, I_DA_KN, I_DA_LQ1, I_DA_LK1, I_DA_LQ2, I_DA_LK2,
       I_DA_SUBLN, I_DA_WO, I_M_WIN, I_M_QAN, I_M_KVAN, I_M_WUQ, I_M_WUKV, I_M_QNN, I_M_QPN, I_M_KNN, I_M_KPN, I_M_WO,
       I_E_WG, I_E_BG, I_E_WR, I_E_BR, I_E_W1, I_E_W3, I_E_W2 };

struct Ctx {
    const float* const* in; float* out; unsigned char* ws; unsigned char* lds;
    int tid, lane, wave, gw, ngw;
    __device__ __forceinline__ const float* mod(int layer, int b, int chunk) const { return (const float*)(ws + WS_MOD) + ((size_t)(layer * NB + b) * 6144 + chunk * 1024); }
};

__device__ __forceinline__ void normmod_row(const f32x4 (&v)[4], f32x4 (&h)[4], const float* g, const float* sh, const float* sc, int lane) {
    float s = 0.f;
#pragma unroll
    for (int j = 0; j < 4; ++j) s += (v[j].x * v[j].x + v[j].y * v[j].y) + (v[j].z * v[j].z + v[j].w * v[j].w);
    const float rstd = 1.0f / sqrtf(wave_sum(s) * (1.0f / D) + EPS);
#pragma unroll
    for (int j = 0; j < 4; ++j) {
        const f32x4 gg = *(const f32x4*)(g + 4 * lane + 256 * j), ss = *(const f32x4*)(sh + 4 * lane + 256 * j), cc = *(const f32x4*)(sc + 4 * lane + 256 * j);
        h[j] = (v[j] * rstd) * gg * (cc + 1.0f) + ss;
    }
}
__device__ __forceinline__ void store_row_bf16(bf16* row, const f32x4 (&h)[4], int lane) {
#pragma unroll
    for (int j = 0; j < 4; ++j) { u32x2 o; o.x = pk2(h[j].x, h[j].y); o.y = pk2(h[j].z, h[j].w); *(u32x2*)(row + 4 * lane + 256 * j) = o; }
}
__device__ __forceinline__ void load_row_fp8(const unsigned char* row, f32x4 (&h)[4], int lane) {
#pragma unroll
    for (int j = 0; j < 4; ++j) { const int w = *(const int*)(row + 4 * lane + 256 * j); const auto lo = __builtin_amdgcn_cvt_pk_f32_fp8(w, false), hi = __builtin_amdgcn_cvt_pk_f32_fp8(w, true);
        h[j] = (f32x4){lo[0], lo[1], hi[0], hi[1]} * 0.03125f; }
}
__device__ __forceinline__ void load_row_bf16(const bf16* row, f32x4 (&h)[4], int lane) {
#pragma unroll
    for (int j = 0; j < 4; ++j) { const u32x2 o = *(const u32x2*)(row + 4 * lane + 256 * j);
        h[j] = (f32x4){bf2f(o.x & 0xffffu), bf2f(o.x >> 16), bf2f(o.y & 0xffffu), bf2f(o.y >> 16)}; }
}


struct TItem { const float* src; bf16* dst; const float* kg; int ldw, K, perm, f8; };
__device__ __forceinline__ void titem_load(const TItem& t, f32x4 (&v)[8], int lane) {
    const float* p = t.src + (size_t)(lane >> 3) * t.ldw + 4 * (lane & 7);
#pragma unroll
    for (int i = 0; i < 8; ++i) v[i] = *(const f32x4*)(p + (size_t)(8 * i) * t.ldw);
}
__device__ __forceinline__ void titem_finish(const TItem& t, const f32x4 (&v)[8], float* scr, int lane) {
    const int rr = lane >> 3, c4 = lane & 7;
#pragma unroll
    for (int i = 0; i < 8; ++i) { f32x4 x = v[i]; if (t.kg) x = x * t.kg[8 * i + rr]; float* d = scr + (8 * i + rr) * 33 + 4 * c4; d[0] = x[0]; d[1] = x[1]; d[2] = x[2]; d[3] = x[3]; }
    asm volatile("s_waitcnt lgkmcnt(0)" ::: "memory");
    const int c = lane & 7;
#pragma unroll
    for (int j = 0; j < 4; ++j) { const int n = (lane >> 3) + 8 * j; const int nl = t.perm ? (16 * ((n >> 2) & 1) + 4 * (n >> 3) + (n & 3)) : n;
        const float* sp = scr + (8 * c) * 33 + nl;
        if (t.f8) { int p0 = __builtin_amdgcn_cvt_pk_fp8_f32(sp[0 * 33] * 32.0f, sp[1 * 33] * 32.0f, 0, false); p0 = __builtin_amdgcn_cvt_pk_fp8_f32(sp[2 * 33] * 32.0f, sp[3 * 33] * 32.0f, p0, true);
            int p1 = __builtin_amdgcn_cvt_pk_fp8_f32(sp[4 * 33] * 32.0f, sp[5 * 33] * 32.0f, 0, false); p1 = __builtin_amdgcn_cvt_pk_fp8_f32(sp[6 * 33] * 32.0f, sp[7 * 33] * 32.0f, p1, true);
            u32x2 o; o.x = (unsigned)p0; o.y = (unsigned)p1; *(u32x2*)((unsigned char*)t.dst + (size_t)n * t.K + 8 * c) = o; }
        else { u32x4 o; o.x = pk2(sp[0 * 33], sp[1 * 33]); o.y = pk2(sp[2 * 33], sp[3 * 33]); o.z = pk2(sp[4 * 33], sp[5 * 33]); o.w = pk2(sp[6 * 33], sp[7 * 33]);
            *(u32x4*)(t.dst + (size_t)n * t.K + 8 * c) = o; } }
    asm volatile("s_waitcnt lgkmcnt(0)" ::: "memory");
}
__device__ __forceinline__ TItem titem_make(const float* W, int ldw, int K, bf16* WT, int k0, int n0, int prow0, const float* kgain, bool perm) {
    TItem t; t.src = W + (size_t)k0 * ldw + n0; t.dst = WT + (size_t)prow0 * K + k0; t.kg = kgain ? kgain + k0 : nullptr; t.ldw = ldw; t.K = K; t.perm = perm ? 1 : 0; t.f8 = 0; return t;
}
constexpr int TI_QKV = 16 * 96, TI_O = 16 * 32, TI_WIN = 16 * 21, TI_UQ = 6 * 48, TI_UKV = 4 * 64, TI_DENSE = TI_QKV + 2 * TI_O + TI_WIN + TI_UQ + TI_UKV, TI_ALL = TI_DENSE + 24576;
__device__ __forceinline__ TItem titem_decode(const Ctx& C, int it) {
    int r = it;
    if (r < TI_QKV) { const int kb = r / 96, lb = r % 96; int pb = lb;
        if (lb < 64) { const int sect = lb >> 5, hm = (lb & 31) >> 1, half = lb & 1; pb = (sect * 4 + (hm >> 2)) * 8 + half * 4 + (hm & 3); }
        else pb = (lb & ~7) + 4 * (lb & 1) + ((lb & 7) >> 1);
        return titem_make(as_global(C.in[I_DA_WQKV]), 3072, 1024, (bf16*)(C.ws + WB_QKV), 64 * kb, 32 * lb, 32 * pb, nullptr, false); } r -= TI_QKV;
    if (r < TI_O) { const int cb = r % 32; return titem_make(as_global(C.in[I_DA_WO]), 1024, 1024, (bf16*)(C.ws + WB_DAO), 64 * (r / 32), 32 * cb, 32 * ((cb & ~7) + 4 * (cb & 1) + ((cb & 7) >> 1)), nullptr, false); } r -= TI_O;
    if (r < TI_O) { const int cb = r % 32; return titem_make(as_global(C.in[I_M_WO]), 1024, 1024, (bf16*)(C.ws + WB_MLO), 64 * (r / 32), 32 * cb, 32 * ((cb & ~7) + 4 * (cb & 1) + ((cb & 7) >> 1)), nullptr, false); } r -= TI_O;
    if (r < TI_WIN) { const int kb = r / 21, lb = r % 21; int pb = 18;
        if (lb < 20) { const int wsl = lb >> 1; pb = (wsl >> 2) * 8 + (lb & 1) * 4 + (wsl & 3); }
        return titem_make(as_global(C.in[I_M_WIN]), 672, 1024, (bf16*)(C.ws + WB_WIN), 64 * kb, 32 * lb, 32 * pb, nullptr, lb == 20); } r -= TI_WIN;
    if (r < TI_UQ) { const int kb = r / 48, lb = r % 48, h = lb / 3, part = lb % 3; int pb;
        if (part < 2) pb = (h >> 2) * 8 + part * 4 + (h & 3); else { const int sl = h >> 1; pb = (4 + (sl >> 2)) * 8 + (h & 1) * 4 + (sl & 3); }
        return titem_make(as_global(C.in[I_M_WUQ]), 1536, 384, (bf16*)(C.ws + WB_WUQ), 64 * kb, 32 * lb, 32 * pb, as_global(C.in[I_M_QAN]), part == 2); } r -= TI_UQ;
    if (r < TI_UKV) { const int kb = r / 64, lb = r % 64, h = lb >> 2, part = lb & 3; const int pb = (((part < 2) ? 0 : 4) + (h >> 2)) * 8 + (part & 1) * 4 + (h & 3);
        return titem_make(as_global(C.in[I_M_WUKV]), 2048, 256, (bf16*)(C.ws + WB_WUKV), 64 * kb, 32 * lb, 32 * pb, as_global(C.in[I_M_KVAN]), false); } r -= TI_UKV;
    if (r < 16384) { const int item = r & 63, mat = (r >> 6) & 1, t = (r >> 7) & 1, e = (r >> 8) & 31, l = r >> 13; const int kb = item >> 2, nb = item & 3;
        const float* W = as_global(C.in[mat ? I_E_W3 : I_E_W1]) + (size_t)(l * 32 + e) * 1024 * 256 + 128 * t;
        TItem ti = titem_make(W, 256, 1024, (bf16*)(C.ws + WB_MOE + (size_t)l * 48 * MiB), 64 * kb, 32 * nb, e * 512 + 256 * t + 128 * mat + 32 * nb, nullptr, false);
        ti.f8 = 1; ti.dst = (bf16*)((unsigned char*)(C.ws + WB_MOE + (size_t)l * 48 * MiB) + (size_t)(e * 512 + 256 * t + 128 * mat + 32 * nb) * 1024 + 64 * kb); return ti; }
    r -= 16384;
    { const int item = r & 127, e = (r >> 7) & 31, l = r >> 12; const int kb = item >> 5, nb = item & 31;
      const float* W = as_global(C.in[I_E_W2]) + (size_t)(l * 32 + e) * 256 * 1024;
      return titem_make(W, 1024, 256, (bf16*)(C.ws + WB_MOE + (size_t)l * 48 * MiB + 32 * MiB), 64 * kb, 32 * nb, e * 1024 + 32 * ((nb & ~7) + 4 * (nb & 1) + ((nb & 7) >> 1)), nullptr, false); }
}
__device__ __forceinline__ void ph_prologue(const Ctx& C) {
    {
        float* sc = (float*)C.lds;
        float* red = sc + 16384;
        const float* c = as_global(C.in[I_C]); const float* adaw = as_global(C.in[I_ADAW]); const float* adab = as_global(C.in[I_ADAB]); float* mod = (float*)(C.ws + WS_MOD);
        for (int item = blockIdx.x; item < 384; item += gridDim.x) {
            const int layer = item / 192, r = item % 192, cc = r >> 1, bhf = r & 1;
            __syncthreads();
            for (int idx = C.tid; idx < 16384; idx += NTHR) { const float v = c[(size_t)(bhf * 16) * D + idx]; sc[(idx & 1023) * 16 + (idx >> 10)] = v / (1.0f + expf(-v)); }
            __syncthreads();
            const int col = C.tid & 63, ks = C.tid >> 6;
            f32x4 acc[4];
#pragma unroll
            for (int i = 0; i < 4; ++i) acc[i] = (f32x4){0.f, 0.f, 0.f, 0.f};
            const float* wp = adaw + ((size_t)layer * D + ks * 128) * 6144 + cc * 64 + col;
#pragma unroll 8
            for (int kk = 0; kk < 128; ++kk) {
                const float w = wp[(size_t)kk * 6144]; const float* sp = sc + (ks * 128 + kk) * 16;
#pragma unroll
                for (int i = 0; i < 4; ++i) acc[i] += *(const f32x4*)(sp + 4 * i) * w;
            }
#pragma unroll
            for (int i = 0; i < 16; ++i) red[(ks * 16 + i) * 64 + col] = acc[i >> 2][i & 3];
            __syncthreads();
            for (int o = C.tid; o < 1024; o += NTHR) { const int i = o >> 6, cl = o & 63; float sm = adab[layer * 6144 + cc * 64 + cl];
#pragma unroll
                for (int k2 = 0; k2 < 8; ++k2) sm += red[(k2 * 16 + i) * 64 + cl];
                mod[(size_t)(layer * NB + bhf * 16 + i) * 6144 + cc * 64 + cl] = sm; }
        }
        if (blockIdx.x == 0 && C.wave == 0) {
            const float a = wave_sum(as_global(C.in[I_DA_LQ1])[C.lane] * as_global(C.in[I_DA_LK1])[C.lane]);
            const float b = wave_sum(as_global(C.in[I_DA_LQ2])[C.lane] * as_global(C.in[I_DA_LK2])[C.lane]);
            if (C.lane == 0) *(float*)(C.ws + WS_LAM) = expf(a) - expf(b) + 0.2f;
        }
    }
    __syncthreads();
    {
        float* ivf = (float*)C.lds;
        if (C.tid < 32) ivf[C.tid] = powf(10000.0f, -(float)(2 * C.tid) / 64.0f); else if (C.tid < 48) ivf[C.tid] = powf(10000.0f, -(float)(2 * (C.tid - 32)) / 32.0f);
        __syncthreads();
        const int* pos = (const int*)as_global(C.in[I_POS]);
        float* cosD = (float*)(C.ws + WS_COSD); float* sinD = (float*)(C.ws + WS_SIND); float* cosM = (float*)(C.ws + WS_COSM); float* sinM = (float*)(C.ws + WS_SINM);
        const int gt = blockIdx.x * NTHR + C.tid, ngt = gridDim.x * NTHR;
        for (int idx = gt; idx < NTOK * 32; idx += ngt) {
            const float ang = (float)pos[idx >> 5] * ivf[idx & 31]; float rev = ang * 0.15915494309189535f; rev -= floorf(rev);
            cosD[idx] = __builtin_amdgcn_cosf(rev); sinD[idx] = __builtin_amdgcn_sinf(rev);
        }
        for (int idx = gt; idx < NTOK * 16; idx += ngt) {
            const float ang = (float)pos[idx >> 4] * ivf[32 + (idx & 15)]; float rev = ang * 0.15915494309189535f; rev -= floorf(rev);
            cosM[idx] = __builtin_amdgcn_cosf(rev); sinM[idx] = __builtin_amdgcn_sinf(rev);
        }
        float* wrt = (float*)(C.ws + WS_WRT); const float* wr = as_global(C.in[I_E_WR]);
        for (int idx = gt; idx < 2 * 32 * 1024; idx += ngt) { const int l = idx >> 15, e = (idx >> 10) & 31, k = idx & 1023; wrt[idx] = wr[((size_t)l * 1024 + k) * 32 + e]; }
        for (int idx = gt; idx < 96 * 1024 / 8; idx += ngt) { const int blk = idx / 4096, rem = idx % 4096; const int pb = (blk == 0) ? 19 : 21 + blk;
            *(u32x4*)((bf16*)(C.ws + WB_WIN) + (size_t)pb * 32 * 1024 + (size_t)rem * 8) = (u32x4){0u, 0u, 0u, 0u}; }
    }
    __syncthreads();
    {
        float* scr = (float*)(C.lds + C.wave * 16384);
        f32x4 va[8], vb[8];
#pragma unroll 1
        for (int it = C.gw; it < TI_ALL; it += 2 * C.ngw) {
            const bool hasb = it + C.ngw < TI_ALL;
            const TItem ta = titem_decode(C, it), tb = titem_decode(C, hasb ? it + C.ngw : it);
            titem_load(ta, va, C.lane); if (hasb) titem_load(tb, vb, C.lane);
            titem_finish(ta, va, scr, C.lane); if (hasb) titem_finish(tb, vb, scr, C.lane);
        }
    }
}
__device__ __forceinline__ void ph_normmod0(const Ctx& C) {
    const float* x = as_global(C.in[I_X]); bf16* H = (bf16*)(C.ws + WS_H);
    for (int tok = C.gw; tok < NTOK; tok += C.ngw) {
        const int b = tok / SEQ; f32x4 v[4], h[4];
#pragma unroll
        for (int j = 0; j < 4; ++j) v[j] = *(const f32x4*)(x + (size_t)tok * D + 4 * C.lane + 256 * j);
        normmod_row(v, h, as_global(C.in[I_NMIX]), C.mod(0, b, 0), C.mod(0, b, 1), C.lane);
        store_row_bf16(H + (size_t)tok * D, h, C.lane);
    }
}
template <bool FINAL>
__device__ __forceinline__ void ph_comb(const Ctx& C, const unsigned char* y2, const float* gate_chunk_base  , int nlayer, const float* gnorm) {
    bf16* H = (bf16*)(C.ws + WS_H); const int lane = C.lane;
    for (int chunk = blockIdx.x; chunk < NTOK / 256; chunk += gridDim.x) {
        for (int i = 0; i < 32; ++i) {
            const int tok = chunk * 256 + C.wave * 32 + i, b = tok / SEQ;
            f32x4 v[4], a[4], a2[4];
            load_row_bf16((const bf16*)(C.ws + WS_XB) + (size_t)tok * D, v, lane);
            const float* gate = gate_chunk_base + (size_t)b * 6144;
            load_row_fp8(y2 + (size_t)(2 * tok) * D, a, lane); load_row_fp8(y2 + (size_t)(2 * tok + 1) * D, a2, lane);
#pragma unroll
            for (int j = 0; j < 4; ++j) { const f32x4 gg = *(const f32x4*)(gate + 4 * lane + 256 * j); v[j] += gg * (a[j] + a2[j]);
                if (FINAL) *(f32x4*)(as_global(C.out) + (size_t)tok * D + 4 * lane + 256 * j) = v[j]; }
            if (FINAL) continue;
            store_row_bf16((bf16*)(C.ws + WS_XB) + (size_t)tok * D, v, lane);
            f32x4 h[4];
            normmod_row(v, h, gnorm, C.mod(nlayer, b, 0), C.mod(nlayer, b, 1), lane);
            store_row_bf16(H + (size_t)tok * D, h, lane);
        }
    }
}

constexpr int MOE_TAB_OFF = 131072 + 512;
__device__ __forceinline__ void moe_prefix256(const Ctx& C, int moe_layer, int* cntl, int* tpre) {
    const unsigned* cnt = (const unsigned*)(C.ws + WS_CTL) + CW_CNT + moe_layer * 32 * 64;
    __syncthreads();
    if (C.tid < 32) cntl[C.tid] = (int)__hip_atomic_load(cnt + C.tid * 64, __ATOMIC_RELAXED, __HIP_MEMORY_SCOPE_AGENT);
    __syncthreads();
    if (C.tid == 0) { int s = 0; for (int e = 0; e < 32; ++e) { tpre[e] = s; s += (cntl[e] + 255) >> 8; } tpre[32] = s; }
    __syncthreads();
    if (C.tid < 32) { for (int rt = tpre[C.tid]; rt < tpre[C.tid + 1]; ++rt) tpre[33 + rt] = C.tid; }
    __syncthreads();
}
__device__ __forceinline__ void ph_moe1_mfma(const Ctx& C, int moe_layer) {
    int* cntl = (int*)(C.lds + MOE_TAB_OFF); int* tpre = cntl + 32;
    moe_prefix256(C, moe_layer, cntl, tpre);
    pg8::MoeOrder S{tpre, 2, (int)gridDim.x, (int)blockIdx.x, tpre[32] * 2};
    pg8::EpiMoe1 E{(bf16*)(C.ws + WS_A), (const int*)(C.ws + WS_LIST), (const float*)(C.ws + WS_LISTW), cntl, NTOK};
    int K1 = 1024; asm volatile("" : "+s"(K1));
    pg8::gemm_phase_gather<pg8::EpiMoe1, pg8::MoeOrder, true>((PG8_LAS unsigned char*)C.lds, (const bf16*)(C.ws + WS_H), (const bf16*)(C.ws + WB_MOE + (size_t)moe_layer * 48 * MiB), K1,
                                                        (const int*)(C.ws + WS_LIST), NTOK, cntl, S, E);
}
__device__ __forceinline__ void ph_moe2_mfma(const Ctx& C, int moe_layer) {
    int* cntl = (int*)(C.lds + MOE_TAB_OFF); int* tpre = cntl + 32;
    moe_prefix256(C, moe_layer, cntl, tpre);
    pg8::MoeOrder S{tpre, 4, (int)gridDim.x, (int)blockIdx.x, tpre[32] * 4};
    pg8::EpiMoe2 E{(unsigned char*)(C.ws + WS_A + 128 * MiB), (const int*)(C.ws + WS_LIST), cntl, NTOK};
    int K2 = 256; asm volatile("" : "+s"(K2));
    pg8::Gemm g{(const bf16*)(C.ws + WS_A), (const bf16*)(C.ws + WB_MOE + (size_t)moe_layer * 48 * MiB + 32 * MiB), 0, 0, K2};
    pg8::gemm_phase<pg8::EpiMoe2, pg8::MoeOrder, PG8_ALIGN, PG8_SP2>((PG8_LAS unsigned char*)C.lds, g, S, E);
}

namespace fa {
typedef short bf16x8 __attribute__((ext_vector_type(8)));
typedef short s16x4 __attribute__((ext_vector_type(4)));
typedef float f32x16 __attribute__((ext_vector_type(16)));
typedef __attribute__((address_space(3))) const char* lds_cptr;
__device__ __forceinline__ int crow(int r, int hi) { return (r & 3) + 8 * (r >> 2) + 4 * hi; }
__device__ __forceinline__ s16x4 vtr(lds_cptr p) { return __builtin_bit_cast(s16x4, __builtin_amdgcn_ds_read_tr16_b64_v4i16((__attribute__((address_space(3))) s16x4*)p)); }
typedef float f32x2_t __attribute__((ext_vector_type(2))); typedef __bf16 bf16x2_t __attribute__((ext_vector_type(2)));
__device__ __forceinline__ unsigned cvtpk(float lo, float hi) { f32x2_t v = {lo, hi}; bf16x2_t b = __builtin_convertvector(v, bf16x2_t); return __builtin_bit_cast(unsigned, b); }
__device__ __forceinline__ float half_swap_max(float v) { auto rr = __builtin_amdgcn_permlane32_swap(__float_as_uint(v), __float_as_uint(v), false, false); return fmaxf(__uint_as_float(rr[0]), __uint_as_float(rr[1])); }
__device__ __forceinline__ float half_swap_sum(float v) { auto rr = __builtin_amdgcn_permlane32_swap(__float_as_uint(v), __float_as_uint(v), false, false); return __uint_as_float(rr[0]) + __uint_as_float(rr[1]); }
__device__ __forceinline__ void dma16(const void* gsrc, LAS unsigned char* ldsdst) { unsigned keep; const unsigned dst = (unsigned)__builtin_amdgcn_readfirstlane((int)(unsigned)(uintptr_t)ldsdst);
    asm volatile("s_mov_b32 %0, m0\n\ts_mov_b32 m0, %2\n\ts_nop 0\n\tglobal_load_lds_dwordx4 %1, off\n\ts_mov_b32 m0, %0" : "=&s"(keep) : "v"(gsrc), "s"(dst) : "memory"); }
__device__ __forceinline__ void dma16s(const void* sbase_, unsigned voff, LAS unsigned char* ldsdst) { unsigned keep; const unsigned dst = (unsigned)__builtin_amdgcn_readfirstlane((int)(unsigned)(uintptr_t)ldsdst);
    const unsigned long long sb_ = (unsigned long long)(uintptr_t)sbase_; const unsigned lo_ = (unsigned)__builtin_amdgcn_readfirstlane((int)(unsigned)sb_), hi_ = (unsigned)__builtin_amdgcn_readfirstlane((int)(unsigned)(sb_ >> 32));
    const void* sbase = (const void*)(uintptr_t)(((unsigned long long)hi_ << 32) | lo_);
    asm volatile("s_mov_b32 %0, m0\n\ts_mov_b32 m0, %3\n\ts_nop 0\n\tglobal_load_lds_dwordx4 %1, %2\n\ts_mov_b32 m0, %0" : "=&s"(keep) : "v"(voff), "s"(sbase), "s"(dst) : "memory"); }

template <int ND0, int NDB>
__device__ __forceinline__ void tile(lds_cptr Kslot, lds_cptr Vslot, const bf16x8 (&qf)[ND0], f32x16 (&o)[NDB], f32x16& negm, float& m, float& l,
                                     LAS float* wsf, bool first, bool diag, int qloc, int lane) {
    const int r32 = lane & 31, hi = lane >> 5;
    lds_cptr kb = Kslot + hi * 1024 + r32 * 16;
    bf16x8 kf0[ND0], kf1[ND0];
#pragma unroll
    for (int d0 = 0; d0 < ND0; ++d0) {
        kf0[d0] = *(const __attribute__((address_space(3))) bf16x8*)(kb + d0 * 2048);
        kf1[d0] = *(const __attribute__((address_space(3))) bf16x8*)(kb + d0 * 2048 + 512);
    }
#pragma unroll
    for (int d0 = 0; d0 < ND0; ++d0) asm volatile("" : "+v"(kf0[d0]), "+v"(kf1[d0]));
    f32x16 p0 = __builtin_amdgcn_mfma_f32_32x32x16_bf16(kf0[0], qf[0], negm, 0, 0, 0);
    f32x16 p1 = __builtin_amdgcn_mfma_f32_32x32x16_bf16(kf1[0], qf[0], negm, 0, 0, 0);
#pragma unroll
    for (int d0 = 1; d0 < ND0; ++d0) {
        p0 = __builtin_amdgcn_mfma_f32_32x32x16_bf16(kf0[d0], qf[d0], p0, 0, 0, 0);
        p1 = __builtin_amdgcn_mfma_f32_32x32x16_bf16(kf1[d0], qf[d0], p1, 0, 0, 0);
    }
    __builtin_amdgcn_sched_barrier(0);
    lds_cptr vp = Vslot + ((lane >> 4) & 1) * 32 + (lane & 3) * 8 + (4 * hi + ((lane & 15) >> 2)) * 64;
    constexpr int NE = (NDB < 2 ? NDB : 2) * 4;
    s16x4 vlo[NDB * 4], vhi[NDB * 4];
#pragma unroll
    for (int i = 0; i < NE; ++i) { vlo[i] = vtr(vp + (i >> 2) * 4096 + (i & 3) * 1024); vhi[i] = vtr(vp + (i >> 2) * 4096 + (i & 3) * 1024 + 512); }
    __builtin_amdgcn_sched_barrier(0);
    if (diag) {
#pragma unroll
        for (int r = 0; r < 16; ++r) { const int kv = crow(r, hi); if (kv > qloc) p0[r] = -1e30f; if (kv + 32 > qloc) p1[r] = -1e30f; }
    }
    float mx = fmaxf(fmaxf(p0[0], p1[0]), p0[1]);
#pragma unroll
    for (int r = 1; r < 16; ++r) { if (r > 1) mx = fmaxf(fmaxf(mx, p0[r]), p1[r]); else mx = fmaxf(mx, p1[r]); }
    mx = half_swap_max(mx);
    const bool need = first || (__builtin_amdgcn_ballot_w64(mx > 8.0f) != 0ull);
    if (need) {
        const float dl = first ? mx : fmaxf(mx, 0.f);
        m += dl;
#pragma unroll
        for (int r = 0; r < 16; ++r) { p0[r] -= dl; p1[r] -= dl; negm[r] = -m; }
        if (!first) {
            const float al = __builtin_amdgcn_exp2f(-dl); l *= al;
            if (hi == 0) wsf[r32] = al;
            asm volatile("s_waitcnt lgkmcnt(0)" ::: "memory");
            f32x4 a4[4];
#pragma unroll
            for (int g = 0; g < 4; ++g) a4[g] = *(const LAS f32x4*)(wsf + 8 * g + 4 * hi);
#pragma unroll
            for (int db = 0; db < NDB; ++db)
#pragma unroll
                for (int r = 0; r < 16; ++r) o[db][r] *= a4[r >> 2][r & 3];
        }
    }
    float sum = 0.f;
#pragma unroll
    for (int ks = 0; ks < 4; ++ks) {
        float e[8];
#pragma unroll
        for (int j = 0; j < 8; ++j) { const float x = (ks < 2) ? p0[8 * ks + j] : p1[8 * (ks - 2) + j]; e[j] = __builtin_amdgcn_exp2f(x); }
        sum += ((e[0] + e[1]) + (e[2] + e[3])) + ((e[4] + e[5]) + (e[6] + e[7]));
        u32x4 w; w.x = cvtpk(e[0], e[1]); w.y = cvtpk(e[2], e[3]); w.z = cvtpk(e[4], e[5]); w.w = cvtpk(e[6], e[7]);
        const bf16x8 pa = __builtin_bit_cast(bf16x8, w);
        if (ks == 0 && NE < NDB * 4) {
#pragma unroll
            for (int i = NE; i < NDB * 4; ++i) { vlo[i] = vtr(vp + (i >> 2) * 4096 + (i & 3) * 1024); vhi[i] = vtr(vp + (i >> 2) * 4096 + (i & 3) * 1024 + 512); }
        }
        __builtin_amdgcn_s_setprio(1);
#pragma unroll
        for (int db = 0; db < NDB; ++db) {
            const s16x4 lo = vlo[db * 4 + ks], hh = vhi[db * 4 + ks];
            const bf16x8 vf = (bf16x8){lo[0], lo[1], lo[2], lo[3], hh[0], hh[1], hh[2], hh[3]};
            o[db] = __builtin_amdgcn_mfma_f32_32x32x16_bf16(pa, vf, o[db], 0, 0, 0);
        }
        __builtin_amdgcn_s_setprio(0);
    }
    l += sum;
}
}


__device__ __forceinline__ void ph_route(const Ctx& C, int layer) {
    typedef float f32x16 __attribute__((ext_vector_type(16)));
    LAS float* hT = (LAS float*)C.lds + C.wave * (32 * 68);
    LAS float* rsl = (LAS float*)C.lds + 8 * 32 * 68 + C.wave * 32;
    int* le0 = (int*)(C.lds + 73728); int* le1 = le0 + 256; int* hist = le1 + 256; int* base = hist + 32; float* lw0 = (float*)(base + 32); float* lw1 = lw0 + 256;
    const bf16* x1 = (const bf16*)(C.ws + WS_XB); unsigned char* H8 = C.ws + WS_H; float* listw = (float*)(C.ws + WS_LISTW); int* list = (int*)(C.ws + WS_LIST);
    unsigned* cnt = (unsigned*)(C.ws + WS_CTL) + CW_CNT + layer * 32 * 64;
    const float* ssqx = (const float*)(C.ws + WS_SSQX);
    const float* gn = as_global(C.in[I_NFFN]) + layer * D;
    const float* WrT = (const float*)(C.ws + WS_WRT) + (size_t)layer * 32 * 1024; const float* wg = as_global(C.in[I_E_WG]) + (size_t)layer * D * 4;
    const float* bg = as_global(C.in[I_E_BG]) + layer * 4; const float* br = as_global(C.in[I_E_BR]) + layer * 32;
    const int lane = C.lane, r32 = lane & 31, hi = lane >> 5, w = C.wave, kq = lane & 15, tsub = lane >> 4;
    LAS float* wgl = (LAS float*)(C.lds + 81920);
    __syncthreads();
    for (int idx = C.tid; idx < 1024; idx += NTHR) *(LAS f32x4*)(wgl + idx * 4) = *(const f32x4*)(wg + (size_t)idx * 4);
    for (int chunk = blockIdx.x; chunk < NTOK / 256; chunk += gridDim.x) {
        __syncthreads();
        if (C.tid < 32) hist[C.tid] = 0;
        const int tok0 = chunk * 256 + w * 32, b = tok0 >> 11;
        const float* shp = C.mod(layer, b, 3); const float* scp = C.mod(layer, b, 4);
        { const float* sp = ssqx + (size_t)(tok0 + r32) * 16; const f32x4 s0 = *(const f32x4*)sp, s1 = *(const f32x4*)(sp + 4), s2 = *(const f32x4*)(sp + 8), s3 = *(const f32x4*)(sp + 12);
          const float sm = ((s0[0] + s0[1]) + (s0[2] + s0[3])) + ((s1[0] + s1[1]) + (s1[2] + s1[3])) + ((s2[0] + s2[1]) + (s2[2] + s2[3])) + ((s3[0] + s3[1]) + (s3[2] + s3[3]));
          if (hi == 0) rsl[r32] = 1.0f / sqrtf(sm * (1.0f / D) + EPS); }
        f32x16 acc;
#pragma unroll
        for (int r = 0; r < 16; ++r) acc[r] = 0.f;
        float gl[4] = {0.f, 0.f, 0.f, 0.f};
        const unsigned xoff = (unsigned)(tok0 + tsub) * 1024u + 4u * kq;
        const unsigned woff = (unsigned)r32 * 1024u + 4u * hi;
        f32x4 X[8], Wa[8], Wb[8];
#define RT_LOADX(kc_) do { _Pragma("unroll") for (int i = 0; i < 8; ++i) { const u32x2 w_ = *(const u32x2*)(x1 + (xoff + 4096u * i + 64u * (kc_))); \
            X[i] = (f32x4){__uint_as_float(w_.x << 16), __uint_as_float(w_.x & 0xffff0000u), __uint_as_float(w_.y << 16), __uint_as_float(w_.y & 0xffff0000u)}; } } while (0)
#define RT_LOADW(W, kc_) do { _Pragma("unroll") for (int c = 0; c < 8; ++c) W[c] = *(const f32x4*)(WrT + (woff + 64u * (kc_) + 8u * c)); } while (0)
#define RT_STEP(W, WN, kc_) do { const unsigned k4 = 64u * (kc_) + 4u * kq; \
            const f32x4 g4 = *(const f32x4*)(gn + k4), sc4 = *(const f32x4*)(scp + k4), sh4 = *(const f32x4*)(shp + k4); const f32x4 gm4 = g4 * (sc4 + 1.0f); \
            _Pragma("unroll") for (int i = 0; i < 8; ++i) { const int tl = 4 * i + tsub; const float rsd = rsl[tl]; const f32x4 h4 = (X[i] * rsd) * gm4 + sh4; \
                int o8 = __builtin_amdgcn_cvt_pk_fp8_f32(h4[0], h4[1], 0, false); o8 = __builtin_amdgcn_cvt_pk_fp8_f32(h4[2], h4[3], o8, true); *(int*)(H8 + (xoff + 4096u * i + 64u * (kc_))) = o8; *(LAS f32x4*)(hT + tl * 68 + 4 * kq) = h4; } \
            if ((kc_) + 1 < 16) { RT_LOADX((kc_) + 1); RT_LOADW(WN, (kc_) + 1); } \
            _Pragma("unroll") for (int c = 0; c < 8; ++c) { const f32x4 b4 = *(const LAS f32x4*)(hT + r32 * 68 + 8 * c + 4 * hi); \
                _Pragma("unroll") for (int j = 0; j < 4; ++j) { acc = __builtin_amdgcn_mfma_f32_32x32x2f32(W[c][j], b4[j], acc, 0, 0, 0); \
                    const f32x4 w4 = *(const LAS f32x4*)(wgl + (64 * (kc_) + 8 * c + 4 * hi + j) * 4); \
                    _Pragma("unroll") for (int q = 0; q < 4; ++q) gl[q] += b4[j] * w4[q]; } asm volatile("" : "+v"(gl[0]), "+v"(gl[1]), "+v"(gl[2]), "+v"(gl[3])); } } while (0)
        RT_LOADX(0); RT_LOADW(Wa, 0);
#pragma unroll 1
        for (int kc = 0; kc < 16; kc += 2) {
            RT_STEP(Wa, Wb, kc);
            RT_STEP(Wb, Wa, kc + 1);
        }
#undef RT_LOADX
#undef RT_LOADW
#undef RT_STEP
#pragma unroll
        for (int q = 0; q < 4; ++q) gl[q] = fa::half_swap_sum(gl[q]);
        float gp[4]; { const float gm = fmaxf(fmaxf(gl[0], gl[1]), fmaxf(gl[2], gl[3])); float gs = 0.f;
#pragma unroll
            for (int g = 0; g < 4; ++g) { gp[g] = expf(gl[g] - gm); gs += gp[g]; }
#pragma unroll
            for (int g = 0; g < 4; ++g) gp[g] /= gs; }
        int gi = 0; float best = -1e30f, gate = 0.f;
#pragma unroll
        for (int g = 0; g < 4; ++g) { const float sv = gp[g] + bg[g]; if (sv > best) { best = sv; gi = g; gate = gp[g]; } }
        float el[8];
#pragma unroll
        for (int j = 0; j < 4; ++j) { const float own = (gi == 0) ? acc[j] : (gi == 1) ? acc[4 + j] : (gi == 2) ? acc[8 + j] : acc[12 + j];
            auto rr = __builtin_amdgcn_permlane32_swap(__float_as_uint(own), __float_as_uint(own), false, false);
            el[j] = __uint_as_float(rr[0]); el[4 + j] = __uint_as_float(rr[1]); }
        float em = el[0];
#pragma unroll
        for (int e = 1; e < 8; ++e) em = fmaxf(em, el[e]);
        float ep[8], es = 0.f;
#pragma unroll
        for (int e = 0; e < 8; ++e) { ep[e] = expf(el[e] - em); es += ep[e]; }
        int i0 = 0; float b0 = -1e30f, p0 = 0.f;
#pragma unroll
        for (int e = 0; e < 8; ++e) { ep[e] /= es; const float sv = ep[e] + br[gi * 8 + e]; if (sv > b0) { b0 = sv; i0 = e; p0 = ep[e]; } }
        int i1 = 0; float b1 = -1e30f, p1 = 0.f;
#pragma unroll
        for (int e = 0; e < 8; ++e) { const float sv = ep[e] + br[gi * 8 + e]; if (e != i0 && sv > b1) { b1 = sv; i1 = e; p1 = ep[e]; } }
        const float den = p0 + p1;
        if (hi == 0) { const int tl = w * 32 + r32; le0[tl] = gi * 8 + i0; le1[tl] = gi * 8 + i1; lw0[tl] = p0 / den * gate; lw1[tl] = p1 / den * gate; }
        __syncthreads();
        int e0 = 0, e1 = 0, q0 = 0, q1 = 0;
        if (C.tid < 256) { e0 = le0[C.tid]; e1 = le1[C.tid]; q0 = atomicAdd(&hist[e0], 1); q1 = atomicAdd(&hist[e1], 1); }
        __syncthreads();
        if (C.tid < 32) base[C.tid] = (int)__hip_atomic_fetch_add(cnt + C.tid * 64, (unsigned)hist[C.tid], __ATOMIC_RELAXED, __HIP_MEMORY_SCOPE_AGENT);
        __syncthreads();
        if (C.tid < 256) { const int tok = chunk * 256 + C.tid;
            const size_t i0_ = (size_t)e0 * NTOK + base[e0] + q0, i1_ = (size_t)e1 * NTOK + base[e1] + q1;
            list[i0_] = 2 * tok; list[i1_] = 2 * tok + 1; listw[i0_] = lw0[C.tid]; listw[i1_] = lw1[C.tid]; }
    }
}

__device__ __forceinline__ void ph_attn_da_mfma(const Ctx& C) {
    using namespace fa;
    LAS unsigned char* L = (LAS unsigned char*)C.lds;
    constexpr int STG = 32768;
    LAS float* wsf = (LAS float*)(L + 3 * STG) + C.wave * 32;
    const int vcu = ((int)blockIdx.x & 7) * 32 + ((int)blockIdx.x >> 3), xcd = vcu >> 5, grp = (vcu >> 4) & 1, jj = vcu & 15;
    const bf16* Q = (const bf16*)(C.ws + WS_A); const bf16* Kb = Q + (size_t)NTOK * D; const bf16* Vb = Kb + (size_t)NTOK * D; bf16* O = (bf16*)(C.ws + WS_O);
    const float lam = *(const float*)(C.ws + WS_LAM);
    const int lane = C.lane, w = C.wave, c = w >> 2, wq = w & 3, r32 = lane & 31, hi = lane >> 5;
    const float c2 = 0.125f * 1.4426950408889634f;
    for (int u = 0; u < 16; ++u) {
        const int bh = xcd * 32 + 2 * u + grp, b = bh >> 3, h = bh & 7, qb = (u & 1) ? 15 - jj : jj, q0 = qb * 128;
        const size_t rowb = (size_t)b * SEQ;
        const int NT = (q0 + 128) / 64, qw0 = q0 + 32 * wq, T = qw0 >> 6;
        const bf16* sbase = (w < 4 ? Kb : Vb) + rowb * D;
        unsigned soff[4]; int dsto[4];
#pragma unroll
        for (int i = 0; i < 4; ++i) {
            if (w < 4) { const int cm = w >> 1, ch = (w & 1) * 4 + i; soff[i] = (unsigned)((lane * D + (2 * h + cm) * 64 + ch * 8) * 2); dsto[i] = cm * 8192 + ch * 1024; }
            else { const int db = w - 4, rg = i; soff[i] = (unsigned)(((rg * 16 + (lane >> 2)) * D + h * 128 + db * 32 + (lane & 3) * 8) * 2); dsto[i] = 16384 + db * 4096 + rg * 1024; }
        }
        bf16x8 qf[4];
#pragma unroll
        for (int d0 = 0; d0 < 4; ++d0) qf[d0] = *(const bf16x8*)(Q + (rowb + qw0 + r32) * D + (2 * h + c) * 64 + d0 * 16 + hi * 8);
#pragma unroll
        for (int d0 = 0; d0 < 4; ++d0) asm volatile("" : "+v"(qf[d0]));
        f32x16 o[4];
#pragma unroll
        for (int db = 0; db < 4; ++db)
#pragma unroll
            for (int r = 0; r < 16; ++r) o[db][r] = 0.f;
        float m = 0.f, l = 0.f; f32x16 negm;
#pragma unroll
        for (int r = 0; r < 16; ++r) negm[r] = 0.f;
        asm volatile("s_waitcnt lgkmcnt(0)" ::: "memory"); __builtin_amdgcn_s_barrier();
#pragma unroll
        for (int i = 0; i < 4; ++i) dma16s(sbase, soff[i], L + dsto[i]);
#pragma unroll
        for (int i = 0; i < 4; ++i) dma16s(sbase + (size_t)64 * D, soff[i], L + STG + dsto[i]);
        int sc_ = 0, sn_ = 2;
        for (int t = 0; t < NT; ++t) {
            if (t + 1 < NT) asm volatile("s_waitcnt vmcnt(4) lgkmcnt(0)" ::: "memory"); else asm volatile("s_waitcnt vmcnt(0) lgkmcnt(0)" ::: "memory");
            __builtin_amdgcn_s_barrier();
            if (t + 2 < NT) {
#pragma unroll
                for (int i = 0; i < 4; ++i) dma16s(sbase + (size_t)(t + 2) * 64 * D, soff[i], L + sn_ * STG + dsto[i]);
            }
            if (t <= T) {
                lds_cptr stg = (lds_cptr)L + sc_ * STG;
                tile<4, 4>(stg + c * 8192, stg + 16384, qf, o, negm, m, l, wsf, t == 0, t == T, qw0 - 64 * T + r32, lane);
            }
            sc_ = (sc_ == 2) ? 0 : sc_ + 1; sn_ = (sn_ == 2) ? 0 : sn_ + 1;
        }
        l = half_swap_sum(l);
        if (hi == 0) wsf[r32] = 1.0f / l;
        asm volatile("s_waitcnt lgkmcnt(0)" ::: "memory");
        f32x4 a4[4];
#pragma unroll
        for (int g = 0; g < 4; ++g) a4[g] = *(const LAS f32x4*)(wsf + 8 * g + 4 * hi);
#pragma unroll
        for (int db = 0; db < 4; ++db)
#pragma unroll
            for (int r = 0; r < 16; ++r) o[db][r] *= a4[r >> 2][r & 3];
        asm volatile("s_waitcnt lgkmcnt(0)" ::: "memory"); __builtin_amdgcn_s_barrier();
        LAS float* X = (LAS float*)L + wq * 4352 + lane * 68;
        if (c == 1) {
#pragma unroll
            for (int db = 0; db < 4; ++db)
#pragma unroll
                for (int g = 0; g < 4; ++g) *(LAS f32x4*)(X + db * 16 + 4 * g) = (f32x4){o[db][4 * g], o[db][4 * g + 1], o[db][4 * g + 2], o[db][4 * g + 3]};
        }
        asm volatile("s_waitcnt lgkmcnt(0)" ::: "memory"); __builtin_amdgcn_s_barrier();
        if (c == 0) {
            float gsub[4];
#pragma unroll
            for (int db = 0; db < 4; ++db) gsub[db] = as_global(C.in[I_DA_SUBLN])[db * 32 + r32] * 0.8f;
#pragma unroll
            for (int db = 0; db < 4; ++db)
#pragma unroll
                for (int g = 0; g < 4; ++g) { const f32x4 x = *(const LAS f32x4*)(X + db * 16 + 4 * g);
#pragma unroll
                    for (int j2 = 0; j2 < 4; ++j2) o[db][4 * g + j2] -= lam * x[j2]; }
            float uu[8];
#pragma unroll
            for (int r = 0; r < 8; ++r) {
                const float sa = (o[0][r] * o[0][r] + o[1][r] * o[1][r]) + (o[2][r] * o[2][r] + o[3][r] * o[3][r]);
                const float sb = (o[0][r + 8] * o[0][r + 8] + o[1][r + 8] * o[1][r + 8]) + (o[2][r + 8] * o[2][r + 8] + o[3][r + 8] * o[3][r + 8]);
                auto sw = __builtin_amdgcn_permlane16_swap(__float_as_uint(sa), __float_as_uint(sb), false, false);
                uu[r] = __uint_as_float(sw[0]) + __uint_as_float(sw[1]);
            }
#pragma unroll
            for (int r = 0; r < 8; ++r) {
                uu[r] += __uint_as_float((unsigned)__builtin_amdgcn_update_dpp(0, (int)__float_as_uint(uu[r]), 0x128, 0xF, 0xF, true));
                uu[r] += __uint_as_float((unsigned)__builtin_amdgcn_update_dpp(0, (int)__float_as_uint(uu[r]), 0x124, 0xF, 0xF, true));
                uu[r] += __uint_as_float((unsigned)__builtin_amdgcn_update_dpp(0, (int)__float_as_uint(uu[r]), 0x122, 0xF, 0xF, true));
                uu[r] += __uint_as_float((unsigned)__builtin_amdgcn_update_dpp(0, (int)__float_as_uint(uu[r]), 0x121, 0xF, 0xF, true));
                uu[r] = __builtin_amdgcn_rsqf(uu[r] * (1.0f / 128.0f) + EPS);
            }
            float rs[16];
#pragma unroll
            for (int r = 0; r < 8; ++r) { auto sw = __builtin_amdgcn_permlane16_swap(__float_as_uint(uu[r]), __float_as_uint(uu[r]), false, false); rs[r] = __uint_as_float(sw[0]); rs[r + 8] = __uint_as_float(sw[1]); }
            asm volatile("s_waitcnt lgkmcnt(0)" ::: "memory");
            LAS unsigned char* TT = (LAS unsigned char*)((LAS float*)L + wq * 4352);
#pragma unroll
            for (int r = 0; r < 16; ++r) {
                const unsigned p01 = cvtpk(o[0][r] * (rs[r] * gsub[0]), o[1][r] * (rs[r] * gsub[1])), p23 = cvtpk(o[2][r] * (rs[r] * gsub[2]), o[3][r] * (rs[r] * gsub[3]));
                LAS unsigned short* tp = (LAS unsigned short*)(TT + crow(r, hi) * 272 + r32 * 2);
                tp[0] = (unsigned short)p01; tp[32] = (unsigned short)(p01 >> 16); tp[64] = (unsigned short)p23; tp[96] = (unsigned short)(p23 >> 16);
            }
            asm volatile("s_waitcnt lgkmcnt(0)" ::: "memory");
#pragma unroll
            for (int i = 0; i < 8; ++i) {
                const int row = 4 * i + (lane >> 4);
                const u32x4 v = *(const LAS u32x4*)(TT + row * 272 + (lane & 15) * 16);
                *(u32x4*)(O + (rowb + qw0 + row) * D + h * 128 + (lane & 15) * 8) = v;
            }
        }
    }
}
__device__ __forceinline__ void ph_attn_mla_mfma(const Ctx& C) {
    using namespace fa;
    LAS unsigned char* L = (LAS unsigned char*)C.lds;
    constexpr int STG = 20480;
    LAS float* wsf = (LAS float*)(L + 3 * STG) + C.wave * 32;
    const int vcu = ((int)blockIdx.x & 7) * 32 + ((int)blockIdx.x >> 3), xcd = vcu >> 5, grp = (vcu >> 3) & 3, jj = vcu & 7;
    const bf16* Q2 = (const bf16*)(C.ws + WS_A); const bf16* KV2 = (const bf16*)(C.ws + WS_A + 192 * MiB);
    const bf16* KPE = (const bf16*)(C.ws + WS_KPE); bf16* O = (bf16*)(C.ws + WS_O);
    const int lane = C.lane, w = C.wave, r32 = lane & 31, hi = lane >> 5;
    const float c2 = 0.10206207261596575f * 1.4426950408889634f;
    for (int u = 0; u < 16; ++u) {
        const int bh = xcd * 64 + 4 * u + grp, b = bh >> 4, h = bh & 15, qb = (u & 1) ? 7 - jj : jj, q0 = qb * 256;
        const size_t rowb = (size_t)b * SEQ;
        const int NT = (q0 + 256) / 64, qw0 = q0 + 32 * w, T = qw0 >> 6;
        const bf16* src[3]; int dsto[3]; size_t sstep[3];
#pragma unroll
        for (int i = 0; i < 3; ++i) {
            const int pi = w + 8 * i;
            if (pi < 8) { src[i] = KV2 + (rowb + lane) * 2048 + h * 128 + pi * 8; dsto[i] = pi * 1024; sstep[i] = (size_t)64 * 2048; }
            else if (pi < 12) { src[i] = KPE + (rowb + lane) * 32 + (pi - 8) * 8; dsto[i] = pi * 1024; sstep[i] = (size_t)64 * 32; }
            else { const int db = (pi - 12) >> 2, rg = (pi - 12) & 3; src[i] = KV2 + (rowb + rg * 16 + (lane >> 2)) * 2048 + h * 128 + 64 + db * 32 + (lane & 3) * 8; dsto[i] = 12288 + db * 4096 + rg * 1024; sstep[i] = (size_t)64 * 2048; }
        }
        const bool has3 = (w + 16) < 20;
        bf16x8 qf[6];
#pragma unroll
        for (int d0 = 0; d0 < 6; ++d0) qf[d0] = *(const bf16x8*)(Q2 + (rowb + qw0 + r32) * 1536 + (d0 < 4 ? h * 64 + d0 * 16 : 1024 + h * 32 + (d0 - 4) * 16) + hi * 8);
#pragma unroll
        for (int d0 = 0; d0 < 6; ++d0) asm volatile("" : "+v"(qf[d0]));
        f32x16 o[2];
#pragma unroll
        for (int db = 0; db < 2; ++db)
#pragma unroll
            for (int r = 0; r < 16; ++r) o[db][r] = 0.f;
        float m = 0.f, l = 0.f; f32x16 negm;
#pragma unroll
        for (int r = 0; r < 16; ++r) negm[r] = 0.f;
        asm volatile("s_waitcnt lgkmcnt(0)" ::: "memory"); __builtin_amdgcn_s_barrier();
        dma16(src[0], L + dsto[0]); dma16(src[1], L + dsto[1]); if (has3) dma16(src[2], L + dsto[2]);
        dma16(src[0] + sstep[0], L + STG + dsto[0]); dma16(src[1] + sstep[1], L + STG + dsto[1]); if (has3) dma16(src[2] + sstep[2], L + STG + dsto[2]);
        int sc_ = 0, sn_ = 2;
        for (int t = 0; t < NT; ++t) {
            if (t + 1 < NT) { if (has3) asm volatile("s_waitcnt vmcnt(3) lgkmcnt(0)" ::: "memory"); else asm volatile("s_waitcnt vmcnt(2) lgkmcnt(0)" ::: "memory"); }
            else asm volatile("s_waitcnt vmcnt(0) lgkmcnt(0)" ::: "memory");
            __builtin_amdgcn_s_barrier();
            if (t + 2 < NT) {
                LAS unsigned char* nb = L + sn_ * STG;
                dma16(src[0] + (t + 2) * sstep[0], nb + dsto[0]); dma16(src[1] + (t + 2) * sstep[1], nb + dsto[1]); if (has3) dma16(src[2] + (t + 2) * sstep[2], nb + dsto[2]);
            }
            if (t <= T) {
                lds_cptr stg = (lds_cptr)L + sc_ * STG;
                tile<6, 2>(stg, stg + 12288, qf, o, negm, m, l, wsf, t == 0, t == T, qw0 - 64 * T + r32, lane);
            }
            sc_ = (sc_ == 2) ? 0 : sc_ + 1; sn_ = (sn_ == 2) ? 0 : sn_ + 1;
        }
        l = half_swap_sum(l);
        if (hi == 0) wsf[r32] = 1.0f / l;
        asm volatile("s_waitcnt lgkmcnt(0)" ::: "memory");
        f32x4 a4[4];
#pragma unroll
        for (int g = 0; g < 4; ++g) a4[g] = *(const LAS f32x4*)(wsf + 8 * g + 4 * hi);
        LAS unsigned char* TT = L + 65536 + w * 4608;
#pragma unroll
        for (int r = 0; r < 16; ++r) {
            const unsigned pk = cvtpk(o[0][r] * a4[r >> 2][r & 3], o[1][r] * a4[r >> 2][r & 3]);
            LAS unsigned short* tp = (LAS unsigned short*)(TT + crow(r, hi) * 144 + r32 * 2);
            tp[0] = (unsigned short)pk; tp[32] = (unsigned short)(pk >> 16);
        }
        asm volatile("s_waitcnt lgkmcnt(0)" ::: "memory");
#pragma unroll
        for (int i = 0; i < 4; ++i) {
            const int row = 8 * i + (lane >> 3);
            const u32x4 v = *(const LAS u32x4*)(TT + row * 144 + (lane & 7) * 16);
            *(u32x4*)(O + (rowb + qw0 + row) * D + h * 64 + (lane & 7) * 8) = v;
        }
    }
}

__global__ void __launch_bounds__(NTHR, 2) fwd(Args args) {
    extern __shared__ __attribute__((aligned(16))) unsigned char lds[];
    Ctx C; C.in = args.in; C.out = args.out; C.ws = args.ws; C.lds = lds;
    C.tid = threadIdx.x; C.lane = C.tid & 63; C.wave = __builtin_amdgcn_readfirstlane(C.tid >> 6);
    C.gw = blockIdx.x * NWAVES + C.wave; C.ngw = gridDim.x * NWAVES;
    const Ctx C0 = C;
    volatile LAS unsigned* MISC = (volatile LAS unsigned*)((LAS unsigned char*)lds + MISC_OFF);
    if (C.tid < 32) MISC[C.tid] = 0u;
    __syncthreads();
    XcdBarrier bar; bar.bar = (unsigned*)(args.ws + WS_CTL) + CW_BAR; bar.x = 0; bar.st = nullptr;
    const int lo = args.ph_lo, hi = args.ph_hi;
    if (hi - lo > 1) bar = xcd_barrier_post((unsigned*)(args.ws + WS_CTL) + CW_BAR, MISC + 8);
#ifndef REPMASK
#define REPMASK 0u
#endif
#ifndef PHMASK
#define PHMASK 0xFFFFFFFFu
#endif
#define IN(k) (lo <= (k) && (k) < hi && ((PHMASK >> (k)) & 1u))
#define SEAM(k) do { if (IN(k) && IN((k) + 1)) xcd_barrier(bar); } while (0)
#define PHLOCAL unsigned char* ws = args.ws; asm volatile("" : "+s"(ws)); ws = as_global(ws); int t_ = threadIdx.x; asm volatile("" : "+v"(t_)); Ctx C = C0; C.ws = ws; C.tid = t_; C.lane = t_ & 63; \
        bf16* H = (bf16*)(ws + WS_H); bf16* O = (bf16*)(ws + WS_O); bf16* A0 = (bf16*)(ws + WS_A); (void)H; (void)O; (void)A0;

    if (IN(0)) { PHLOCAL ph_prologue(C); } SEAM(0);
    if (IN(1)) { PHLOCAL ph_normmod0(C); } SEAM(1);
    if (IN(2)) { PHLOCAL
        pg8::Gemm g{H, (const bf16*)(ws + WB_QKV), NTOK, 3 * D, D}; pg8::StaticOrder S; S.init(NTOK, 3 * D, (int)gridDim.x, (int)blockIdx.x);
        pg8::EpiQKV E{A0, A0 + (size_t)NTOK * D, A0 + (size_t)2 * NTOK * D, (const float*)(ws + WS_COSD), (const float*)(ws + WS_SIND), as_global(args.in[I_DA_QN]), as_global(args.in[I_DA_KN]), 0.125f * 1.4426950408889634f, EPS};
        pg8::gemm_phase<pg8::EpiQKV, pg8::StaticOrder, PG8_ALIGN, PG8_SP2>((PG8_LAS unsigned char*)lds, g, S, E);
    } SEAM(2);
    if (IN(3)) { PHLOCAL ph_attn_da_mfma(C); } SEAM(3);
    if (IN(4)) { PHLOCAL
        pg8::Gemm g{O, (const bf16*)(ws + WB_DAO), NTOK, D, D}; pg8::StaticOrder S; S.init(NTOK, D, (int)gridDim.x, (int)blockIdx.x);
        pg8::EpiResid<true> E{as_global(args.in[I_X]), (bf16*)(ws + WS_XB), C.mod(0, 0, 2), (float*)(ws + WS_SSQX)};
        pg8::gemm_phase<pg8::EpiResid<true>, pg8::StaticOrder, PG8_ALIGN, PG8_SP2>((PG8_LAS unsigned char*)lds, g, S, E);
    } SEAM(4);
    if (IN(5)) { PHLOCAL ph_route(C, 0); } SEAM(5);
    if (IN(6)) { PHLOCAL ph_moe1_mfma(C, 0); } SEAM(6);
    if (IN(7)) { PHLOCAL ph_moe2_mfma(C, 0); } SEAM(7);
    if (IN(8)) { PHLOCAL ph_comb<false>(C, ws + WS_A + 128 * MiB, C.mod(0, 0, 5), 1, as_global(args.in[I_NMIX]) + D); } SEAM(8);
    if (IN(9)) { PHLOCAL
        bf16* CQ = (bf16*)(ws + WS_S); bf16* CKV = CQ + (size_t)NTOK * 384; bf16* KPE = (bf16*)(ws + WS_KPE);
        pg8::Gemm g{H, (const bf16*)(ws + WB_WIN), NTOK, 768, D}; pg8::StaticOrder S; S.init(NTOK, 768, (int)gridDim.x, (int)blockIdx.x);
        pg8::EpiWin E{CQ, CKV, KPE, (float*)(ws + WS_SSQ), (const float*)(ws + WS_COSM), (const float*)(ws + WS_SINM), as_global(args.in[I_M_KPN]), EPS};
        pg8::gemm_phase<pg8::EpiWin, pg8::StaticOrder, PG8_ALIGN, PG8_SP2>((PG8_LAS unsigned char*)lds, g, S, E);
    } SEAM(9);
    if (IN(10)) { PHLOCAL
        const bf16* CQ = (const bf16*)(ws + WS_S); const bf16* CKV = CQ + (size_t)NTOK * 384;
        int Kq = 384, Kkv = 256; asm volatile("" : "+s"(Kq), "+s"(Kkv));
        { pg8::Gemm g{CQ, (const bf16*)(ws + WB_WUQ), NTOK, 1536, Kq}; pg8::StaticOrder S; S.init(NTOK, 1536, (int)gridDim.x, (int)blockIdx.x);
          pg8::EpiUQ E{A0, (const float*)(ws + WS_SSQ), (const float*)(ws + WS_COSM), (const float*)(ws + WS_SINM), as_global(args.in[I_M_QNN]), as_global(args.in[I_M_QPN]), 0.10206207261596575f * 1.4426950408889634f, EPS};
          pg8::gemm_phase<pg8::EpiUQ, pg8::StaticOrder, PG8_ALIGN, PG8_SP2>((PG8_LAS unsigned char*)lds, g, S, E); }
        { pg8::Gemm g{CKV, (const bf16*)(ws + WB_WUKV), NTOK, 2048, Kkv}; pg8::StaticOrder S; S.init(NTOK, 2048, (int)gridDim.x, (int)blockIdx.x);
          pg8::EpiUKV E{(bf16*)(ws + WS_A + 192 * MiB), (const float*)(ws + WS_SSQ), as_global(args.in[I_M_KNN]), EPS};
          pg8::gemm_phase<pg8::EpiUKV, pg8::StaticOrder, PG8_ALIGN, PG8_SP2>((PG8_LAS unsigned char*)lds, g, S, E); }
    } SEAM(10);
    if (IN(11)) { PHLOCAL ph_attn_mla_mfma(C); } SEAM(11);
    if (IN(12)) { PHLOCAL
        pg8::Gemm g{O, (const bf16*)(ws + WB_MLO), NTOK, D, D}; pg8::StaticOrder S; S.init(NTOK, D, (int)gridDim.x, (int)blockIdx.x);
        pg8::EpiResid<false> E{ws + WS_XB, (bf16*)(ws + WS_XB), C.mod(1, 0, 2), (float*)(ws + WS_SSQX)};
        pg8::gemm_phase<pg8::EpiResid<false>, pg8::StaticOrder, PG8_ALIGN, PG8_SP2>((PG8_LAS unsigned char*)lds, g, S, E);
    } SEAM(12);
    if (IN(13)) { PHLOCAL ph_route(C, 1); } SEAM(13);
    if (IN(14)) { PHLOCAL ph_moe1_mfma(C, 1); } SEAM(14);
    if (IN(15)) { PHLOCAL ph_moe2_mfma(C, 1); } SEAM(15);
    if (IN(16)) { PHLOCAL ph_comb<true>(C, ws + WS_A + 128 * MiB, C.mod(1, 0, 5), 1, as_global(args.in[I_NMIX])); }
#undef IN
#undef SEAM
}

extern "C" void kernel_launch(void* const* d_in, const int* in_sizes, int n_in, void* d_out, int out_size, void* d_ws, size_t ws_size, hipStream_t stream) {
    static int grid = 0;
    if (grid == 0) {
        if (n_in != 33 || out_size != NTOK * D || ws_size < WS_END) { fprintf(stderr, "kernel_launch: unexpected shapes n_in %d out %d ws %zu\n", n_in, out_size, ws_size); grid = -1; return; }
        int dev = 0, cus = 0;
        if (hipGetDevice(&dev) != hipSuccess || hipDeviceGetAttribute(&cus, hipDeviceAttributeMultiprocessorCount, dev) != hipSuccess) { grid = -1; return; }
        if (hipFuncSetAttribute((const void*)fwd, hipFuncAttributeMaxDynamicSharedMemorySize, LDS_BYTES) != hipSuccess) { fprintf(stderr, "hipFuncSetAttribute failed\n"); grid = -1; return; }
        (void)hipGetLastError();
        grid = cus;
        if (grid != 256) { fprintf(stderr, "kernel_launch: built for 256 CUs, device reports %d\n", cus); grid = -1; return; }
    }
    if (grid < 0) return;
    (void)hipMemsetAsync((char*)d_ws + WS_CTL, 0, CTL_ZERO_BYTES, stream);
    Args a{};
    for (int i = 0; i < 33; ++i) a.in[i] = (const float*)d_in[i];
    a.out = (float*)d_out; a.ws = (unsigned char*)d_ws;
#if MK_ONE_LAUNCH
    a.ph_lo = 0; a.ph_hi = N_PHASES;
    hipLaunchKernelGGL(fwd, dim3(grid), dim3(NTHR), LDS_BYTES, stream, a);
#else
    for (int p = 0; p < N_PHASES; ++p) { a.ph_lo = p; a.ph_hi = p + 1; hipLaunchKernelGGL(fwd, dim3(grid), dim3(NTHR), LDS_BYTES, stream, a); }
#endif
}
```

```cpp
#include <hip/hip_runtime.h>
#include <cstdio>
#include <cstdint>

#define LAS __attribute__((address_space(3)))
#define GAS __attribute__((address_space(1)))
template <class T> __device__ __forceinline__ T* as_global(T* p) { GAS T* g = (GAS T*)p; asm("" : "+s"(g)); return (T*)g; }
typedef unsigned short bf16;
typedef float f32x4 __attribute__((ext_vector_type(4)));
typedef unsigned u32x4 __attribute__((ext_vector_type(4)));
typedef unsigned u32x2 __attribute__((ext_vector_type(2)));

constexpr int NB = 32, SEQ = 2048, D = 1024, NTOK = NB * SEQ;
constexpr float EPS = 1e-6f;
constexpr int NWAVES = 8, NTHR = 512;
constexpr int N_PHASES = 17;
#ifndef MK_ONE_LAUNCH
#define MK_ONE_LAUNCH 1
#endif

constexpr size_t MiB = 1u << 20;
constexpr size_t WS_CTL = 0, CTL_ZERO_BYTES = 1 * MiB;
constexpr size_t WS_MOD = 1 * MiB;
constexpr size_t WS_LAM = WS_MOD + 7 * MiB / 4;
constexpr size_t WS_SSQX = 4 * MiB;
constexpr size_t WS_SSQ = 8 * MiB;
constexpr size_t WS_WRT = 12 * MiB;
constexpr size_t WS_COSD = 16 * MiB, WS_SIND = 24 * MiB, WS_COSM = 32 * MiB, WS_SINM = 36 * MiB;
constexpr size_t WS_TOKW = 40 * MiB;
constexpr size_t WS_LIST = 42 * MiB;
constexpr size_t WS_WB = 50 * MiB;
constexpr size_t WB_QKV = WS_WB, WB_DAO = WB_QKV + 6 * MiB, WB_WIN = WB_DAO + 2 * MiB, WB_WUQ = WB_WIN + 3 * MiB / 2, WB_WUKV = WB_WUQ + 9 * MiB / 8, WB_MLO = WB_WUKV + 1 * MiB, WB_MOE = WB_MLO + 2 * MiB;
constexpr size_t WS_H = 176 * MiB;
constexpr size_t WS_O = 304 * MiB;
constexpr size_t WS_A = 432 * MiB;
constexpr size_t WS_LISTW = 160 * MiB;
constexpr size_t WS_KPE = 168 * MiB;
constexpr size_t WS_S = WS_O;
constexpr size_t WS_XB = 880 * MiB;
constexpr size_t WS_END = 1008 * MiB;
constexpr int CW_BAR = 4096;
constexpr int CW_CNT = 16384;
constexpr int HID_ROWS = 2 * NTOK + 32 * 128;

constexpr int LDS_BYTES = 147456;
constexpr int MISC_OFF = 131072 + 320;

__device__ __forceinline__ unsigned f2bf(float f) { unsigned u = __builtin_bit_cast(unsigned, f); return (u + 0x7fffu + ((u >> 16) & 1u)) >> 16; }
__device__ __forceinline__ float bf2f(unsigned h) { return __builtin_bit_cast(float, h << 16); }
__device__ __forceinline__ unsigned pk2(float lo, float hi) { return f2bf(lo) | (f2bf(hi) << 16); }
__device__ __forceinline__ float wave_sum(float v) {
#pragma unroll
    for (int o = 1; o < 64; o <<= 1) v += __shfl_xor(v, o);
    return v;
}
__device__ __forceinline__ float wave_max(float v) {
#pragma unroll
    for (int o = 1; o < 64; o <<= 1) v = fmaxf(v, __shfl_xor(v, o));
    return v;
}

#define XB_TMO      128
#define XB_XCNT(j)  (256  + 64 * (j))
#define XB_XSUB(j)  (1280 + 64 * (j))
#define XB_XGEN(j)  (2304 + 64 * (j))
#define XB_TOP      3328
#define XB_TOPGEN   3392
#define XCD_BAR_WORDS 3456
#define XB_SPIN_CAP (1u << 20)
__device__ __forceinline__ unsigned xb_ld(unsigned* p)              { return __hip_atomic_load(p, __ATOMIC_RELAXED, __HIP_MEMORY_SCOPE_AGENT); }
__device__ __forceinline__ unsigned xb_add(unsigned* p, unsigned v) { return __hip_atomic_fetch_add(p, v, __ATOMIC_RELAXED, __HIP_MEMORY_SCOPE_AGENT); }
__device__ __forceinline__ unsigned xb_xcc_id() { return (unsigned)__builtin_amdgcn_s_getreg((3 << 11) | 20) & 0xFu; }
#define XB_SPIN(cond, bar) do { unsigned _sp = 0; while (cond) { __builtin_amdgcn_s_sleep(1); \
    if ((++_sp & 255u) == 0u) { if (xb_ld(&(bar)[XB_TMO])) break; if (_sp > XB_SPIN_CAP) { atomicAdd(&(bar)[XB_TMO], 1u); break; } } } } while (0)
struct XcdBarrier { unsigned* bar; unsigned x; volatile LAS unsigned* st; };
__device__ __forceinline__ XcdBarrier xcd_barrier_post(unsigned* bar, volatile LAS unsigned* st) {
    XcdBarrier b; b.bar = bar; b.x = xb_xcc_id(); b.st = st;
    if (threadIdx.x == 0) (void)xb_add(&bar[XB_XCNT(b.x)], 1u);
    return b;
}
__device__ __forceinline__ void xcd_barrier_complete(unsigned* bar, unsigned x, unsigned& nloc, unsigned& nx) {
    const unsigned G = gridDim.x * gridDim.y * gridDim.z;
    unsigned sum, cnt, mine, sp = 0u;
    for (;;) {
        sum = 0u; cnt = 0u; mine = 0u;
#pragma unroll
        for (unsigned j = 0; j < 16; ++j) { const unsigned c = xb_ld(&bar[XB_XCNT(j)]); sum += c; cnt += (c > 0u) ? 1u : 0u; mine = (j == x) ? c : mine; }
        if (sum == G) break;
        __builtin_amdgcn_s_sleep(1);
        if ((++sp & 255u) == 0u) { if (xb_ld(&bar[XB_TMO])) break; if (sp > XB_SPIN_CAP) { atomicAdd(&bar[XB_TMO], 1u); break; } }
    }
    nloc = mine > 0u ? mine : 1u; nx = cnt > 0u ? cnt : 1u;
}
__device__ __forceinline__ void xcd_barrier(const XcdBarrier& b) {
    asm volatile("s_waitcnt vmcnt(0)" ::: "memory");
    __syncthreads();
    if (threadIdx.x == 0) {
        unsigned* bar = b.bar;
        __builtin_amdgcn_s_waitcnt(0);
        unsigned nloc = b.st[0], nx = b.st[1];
        if (nloc == 0u) { xcd_barrier_complete(bar, b.x, nloc, nx); b.st[0] = nloc; b.st[1] = nx; }
        const unsigned old = xb_add(&bar[XB_XSUB(b.x)], 1u);
        const unsigned gen = old / nloc;
        if (old + 1u == (gen + 1u) * nloc) {
            __builtin_amdgcn_fence(__ATOMIC_RELEASE, "agent");
            asm volatile("s_waitcnt vmcnt(0)" ::: "memory");
            const unsigned og = xb_add(&bar[XB_TOP], 1u);
            const unsigned tg = og / nx;
            if (og + 1u == (tg + 1u) * nx) xb_add(&bar[XB_TOPGEN], 1u);
            else XB_SPIN(xb_ld(&bar[XB_TOPGEN]) == tg, bar);
            __builtin_amdgcn_fence(__ATOMIC_ACQUIRE, "agent");
            xb_add(&bar[XB_XGEN(b.x)], 1u);
            asm volatile("s_waitcnt vmcnt(0)" ::: "memory");
        } else {
            XB_SPIN(xb_ld(&bar[XB_XGEN(b.x)]) == gen, bar);
            __builtin_amdgcn_fence(__ATOMIC_ACQUIRE, "agent");
            asm volatile("s_waitcnt vmcnt(0)" ::: "memory");
        }
    }
    __syncthreads();
}

namespace pg8 {
#define PG8_LAS __attribute__((address_space(3)))
typedef unsigned short bf16_t;
typedef short bf16x8 __attribute__((ext_vector_type(8)));
typedef float f32x4 __attribute__((ext_vector_type(4)));
typedef unsigned u32x4 __attribute__((ext_vector_type(4)));
constexpr int BM = 256, BK = 64, HALF = 128, HTB = HALF * BK * 2  , STAGE_BYTES = 8 * HTB, NXCD = 8, WGM = 8;

__host__ __device__ __forceinline__ int lds_byte(int r, int c) { const int st = (r >> 4) * 2 + (c >> 5), rr = r & 15, cc = c & 31, ob = rr * 64 + cc * 2; return st * 1024 + (ob ^ (((ob >> 9) & 1) << 5)); }
__host__ __device__ __forceinline__ void stage_rc(int b, int& R, int& C) { const int st = b / 1024, sb = b % 1024, swz = sb ^ (((sb >> 9) & 1) << 5); R = (st >> 1) * 16 + swz / 64; C = (st & 1) * 32 + (swz % 64) / 2; }
__host__ __device__ __forceinline__ int perm32(int rho) { const int n = rho >> 4, i = rho & 15; return 8 * (i >> 2) + 4 * n + (i & 3); }

struct Unit { int pm, pn; };
struct Gemm { const bf16_t* A; const bf16_t* Bt; int M, N, K; };

struct StaticOrder {
    typedef Unit UnitT;
    int nM, nN, nwg, G, c;
    __host__ __device__ void init(int M, int N, int G_, int c_) { nM = M / BM; nN = N / BM; nwg = nM * nN; G = G_; c = c_; }
    __host__ __device__ bool next(int i, Unit& u) const {
        const long L = (long)i * G + c; if (L >= nwg) return false;
        int wgid = (int)L; { const int q = nwg / NXCD, r = nwg % NXCD, xcd = wgid % NXCD, off = wgid / NXCD; wgid = (xcd < r ? xcd * (q + 1) : r * (q + 1) + (xcd - r) * q) + off; }
        const int nig = WGM * nN, gid = wgid / nig, fm = gid * WGM, gsz = (nM - fm) < WGM ? (nM - fm) : WGM;
        u.pm = fm + ((wgid % nig) % gsz); u.pn = (wgid % nig) / gsz; return true;
    }
    __device__ __forceinline__ void a_ready(const Unit&) const {}
    __device__ __forceinline__ void done(const Unit&) const {}
};

__device__ __forceinline__ unsigned cvt_pk_bf16(float lo, float hi) { unsigned r; asm volatile("v_cvt_pk_bf16_f32 %0, %1, %2" : "=v"(r) : "v"(lo), "v"(hi)); return r; }
typedef float f32x2 __attribute__((ext_vector_type(2)));
__device__ __forceinline__ f32x2 gelu_pk(f32x2 v) {
    const f32x2 av = __builtin_elementwise_abs(v), d = av * 0.2316418882f + 1.0f;
    f32x2 t; t.x = __builtin_amdgcn_rcpf(d.x); t.y = __builtin_amdgcn_rcpf(d.y);
    f32x2 q = t * 0.5307027145f + (-0.7265760135f); q = q * t + 0.7107068705f; q = q * t + (-0.142248368f); q = q * t + 0.127414796f; q = q * t;
    const f32x2 s = (v * v) * (-0.72134752044f);
    f32x2 e; e.x = __builtin_amdgcn_exp2f(s.x); e.y = __builtin_amdgcn_exp2f(s.y);
    const f32x2 m = v * (q * e), r = v - m;
    f32x2 o; o.x = v.x < 0.f ? m.x : r.x; o.y = v.y < 0.f ? m.y : r.y; return o;
}

template <int ACT  > struct EpiBf16 {
    static constexpr bool PERM = true, AFTER_DRAIN = false; static_assert(ACT == 0 || ACT == 1, "EpiBf16: ACT is 0 (none) or 1 (gelu_pk)");
    bf16_t* O; int ldc; const float* bias; int split_cols; size_t split_stride; float scale0;
    __device__ __forceinline__ void operator()(const f32x4 (&acc)[2][2][4][2], const Unit& u, int wr, int wc, int fr, int fq) const {
        const int row0 = u.pm * BM + wr * 64 + fr; int colt = u.pn * BM; bf16_t* base = O;
        float sc = 1.f; if (split_cols) { const int t = colt / split_cols; base += (size_t)t * split_stride; colt -= t * split_cols; if (t == 0) sc = scale0; }
        const int col0 = colt + wc * 32 + 8 * fq, bcol0 = u.pn * BM + wc * 32 + 8 * fq;
        f32x4 bv[2][2];
#pragma unroll
        for (int bj = 0; bj < 2; ++bj)
#pragma unroll
            for (int n = 0; n < 2; ++n) bv[bj][n] = bias ? *(const f32x4*)(bias + bcol0 + bj * HALF + 4 * n) : (f32x4){0.f, 0.f, 0.f, 0.f};
#pragma unroll
        for (int ai = 0; ai < 2; ++ai)
#pragma unroll
            for (int m = 0; m < 4; ++m) { bf16_t* rowp = base + (size_t)(row0 + ai * HALF + m * 16) * ldc + col0;
#pragma unroll
                for (int bj = 0; bj < 2; ++bj) { f32x4 v0 = acc[ai][bj][m][0] + bv[bj][0], v1 = acc[ai][bj][m][1] + bv[bj][1];
                    if (ACT == 1) { f32x2 a = gelu_pk((f32x2){v0[0], v0[1]}), b = gelu_pk((f32x2){v0[2], v0[3]}), c = gelu_pk((f32x2){v1[0], v1[1]}), d = gelu_pk((f32x2){v1[2], v1[3]});
                        v0 = (f32x4){a.x, a.y, b.x, b.y}; v1 = (f32x4){c.x, c.y, d.x, d.y}; }
                    v0 = v0 * sc; v1 = v1 * sc; u32x4 w; w.x = cvt_pk_bf16(v0[0], v0[1]); w.y = cvt_pk_bf16(v0[2], v0[3]); w.z = cvt_pk_bf16(v1[0], v1[1]); w.w = cvt_pk_bf16(v1[2], v1[3]);
                    *(u32x4*)(rowp + bj * HALF) = w; } }
    }
};

template <class Epi, class Sched, bool ALIGN_EPI = false, bool SP2 = false>
__device__ __forceinline__ void gemm_phase(PG8_LAS unsigned char* lds, const Gemm g, const Sched& S, const Epi& E) {
    int tid_ = threadIdx.x; asm volatile("" : "+v"(tid_));
    const int tid = tid_, wid = __builtin_amdgcn_readfirstlane(tid >> 6), lane = tid & 63, wr = wid >> 2, wc = wid & 3, fr = lane & 15, fq = lane >> 4;
    const int K = g.K, nt = K / BK;
    unsigned voffA[2], voffB[2];
#pragma unroll
    for (int i = 0; i < 2; ++i) { int R, C; stage_rc(tid * 16 + i * 8192, R, C); const int Rb = Epi::PERM ? ((R & ~31) + perm32(R & 31)) : R;
        voffA[i] = (unsigned)(R * K + C) * 2u; voffB[i] = (unsigned)(Rb * K + C) * 2u; }
    const size_t kstep = (size_t)(BK * 2);
    const size_t hstep = (size_t)HALF * K * 2;
    const size_t tstep = 2 * hstep;
    const unsigned ldsw = (unsigned)wid * 1024u;
    const int aoff = lds_byte(wr * 64 + fr, fq * 8), boff = lds_byte(wc * 32 + fr, fq * 8);
#define PG8_SA(b, h) (((b) * 2 + (h)) * HTB)
#define PG8_SB(b, h) ((4 + (b) * 2 + (h)) * HTB)
#define PG8_STAGE(bufoff, gbase, voff) do { _Pragma("unroll") for (int _i = 0; _i < 2; ++_i) \
        __builtin_amdgcn_global_load_lds((const unsigned*)((const char*)(gbase) + (voff)[_i]), (PG8_LAS unsigned*)(lds + (bufoff) + ldsw + _i * 8192), 16, 0, 0); } while (0)
#define PG8_LDA(dst, b, h) do { _Pragma("unroll") for (int m = 0; m < 4; ++m) _Pragma("unroll") for (int k = 0; k < 2; ++k) dst[m][k] = *(const PG8_LAS bf16x8*)(lds + PG8_SA(b, h) + aoff + m * 2048 + k * 1024); } while (0)
#define PG8_LDB(dst, b, h) do { _Pragma("unroll") for (int n = 0; n < 2; ++n) _Pragma("unroll") for (int k = 0; k < 2; ++k) dst[n][k] = *(const PG8_LAS bf16x8*)(lds + PG8_SB(b, h) + boff + n * 2048 + k * 1024); } while (0)
#define PG8_MMA(ai, bj, At, Bt) do { __builtin_amdgcn_s_setprio(1); _Pragma("unroll") for (int m = 0; m < 4; ++m) _Pragma("unroll") for (int n = 0; n < 2; ++n) _Pragma("unroll") for (int k = 0; k < 2; ++k) \
        acc[ai][bj][m][n] = __builtin_amdgcn_mfma_f32_16x16x32_bf16(Bt[n][k], At[m][k], acc[ai][bj][m][n], 0, 0, 0); __builtin_amdgcn_s_setprio(0); } while (0)
#define PG8_WAIT_V(n) asm volatile("s_waitcnt vmcnt(" #n ")" ::: "memory")
#define PG8_WAIT_L(n) asm volatile("s_waitcnt lgkmcnt(" #n ")" ::: "memory")
#define PG8_BAR __builtin_amdgcn_s_barrier()
#define PG8_SCHED __builtin_amdgcn_sched_barrier(0)
    typename Sched::UnitT cur, nxt; int ui = 0;
    if (!S.next(0, cur)) return;
    f32x4 acc[2][2][4][2];
#pragma unroll
    for (int a = 0; a < 2; ++a)
#pragma unroll
        for (int b = 0; b < 2; ++b)
#pragma unroll
            for (int m = 0; m < 4; ++m)
#pragma unroll
                for (int n = 0; n < 2; ++n) acc[a][b][m][n] = (f32x4){0.f, 0.f, 0.f, 0.f};
    bf16x8 At[4][2], B0[2][2], B1[2][2];
    const char* cA = (const char*)g.A + (size_t)cur.pm * tstep; const char* cB = (const char*)g.Bt + (size_t)cur.pn * tstep;
    S.a_ready(cur);
    if constexpr (SP2) {
        PG8_STAGE(PG8_SB(0, 0), cB, voffB); PG8_STAGE(PG8_SB(0, 1), cB + hstep, voffB); PG8_STAGE(PG8_SA(0, 0), cA, voffA); PG8_STAGE(PG8_SA(0, 1), cA + hstep, voffA);
        if (wr == 1) PG8_BAR;
        PG8_WAIT_V(2); PG8_BAR;
        PG8_STAGE(PG8_SB(1, 0), cB + kstep, voffB); PG8_STAGE(PG8_SA(1, 0), cA + kstep, voffA); PG8_STAGE(PG8_SB(1, 1), cB + hstep + kstep, voffB);
        PG8_WAIT_V(6); PG8_BAR;
    } else {
        PG8_STAGE(PG8_SB(0, 0), cB, voffB); PG8_STAGE(PG8_SA(0, 0), cA, voffA); PG8_STAGE(PG8_SB(0, 1), cB + hstep, voffB); PG8_STAGE(PG8_SA(0, 1), cA + hstep, voffA);
        if (wr == 1) PG8_BAR;
        PG8_WAIT_V(4); PG8_BAR;
        PG8_STAGE(PG8_SB(1, 0), cB + kstep, voffB); PG8_STAGE(PG8_SA(1, 0), cA + kstep, voffA); PG8_STAGE(PG8_SB(1, 1), cB + hstep + kstep, voffB);
        PG8_WAIT_V(6); PG8_BAR;
    }
    for (;;) {
        const bool has_next = S.next(ui + 1, nxt);
        const char* nA = has_next ? (const char*)g.A + (size_t)nxt.pm * tstep : cA; const char* nB = has_next ? (const char*)g.Bt + (size_t)nxt.pn * tstep : cB;
        for (int t = 0; t < nt; t += 2) {
            const bool last = (t == nt - 2);
            const char* a1 = cA + (size_t)(t + 1) * kstep;
            const char* a2 = last ? nA : cA + (size_t)(t + 2) * kstep; const char* b2 = last ? nB : cB + (size_t)(t + 2) * kstep;
            const char* a3 = a2 + kstep; const char* b3 = b2 + kstep;
            if (last && has_next) S.a_ready(nxt);
            if constexpr (SP2) {
            PG8_LDB(B0, 0, 0); PG8_LDB(B1, 0, 1); PG8_SCHED; PG8_LDA(At, 0, 0); PG8_STAGE(PG8_SA(1, 1), a1 + hstep, voffA);
            PG8_WAIT_V(8); PG8_WAIT_L(0); PG8_BAR; PG8_MMA(0, 0, At, B0); PG8_MMA(0, 1, At, B1); PG8_BAR; PG8_SCHED;
            PG8_LDA(At, 0, 1); PG8_STAGE(PG8_SB(0, 0), b2, voffB); PG8_STAGE(PG8_SB(0, 1), b2 + hstep, voffB); PG8_STAGE(PG8_SA(0, 0), a2, voffA);
            PG8_WAIT_V(8); PG8_WAIT_L(0); PG8_BAR; PG8_MMA(1, 0, At, B0); PG8_MMA(1, 1, At, B1); PG8_BAR; PG8_SCHED;
            PG8_LDB(B0, 1, 0); PG8_LDB(B1, 1, 1); PG8_SCHED; PG8_LDA(At, 1, 0); PG8_STAGE(PG8_SA(0, 1), a2 + hstep, voffA);
            PG8_WAIT_V(8); PG8_WAIT_L(0); PG8_BAR; PG8_MMA(0, 0, At, B0); PG8_MMA(0, 1, At, B1); PG8_BAR; PG8_SCHED;
            PG8_LDA(At, 1, 1); PG8_STAGE(PG8_SB(1, 0), b3, voffB); PG8_STAGE(PG8_SB(1, 1), b3 + hstep, voffB); PG8_STAGE(PG8_SA(1, 0), a3, voffA);
            PG8_WAIT_V(8); PG8_WAIT_L(0); PG8_BAR; PG8_MMA(1, 0, At, B0); PG8_MMA(1, 1, At, B1); PG8_BAR; PG8_SCHED;
            } else {
            PG8_LDB(B0, 0, 0); PG8_SCHED; PG8_LDA(At, 0, 0); PG8_STAGE(PG8_SA(1, 1), a1 + hstep, voffA);
            PG8_WAIT_L(8); PG8_BAR; PG8_WAIT_L(0); PG8_MMA(0, 0, At, B0); PG8_BAR; PG8_SCHED;
            PG8_LDB(B1, 0, 1); PG8_STAGE(PG8_SB(0, 0), b2, voffB);
            PG8_BAR; PG8_WAIT_L(0); PG8_MMA(0, 1, At, B1); PG8_BAR;
            PG8_LDA(At, 0, 1); PG8_STAGE(PG8_SA(0, 0), a2, voffA);
            PG8_BAR; PG8_WAIT_L(0); PG8_MMA(1, 0, At, B0); PG8_BAR; PG8_SCHED;
            PG8_STAGE(PG8_SB(0, 1), b2 + hstep, voffB);
            PG8_WAIT_V(6); PG8_BAR; PG8_MMA(1, 1, At, B1); PG8_BAR;
            PG8_LDB(B0, 1, 0); PG8_SCHED; PG8_LDA(At, 1, 0); PG8_STAGE(PG8_SA(0, 1), a2 + hstep, voffA);
            PG8_WAIT_L(8); PG8_BAR; PG8_WAIT_L(0); PG8_MMA(0, 0, At, B0); PG8_BAR; PG8_SCHED;
            PG8_LDB(B1, 1, 1); PG8_STAGE(PG8_SB(1, 0), b3, voffB);
            PG8_BAR; PG8_WAIT_L(0); PG8_MMA(0, 1, At, B1); PG8_BAR;
            PG8_LDA(At, 1, 1); PG8_STAGE(PG8_SA(1, 0), a3, voffA);
            PG8_BAR; PG8_WAIT_L(0); PG8_MMA(1, 0, At, B0); PG8_BAR; PG8_SCHED;
            PG8_STAGE(PG8_SB(1, 1), b3 + hstep, voffB);
            PG8_WAIT_V(6); PG8_BAR; PG8_MMA(1, 1, At, B1); PG8_BAR;
            }
        }
        if constexpr (ALIGN_EPI) { if (wr == 0) PG8_BAR; }
        if constexpr (!Epi::AFTER_DRAIN) { E(acc, cur, wr, wc, fr, fq); S.done(cur); }
        if (!has_next) break;
#pragma unroll
        for (int a = 0; a < 2; ++a)
#pragma unroll
            for (int b = 0; b < 2; ++b)
#pragma unroll
                for (int m = 0; m < 4; ++m)
#pragma unroll
                    for (int n = 0; n < 2; ++n) acc[a][b][m][n] = (f32x4){0.f, 0.f, 0.f, 0.f};
        cur = nxt; cA = nA; cB = nB; ++ui;
        if constexpr (ALIGN_EPI) { if (wr == 1) PG8_BAR; }
    }
    PG8_WAIT_V(0);
    if constexpr (!ALIGN_EPI) { if (wr == 0) PG8_BAR; }
    PG8_BAR;
    if constexpr (Epi::AFTER_DRAIN) { E.fused(acc, cur, wr, wc, fr, fq, lds, wid, lane); S.done(cur); }
#undef PG8_SA
#undef PG8_SB
#undef PG8_STAGE
#undef PG8_LDA
#undef PG8_LDB
#undef PG8_MMA
#undef PG8_WAIT_V
#undef PG8_WAIT_L
#undef PG8_BAR
#undef PG8_SCHED
}


__device__ __forceinline__ float quad_sum(float v) {
    auto a = __builtin_amdgcn_permlane16_swap(__float_as_uint(v), __float_as_uint(v), false, false); v = __uint_as_float(a[0]) + __uint_as_float(a[1]);
    auto b = __builtin_amdgcn_permlane32_swap(__float_as_uint(v), __float_as_uint(v), false, false); return __uint_as_float(b[0]) + __uint_as_float(b[1]);
}
__device__ __forceinline__ float sq4(const f32x4& v) { return (v[0] * v[0] + v[1] * v[1]) + (v[2] * v[2] + v[3] * v[3]); }
__device__ __forceinline__ u32x4 pack8(const f32x4& a, const f32x4& b) { u32x4 o; o.x = cvt_pk_bf16(a[0], a[1]); o.y = cvt_pk_bf16(a[2], a[3]); o.z = cvt_pk_bf16(b[0], b[1]); o.w = cvt_pk_bf16(b[2], b[3]); return o; }
__device__ __forceinline__ void store_rows8(bf16_t* base, unsigned rowA, unsigned pitch, const u32x4& x0, const u32x4& x1) {
    u32x4 a, b;
#pragma unroll
    for (int c = 0; c < 4; ++c) { a[c] = (unsigned)__builtin_amdgcn_update_dpp((int)x0[c], (int)x1[c], 0x128, 0xF, 0xC, false); b[c] = (unsigned)__builtin_amdgcn_update_dpp((int)x1[c], (int)x0[c], 0x128, 0xF, 0x3, false); }
    *(u32x4*)(base + rowA * pitch) = a; *(u32x4*)(base + (rowA + 8u) * pitch) = b;
}
struct EpiQKV {
    static constexpr bool PERM = true, AFTER_DRAIN = false;
    bf16_t* Q; bf16_t* K; bf16_t* V; const float* cosD; const float* sinD; const float* gq; const float* gk; float qscale; float eps;
    __device__ __forceinline__ void operator()(const f32x4 (&acc)[2][2][4][2], const Unit& u, int wr, int wc, int fr, int fq) const {
        asm volatile("" : "+v"(fr), "+v"(fq));
        const int tile = u.pn; const unsigned row0 = (unsigned)(u.pm * BM + wr * 64 + fr);
        if (tile >= 8) {
            bf16_t* vb = V + (tile - 8) * 256 + wc * 64 + 32 * (fr >> 3) + fq * 8; const unsigned rowA0 = (unsigned)(u.pm * BM + wr * 64 + (fr & 7));
#pragma unroll
            for (int ai = 0; ai < 2; ++ai)
#pragma unroll
                for (int m = 0; m < 4; ++m) store_rows8(vb, rowA0 + ai * HALF + m * 16, 1024u, pack8(acc[ai][0][m][0], acc[ai][0][m][1]), pack8(acc[ai][1][m][0], acc[ai][1][m][1]));
        } else {
            const bool isk = tile >= 4; const int hm = (tile & 3) * 4 + wc; bf16_t* dst = (isk ? K : Q) + hm * 64 + 32 * (fr >> 3) + 8 * fq; const unsigned rowA0 = (unsigned)(u.pm * BM + wr * 64 + (fr & 7)); const float* g = isk ? gk : gq; const float sc = isk ? 1.0f : qscale;
            const f32x4 g0a = *(const f32x4*)(g + 8 * fq), g0b = *(const f32x4*)(g + 8 * fq + 4), g1a = *(const f32x4*)(g + 32 + 8 * fq), g1b = *(const f32x4*)(g + 36 + 8 * fq);
            const float* cb = cosD + 8 * fq; const float* sb = sinD + 8 * fq;
#pragma unroll
            for (int ai = 0; ai < 2; ++ai)
#pragma unroll
                for (int m = 0; m < 4; ++m) {
                    const unsigned row = row0 + ai * HALF + m * 16;
                    const f32x4 c0 = *(const f32x4*)(cb + row * 32u), c1 = *(const f32x4*)(cb + row * 32u + 4), s0 = *(const f32x4*)(sb + row * 32u), s1 = *(const f32x4*)(sb + row * 32u + 4);
                    const f32x4 a0 = acc[ai][0][m][0], a1 = acc[ai][0][m][1], b0 = acc[ai][1][m][0], b1 = acc[ai][1][m][1];
                    const float ss = quad_sum((sq4(a0) + sq4(a1)) + (sq4(b0) + sq4(b1)));
                    const float rs = __builtin_amdgcn_rsqf(ss * (1.0f / 64.0f) + eps) * sc;
                    const f32x4 x1a = a0 * (g0a * rs), x1b = a1 * (g0b * rs), x2a = b0 * (g1a * rs), x2b = b1 * (g1b * rs);
                    store_rows8(dst, rowA0 + ai * HALF + m * 16, 1024u, pack8(x1a * c0 - x2a * s0, x1b * c1 - x2b * s1), pack8(x2a * c0 + x1a * s0, x2b * c1 + x1b * s1));
                }
        }
    }
};
template <bool XF32>
struct EpiResid {
    static constexpr bool PERM = true, AFTER_DRAIN = false;
    const void* xin; bf16_t* xout; const float* gate; float* ssq;
    __device__ __forceinline__ void operator()(const f32x4 (&acc)[2][2][4][2], const Unit& u, int wr, int wc, int fr, int fq) const {
        asm volatile("" : "+v"(fr), "+v"(fq));
        const int b = (u.pm * BM) >> 11; const unsigned colb = (unsigned)(u.pn * BM + wc * 64 + 8 * fq); const unsigned row0 = (unsigned)(u.pm * BM + wr * 64 + fr);
        const float* gp = gate + (size_t)b * 6144 + colb;
        f32x4 g[2][2];
#pragma unroll
        for (int bj = 0; bj < 2; ++bj)
#pragma unroll
            for (int n = 0; n < 2; ++n) g[bj][n] = *(const f32x4*)(gp + bj * 32 + n * 4);
        bf16_t* xo = xout + u.pn * BM + wc * 64 + 32 * (fr >> 3) + 8 * fq; float* sq = ssq + u.pn * 4 + wc; const unsigned rowA0 = (unsigned)(u.pm * BM + wr * 64 + (fr & 7));
#pragma unroll
        for (int ai = 0; ai < 2; ++ai) {
            f32x4 xq[4][2][2];
#pragma unroll
            for (int m = 0; m < 4; ++m) { const unsigned off_ = (row0 + ai * HALF + m * 16) * 1024u + colb;
#pragma unroll
                for (int bj = 0; bj < 2; ++bj) {
                    if (XF32) { xq[m][bj][0] = *(const f32x4*)((const float*)xin + off_ + bj * 32); xq[m][bj][1] = *(const f32x4*)((const float*)xin + off_ + bj * 32 + 4); }
                    else { const u32x4 w = *(const u32x4*)((const bf16_t*)xin + off_ + bj * 32);
                        xq[m][bj][0] = (f32x4){__uint_as_float(w.x << 16), __uint_as_float(w.x & 0xffff0000u), __uint_as_float(w.y << 16), __uint_as_float(w.y & 0xffff0000u)};
                        xq[m][bj][1] = (f32x4){__uint_as_float(w.z << 16), __uint_as_float(w.z & 0xffff0000u), __uint_as_float(w.w << 16), __uint_as_float(w.w & 0xffff0000u)}; } } }
#pragma unroll
            for (int m = 0; m < 4; ++m) {
                const unsigned row = row0 + ai * HALF + m * 16; float ss = 0.f; u32x4 pk[2];
#pragma unroll
                for (int bj = 0; bj < 2; ++bj) { const f32x4 v0 = xq[m][bj][0] + g[bj][0] * acc[ai][bj][m][0], v1 = xq[m][bj][1] + g[bj][1] * acc[ai][bj][m][1];
                    pk[bj] = pack8(v0, v1); ss += sq4(v0) + sq4(v1); }
                store_rows8(xo, rowA0 + ai * HALF + m * 16, 1024u, pk[0], pk[1]);
                ss = quad_sum(ss);
                if (fq == 0) sq[row * 16u] = ss;
            }
        }
    }
};
struct EpiWin {
    static constexpr bool PERM = true, AFTER_DRAIN = false;
    bf16_t* CQ; bf16_t* CKV; bf16_t* KPE; float* ssq; const float* cosM; const float* sinM; const float* gkpe; float eps;
    __device__ __forceinline__ void operator()(const f32x4 (&acc)[2][2][4][2], const Unit& u, int wr, int wc, int fr, int fq) const {
        asm volatile("" : "+v"(fr), "+v"(fq));
        const int ws = u.pn * 4 + wc; const unsigned row0 = (unsigned)(u.pm * BM + wr * 64 + fr);
        if (ws < 10) {
            bf16_t* dst = ((ws < 6) ? CQ + 64 * ws : CKV + 64 * (ws - 6)) + 32 * (fr >> 3) + 8 * fq; const unsigned ld = (ws < 6) ? 384u : 256u; float* sq = ssq + ws; const unsigned rowA0 = (unsigned)(u.pm * BM + wr * 64 + (fr & 7));
#pragma unroll
            for (int ai = 0; ai < 2; ++ai)
#pragma unroll
                for (int m = 0; m < 4; ++m) {
                    const unsigned row = row0 + ai * HALF + m * 16;
                    const f32x4 a0 = acc[ai][0][m][0], a1 = acc[ai][0][m][1], b0 = acc[ai][1][m][0], b1 = acc[ai][1][m][1];
                    store_rows8(dst, rowA0 + ai * HALF + m * 16, ld, pack8(a0, a1), pack8(b0, b1));
                    const float ss = quad_sum((sq4(a0) + sq4(a1)) + (sq4(b0) + sq4(b1)));
                    if (fq == 0) sq[row * 16u] = ss;
                }
        } else if (ws == 10) {
            const f32x4 g0 = *(const f32x4*)(gkpe + 4 * fq), g1 = *(const f32x4*)(gkpe + 16 + 4 * fq);
#pragma unroll
            for (int ai = 0; ai < 2; ++ai)
#pragma unroll
                for (int m = 0; m < 4; ++m) {
                    const unsigned row = row0 + ai * HALF + m * 16;
                    const f32x4 c = *(const f32x4*)(cosM + row * 16u + 4 * fq), sn = *(const f32x4*)(sinM + row * 16u + 4 * fq);
                    const f32x4 y0 = acc[ai][0][m][0], y1 = acc[ai][0][m][1];
                    const float rs = __builtin_amdgcn_rsqf(quad_sum(sq4(y0) + sq4(y1)) * (1.0f / 32.0f) + eps);
                    const f32x4 x1 = y0 * (g0 * rs), x2 = y1 * (g1 * rs);
                    *(u32x4*)(KPE + row * 32u + 8 * fq) = pack8(x1 * c - x2 * sn, x2 * c + x1 * sn);
                }
        }
    }
};
struct EpiUQ {
    static constexpr bool PERM = true, AFTER_DRAIN = false;
    bf16_t* Q2; const float* ssq; const float* cosM; const float* sinM; const float* gqn; const float* gqp; float qscale; float eps;
    __device__ __forceinline__ void operator()(const f32x4 (&acc)[2][2][4][2], const Unit& u, int wr, int wc, int fr, int fq) const {
        asm volatile("" : "+v"(fr), "+v"(fq));
        const int tile = u.pn; const unsigned row0 = (unsigned)(u.pm * BM + wr * 64 + fr);
        if (tile < 4) {
            bf16_t* dst = Q2 + (tile * 4 + wc) * 64 + 32 * (fr >> 3) + 8 * fq; const unsigned rowA0 = (unsigned)(u.pm * BM + wr * 64 + (fr & 7));
            const f32x4 g0a = *(const f32x4*)(gqn + 8 * fq) * qscale, g0b = *(const f32x4*)(gqn + 8 * fq + 4) * qscale, g1a = *(const f32x4*)(gqn + 32 + 8 * fq) * qscale, g1b = *(const f32x4*)(gqn + 36 + 8 * fq) * qscale;
#pragma unroll
            for (int ai = 0; ai < 2; ++ai) {
                f32x4 sA[4], sB[4];
#pragma unroll
                for (int m = 0; m < 4; ++m) { const unsigned row = row0 + ai * HALF + m * 16; sA[m] = *(const f32x4*)(ssq + row * 16u); sB[m] = *(const f32x4*)(ssq + row * 16u + 4); }
#pragma unroll
                for (int m = 0; m < 4; ++m) {
                    const unsigned row = row0 + ai * HALF + m * 16;
                    const f32x4 a0 = acc[ai][0][m][0], a1 = acc[ai][0][m][1], b0 = acc[ai][1][m][0], b1 = acc[ai][1][m][1];
                    const float ss = quad_sum((sq4(a0) + sq4(a1)) + (sq4(b0) + sq4(b1)));
                    const float em = eps * ((((sA[m][0] + sA[m][1]) + (sA[m][2] + sA[m][3])) + (sB[m][0] + sB[m][1])) * (1.0f / 384.0f) + eps);
                    const float rn = __builtin_amdgcn_rsqf(ss * (1.0f / 64.0f) + em);
                    store_rows8(dst, rowA0 + ai * HALF + m * 16, 1536u, pack8(a0 * (g0a * rn), a1 * (g0b * rn)), pack8(b0 * (g1a * rn), b1 * (g1b * rn)));
                }
            }
        } else {
            const f32x4 g0 = *(const f32x4*)(gqp + 4 * fq) * qscale, g1 = *(const f32x4*)(gqp + 16 + 4 * fq) * qscale;
            bf16_t* dst = Q2 + 1024 + ((tile - 4) * 4 + wc) * 64 + 32 * (fr >> 3) + 8 * fq; const unsigned rowA0 = (unsigned)(u.pm * BM + wr * 64 + (fr & 7));
#pragma unroll
            for (int ai = 0; ai < 2; ++ai) {
                f32x4 sA[4], sB[4], cc[4], sn[4];
#pragma unroll
                for (int m = 0; m < 4; ++m) { const unsigned row = row0 + ai * HALF + m * 16; sA[m] = *(const f32x4*)(ssq + row * 16u); sB[m] = *(const f32x4*)(ssq + row * 16u + 4);
                    cc[m] = *(const f32x4*)(cosM + row * 16u + 4 * fq); sn[m] = *(const f32x4*)(sinM + row * 16u + 4 * fq); }
#pragma unroll
                for (int m = 0; m < 4; ++m) {
                    const unsigned row = row0 + ai * HALF + m * 16;
                    const float em = eps * ((((sA[m][0] + sA[m][1]) + (sA[m][2] + sA[m][3])) + (sB[m][0] + sB[m][1])) * (1.0f / 384.0f) + eps);
                    u32x4 pk[2];
#pragma unroll
                    for (int bj = 0; bj < 2; ++bj) {
                        const f32x4 y0 = acc[ai][bj][m][0], y1 = acc[ai][bj][m][1];
                        const float rn = __builtin_amdgcn_rsqf(quad_sum(sq4(y0) + sq4(y1)) * (1.0f / 32.0f) + em);
                        const f32x4 x1 = y0 * (g0 * rn), x2 = y1 * (g1 * rn);
                        pk[bj] = pack8(x1 * cc[m] - x2 * sn[m], x2 * cc[m] + x1 * sn[m]);
                    }
                    store_rows8(dst, rowA0 + ai * HALF + m * 16, 1536u, pk[0], pk[1]);
                }
            }
        }
    }
};
struct EpiUKV {
    static constexpr bool PERM = true, AFTER_DRAIN = false;
    bf16_t* KV2; const float* ssq; const float* gkn; float eps;
    __device__ __forceinline__ void operator()(const f32x4 (&acc)[2][2][4][2], const Unit& u, int wr, int wc, int fr, int fq) const {
        asm volatile("" : "+v"(fr), "+v"(fq));
        const int tile = u.pn, head = (tile & 3) * 4 + wc; const unsigned row0 = (unsigned)(u.pm * BM + wr * 64 + fr), rowA0 = (unsigned)(u.pm * BM + wr * 64 + (fr & 7)); const int hcol = 32 * (fr >> 3) + 8 * fq;
        f32x4 sB[2][4], sC[2][4];
#pragma unroll
        for (int ai = 0; ai < 2; ++ai)
#pragma unroll
            for (int m = 0; m < 4; ++m) { const unsigned row = row0 + ai * HALF + m * 16; sB[ai][m] = *(const f32x4*)(ssq + row * 16u + 4); sC[ai][m] = *(const f32x4*)(ssq + row * 16u + 8); }
        if (tile < 4) {
            bf16_t* dst = KV2 + head * 128 + hcol;
            const f32x4 g0a = *(const f32x4*)(gkn + 8 * fq), g0b = *(const f32x4*)(gkn + 8 * fq + 4), g1a = *(const f32x4*)(gkn + 32 + 8 * fq), g1b = *(const f32x4*)(gkn + 36 + 8 * fq);
#pragma unroll
            for (int ai = 0; ai < 2; ++ai)
#pragma unroll
                for (int m = 0; m < 4; ++m) {
                    const unsigned row = row0 + ai * HALF + m * 16;
                    const f32x4 a0 = acc[ai][0][m][0], a1 = acc[ai][0][m][1], b0 = acc[ai][1][m][0], b1 = acc[ai][1][m][1];
                    const float ss = quad_sum((sq4(a0) + sq4(a1)) + (sq4(b0) + sq4(b1)));
                    const float msq = ((sB[ai][m][2] + sB[ai][m][3]) + (sC[ai][m][0] + sC[ai][m][1])) * (1.0f / 256.0f) + eps;
                    const float rn = __builtin_amdgcn_rsqf(ss * (1.0f / 64.0f) + eps * msq);
                    store_rows8(dst, rowA0 + ai * HALF + m * 16, 2048u, pack8(a0 * (g0a * rn), a1 * (g0b * rn)), pack8(b0 * (g1a * rn), b1 * (g1b * rn)));
                }
        } else {
            bf16_t* dst = KV2 + head * 128 + 64 + hcol;
#pragma unroll
            for (int ai = 0; ai < 2; ++ai)
#pragma unroll
                for (int m = 0; m < 4; ++m) {
                    const unsigned row = row0 + ai * HALF + m * 16;
                    const float rsq = __builtin_amdgcn_rsqf(((sB[ai][m][2] + sB[ai][m][3]) + (sC[ai][m][0] + sC[ai][m][1])) * (1.0f / 256.0f) + eps);
                    store_rows8(dst, rowA0 + ai * HALF + m * 16, 2048u, pack8(acc[ai][0][m][0] * rsq, acc[ai][0][m][1] * rsq), pack8(acc[ai][1][m][0] * rsq, acc[ai][1][m][1] * rsq));
                }
        }
    }
};

struct MUnit { int pm, pn, e, r0; };
struct MoeOrder {
    typedef MUnit UnitT;
    const int* tpre; int ncol, G, c, total;
    __device__ __forceinline__ bool next(int i, MUnit& u) const {
        const int L = i * G + c; if (L >= total) return false;
        const int rt = L / ncol, ct = L - rt * ncol; const int e = tpre[33 + rt];
        u.e = e; u.pm = rt; u.r0 = (rt - tpre[e]) * 256; u.pn = e * ncol + ct; return true;
    }
    __device__ __forceinline__ void a_ready(const MUnit&) const {}
    __device__ __forceinline__ void done(const MUnit&) const {}
};
__device__ __forceinline__ float silu_f(float a) { return a * __builtin_amdgcn_rcpf(1.0f + __builtin_amdgcn_exp2f(-1.4426950408889634f * a)); }
struct EpiMoe1 {
    static constexpr bool PERM = true, AFTER_DRAIN = false;
    bf16_t* hid; const int* glist; const float* tokw; const int* cntl; int ntok;
    __device__ __forceinline__ void operator()(const f32x4 (&acc)[2][2][4][2], const MUnit& u, int wr, int wc, int fr, int fq) const {
        const int cnt = cntl[u.e], t = u.pn & 1;
        asm volatile("" : "+v"(fr), "+v"(fq));
        float wrow[2][4];
#pragma unroll
        for (int ai = 0; ai < 2; ++ai)
#pragma unroll
            for (int m = 0; m < 4; ++m) { const int r = u.r0 + ai * HALF + wr * 64 + m * 16 + fr; const float w_ = tokw[(unsigned)(u.e * ntok + (r < cnt ? r : 0))]; wrow[ai][m] = (r < cnt) ? w_ : 0.f; }
#pragma unroll
        for (int ai = 0; ai < 2; ++ai)
#pragma unroll
            for (int m = 0; m < 4; ++m) {
                const int rl = ai * HALF + wr * 64 + m * 16 + fr; const float w = wrow[ai][m];
                const f32x4 a0 = acc[ai][0][m][0], a1 = acc[ai][0][m][1], b0 = acc[ai][1][m][0], b1 = acc[ai][1][m][1];
                u32x4 o;
                o.x = cvt_pk_bf16(silu_f(a0[0]) * b0[0] * w, silu_f(a0[1]) * b0[1] * w); o.y = cvt_pk_bf16(silu_f(a0[2]) * b0[2] * w, silu_f(a0[3]) * b0[3] * w);
                o.z = cvt_pk_bf16(silu_f(a1[0]) * b1[0] * w, silu_f(a1[1]) * b1[1] * w); o.w = cvt_pk_bf16(silu_f(a1[2]) * b1[2] * w, silu_f(a1[3]) * b1[3] * w);
                *(u32x4*)(hid + ((size_t)u.pm * BM + rl) * 256 + t * 128 + wc * 32 + fq * 8) = o;
                asm volatile("" ::: "memory");
            }
    }
};
struct EpiMoe2 {
    static constexpr bool PERM = true, AFTER_DRAIN = false;
    unsigned char* y2; const int* glist; const int* cntl; int ntok;
    __device__ __forceinline__ void operator()(const f32x4 (&acc)[2][2][4][2], const MUnit& u, int wr, int wc, int fr, int fq) const {
        const int cnt = cntl[u.e], ct = u.pn & 3;
        asm volatile("" : "+v"(fr), "+v"(fq));
        int ents[2][4];
#pragma unroll
        for (int ai = 0; ai < 2; ++ai)
#pragma unroll
            for (int m = 0; m < 4; ++m) { const int r = u.r0 + ai * HALF + wr * 64 + m * 16 + fr; const int e_ = glist[(unsigned)(u.e * ntok + (r < cnt ? r : 0))]; ents[ai][m] = (r < cnt) ? e_ : 2 * ntok; }
#pragma unroll
        for (int ai = 0; ai < 2; ++ai)
#pragma unroll
            for (int m = 0; m < 4; ++m) {
                unsigned char* rowp = y2 + (size_t)(unsigned)ents[ai][m] * 1024 + ct * 256 + wc * 64 + fq * 16;
                unsigned q[2][2];
#pragma unroll
                for (int bj = 0; bj < 2; ++bj) { const f32x4 v0 = acc[ai][bj][m][0] * 32.0f, v1 = acc[ai][bj][m][1] * 32.0f;
                    int p = __builtin_amdgcn_cvt_pk_fp8_f32(v0[0], v0[1], 0, false); p = __builtin_amdgcn_cvt_pk_fp8_f32(v0[2], v0[3], p, true); q[bj][0] = (unsigned)p;
                    p = __builtin_amdgcn_cvt_pk_fp8_f32(v1[0], v1[1], 0, false); p = __builtin_amdgcn_cvt_pk_fp8_f32(v1[2], v1[3], p, true); q[bj][1] = (unsigned)p; }
#pragma unroll
                for (int d = 0; d < 2; ++d) { auto s1 = __builtin_amdgcn_permlane32_swap(q[0][d], q[1][d], false, false); auto s2 = __builtin_amdgcn_permlane16_swap(s1[0], s1[1], false, false); q[0][d] = s2[0]; q[1][d] = s2[1]; }
                *(u32x4*)rowp = (u32x4){q[0][0], q[0][1], q[1][0], q[1][1]};
                asm volatile("" ::: "memory");
            }
    }
};
template <class Epi, class Sched, bool FP8 = false>
__device__ __forceinline__ void gemm_phase_gather(PG8_LAS unsigned char* lds, const bf16_t* A, const bf16_t* Bt, int K, const int* glist, int ntok, const int* cntl, const Sched& S, const Epi& E) {
    int tid_ = threadIdx.x; asm volatile("" : "+v"(tid_));
    const int tid = tid_, wid = __builtin_amdgcn_readfirstlane(tid >> 6), lane = tid & 63, wr = wid >> 2, wc = wid & 3, fr = lane & 15, fq = lane >> 4;
    const int rowb = FP8 ? K : 2 * K, nt = FP8 ? K / (2 * BK) : K / BK;
    unsigned voffB[2];
#pragma unroll
    for (int i = 0; i < 2; ++i) { int R, C; stage_rc(tid * 16 + i * 8192, R, C); const int Rb = Epi::PERM ? ((R & ~31) + perm32(R & 31)) : R;
        voffB[i] = (unsigned)(Rb * rowb + C * 2); }
    const size_t kstep = (size_t)(BK * 2);
    const size_t hstep = (size_t)HALF * rowb;
    const size_t tstep = 2 * hstep;
    const unsigned ldsw = (unsigned)wid * 1024u;
    const int aoff = lds_byte(wr * 64 + fr, fq * 8), boff = lds_byte(wc * 32 + fr, fq * 8);
#define PG8_SA(b, h) (((b) * 2 + (h)) * HTB)
#define PG8_SB(b, h) ((4 + (b) * 2 + (h)) * HTB)
#define PG8_STAGE(bufoff, gbase, voff) do { _Pragma("unroll") for (int _i = 0; _i < 2; ++_i) \
        __builtin_amdgcn_global_load_lds((const unsigned*)((const char*)(gbase) + (voff)[_i]), (PG8_LAS unsigned*)(lds + (bufoff) + ldsw + _i * 8192), 16, 0, 0); } while (0)
    typedef int i32x4_ __attribute__((ext_vector_type(4))); typedef int i32x8_ __attribute__((ext_vector_type(8)));
#define PG8_LDA(dst, b, h) do { _Pragma("unroll") for (int m = 0; m < 4; ++m) { if constexpr (FP8) { const i32x4_ l0_ = *(const PG8_LAS i32x4_*)(lds + PG8_SA(b, h) + aoff + m * 2048), l1_ = *(const PG8_LAS i32x4_*)(lds + PG8_SA(b, h) + aoff + m * 2048 + 1024); \
            dst##8[m] = __builtin_shufflevector(l0_, l1_, 0, 1, 2, 3, 4, 5, 6, 7); } else { _Pragma("unroll") for (int k = 0; k < 2; ++k) dst[m][k] = *(const PG8_LAS bf16x8*)(lds + PG8_SA(b, h) + aoff + m * 2048 + k * 1024); } } } while (0)
#define PG8_LDB(dst, b, h) do { _Pragma("unroll") for (int n = 0; n < 2; ++n) { if constexpr (FP8) { const i32x4_ l0_ = *(const PG8_LAS i32x4_*)(lds + PG8_SB(b, h) + boff + n * 2048), l1_ = *(const PG8_LAS i32x4_*)(lds + PG8_SB(b, h) + boff + n * 2048 + 1024); \
            dst##8[n] = __builtin_shufflevector(l0_, l1_, 0, 1, 2, 3, 4, 5, 6, 7); } else { _Pragma("unroll") for (int k = 0; k < 2; ++k) dst[n][k] = *(const PG8_LAS bf16x8*)(lds + PG8_SB(b, h) + boff + n * 2048 + k * 1024); } } } while (0)
#define PG8_MMA(ai, bj, At, Bt) do { __builtin_amdgcn_s_setprio(1); _Pragma("unroll") for (int m = 0; m < 4; ++m) _Pragma("unroll") for (int n = 0; n < 2; ++n) { \
        if constexpr (FP8) acc[ai][bj][m][n] = __builtin_amdgcn_mfma_scale_f32_16x16x128_f8f6f4(Bt##8[n], At##8[m], acc[ai][bj][m][n], 0, 0, 0, 0x7a7a7a7a, 0, 0x7f7f7f7f); \
        else { _Pragma("unroll") for (int k = 0; k < 2; ++k) acc[ai][bj][m][n] = __builtin_amdgcn_mfma_f32_16x16x32_bf16(Bt[n][k], At[m][k], acc[ai][bj][m][n], 0, 0, 0); } } \
        __builtin_amdgcn_s_setprio(0); } while (0)
#define PG8_WAIT_V(n) asm volatile("s_waitcnt vmcnt(" #n ")" ::: "memory")
#define PG8_WAIT_L(n) asm volatile("s_waitcnt lgkmcnt(" #n ")" ::: "memory")
#define PG8_BAR __builtin_amdgcn_s_barrier()
#define PG8_SCHED __builtin_amdgcn_sched_barrier(0)
#define PG8_GOFF(u, off) do { const int _cnt = cntl[(u).e]; _Pragma("unroll") for (int _h = 0; _h < 2; ++_h) _Pragma("unroll") for (int _i = 0; _i < 2; ++_i) { \
        int _R, _C; stage_rc(tid * 16 + _i * 8192, _R, _C); const int _r = (u).r0 + _h * HALF + _R; const int _ent = glist[(unsigned)((u).e * ntok + (_r < _cnt ? _r : 0))]; \
        off[_h][_i] = (unsigned)(_ent >> 1) * (unsigned)rowb + (unsigned)(_C * 2); } } while (0)
    typename Sched::UnitT cur, nxt; int ui = 0;
    if (!S.next(0, cur)) return;
    f32x4 acc[2][2][4][2];
#pragma unroll
    for (int a = 0; a < 2; ++a)
#pragma unroll
        for (int b = 0; b < 2; ++b)
#pragma unroll
            for (int m = 0; m < 4; ++m)
#pragma unroll
                for (int n = 0; n < 2; ++n) acc[a][b][m][n] = (f32x4){0.f, 0.f, 0.f, 0.f};
    bf16x8 At[4][2], B0[2][2], B1[2][2]; i32x8_ At8[4], B08[2], B18[2];
    unsigned coff[2][2], noff[2][2];
    PG8_GOFF(cur, coff);
    const char* cA = (const char*)A; const char* cB = (const char*)Bt + (size_t)cur.pn * tstep;
    PG8_STAGE(PG8_SB(0, 0), cB, voffB); PG8_STAGE(PG8_SB(0, 1), cB + hstep, voffB); PG8_STAGE(PG8_SA(0, 0), cA, coff[0]); PG8_STAGE(PG8_SA(0, 1), cA, coff[1]);
    if (wr == 1) PG8_BAR;
    PG8_WAIT_V(2); PG8_BAR;
    PG8_STAGE(PG8_SB(1, 0), cB + kstep, voffB); PG8_STAGE(PG8_SA(1, 0), cA + kstep, coff[0]); PG8_STAGE(PG8_SB(1, 1), cB + hstep + kstep, voffB);
    PG8_WAIT_V(6); PG8_BAR;
    for (;;) {
        const bool has_next = S.next(ui + 1, nxt);
        if (has_next) { PG8_GOFF(nxt, noff); } else {
#pragma unroll
            for (int h = 0; h < 2; ++h)
#pragma unroll
                for (int i = 0; i < 2; ++i) noff[h][i] = coff[h][i]; }
        const char* nB = has_next ? (const char*)Bt + (size_t)nxt.pn * tstep : cB;
        for (int t = 0; t < nt; t += 2) {
            const bool last = (t == nt - 2);
            const char* a1 = cA + (size_t)(t + 1) * kstep;
            const char* a2 = last ? cA : cA + (size_t)(t + 2) * kstep; const char* b2 = last ? nB : cB + (size_t)(t + 2) * kstep;
            const char* a3 = a2 + kstep; const char* b3 = b2 + kstep;
            PG8_LDB(B0, 0, 0); PG8_LDB(B1, 0, 1); PG8_SCHED; PG8_LDA(At, 0, 0); PG8_STAGE(PG8_SA(1, 1), a1, coff[1]);
            if (last) {
#pragma unroll
                for (int h = 0; h < 2; ++h)
#pragma unroll
                    for (int i = 0; i < 2; ++i) coff[h][i] = noff[h][i]; }
            PG8_WAIT_V(8); PG8_WAIT_L(0); PG8_BAR; PG8_MMA(0, 0, At, B0); PG8_MMA(0, 1, At, B1); PG8_BAR; PG8_SCHED;
            PG8_LDA(At, 0, 1); PG8_STAGE(PG8_SB(0, 0), b2, voffB); PG8_STAGE(PG8_SB(0, 1), b2 + hstep, voffB); PG8_STAGE(PG8_SA(0, 0), a2, coff[0]);
            PG8_WAIT_V(8); PG8_WAIT_L(0); PG8_BAR; PG8_MMA(1, 0, At, B0); PG8_MMA(1, 1, At, B1); PG8_BAR; PG8_SCHED;
            PG8_LDB(B0, 1, 0); PG8_LDB(B1, 1, 1); PG8_SCHED; PG8_LDA(At, 1, 0); PG8_STAGE(PG8_SA(0, 1), a2, coff[1]);
            PG8_WAIT_V(8); PG8_WAIT_L(0); PG8_BAR; PG8_MMA(0, 0, At, B0); PG8_MMA(0, 1, At, B1); PG8_BAR; PG8_SCHED;
            PG8_LDA(At, 1, 1); PG8_STAGE(PG8_SB(1, 0), b3, voffB); PG8_STAGE(PG8_SB(1, 1), b3 + hstep, voffB); PG8_STAGE(PG8_SA(1, 0), a3, coff[0]);
            PG8_WAIT_V(8); PG8_WAIT_L(0); PG8_BAR; PG8_MMA(1, 0, At, B0); PG8_MMA(1, 1, At, B1); PG8_BAR; PG8_SCHED;
        }
        if (wr == 0) PG8_BAR;
        E(acc, cur, wr, wc, fr, fq);
        if (!has_next) break;
#pragma unroll
        for (int a = 0; a < 2; ++a)
#pragma unroll
            for (int b = 0; b < 2; ++b)
#pragma unroll
                for (int m = 0; m < 4; ++m)
#pragma unroll
                    for (int n = 0; n < 2; ++n) acc[a][b][m][n] = (f32x4){0.f, 0.f, 0.f, 0.f};
        cur = nxt; cB = nB; ++ui;
        if (wr == 1) PG8_BAR;
    }
    PG8_WAIT_V(0);
    PG8_BAR;
#undef PG8_SA
#undef PG8_SB
#undef PG8_STAGE
#undef PG8_LDA
#undef PG8_LDB
#undef PG8_MMA
#undef PG8_WAIT_V
#undef PG8_WAIT_L
#undef PG8_BAR
#undef PG8_SCHED
#undef PG8_GOFF
}
}

#define PG8_SP2 true
#define PG8_ALIGN true

struct Args { const float* in[33]; float* out; unsigned char* ws; int ph_lo, ph_hi; };
enum { I_X = 0, I_C, I_POS, I_ADAW, I_ADAB, I_NMIX, I_NFFN, I_DA_WQKV, I_DA_QN, I_DA_KN, I_DA_LQ1, I_DA_LK1, I_DA_LQ2, I_DA_LK2,
       I_DA_SUBLN, I_DA_WO, I_M_WIN, I_M_QAN, I_M_KVAN, I_M_WUQ, I_M_WUKV, I_M_QNN, I_M_QPN, I_M_KNN, I_M_KPN, I_M_WO,
       I_E_WG, I_E_BG, I_E_WR, I_E_BR, I_E_W1, I_E_W3, I_E_W2 };

struct Ctx {
    const float* const* in; float* out; unsigned char* ws; unsigned char* lds;
    int tid, lane, wave, gw, ngw;
    __device__ __forceinline__ const float* mod(int layer, int b, int chunk) const { return (const float*)(ws + WS_MOD) + ((size_t)(layer * NB + b) * 6144 + chunk * 1024); }
};

__device__ __forceinline__ void normmod_row(const f32x4 (&v)[4], f32x4 (&h)[4], const float* g, const float* sh, const float* sc, int lane) {
    float s = 0.f;
#pragma unroll
    for (int j = 0; j < 4; ++j) s += (v[j].x * v[j].x + v[j].y * v[j].y) + (v[j].z * v[j].z + v[j].w * v[j].w);
    const float rstd = 1.0f / sqrtf(wave_sum(s) * (1.0f / D) + EPS);
#pragma unroll
    for (int j = 0; j < 4; ++j) {
        const f32x4 gg = *(const f32x4*)(g + 4 * lane + 256 * j), ss = *(const f32x4*)(sh + 4 * lane + 256 * j), cc = *(const f32x4*)(sc + 4 * lane + 256 * j);
        h[j] = (v[j] * rstd) * gg * (cc + 1.0f) + ss;
    }
}
__device__ __forceinline__ void store_row_bf16(bf16* row, const f32x4 (&h)[4], int lane) {
#pragma unroll
    for (int j = 0; j < 4; ++j) { u32x2 o; o.x = pk2(h[j].x, h[j].y); o.y = pk2(h[j].z, h[j].w); *(u32x2*)(row + 4 * lane + 256 * j) = o; }
}
__device__ __forceinline__ void load_row_fp8(const unsigned char* row, f32x4 (&h)[4], int lane) {
#pragma unroll
    for (int j = 0; j < 4; ++j) { const int w = *(const int*)(row + 4 * lane + 256 * j); const auto lo = __builtin_amdgcn_cvt_pk_f32_fp8(w, false), hi = __builtin_amdgcn_cvt_pk_f32_fp8(w, true);
        h[j] = (f32x4){lo[0], lo[1], hi[0], hi[1]} * 0.03125f; }
}
__device__ __forceinline__ void load_row_bf16(const bf16* row, f32x4 (&h)[4], int lane) {
#pragma unroll
    for (int j = 0; j < 4; ++j) { const u32x2 o = *(const u32x2*)(row + 4 * lane + 256 * j);
        h[j] = (f32x4){bf2f(o.x & 0xffffu), bf2f(o.x >> 16), bf2f(o.y & 0xffffu), bf2f(o.y >> 16)}; }
}


struct TItem { const float* src; bf16* dst; const float* kg; int ldw, K, perm, f8; };
__device__ __forceinline__ void titem_load(const TItem& t, f32x4 (&v)[8], int lane) {
    const float* p = t.src + (size_t)(lane >> 3) * t.ldw + 4 * (lane & 7);
#pragma unroll
    for (int i = 0; i < 8; ++i) v[i] = *(const f32x4*)(p + (size_t)(8 * i) * t.ldw);
}
__device__ __forceinline__ void titem_finish(const TItem& t, const f32x4 (&v)[8], float* scr, int lane) {
    const int rr = lane >> 3, c4 = lane & 7;
#pragma unroll
    for (int i = 0; i < 8; ++i) { f32x4 x = v[i]; if (t.kg) x = x * t.kg[8 * i + rr]; float* d = scr + (8 * i + rr) * 33 + 4 * c4; d[0] = x[0]; d[1] = x[1]; d[2] = x[2]; d[3] = x[3]; }
    asm volatile("s_waitcnt lgkmcnt(0)" ::: "memory");
    const int c = lane & 7;
#pragma unroll
    for (int j = 0; j < 4; ++j) { const int n = (lane >> 3) + 8 * j; const int nl = t.perm ? (16 * ((n >> 2) & 1) + 4 * (n >> 3) + (n & 3)) : n;
        const float* sp = scr + (8 * c) * 33 + nl;
        if (t.f8) { int p0 = __builtin_amdgcn_cvt_pk_fp8_f32(sp[0 * 33] * 32.0f, sp[1 * 33] * 32.0f, 0, false); p0 = __builtin_amdgcn_cvt_pk_fp8_f32(sp[2 * 33] * 32.0f, sp[3 * 33] * 32.0f, p0, true);
            int p1 = __builtin_amdgcn_cvt_pk_fp8_f32(sp[4 * 33] * 32.0f, sp[5 * 33] * 32.0f, 0, false); p1 = __builtin_amdgcn_cvt_pk_fp8_f32(sp[6 * 33] * 32.0f, sp[7 * 33] * 32.0f, p1, true);
            u32x2 o; o.x = (unsigned)p0; o.y = (unsigned)p1; *(u32x2*)((unsigned char*)t.dst + (size_t)n * t.K + 8 * c) = o; }
        else { u32x4 o; o.x = pk2(sp[0 * 33], sp[1 * 33]); o.y = pk2(sp[2 * 33], sp[3 * 33]); o.z = pk2(sp[4 * 33], sp[5 * 33]); o.w = pk2(sp[6 * 33], sp[7 * 33]);
            *(u32x4*)(t.dst + (size_t)n * t.K + 8 * c) = o; } }
    asm volatile("s_waitcnt lgkmcnt(0)" ::: "memory");
}
__device__ __forceinline__ TItem titem_make(const float* W, int ldw, int K, bf16* WT, int k0, int n0, int prow0, const float* kgain, bool perm) {
    TItem t; t.src = W + (size_t)k0 * ldw + n0; t.dst = WT + (size_t)prow0 * K + k0; t.kg = kgain ? kgain + k0 : nullptr; t.ldw = ldw; t.K = K; t.perm = perm ? 1 : 0; t.f8 = 0; return t;
}
constexpr int TI_QKV = 16 * 96, TI_O = 16 * 32, TI_WIN = 16 * 21, TI_UQ = 6 * 48, TI_UKV = 4 * 64, TI_DENSE = TI_QKV + 2 * TI_O + TI_WIN + TI_UQ + TI_UKV, TI_ALL = TI_DENSE + 24576;
__device__ __forceinline__ TItem titem_decode(const Ctx& C, int it) {
    int r = it;
    if (r < TI_QKV) { const int kb = r / 96, lb = r % 96; int pb = lb;
        if (lb < 64) { const int sect = lb >> 5, hm = (lb & 31) >> 1, half = lb & 1; pb = (sect * 4 + (hm >> 2)) * 8 + half * 4 + (hm & 3); }
        else pb = (lb & ~7) + 4 * (lb & 1) + ((lb & 7) >> 1);
        return titem_make(as_global(C.in[I_DA_WQKV]), 3072, 1024, (bf16*)(C.ws + WB_QKV), 64 * kb, 32 * lb, 32 * pb, nullptr, false); } r -= TI_QKV;
    if (r < TI_O) { const int cb = r % 32; return titem_make(as_global(C.in[I_DA_WO]), 1024, 1024, (bf16*)(C.ws + WB_DAO), 64 * (r / 32), 32 * cb, 32 * ((cb & ~7) + 4 * (cb & 1) + ((cb & 7) >> 1)), nullptr, false); } r -= TI_O;
    if (r < TI_O) { const int cb = r % 32; return titem_make(as_global(C.in[I_M_WO]), 1024, 1024, (bf16*)(C.ws + WB_MLO), 64 * (r / 32), 32 * cb, 32 * ((cb & ~7) + 4 * (cb & 1) + ((cb & 7) >> 1)), nullptr, false); } r -= TI_O;
    if (r < TI_WIN) { const int kb = r / 21, lb = r % 21; int pb = 18;
        if (lb < 20) { const int wsl = lb >> 1; pb = (wsl >> 2) * 8 + (lb & 1) * 4 + (wsl & 3); }
        return titem_make(as_global(C.in[I_M_WIN]), 672, 1024, (bf16*)(C.ws + WB_WIN), 64 * kb, 32 * lb, 32 * pb, nullptr, lb == 20); } r -= TI_WIN;
    if (r < TI_UQ) { const int kb = r / 48, lb = r % 48, h = lb / 3, part = lb % 3; int pb;
        if (part < 2) pb = (h >> 2) * 8 + part * 4 + (h & 3); else { const int sl = h >> 1; pb = (4 + (sl >> 2)) * 8 + (h & 1) * 4 + (sl & 3); }
        return titem_make(as_global(C.in[I_M_WUQ]), 1536, 384, (bf16*)(C.ws + WB_WUQ), 64 * kb, 32 * lb, 32 * pb, as_global(C.in[I_M_QAN]), part == 2); } r -= TI_UQ;
    if (r < TI_UKV) { const int kb = r / 64, lb = r % 64, h = lb >> 2, part = lb & 3; const int pb = (((part < 2) ? 0 : 4) + (h >> 2)) * 8 + (part & 1) * 4 + (h & 3);
        return titem_make(as_global(C.in[I_M_WUKV]), 2048, 256, (bf16*)(C.ws + WB_WUKV), 64 * kb, 32 * lb, 32 * pb, as_global(C.in[I_M_KVAN]), false); } r -= TI_UKV;
    if (r < 16384) { const int item = r & 63, mat = (r >> 6) & 1, t = (r >> 7) & 1, e = (r >> 8) & 31, l = r >> 13; const int kb = item >> 2, nb = item & 3;
        const float* W = as_global(C.in[mat ? I_E_W3 : I_E_W1]) + (size_t)(l * 32 + e) * 1024 * 256 + 128 * t;
        TItem ti = titem_make(W, 256, 1024, (bf16*)(C.ws + WB_MOE + (size_t)l * 48 * MiB), 64 * kb, 32 * nb, e * 512 + 256 * t + 128 * mat + 32 * nb, nullptr, false);
        ti.f8 = 1; ti.dst = (bf16*)((unsigned char*)(C.ws + WB_MOE + (size_t)l * 48 * MiB) + (size_t)(e * 512 + 256 * t + 128 * mat + 32 * nb) * 1024 + 64 * kb); return ti; }
    r -= 16384;
    { const int item = r & 127, e = (r >> 7) & 31, l = r >> 12; const int kb = item >> 5, nb = item & 31;
      const float* W = as_global(C.in[I_E_W2]) + (size_t)(l * 32 + e) * 256 * 1024;
      return titem_make(W, 1024, 256, (bf16*)(C.ws + WB_MOE + (size_t)l * 48 * MiB + 32 * MiB), 64 * kb, 32 * nb, e * 1024 + 32 * ((nb & ~7) + 4 * (nb & 1) + ((nb & 7) >> 1)), nullptr, false); }
}
__device__ __forceinline__ void ph_prologue(const Ctx& C) {
    {
        float* sc = (float*)C.lds;
        float* red = sc + 16384;
        const float* c = as_global(C.in[I_C]); const float* adaw = as_global(C.in[I_ADAW]); const float* adab = as_global(C.in[I_ADAB]); float* mod = (float*)(C.ws + WS_MOD);
        for (int item = blockIdx.x; item < 384; item += gridDim.x) {
            const int layer = item / 192, r = item % 192, cc = r >> 1, bhf = r & 1;
            __syncthreads();
            for (int idx = C.tid; idx < 16384; idx += NTHR) { const float v = c[(size_t)(bhf * 16) * D + idx]; sc[(idx & 1023) * 16 + (idx >> 10)] = v / (1.0f + expf(-v)); }
            __syncthreads();
            const int col = C.tid & 63, ks = C.tid >> 6;
            f32x4 acc[4];
#pragma unroll
            for (int i = 0; i < 4; ++i) acc[i] = (f32x4){0.f, 0.f, 0.f, 0.f};
            const float* wp = adaw + ((size_t)layer * D + ks * 128) * 6144 + cc * 64 + col;
#pragma unroll 8
            for (int kk = 0; kk < 128; ++kk) {
                const float w = wp[(size_t)kk * 6144]; const float* sp = sc + (ks * 128 + kk) * 16;
#pragma unroll
                for (int i = 0; i < 4; ++i) acc[i] += *(const f32x4*)(sp + 4 * i) * w;
            }
#pragma unroll
            for (int i = 0; i < 16; ++i) red[(ks * 16 + i) * 64 + col] = acc[i >> 2][i & 3];
            __syncthreads();
            for (int o = C.tid; o < 1024; o += NTHR) { const int i = o >> 6, cl = o & 63; float sm = adab[layer * 6144 + cc * 64 + cl];
#pragma unroll
                for (int k2 = 0; k2 < 8; ++k2) sm += red[(k2 * 16 + i) * 64 + cl];
                mod[(size_t)(layer * NB + bhf * 16 + i) * 6144 + cc * 64 + cl] = sm; }
        }
        if (blockIdx.x == 0 && C.wave == 0) {
            const float a = wave_sum(as_global(C.in[I_DA_LQ1])[C.lane] * as_global(C.in[I_DA_LK1])[C.lane]);
            const float b = wave_sum(as_global(C.in[I_DA_LQ2])[C.lane] * as_global(C.in[I_DA_LK2])[C.lane]);
            if (C.lane == 0) *(float*)(C.ws + WS_LAM) = expf(a) - expf(b) + 0.2f;
        }
    }
    __syncthreads();
    {
        float* ivf = (float*)C.lds;
        if (C.tid < 32) ivf[C.tid] = powf(10000.0f, -(float)(2 * C.tid) / 64.0f); else if (C.tid < 48) ivf[C.tid] = powf(10000.0f, -(float)(2 * (C.tid - 32)) / 32.0f);
        __syncthreads();
        const int* pos = (const int*)as_global(C.in[I_POS]);
        float* cosD = (float*)(C.ws + WS_COSD); float* sinD = (float*)(C.ws + WS_SIND); float* cosM = (float*)(C.ws + WS_COSM); float* sinM = (float*)(C.ws + WS_SINM);
        const int gt = blockIdx.x * NTHR + C.tid, ngt = gridDim.x * NTHR;
        for (int idx = gt; idx < NTOK * 32; idx += ngt) {
            const float ang = (float)pos[idx >> 5] * ivf[idx & 31]; float rev = ang * 0.15915494309189535f; rev -= floorf(rev);
            cosD[idx] = __builtin_amdgcn_cosf(rev); sinD[idx] = __builtin_amdgcn_sinf(rev);
        }
        for (int idx = gt; idx < NTOK * 16; idx += ngt) {
            const float ang = (float)pos[idx >> 4] * ivf[32 + (idx & 15)]; float rev = ang * 0.15915494309189535f; rev -= floorf(rev);
            cosM[idx] = __builtin_amdgcn_cosf(rev); sinM[idx] = __builtin_amdgcn_sinf(rev);
        }
        float* wrt = (float*)(C.ws + WS_WRT); const float* wr = as_global(C.in[I_E_WR]);
        for (int idx = gt; idx < 2 * 32 * 1024; idx += ngt) { const int l = idx >> 15, e = (idx >> 10) & 31, k = idx & 1023; wrt[idx] = wr[((size_t)l * 1024 + k) * 32 + e]; }
        for (int idx = gt; idx < 96 * 1024 / 8; idx += ngt) { const int blk = idx / 4096, rem = idx % 4096; const int pb = (blk == 0) ? 19 : 21 + blk;
            *(u32x4*)((bf16*)(C.ws + WB_WIN) + (size_t)pb * 32 * 1024 + (size_t)rem * 8) = (u32x4){0u, 0u, 0u, 0u}; }
    }
    __syncthreads();
    {
        float* scr = (float*)(C.lds + C.wave * 16384);
        f32x4 va[8], vb[8];
#pragma unroll 1
        for (int it = C.gw; it < TI_ALL; it += 2 * C.ngw) {
            const bool hasb = it + C.ngw < TI_ALL;
            const TItem ta = titem_decode(C, it), tb = titem_decode(C, hasb ? it + C.ngw : it);
            titem_load(ta, va, C.lane); if (hasb) titem_load(tb, vb, C.lane);
            titem_finish(ta, va, scr, C.lane); if (hasb) titem_finish(tb, vb, scr, C.lane);
        }
    }
}
__device__ __forceinline__ void ph_normmod0(const Ctx& C) {
    const float* x = as_global(C.in[I_X]); bf16* H = (bf16*)(C.ws + WS_H);
    for (int tok = C.gw; tok < NTOK; tok += C.ngw) {
        const int b = tok / SEQ; f32x4 v[4], h[4];
#pragma unroll
        for (int j = 0; j < 4; ++j) v[j] = *(const f32x4*)(x + (size_t)tok * D + 4 * C.lane + 256 * j);
        normmod_row(v, h, as_global(C.in[I_NMIX]), C.mod(0, b, 0), C.mod(0, b, 1), C.lane);
        store_row_bf16(H + (size_t)tok * D, h, C.lane);
    }
}
template <bool FINAL>
__device__ __forceinline__ void ph_comb(const Ctx& C, const unsigned char* y2, const float* gate_chunk_base  , int nlayer, const float* gnorm) {
    bf16* H = (bf16*)(C.ws + WS_H); const int lane = C.lane;
    for (int chunk = blockIdx.x; chunk < NTOK / 256; chunk += gridDim.x) {
        for (int i = 0; i < 32; ++i) {
            const int tok = chunk * 256 + C.wave * 32 + i, b = tok / SEQ;
            f32x4 v[4], a[4], a2[4];
            load_row_bf16((const bf16*)(C.ws + WS_XB) + (size_t)tok * D, v, lane);
            const float* gate = gate_chunk_base + (size_t)b * 6144;
            load_row_fp8(y2 + (size_t)(2 * tok) * D, a, lane); load_row_fp8(y2 + (size_t)(2 * tok + 1) * D, a2, lane);
#pragma unroll
            for (int j = 0; j < 4; ++j) { const f32x4 gg = *(const f32x4*)(gate + 4 * lane + 256 * j); v[j] += gg * (a[j] + a2[j]);
                if (FINAL) *(f32x4*)(as_global(C.out) + (size_t)tok * D + 4 * lane + 256 * j) = v[j]; }
            if (FINAL) continue;
            store_row_bf16((bf16*)(C.ws + WS_XB) + (size_t)tok * D, v, lane);
            f32x4 h[4];
            normmod_row(v, h, gnorm, C.mod(nlayer, b, 0), C.mod(nlayer, b, 1), lane);
            store_row_bf16(H + (size_t)tok * D, h, lane);
        }
    }
}

constexpr int MOE_TAB_OFF = 131072 + 512;
__device__ __forceinline__ void moe_prefix256(const Ctx& C, int moe_layer, int* cntl, int* tpre) {
    const unsigned* cnt = (const unsigned*)(C.ws + WS_CTL) + CW_CNT + moe_layer * 32 * 64;
    __syncthreads();
    if (C.tid < 32) cntl[C.tid] = (int)__hip_atomic_load(cnt + C.tid * 64, __ATOMIC_RELAXED, __HIP_MEMORY_SCOPE_AGENT);
    __syncthreads();
    if (C.tid == 0) { int s = 0; for (int e = 0; e < 32; ++e) { tpre[e] = s; s += (cntl[e] + 255) >> 8; } tpre[32] = s; }
    __syncthreads();
    if (C.tid < 32) { for (int rt = tpre[C.tid]; rt < tpre[C.tid + 1]; ++rt) tpre[33 + rt] = C.tid; }
    __syncthreads();
}
__device__ __forceinline__ void ph_moe1_mfma(const Ctx& C, int moe_layer) {
    int* cntl = (int*)(C.lds + MOE_TAB_OFF); int* tpre = cntl + 32;
    moe_prefix256(C, moe_layer, cntl, tpre);
    pg8::MoeOrder S{tpre, 2, (int)gridDim.x, (((int)blockIdx.x & 7) * 32 + ((int)blockIdx.x >> 3)), tpre[32] * 2};
    pg8::EpiMoe1 E{(bf16*)(C.ws + WS_A), (const int*)(C.ws + WS_LIST), (const float*)(C.ws + WS_LISTW), cntl, NTOK};
    int K1 = 1024; asm volatile("" : "+s"(K1));
    pg8::gemm_phase_gather<pg8::EpiMoe1, pg8::MoeOrder, true>((PG8_LAS unsigned char*)C.lds, (const bf16*)(C.ws + WS_H), (const bf16*)(C.ws + WB_MOE + (size_t)moe_layer * 48 * MiB), K1,
                                                        (const int*)(C.ws + WS_LIST), NTOK, cntl, S, E);
}
__device__ __forceinline__ void ph_moe2_mfma(const Ctx& C, int moe_layer) {
    int* cntl = (int*)(C.lds + MOE_TAB_OFF); int* tpre = cntl + 32;
    moe_prefix256(C, moe_layer, cntl, tpre);
    pg8::MoeOrder S{tpre, 4, (int)gridDim.x, (((int)blockIdx.x & 7) * 32 + ((int)blockIdx.x >> 3)), tpre[32] * 4};
    pg8::EpiMoe2 E{(unsigned char*)(C.ws + WS_A + 128 * MiB), (const int*)(C.ws + WS_LIST), cntl, NTOK};
    int K2 = 256; asm volatile("" : "+s"(K2));
    pg8::Gemm g{(const bf16*)(C.ws + WS_A), (const bf16*)(C.ws + WB_MOE + (size_t)moe_layer * 48 * MiB + 32 * MiB), 0, 0, K2};
    pg8::gemm_phase<pg8::EpiMoe2, pg8::MoeOrder, PG8_ALIGN, PG8_SP2>((PG8_LAS unsigned char*)C.lds, g, S, E);
}

namespace fa {
typedef short bf16x8 __attribute__((ext_vector_type(8)));
typedef short s16x4 __attribute__((ext_vector_type(4)));
typedef float f32x16 __attribute__((ext_vector_type(16)));
typedef __attribute__((address_space(3))) const char* lds_cptr;
__device__ __forceinline__ int crow(int r, int hi) { return (r & 3) + 8 * (r >> 2) + 4 * hi; }
__device__ __forceinline__ s16x4 vtr(lds_cptr p) { return __builtin_bit_cast(s16x4, __builtin_amdgcn_ds_read_tr16_b64_v4i16((__attribute__((address_space(3))) s16x4*)p)); }
typedef float f32x2_t __attribute__((ext_vector_type(2))); typedef __bf16 bf16x2_t __attribute__((ext_vector_type(2)));
__device__ __forceinline__ unsigned cvtpk(float lo, float hi) { f32x2_t v = {lo, hi}; bf16x2_t b = __builtin_convertvector(v, bf16x2_t); return __builtin_bit_cast(unsigned, b); }
__device__ __forceinline__ float half_swap_max(float v) { auto rr = __builtin_amdgcn_permlane32_swap(__float_as_uint(v), __float_as_uint(v), false, false); return fmaxf(__uint_as_float(rr[0]), __uint_as_float(rr[1])); }
__device__ __forceinline__ float half_swap_sum(float v) { auto rr = __builtin_amdgcn_permlane32_swap(__float_as_uint(v), __float_as_uint(v), false, false); return __uint_as_float(rr[0]) + __uint_as_float(rr[1]); }
__device__ __forceinline__ void dma16(const void* gsrc, LAS unsigned char* ldsdst) { unsigned keep; const unsigned dst = (unsigned)__builtin_amdgcn_readfirstlane((int)(unsigned)(uintptr_t)ldsdst);
    asm volatile("s_mov_b32 %0, m0\n\ts_mov_b32 m0, %2\n\ts_nop 0\n\tglobal_load_lds_dwordx4 %1, off\n\ts_mov_b32 m0, %0" : "=&s"(keep) : "v"(gsrc), "s"(dst) : "memory"); }
__device__ __forceinline__ void dma16s(const void* sbase_, unsigned voff, LAS unsigned char* ldsdst) { unsigned keep; const unsigned dst = (unsigned)__builtin_amdgcn_readfirstlane((int)(unsigned)(uintptr_t)ldsdst);
    const unsigned long long sb_ = (unsigned long long)(uintptr_t)sbase_; const unsigned lo_ = (unsigned)__builtin_amdgcn_readfirstlane((int)(unsigned)sb_), hi_ = (unsigned)__builtin_amdgcn_readfirstlane((int)(unsigned)(sb_ >> 32));
    const void* sbase = (const void*)(uintptr_t)(((unsigned long long)hi_ << 32) | lo_);
    asm volatile("s_mov_b32 %0, m0\n\ts_mov_b32 m0, %3\n\ts_nop 0\n\tglobal_load_lds_dwordx4 %1, %2\n\ts_mov_b32 m0, %0" : "=&s"(keep) : "v"(voff), "s"(sbase), "s"(dst) : "memory"); }

template <int ND0, int NDB>
__device__ __forceinline__ void tile(lds_cptr Kslot, lds_cptr Vslot, const bf16x8 (&qf)[ND0], f32x16 (&o)[NDB], f32x16& negm, float& m, float& l,
                                     LAS float* wsf, bool first, bool diag, int qloc, int lane) {
    const int r32 = lane & 31, hi = lane >> 5;
    lds_cptr kb = Kslot + hi * 1024 + r32 * 16;
    bf16x8 kf0[ND0], kf1[ND0];
#pragma unroll
    for (int d0 = 0; d0 < ND0; ++d0) {
        kf0[d0] = *(const __attribute__((address_space(3))) bf16x8*)(kb + d0 * 2048);
        kf1[d0] = *(const __attribute__((address_space(3))) bf16x8*)(kb + d0 * 2048 + 512);
    }
#pragma unroll
    for (int d0 = 0; d0 < ND0; ++d0) asm volatile("" : "+v"(kf0[d0]), "+v"(kf1[d0]));
    f32x16 p0 = __builtin_amdgcn_mfma_f32_32x32x16_bf16(kf0[0], qf[0], negm, 0, 0, 0);
    f32x16 p1 = __builtin_amdgcn_mfma_f32_32x32x16_bf16(kf1[0], qf[0], negm, 0, 0, 0);
#pragma unroll
    for (int d0 = 1; d0 < ND0; ++d0) {
        p0 = __builtin_amdgcn_mfma_f32_32x32x16_bf16(kf0[d0], qf[d0], p0, 0, 0, 0);
        p1 = __builtin_amdgcn_mfma_f32_32x32x16_bf16(kf1[d0], qf[d0], p1, 0, 0, 0);
    }
    __builtin_amdgcn_sched_barrier(0);
    lds_cptr vp = Vslot + ((lane >> 4) & 1) * 32 + (lane & 3) * 8 + (4 * hi + ((lane & 15) >> 2)) * 64;
    constexpr int NE = (NDB < 2 ? NDB : 2) * 4;
    s16x4 vlo[NDB * 4], vhi[NDB * 4];
#pragma unroll
    for (int i = 0; i < NE; ++i) { vlo[i] = vtr(vp + (i >> 2) * 4096 + (i & 3) * 1024); vhi[i] = vtr(vp + (i >> 2) * 4096 + (i & 3) * 1024 + 512); }
    __builtin_amdgcn_sched_barrier(0);
    if (diag) {
#pragma unroll
        for (int r = 0; r < 16; ++r) { const int kv = crow(r, hi); if (kv > qloc) p0[r] = -1e30f; if (kv + 32 > qloc) p1[r] = -1e30f; }
    }
    float mx = fmaxf(fmaxf(p0[0], p1[0]), p0[1]);
#pragma unroll
    for (int r = 1; r < 16; ++r) { if (r > 1) mx = fmaxf(fmaxf(mx, p0[r]), p1[r]); else mx = fmaxf(mx, p1[r]); }
    mx = half_swap_max(mx);
    const bool need = first || (__builtin_amdgcn_ballot_w64(mx > 8.0f) != 0ull);
    if (need) {
        const float dl = first ? mx : fmaxf(mx, 0.f);
        m += dl;
#pragma unroll
        for (int r = 0; r < 16; ++r) { p0[r] -= dl; p1[r] -= dl; negm[r] = -m; }
        if (!first) {
            const float al = __builtin_amdgcn_exp2f(-dl); l *= al;
            if (hi == 0) wsf[r32] = al;
            asm volatile("s_waitcnt lgkmcnt(0)" ::: "memory");
            f32x4 a4[4];
#pragma unroll
            for (int g = 0; g < 4; ++g) a4[g] = *(const LAS f32x4*)(wsf + 8 * g + 4 * hi);
#pragma unroll
            for (int db = 0; db < NDB; ++db)
#pragma unroll
                for (int r = 0; r < 16; ++r) o[db][r] *= a4[r >> 2][r & 3];
        }
    }
    float sum = 0.f;
#pragma unroll
    for (int ks = 0; ks < 4; ++ks) {
        float e[8];
#pragma unroll
        for (int j = 0; j < 8; ++j) { const float x = (ks < 2) ? p0[8 * ks + j] : p1[8 * (ks - 2) + j]; e[j] = __builtin_amdgcn_exp2f(x); }
        sum += ((e[0] + e[1]) + (e[2] + e[3])) + ((e[4] + e[5]) + (e[6] + e[7]));
        u32x4 w; w.x = cvtpk(e[0], e[1]); w.y = cvtpk(e[2], e[3]); w.z = cvtpk(e[4], e[5]); w.w = cvtpk(e[6], e[7]);
        const bf16x8 pa = __builtin_bit_cast(bf16x8, w);
        if (ks == 0 && NE < NDB * 4) {
#pragma unroll
            for (int i = NE; i < NDB * 4; ++i) { vlo[i] = vtr(vp + (i >> 2) * 4096 + (i & 3) * 1024); vhi[i] = vtr(vp + (i >> 2) * 4096 + (i & 3) * 1024 + 512); }
        }
        __builtin_amdgcn_s_setprio(1);
#pragma unroll
        for (int db = 0; db < NDB; ++db) {
            const s16x4 lo = vlo[db * 4 + ks], hh = vhi[db * 4 + ks];
            const bf16x8 vf = (bf16x8){lo[0], lo[1], lo[2], lo[3], hh[0], hh[1], hh[2], hh[3]};
            o[db] = __builtin_amdgcn_mfma_f32_32x32x16_bf16(pa, vf, o[db], 0, 0, 0);
        }
        __builtin_amdgcn_s_setprio(0);
    }
    l += sum;
}
}


__device__ __forceinline__ void ph_route(const Ctx& C, int layer) {
    typedef float f32x16 __attribute__((ext_vector_type(16)));
    LAS float* hT = (LAS float*)C.lds + C.wave * (32 * 68);
    LAS float* rsl = (LAS float*)C.lds + 8 * 32 * 68 + C.wave * 32;
    int* le0 = (int*)(C.lds + 73728); int* le1 = le0 + 256; int* hist = le1 + 256; int* base = hist + 32; float* lw0 = (float*)(base + 32); float* lw1 = lw0 + 256;
    const bf16* x1 = (const bf16*)(C.ws + WS_XB); unsigned char* H8 = C.ws + WS_H; float* listw = (float*)(C.ws + WS_LISTW); int* list = (int*)(C.ws + WS_LIST);
    unsigned* cnt = (unsigned*)(C.ws + WS_CTL) + CW_CNT + layer * 32 * 64;
    const float* ssqx = (const float*)(C.ws + WS_SSQX);
    const float* gn = as_global(C.in[I_NFFN]) + layer * D;
    const float* WrT = (const float*)(C.ws + WS_WRT) + (size_t)layer * 32 * 1024; const float* wg = as_global(C.in[I_E_WG]) + (size_t)layer * D * 4;
    const float* bg = as_global(C.in[I_E_BG]) + layer * 4; const float* br = as_global(C.in[I_E_BR]) + layer * 32;
    const int lane = C.lane, r32 = lane & 31, hi = lane >> 5, w = C.wave, kq = lane & 15, tsub = lane >> 4;
    LAS float* wgl = (LAS float*)(C.lds + 81920);
    __syncthreads();
    for (int idx = C.tid; idx < 1024; idx += NTHR) *(LAS f32x4*)(wgl + idx * 4) = *(const f32x4*)(wg + (size_t)idx * 4);
    for (int chunk = blockIdx.x; chunk < NTOK / 256; chunk += gridDim.x) {
        __syncthreads();
        if (C.tid < 32) hist[C.tid] = 0;
        const int tok0 = chunk * 256 + w * 32, b = tok0 >> 11;
        const float* shp = C.mod(layer, b, 3); const float* scp = C.mod(layer, b, 4);
        { const float* sp = ssqx + (size_t)(tok0 + r32) * 16; const f32x4 s0 = *(const f32x4*)sp, s1 = *(const f32x4*)(sp + 4), s2 = *(const f32x4*)(sp + 8), s3 = *(const f32x4*)(sp + 12);
          const float sm = ((s0[0] + s0[1]) + (s0[2] + s0[3])) + ((s1[0] + s1[1]) + (s1[2] + s1[3])) + ((s2[0] + s2[1]) + (s2[2] + s2[3])) + ((s3[0] + s3[1]) + (s3[2] + s3[3]));
          if (hi == 0) rsl[r32] = 1.0f / sqrtf(sm * (1.0f / D) + EPS); }
        f32x16 acc;
#pragma unroll
        for (int r = 0; r < 16; ++r) acc[r] = 0.f;
        float gl[4] = {0.f, 0.f, 0.f, 0.f};
        const unsigned xoff = (unsigned)(tok0 + tsub) * 1024u + 4u * kq;
        const unsigned woff = (unsigned)r32 * 1024u + 4u * hi;
        f32x4 X[8], Wa[8], Wb[8];
#define RT_LOADX(kc_) do { _Pragma("unroll") for (int i = 0; i < 8; ++i) { const u32x2 w_ = *(const u32x2*)(x1 + (xoff + 4096u * i + 64u * (kc_))); \
            X[i] = (f32x4){__uint_as_float(w_.x << 16), __uint_as_float(w_.x & 0xffff0000u), __uint_as_float(w_.y << 16), __uint_as_float(w_.y & 0xffff0000u)}; } } while (0)
#define RT_LOADW(W, kc_) do { _Pragma("unroll") for (int c = 0; c < 8; ++c) W[c] = *(const f32x4*)(WrT + (woff + 64u * (kc_) + 8u * c)); } while (0)
#define RT_STEP(W, WN, kc_) do { const unsigned k4 = 64u * (kc_) + 4u * kq; \
            const f32x4 g4 = *(const f32x4*)(gn + k4), sc4 = *(const f32x4*)(scp + k4), sh4 = *(const f32x4*)(shp + k4); const f32x4 gm4 = g4 * (sc4 + 1.0f); \
            _Pragma("unroll") for (int i = 0; i < 8; ++i) { const int tl = 4 * i + tsub; const float rsd = rsl[tl]; const f32x4 h4 = (X[i] * rsd) * gm4 + sh4; \
                int o8 = __builtin_amdgcn_cvt_pk_fp8_f32(h4[0], h4[1], 0, false); o8 = __builtin_amdgcn_cvt_pk_fp8_f32(h4[2], h4[3], o8, true); *(int*)(H8 + (xoff + 4096u * i + 64u * (kc_))) = o8; *(LAS f32x4*)(hT + tl * 68 + 4 * kq) = h4; } \
            if ((kc_) + 1 < 16) { RT_LOADX((kc_) + 1); RT_LOADW(WN, (kc_) + 1); } \
            _Pragma("unroll") for (int c = 0; c < 8; ++c) { const f32x4 b4 = *(const LAS f32x4*)(hT + r32 * 68 + 8 * c + 4 * hi); \
                _Pragma("unroll") for (int j = 0; j < 4; ++j) { acc = __builtin_amdgcn_mfma_f32_32x32x2f32(W[c][j], b4[j], acc, 0, 0, 0); \
                    const f32x4 w4 = *(const LAS f32x4*)(wgl + (64 * (kc_) + 8 * c + 4 * hi + j) * 4); \
                    _Pragma("unroll") for (int q = 0; q < 4; ++q) gl[q] += b4[j] * w4[q]; } asm volatile("" : "+v"(gl[0]), "+v"(gl[1]), "+v"(gl[2]), "+v"(gl[3])); } } while (0)
        RT_LOADX(0); RT_LOADW(Wa, 0);
#pragma unroll 1
        for (int kc = 0; kc < 16; kc += 2) {
            RT_STEP(Wa, Wb, kc);
            RT_STEP(Wb, Wa, kc + 1);
        }
#undef RT_LOADX
#undef RT_LOADW
#undef RT_STEP
#pragma unroll
        for (int q = 0; q < 4; ++q) gl[q] = fa::half_swap_sum(gl[q]);
        float gp[4]; { const float gm = fmaxf(fmaxf(gl[0], gl[1]), fmaxf(gl[2], gl[3])); float gs = 0.f;
#pragma unroll
            for (int g = 0; g < 4; ++g) { gp[g] = expf(gl[g] - gm); gs += gp[g]; }
#pragma unroll
            for (int g = 0; g < 4; ++g) gp[g] /= gs; }
        int gi = 0; float best = -1e30f, gate = 0.f;
#pragma unroll
        for (int g = 0; g < 4; ++g) { const float sv = gp[g] + bg[g]; if (sv > best) { best = sv; gi = g; gate = gp[g]; } }
        float el[8];
#pragma unroll
        for (int j = 0; j < 4; ++j) { const float own = (gi == 0) ? acc[j] : (gi == 1) ? acc[4 + j] : (gi == 2) ? acc[8 + j] : acc[12 + j];
            auto rr = __builtin_amdgcn_permlane32_swap(__float_as_uint(own), __float_as_uint(own), false, false);
            el[j] = __uint_as_float(rr[0]); el[4 + j] = __uint_as_float(rr[1]); }
        float em = el[0];
#pragma unroll
        for (int e = 1; e < 8; ++e) em = fmaxf(em, el[e]);
        float ep[8], es = 0.f;
#pragma unroll
        for (int e = 0; e < 8; ++e) { ep[e] = expf(el[e] - em); es += ep[e]; }
        int i0 = 0; float b0 = -1e30f, p0 = 0.f;
#pragma unroll
        for (int e = 0; e < 8; ++e) { ep[e] /= es; const float sv = ep[e] + br[gi * 8 + e]; if (sv > b0) { b0 = sv; i0 = e; p0 = ep[e]; } }
        int i1 = 0; float b1 = -1e30f, p1 = 0.f;
#pragma unroll
        for (int e = 0; e < 8; ++e) { const float sv = ep[e] + br[gi * 8 + e]; if (e != i0 && sv > b1) { b1 = sv; i1 = e; p1 = ep[e]; } }
        const float den = p0 + p1;
        if (hi == 0) { const int tl = w * 32 + r32; le0[tl] = gi * 8 + i0; le1[tl] = gi * 8 + i1; lw0[tl] = p0 / den * gate; lw1[tl] = p1 / den * gate; }
        __syncthreads();
        int e0 = 0, e1 = 0, q0 = 0, q1 = 0;
        if (C.tid < 256) { e0 = le0[C.tid]; e1 = le1[C.tid]; q0 = atomicAdd(&hist[e0], 1); q1 = atomicAdd(&hist[e1], 1); }
        __syncthreads();
        if (C.tid < 32) base[C.tid] = (int)__hip_atomic_fetch_add(cnt + C.tid * 64, (unsigned)hist[C.tid], __ATOMIC_RELAXED, __HIP_MEMORY_SCOPE_AGENT);
        __syncthreads();
        if (C.tid < 256) { const int tok = chunk * 256 + C.tid;
            const size_t i0_ = (size_t)e0 * NTOK + base[e0] + q0, i1_ = (size_t)e1 * NTOK + base[e1] + q1;
            list[i0_] = 2 * tok; list[i1_] = 2 * tok + 1; listw[i0_] = lw0[C.tid]; listw[i1_] = lw1[C.tid]; }
    }
}

__device__ __forceinline__ void ph_attn_da_mfma(const Ctx& C) {
    using namespace fa;
    LAS unsigned char* L = (LAS unsigned char*)C.lds;
    constexpr int STG = 32768;
    LAS float* wsf = (LAS float*)(L + 3 * STG) + C.wave * 32;
    const int vcu = ((int)blockIdx.x & 7) * 32 + ((int)blockIdx.x >> 3), xcd = vcu >> 5, grp = (vcu >> 4) & 1, jj = vcu & 15;
    const bf16* Q = (const bf16*)(C.ws + WS_A); const bf16* Kb = Q + (size_t)NTOK * D; const bf16* Vb = Kb + (size_t)NTOK * D; bf16* O = (bf16*)(C.ws + WS_O);
    const float lam = *(const float*)(C.ws + WS_LAM);
    const int lane = C.lane, w = C.wave, c = w >> 2, wq = w & 3, r32 = lane & 31, hi = lane >> 5;
    const float c2 = 0.125f * 1.4426950408889634f;
    for (int u = 0; u < 16; ++u) {
        const int bh = xcd * 32 + 2 * u + grp, b = bh >> 3, h = bh & 7, qb = (u & 1) ? 15 - jj : jj, q0 = qb * 128;
        const size_t rowb = (size_t)b * SEQ;
        const int NT = (q0 + 128) / 64, qw0 = q0 + 32 * wq, T = qw0 >> 6;
        const bf16* sbase = (w < 4 ? Kb : Vb) + rowb * D;
        unsigned soff[4]; int dsto[4];
#pragma unroll
        for (int i = 0; i < 4; ++i) {
            if (w < 4) { const int cm = w >> 1, ch = (w & 1) * 4 + i; soff[i] = (unsigned)((lane * D + (2 * h + cm) * 64 + ch * 8) * 2); dsto[i] = cm * 8192 + ch * 1024; }
            else { const int db = w - 4, rg = i; soff[i] = (unsigned)(((rg * 16 + (lane >> 2)) * D + h * 128 + db * 32 + (lane & 3) * 8) * 2); dsto[i] = 16384 + db * 4096 + rg * 1024; }
        }
        bf16x8 qf[4];
#pragma unroll
        for (int d0 = 0; d0 < 4; ++d0) qf[d0] = *(const bf16x8*)(Q + (rowb + qw0 + r32) * D + (2 * h + c) * 64 + d0 * 16 + hi * 8);
#pragma unroll
        for (int d0 = 0; d0 < 4; ++d0) asm volatile("" : "+v"(qf[d0]));
        f32x16 o[4];
#pragma unroll
        for (int db = 0; db < 4; ++db)
#pragma unroll
            for (int r = 0; r < 16; ++r) o[db][r] = 0.f;
        float m = 0.f, l = 0.f; f32x16 negm;
#pragma unroll
        for (int r = 0; r < 16; ++r) negm[r] = 0.f;
        asm volatile("s_waitcnt lgkmcnt(0)" ::: "memory"); __builtin_amdgcn_s_barrier();
#pragma unroll
        for (int i = 0; i < 4; ++i) dma16s(sbase, soff[i], L + dsto[i]);
#pragma unroll
        for (int i = 0; i < 4; ++i) dma16s(sbase + (size_t)64 * D, soff[i], L + STG + dsto[i]);
        int sc_ = 0, sn_ = 2;
        for (int t = 0; t < NT; ++t) {
            if (t + 1 < NT) asm volatile("s_waitcnt vmcnt(4) lgkmcnt(0)" ::: "memory"); else asm volatile("s_waitcnt vmcnt(0) lgkmcnt(0)" ::: "memory");
            __builtin_amdgcn_s_barrier();
            if (t + 2 < NT) {
#pragma unroll
                for (int i = 0; i < 4; ++i) dma16s(sbase + (size_t)(t + 2) * 64 * D, soff[i], L + sn_ * STG + dsto[i]);
            }
            if (t <= T) {
                lds_cptr stg = (lds_cptr)L + sc_ * STG;
                tile<4, 4>(stg + c * 8192, stg + 16384, qf, o, negm, m, l, wsf, t == 0, t == T, qw0 - 64 * T + r32, lane);
            }
            sc_ = (sc_ == 2) ? 0 : sc_ + 1; sn_ = (sn_ == 2) ? 0 : sn_ + 1;
        }
        l = half_swap_sum(l);
        if (hi == 0) wsf[r32] = 1.0f / l;
        asm volatile("s_waitcnt lgkmcnt(0)" ::: "memory");
        f32x4 a4[4];
#pragma unroll
        for (int g = 0; g < 4; ++g) a4[g] = *(const LAS f32x4*)(wsf + 8 * g + 4 * hi);
#pragma unroll
        for (int db = 0; db < 4; ++db)
#pragma unroll
            for (int r = 0; r < 16; ++r) o[db][r] *= a4[r >> 2][r & 3];
        asm volatile("s_waitcnt lgkmcnt(0)" ::: "memory"); __builtin_amdgcn_s_barrier();
        LAS float* X = (LAS float*)L + wq * 4352 + lane * 68;
        if (c == 1) {
#pragma unroll
            for (int db = 0; db < 4; ++db)
#pragma unroll
                for (int g = 0; g < 4; ++g) *(LAS f32x4*)(X + db * 16 + 4 * g) = (f32x4){o[db][4 * g], o[db][4 * g + 1], o[db][4 * g + 2], o[db][4 * g + 3]};
        }
        asm volatile("s_waitcnt lgkmcnt(0)" ::: "memory"); __builtin_amdgcn_s_barrier();
        if (c == 0) {
            float gsub[4];
#pragma unroll
            for (int db = 0; db < 4; ++db) gsub[db] = as_global(C.in[I_DA_SUBLN])[db * 32 + r32] * 0.8f;
#pragma unroll
            for (int db = 0; db < 4; ++db)
#pragma unroll
                for (int g = 0; g < 4; ++g) { const f32x4 x = *(const LAS f32x4*)(X + db * 16 + 4 * g);
#pragma unroll
                    for (int j2 = 0; j2 < 4; ++j2) o[db][4 * g + j2] -= lam * x[j2]; }
            float uu[8];
#pragma unroll
            for (int r = 0; r < 8; ++r) {
                const float sa = (o[0][r] * o[0][r] + o[1][r] * o[1][r]) + (o[2][r] * o[2][r] + o[3][r] * o[3][r]);
                const float sb = (o[0][r + 8] * o[0][r + 8] + o[1][r + 8] * o[1][r + 8]) + (o[2][r + 8] * o[2][r + 8] + o[3][r + 8] * o[3][r + 8]);
                auto sw = __builtin_amdgcn_permlane16_swap(__float_as_uint(sa), __float_as_uint(sb), false, false);
                uu[r] = __uint_as_float(sw[0]) + __uint_as_float(sw[1]);
            }
#pragma unroll
            for (int r = 0; r < 8; ++r) {
                uu[r] += __uint_as_float((unsigned)__builtin_amdgcn_update_dpp(0, (int)__float_as_uint(uu[r]), 0x128, 0xF, 0xF, true));
                uu[r] += __uint_as_float((unsigned)__builtin_amdgcn_update_dpp(0, (int)__float_as_uint(uu[r]), 0x124, 0xF, 0xF, true));
                uu[r] += __uint_as_float((unsigned)__builtin_amdgcn_update_dpp(0, (int)__float_as_uint(uu[r]), 0x122, 0xF, 0xF, true));
                uu[r] += __uint_as_float((unsigned)__builtin_amdgcn_update_dpp(0, (int)__float_as_uint(uu[r]), 0x121, 0xF, 0xF, true));
                uu[r] = __builtin_amdgcn_rsqf(uu[r] * (1.0f / 128.0f) + EPS);
            }
            float rs[16];
#pragma unroll
            for (int r = 0; r < 8; ++r) { auto sw = __builtin_amdgcn_permlane16_swap(__float_as_uint(uu[r]), __float_as_uint(uu[r]), false, false); rs[r] = __uint_as_float(sw[0]); rs[r + 8] = __uint_as_float(sw[1]); }
            asm volatile("s_waitcnt lgkmcnt(0)" ::: "memory");
            LAS unsigned char* TT = (LAS unsigned char*)((LAS float*)L + wq * 4352);
#pragma unroll
            for (int r = 0; r < 16; ++r) {
                const unsigned p01 = cvtpk(o[0][r] * (rs[r] * gsub[0]), o[1][r] * (rs[r] * gsub[1])), p23 = cvtpk(o[2][r] * (rs[r] * gsub[2]), o[3][r] * (rs[r] * gsub[3]));
                LAS unsigned short* tp = (LAS unsigned short*)(TT + crow(r, hi) * 272 + r32 * 2);
                tp[0] = (unsigned short)p01; tp[32] = (unsigned short)(p01 >> 16); tp[64] = (unsigned short)p23; tp[96] = (unsigned short)(p23 >> 16);
            }
            asm volatile("s_waitcnt lgkmcnt(0)" ::: "memory");
#pragma unroll
            for (int i = 0; i < 8; ++i) {
                const int row = 4 * i + (lane >> 4);
                const u32x4 v = *(const LAS u32x4*)(TT + row * 272 + (lane & 15) * 16);
                *(u32x4*)(O + (rowb + qw0 + row) * D + h * 128 + (lane & 15) * 8) = v;
            }
        }
    }
}
__device__ __forceinline__ void ph_attn_mla_mfma(const Ctx& C) {
    using namespace fa;
    LAS unsigned char* L = (LAS unsigned char*)C.lds;
    constexpr int STG = 20480;
    LAS float* wsf = (LAS float*)(L + 3 * STG) + C.wave * 32;
    const int vcu = ((int)blockIdx.x & 7) * 32 + ((int)blockIdx.x >> 3), xcd = vcu >> 5, grp = (vcu >> 3) & 3, jj = vcu & 7;
    const bf16* Q2 = (const bf16*)(C.ws + WS_A); const bf16* KV2 = (const bf16*)(C.ws + WS_A + 192 * MiB);
    const bf16* KPE = (const bf16*)(C.ws + WS_KPE); bf16* O = (bf16*)(C.ws + WS_O);
    const int lane = C.lane, w = C.wave, r32 = lane & 31, hi = lane >> 5;
    const float c2 = 0.10206207261596575f * 1.4426950408889634f;
    for (int u = 0; u < 16; ++u) {
        const int bh = xcd * 64 + 4 * u + grp, b = bh >> 4, h = bh & 15, qb = (u & 1) ? 7 - jj : jj, q0 = qb * 256;
        const size_t rowb = (size_t)b * SEQ;
        const int NT = (q0 + 256) / 64, qw0 = q0 + 32 * w, T = qw0 >> 6;
        const bf16* src[3]; int dsto[3]; size_t sstep[3];
#pragma unroll
        for (int i = 0; i < 3; ++i) {
            const int pi = w + 8 * i;
            if (pi < 8) { src[i] = KV2 + (rowb + lane) * 2048 + h * 128 + pi * 8; dsto[i] = pi * 1024; sstep[i] = (size_t)64 * 2048; }
            else if (pi < 12) { src[i] = KPE + (rowb + lane) * 32 + (pi - 8) * 8; dsto[i] = pi * 1024; sstep[i] = (size_t)64 * 32; }
            else { const int db = (pi - 12) >> 2, rg = (pi - 12) & 3; src[i] = KV2 + (rowb + rg * 16 + (lane >> 2)) * 2048 + h * 128 + 64 + db * 32 + (lane & 3) * 8; dsto[i] = 12288 + db * 4096 + rg * 1024; sstep[i] = (size_t)64 * 2048; }
        }
        const bool has3 = (w + 16) < 20;
        bf16x8 qf[6];
#pragma unroll
        for (int d0 = 0; d0 < 6; ++d0) qf[d0] = *(const bf16x8*)(Q2 + (rowb + qw0 + r32) * 1536 + (d0 < 4 ? h * 64 + d0 * 16 : 1024 + h * 32 + (d0 - 4) * 16) + hi * 8);
#pragma unroll
        for (int d0 = 0; d0 < 6; ++d0) asm volatile("" : "+v"(qf[d0]));
        f32x16 o[2];
#pragma unroll
        for (int db = 0; db < 2; ++db)
#pragma unroll
            for (int r = 0; r < 16; ++r) o[db][r] = 0.f;
        float m = 0.f, l = 0.f; f32x16 negm;
#pragma unroll
        for (int r = 0; r < 16; ++r) negm[r] = 0.f;
        asm volatile("s_waitcnt lgkmcnt(0)" ::: "memory"); __builtin_amdgcn_s_barrier();
        dma16(src[0], L + dsto[0]); dma16(src[1], L + dsto[1]); if (has3) dma16(src[2], L + dsto[2]);
        dma16(src[0] + sstep[0], L + STG + dsto[0]); dma16(src[1] + sstep[1], L + STG + dsto[1]); if (has3) dma16(src[2] + sstep[2], L + STG + dsto[2]);
        int sc_ = 0, sn_ = 2;
        for (int t = 0; t < NT; ++t) {
            if (t + 1 < NT) { if (has3) asm volatile("s_waitcnt vmcnt(3) lgkmcnt(0)" ::: "memory"); else asm volatile("s_waitcnt vmcnt(2) lgkmcnt(0)" ::: "memory"); }
            else asm volatile("s_waitcnt vmcnt(0) lgkmcnt(0)" ::: "memory");
            __builtin_amdgcn_s_barrier();
            if (t + 2 < NT) {
                LAS unsigned char* nb = L + sn_ * STG;
                dma16(src[0] + (t + 2) * sstep[0], nb + dsto[0]); dma16(src[1] + (t + 2) * sstep[1], nb + dsto[1]); if (has3) dma16(src[2] + (t + 2) * sstep[2], nb + dsto[2]);
            }
            if (t <= T) {
                lds_cptr stg = (lds_cptr)L + sc_ * STG;
                tile<6, 2>(stg, stg + 12288, qf, o, negm, m, l, wsf, t == 0, t == T, qw0 - 64 * T + r32, lane);
            }
            sc_ = (sc_ == 2) ? 0 : sc_ + 1; sn_ = (sn_ == 2) ? 0 : sn_ + 1;
        }
        l = half_swap_sum(l);
        if (hi == 0) wsf[r32] = 1.0f / l;
        asm volatile("s_waitcnt lgkmcnt(0)" ::: "memory");
        f32x4 a4[4];
#pragma unroll
        for (int g = 0; g < 4; ++g) a4[g] = *(const LAS f32x4*)(wsf + 8 * g + 4 * hi);
        LAS unsigned char* TT = L + 65536 + w * 4608;
#pragma unroll
        for (int r = 0; r < 16; ++r) {
            const unsigned pk = cvtpk(o[0][r] * a4[r >> 2][r & 3], o[1][r] * a4[r >> 2][r & 3]);
            LAS unsigned short* tp = (LAS unsigned short*)(TT + crow(r, hi) * 144 + r32 * 2);
            tp[0] = (unsigned short)pk; tp[32] = (unsigned short)(pk >> 16);
        }
        asm volatile("s_waitcnt lgkmcnt(0)" ::: "memory");
#pragma unroll
        for (int i = 0; i < 4; ++i) {
            const int row = 8 * i + (lane >> 3);
            const u32x4 v = *(const LAS u32x4*)(TT + row * 144 + (lane & 7) * 16);
            *(u32x4*)(O + (rowb + qw0 + row) * D + h * 64 + (lane & 7) * 8) = v;
        }
    }
}

__global__ void __launch_bounds__(NTHR, 2) fwd(Args args) {
    extern __shared__ __attribute__((aligned(16))) unsigned char lds[];
    Ctx C; C.in = args.in; C.out = args.out; C.ws = args.ws; C.lds = lds;
    C.tid = threadIdx.x; C.lane = C.tid & 63; C.wave = __builtin_amdgcn_readfirstlane(C.tid >> 6);
    C.gw = blockIdx.x * NWAVES + C.wave; C.ngw = gridDim.x * NWAVES;
    const Ctx C0 = C;
    volatile LAS unsigned* MISC = (volatile LAS unsigned*)((LAS unsigned char*)lds + MISC_OFF);
    if (C.tid < 32) MISC[C.tid] = 0u;
    __syncthreads();
    XcdBarrier bar; bar.bar = (unsigned*)(args.ws + WS_CTL) + CW_BAR; bar.x = 0; bar.st = nullptr;
    const int lo = args.ph_lo, hi = args.ph_hi;
    if (hi - lo > 1) bar = xcd_barrier_post((unsigned*)(args.ws + WS_CTL) + CW_BAR, MISC + 8);
#ifndef REPMASK
#define REPMASK 0u
#endif
#ifndef PHMASK
#define PHMASK 0xFFFFFFFFu
#endif
#define IN(k) (lo <= (k) && (k) < hi && ((PHMASK >> (k)) & 1u))
#define SEAM(k) do { if (IN(k) && IN((k) + 1)) xcd_barrier(bar); } while (0)
#define PHLOCAL unsigned char* ws = args.ws; asm volatile("" : "+s"(ws)); ws = as_global(ws); int t_ = threadIdx.x; asm volatile("" : "+v"(t_)); Ctx C = C0; C.ws = ws; C.tid = t_; C.lane = t_ & 63; \
        bf16* H = (bf16*)(ws + WS_H); bf16* O = (bf16*)(ws + WS_O); bf16* A0 = (bf16*)(ws + WS_A); (void)H; (void)O; (void)A0;

    if (IN(0)) { PHLOCAL ph_prologue(C); } SEAM(0);
    if (IN(1)) { PHLOCAL ph_normmod0(C); } SEAM(1);
    if (IN(2)) { PHLOCAL
        pg8::Gemm g{H, (const bf16*)(ws + WB_QKV), NTOK, 3 * D, D}; pg8::StaticOrder S; S.init(NTOK, 3 * D, (int)gridDim.x, (int)blockIdx.x);
        pg8::EpiQKV E{A0, A0 + (size_t)NTOK * D, A0 + (size_t)2 * NTOK * D, (const float*)(ws + WS_COSD), (const float*)(ws + WS_SIND), as_global(args.in[I_DA_QN]), as_global(args.in[I_DA_KN]), 0.125f * 1.4426950408889634f, EPS};
        pg8::gemm_phase<pg8::EpiQKV, pg8::StaticOrder, PG8_ALIGN, PG8_SP2>((PG8_LAS unsigned char*)lds, g, S, E);
    } SEAM(2);
    if (IN(3)) { PHLOCAL ph_attn_da_mfma(C); } SEAM(3);
    if (IN(4)) { PHLOCAL
        pg8::Gemm g{O, (const bf16*)(ws + WB_DAO), NTOK, D, D}; pg8::StaticOrder S; S.init(NTOK, D, (int)gridDim.x, (int)blockIdx.x);
        pg8::EpiResid<true> E{as_global(args.in[I_X]), (bf16*)(ws + WS_XB), C.mod(0, 0, 2), (float*)(ws + WS_SSQX)};
        pg8::gemm_phase<pg8::EpiResid<true>, pg8::StaticOrder, PG8_ALIGN, PG8_SP2>((PG8_LAS unsigned char*)lds, g, S, E);
    } SEAM(4);
    if (IN(5)) { PHLOCAL ph_route(C, 0); } SEAM(5);
    if (IN(6)) { PHLOCAL ph_moe1_mfma(C, 0); } SEAM(6);
    if (IN(7)) { PHLOCAL ph_moe2_mfma(C, 0); } SEAM(7);
    if (IN(8)) { PHLOCAL ph_comb<false>(C, ws + WS_A + 128 * MiB, C.mod(0, 0, 5), 1, as_global(args.in[I_NMIX]) + D); } SEAM(8);
    if (IN(9)) { PHLOCAL
        bf16* CQ = (bf16*)(ws + WS_S); bf16* CKV = CQ + (size_t)NTOK * 384; bf16* KPE = (bf16*)(ws + WS_KPE);
        pg8::Gemm g{H, (const bf16*)(ws + WB_WIN), NTOK, 768, D}; pg8::StaticOrder S; S.init(NTOK, 768, (int)gridDim.x, (int)blockIdx.x);
        pg8::EpiWin E{CQ, CKV, KPE, (float*)(ws + WS_SSQ), (const float*)(ws + WS_COSM), (const float*)(ws + WS_SINM), as_global(args.in[I_M_KPN]), EPS};
        pg8::gemm_phase<pg8::EpiWin, pg8::StaticOrder, PG8_ALIGN, PG8_SP2>((PG8_LAS unsigned char*)lds, g, S, E);
    } SEAM(9);
    if (IN(10)) { PHLOCAL
        const bf16* CQ = (const bf16*)(ws + WS_S); const bf16* CKV = CQ + (size_t)NTOK * 384;
        int Kq = 384, Kkv = 256; asm volatile("" : "+s"(Kq), "+s"(Kkv));
        { pg8::Gemm g{CQ, (const bf16*)(ws + WB_WUQ), NTOK, 1536, Kq}; pg8::StaticOrder S; S.init(NTOK, 1536, (int)gridDim.x, (int)blockIdx.x);
          pg8::EpiUQ E{A0, (const float*)(ws + WS_SSQ), (const float*)(ws + WS_COSM), (const float*)(ws + WS_SINM), as_global(args.in[I_M_QNN]), as_global(args.in[I_M_QPN]), 0.10206207261596575f * 1.4426950408889634f, EPS};
          pg8::gemm_phase<pg8::EpiUQ, pg8::StaticOrder, PG8_ALIGN, PG8_SP2>((PG8_LAS unsigned char*)lds, g, S, E); }
        { pg8::Gemm g{CKV, (const bf16*)(ws + WB_WUKV), NTOK, 2048, Kkv}; pg8::StaticOrder S; S.init(NTOK, 2048, (int)gridDim.x, (int)blockIdx.x);
          pg8::EpiUKV E{(bf16*)(ws + WS_A + 192 * MiB), (const float*)(ws + WS_SSQ), as_global(args.in[I_M_KNN]), EPS};
          pg8::gemm_phase<pg8::EpiUKV, pg8::StaticOrder, PG8_ALIGN, PG8_SP2>((PG8_LAS unsigned char*)lds, g, S, E); }
    } SEAM(10);
    if (IN(11)) { PHLOCAL ph_attn_mla_mfma(C); } SEAM(11);
    if (IN(12)) { PHLOCAL
        pg8::Gemm g{O, (const bf16*)(ws + WB_MLO), NTOK, D, D}; pg8::StaticOrder S; S.init(NTOK, D, (int)gridDim.x, (int)blockIdx.x);
        pg8::EpiResid<false> E{ws + WS_XB, (bf16*)(ws + WS_XB), C.mod(1, 0, 2), (float*)(ws + WS_SSQX)};
        pg8::gemm_phase<pg8::EpiResid<false>, pg8::StaticOrder, PG8_ALIGN, PG8_SP2>((PG8_LAS unsigned char*)lds, g, S, E);
    } SEAM(12);
    if (IN(13)) { PHLOCAL ph_route(C, 1); } SEAM(13);
    if (IN(14)) { PHLOCAL ph_moe1_mfma(C, 1); } SEAM(14);
    if (IN(15)) { PHLOCAL ph_moe2_mfma(C, 1); } SEAM(15);
    if (IN(16)) { PHLOCAL ph_comb<true>(C, ws + WS_A + 128 * MiB, C.mod(1, 0, 5), 1, as_global(args.in[I_NMIX])); }
#undef IN
#undef SEAM
}

extern "C" void kernel_launch(void* const* d_in, const int* in_sizes, int n_in, void* d_out, int out_size, void* d_ws, size_t ws_size, hipStream_t stream) {
    static int grid = 0;
    if (grid == 0) {
        if (n_in != 33 || out_size != NTOK * D || ws_size < WS_END) { fprintf(stderr, "kernel_launch: unexpected shapes n_in %d out %d ws %zu\n", n_in, out_size, ws_size); grid = -1; return; }
        int dev = 0, cus = 0;
        if (hipGetDevice(&dev) != hipSuccess || hipDeviceGetAttribute(&cus, hipDeviceAttributeMultiprocessorCount, dev) != hipSuccess) { grid = -1; return; }
        if (hipFuncSetAttribute((const void*)fwd, hipFuncAttributeMaxDynamicSharedMemorySize, LDS_BYTES) != hipSuccess) { fprintf(stderr, "hipFuncSetAttribute failed\n"); grid = -1; return; }
        (void)hipGetLastError();
        grid = cus;
        if (grid != 256) { fprintf(stderr, "kernel_launch: built for 256 CUs, device reports %d\n", cus); grid = -1; return; }
    }
    if (grid < 0) return;
    (void)hipMemsetAsync((char*)d_ws + WS_CTL, 0, CTL_ZERO_BYTES, stream);
    Args a{};
    for (int i = 0; i < 33; ++i) a.in[i] = (const float*)d_in[i];
    a.out = (float*)d_out; a.ws = (unsigned char*)d_ws;
#if MK_ONE_LAUNCH
    a.ph_lo = 0; a.ph_hi = N_PHASES;
    hipLaunchKernelGGL(fwd, dim3(grid), dim3(NTHR), LDS_BYTES, stream, a);
#else
    for (int p = 0; p < N_PHASES; ++p) { a.ph_lo = p; a.ph_hi = p + 1; hipLaunchKernelGGL(fwd, dim3(grid), dim3(NTHR), LDS_BYTES, stream, a); }
#endif
}
```

```cpp
#include <hip/hip_runtime.h>
#include <cstdio>
#include <cstdint>

#define LAS __attribute__((address_space(3)))
#define GAS __attribute__((address_space(1)))
template <class T> __device__ __forceinline__ T* as_global(T* p) { GAS T* g = (GAS T*)p; asm("" : "+s"(g)); return (T*)g; }
typedef unsigned short bf16;
typedef float f32x4 __attribute__((ext_vector_type(4)));
typedef unsigned u32x4 __attribute__((ext_vector_type(4)));
typedef unsigned u32x2 __attribute__((ext_vector_type(2)));

constexpr int NB = 32, SEQ = 2048, D = 1024, NTOK = NB * SEQ;
constexpr float EPS = 1e-6f;
constexpr int NWAVES = 8, NTHR = 512;
constexpr int N_PHASES = 17;
#ifndef MK_ONE_LAUNCH
#define MK_ONE_LAUNCH 1
#endif

constexpr size_t MiB = 1u << 20;
constexpr size_t WS_CTL = 0, CTL_ZERO_BYTES = 1 * MiB;
constexpr size_t WS_MOD = 1 * MiB;
constexpr size_t WS_LAM = WS_MOD + 7 * MiB / 4;
constexpr size_t WS_SSQX = 4 * MiB;
constexpr size_t WS_SSQ = 8 * MiB;
constexpr size_t WS_WRT = 12 * MiB;
constexpr size_t WS_COSD = 16 * MiB, WS_SIND = 24 * MiB, WS_COSM = 32 * MiB, WS_SINM = 36 * MiB;
constexpr size_t WS_TOKW = 40 * MiB;
constexpr size_t WS_LIST = 42 * MiB;
constexpr size_t WS_WB = 50 * MiB;
constexpr size_t WB_QKV = WS_WB, WB_DAO = WB_QKV + 6 * MiB, WB_WIN = WB_DAO + 2 * MiB, WB_WUQ = WB_WIN + 3 * MiB / 2, WB_WUKV = WB_WUQ + 9 * MiB / 8, WB_MLO = WB_WUKV + 1 * MiB, WB_MOE = WB_MLO + 2 * MiB;
constexpr size_t WS_H = 176 * MiB;
constexpr size_t WS_O = 304 * MiB;
constexpr size_t WS_A = 432 * MiB;
constexpr size_t WS_LISTW = 160 * MiB;
constexpr size_t WS_KPE = 168 * MiB;
constexpr size_t WS_S = WS_O;
constexpr size_t WS_XB = 880 * MiB;
constexpr size_t WS_END = 1008 * MiB;
constexpr int CW_BAR = 4096;
constexpr int CW_CNT = 16384;
constexpr int HID_ROWS = 2 * NTOK + 32 * 128;

constexpr int LDS_BYTES = 147456;
constexpr int MISC_OFF = 131072 + 320;

__device__ __forceinline__ unsigned f2bf(float f) { unsigned u = __builtin_bit_cast(unsigned, f); return (u + 0x7fffu + ((u >> 16) & 1u)) >> 16; }
__device__ __forceinline__ float bf2f(unsigned h) { return __builtin_bit_cast(float, h << 16); }
__device__ __forceinline__ unsigned pk2(float lo, float hi) { return f2bf(lo) | (f2bf(hi) << 16); }
__device__ __forceinline__ float wave_sum(float v) {
#pragma unroll
    for (int o = 1; o < 64; o <<= 1) v += __shfl_xor(v, o);
    return v;
}
__device__ __forceinline__ float wave_max(float v) {
#pragma unroll
    for (int o = 1; o < 64; o <<= 1) v = fmaxf(v, __shfl_xor(v, o));
    return v;
}

#define XB_TMO      128
#define XB_XCNT(j)  (256  + 64 * (j))
#define XB_XSUB(j)  (1280 + 64 * (j))
#define XB_XGEN(j)  (2304 + 64 * (j))
#define XB_TOP      3328
#define XB_TOPGEN   3392
#define XCD_BAR_WORDS 3456
#define XB_SPIN_CAP (1u << 20)
__device__ __forceinline__ unsigned xb_ld(unsigned* p)              { return __hip_atomic_load(p, __ATOMIC_RELAXED, __HIP_MEMORY_SCOPE_AGENT); }
__device__ __forceinline__ unsigned xb_add(unsigned* p, unsigned v) { return __hip_atomic_fetch_add(p, v, __ATOMIC_RELAXED, __HIP_MEMORY_SCOPE_AGENT); }
__device__ __forceinline__ unsigned xb_xcc_id() { return (unsigned)__builtin_amdgcn_s_getreg((3 << 11) | 20) & 0xFu; }
#define XB_SPIN(cond, bar) do { unsigned _sp = 0; while (cond) { __builtin_amdgcn_s_sleep(1); \
    if ((++_sp & 255u) == 0u) { if (xb_ld(&(bar)[XB_TMO])) break; if (_sp > XB_SPIN_CAP) { atomicAdd(&(bar)[XB_TMO], 1u); break; } } } } while (0)
struct XcdBarrier { unsigned* bar; unsigned x; volatile LAS unsigned* st; };
__device__ __forceinline__ XcdBarrier xcd_barrier_post(unsigned* bar, volatile LAS unsigned* st) {
    XcdBarrier b; b.bar = bar; b.x = xb_xcc_id(); b.st = st;
    if (threadIdx.x == 0) (void)xb_add(&bar[XB_XCNT(b.x)], 1u);
    return b;
}
__device__ __forceinline__ void xcd_barrier_complete(unsigned* bar, unsigned x, unsigned& nloc, unsigned& nx) {
    const unsigned G = gridDim.x * gridDim.y * gridDim.z;
    unsigned sum, cnt, mine, sp = 0u;
    for (;;) {
        sum = 0u; cnt = 0u; mine = 0u;
#pragma unroll
        for (unsigned j = 0; j < 16; ++j) { const unsigned c = xb_ld(&bar[XB_XCNT(j)]); sum += c; cnt += (c > 0u) ? 1u : 0u; mine = (j == x) ? c : mine; }
        if (sum == G) break;
        __builtin_amdgcn_s_sleep(1);
        if ((++sp & 255u) == 0u) { if (xb_ld(&bar[XB_TMO])) break; if (sp > XB_SPIN_CAP) { atomicAdd(&bar[XB_TMO], 1u); break; } }
    }
    nloc = mine > 0u ? mine : 1u; nx = cnt > 0u ? cnt : 1u;
}
__device__ __forceinline__ void xcd_barrier(const XcdBarrier& b) {
    asm volatile("s_waitcnt vmcnt(0)" ::: "memory");
    __syncthreads();
    if (threadIdx.x == 0) {
        unsigned* bar = b.bar;
        __builtin_amdgcn_s_waitcnt(0);
        unsigned nloc = b.st[0], nx = b.st[1];
        if (nloc == 0u) { xcd_barrier_complete(bar, b.x, nloc, nx); b.st[0] = nloc; b.st[1] = nx; }
        const unsigned old = xb_add(&bar[XB_XSUB(b.x)], 1u);
        const unsigned gen = old / nloc;
        if (old + 1u == (gen + 1u) * nloc) {
            __builtin_amdgcn_fence(__ATOMIC_RELEASE, "agent");
            asm volatile("s_waitcnt vmcnt(0)" ::: "memory");
            const unsigned og = xb_add(&bar[XB_TOP], 1u);
            const unsigned tg = og / nx;
            if (og + 1u == (tg + 1u) * nx) xb_add(&bar[XB_TOPGEN], 1u);
            else XB_SPIN(xb_ld(&bar[XB_TOPGEN]) == tg, bar);
            __builtin_amdgcn_fence(__ATOMIC_ACQUIRE, "agent");
            xb_add(&bar[XB_XGEN(b.x)], 1u);
            asm volatile("s_waitcnt vmcnt(0)" ::: "memory");
        } else {
            XB_SPIN(xb_ld(&bar[XB_XGEN(b.x)]) == gen, bar);
            __builtin_amdgcn_fence(__ATOMIC_ACQUIRE, "agent");
            asm volatile("s_waitcnt vmcnt(0)" ::: "memory");
        }
    }
    __syncthreads();
}

namespace pg8 {
#define PG8_LAS __attribute__((address_space(3)))
typedef unsigned short bf16_t;
typedef short bf16x8 __attribute__((ext_vector_type(8)));
typedef float f32x4 __attribute__((ext_vector_type(4)));
typedef unsigned u32x4 __attribute__((ext_vector_type(4)));
constexpr int BM = 256, BK = 64, HALF = 128, HTB = HALF * BK * 2  , STAGE_BYTES = 8 * HTB, NXCD = 8, WGM = 8;

__host__ __device__ __forceinline__ int lds_byte(int r, int c) { const int st = (r >> 4) * 2 + (c >> 5), rr = r & 15, cc = c & 31, ob = rr * 64 + cc * 2; return st * 1024 + (ob ^ (((ob >> 9) & 1) << 5)); }
__host__ __device__ __forceinline__ void stage_rc(int b, int& R, int& C) { const int st = b / 1024, sb = b % 1024, swz = sb ^ (((sb >> 9) & 1) << 5); R = (st >> 1) * 16 + swz / 64; C = (st & 1) * 32 + (swz % 64) / 2; }
__host__ __device__ __forceinline__ int perm32(int rho) { const int n = rho >> 4, i = rho & 15; return 8 * (i >> 2) + 4 * n + (i & 3); }

struct Unit { int pm, pn; };
struct Gemm { const bf16_t* A; const bf16_t* Bt; int M, N, K; };

struct StaticOrder {
    typedef Unit UnitT;
    int nM, nN, nwg, G, c;
    __host__ __device__ void init(int M, int N, int G_, int c_) { nM = M / BM; nN = N / BM; nwg = nM * nN; G = G_; c = c_; }
    __host__ __device__ bool next(int i, Unit& u) const {
        const long L = (long)i * G + c; if (L >= nwg) return false;
        int wgid = (int)L; { const int q = nwg / NXCD, r = nwg % NXCD, xcd = wgid % NXCD, off = wgid / NXCD; wgid = (xcd < r ? xcd * (q + 1) : r * (q + 1) + (xcd - r) * q) + off; }
        const int nig = WGM * nN, gid = wgid / nig, fm = gid * WGM, gsz = (nM - fm) < WGM ? (nM - fm) : WGM;
        u.pm = fm + ((wgid % nig) % gsz); u.pn = (wgid % nig) / gsz; return true;
    }
    __device__ __forceinline__ void a_ready(const Unit&) const {}
    __device__ __forceinline__ void done(const Unit&) const {}
};

__device__ __forceinline__ unsigned cvt_pk_bf16(float lo, float hi) { unsigned r; asm volatile("v_cvt_pk_bf16_f32 %0, %1, %2" : "=v"(r) : "v"(lo), "v"(hi)); return r; }
typedef float f32x2 __attribute__((ext_vector_type(2)));
__device__ __forceinline__ f32x2 gelu_pk(f32x2 v) {
    const f32x2 av = __builtin_elementwise_abs(v), d = av * 0.2316418882f + 1.0f;
    f32x2 t; t.x = __builtin_amdgcn_rcpf(d.x); t.y = __builtin_amdgcn_rcpf(d.y);
    f32x2 q = t * 0.5307027145f + (-0.7265760135f); q = q * t + 0.7107068705f; q = q * t + (-0.142248368f); q = q * t + 0.127414796f; q = q * t;
    const f32x2 s = (v * v) * (-0.72134752044f);
    f32x2 e; e.x = __builtin_amdgcn_exp2f(s.x); e.y = __builtin_amdgcn_exp2f(s.y);
    const f32x2 m = v * (q * e), r = v - m;
    f32x2 o; o.x = v.x < 0.f ? m.x : r.x; o.y = v.y < 0.f ? m.y : r.y; return o;
}

template <int ACT  > struct EpiBf16 {
    static constexpr bool PERM = true, AFTER_DRAIN = false; static constexpr int NVM = 0; static_assert(ACT == 0 || ACT == 1, "EpiBf16: ACT is 0 (none) or 1 (gelu_pk)");
    bf16_t* O; int ldc; const float* bias; int split_cols; size_t split_stride; float scale0;
    __device__ __forceinline__ void operator()(const f32x4 (&acc)[2][2][4][2], const Unit& u, int wr, int wc, int fr, int fq) const {
        const int row0 = u.pm * BM + wr * 64 + fr; int colt = u.pn * BM; bf16_t* base = O;
        float sc = 1.f; if (split_cols) { const int t = colt / split_cols; base += (size_t)t * split_stride; colt -= t * split_cols; if (t == 0) sc = scale0; }
        const int col0 = colt + wc * 32 + 8 * fq, bcol0 = u.pn * BM + wc * 32 + 8 * fq;
        f32x4 bv[2][2];
#pragma unroll
        for (int bj = 0; bj < 2; ++bj)
#pragma unroll
            for (int n = 0; n < 2; ++n) bv[bj][n] = bias ? *(const f32x4*)(bias + bcol0 + bj * HALF + 4 * n) : (f32x4){0.f, 0.f, 0.f, 0.f};
#pragma unroll
        for (int ai = 0; ai < 2; ++ai)
#pragma unroll
            for (int m = 0; m < 4; ++m) { bf16_t* rowp = base + (size_t)(row0 + ai * HALF + m * 16) * ldc + col0;
#pragma unroll
                for (int bj = 0; bj < 2; ++bj) { f32x4 v0 = acc[ai][bj][m][0] + bv[bj][0], v1 = acc[ai][bj][m][1] + bv[bj][1];
                    if (ACT == 1) { f32x2 a = gelu_pk((f32x2){v0[0], v0[1]}), b = gelu_pk((f32x2){v0[2], v0[3]}), c = gelu_pk((f32x2){v1[0], v1[1]}), d = gelu_pk((f32x2){v1[2], v1[3]});
                        v0 = (f32x4){a.x, a.y, b.x, b.y}; v1 = (f32x4){c.x, c.y, d.x, d.y}; }
                    v0 = v0 * sc; v1 = v1 * sc; u32x4 w; w.x = cvt_pk_bf16(v0[0], v0[1]); w.y = cvt_pk_bf16(v0[2], v0[3]); w.z = cvt_pk_bf16(v1[0], v1[1]); w.w = cvt_pk_bf16(v1[2], v1[3]);
                    *(u32x4*)(rowp + bj * HALF) = w; } }
    }
};

template <class Epi, class Sched, bool ALIGN_EPI = false, bool SP2 = false>
__device__ __forceinline__ void gemm_phase(PG8_LAS unsigned char* lds, const Gemm g, const Sched& S, const Epi& E) {
    int tid_ = threadIdx.x; asm volatile("" : "+v"(tid_));
    const int tid = tid_, wid = __builtin_amdgcn_readfirstlane(tid >> 6), lane = tid & 63, wr = wid >> 2, wc = wid & 3, fr = lane & 15, fq = lane >> 4;
    const int K = g.K, nt = K / BK;
    unsigned voffA[2], voffB[2];
#pragma unroll
    for (int i = 0; i < 2; ++i) { int R, C; stage_rc(tid * 16 + i * 8192, R, C); const int Rb = Epi::PERM ? ((R & ~31) + perm32(R & 31)) : R;
        voffA[i] = (unsigned)(R * K + C) * 2u; voffB[i] = (unsigned)(Rb * K + C) * 2u; }
    const size_t kstep = (size_t)(BK * 2);
    const size_t hstep = (size_t)HALF * K * 2;
    const size_t tstep = 2 * hstep;
    const unsigned ldsw = (unsigned)wid * 1024u;
    const int aoff = lds_byte(wr * 64 + fr, fq * 8), boff = lds_byte(wc * 32 + fr, fq * 8);
#define PG8_SA(b, h) (((b) * 2 + (h)) * HTB)
#define PG8_SB(b, h) ((4 + (b) * 2 + (h)) * HTB)
#define PG8_STAGE(bufoff, gbase, voff) do { _Pragma("unroll") for (int _i = 0; _i < 2; ++_i) \
        __builtin_amdgcn_global_load_lds((const unsigned*)((const char*)(gbase) + (voff)[_i]), (PG8_LAS unsigned*)(lds + (bufoff) + ldsw + _i * 8192), 16, 0, 0); } while (0)
#define PG8_LDA(dst, b, h) do { _Pragma("unroll") for (int m = 0; m < 4; ++m) _Pragma("unroll") for (int k = 0; k < 2; ++k) dst[m][k] = *(const PG8_LAS bf16x8*)(lds + PG8_SA(b, h) + aoff + m * 2048 + k * 1024); } while (0)
#define PG8_LDB(dst, b, h) do { _Pragma("unroll") for (int n = 0; n < 2; ++n) _Pragma("unroll") for (int k = 0; k < 2; ++k) dst[n][k] = *(const PG8_LAS bf16x8*)(lds + PG8_SB(b, h) + boff + n * 2048 + k * 1024); } while (0)
#define PG8_MMA(ai, bj, At, Bt) do { __builtin_amdgcn_s_setprio(1); _Pragma("unroll") for (int m = 0; m < 4; ++m) _Pragma("unroll") for (int n = 0; n < 2; ++n) _Pragma("unroll") for (int k = 0; k < 2; ++k) \
        acc[ai][bj][m][n] = __builtin_amdgcn_mfma_f32_16x16x32_bf16(Bt[n][k], At[m][k], acc[ai][bj][m][n], 0, 0, 0); __builtin_amdgcn_s_setprio(0); } while (0)
#define PG8_WAIT_V(n) asm volatile("s_waitcnt vmcnt(" #n ")" ::: "memory")
#define PG8_WAIT_V8R(relax) do { if constexpr (Epi::NVM >= 16) asm volatile("s_cmp_lg_u32 %0, 0\n\ts_cbranch_scc1 .Lrx1_%=\n\ts_waitcnt vmcnt(8)\n\ts_branch .Lrx2_%=\n.Lrx1_%=:\n\ts_waitcnt vmcnt(24)\n.Lrx2_%=:" :: "s"(relax) : "memory", "scc"); \
        else if constexpr (Epi::NVM >= 8) asm volatile("s_cmp_lg_u32 %0, 0\n\ts_cbranch_scc1 .Lrx1_%=\n\ts_waitcnt vmcnt(8)\n\ts_branch .Lrx2_%=\n.Lrx1_%=:\n\ts_waitcnt vmcnt(16)\n.Lrx2_%=:" :: "s"(relax) : "memory", "scc"); \
        else asm volatile("s_waitcnt vmcnt(8)" ::: "memory"); } while (0)
#define PG8_WAIT_L(n) asm volatile("s_waitcnt lgkmcnt(" #n ")" ::: "memory")
#define PG8_BAR __builtin_amdgcn_s_barrier()
#define PG8_SCHED __builtin_amdgcn_sched_barrier(0)
    typename Sched::UnitT cur, nxt; int ui = 0;
    if (!S.next(0, cur)) return;
    f32x4 acc[2][2][4][2];
#pragma unroll
    for (int a = 0; a < 2; ++a)
#pragma unroll
        for (int b = 0; b < 2; ++b)
#pragma unroll
            for (int m = 0; m < 4; ++m)
#pragma unroll
                for (int n = 0; n < 2; ++n) acc[a][b][m][n] = (f32x4){0.f, 0.f, 0.f, 0.f};
    bf16x8 At[4][2], B0[2][2], B1[2][2];
    const char* cA = (const char*)g.A + (size_t)cur.pm * tstep; const char* cB = (const char*)g.Bt + (size_t)cur.pn * tstep;
    S.a_ready(cur);
    if constexpr (SP2) {
        PG8_STAGE(PG8_SB(0, 0), cB, voffB); PG8_STAGE(PG8_SB(0, 1), cB + hstep, voffB); PG8_STAGE(PG8_SA(0, 0), cA, voffA); PG8_STAGE(PG8_SA(0, 1), cA + hstep, voffA);
        if (wr == 1) PG8_BAR;
        PG8_WAIT_V(2); PG8_BAR;
        PG8_STAGE(PG8_SB(1, 0), cB + kstep, voffB); PG8_STAGE(PG8_SA(1, 0), cA + kstep, voffA); PG8_STAGE(PG8_SB(1, 1), cB + hstep + kstep, voffB);
        PG8_WAIT_V(6); PG8_BAR;
        PG8_STAGE(PG8_SA(1, 1), cA + kstep + hstep, voffA);
    } else {
        PG8_STAGE(PG8_SB(0, 0), cB, voffB); PG8_STAGE(PG8_SA(0, 0), cA, voffA); PG8_STAGE(PG8_SB(0, 1), cB + hstep, voffB); PG8_STAGE(PG8_SA(0, 1), cA + hstep, voffA);
        if (wr == 1) PG8_BAR;
        PG8_WAIT_V(4); PG8_BAR;
        PG8_STAGE(PG8_SB(1, 0), cB + kstep, voffB); PG8_STAGE(PG8_SA(1, 0), cA + kstep, voffA); PG8_STAGE(PG8_SB(1, 1), cB + hstep + kstep, voffB);
        PG8_WAIT_V(6); PG8_BAR;
    }
    for (;;) {
        const bool has_next = S.next(ui + 1, nxt);
        const char* nA = has_next ? (const char*)g.A + (size_t)nxt.pm * tstep : cA; const char* nB = has_next ? (const char*)g.Bt + (size_t)nxt.pn * tstep : cB;
        for (int t = 0; t < nt; t += 2) {
            const bool last = (t == nt - 2);
            const char* a1 = cA + (size_t)(t + 1) * kstep; (void)a1;
            const char* a2 = last ? nA : cA + (size_t)(t + 2) * kstep; const char* b2 = last ? nB : cB + (size_t)(t + 2) * kstep;
            const char* a3 = a2 + kstep; const char* b3 = b2 + kstep;
            if (last && has_next) S.a_ready(nxt);
            if constexpr (SP2) {
            const int relax = __builtin_amdgcn_readfirstlane(((t == 0) && (ui > 0)) ? 1 : 0);
            PG8_LDB(B0, 0, 0); PG8_LDB(B1, 0, 1); PG8_SCHED; PG8_LDA(At, 0, 0);
            PG8_WAIT_V8R(relax); PG8_WAIT_L(0); PG8_BAR; PG8_MMA(0, 0, At, B0); PG8_MMA(0, 1, At, B1); PG8_BAR; PG8_SCHED;
            PG8_LDA(At, 0, 1); PG8_STAGE(PG8_SB(0, 0), b2, voffB); PG8_STAGE(PG8_SB(0, 1), b2 + hstep, voffB); PG8_STAGE(PG8_SA(0, 0), a2, voffA);
            PG8_WAIT_V8R(relax); PG8_WAIT_L(0); PG8_BAR; PG8_MMA(1, 0, At, B0); PG8_MMA(1, 1, At, B1); PG8_BAR; PG8_SCHED;
            PG8_LDB(B0, 1, 0); PG8_LDB(B1, 1, 1); PG8_SCHED; PG8_LDA(At, 1, 0); PG8_STAGE(PG8_SA(0, 1), a2 + hstep, voffA);
            PG8_WAIT_V8R(relax); PG8_WAIT_L(0); PG8_BAR; PG8_MMA(0, 0, At, B0); PG8_MMA(0, 1, At, B1); PG8_BAR; PG8_SCHED;
            PG8_LDA(At, 1, 1); PG8_STAGE(PG8_SB(1, 0), b3, voffB); PG8_STAGE(PG8_SB(1, 1), b3 + hstep, voffB); PG8_STAGE(PG8_SA(1, 0), a3, voffA);
            PG8_WAIT_V(8); PG8_WAIT_L(0); PG8_BAR; PG8_MMA(1, 0, At, B0); PG8_MMA(1, 1, At, B1); PG8_BAR; PG8_SCHED;
            PG8_STAGE(PG8_SA(1, 1), a3 + hstep, voffA);
            } else {
            PG8_LDB(B0, 0, 0); PG8_SCHED; PG8_LDA(At, 0, 0); PG8_STAGE(PG8_SA(1, 1), a1 + hstep, voffA);
            PG8_WAIT_L(8); PG8_BAR; PG8_WAIT_L(0); PG8_MMA(0, 0, At, B0); PG8_BAR; PG8_SCHED;
            PG8_LDB(B1, 0, 1); PG8_STAGE(PG8_SB(0, 0), b2, voffB);
            PG8_BAR; PG8_WAIT_L(0); PG8_MMA(0, 1, At, B1); PG8_BAR;
            PG8_LDA(At, 0, 1); PG8_STAGE(PG8_SA(0, 0), a2, voffA);
            PG8_BAR; PG8_WAIT_L(0); PG8_MMA(1, 0, At, B0); PG8_BAR; PG8_SCHED;
            PG8_STAGE(PG8_SB(0, 1), b2 + hstep, voffB);
            PG8_WAIT_V(6); PG8_BAR; PG8_MMA(1, 1, At, B1); PG8_BAR;
            PG8_LDB(B0, 1, 0); PG8_SCHED; PG8_LDA(At, 1, 0); PG8_STAGE(PG8_SA(0, 1), a2 + hstep, voffA);
            PG8_WAIT_L(8); PG8_BAR; PG8_WAIT_L(0); PG8_MMA(0, 0, At, B0); PG8_BAR; PG8_SCHED;
            PG8_LDB(B1, 1, 1); PG8_STAGE(PG8_SB(1, 0), b3, voffB);
            PG8_BAR; PG8_WAIT_L(0); PG8_MMA(0, 1, At, B1); PG8_BAR;
            PG8_LDA(At, 1, 1); PG8_STAGE(PG8_SA(1, 0), a3, voffA);
            PG8_BAR; PG8_WAIT_L(0); PG8_MMA(1, 0, At, B0); PG8_BAR; PG8_SCHED;
            PG8_STAGE(PG8_SB(1, 1), b3 + hstep, voffB);
            PG8_WAIT_V(6); PG8_BAR; PG8_MMA(1, 1, At, B1); PG8_BAR;
            }
        }
        if constexpr (ALIGN_EPI) { if (wr == 0) PG8_BAR; }
        if constexpr (!Epi::AFTER_DRAIN) { E(acc, cur, wr, wc, fr, fq); S.done(cur); }
        if (!has_next) break;
#pragma unroll
        for (int a = 0; a < 2; ++a)
#pragma unroll
            for (int b = 0; b < 2; ++b)
#pragma unroll
                for (int m = 0; m < 4; ++m)
#pragma unroll
                    for (int n = 0; n < 2; ++n) acc[a][b][m][n] = (f32x4){0.f, 0.f, 0.f, 0.f};
        cur = nxt; cA = nA; cB = nB; ++ui;
        if constexpr (ALIGN_EPI) { if (wr == 1) PG8_BAR; }
    }
    PG8_WAIT_V(0);
    if constexpr (!ALIGN_EPI) { if (wr == 0) PG8_BAR; }
    PG8_BAR;
    if constexpr (Epi::AFTER_DRAIN) { E.fused(acc, cur, wr, wc, fr, fq, lds, wid, lane); S.done(cur); }
#undef PG8_SA
#undef PG8_SB
#undef PG8_STAGE
#undef PG8_LDA
#undef PG8_LDB
#undef PG8_MMA
#undef PG8_WAIT_V
#undef PG8_WAIT_V8R
#undef PG8_WAIT_L
#undef PG8_BAR
#undef PG8_SCHED
}


__device__ __forceinline__ float quad_sum(float v) {
    auto a = __builtin_amdgcn_permlane16_swap(__float_as_uint(v), __float_as_uint(v), false, false); v = __uint_as_float(a[0]) + __uint_as_float(a[1]);
    auto b = __builtin_amdgcn_permlane32_swap(__float_as_uint(v), __float_as_uint(v), false, false); return __uint_as_float(b[0]) + __uint_as_float(b[1]);
}
__device__ __forceinline__ float sq4(const f32x4& v) { return (v[0] * v[0] + v[1] * v[1]) + (v[2] * v[2] + v[3] * v[3]); }
__device__ __forceinline__ u32x4 pack8(const f32x4& a, const f32x4& b) { u32x4 o; o.x = cvt_pk_bf16(a[0], a[1]); o.y = cvt_pk_bf16(a[2], a[3]); o.z = cvt_pk_bf16(b[0], b[1]); o.w = cvt_pk_bf16(b[2], b[3]); return o; }
__device__ __forceinline__ void store_rows8(bf16_t* base, unsigned rowA, unsigned pitch, const u32x4& x0, const u32x4& x1) {
    u32x4 a, b;
#pragma unroll
    for (int c = 0; c < 4; ++c) { a[c] = (unsigned)__builtin_amdgcn_update_dpp((int)x0[c], (int)x1[c], 0x128, 0xF, 0xC, false); b[c] = (unsigned)__builtin_amdgcn_update_dpp((int)x1[c], (int)x0[c], 0x128, 0xF, 0x3, false); }
    *(u32x4*)(base + rowA * pitch) = a; *(u32x4*)(base + (rowA + 8u) * pitch) = b;
}
struct EpiQKV {
    static constexpr bool PERM = true, AFTER_DRAIN = false; static constexpr int NVM = 16;
    bf16_t* Q; bf16_t* K; bf16_t* V; const float* cosD; const float* sinD; const float* gq; const float* gk; float qscale; float eps;
    __device__ __forceinline__ void operator()(const f32x4 (&acc)[2][2][4][2], const Unit& u, int wr, int wc, int fr, int fq) const {
        asm volatile("" : "+v"(fr), "+v"(fq));
        const int tile = u.pn; const unsigned row0 = (unsigned)(u.pm * BM + wr * 64 + fr);
        if (tile >= 8) {
            bf16_t* vb = V + (tile - 8) * 256 + wc * 64 + 32 * (fr >> 3) + fq * 8; const unsigned rowA0 = (unsigned)(u.pm * BM + wr * 64 + (fr & 7));
#pragma unroll
            for (int ai = 0; ai < 2; ++ai)
#pragma unroll
                for (int m = 0; m < 4; ++m) store_rows8(vb, rowA0 + ai * HALF + m * 16, 1024u, pack8(acc[ai][0][m][0], acc[ai][0][m][1]), pack8(acc[ai][1][m][0], acc[ai][1][m][1]));
        } else {
            const bool isk = tile >= 4; const int hm = (tile & 3) * 4 + wc; bf16_t* dst = (isk ? K : Q) + hm * 64 + 32 * (fr >> 3) + 8 * fq; const unsigned rowA0 = (unsigned)(u.pm * BM + wr * 64 + (fr & 7)); const float* g = isk ? gk : gq; const float sc = isk ? 1.0f : qscale;
            const f32x4 g0a = *(const f32x4*)(g + 8 * fq), g0b = *(const f32x4*)(g + 8 * fq + 4), g1a = *(const f32x4*)(g + 32 + 8 * fq), g1b = *(const f32x4*)(g + 36 + 8 * fq);
            const float* cb = cosD + 8 * fq; const float* sb = sinD + 8 * fq;
#pragma unroll
            for (int ai = 0; ai < 2; ++ai)
#pragma unroll
                for (int m = 0; m < 4; ++m) {
                    const unsigned row = row0 + ai * HALF + m * 16;
                    const f32x4 c0 = *(const f32x4*)(cb + row * 32u), c1 = *(const f32x4*)(cb + row * 32u + 4), s0 = *(const f32x4*)(sb + row * 32u), s1 = *(const f32x4*)(sb + row * 32u + 4);
                    const f32x4 a0 = acc[ai][0][m][0], a1 = acc[ai][0][m][1], b0 = acc[ai][1][m][0], b1 = acc[ai][1][m][1];
                    const float ss = quad_sum((sq4(a0) + sq4(a1)) + (sq4(b0) + sq4(b1)));
                    const float rs = __builtin_amdgcn_rsqf(ss * (1.0f / 64.0f) + eps) * sc;
                    const f32x4 x1a = a0 * (g0a * rs), x1b = a1 * (g0b * rs), x2a = b0 * (g1a * rs), x2b = b1 * (g1b * rs);
                    store_rows8(dst, rowA0 + ai * HALF + m * 16, 1024u, pack8(x1a * c0 - x2a * s0, x1b * c1 - x2b * s1), pack8(x2a * c0 + x1a * s0, x2b * c1 + x1b * s1));
                }
        }
    }
};
template <bool XF32>
struct EpiResid {
    static constexpr bool PERM = true, AFTER_DRAIN = false; static constexpr int NVM = 16;
    const void* xin; bf16_t* xout; const float* gate; float* ssq;
    __device__ __forceinline__ void operator()(const f32x4 (&acc)[2][2][4][2], const Unit& u, int wr, int wc, int fr, int fq) const {
        asm volatile("" : "+v"(fr), "+v"(fq));
        const int b = (u.pm * BM) >> 11; const unsigned colb = (unsigned)(u.pn * BM + wc * 64 + 8 * fq); const unsigned row0 = (unsigned)(u.pm * BM + wr * 64 + fr);
        const float* gp = gate + (size_t)b * 6144 + colb;
        f32x4 g[2][2];
#pragma unroll
        for (int bj = 0; bj < 2; ++bj)
#pragma unroll
            for (int n = 0; n < 2; ++n) g[bj][n] = *(const f32x4*)(gp + bj * 32 + n * 4);
        bf16_t* xo = xout + u.pn * BM + wc * 64 + 32 * (fr >> 3) + 8 * fq; float* sq = ssq + u.pn * 4 + wc; const unsigned rowA0 = (unsigned)(u.pm * BM + wr * 64 + (fr & 7));
#pragma unroll
        for (int ai = 0; ai < 2; ++ai) {
            f32x4 xq[4][2][2];
#pragma unroll
            for (int m = 0; m < 4; ++m) { const unsigned off_ = (row0 + ai * HALF + m * 16) * 1024u + colb;
#pragma unroll
                for (int bj = 0; bj < 2; ++bj) {
                    if (XF32) { xq[m][bj][0] = *(const f32x4*)((const float*)xin + off_ + bj * 32); xq[m][bj][1] = *(const f32x4*)((const float*)xin + off_ + bj * 32 + 4); }
                    else { const u32x4 w = *(const u32x4*)((const bf16_t*)xin + off_ + bj * 32);
                        xq[m][bj][0] = (f32x4){__uint_as_float(w.x << 16), __uint_as_float(w.x & 0xffff0000u), __uint_as_float(w.y << 16), __uint_as_float(w.y & 0xffff0000u)};
                        xq[m][bj][1] = (f32x4){__uint_as_float(w.z << 16), __uint_as_float(w.z & 0xffff0000u), __uint_as_float(w.w << 16), __uint_as_float(w.w & 0xffff0000u)}; } } }
#pragma unroll
            for (int m = 0; m < 4; ++m) {
                const unsigned row = row0 + ai * HALF + m * 16; float ss = 0.f; u32x4 pk[2];
#pragma unroll
                for (int bj = 0; bj < 2; ++bj) { const f32x4 v0 = xq[m][bj][0] + g[bj][0] * acc[ai][bj][m][0], v1 = xq[m][bj][1] + g[bj][1] * acc[ai][bj][m][1];
                    pk[bj] = pack8(v0, v1); ss += sq4(v0) + sq4(v1); }
                store_rows8(xo, rowA0 + ai * HALF + m * 16, 1024u, pk[0], pk[1]);
                ss = quad_sum(ss);
                if (fq == 0) sq[row * 16u] = ss;
            }
        }
    }
};
struct EpiWin {
    static constexpr bool PERM = true, AFTER_DRAIN = false; static constexpr int NVM = 0;
    bf16_t* CQ; bf16_t* CKV; bf16_t* KPE; float* ssq; const float* cosM; const float* sinM; const float* gkpe; float eps;
    __device__ __forceinline__ void operator()(const f32x4 (&acc)[2][2][4][2], const Unit& u, int wr, int wc, int fr, int fq) const {
        asm volatile("" : "+v"(fr), "+v"(fq));
        const int ws = u.pn * 4 + wc; const unsigned row0 = (unsigned)(u.pm * BM + wr * 64 + fr);
        if (ws < 10) {
            bf16_t* dst = ((ws < 6) ? CQ + 64 * ws : CKV + 64 * (ws - 6)) + 32 * (fr >> 3) + 8 * fq; const unsigned ld = (ws < 6) ? 384u : 256u; float* sq = ssq + ws; const unsigned rowA0 = (unsigned)(u.pm * BM + wr * 64 + (fr & 7));
#pragma unroll
            for (int ai = 0; ai < 2; ++ai)
#pragma unroll
                for (int m = 0; m < 4; ++m) {
                    const unsigned row = row0 + ai * HALF + m * 16;
                    const f32x4 a0 = acc[ai][0][m][0], a1 = acc[ai][0][m][1], b0 = acc[ai][1][m][0], b1 = acc[ai][1][m][1];
                    store_rows8(dst, rowA0 + ai * HALF + m * 16, ld, pack8(a0, a1), pack8(b0, b1));
                    const float ss = quad_sum((sq4(a0) + sq4(a1)) + (sq4(b0) + sq4(b1)));
                    if (fq == 0) sq[row * 16u] = ss;
                }
        } else if (ws == 10) {
            const f32x4 g0 = *(const f32x4*)(gkpe + 4 * fq), g1 = *(const f32x4*)(gkpe + 16 + 4 * fq);
#pragma unroll
            for (int ai = 0; ai < 2; ++ai)
#pragma unroll
                for (int m = 0; m < 4; ++m) {
                    const unsigned row = row0 + ai * HALF + m * 16;
                    const f32x4 c = *(const f32x4*)(cosM + row * 16u + 4 * fq), sn = *(const f32x4*)(sinM + row * 16u + 4 * fq);
                    const f32x4 y0 = acc[ai][0][m][0], y1 = acc[ai][0][m][1];
                    const float rs = __builtin_amdgcn_rsqf(quad_sum(sq4(y0) + sq4(y1)) * (1.0f / 32.0f) + eps);
                    const f32x4 x1 = y0 * (g0 * rs), x2 = y1 * (g1 * rs);
                    *(u32x4*)(KPE + row * 32u + 8 * fq) = pack8(x1 * c - x2 * sn, x2 * c + x1 * sn);
                }
        }
    }
};
struct EpiUQ {
    static constexpr bool PERM = true, AFTER_DRAIN = false; static constexpr int NVM = 16;
    bf16_t* Q2; const float* ssq; const float* cosM; const float* sinM; const float* gqn; const float* gqp; float qscale; float eps;
    __device__ __forceinline__ void operator()(const f32x4 (&acc)[2][2][4][2], const Unit& u, int wr, int wc, int fr, int fq) const {
        asm volatile("" : "+v"(fr), "+v"(fq));
        const int tile = u.pn; const unsigned row0 = (unsigned)(u.pm * BM + wr * 64 + fr);
        if (tile < 4) {
            bf16_t* dst = Q2 + (tile * 4 + wc) * 64 + 32 * (fr >> 3) + 8 * fq; const unsigned rowA0 = (unsigned)(u.pm * BM + wr * 64 + (fr & 7));
            const f32x4 g0a = *(const f32x4*)(gqn + 8 * fq) * qscale, g0b = *(const f32x4*)(gqn + 8 * fq + 4) * qscale, g1a = *(const f32x4*)(gqn + 32 + 8 * fq) * qscale, g1b = *(const f32x4*)(gqn + 36 + 8 * fq) * qscale;
#pragma unroll
            for (int ai = 0; ai < 2; ++ai) {
                f32x4 sA[4], sB[4];
#pragma unroll
                for (int m = 0; m < 4; ++m) { const unsigned row = row0 + ai * HALF + m * 16; sA[m] = *(const f32x4*)(ssq + row * 16u); sB[m] = *(const f32x4*)(ssq + row * 16u + 4); }
#pragma unroll
                for (int m = 0; m < 4; ++m) {
                    const unsigned row = row0 + ai * HALF + m * 16;
                    const f32x4 a0 = acc[ai][0][m][0], a1 = acc[ai][0][m][1], b0 = acc[ai][1][m][0], b1 = acc[ai][1][m][1];
                    const float ss = quad_sum((sq4(a0) + sq4(a1)) + (sq4(b0) + sq4(b1)));
                    const float em = eps * ((((sA[m][0] + sA[m][1]) + (sA[m][2] + sA[m][3])) + (sB[m][0] + sB[m][1])) * (1.0f / 384.0f) + eps);
                    const float rn = __builtin_amdgcn_rsqf(ss * (1.0f / 64.0f) + em);
                    store_rows8(dst, rowA0 + ai * HALF + m * 16, 1536u, pack8(a0 * (g0a * rn), a1 * (g0b * rn)), pack8(b0 * (g1a * rn), b1 * (g1b * rn)));
                }
            }
        } else {
            const f32x4 g0 = *(const f32x4*)(gqp + 4 * fq) * qscale, g1 = *(const f32x4*)(gqp + 16 + 4 * fq) * qscale;
            bf16_t* dst = Q2 + 1024 + ((tile - 4) * 4 + wc) * 64 + 32 * (fr >> 3) + 8 * fq; const unsigned rowA0 = (unsigned)(u.pm * BM + wr * 64 + (fr & 7));
#pragma unroll
            for (int ai = 0; ai < 2; ++ai) {
                f32x4 sA[4], sB[4], cc[4], sn[4];
#pragma unroll
                for (int m = 0; m < 4; ++m) { const unsigned row = row0 + ai * HALF + m * 16; sA[m] = *(const f32x4*)(ssq + row * 16u); sB[m] = *(const f32x4*)(ssq + row * 16u + 4);
                    cc[m] = *(const f32x4*)(cosM + row * 16u + 4 * fq); sn[m] = *(const f32x4*)(sinM + row * 16u + 4 * fq); }
#pragma unroll
                for (int m = 0; m < 4; ++m) {
                    const unsigned row = row0 + ai * HALF + m * 16;
                    const float em = eps * ((((sA[m][0] + sA[m][1]) + (sA[m][2] + sA[m][3])) + (sB[m][0] + sB[m][1])) * (1.0f / 384.0f) + eps);
                    u32x4 pk[2];
#pragma unroll
                    for (int bj = 0; bj < 2; ++bj) {
                        const f32x4 y0 = acc[ai][bj][m][0], y1 = acc[ai][bj][m][1];
                        const float rn = __builtin_amdgcn_rsqf(quad_sum(sq4(y0) + sq4(y1)) * (1.0f / 32.0f) + em);
                        const f32x4 x1 = y0 * (g0 * rn), x2 = y1 * (g1 * rn);
                        pk[bj] = pack8(x1 * cc[m] - x2 * sn[m], x2 * cc[m] + x1 * sn[m]);
                    }
                    store_rows8(dst, rowA0 + ai * HALF + m * 16, 1536u, pk[0], pk[1]);
                }
            }
        }
    }
};
struct EpiUKV {
    static constexpr bool PERM = true, AFTER_DRAIN = false; static constexpr int NVM = 16;
    bf16_t* KV2; const float* ssq; const float* gkn; float eps;
    __device__ __forceinline__ void operator()(const f32x4 (&acc)[2][2][4][2], const Unit& u, int wr, int wc, int fr, int fq) const {
        asm volatile("" : "+v"(fr), "+v"(fq));
        const int tile = u.pn, head = (tile & 3) * 4 + wc; const unsigned row0 = (unsigned)(u.pm * BM + wr * 64 + fr), rowA0 = (unsigned)(u.pm * BM + wr * 64 + (fr & 7)); const int hcol = 32 * (fr >> 3) + 8 * fq;
        f32x4 sB[2][4], sC[2][4];
#pragma unroll
        for (int ai = 0; ai < 2; ++ai)
#pragma unroll
            for (int m = 0; m < 4; ++m) { const unsigned row = row0 + ai * HALF + m * 16; sB[ai][m] = *(const f32x4*)(ssq + row * 16u + 4); sC[ai][m] = *(const f32x4*)(ssq + row * 16u + 8); }
        if (tile < 4) {
            bf16_t* dst = KV2 + head * 128 + hcol;
            const f32x4 g0a = *(const f32x4*)(gkn + 8 * fq), g0b = *(const f32x4*)(gkn + 8 * fq + 4), g1a = *(const f32x4*)(gkn + 32 + 8 * fq), g1b = *(const f32x4*)(gkn + 36 + 8 * fq);
#pragma unroll
            for (int ai = 0; ai < 2; ++ai)
#pragma unroll
                for (int m = 0; m < 4; ++m) {
                    const unsigned row = row0 + ai * HALF + m * 16;
                    const f32x4 a0 = acc[ai][0][m][0], a1 = acc[ai][0][m][1], b0 = acc[ai][1][m][0], b1 = acc[ai][1][m][1];
                    const float ss = quad_sum((sq4(a0) + sq4(a1)) + (sq4(b0) + sq4(b1)));
                    const float msq = ((sB[ai][m][2] + sB[ai][m][3]) + (sC[ai][m][0] + sC[ai][m][1])) * (1.0f / 256.0f) + eps;
                    const float rn = __builtin_amdgcn_rsqf(ss * (1.0f / 64.0f) + eps * msq);
                    store_rows8(dst, rowA0 + ai * HALF + m * 16, 2048u, pack8(a0 * (g0a * rn), a1 * (g0b * rn)), pack8(b0 * (g1a * rn), b1 * (g1b * rn)));
                }
        } else {
            bf16_t* dst = KV2 + head * 128 + 64 + hcol;
#pragma unroll
            for (int ai = 0; ai < 2; ++ai)
#pragma unroll
                for (int m = 0; m < 4; ++m) {
                    const unsigned row = row0 + ai * HALF + m * 16;
                    const float rsq = __builtin_amdgcn_rsqf(((sB[ai][m][2] + sB[ai][m][3]) + (sC[ai][m][0] + sC[ai][m][1])) * (1.0f / 256.0f) + eps);
                    store_rows8(dst, rowA0 + ai * HALF + m * 16, 2048u, pack8(acc[ai][0][m][0] * rsq, acc[ai][0][m][1] * rsq), pack8(acc[ai][1][m][0] * rsq, acc[ai][1][m][1] * rsq));
                }
        }
    }
};

struct MUnit { int pm, pn, e, r0; };
struct MoeOrder {
    typedef MUnit UnitT;
    const int* tpre; int ncol, G, c, total;
    __device__ __forceinline__ bool next(int i, MUnit& u) const {
        const int L = i * G + c; if (L >= total) return false;
        const int rt = L / ncol, ct = L - rt * ncol; const int e = tpre[33 + rt];
        u.e = e; u.pm = rt; u.r0 = (rt - tpre[e]) * 256; u.pn = e * ncol + ct; return true;
    }
    __device__ __forceinline__ void a_ready(const MUnit&) const {}
    __device__ __forceinline__ void done(const MUnit&) const {}
};
__device__ __forceinline__ float silu_f(float a) { return a * __builtin_amdgcn_rcpf(1.0f + __builtin_amdgcn_exp2f(-1.4426950408889634f * a)); }
struct EpiMoe1 {
    static constexpr bool PERM = true, AFTER_DRAIN = false; static constexpr int NVM = 0;
    bf16_t* hid; const int* glist; const float* tokw; const int* cntl; int ntok;
    __device__ __forceinline__ void operator()(const f32x4 (&acc)[2][2][4][2], const MUnit& u, int wr, int wc, int fr, int fq) const {
        const int cnt = cntl[u.e], t = u.pn & 1;
        asm volatile("" : "+v"(fr), "+v"(fq));
        float wrow[2][4];
#pragma unroll
        for (int ai = 0; ai < 2; ++ai)
#pragma unroll
            for (int m = 0; m < 4; ++m) { const int r = u.r0 + ai * HALF + wr * 64 + m * 16 + fr; const float w_ = tokw[(unsigned)(u.e * ntok + (r < cnt ? r : 0))]; wrow[ai][m] = (r < cnt) ? w_ : 0.f; }
#pragma unroll
        for (int ai = 0; ai < 2; ++ai)
#pragma unroll
            for (int m = 0; m < 4; ++m) {
                const int rl = ai * HALF + wr * 64 + m * 16 + fr; const float w = wrow[ai][m];
                const f32x4 a0 = acc[ai][0][m][0], a1 = acc[ai][0][m][1], b0 = acc[ai][1][m][0], b1 = acc[ai][1][m][1];
                u32x4 o;
                o.x = cvt_pk_bf16(silu_f(a0[0]) * b0[0] * w, silu_f(a0[1]) * b0[1] * w); o.y = cvt_pk_bf16(silu_f(a0[2]) * b0[2] * w, silu_f(a0[3]) * b0[3] * w);
                o.z = cvt_pk_bf16(silu_f(a1[0]) * b1[0] * w, silu_f(a1[1]) * b1[1] * w); o.w = cvt_pk_bf16(silu_f(a1[2]) * b1[2] * w, silu_f(a1[3]) * b1[3] * w);
                *(u32x4*)(hid + ((size_t)u.pm * BM + rl) * 256 + t * 128 + wc * 32 + fq * 8) = o;
                asm volatile("" ::: "memory");
            }
    }
};
struct EpiMoe2 {
    static constexpr bool PERM = true, AFTER_DRAIN = false; static constexpr int NVM = 8;
    unsigned char* y2; const int* glist; const int* cntl; int ntok;
    __device__ __forceinline__ void operator()(const f32x4 (&acc)[2][2][4][2], const MUnit& u, int wr, int wc, int fr, int fq) const {
        const int cnt = cntl[u.e], ct = u.pn & 3;
        asm volatile("" : "+v"(fr), "+v"(fq));
        int ents[2][4];
#pragma unroll
        for (int ai = 0; ai < 2; ++ai)
#pragma unroll
            for (int m = 0; m < 4; ++m) { const int r = u.r0 + ai * HALF + wr * 64 + m * 16 + fr; const int e_ = glist[(unsigned)(u.e * ntok + (r < cnt ? r : 0))]; ents[ai][m] = (r < cnt) ? e_ : 2 * ntok; }
#pragma unroll
        for (int ai = 0; ai < 2; ++ai)
#pragma unroll
            for (int m = 0; m < 4; ++m) {
                unsigned char* rowp = y2 + (size_t)(unsigned)ents[ai][m] * 1024 + ct * 256 + wc * 64 + fq * 16;
                unsigned q[2][2];
#pragma unroll
                for (int bj = 0; bj < 2; ++bj) { const f32x4 v0 = acc[ai][bj][m][0] * 32.0f, v1 = acc[ai][bj][m][1] * 32.0f;
                    int p = __builtin_amdgcn_cvt_pk_fp8_f32(v0[0], v0[1], 0, false); p = __builtin_amdgcn_cvt_pk_fp8_f32(v0[2], v0[3], p, true); q[bj][0] = (unsigned)p;
                    p = __builtin_amdgcn_cvt_pk_fp8_f32(v1[0], v1[1], 0, false); p = __builtin_amdgcn_cvt_pk_fp8_f32(v1[2], v1[3], p, true); q[bj][1] = (unsigned)p; }
#pragma unroll
                for (int d = 0; d < 2; ++d) { auto s1 = __builtin_amdgcn_permlane32_swap(q[0][d], q[1][d], false, false); auto s2 = __builtin_amdgcn_permlane16_swap(s1[0], s1[1], false, false); q[0][d] = s2[0]; q[1][d] = s2[1]; }
                *(u32x4*)rowp = (u32x4){q[0][0], q[0][1], q[1][0], q[1][1]};
                asm volatile("" ::: "memory");
            }
    }
};
template <class Epi, class Sched, bool FP8 = false>
__device__ __forceinline__ void gemm_phase_gather(PG8_LAS unsigned char* lds, const bf16_t* A, const bf16_t* Bt, int K, const int* glist, int ntok, const int* cntl, const Sched& S, const Epi& E) {
    int tid_ = threadIdx.x; asm volatile("" : "+v"(tid_));
    const int tid = tid_, wid = __builtin_amdgcn_readfirstlane(tid >> 6), lane = tid & 63, wr = wid >> 2, wc = wid & 3, fr = lane & 15, fq = lane >> 4;
    const int rowb = FP8 ? K : 2 * K, nt = FP8 ? K / (2 * BK) : K / BK;
    unsigned voffB[2];
#pragma unroll
    for (int i = 0; i < 2; ++i) { int R, C; stage_rc(tid * 16 + i * 8192, R, C); const int Rb = Epi::PERM ? ((R & ~31) + perm32(R & 31)) : R;
        voffB[i] = (unsigned)(Rb * rowb + C * 2); }
    const size_t kstep = (size_t)(BK * 2);
    const size_t hstep = (size_t)HALF * rowb;
    const size_t tstep = 2 * hstep;
    const unsigned ldsw = (unsigned)wid * 1024u;
    const int aoff = lds_byte(wr * 64 + fr, fq * 8), boff = lds_byte(wc * 32 + fr, fq * 8);
#define PG8_SA(b, h) (((b) * 2 + (h)) * HTB)
#define PG8_SB(b, h) ((4 + (b) * 2 + (h)) * HTB)
#define PG8_STAGE(bufoff, gbase, voff) do { _Pragma("unroll") for (int _i = 0; _i < 2; ++_i) \
        __builtin_amdgcn_global_load_lds((const unsigned*)((const char*)(gbase) + (voff)[_i]), (PG8_LAS unsigned*)(lds + (bufoff) + ldsw + _i * 8192), 16, 0, 0); } while (0)
    typedef int i32x4_ __attribute__((ext_vector_type(4))); typedef int i32x8_ __attribute__((ext_vector_type(8)));
#define PG8_LDA(dst, b, h) do { _Pragma("unroll") for (int m = 0; m < 4; ++m) { if constexpr (FP8) { const i32x4_ l0_ = *(const PG8_LAS i32x4_*)(lds + PG8_SA(b, h) + aoff + m * 2048), l1_ = *(const PG8_LAS i32x4_*)(lds + PG8_SA(b, h) + aoff + m * 2048 + 1024); \
            dst##8[m] = __builtin_shufflevector(l0_, l1_, 0, 1, 2, 3, 4, 5, 6, 7); } else { _Pragma("unroll") for (int k = 0; k < 2; ++k) dst[m][k] = *(const PG8_LAS bf16x8*)(lds + PG8_SA(b, h) + aoff + m * 2048 + k * 1024); } } } while (0)
#define PG8_LDB(dst, b, h) do { _Pragma("unroll") for (int n = 0; n < 2; ++n) { if constexpr (FP8) { const i32x4_ l0_ = *(const PG8_LAS i32x4_*)(lds + PG8_SB(b, h) + boff + n * 2048), l1_ = *(const PG8_LAS i32x4_*)(lds + PG8_SB(b, h) + boff + n * 2048 + 1024); \
            dst##8[n] = __builtin_shufflevector(l0_, l1_, 0, 1, 2, 3, 4, 5, 6, 7); } else { _Pragma("unroll") for (int k = 0; k < 2; ++k) dst[n][k] = *(const PG8_LAS bf16x8*)(lds + PG8_SB(b, h) + boff + n * 2048 + k * 1024); } } } while (0)
#define PG8_MMA(ai, bj, At, Bt) do { __builtin_amdgcn_s_setprio(1); _Pragma("unroll") for (int m = 0; m < 4; ++m) _Pragma("unroll") for (int n = 0; n < 2; ++n) { \
        if constexpr (FP8) acc[ai][bj][m][n] = __builtin_amdgcn_mfma_scale_f32_16x16x128_f8f6f4(Bt##8[n], At##8[m], acc[ai][bj][m][n], 0, 0, 0, 0x7a7a7a7a, 0, 0x7f7f7f7f); \
        else { _Pragma("unroll") for (int k = 0; k < 2; ++k) acc[ai][bj][m][n] = __builtin_amdgcn_mfma_f32_16x16x32_bf16(Bt[n][k], At[m][k], acc[ai][bj][m][n], 0, 0, 0); } } \
        __builtin_amdgcn_s_setprio(0); } while (0)
#define PG8_WAIT_V(n) asm volatile("s_waitcnt vmcnt(" #n ")" ::: "memory")
#define PG8_WAIT_L(n) asm volatile("s_waitcnt lgkmcnt(" #n ")" ::: "memory")
#define PG8_BAR __builtin_amdgcn_s_barrier()
#define PG8_SCHED __builtin_amdgcn_sched_barrier(0)
#define PG8_GOFF(u, off) do { const int _cnt = cntl[(u).e]; _Pragma("unroll") for (int _h = 0; _h < 2; ++_h) _Pragma("unroll") for (int _i = 0; _i < 2; ++_i) { \
        int _R, _C; stage_rc(tid * 16 + _i * 8192, _R, _C); const int _r = (u).r0 + _h * HALF + _R; const int _ent = glist[(unsigned)((u).e * ntok + (_r < _cnt ? _r : 0))]; \
        off[_h][_i] = (unsigned)(_ent >> 1) * (unsigned)rowb + (unsigned)(_C * 2); } } while (0)
    typename Sched::UnitT cur, nxt; int ui = 0;
    if (!S.next(0, cur)) return;
    f32x4 acc[2][2][4][2];
#pragma unroll
    for (int a = 0; a < 2; ++a)
#pragma unroll
        for (int b = 0; b < 2; ++b)
#pragma unroll
            for (int m = 0; m < 4; ++m)
#pragma unroll
                for (int n = 0; n < 2; ++n) acc[a][b][m][n] = (f32x4){0.f, 0.f, 0.f, 0.f};
    bf16x8 At[4][2], B0[2][2], B1[2][2]; i32x8_ At8[4], B08[2], B18[2];
    unsigned coff[2][2], noff[2][2];
    PG8_GOFF(cur, coff);
    const char* cA = (const char*)A; const char* cB = (const char*)Bt + (size_t)cur.pn * tstep;
    PG8_STAGE(PG8_SB(0, 0), cB, voffB); PG8_STAGE(PG8_SB(0, 1), cB + hstep, voffB); PG8_STAGE(PG8_SA(0, 0), cA, coff[0]); PG8_STAGE(PG8_SA(0, 1), cA, coff[1]);
    if (wr == 1) PG8_BAR;
    PG8_WAIT_V(2); PG8_BAR;
    PG8_STAGE(PG8_SB(1, 0), cB + kstep, voffB); PG8_STAGE(PG8_SA(1, 0), cA + kstep, coff[0]); PG8_STAGE(PG8_SB(1, 1), cB + hstep + kstep, voffB);
    PG8_WAIT_V(6); PG8_BAR;
    for (;;) {
        const bool has_next = S.next(ui + 1, nxt);
        if (has_next) { PG8_GOFF(nxt, noff); } else {
#pragma unroll
            for (int h = 0; h < 2; ++h)
#pragma unroll
                for (int i = 0; i < 2; ++i) noff[h][i] = coff[h][i]; }
        const char* nB = has_next ? (const char*)Bt + (size_t)nxt.pn * tstep : cB;
        for (int t = 0; t < nt; t += 2) {
            const bool last = (t == nt - 2);
            const char* a1 = cA + (size_t)(t + 1) * kstep;
            const char* a2 = last ? cA : cA + (size_t)(t + 2) * kstep; const char* b2 = last ? nB : cB + (size_t)(t + 2) * kstep;
            const char* a3 = a2 + kstep; const char* b3 = b2 + kstep;
            PG8_LDB(B0, 0, 0); PG8_LDB(B1, 0, 1); PG8_SCHED; PG8_LDA(At, 0, 0); PG8_STAGE(PG8_SA(1, 1), a1, coff[1]);
            if (last) {
#pragma unroll
                for (int h = 0; h < 2; ++h)
#pragma unroll
                    for (int i = 0; i < 2; ++i) coff[h][i] = noff[h][i]; }
            PG8_WAIT_V(8); PG8_WAIT_L(0); PG8_BAR; PG8_MMA(0, 0, At, B0); PG8_MMA(0, 1, At, B1); PG8_BAR; PG8_SCHED;
            PG8_LDA(At, 0, 1); PG8_STAGE(PG8_SB(0, 0), b2, voffB); PG8_STAGE(PG8_SB(0, 1), b2 + hstep, voffB); PG8_STAGE(PG8_SA(0, 0), a2, coff[0]);
            PG8_WAIT_V(8); PG8_WAIT_L(0); PG8_BAR; PG8_MMA(1, 0, At, B0); PG8_MMA(1, 1, At, B1); PG8_BAR; PG8_SCHED;
            PG8_LDB(B0, 1, 0); PG8_LDB(B1, 1, 1); PG8_SCHED; PG8_LDA(At, 1, 0); PG8_STAGE(PG8_SA(0, 1), a2, coff[1]);
            PG8_WAIT_V(8); PG8_WAIT_L(0); PG8_BAR; PG8_MMA(0, 0, At, B0); PG8_MMA(0, 1, At, B1); PG8_BAR; PG8_SCHED;
            PG8_LDA(At, 1, 1); PG8_STAGE(PG8_SB(1, 0), b3, voffB); PG8_STAGE(PG8_SB(1, 1), b3 + hstep, voffB); PG8_STAGE(PG8_SA(1, 0), a3, coff[0]);
            PG8_WAIT_V(8); PG8_WAIT_L(0); PG8_BAR; PG8_MMA(1, 0, At, B0); PG8_MMA(1, 1, At, B1); PG8_BAR; PG8_SCHED;
        }
        if (wr == 0) PG8_BAR;
        E(acc, cur, wr, wc, fr, fq);
        if (!has_next) break;
#pragma unroll
        for (int a = 0; a < 2; ++a)
#pragma unroll
            for (int b = 0; b < 2; ++b)
#pragma unroll
                for (int m = 0; m < 4; ++m)
#pragma unroll
                    for (int n = 0; n < 2; ++n) acc[a][b][m][n] = (f32x4){0.f, 0.f, 0.f, 0.f};
        cur = nxt; cB = nB; ++ui;
        if (wr == 1) PG8_BAR;
    }
    PG8_WAIT_V(0);
    PG8_BAR;
#undef PG8_SA
#undef PG8_SB
#undef PG8_STAGE
#undef PG8_LDA
#undef PG8_LDB
#undef PG8_MMA
#undef PG8_WAIT_V
#undef PG8_WAIT_L
#undef PG8_BAR
#undef PG8_SCHED
#undef PG8_GOFF
}
}

#define PG8_SP2 true
#define PG8_ALIGN true

struct Args { const float* in[33]; float* out; unsigned char* ws; int ph_lo, ph_hi; };
enum { I_X = 0, I_C, I_POS, I_ADAW, I_ADAB, I_NMIX, I_NFFN, I_DA_WQKV, I_DA_QN, I_DA_KN, I_DA_LQ1, I_DA_LK1, I_DA_LQ2, I_DA_LK2,
       I_DA_SUBLN, I_DA_WO, I_M_WIN, I_M_QAN, I_M_KVAN, I_M_WUQ, I_M_WUKV, I_M_QNN, I_M_QPN, I_M_KNN, I_M_KPN, I_M_WO,
       I_E_WG, I_E_BG, I_E_WR, I_E_BR, I_E_W1, I_E_W3, I_E_W2 };

struct Ctx {
    const float* const* in; float* out; unsigned char* ws; unsigned char* lds;
    int tid, lane, wave, gw, ngw;
    __device__ __forceinline__ const float* mod(int layer, int b, int chunk) const { return (const float*)(ws + WS_MOD) + ((size_t)(layer * NB + b) * 6144 + chunk * 1024); }
};

__device__ __forceinline__ void normmod_row(const f32x4 (&v)[4], f32x4 (&h)[4], const float* g, const float* sh, const float* sc, int lane) {
    float s = 0.f;
#pragma unroll
    for (int j = 0; j < 4; ++j) s += (v[j].x * v[j].x + v[j].y * v[j].y) + (v[j].z * v[j].z + v[j].w * v[j].w);
    const float rstd = 1.0f / sqrtf(wave_sum(s) * (1.0f / D) + EPS);
#pragma unroll
    for (int j = 0; j < 4; ++j) {
        const f32x4 gg = *(const f32x4*)(g + 4 * lane + 256 * j), ss = *(const f32x4*)(sh + 4 * lane + 256 * j), cc = *(const f32x4*)(sc + 4 * lane + 256 * j);
        h[j] = (v[j] * rstd) * gg * (cc + 1.0f) + ss;
    }
}
__device__ __forceinline__ void store_row_bf16(bf16* row, const f32x4 (&h)[4], int lane) {
#pragma unroll
    for (int j = 0; j < 4; ++j) { u32x2 o; o.x = pk2(h[j].x, h[j].y); o.y = pk2(h[j].z, h[j].w); *(u32x2*)(row + 4 * lane + 256 * j) = o; }
}
__device__ __forceinline__ void load_row_fp8(const unsigned char* row, f32x4 (&h)[4], int lane) {
#pragma unroll
    for (int j = 0; j < 4; ++j) { const int w = *(const int*)(row + 4 * lane + 256 * j); const auto lo = __builtin_amdgcn_cvt_pk_f32_fp8(w, false), hi = __builtin_amdgcn_cvt_pk_f32_fp8(w, true);
        h[j] = (f32x4){lo[0], lo[1], hi[0], hi[1]} * 0.03125f; }
}
__device__ __forceinline__ void load_row_bf16(const bf16* row, f32x4 (&h)[4], int lane) {
#pragma unroll
    for (int j = 0; j < 4; ++j) { const u32x2 o = *(const u32x2*)(row + 4 * lane + 256 * j);
        h[j] = (f32x4){bf2f(o.x & 0xffffu), bf2f(o.x >> 16), bf2f(o.y & 0xffffu), bf2f(o.y >> 16)}; }
}


struct TItem { const float* src; bf16* dst; const float* kg; int ldw, K, perm, f8; };
__device__ __forceinline__ void titem_load(const TItem& t, f32x4 (&v)[8], int lane) {
    const float* p = t.src + (size_t)(lane >> 3) * t.ldw + 4 * (lane & 7);
#pragma unroll
    for (int i = 0; i < 8; ++i) v[i] = *(const f32x4*)(p + (size_t)(8 * i) * t.ldw);
}
__device__ __forceinline__ void titem_finish(const TItem& t, const f32x4 (&v)[8], float* scr, int lane) {
    const int rr = lane >> 3, c4 = lane & 7;
#pragma unroll
    for (int i = 0; i < 8; ++i) { f32x4 x = v[i]; if (t.kg) x = x * t.kg[8 * i + rr]; float* d = scr + (8 * i + rr) * 33 + 4 * c4; d[0] = x[0]; d[1] = x[1]; d[2] = x[2]; d[3] = x[3]; }
    asm volatile("s_waitcnt lgkmcnt(0)" ::: "memory");
    const int c = lane & 7;
#pragma unroll
    for (int j = 0; j < 4; ++j) { const int n = (lane >> 3) + 8 * j; const int nl = t.perm ? (16 * ((n >> 2) & 1) + 4 * (n >> 3) + (n & 3)) : n;
        const float* sp = scr + (8 * c) * 33 + nl;
        if (t.f8) { int p0 = __builtin_amdgcn_cvt_pk_fp8_f32(sp[0 * 33] * 32.0f, sp[1 * 33] * 32.0f, 0, false); p0 = __builtin_amdgcn_cvt_pk_fp8_f32(sp[2 * 33] * 32.0f, sp[3 * 33] * 32.0f, p0, true);
            int p1 = __builtin_amdgcn_cvt_pk_fp8_f32(sp[4 * 33] * 32.0f, sp[5 * 33] * 32.0f, 0, false); p1 = __builtin_amdgcn_cvt_pk_fp8_f32(sp[6 * 33] * 32.0f, sp[7 * 33] * 32.0f, p1, true);
            u32x2 o; o.x = (unsigned)p0; o.y = (unsigned)p1; *(u32x2*)((unsigned char*)t.dst + (size_t)n * t.K + 8 * c) = o; }
        else { u32x4 o; o.x = pk2(sp[0 * 33], sp[1 * 33]); o.y = pk2(sp[2 * 33], sp[3 * 33]); o.z = pk2(sp[4 * 33], sp[5 * 33]); o.w = pk2(sp[6 * 33], sp[7 * 33]);
            *(u32x4*)(t.dst + (size_t)n * t.K + 8 * c) = o; } }
    asm volatile("s_waitcnt lgkmcnt(0)" ::: "memory");
}
__device__ __forceinline__ TItem titem_make(const float* W, int ldw, int K, bf16* WT, int k0, int n0, int prow0, const float* kgain, bool perm) {
    TItem t; t.src = W + (size_t)k0 * ldw + n0; t.dst = WT + (size_t)prow0 * K + k0; t.kg = kgain ? kgain + k0 : nullptr; t.ldw = ldw; t.K = K; t.perm = perm ? 1 : 0; t.f8 = 0; return t;
}
constexpr int TI_QKV = 16 * 96, TI_O = 16 * 32, TI_WIN = 16 * 21, TI_UQ = 6 * 48, TI_UKV = 4 * 64, TI_DENSE = TI_QKV + 2 * TI_O + TI_WIN + TI_UQ + TI_UKV, TI_ALL = TI_DENSE + 24576;
__device__ __forceinline__ TItem titem_decode(const Ctx& C, int it) {
    int r = it;
    if (r < TI_QKV) { const int kb = r / 96, lb = r % 96; int pb = lb;
        if (lb < 64) { const int sect = lb >> 5, hm = (lb & 31) >> 1, half = lb & 1; pb = (sect * 4 + (hm >> 2)) * 8 + half * 4 + (hm & 3); }
        else pb = (lb & ~7) + 4 * (lb & 1) + ((lb & 7) >> 1);
        return titem_make(as_global(C.in[I_DA_WQKV]), 3072, 1024, (bf16*)(C.ws + WB_QKV), 64 * kb, 32 * lb, 32 * pb, nullptr, false); } r -= TI_QKV;
    if (r < TI_O) { const int cb = r % 32; return titem_make(as_global(C.in[I_DA_WO]), 1024, 1024, (bf16*)(C.ws + WB_DAO), 64 * (r / 32), 32 * cb, 32 * ((cb & ~7) + 4 * (cb & 1) + ((cb & 7) >> 1)), nullptr, false); } r -= TI_O;
    if (r < TI_O) { const int cb = r % 32; return titem_make(as_global(C.in[I_M_WO]), 1024, 1024, (bf16*)(C.ws + WB_MLO), 64 * (r / 32), 32 * cb, 32 * ((cb & ~7) + 4 * (cb & 1) + ((cb & 7) >> 1)), nullptr, false); } r -= TI_O;
    if (r < TI_WIN) { const int kb = r / 21, lb = r % 21; int pb = 18;
        if (lb < 20) { const int wsl = lb >> 1; pb = (wsl >> 2) * 8 + (lb & 1) * 4 + (wsl & 3); }
        return titem_make(as_global(C.in[I_M_WIN]), 672, 1024, (bf16*)(C.ws + WB_WIN), 64 * kb, 32 * lb, 32 * pb, nullptr, lb == 20); } r -= TI_WIN;
    if (r < TI_UQ) { const int kb = r / 48, lb = r % 48, h = lb / 3, part = lb % 3; int pb;
        if (part < 2) pb = (h >> 2) * 8 + part * 4 + (h & 3); else { const int sl = h >> 1; pb = (4 + (sl >> 2)) * 8 + (h & 1) * 4 + (sl & 3); }
        return titem_make(as_global(C.in[I_M_WUQ]), 1536, 384, (bf16*)(C.ws + WB_WUQ), 64 * kb, 32 * lb, 32 * pb, as_global(C.in[I_M_QAN]), part == 2); } r -= TI_UQ;
    if (r < TI_UKV) { const int kb = r / 64, lb = r % 64, h = lb >> 2, part = lb & 3; const int pb = (((part < 2) ? 0 : 4) + (h >> 2)) * 8 + (part & 1) * 4 + (h & 3);
        return titem_make(as_global(C.in[I_M_WUKV]), 2048, 256, (bf16*)(C.ws + WB_WUKV), 64 * kb, 32 * lb, 32 * pb, as_global(C.in[I_M_KVAN]), false); } r -= TI_UKV;
    if (r < 16384) { const int item = r & 63, mat = (r >> 6) & 1, t = (r >> 7) & 1, e = (r >> 8) & 31, l = r >> 13; const int kb = item >> 2, nb = item & 3;
        const float* W = as_global(C.in[mat ? I_E_W3 : I_E_W1]) + (size_t)(l * 32 + e) * 1024 * 256 + 128 * t;
        TItem ti = titem_make(W, 256, 1024, (bf16*)(C.ws + WB_MOE + (size_t)l * 48 * MiB), 64 * kb, 32 * nb, e * 512 + 256 * t + 128 * mat + 32 * nb, nullptr, false);
        ti.f8 = 1; ti.dst = (bf16*)((unsigned char*)(C.ws + WB_MOE + (size_t)l * 48 * MiB) + (size_t)(e * 512 + 256 * t + 128 * mat + 32 * nb) * 1024 + 64 * kb); return ti; }
    r -= 16384;
    { const int item = r & 127, e = (r >> 7) & 31, l = r >> 12; const int kb = item >> 5, nb = item & 31;
      const float* W = as_global(C.in[I_E_W2]) + (size_t)(l * 32 + e) * 256 * 1024;
      return titem_make(W, 1024, 256, (bf16*)(C.ws + WB_MOE + (size_t)l * 48 * MiB + 32 * MiB), 64 * kb, 32 * nb, e * 1024 + 32 * ((nb & ~7) + 4 * (nb & 1) + ((nb & 7) >> 1)), nullptr, false); }
}
__device__ __forceinline__ void ph_prologue(const Ctx& C) {
    {
        float* sc = (float*)C.lds;
        float* red = sc + 16384;
        const float* c = as_global(C.in[I_C]); const float* adaw = as_global(C.in[I_ADAW]); const float* adab = as_global(C.in[I_ADAB]); float* mod = (float*)(C.ws + WS_MOD);
        for (int item = blockIdx.x; item < 384; item += gridDim.x) {
            const int layer = item / 192, r = item % 192, cc = r >> 1, bhf = r & 1;
            __syncthreads();
            for (int idx = C.tid; idx < 16384; idx += NTHR) { const float v = c[(size_t)(bhf * 16) * D + idx]; sc[(idx & 1023) * 16 + (idx >> 10)] = v / (1.0f + expf(-v)); }
            __syncthreads();
            const int col = C.tid & 63, ks = C.tid >> 6;
            f32x4 acc[4];
#pragma unroll
            for (int i = 0; i < 4; ++i) acc[i] = (f32x4){0.f, 0.f, 0.f, 0.f};
            const float* wp = adaw + ((size_t)layer * D + ks * 128) * 6144 + cc * 64 + col;
#pragma unroll 8
            for (int kk = 0; kk < 128; ++kk) {
                const float w = wp[(size_t)kk * 6144]; const float* sp = sc + (ks * 128 + kk) * 16;
#pragma unroll
                for (int i = 0; i < 4; ++i) acc[i] += *(const f32x4*)(sp + 4 * i) * w;
            }
#pragma unroll
            for (int i = 0; i < 16; ++i) red[(ks * 16 + i) * 64 + col] = acc[i >> 2][i & 3];
            __syncthreads();
            for (int o = C.tid; o < 1024; o += NTHR) { const int i = o >> 6, cl = o & 63; float sm = adab[layer * 6144 + cc * 64 + cl];
#pragma unroll
                for (int k2 = 0; k2 < 8; ++k2) sm += red[(k2 * 16 + i) * 64 + cl];
                mod[(size_t)(layer * NB + bhf * 16 + i) * 6144 + cc * 64 + cl] = sm; }
        }
        if (blockIdx.x == 0 && C.wave == 0) {
            const float a = wave_sum(as_global(C.in[I_DA_LQ1])[C.lane] * as_global(C.in[I_DA_LK1])[C.lane]);
            const float b = wave_sum(as_global(C.in[I_DA_LQ2])[C.lane] * as_global(C.in[I_DA_LK2])[C.lane]);
            if (C.lane == 0) *(float*)(C.ws + WS_LAM) = expf(a) - expf(b) + 0.2f;
        }
    }
    __syncthreads();
    {
        float* ivf = (float*)C.lds;
        if (C.tid < 32) ivf[C.tid] = powf(10000.0f, -(float)(2 * C.tid) / 64.0f); else if (C.tid < 48) ivf[C.tid] = powf(10000.0f, -(float)(2 * (C.tid - 32)) / 32.0f);
        __syncthreads();
        const int* pos = (const int*)as_global(C.in[I_POS]);
        float* cosD = (float*)(C.ws + WS_COSD); float* sinD = (float*)(C.ws + WS_SIND); float* cosM = (float*)(C.ws + WS_COSM); float* sinM = (float*)(C.ws + WS_SINM);
        const int gt = blockIdx.x * NTHR + C.tid, ngt = gridDim.x * NTHR;
        for (int idx = gt; idx < NTOK * 32; idx += ngt) {
            const float ang = (float)pos[idx >> 5] * ivf[idx & 31]; float rev = ang * 0.15915494309189535f; rev -= floorf(rev);
            cosD[idx] = __builtin_amdgcn_cosf(rev); sinD[idx] = __builtin_amdgcn_sinf(rev);
        }
        for (int idx = gt; idx < NTOK * 16; idx += ngt) {
            const float ang = (float)pos[idx >> 4] * ivf[32 + (idx & 15)]; float rev = ang * 0.15915494309189535f; rev -= floorf(rev);
            cosM[idx] = __builtin_amdgcn_cosf(rev); sinM[idx] = __builtin_amdgcn_sinf(rev);
        }
        float* wrt = (float*)(C.ws + WS_WRT); const float* wr = as_global(C.in[I_E_WR]);
        for (int idx = gt; idx < 2 * 32 * 1024; idx += ngt) { const int l = idx >> 15, e = (idx >> 10) & 31, k = idx & 1023; wrt[idx] = wr[((size_t)l * 1024 + k) * 32 + e]; }
        for (int idx = gt; idx < 96 * 1024 / 8; idx += ngt) { const int blk = idx / 4096, rem = idx % 4096; const int pb = (blk == 0) ? 19 : 21 + blk;
            *(u32x4*)((bf16*)(C.ws + WB_WIN) + (size_t)pb * 32 * 1024 + (size_t)rem * 8) = (u32x4){0u, 0u, 0u, 0u}; }
    }
    __syncthreads();
    {
        float* scr = (float*)(C.lds + C.wave * 16384);
        f32x4 va[8], vb[8];
#pragma unroll 1
        for (int it = C.gw; it < TI_ALL; it += 2 * C.ngw) {
            const bool hasb = it + C.ngw < TI_ALL;
            const TItem ta = titem_decode(C, it), tb = titem_decode(C, hasb ? it + C.ngw : it);
            titem_load(ta, va, C.lane); if (hasb) titem_load(tb, vb, C.lane);
            titem_finish(ta, va, scr, C.lane); if (hasb) titem_finish(tb, vb, scr, C.lane);
        }
    }
}
__device__ __forceinline__ void ph_normmod0(const Ctx& C) {
    const float* x = as_global(C.in[I_X]); bf16* H = (bf16*)(C.ws + WS_H);
    for (int tok = C.gw; tok < NTOK; tok += C.ngw) {
        const int b = tok / SEQ; f32x4 v[4], h[4];
#pragma unroll
        for (int j = 0; j < 4; ++j) v[j] = *(const f32x4*)(x + (size_t)tok * D + 4 * C.lane + 256 * j);
        normmod_row(v, h, as_global(C.in[I_NMIX]), C.mod(0, b, 0), C.mod(0, b, 1), C.lane);
        store_row_bf16(H + (size_t)tok * D, h, C.lane);
    }
}
template <bool FINAL>
__device__ __forceinline__ void ph_comb(const Ctx& C, const unsigned char* y2, const float* gate_chunk_base  , int nlayer, const float* gnorm) {
    bf16* H = (bf16*)(C.ws + WS_H); const int lane = C.lane;
    for (int chunk = blockIdx.x; chunk < NTOK / 256; chunk += gridDim.x) {
        for (int i = 0; i < 32; ++i) {
            const int tok = chunk * 256 + C.wave * 32 + i, b = tok / SEQ;
            f32x4 v[4], a[4], a2[4];
            load_row_bf16((const bf16*)(C.ws + WS_XB) + (size_t)tok * D, v, lane);
            const float* gate = gate_chunk_base + (size_t)b * 6144;
            load_row_fp8(y2 + (size_t)(2 * tok) * D, a, lane); load_row_fp8(y2 + (size_t)(2 * tok + 1) * D, a2, lane);
#pragma unroll
            for (int j = 0; j < 4; ++j) { const f32x4 gg = *(const f32x4*)(gate + 4 * lane + 256 * j); v[j] += gg * (a[j] + a2[j]);
                if (FINAL) *(f32x4*)(as_global(C.out) + (size_t)tok * D + 4 * lane + 256 * j) = v[j]; }
            if (FINAL) continue;
            store_row_bf16((bf16*)(C.ws + WS_XB) + (size_t)tok * D, v, lane);
            f32x4 h[4];
            normmod_row(v, h, gnorm, C.mod(nlayer, b, 0), C.mod(nlayer, b, 1), lane);
            store_row_bf16(H + (size_t)tok * D, h, lane);
        }
    }
}

constexpr int MOE_TAB_OFF = 131072 + 512;
__device__ __forceinline__ void moe_prefix256(const Ctx& C, int moe_layer, int* cntl, int* tpre) {
    const unsigned* cnt = (const unsigned*)(C.ws + WS_CTL) + CW_CNT + moe_layer * 32 * 64;
    __syncthreads();
    if (C.tid < 32) cntl[C.tid] = (int)__hip_atomic_load(cnt + C.tid * 64, __ATOMIC_RELAXED, __HIP_MEMORY_SCOPE_AGENT);
    __syncthreads();
    if (C.tid == 0) { int s = 0; for (int e = 0; e < 32; ++e) { tpre[e] = s; s += (cntl[e] + 255) >> 8; } tpre[32] = s; }
    __syncthreads();
    if (C.tid < 32) { for (int rt = tpre[C.tid]; rt < tpre[C.tid + 1]; ++rt) tpre[33 + rt] = C.tid; }
    __syncthreads();
}
__device__ __forceinline__ void ph_moe1_mfma(const Ctx& C, int moe_layer) {
    int* cntl = (int*)(C.lds + MOE_TAB_OFF); int* tpre = cntl + 32;
    moe_prefix256(C, moe_layer, cntl, tpre);
    pg8::MoeOrder S{tpre, 2, (int)gridDim.x, (((int)blockIdx.x & 7) * 32 + ((int)blockIdx.x >> 3)), tpre[32] * 2};
    pg8::EpiMoe1 E{(bf16*)(C.ws + WS_A), (const int*)(C.ws + WS_LIST), (const float*)(C.ws + WS_LISTW), cntl, NTOK};
    int K1 = 1024; asm volatile("" : "+s"(K1));
    pg8::gemm_phase_gather<pg8::EpiMoe1, pg8::MoeOrder, true>((PG8_LAS unsigned char*)C.lds, (const bf16*)(C.ws + WS_H), (const bf16*)(C.ws + WB_MOE + (size_t)moe_layer * 48 * MiB), K1,
                                                        (const int*)(C.ws + WS_LIST), NTOK, cntl, S, E);
}
__device__ __forceinline__ void ph_moe2_mfma(const Ctx& C, int moe_layer) {
    int* cntl = (int*)(C.lds + MOE_TAB_OFF); int* tpre = cntl + 32;
    moe_prefix256(C, moe_layer, cntl, tpre);
    pg8::MoeOrder S{tpre, 4, (int)gridDim.x, (((int)blockIdx.x & 7) * 32 + ((int)blockIdx.x >> 3)), tpre[32] * 4};
    pg8::EpiMoe2 E{(unsigned char*)(C.ws + WS_A + 128 * MiB), (const int*)(C.ws + WS_LIST), cntl, NTOK};
    int K2 = 256; asm volatile("" : "+s"(K2));
    pg8::Gemm g{(const bf16*)(C.ws + WS_A), (const bf16*)(C.ws + WB_MOE + (size_t)moe_layer * 48 * MiB + 32 * MiB), 0, 0, K2};
    pg8::gemm_phase<pg8::EpiMoe2, pg8::MoeOrder, PG8_ALIGN, PG8_SP2>((PG8_LAS unsigned char*)C.lds, g, S, E);
}

namespace fa {
typedef short bf16x8 __attribute__((ext_vector_type(8)));
typedef short s16x4 __attribute__((ext_vector_type(4)));
typedef float f32x16 __attribute__((ext_vector_type(16)));
typedef __attribute__((address_space(3))) const char* lds_cptr;
__device__ __forceinline__ int crow(int r, int hi) { return (r & 3) + 8 * (r >> 2) + 4 * hi; }
__device__ __forceinline__ s16x4 vtr(lds_cptr p) { return __builtin_bit_cast(s16x4, __builtin_amdgcn_ds_read_tr16_b64_v4i16((__attribute__((address_space(3))) s16x4*)p)); }
typedef float f32x2_t __attribute__((ext_vector_type(2))); typedef __bf16 bf16x2_t __attribute__((ext_vector_type(2)));
__device__ __forceinline__ unsigned cvtpk(float lo, float hi) { f32x2_t v = {lo, hi}; bf16x2_t b = __builtin_convertvector(v, bf16x2_t); return __builtin_bit_cast(unsigned, b); }
__device__ __forceinline__ float half_swap_max(float v) { auto rr = __builtin_amdgcn_permlane32_swap(__float_as_uint(v), __float_as_uint(v), false, false); return fmaxf(__uint_as_float(rr[0]), __uint_as_float(rr[1])); }
__device__ __forceinline__ float half_swap_sum(float v) { auto rr = __builtin_amdgcn_permlane32_swap(__float_as_uint(v), __float_as_uint(v), false, false); return __uint_as_float(rr[0]) + __uint_as_float(rr[1]); }
__device__ __forceinline__ void dma16(const void* gsrc, LAS unsigned char* ldsdst) { unsigned keep; const unsigned dst = (unsigned)__builtin_amdgcn_readfirstlane((int)(unsigned)(uintptr_t)ldsdst);
    asm volatile("s_mov_b32 %0, m0\n\ts_mov_b32 m0, %2\n\ts_nop 0\n\tglobal_load_lds_dwordx4 %1, off\n\ts_mov_b32 m0, %0" : "=&s"(keep) : "v"(gsrc), "s"(dst) : "memory"); }
__device__ __forceinline__ void dma16s(const void* sbase_, unsigned voff, LAS unsigned char* ldsdst) { unsigned keep; const unsigned dst = (unsigned)__builtin_amdgcn_readfirstlane((int)(unsigned)(uintptr_t)ldsdst);
    const unsigned long long sb_ = (unsigned long long)(uintptr_t)sbase_; const unsigned lo_ = (unsigned)__builtin_amdgcn_readfirstlane((int)(unsigned)sb_), hi_ = (unsigned)__builtin_amdgcn_readfirstlane((int)(unsigned)(sb_ >> 32));
    const void* sbase = (const void*)(uintptr_t)(((unsigned long long)hi_ << 32) | lo_);
    asm volatile("s_mov_b32 %0, m0\n\ts_mov_b32 m0, %3\n\ts_nop 0\n\tglobal_load_lds_dwordx4 %1, %2\n\ts_mov_b32 m0, %0" : "=&s"(keep) : "v"(voff), "s"(sbase), "s"(dst) : "memory"); }

template <int ND0, int NDB>
__device__ __forceinline__ void tile(lds_cptr Kslot, lds_cptr Vslot, const bf16x8 (&qf)[ND0], f32x16 (&o)[NDB], f32x16& negm, float& m, float& l,
                                     LAS float* wsf, bool first, bool diag, int qloc, int lane) {
    const int r32 = lane & 31, hi = lane >> 5;
    lds_cptr kb = Kslot + hi * 1024 + r32 * 16;
    bf16x8 kf0[ND0], kf1[ND0];
#pragma unroll
    for (int d0 = 0; d0 < ND0; ++d0) {
        kf0[d0] = *(const __attribute__((address_space(3))) bf16x8*)(kb + d0 * 2048);
        kf1[d0] = *(const __attribute__((address_space(3))) bf16x8*)(kb + d0 * 2048 + 512);
    }
#pragma unroll
    for (int d0 = 0; d0 < ND0; ++d0) asm volatile("" : "+v"(kf0[d0]), "+v"(kf1[d0]));
    f32x16 p0 = __builtin_amdgcn_mfma_f32_32x32x16_bf16(kf0[0], qf[0], negm, 0, 0, 0);
    f32x16 p1 = __builtin_amdgcn_mfma_f32_32x32x16_bf16(kf1[0], qf[0], negm, 0, 0, 0);
#pragma unroll
    for (int d0 = 1; d0 < ND0; ++d0) {
        p0 = __builtin_amdgcn_mfma_f32_32x32x16_bf16(kf0[d0], qf[d0], p0, 0, 0, 0);
        p1 = __builtin_amdgcn_mfma_f32_32x32x16_bf16(kf1[d0], qf[d0], p1, 0, 0, 0);
    }
    __builtin_amdgcn_sched_barrier(0);
    lds_cptr vp = Vslot + ((lane >> 4) & 1) * 32 + (lane & 3) * 8 + (4 * hi + ((lane & 15) >> 2)) * 64;
    constexpr int NE = (NDB < 2 ? NDB : 2) * 4;
    s16x4 vlo[NDB * 4], vhi[NDB * 4];
#pragma unroll
    for (int i = 0; i < NE; ++i) { vlo[i] = vtr(vp + (i >> 2) * 4096 + (i & 3) * 1024); vhi[i] = vtr(vp + (i >> 2) * 4096 + (i & 3) * 1024 + 512); }
    __builtin_amdgcn_sched_barrier(0);
    if (diag) {
#pragma unroll
        for (int r = 0; r < 16; ++r) { const int kv = crow(r, hi); if (kv > qloc) p0[r] = -1e30f; if (kv + 32 > qloc) p1[r] = -1e30f; }
    }
    float mx = fmaxf(fmaxf(p0[0], p1[0]), p0[1]);
#pragma unroll
    for (int r = 1; r < 16; ++r) { if (r > 1) mx = fmaxf(fmaxf(mx, p0[r]), p1[r]); else mx = fmaxf(mx, p1[r]); }
    mx = half_swap_max(mx);
    const bool need = first || (__builtin_amdgcn_ballot_w64(mx > 8.0f) != 0ull);
    if (need) {
        const float dl = first ? mx : fmaxf(mx, 0.f);
        m += dl;
#pragma unroll
        for (int r = 0; r < 16; ++r) { p0[r] -= dl; p1[r] -= dl; negm[r] = -m; }
        if (!first) {
            const float al = __builtin_amdgcn_exp2f(-dl); l *= al;
            if (hi == 0) wsf[r32] = al;
            asm volatile("s_waitcnt lgkmcnt(0)" ::: "memory");
            f32x4 a4[4];
#pragma unroll
            for (int g = 0; g < 4; ++g) a4[g] = *(const LAS f32x4*)(wsf + 8 * g + 4 * hi);
#pragma unroll
            for (int db = 0; db < NDB; ++db)
#pragma unroll
                for (int r = 0; r < 16; ++r) o[db][r] *= a4[r >> 2][r & 3];
        }
    }
    float sum = 0.f;
#pragma unroll
    for (int ks = 0; ks < 4; ++ks) {
        float e[8];
#pragma unroll
        for (int j = 0; j < 8; ++j) { const float x = (ks < 2) ? p0[8 * ks + j] : p1[8 * (ks - 2) + j]; e[j] = __builtin_amdgcn_exp2f(x); }
        sum += ((e[0] + e[1]) + (e[2] + e[3])) + ((e[4] + e[5]) + (e[6] + e[7]));
        u32x4 w; w.x = cvtpk(e[0], e[1]); w.y = cvtpk(e[2], e[3]); w.z = cvtpk(e[4], e[5]); w.w = cvtpk(e[6], e[7]);
        const bf16x8 pa = __builtin_bit_cast(bf16x8, w);
        if (ks == 0 && NE < NDB * 4) {
#pragma unroll
            for (int i = NE; i < NDB * 4; ++i) { vlo[i] = vtr(vp + (i >> 2) * 4096 + (i & 3) * 1024); vhi[i] = vtr(vp + (i >> 2) * 4096 + (i & 3) * 1024 + 512); }
        }
        __builtin_amdgcn_s_setprio(1);
#pragma unroll
        for (int db = 0; db < NDB; ++db) {
            const s16x4 lo = vlo[db * 4 + ks], hh = vhi[db * 4 + ks];
            const bf16x8 vf = (bf16x8){lo[0], lo[1], lo[2], lo[3], hh[0], hh[1], hh[2], hh[3]};
            o[db] = __builtin_amdgcn_mfma_f32_32x32x16_bf16(pa, vf, o[db], 0, 0, 0);
        }
        __builtin_amdgcn_s_setprio(0);
    }
    l += sum;
}
}


__device__ __forceinline__ void ph_route(const Ctx& C, int layer) {
    typedef float f32x16 __attribute__((ext_vector_type(16)));
    LAS float* hT = (LAS float*)C.lds + C.wave * (32 * 68);
    LAS float* rsl = (LAS float*)C.lds + 8 * 32 * 68 + C.wave * 32;
    int* le0 = (int*)(C.lds + 73728); int* le1 = le0 + 256; int* hist = le1 + 256; int* base = hist + 32; float* lw0 = (float*)(base + 32); float* lw1 = lw0 + 256;
    const bf16* x1 = (const bf16*)(C.ws + WS_XB); unsigned char* H8 = C.ws + WS_H; float* listw = (float*)(C.ws + WS_LISTW); int* list = (int*)(C.ws + WS_LIST);
    unsigned* cnt = (unsigned*)(C.ws + WS_CTL) + CW_CNT + layer * 32 * 64;
    const float* ssqx = (const float*)(C.ws + WS_SSQX);
    const float* gn = as_global(C.in[I_NFFN]) + layer * D;
    const float* WrT = (const float*)(C.ws + WS_WRT) + (size_t)layer * 32 * 1024; const float* wg = as_global(C.in[I_E_WG]) + (size_t)layer * D * 4;
    const float* bg = as_global(C.in[I_E_BG]) + layer * 4; const float* br = as_global(C.in[I_E_BR]) + layer * 32;
    const int lane = C.lane, r32 = lane & 31, hi = lane >> 5, w = C.wave, kq = lane & 15, tsub = lane >> 4;
    LAS float* wgl = (LAS float*)(C.lds + 81920);
    __syncthreads();
    for (int idx = C.tid; idx < 1024; idx += NTHR) *(LAS f32x4*)(wgl + idx * 4) = *(const f32x4*)(wg + (size_t)idx * 4);
    for (int chunk = blockIdx.x; chunk < NTOK / 256; chunk += gridDim.x) {
        __syncthreads();
        if (C.tid < 32) hist[C.tid] = 0;
        const int tok0 = chunk * 256 + w * 32, b = tok0 >> 11;
        const float* shp = C.mod(layer, b, 3); const float* scp = C.mod(layer, b, 4);
        { const float* sp = ssqx + (size_t)(tok0 + r32) * 16; const f32x4 s0 = *(const f32x4*)sp, s1 = *(const f32x4*)(sp + 4), s2 = *(const f32x4*)(sp + 8), s3 = *(const f32x4*)(sp + 12);
          const float sm = ((s0[0] + s0[1]) + (s0[2] + s0[3])) + ((s1[0] + s1[1]) + (s1[2] + s1[3])) + ((s2[0] + s2[1]) + (s2[2] + s2[3])) + ((s3[0] + s3[1]) + (s3[2] + s3[3]));
          if (hi == 0) rsl[r32] = 1.0f / sqrtf(sm * (1.0f / D) + EPS); }
        f32x16 acc;
#pragma unroll
        for (int r = 0; r < 16; ++r) acc[r] = 0.f;
        float gl[4] = {0.f, 0.f, 0.f, 0.f};
        const unsigned xoff = (unsigned)(tok0 + tsub) * 1024u + 4u * kq;
        const unsigned woff = (unsigned)r32 * 1024u + 4u * hi;
        f32x4 X[8], Wa[8], Wb[8];
#define RT_LOADX(kc_) do { _Pragma("unroll") for (int i = 0; i < 8; ++i) { const u32x2 w_ = *(const u32x2*)(x1 + (xoff + 4096u * i + 64u * (kc_))); \
            X[i] = (f32x4){__uint_as_float(w_.x << 16), __uint_as_float(w_.x & 0xffff0000u), __uint_as_float(w_.y << 16), __uint_as_float(w_.y & 0xffff0000u)}; } } while (0)
#define RT_LOADW(W, kc_) do { _Pragma("unroll") for (int c = 0; c < 8; ++c) W[c] = *(const f32x4*)(WrT + (woff + 64u * (kc_) + 8u * c)); } while (0)
#define RT_STEP(W, WN, kc_) do { const unsigned k4 = 64u * (kc_) + 4u * kq; \
            const f32x4 g4 = *(const f32x4*)(gn + k4), sc4 = *(const f32x4*)(scp + k4), sh4 = *(const f32x4*)(shp + k4); const f32x4 gm4 = g4 * (sc4 + 1.0f); \
            _Pragma("unroll") for (int i = 0; i < 8; ++i) { const int tl = 4 * i + tsub; const float rsd = rsl[tl]; const f32x4 h4 = (X[i] * rsd) * gm4 + sh4; \
                int o8 = __builtin_amdgcn_cvt_pk_fp8_f32(h4[0], h4[1], 0, false); o8 = __builtin_amdgcn_cvt_pk_fp8_f32(h4[2], h4[3], o8, true); *(int*)(H8 + (xoff + 4096u * i + 64u * (kc_))) = o8; *(LAS f32x4*)(hT + tl * 68 + 4 * kq) = h4; } \
            if ((kc_) + 1 < 16) { RT_LOADX((kc_) + 1); RT_LOADW(WN, (kc_) + 1); } \
            _Pragma("unroll") for (int c = 0; c < 8; ++c) { const f32x4 b4 = *(const LAS f32x4*)(hT + r32 * 68 + 8 * c + 4 * hi); \
                _Pragma("unroll") for (int j = 0; j < 4; ++j) { acc = __builtin_amdgcn_mfma_f32_32x32x2f32(W[c][j], b4[j], acc, 0, 0, 0); \
                    const f32x4 w4 = *(const LAS f32x4*)(wgl + (64 * (kc_) + 8 * c + 4 * hi + j) * 4); \
                    _Pragma("unroll") for (int q = 0; q < 4; ++q) gl[q] += b4[j] * w4[q]; } asm volatile("" : "+v"(gl[0]), "+v"(gl[1]), "+v"(gl[2]), "+v"(gl[3])); } } while (0)
        RT_LOADX(0); RT_LOADW(Wa, 0);
#pragma unroll 1
        for (int kc = 0; kc < 16; kc += 2) {
            RT_STEP(Wa, Wb, kc);
            RT_STEP(Wb, Wa, kc + 1);
        }
#undef RT_LOADX
#undef RT_LOADW
#undef RT_STEP
#pragma unroll
        for (int q = 0; q < 4; ++q) gl[q] = fa::half_swap_sum(gl[q]);
        float gp[4]; { const float gm = fmaxf(fmaxf(gl[0], gl[1]), fmaxf(gl[2], gl[3])); float gs = 0.f;
#pragma unroll
            for (int g = 0; g < 4; ++g) { gp[g] = expf(gl[g] - gm); gs += gp[g]; }
#pragma unroll
            for (int g = 0; g < 4; ++g) gp[g] /= gs; }
        int gi = 0; float best = -1e30f, gate = 0.f;
#pragma unroll
        for (int g = 0; g < 4; ++g) { const float sv = gp[g] + bg[g]; if (sv > best) { best = sv; gi = g; gate = gp[g]; } }
        float el[8];
#pragma unroll
        for (int j = 0; j < 4; ++j) { const float own = (gi == 0) ? acc[j] : (gi == 1) ? acc[4 + j] : (gi == 2) ? acc[8 + j] : acc[12 + j];
            auto rr = __builtin_amdgcn_permlane32_swap(__float_as_uint(own), __float_as_uint(own), false, false);
            el[j] = __uint_as_float(rr[0]); el[4 + j] = __uint_as_float(rr[1]); }
        float em = el[0];
#pragma unroll
        for (int e = 1; e < 8; ++e) em = fmaxf(em, el[e]);
        float ep[8], es = 0.f;
#pragma unroll
        for (int e = 0; e < 8; ++e) { ep[e] = expf(el[e] - em); es += ep[e]; }
        int i0 = 0; float b0 = -1e30f, p0 = 0.f;
#pragma unroll
        for (int e = 0; e < 8; ++e) { ep[e] /= es; const float sv = ep[e] + br[gi * 8 + e]; if (sv > b0) { b0 = sv; i0 = e; p0 = ep[e]; } }
        int i1 = 0; float b1 = -1e30f, p1 = 0.f;
#pragma unroll
        for (int e = 0; e < 8; ++e) { const float sv = ep[e] + br[gi * 8 + e]; if (e != i0 && sv > b1) { b1 = sv; i1 = e; p1 = ep[e]; } }
        const float den = p0 + p1;
        if (hi == 0) { const int tl = w * 32 + r32; le0[tl] = gi * 8 + i0; le1[tl] = gi * 8 + i1; lw0[tl] = p0 / den * gate; lw1[tl] = p1 / den * gate; }
        __syncthreads();
        int e0 = 0, e1 = 0, q0 = 0, q1 = 0;
        if (C.tid < 256) { e0 = le0[C.tid]; e1 = le1[C.tid]; q0 = atomicAdd(&hist[e0], 1); q1 = atomicAdd(&hist[e1], 1); }
        __syncthreads();
        if (C.tid < 32) base[C.tid] = (int)__hip_atomic_fetch_add(cnt + C.tid * 64, (unsigned)hist[C.tid], __ATOMIC_RELAXED, __HIP_MEMORY_SCOPE_AGENT);
        __syncthreads();
        if (C.tid < 256) { const int tok = chunk * 256 + C.tid;
            const size_t i0_ = (size_t)e0 * NTOK + base[e0] + q0, i1_ = (size_t)e1 * NTOK + base[e1] + q1;
            list[i0_] = 2 * tok; list[i1_] = 2 * tok + 1; listw[i0_] = lw0[C.tid]; listw[i1_] = lw1[C.tid]; }
    }
}

__device__ __forceinline__ void ph_attn_da_mfma(const Ctx& C) {
    using namespace fa;
    LAS unsigned char* L = (LAS unsigned char*)C.lds;
    constexpr int STG = 32768;
    LAS float* wsf = (LAS float*)(L + 3 * STG) + C.wave * 32;
    const int vcu = ((int)blockIdx.x & 7) * 32 + ((int)blockIdx.x >> 3), xcd = vcu >> 5, grp = (vcu >> 4) & 1, jj = vcu & 15;
    const bf16* Q = (const bf16*)(C.ws + WS_A); const bf16* Kb = Q + (size_t)NTOK * D; const bf16* Vb = Kb + (size_t)NTOK * D; bf16* O = (bf16*)(C.ws + WS_O);
    const float lam = *(const float*)(C.ws + WS_LAM);
    const int lane = C.lane, w = C.wave, c = w >> 2, wq = w & 3, r32 = lane & 31, hi = lane >> 5;
    const float c2 = 0.125f * 1.4426950408889634f;
    for (int u = 0; u < 16; ++u) {
        const int bh = xcd * 32 + 2 * u + grp, b = bh >> 3, h = bh & 7, qb = (u & 1) ? 15 - jj : jj, q0 = qb * 128;
        const size_t rowb = (size_t)b * SEQ;
        const int NT = (q0 + 128) / 64, qw0 = q0 + 32 * wq, T = qw0 >> 6;
        const bf16* sbase = (w < 4 ? Kb : Vb) + rowb * D;
        unsigned soff[4]; int dsto[4];
#pragma unroll
        for (int i = 0; i < 4; ++i) {
            if (w < 4) { const int cm = w >> 1, ch = (w & 1) * 4 + i; soff[i] = (unsigned)((lane * D + (2 * h + cm) * 64 + ch * 8) * 2); dsto[i] = cm * 8192 + ch * 1024; }
            else { const int db = w - 4, rg = i; soff[i] = (unsigned)(((rg * 16 + (lane >> 2)) * D + h * 128 + db * 32 + (lane & 3) * 8) * 2); dsto[i] = 16384 + db * 4096 + rg * 1024; }
        }
        bf16x8 qf[4];
#pragma unroll
        for (int d0 = 0; d0 < 4; ++d0) qf[d0] = *(const bf16x8*)(Q + (rowb + qw0 + r32) * D + (2 * h + c) * 64 + d0 * 16 + hi * 8);
#pragma unroll
        for (int d0 = 0; d0 < 4; ++d0) asm volatile("" : "+v"(qf[d0]));
        f32x16 o[4];
#pragma unroll
        for (int db = 0; db < 4; ++db)
#pragma unroll
            for (int r = 0; r < 16; ++r) o[db][r] = 0.f;
        float m = 0.f, l = 0.f; f32x16 negm;
#pragma unroll
        for (int r = 0; r < 16; ++r) negm[r] = 0.f;
        asm volatile("s_waitcnt lgkmcnt(0)" ::: "memory"); __builtin_amdgcn_s_barrier();
#pragma unroll
        for (int i = 0; i < 4; ++i) dma16s(sbase, soff[i], L + dsto[i]);
#pragma unroll
        for (int i = 0; i < 4; ++i) dma16s(sbase + (size_t)64 * D, soff[i], L + STG + dsto[i]);
        int sc_ = 0, sn_ = 2;
        for (int t = 0; t < NT; ++t) {
            if (t + 1 < NT) asm volatile("s_waitcnt vmcnt(4) lgkmcnt(0)" ::: "memory"); else asm volatile("s_waitcnt vmcnt(0) lgkmcnt(0)" ::: "memory");
            __builtin_amdgcn_s_barrier();
            if (t + 2 < NT) {
#pragma unroll
                for (int i = 0; i < 4; ++i) dma16s(sbase + (size_t)(t + 2) * 64 * D, soff[i], L + sn_ * STG + dsto[i]);
            }
            if (t <= T) {
                lds_cptr stg = (lds_cptr)L + sc_ * STG;
                tile<4, 4>(stg + c * 8192, stg + 16384, qf, o, negm, m, l, wsf, t == 0, t == T, qw0 - 64 * T + r32, lane);
            }
            sc_ = (sc_ == 2) ? 0 : sc_ + 1; sn_ = (sn_ == 2) ? 0 : sn_ + 1;
        }
        l = half_swap_sum(l);
        if (hi == 0) wsf[r32] = 1.0f / l;
        asm volatile("s_waitcnt lgkmcnt(0)" ::: "memory");
        f32x4 a4[4];
#pragma unroll
        for (int g = 0; g < 4; ++g) a4[g] = *(const LAS f32x4*)(wsf + 8 * g + 4 * hi);
#pragma unroll
        for (int db = 0; db < 4; ++db)
#pragma unroll
            for (int r = 0; r < 16; ++r) o[db][r] *= a4[r >> 2][r & 3];
        asm volatile("s_waitcnt lgkmcnt(0)" ::: "memory"); __builtin_amdgcn_s_barrier();
        LAS float* X = (LAS float*)L + wq * 4352 + lane * 68;
        if (c == 1) {
#pragma unroll
            for (int db = 0; db < 4; ++db)
#pragma unroll
                for (int g = 0; g < 4; ++g) *(LAS f32x4*)(X + db * 16 + 4 * g) = (f32x4){o[db][4 * g], o[db][4 * g + 1], o[db][4 * g + 2], o[db][4 * g + 3]};
        }
        asm volatile("s_waitcnt lgkmcnt(0)" ::: "memory"); __builtin_amdgcn_s_barrier();
        if (c == 0) {
            float gsub[4];
#pragma unroll
            for (int db = 0; db < 4; ++db) gsub[db] = as_global(C.in[I_DA_SUBLN])[db * 32 + r32] * 0.8f;
#pragma unroll
            for (int db = 0; db < 4; ++db)
#pragma unroll
                for (int g = 0; g < 4; ++g) { const f32x4 x = *(const LAS f32x4*)(X + db * 16 + 4 * g);
#pragma unroll
                    for (int j2 = 0; j2 < 4; ++j2) o[db][4 * g + j2] -= lam * x[j2]; }
            float uu[8];
#pragma unroll
            for (int r = 0; r < 8; ++r) {
                const float sa = (o[0][r] * o[0][r] + o[1][r] * o[1][r]) + (o[2][r] * o[2][r] + o[3][r] * o[3][r]);
                const float sb = (o[0][r + 8] * o[0][r + 8] + o[1][r + 8] * o[1][r + 8]) + (o[2][r + 8] * o[2][r + 8] + o[3][r + 8] * o[3][r + 8]);
                auto sw = __builtin_amdgcn_permlane16_swap(__float_as_uint(sa), __float_as_uint(sb), false, false);
                uu[r] = __uint_as_float(sw[0]) + __uint_as_float(sw[1]);
            }
#pragma unroll
            for (int r = 0; r < 8; ++r) {
                uu[r] += __uint_as_float((unsigned)__builtin_amdgcn_update_dpp(0, (int)__float_as_uint(uu[r]), 0x128, 0xF, 0xF, true));
                uu[r] += __uint_as_float((unsigned)__builtin_amdgcn_update_dpp(0, (int)__float_as_uint(uu[r]), 0x124, 0xF, 0xF, true));
                uu[r] += __uint_as_float((unsigned)__builtin_amdgcn_update_dpp(0, (int)__float_as_uint(uu[r]), 0x122, 0xF, 0xF, true));
                uu[r] += __uint_as_float((unsigned)__builtin_amdgcn_update_dpp(0, (int)__float_as_uint(uu[r]), 0x121, 0xF, 0xF, true));
                uu[r] = __builtin_amdgcn_rsqf(uu[r] * (1.0f / 128.0f) + EPS);
            }
            float rs[16];
#pragma unroll
            for (int r = 0; r < 8; ++r) { auto sw = __builtin_amdgcn_permlane16_swap(__float_as_uint(uu[r]), __float_as_uint(uu[r]), false, false); rs[r] = __uint_as_float(sw[0]); rs[r + 8] = __uint_as_float(sw[1]); }
            asm volatile("s_waitcnt lgkmcnt(0)" ::: "memory");
            LAS unsigned char* TT = (LAS unsigned char*)((LAS float*)L + wq * 4352);
#pragma unroll
            for (int r = 0; r < 16; ++r) {
                const unsigned p01 = cvtpk(o[0][r] * (rs[r] * gsub[0]), o[1][r] * (rs[r] * gsub[1])), p23 = cvtpk(o[2][r] * (rs[r] * gsub[2]), o[3][r] * (rs[r] * gsub[3]));
                LAS unsigned short* tp = (LAS unsigned short*)(TT + crow(r, hi) * 272 + r32 * 2);
                tp[0] = (unsigned short)p01; tp[32] = (unsigned short)(p01 >> 16); tp[64] = (unsigned short)p23; tp[96] = (unsigned short)(p23 >> 16);
            }
            asm volatile("s_waitcnt lgkmcnt(0)" ::: "memory");
#pragma unroll
            for (int i = 0; i < 8; ++i) {
                const int row = 4 * i + (lane >> 4);
                const u32x4 v = *(const LAS u32x4*)(TT + row * 272 + (lane & 15) * 16);
                *(u32x4*)(O + (rowb + qw0 + row) * D + h * 128 + (lane & 15) * 8) = v;
            }
        }
    }
}
__device__ __forceinline__ void ph_attn_mla_mfma(const Ctx& C) {
    using namespace fa;
    LAS unsigned char* L = (LAS unsigned char*)C.lds;
    constexpr int STG = 20480;
    LAS float* wsf = (LAS float*)(L + 3 * STG) + C.wave * 32;
    const int vcu = ((int)blockIdx.x & 7) * 32 + ((int)blockIdx.x >> 3), xcd = vcu >> 5, grp = (vcu >> 3) & 3, jj = vcu & 7;
    const bf16* Q2 = (const bf16*)(C.ws + WS_A); const bf16* KV2 = (const bf16*)(C.ws + WS_A + 192 * MiB);
    const bf16* KPE = (const bf16*)(C.ws + WS_KPE); bf16* O = (bf16*)(C.ws + WS_O);
    const int lane = C.lane, w = C.wave, r32 = lane & 31, hi = lane >> 5;
    const float c2 = 0.10206207261596575f * 1.4426950408889634f;
    for (int u = 0; u < 16; ++u) {
        const int bh = xcd * 64 + 4 * u + grp, b = bh >> 4, h = bh & 15, qb = (u & 1) ? 7 - jj : jj, q0 = qb * 256;
        const size_t rowb = (size_t)b * SEQ;
        const int NT = (q0 + 256) / 64, qw0 = q0 + 32 * w, T = qw0 >> 6;
        const bf16* src[3]; int dsto[3]; size_t sstep[3];
#pragma unroll
        for (int i = 0; i < 3; ++i) {
            const int pi = w + 8 * i;
            if (pi < 8) { src[i] = KV2 + (rowb + lane) * 2048 + h * 128 + pi * 8; dsto[i] = pi * 1024; sstep[i] = (size_t)64 * 2048; }
            else if (pi < 12) { src[i] = KPE + (rowb + lane) * 32 + (pi - 8) * 8; dsto[i] = pi * 1024; sstep[i] = (size_t)64 * 32; }
            else { const int db = (pi - 12) >> 2, rg = (pi - 12) & 3; src[i] = KV2 + (rowb + rg * 16 + (lane >> 2)) * 2048 + h * 128 + 64 + db * 32 + (lane & 3) * 8; dsto[i] = 12288 + db * 4096 + rg * 1024; sstep[i] = (size_t)64 * 2048; }
        }
        const bool has3 = (w + 16) < 20;
        bf16x8 qf[6];
#pragma unroll
        for (int d0 = 0; d0 < 6; ++d0) qf[d0] = *(const bf16x8*)(Q2 + (rowb + qw0 + r32) * 1536 + (d0 < 4 ? h * 64 + d0 * 16 : 1024 + h * 32 + (d0 - 4) * 16) + hi * 8);
#pragma unroll
        for (int d0 = 0; d0 < 6; ++d0) asm volatile("" : "+v"(qf[d0]));
        f32x16 o[2];
#pragma unroll
        for (int db = 0; db < 2; ++db)
#pragma unroll
            for (int r = 0; r < 16; ++r) o[db][r] = 0.f;
        float m = 0.f, l = 0.f; f32x16 negm;
#pragma unroll
        for (int r = 0; r < 16; ++r) negm[r] = 0.f;
        asm volatile("s_waitcnt lgkmcnt(0)" ::: "memory"); __builtin_amdgcn_s_barrier();
        dma16(src[0], L + dsto[0]); dma16(src[1], L + dsto[1]); if (has3) dma16(src[2], L + dsto[2]);
        dma16(src[0] + sstep[0], L + STG + dsto[0]); dma16(src[1] + sstep[1], L + STG + dsto[1]); if (has3) dma16(src[2] + sstep[2], L + STG + dsto[2]);
        int sc_ = 0, sn_ = 2;
        for (int t = 0; t < NT; ++t) {
            if (t + 1 < NT) { if (has3) asm volatile("s_waitcnt vmcnt(3) lgkmcnt(0)" ::: "memory"); else asm volatile("s_waitcnt vmcnt(2) lgkmcnt(0)" ::: "memory"); }
            else asm volatile("s_waitcnt vmcnt(0) lgkmcnt(0)" ::: "memory");
            __builtin_amdgcn_s_barrier();
            if (t + 2 < NT) {
                LAS unsigned char* nb = L + sn_ * STG;
                dma16(src[0] + (t + 2) * sstep[0], nb + dsto[0]); dma16(src[1] + (t + 2) * sstep[1], nb + dsto[1]); if (has3) dma16(src[2] + (t + 2) * sstep[2], nb + dsto[2]);
            }
            if (t <= T) {
                lds_cptr stg = (lds_cptr)L + sc_ * STG;
                tile<6, 2>(stg, stg + 12288, qf, o, negm, m, l, wsf, t == 0, t == T, qw0 - 64 * T + r32, lane);
            }
            sc_ = (sc_ == 2) ? 0 : sc_ + 1; sn_ = (sn_ == 2) ? 0 : sn_ + 1;
        }
        l = half_swap_sum(l);
        if (hi == 0) wsf[r32] = 1.0f / l;
        asm volatile("s_waitcnt lgkmcnt(0)" ::: "memory");
        f32x4 a4[4];
#pragma unroll
        for (int g = 0; g < 4; ++g) a4[g] = *(const LAS f32x4*)(wsf + 8 * g + 4 * hi);
        LAS unsigned char* TT = L + 65536 + w * 4608;
#pragma unroll
        for (int r = 0; r < 16; ++r) {
            const unsigned pk = cvtpk(o[0][r] * a4[r >> 2][r & 3], o[1][r] * a4[r >> 2][r & 3]);
            LAS unsigned short* tp = (LAS unsigned short*)(TT + crow(r, hi) * 144 + r32 * 2);
            tp[0] = (unsigned short)pk; tp[32] = (unsigned short)(pk >> 16);
        }
        asm volatile("s_waitcnt lgkmcnt(0)" ::: "memory");
#pragma unroll
        for (int i = 0; i < 4; ++i) {
            const int row = 8 * i + (lane >> 3);
            const u32x4 v = *(const LAS u32x4*)(TT + row * 144 + (lane & 7) * 16);
            *(u32x4*)(O + (rowb + qw0 + row) * D + h * 64 + (lane & 7) * 8) = v;
        }
    }
}

__global__ void __launch_bounds__(NTHR, 2) fwd(Args args) {
    extern __shared__ __attribute__((aligned(16))) unsigned char lds[];
    Ctx C; C.in = args.in; C.out = args.out; C.ws = args.ws; C.lds = lds;
    C.tid = threadIdx.x; C.lane = C.tid & 63; C.wave = __builtin_amdgcn_readfirstlane(C.tid >> 6);
    C.gw = blockIdx.x * NWAVES + C.wave; C.ngw = gridDim.x * NWAVES;
    const Ctx C0 = C;
    volatile LAS unsigned* MISC = (volatile LAS unsigned*)((LAS unsigned char*)lds + MISC_OFF);
    if (C.tid < 32) MISC[C.tid] = 0u;
    __syncthreads();
    XcdBarrier bar; bar.bar = (unsigned*)(args.ws + WS_CTL) + CW_BAR; bar.x = 0; bar.st = nullptr;
    const int lo = args.ph_lo, hi = args.ph_hi;
    if (hi - lo > 1) bar = xcd_barrier_post((unsigned*)(args.ws + WS_CTL) + CW_BAR, MISC + 8);
#ifndef REPMASK
#define REPMASK 0u
#endif
#ifndef PHMASK
#define PHMASK 0xFFFFFFFFu
#endif
#define IN(k) (lo <= (k) && (k) < hi && ((PHMASK >> (k)) & 1u))
#define SEAM(k) do { if (IN(k) && IN((k) + 1)) xcd_barrier(bar); } while (0)
#define PHLOCAL unsigned char* ws = args.ws; asm volatile("" : "+s"(ws)); ws = as_global(ws); int t_ = threadIdx.x; asm volatile("" : "+v"(t_)); Ctx C = C0; C.ws = ws; C.tid = t_; C.lane = t_ & 63; \
        bf16* H = (bf16*)(ws + WS_H); bf16* O = (bf16*)(ws + WS_O); bf16* A0 = (bf16*)(ws + WS_A); (void)H; (void)O; (void)A0;

    if (IN(0)) { PHLOCAL ph_prologue(C); } SEAM(0);
    if (IN(1)) { PHLOCAL ph_normmod0(C); } SEAM(1);
    if (IN(2)) { PHLOCAL
        pg8::Gemm g{H, (const bf16*)(ws + WB_QKV), NTOK, 3 * D, D}; pg8::StaticOrder S; S.init(NTOK, 3 * D, (int)gridDim.x, (int)blockIdx.x);
        pg8::EpiQKV E{A0, A0 + (size_t)NTOK * D, A0 + (size_t)2 * NTOK * D, (const float*)(ws + WS_COSD), (const float*)(ws + WS_SIND), as_global(args.in[I_DA_QN]), as_global(args.in[I_DA_KN]), 0.125f * 1.4426950408889634f, EPS};
        pg8::gemm_phase<pg8::EpiQKV, pg8::StaticOrder, PG8_ALIGN, PG8_SP2>((PG8_LAS unsigned char*)lds, g, S, E);
    } SEAM(2);
    if (IN(3)) { PHLOCAL ph_attn_da_mfma(C); } SEAM(3);
    if (IN(4)) { PHLOCAL
        pg8::Gemm g{O, (const bf16*)(ws + WB_DAO), NTOK, D, D}; pg8::StaticOrder S; S.init(NTOK, D, (int)gridDim.x, (int)blockIdx.x);
        pg8::EpiResid<true> E{as_global(args.in[I_X]), (bf16*)(ws + WS_XB), C.mod(0, 0, 2), (float*)(ws + WS_SSQX)};
        pg8::gemm_phase<pg8::EpiResid<true>, pg8::StaticOrder, PG8_ALIGN, PG8_SP2>((PG8_LAS unsigned char*)lds, g, S, E);
    } SEAM(4);
    if (IN(5)) { PHLOCAL ph_route(C, 0); } SEAM(5);
    if (IN(6)) { PHLOCAL ph_moe1_mfma(C, 0); } SEAM(6);
    if (IN(7)) { PHLOCAL ph_moe2_mfma(C, 0); } SEAM(7);
    if (IN(8)) { PHLOCAL ph_comb<false>(C, ws + WS_A + 128 * MiB, C.mod(0, 0, 5), 1, as_global(args.in[I_NMIX]) + D); } SEAM(8);
    if (IN(9)) { PHLOCAL
        bf16* CQ = (bf16*)(ws + WS_S); bf16* CKV = CQ + (size_t)NTOK * 384; bf16* KPE = (bf16*)(ws + WS_KPE);
        pg8::Gemm g{H, (const bf16*)(ws + WB_WIN), NTOK, 768, D}; pg8::StaticOrder S; S.init(NTOK, 768, (int)gridDim.x, (int)blockIdx.x);
        pg8::EpiWin E{CQ, CKV, KPE, (float*)(ws + WS_SSQ), (const float*)(ws + WS_COSM), (const float*)(ws + WS_SINM), as_global(args.in[I_M_KPN]), EPS};
        pg8::gemm_phase<pg8::EpiWin, pg8::StaticOrder, PG8_ALIGN, PG8_SP2>((PG8_LAS unsigned char*)lds, g, S, E);
    } SEAM(9);
    if (IN(10)) { PHLOCAL
        const bf16* CQ = (const bf16*)(ws + WS_S); const bf16* CKV = CQ + (size_t)NTOK * 384;
        int Kq = 384, Kkv = 256; asm volatile("" : "+s"(Kq), "+s"(Kkv));
        { pg8::Gemm g{CQ, (const bf16*)(ws + WB_WUQ), NTOK, 1536, Kq}; pg8::StaticOrder S; S.init(NTOK, 1536, (int)gridDim.x, (int)blockIdx.x);
          pg8::EpiUQ E{A0, (const float*)(ws + WS_SSQ), (const float*)(ws + WS_COSM), (const float*)(ws + WS_SINM), as_global(args.in[I_M_QNN]), as_global(args.in[I_M_QPN]), 0.10206207261596575f * 1.4426950408889634f, EPS};
          pg8::gemm_phase<pg8::EpiUQ, pg8::StaticOrder, PG8_ALIGN, PG8_SP2>((PG8_LAS unsigned char*)lds, g, S, E); }
        { pg8::Gemm g{CKV, (const bf16*)(ws + WB_WUKV), NTOK, 2048, Kkv}; pg8::StaticOrder S; S.init(NTOK, 2048, (int)gridDim.x, (int)blockIdx.x);
          pg8::EpiUKV E{(bf16*)(ws + WS_A + 192 * MiB), (const float*)(ws + WS_SSQ), as_global(args.in[I_M_KNN]), EPS};
          pg8::gemm_phase<pg8::EpiUKV, pg8::StaticOrder, PG8_ALIGN, PG8_SP2>((PG8_LAS unsigned char*)lds, g, S, E); }
    } SEAM(10);
    if (IN(11)) { PHLOCAL ph_attn_mla_mfma(C); } SEAM(11);
    if (IN(12)) { PHLOCAL
        pg8::Gemm g{O, (const bf16*)(ws + WB_MLO), NTOK, D, D}; pg8::StaticOrder S; S.init(NTOK, D, (int)gridDim.x, (int)blockIdx.x);
        pg8::EpiResid<false> E{ws + WS_XB, (bf16*)(ws + WS_XB), C.mod(1, 0, 2), (float*)(ws + WS_SSQX)};
        pg8::gemm_phase<pg8::EpiResid<false>, pg8::StaticOrder, PG8_ALIGN, PG8_SP2>((PG8_LAS unsigned char*)lds, g, S, E);
    } SEAM(12);
    if (IN(13)) { PHLOCAL ph_route(C, 1); } SEAM(13);
    if (IN(14)) { PHLOCAL ph_moe1_mfma(C, 1); } SEAM(14);
    if (IN(15)) { PHLOCAL ph_moe2_mfma(C, 1); } SEAM(15);
    if (IN(16)) { PHLOCAL ph_comb<true>(C, ws + WS_A + 128 * MiB, C.mod(1, 0, 5), 1, as_global(args.in[I_NMIX])); }
#undef IN
#undef SEAM
}

extern "C" void kernel_launch(void* const* d_in, const int* in_sizes, int n_in, void* d_out, int out_size, void* d_ws, size_t ws_size, hipStream_t stream) {
    static int grid = 0;
    if (grid == 0) {
        if (n_in != 33 || out_size != NTOK * D || ws_size < WS_END) { fprintf(stderr, "kernel_launch: unexpected shapes n_in %d out %d ws %zu\n", n_in, out_size, ws_size); grid = -1; return; }
        int dev = 0, cus = 0;
        if (hipGetDevice(&dev) != hipSuccess || hipDeviceGetAttribute(&cus, hipDeviceAttributeMultiprocessorCount, dev) != hipSuccess) { grid = -1; return; }
        if (hipFuncSetAttribute((const void*)fwd, hipFuncAttributeMaxDynamicSharedMemorySize, LDS_BYTES) != hipSuccess) { fprintf(stderr, "hipFuncSetAttribute failed\n"); grid = -1; return; }
        (void)hipGetLastError();
        grid = cus;
        if (grid != 256) { fprintf(stderr, "kernel_launch: built for 256 CUs, device reports %d\n", cus); grid = -1; return; }
    }
    if (grid < 0) return;
    (void)hipMemsetAsync((char*)d_ws + WS_CTL, 0, CTL_ZERO_BYTES, stream);
    Args a{};
    for (int i = 0; i < 33; ++i) a.in[i] = (const float*)d_in[i];
    a.out = (float*)d_out; a.ws = (unsigned char*)d_ws;
#if MK_ONE_LAUNCH
    a.ph_lo = 0; a.ph_hi = N_PHASES;
    hipLaunchKernelGGL(fwd, dim3(grid), dim3(NTHR), LDS_BYTES, stream, a);
#else
    for (int p = 0; p < N_PHASES; ++p) { a.ph_lo = p; a.ph_hi = p + 1; hipLaunchKernelGGL(fwd, dim3(grid), dim3(NTHR), LDS_BYTES, stream, a); }
#endif
}
```

```cpp
#include <hip/hip_runtime.h>
#include <cstdio>
#include <cstdint>

#define LAS __attribute__((address_space(3)))
#define GAS __attribute__((address_space(1)))
template <class T> __device__ __forceinline__ T* as_global(T* p) { GAS T* g = (GAS T*)p; asm("" : "+s"(g)); return (T*)g; }
typedef unsigned short bf16;
typedef float f32x4 __attribute__((ext_vector_type(4)));
typedef unsigned u32x4 __attribute__((ext_vector_type(4)));
typedef unsigned u32x2 __attribute__((ext_vector_type(2)));

constexpr int NB = 32, SEQ = 2048, D = 1024, NTOK = NB * SEQ;
constexpr float EPS = 1e-6f;
constexpr int NWAVES = 8, NTHR = 512;
constexpr int N_PHASES = 17;
#ifndef MK_ONE_LAUNCH
#define MK_ONE_LAUNCH 1
#endif

constexpr size_t MiB = 1u << 20;
constexpr size_t WS_CTL = 0, CTL_ZERO_BYTES = 1 * MiB;
constexpr size_t WS_MOD = 1 * MiB;
constexpr size_t WS_LAM = WS_MOD + 7 * MiB / 4;
constexpr size_t WS_SSQX = 4 * MiB;
constexpr size_t WS_SSQ = 8 * MiB;
constexpr size_t WS_WRT = 12 * MiB;
constexpr size_t WS_COSD = 16 * MiB, WS_SIND = 24 * MiB, WS_COSM = 32 * MiB, WS_SINM = 36 * MiB;
constexpr size_t WS_TOKW = 40 * MiB;
constexpr size_t WS_LIST = 42 * MiB;
constexpr size_t WS_WB = 50 * MiB;
constexpr size_t WB_QKV = WS_WB, WB_DAO = WB_QKV + 6 * MiB, WB_WIN = WB_DAO + 2 * MiB, WB_WUQ = WB_WIN + 3 * MiB / 2, WB_WUKV = WB_WUQ + 9 * MiB / 8, WB_MLO = WB_WUKV + 1 * MiB, WB_MOE = WB_MLO + 2 * MiB;
constexpr size_t WS_H = 176 * MiB;
constexpr size_t WS_O = 304 * MiB;
constexpr size_t WS_A = 432 * MiB;
constexpr size_t WS_LISTW = 160 * MiB;
constexpr size_t WS_KPE = 168 * MiB;
constexpr size_t WS_S = WS_O;
constexpr size_t WS_XB = 880 * MiB;
constexpr size_t WS_END = 1008 * MiB;
constexpr int CW_BAR = 4096;
constexpr int CW_CNT = 16384;
constexpr int HID_ROWS = 2 * NTOK + 32 * 128;

constexpr int LDS_BYTES = 147456;
constexpr int MISC_OFF = 131072 + 320;

__device__ __forceinline__ unsigned f2bf(float f) { unsigned u = __builtin_bit_cast(unsigned, f); return (u + 0x7fffu + ((u >> 16) & 1u)) >> 16; }
__device__ __forceinline__ float bf2f(unsigned h) { return __builtin_bit_cast(float, h << 16); }
__device__ __forceinline__ unsigned pk2(float lo, float hi) { return f2bf(lo) | (f2bf(hi) << 16); }
__device__ __forceinline__ float wave_sum(float v) {
#pragma unroll
    for (int o = 1; o < 64; o <<= 1) v += __shfl_xor(v, o);
    return v;
}
__device__ __forceinline__ float wave_max(float v) {
#pragma unroll
    for (int o = 1; o < 64; o <<= 1) v = fmaxf(v, __shfl_xor(v, o));
    return v;
}

#define XB_TMO      128
#define XB_XCNT(j)  (256  + 64 * (j))
#define XB_XSUB(j)  (1280 + 64 * (j))
#define XB_XGEN(j)  (2304 + 64 * (j))
#define XB_TOP      3328
#define XB_TOPGEN   3392
#define XCD_BAR_WORDS 3456
#define XB_SPIN_CAP (1u << 20)
__device__ __forceinline__ unsigned xb_ld(unsigned* p)              { return __hip_atomic_load(p, __ATOMIC_RELAXED, __HIP_MEMORY_SCOPE_AGENT); }
__device__ __forceinline__ unsigned xb_add(unsigned* p, unsigned v) { return __hip_atomic_fetch_add(p, v, __ATOMIC_RELAXED, __HIP_MEMORY_SCOPE_AGENT); }
__device__ __forceinline__ unsigned xb_xcc_id() { return (unsigned)__builtin_amdgcn_s_getreg((3 << 11) | 20) & 0xFu; }
#define XB_SPIN(cond, bar) do { unsigned _sp = 0; while (cond) { __builtin_amdgcn_s_sleep(1); \
    if ((++_sp & 255u) == 0u) { if (xb_ld(&(bar)[XB_TMO])) break; if (_sp > XB_SPIN_CAP) { atomicAdd(&(bar)[XB_TMO], 1u); break; } } } } while (0)
struct XcdBarrier { unsigned* bar; unsigned x; volatile LAS unsigned* st; };
__device__ __forceinline__ XcdBarrier xcd_barrier_post(unsigned* bar, volatile LAS unsigned* st) {
    XcdBarrier b; b.bar = bar; b.x = xb_xcc_id(); b.st = st;
    if (threadIdx.x == 0) (void)xb_add(&bar[XB_XCNT(b.x)], 1u);
    return b;
}
__device__ __forceinline__ void xcd_barrier_complete(unsigned* bar, unsigned x, unsigned& nloc, unsigned& nx) {
    const unsigned G = gridDim.x * gridDim.y * gridDim.z;
    unsigned sum, cnt, mine, sp = 0u;
    for (;;) {
        sum = 0u; cnt = 0u; mine = 0u;
#pragma unroll
        for (unsigned j = 0; j < 16; ++j) { const unsigned c = xb_ld(&bar[XB_XCNT(j)]); sum += c; cnt += (c > 0u) ? 1u : 0u; mine = (j == x) ? c : mine; }
        if (sum == G) break;
        __builtin_amdgcn_s_sleep(1);
        if ((++sp & 255u) == 0u) { if (xb_ld(&bar[XB_TMO])) break; if (sp > XB_SPIN_CAP) { atomicAdd(&bar[XB_TMO], 1u); break; } }
    }
    nloc = mine > 0u ? mine : 1u; nx = cnt > 0u ? cnt : 1u;
}
__device__ __forceinline__ void xcd_barrier(const XcdBarrier& b) {
    asm volatile("s_waitcnt vmcnt(0)" ::: "memory");
    __syncthreads();
    if (threadIdx.x == 0) {
        unsigned* bar = b.bar;
        __builtin_amdgcn_s_waitcnt(0);
        unsigned nloc = b.st[0], nx = b.st[1];
        if (nloc == 0u) { xcd_barrier_complete(bar, b.x, nloc, nx); b.st[0] = nloc; b.st[1] = nx; }
        const unsigned old = xb_add(&bar[XB_XSUB(b.x)], 1u);
        const unsigned gen = old / nloc;
        if (old + 1u == (gen + 1u) * nloc) {
            __builtin_amdgcn_fence(__ATOMIC_RELEASE, "agent");
            asm volatile("s_waitcnt vmcnt(0)" ::: "memory");
            const unsigned og = xb_add(&bar[XB_TOP], 1u);
            const unsigned tg = og / nx;
            if (og + 1u == (tg + 1u) * nx) xb_add(&bar[XB_TOPGEN], 1u);
            else XB_SPIN(xb_ld(&bar[XB_TOPGEN]) == tg, bar);
            __builtin_amdgcn_fence(__ATOMIC_ACQUIRE, "agent");
            xb_add(&bar[XB_XGEN(b.x)], 1u);
            asm volatile("s_waitcnt vmcnt(0)" ::: "memory");
        } else {
            XB_SPIN(xb_ld(&bar[XB_XGEN(b.x)]) == gen, bar);
            __builtin_amdgcn_fence(__ATOMIC_ACQUIRE, "agent");
            asm volatile("s_waitcnt vmcnt(0)" ::: "memory");
        }
    }
    __syncthreads();
}

namespace pg8 {
#define PG8_LAS __attribute__((address_space(3)))
typedef unsigned short bf16_t;
typedef short bf16x8 __attribute__((ext_vector_type(8)));
typedef float f32x4 __attribute__((ext_vector_type(4)));
typedef unsigned u32x4 __attribute__((ext_vector_type(4)));
constexpr int BM = 256, BK = 64, HALF = 128, HTB = HALF * BK * 2  , STAGE_BYTES = 8 * HTB, NXCD = 8, WGM = 8;

__host__ __device__ __forceinline__ int lds_byte(int r, int c) { const int st = (r >> 4) * 2 + (c >> 5), rr = r & 15, cc = c & 31, ob = rr * 64 + cc * 2; return st * 1024 + (ob ^ (((ob >> 9) & 1) << 5)); }
__host__ __device__ __forceinline__ void stage_rc(int b, int& R, int& C) { const int st = b / 1024, sb = b % 1024, swz = sb ^ (((sb >> 9) & 1) << 5); R = (st >> 1) * 16 + swz / 64; C = (st & 1) * 32 + (swz % 64) / 2; }
__host__ __device__ __forceinline__ int perm32(int rho) { const int n = rho >> 4, i = rho & 15; return 8 * (i >> 2) + 4 * n + (i & 3); }

struct Unit { int pm, pn; };
struct Gemm { const bf16_t* A; const bf16_t* Bt; int M, N, K; };

struct StaticOrder {
    typedef Unit UnitT;
    int nM, nN, nwg, G, c;
    __host__ __device__ void init(int M, int N, int G_, int c_) { nM = M / BM; nN = N / BM; nwg = nM * nN; G = G_; c = c_; }
    __host__ __device__ bool next(int i, Unit& u) const {
        const long L = (long)i * G + c; if (L >= nwg) return false;
        int wgid = (int)L; { const int q = nwg / NXCD, r = nwg % NXCD, xcd = wgid % NXCD, off = wgid / NXCD; wgid = (xcd < r ? xcd * (q + 1) : r * (q + 1) + (xcd - r) * q) + off; }
        const int nig = WGM * nN, gid = wgid / nig, fm = gid * WGM, gsz = (nM - fm) < WGM ? (nM - fm) : WGM;
        u.pm = fm + ((wgid % nig) % gsz); u.pn = (wgid % nig) / gsz; return true;
    }
    __device__ __forceinline__ void a_ready(const Unit&) const {}
    __device__ __forceinline__ void done(const Unit&) const {}
};

__device__ __forceinline__ unsigned cvt_pk_bf16(float lo, float hi) { unsigned r; asm volatile("v_cvt_pk_bf16_f32 %0, %1, %2" : "=v"(r) : "v"(lo), "v"(hi)); return r; }
typedef float f32x2 __attribute__((ext_vector_type(2)));
__device__ __forceinline__ f32x2 gelu_pk(f32x2 v) {
    const f32x2 av = __builtin_elementwise_abs(v), d = av * 0.2316418882f + 1.0f;
    f32x2 t; t.x = __builtin_amdgcn_rcpf(d.x); t.y = __builtin_amdgcn_rcpf(d.y);
    f32x2 q = t * 0.5307027145f + (-0.7265760135f); q = q * t + 0.7107068705f; q = q * t + (-0.142248368f); q = q * t + 0.127414796f; q = q * t;
    const f32x2 s = (v * v) * (-0.72134752044f);
    f32x2 e; e.x = __builtin_amdgcn_exp2f(s.x); e.y = __builtin_amdgcn_exp2f(s.y);
    const f32x2 m = v * (q * e), r = v - m;
    f32x2 o; o.x = v.x < 0.f ? m.x : r.x; o.y = v.y < 0.f ? m.y : r.y; return o;
}

template <int ACT  > struct EpiBf16 {
    static constexpr bool PERM = true, AFTER_DRAIN = false; static constexpr int NVM = 0; static_assert(ACT == 0 || ACT == 1, "EpiBf16: ACT is 0 (none) or 1 (gelu_pk)");
    bf16_t* O; int ldc; const float* bias; int split_cols; size_t split_stride; float scale0;
    __device__ __forceinline__ void operator()(const f32x4 (&acc)[2][2][4][2], const Unit& u, int wr, int wc, int fr, int fq) const {
        const int row0 = u.pm * BM + wr * 64 + fr; int colt = u.pn * BM; bf16_t* base = O;
        float sc = 1.f; if (split_cols) { const int t = colt / split_cols; base += (size_t)t * split_stride; colt -= t * split_cols; if (t == 0) sc = scale0; }
        const int col0 = colt + wc * 32 + 8 * fq, bcol0 = u.pn * BM + wc * 32 + 8 * fq;
        f32x4 bv[2][2];
#pragma unroll
        for (int bj = 0; bj < 2; ++bj)
#pragma unroll
            for (int n = 0; n < 2; ++n) bv[bj][n] = bias ? *(const f32x4*)(bias + bcol0 + bj * HALF + 4 * n) : (f32x4){0.f, 0.f, 0.f, 0.f};
#pragma unroll
        for (int ai = 0; ai < 2; ++ai)
#pragma unroll
            for (int m = 0; m < 4; ++m) { bf16_t* rowp = base + (size_t)(row0 + ai * HALF + m * 16) * ldc + col0;
#pragma unroll
                for (int bj = 0; bj < 2; ++bj) { f32x4 v0 = acc[ai][bj][m][0] + bv[bj][0], v1 = acc[ai][bj][m][1] + bv[bj][1];
                    if (ACT == 1) { f32x2 a = gelu_pk((f32x2){v0[0], v0[1]}), b = gelu_pk((f32x2){v0[2], v0[3]}), c = gelu_pk((f32x2){v1[0], v1[1]}), d = gelu_pk((f32x2){v1[2], v1[3]});
                        v0 = (f32x4){a.x, a.y, b.x, b.y}; v1 = (f32x4){c.x, c.y, d.x, d.y}; }
                    v0 = v0 * sc; v1 = v1 * sc; u32x4 w; w.x = cvt_pk_bf16(v0[0], v0[1]); w.y = cvt_pk_bf16(v0[2], v0[3]); w.z = cvt_pk_bf16(v1[0], v1[1]); w.w = cvt_pk_bf16(v1[2], v1[3]);
                    *(u32x4*)(rowp + bj * HALF) = w; } }
    }
};

template <class Epi, class Sched, bool ALIGN_EPI = false, bool SP2 = false>
__device__ __forceinline__ void gemm_phase(PG8_LAS unsigned char* lds, const Gemm g, const Sched& S, const Epi& E) {
    int tid_ = threadIdx.x; asm volatile("" : "+v"(tid_));
    const int tid = tid_, wid = __builtin_amdgcn_readfirstlane(tid >> 6), lane = tid & 63, wr = wid >> 2, wc = wid & 3, fr = lane & 15, fq = lane >> 4;
    const int K = g.K, nt = K / BK;
    unsigned voffA[2], voffB[2];
#pragma unroll
    for (int i = 0; i < 2; ++i) { int R, C; stage_rc(tid * 16 + i * 8192, R, C); const int Rb = Epi::PERM ? ((R & ~31) + perm32(R & 31)) : R;
        voffA[i] = (unsigned)(R * K + C) * 2u; voffB[i] = (unsigned)(Rb * K + C) * 2u; }
    const size_t kstep = (size_t)(BK * 2);
    const size_t hstep = (size_t)HALF * K * 2;
    const size_t tstep = 2 * hstep;
    const unsigned ldsw = (unsigned)wid * 1024u;
    const int aoff = lds_byte(wr * 64 + fr, fq * 8), boff = lds_byte(wc * 32 + fr, fq * 8);
#define PG8_SA(b, h) (((b) * 2 + (h)) * HTB)
#define PG8_SB(b, h) ((4 + (b) * 2 + (h)) * HTB)
#define PG8_STAGE(bufoff, gbase, voff) do { _Pragma("unroll") for (int _i = 0; _i < 2; ++_i) \
        __builtin_amdgcn_global_load_lds((const unsigned*)((const char*)(gbase) + (voff)[_i]), (PG8_LAS unsigned*)(lds + (bufoff) + ldsw + _i * 8192), 16, 0, 0); } while (0)
#define PG8_LDA(dst, b, h) do { _Pragma("unroll") for (int m = 0; m < 4; ++m) _Pragma("unroll") for (int k = 0; k < 2; ++k) dst[m][k] = *(const PG8_LAS bf16x8*)(lds + PG8_SA(b, h) + aoff + m * 2048 + k * 1024); } while (0)
#define PG8_LDB(dst, b, h) do { _Pragma("unroll") for (int n = 0; n < 2; ++n) _Pragma("unroll") for (int k = 0; k < 2; ++k) dst[n][k] = *(const PG8_LAS bf16x8*)(lds + PG8_SB(b, h) + boff + n * 2048 + k * 1024); } while (0)
#define PG8_MMA(ai, bj, At, Bt) do { __builtin_amdgcn_s_setprio(1); _Pragma("unroll") for (int m = 0; m < 4; ++m) _Pragma("unroll") for (int n = 0; n < 2; ++n) _Pragma("unroll") for (int k = 0; k < 2; ++k) \
        acc[ai][bj][m][n] = __builtin_amdgcn_mfma_f32_16x16x32_bf16(Bt[n][k], At[m][k], acc[ai][bj][m][n], 0, 0, 0); __builtin_amdgcn_s_setprio(0); } while (0)
#define PG8_WAIT_V(n) asm volatile("s_waitcnt vmcnt(" #n ")" ::: "memory")
#define PG8_WAIT_V8R(relax) do { if constexpr (Epi::NVM >= 16) asm volatile("s_cmp_lg_u32 %0, 0\n\ts_cbranch_scc1 .Lrx1_%=\n\ts_waitcnt vmcnt(8)\n\ts_branch .Lrx2_%=\n.Lrx1_%=:\n\ts_waitcnt vmcnt(24)\n.Lrx2_%=:" :: "s"(relax) : "memory", "scc"); \
        else if constexpr (Epi::NVM >= 8) asm volatile("s_cmp_lg_u32 %0, 0\n\ts_cbranch_scc1 .Lrx1_%=\n\ts_waitcnt vmcnt(8)\n\ts_branch .Lrx2_%=\n.Lrx1_%=:\n\ts_waitcnt vmcnt(16)\n.Lrx2_%=:" :: "s"(relax) : "memory", "scc"); \
        else asm volatile("s_waitcnt vmcnt(8)" ::: "memory"); } while (0)
#define PG8_WAIT_L(n) asm volatile("s_waitcnt lgkmcnt(" #n ")" ::: "memory")
#define PG8_BAR __builtin_amdgcn_s_barrier()
#define PG8_SCHED __builtin_amdgcn_sched_barrier(0)
    typename Sched::UnitT cur, nxt; int ui = 0;
    if (!S.next(0, cur)) return;
    f32x4 acc[2][2][4][2];
#pragma unroll
    for (int a = 0; a < 2; ++a)
#pragma unroll
        for (int b = 0; b < 2; ++b)
#pragma unroll
            for (int m = 0; m < 4; ++m)
#pragma unroll
                for (int n = 0; n < 2; ++n) acc[a][b][m][n] = (f32x4){0.f, 0.f, 0.f, 0.f};
    bf16x8 At[4][2], B0[2][2], B1[2][2];
    const char* cA = (const char*)g.A + (size_t)cur.pm * tstep; const char* cB = (const char*)g.Bt + (size_t)cur.pn * tstep;
    S.a_ready(cur);
    if constexpr (SP2) {
        PG8_STAGE(PG8_SB(0, 0), cB, voffB); PG8_STAGE(PG8_SB(0, 1), cB + hstep, voffB); PG8_STAGE(PG8_SA(0, 0), cA, voffA); PG8_STAGE(PG8_SA(0, 1), cA + hstep, voffA);
        if (wr == 1) PG8_BAR;
        PG8_WAIT_V(2); PG8_BAR;
        PG8_STAGE(PG8_SB(1, 0), cB + kstep, voffB); PG8_STAGE(PG8_SA(1, 0), cA + kstep, voffA); PG8_STAGE(PG8_SB(1, 1), cB + hstep + kstep, voffB);
        PG8_WAIT_V(6); PG8_BAR;
        PG8_STAGE(PG8_SA(1, 1), cA + kstep + hstep, voffA);
    } else {
        PG8_STAGE(PG8_SB(0, 0), cB, voffB); PG8_STAGE(PG8_SA(0, 0), cA, voffA); PG8_STAGE(PG8_SB(0, 1), cB + hstep, voffB); PG8_STAGE(PG8_SA(0, 1), cA + hstep, voffA);
        if (wr == 1) PG8_BAR;
        PG8_WAIT_V(4); PG8_BAR;
        PG8_STAGE(PG8_SB(1, 0), cB + kstep, voffB); PG8_STAGE(PG8_SA(1, 0), cA + kstep, voffA); PG8_STAGE(PG8_SB(1, 1), cB + hstep + kstep, voffB);
        PG8_WAIT_V(6); PG8_BAR;
    }
    for (;;) {
        const bool has_next = S.next(ui + 1, nxt);
        const char* nA = has_next ? (const char*)g.A + (size_t)nxt.pm * tstep : cA; const char* nB = has_next ? (const char*)g.Bt + (size_t)nxt.pn * tstep : cB;
        for (int t = 0; t < nt; t += 2) {
            const bool last = (t == nt - 2);
            const char* a1 = cA + (size_t)(t + 1) * kstep; (void)a1;
            const char* a2 = last ? nA : cA + (size_t)(t + 2) * kstep; const char* b2 = last ? nB : cB + (size_t)(t + 2) * kstep;
            const char* a3 = a2 + kstep; const char* b3 = b2 + kstep;
            if (last && has_next) S.a_ready(nxt);
            if constexpr (SP2) {
            const int relax = __builtin_amdgcn_readfirstlane(((t == 0) && (ui > 0)) ? 1 : 0);
            PG8_LDB(B0, 0, 0); PG8_LDB(B1, 0, 1); PG8_SCHED; PG8_LDA(At, 0, 0);
            PG8_WAIT_V8R(relax); PG8_WAIT_L(0); PG8_BAR; PG8_MMA(0, 0, At, B0); PG8_MMA(0, 1, At, B1); PG8_BAR; PG8_SCHED;
            PG8_LDA(At, 0, 1); PG8_STAGE(PG8_SB(0, 0), b2, voffB); PG8_STAGE(PG8_SB(0, 1), b2 + hstep, voffB); PG8_STAGE(PG8_SA(0, 0), a2, voffA);
            PG8_WAIT_V8R(relax); PG8_WAIT_L(0); PG8_BAR; PG8_MMA(1, 0, At, B0); PG8_MMA(1, 1, At, B1); PG8_BAR; PG8_SCHED;
            PG8_LDB(B0, 1, 0); PG8_LDB(B1, 1, 1); PG8_SCHED; PG8_LDA(At, 1, 0); PG8_STAGE(PG8_SA(0, 1), a2 + hstep, voffA);
            PG8_WAIT_V8R(relax); PG8_WAIT_L(0); PG8_BAR; PG8_MMA(0, 0, At, B0); PG8_MMA(0, 1, At, B1); PG8_BAR; PG8_SCHED;
            PG8_LDA(At, 1, 1); PG8_STAGE(PG8_SB(1, 0), b3, voffB); PG8_STAGE(PG8_SB(1, 1), b3 + hstep, voffB); PG8_STAGE(PG8_SA(1, 0), a3, voffA);
            PG8_WAIT_V(8); PG8_WAIT_L(0); PG8_BAR; PG8_MMA(1, 0, At, B0); PG8_MMA(1, 1, At, B1); PG8_BAR; PG8_SCHED;
            PG8_STAGE(PG8_SA(1, 1), a3 + hstep, voffA);
            } else {
            PG8_LDB(B0, 0, 0); PG8_SCHED; PG8_LDA(At, 0, 0); PG8_STAGE(PG8_SA(1, 1), a1 + hstep, voffA);
            PG8_WAIT_L(8); PG8_BAR; PG8_WAIT_L(0); PG8_MMA(0, 0, At, B0); PG8_BAR; PG8_SCHED;
            PG8_LDB(B1, 0, 1); PG8_STAGE(PG8_SB(0, 0), b2, voffB);
            PG8_BAR; PG8_WAIT_L(0); PG8_MMA(0, 1, At, B1); PG8_BAR;
            PG8_LDA(At, 0, 1); PG8_STAGE(PG8_SA(0, 0), a2, voffA);
            PG8_BAR; PG8_WAIT_L(0); PG8_MMA(1, 0, At, B0); PG8_BAR; PG8_SCHED;
            PG8_STAGE(PG8_SB(0, 1), b2 + hstep, voffB);
            PG8_WAIT_V(6); PG8_BAR; PG8_MMA(1, 1, At, B1); PG8_BAR;
            PG8_LDB(B0, 1, 0); PG8_SCHED; PG8_LDA(At, 1, 0); PG8_STAGE(PG8_SA(0, 1), a2 + hstep, voffA);
            PG8_WAIT_L(8); PG8_BAR; PG8_WAIT_L(0); PG8_MMA(0, 0, At, B0); PG8_BAR; PG8_SCHED;
            PG8_LDB(B1, 1, 1); PG8_STAGE(PG8_SB(1, 0), b3, voffB);
            PG8_BAR; PG8_WAIT_L(0); PG8_MMA(0, 1, At, B1); PG8_BAR;
            PG8_LDA(At, 1, 1); PG8_STAGE(PG8_SA(1, 0), a3, voffA);
            PG8_BAR; PG8_WAIT_L(0); PG8_MMA(1, 0, At, B0); PG8_BAR; PG8_SCHED;
            PG8_STAGE(PG8_SB(1, 1), b3 + hstep, voffB);
            PG8_WAIT_V(6); PG8_BAR; PG8_MMA(1, 1, At, B1); PG8_BAR;
            }
        }
        if constexpr (ALIGN_EPI) { if (wr == 0) PG8_BAR; }
        if constexpr (!Epi::AFTER_DRAIN) { E(acc, cur, wr, wc, fr, fq); S.done(cur); }
        if (!has_next) break;
#pragma unroll
        for (int a = 0; a < 2; ++a)
#pragma unroll
            for (int b = 0; b < 2; ++b)
#pragma unroll
                for (int m = 0; m < 4; ++m)
#pragma unroll
                    for (int n = 0; n < 2; ++n) acc[a][b][m][n] = (f32x4){0.f, 0.f, 0.f, 0.f};
        cur = nxt; cA = nA; cB = nB; ++ui;
        if constexpr (ALIGN_EPI) { if (wr == 1) PG8_BAR; }
    }
    PG8_WAIT_V(0);
    if constexpr (!ALIGN_EPI) { if (wr == 0) PG8_BAR; }
    PG8_BAR;
    if constexpr (Epi::AFTER_DRAIN) { E.fused(acc, cur, wr, wc, fr, fq, lds, wid, lane); S.done(cur); }
#undef PG8_SA
#undef PG8_SB
#undef PG8_STAGE
#undef PG8_LDA
#undef PG8_LDB
#undef PG8_MMA
#undef PG8_WAIT_V
#undef PG8_WAIT_V8R
#undef PG8_WAIT_L
#undef PG8_BAR
#undef PG8_SCHED
}


__device__ __forceinline__ float quad_sum(float v) {
    auto a = __builtin_amdgcn_permlane16_swap(__float_as_uint(v), __float_as_uint(v), false, false); v = __uint_as_float(a[0]) + __uint_as_float(a[1]);
    auto b = __builtin_amdgcn_permlane32_swap(__float_as_uint(v), __float_as_uint(v), false, false); return __uint_as_float(b[0]) + __uint_as_float(b[1]);
}
__device__ __forceinline__ float sq4(const f32x4& v) { return (v[0] * v[0] + v[1] * v[1]) + (v[2] * v[2] + v[3] * v[3]); }
__device__ __forceinline__ u32x4 pack8(const f32x4& a, const f32x4& b) { u32x4 o; o.x = cvt_pk_bf16(a[0], a[1]); o.y = cvt_pk_bf16(a[2], a[3]); o.z = cvt_pk_bf16(b[0], b[1]); o.w = cvt_pk_bf16(b[2], b[3]); return o; }
__device__ __forceinline__ void store_rows8(bf16_t* base, unsigned rowA, unsigned pitch, const u32x4& x0, const u32x4& x1) {
    u32x4 a, b;
#pragma unroll
    for (int c = 0; c < 4; ++c) { a[c] = (unsigned)__builtin_amdgcn_update_dpp((int)x0[c], (int)x1[c], 0x128, 0xF, 0xC, false); b[c] = (unsigned)__builtin_amdgcn_update_dpp((int)x1[c], (int)x0[c], 0x128, 0xF, 0x3, false); }
    *(u32x4*)(base + rowA * pitch) = a; *(u32x4*)(base + (rowA + 8u) * pitch) = b;
}
struct EpiQKV {
    static constexpr bool PERM = true, AFTER_DRAIN = false; static constexpr int NVM = 16;
    bf16_t* Q; bf16_t* K; bf16_t* V; const float* cosD; const float* sinD; const float* gq; const float* gk; float qscale; float eps;
    __device__ __forceinline__ void operator()(const f32x4 (&acc)[2][2][4][2], const Unit& u, int wr, int wc, int fr, int fq) const {
        asm volatile("" : "+v"(fr), "+v"(fq));
        const int tile = u.pn; const unsigned row0 = (unsigned)(u.pm * BM + wr * 64 + fr);
        if (tile >= 8) {
            const int vh = (tile - 8) * 2 + (wc >> 1); bf16_t* vb = V + (size_t)((((u.pm * BM) >> 11) * 8 + vh) * 2048) * 128 + (wc & 1) * 64 + 32 * (fr >> 3) + fq * 8; const unsigned rowA0 = (unsigned)(((u.pm * BM) & 2047) + wr * 64 + (fr & 7));
#pragma unroll
            for (int ai = 0; ai < 2; ++ai)
#pragma unroll
                for (int m = 0; m < 4; ++m) store_rows8(vb, rowA0 + ai * HALF + m * 16, 128u, pack8(acc[ai][0][m][0], acc[ai][0][m][1]), pack8(acc[ai][1][m][0], acc[ai][1][m][1]));
        } else {
            const bool isk = tile >= 4; const int hm = (tile & 3) * 4 + wc; bf16_t* dst = (isk ? K : Q) + (size_t)((((u.pm * BM) >> 11) * 16 + hm) * 2048) * 64 + 32 * (fr >> 3) + 8 * fq; const unsigned rowA0 = (unsigned)(((u.pm * BM) & 2047) + wr * 64 + (fr & 7)); const float* g = isk ? gk : gq; const float sc = isk ? 1.0f : qscale;
            const f32x4 g0a = *(const f32x4*)(g + 8 * fq), g0b = *(const f32x4*)(g + 8 * fq + 4), g1a = *(const f32x4*)(g + 32 + 8 * fq), g1b = *(const f32x4*)(g + 36 + 8 * fq);
            const unsigned* cs = (const unsigned*)cosD + 8 * fq; (void)sinD;
#pragma unroll
            for (int ai = 0; ai < 2; ++ai)
#pragma unroll
                for (int m = 0; m < 4; ++m) {
                    const unsigned row = row0 + ai * HALF + m * 16;
                    const u32x4 w0 = *(const u32x4*)(cs + row * 32u), w1 = *(const u32x4*)(cs + row * 32u + 4);
                    const f32x4 c0 = {__uint_as_float(w0.x << 16), __uint_as_float(w0.y << 16), __uint_as_float(w0.z << 16), __uint_as_float(w0.w << 16)}, s0 = {__uint_as_float(w0.x & 0xffff0000u), __uint_as_float(w0.y & 0xffff0000u), __uint_as_float(w0.z & 0xffff0000u), __uint_as_float(w0.w & 0xffff0000u)};
                    const f32x4 c1 = {__uint_as_float(w1.x << 16), __uint_as_float(w1.y << 16), __uint_as_float(w1.z << 16), __uint_as_float(w1.w << 16)}, s1 = {__uint_as_float(w1.x & 0xffff0000u), __uint_as_float(w1.y & 0xffff0000u), __uint_as_float(w1.z & 0xffff0000u), __uint_as_float(w1.w & 0xffff0000u)};
                    const f32x4 a0 = acc[ai][0][m][0], a1 = acc[ai][0][m][1], b0 = acc[ai][1][m][0], b1 = acc[ai][1][m][1];
                    const float ss = quad_sum((sq4(a0) + sq4(a1)) + (sq4(b0) + sq4(b1)));
                    const float rs = __builtin_amdgcn_rsqf(ss * (1.0f / 64.0f) + eps) * sc;
                    const f32x4 x1a = a0 * (g0a * rs), x1b = a1 * (g0b * rs), x2a = b0 * (g1a * rs), x2b = b1 * (g1b * rs);
                    store_rows8(dst, rowA0 + ai * HALF + m * 16, 64u, pack8(x1a * c0 - x2a * s0, x1b * c1 - x2b * s1), pack8(x2a * c0 + x1a * s0, x2b * c1 + x1b * s1));
                }
        }
    }
};
template <bool XF32>
struct EpiResid {
    static constexpr bool PERM = true, AFTER_DRAIN = false; static constexpr int NVM = 16;
    const void* xin; bf16_t* xout; const float* gate; float* ssq;
    __device__ __forceinline__ void operator()(const f32x4 (&acc)[2][2][4][2], const Unit& u, int wr, int wc, int fr, int fq) const {
        asm volatile("" : "+v"(fr), "+v"(fq));
        const int b = (u.pm * BM) >> 11; const unsigned colb = (unsigned)(u.pn * BM + wc * 64 + 8 * fq); const unsigned row0 = (unsigned)(u.pm * BM + wr * 64 + fr);
        const float* gp = gate + (size_t)b * 6144 + colb;
        f32x4 g[2][2];
#pragma unroll
        for (int bj = 0; bj < 2; ++bj)
#pragma unroll
            for (int n = 0; n < 2; ++n) g[bj][n] = *(const f32x4*)(gp + bj * 32 + n * 4);
        bf16_t* xo = xout + u.pn * BM + wc * 64 + 32 * (fr >> 3) + 8 * fq; float* sq = ssq + u.pn * 4 + wc; const unsigned rowA0 = (unsigned)(u.pm * BM + wr * 64 + (fr & 7));
#pragma unroll
        for (int ai = 0; ai < 2; ++ai) {
            f32x4 xq[4][2][2];
#pragma unroll
            for (int m = 0; m < 4; ++m) { const unsigned off_ = (row0 + ai * HALF + m * 16) * 1024u + colb;
#pragma unroll
                for (int bj = 0; bj < 2; ++bj) {
                    if (XF32) { xq[m][bj][0] = *(const f32x4*)((const float*)xin + off_ + bj * 32); xq[m][bj][1] = *(const f32x4*)((const float*)xin + off_ + bj * 32 + 4); }
                    else { const u32x4 w = *(const u32x4*)((const bf16_t*)xin + off_ + bj * 32);
                        xq[m][bj][0] = (f32x4){__uint_as_float(w.x << 16), __uint_as_float(w.x & 0xffff0000u), __uint_as_float(w.y << 16), __uint_as_float(w.y & 0xffff0000u)};
                        xq[m][bj][1] = (f32x4){__uint_as_float(w.z << 16), __uint_as_float(w.z & 0xffff0000u), __uint_as_float(w.w << 16), __uint_as_float(w.w & 0xffff0000u)}; } } }
            float ssm = 0.f;
#pragma unroll
            for (int m = 0; m < 4; ++m) {
                float ss = 0.f; u32x4 pk[2];
#pragma unroll
                for (int bj = 0; bj < 2; ++bj) { const f32x4 v0 = xq[m][bj][0] + g[bj][0] * acc[ai][bj][m][0], v1 = xq[m][bj][1] + g[bj][1] * acc[ai][bj][m][1];
                    pk[bj] = pack8(v0, v1); ss += sq4(v0) + sq4(v1); }
                store_rows8(xo, rowA0 + ai * HALF + m * 16, 1024u, pk[0], pk[1]);
                ss = quad_sum(ss);
                ssm = (fq == m) ? ss : ssm;
            }
            sq[(row0 + ai * HALF + 16 * fq) * 16u] = ssm;
        }
    }
};
struct EpiWin {
    static constexpr bool PERM = true, AFTER_DRAIN = false; static constexpr int NVM = 0;
    bf16_t* CQ; bf16_t* CKV; bf16_t* KPE; float* ssq; const float* cosM; const float* sinM; const float* gkpe; float eps; PG8_LAS float* xch;
    __device__ __forceinline__ void operator()(const f32x4 (&acc)[2][2][4][2], const Unit& u, int wr, int wc, int fr, int fq) const {
        asm volatile("" : "+v"(fr), "+v"(fq));
        const int ws = u.pn * 4 + wc; const unsigned row0 = (unsigned)(u.pm * BM + wr * 64 + fr); const unsigned rowA0 = (unsigned)(u.pm * BM + wr * 64 + (fr & 7));
        if (u.pn == 1) {
            float ssv[2][4];
#pragma unroll
            for (int ai = 0; ai < 2; ++ai)
#pragma unroll
                for (int m = 0; m < 4; ++m) { const f32x4 a0 = acc[ai][0][m][0], a1 = acc[ai][0][m][1], b0 = acc[ai][1][m][0], b1 = acc[ai][1][m][1];
                    ssv[ai][m] = quad_sum((sq4(a0) + sq4(a1)) + (sq4(b0) + sq4(b1)));
                    if (fq == 0) xch[(ai * HALF + wr * 64 + m * 16 + fr) * 4 + wc] = ssv[ai][m]; }
            asm volatile("s_waitcnt lgkmcnt(0)" ::: "memory"); __builtin_amdgcn_s_barrier();
            bf16_t* dst = CKV + 64 * wc + 32 * (fr >> 3) + 8 * fq;
#pragma unroll
            for (int ai = 0; ai < 2; ++ai)
#pragma unroll
                for (int m = 0; m < 4; ++m) { const f32x4 p4 = *(const PG8_LAS f32x4*)(xch + (ai * HALF + wr * 64 + m * 16 + fr) * 4);
                    const float rs = __builtin_amdgcn_rsqf(((p4[0] + p4[1]) + (p4[2] + p4[3])) * (1.0f / 256.0f) + eps);
                    store_rows8(dst, rowA0 + ai * HALF + m * 16, 256u, pack8(acc[ai][0][m][0] * rs, acc[ai][0][m][1] * rs), pack8(acc[ai][1][m][0] * rs, acc[ai][1][m][1] * rs)); }
        } else if (ws < 4 || ws == 8 || ws == 9) {
            const int cs = (ws < 4) ? ws : ws - 4;
            bf16_t* dst = CQ + 64 * cs + 32 * (fr >> 3) + 8 * fq; float* sq = ssq + 4 + cs;
#pragma unroll
            for (int ai = 0; ai < 2; ++ai) { float ssm = 0.f;
#pragma unroll
                for (int m = 0; m < 4; ++m) {
                    const f32x4 a0 = acc[ai][0][m][0], a1 = acc[ai][0][m][1], b0 = acc[ai][1][m][0], b1 = acc[ai][1][m][1];
                    store_rows8(dst, rowA0 + ai * HALF + m * 16, 384u, pack8(a0, a1), pack8(b0, b1));
                    const float ss = quad_sum((sq4(a0) + sq4(a1)) + (sq4(b0) + sq4(b1)));
                    ssm = (fq == m) ? ss : ssm;
                }
                sq[(row0 + ai * HALF + 16 * fq) * 16u] = ssm;
            }
        } else if (ws == 10) {
            const f32x4 g0 = *(const f32x4*)(gkpe + 4 * fq), g1 = *(const f32x4*)(gkpe + 16 + 4 * fq);
#pragma unroll
            for (int ai = 0; ai < 2; ++ai)
#pragma unroll
                for (int m = 0; m < 4; ++m) {
                    const unsigned row = row0 + ai * HALF + m * 16;
                    const f32x4 c = *(const f32x4*)(cosM + row * 16u + 4 * fq), sn = *(const f32x4*)(sinM + row * 16u + 4 * fq);
                    const f32x4 y0 = acc[ai][0][m][0], y1 = acc[ai][0][m][1];
                    const float rs = __builtin_amdgcn_rsqf(quad_sum(sq4(y0) + sq4(y1)) * (1.0f / 32.0f) + eps);
                    const f32x4 x1 = y0 * (g0 * rs), x2 = y1 * (g1 * rs);
                    *(u32x4*)(KPE + row * 32u + 8 * fq) = pack8(x1 * c - x2 * sn, x2 * c + x1 * sn);
                }
        }
    }
};
struct EpiUQ {
    static constexpr bool PERM = true, AFTER_DRAIN = false; static constexpr int NVM = 16;
    bf16_t* Q2; const float* ssq; const float* cosM; const float* sinM; const float* gqn; const float* gqp; float qscale; float eps;
    __device__ __forceinline__ void operator()(const f32x4 (&acc)[2][2][4][2], const Unit& u, int wr, int wc, int fr, int fq) const {
        asm volatile("" : "+v"(fr), "+v"(fq));
        const int tile = u.pn; const unsigned row0 = (unsigned)(u.pm * BM + wr * 64 + fr);
        if (tile < 4) {
            bf16_t* dst = Q2 + (size_t)((((u.pm * BM) >> 11) * 16 + tile * 4 + wc) * 2048) * 64 + 32 * (fr >> 3) + 8 * fq; const unsigned rowA0 = (unsigned)(((u.pm * BM) & 2047) + wr * 64 + (fr & 7));
            const f32x4 g0a = *(const f32x4*)(gqn + 8 * fq) * qscale, g0b = *(const f32x4*)(gqn + 8 * fq + 4) * qscale, g1a = *(const f32x4*)(gqn + 32 + 8 * fq) * qscale, g1b = *(const f32x4*)(gqn + 36 + 8 * fq) * qscale;
#pragma unroll
            for (int ai = 0; ai < 2; ++ai) {
                f32x4 sA[4], sB[4];
#pragma unroll
                for (int m = 0; m < 4; ++m) { const unsigned row = row0 + ai * HALF + m * 16; sA[m] = *(const f32x4*)(ssq + row * 16u + 4); sB[m] = *(const f32x4*)(ssq + row * 16u + 8); }
#pragma unroll
                for (int m = 0; m < 4; ++m) {
                    const unsigned row = row0 + ai * HALF + m * 16;
                    const f32x4 a0 = acc[ai][0][m][0], a1 = acc[ai][0][m][1], b0 = acc[ai][1][m][0], b1 = acc[ai][1][m][1];
                    const float ss = quad_sum((sq4(a0) + sq4(a1)) + (sq4(b0) + sq4(b1)));
                    const float em = eps * ((((sA[m][0] + sA[m][1]) + (sA[m][2] + sA[m][3])) + (sB[m][0] + sB[m][1])) * (1.0f / 384.0f) + eps);
                    const float rn = __builtin_amdgcn_rsqf(ss * (1.0f / 64.0f) + em);
                    store_rows8(dst, rowA0 + ai * HALF + m * 16, 64u, pack8(a0 * (g0a * rn), a1 * (g0b * rn)), pack8(b0 * (g1a * rn), b1 * (g1b * rn)));
                }
            }
        } else {
            const f32x4 g0 = *(const f32x4*)(gqp + 4 * fq) * qscale, g1 = *(const f32x4*)(gqp + 16 + 4 * fq) * qscale;
            const int hd0 = ((tile - 4) * 4 + wc) * 2;
            bf16_t* dst = Q2 + (size_t)NTOK * 1024 + (size_t)((((u.pm * BM) >> 11) * 16 + hd0) * 2048) * 32 + 8 * fq; const unsigned rowS0 = (unsigned)(((u.pm * BM) & 2047) + wr * 64 + fr);
#pragma unroll
            for (int ai = 0; ai < 2; ++ai) {
                f32x4 sA[4], sB[4], cc[4], sn[4];
#pragma unroll
                for (int m = 0; m < 4; ++m) { const unsigned row = row0 + ai * HALF + m * 16; sA[m] = *(const f32x4*)(ssq + row * 16u + 4); sB[m] = *(const f32x4*)(ssq + row * 16u + 8);
                    cc[m] = *(const f32x4*)(cosM + row * 16u + 4 * fq); sn[m] = *(const f32x4*)(sinM + row * 16u + 4 * fq); }
#pragma unroll
                for (int m = 0; m < 4; ++m) {
                    const unsigned row = row0 + ai * HALF + m * 16;
                    const float em = eps * ((((sA[m][0] + sA[m][1]) + (sA[m][2] + sA[m][3])) + (sB[m][0] + sB[m][1])) * (1.0f / 384.0f) + eps);
                    u32x4 pk[2];
#pragma unroll
                    for (int bj = 0; bj < 2; ++bj) {
                        const f32x4 y0 = acc[ai][bj][m][0], y1 = acc[ai][bj][m][1];
                        const float rn = __builtin_amdgcn_rsqf(quad_sum(sq4(y0) + sq4(y1)) * (1.0f / 32.0f) + em);
                        const f32x4 x1 = y0 * (g0 * rn), x2 = y1 * (g1 * rn);
                        pk[bj] = pack8(x1 * cc[m] - x2 * sn[m], x2 * cc[m] + x1 * sn[m]);
                    }
                    { const unsigned rs_ = (rowS0 + ai * HALF + m * 16) * 32u; *(u32x4*)(dst + rs_) = pk[0]; *(u32x4*)(dst + (size_t)2048 * 32 + rs_) = pk[1]; }
                }
            }
        }
    }
};
struct EpiUKV {
    static constexpr bool PERM = true, AFTER_DRAIN = false; static constexpr int NVM = 16;
    bf16_t* KV2; const float* gkn; float eps;
    __device__ __forceinline__ void operator()(const f32x4 (&acc)[2][2][4][2], const Unit& u, int wr, int wc, int fr, int fq) const {
        asm volatile("" : "+v"(fr), "+v"(fq));
        const int tile = u.pn, head = (tile & 3) * 4 + wc; const int hcol = 32 * (fr >> 3) + 8 * fq;
        const unsigned rowA0 = (unsigned)(((u.pm * BM) & 2047) + wr * 64 + (fr & 7));
        bf16_t* hb = KV2 + (size_t)((((u.pm * BM) >> 11) * 16 + head) * 2048) * 128;
        if (tile < 4) {
            bf16_t* dst = hb + hcol;
            const f32x4 g0a = *(const f32x4*)(gkn + 8 * fq), g0b = *(const f32x4*)(gkn + 8 * fq + 4), g1a = *(const f32x4*)(gkn + 32 + 8 * fq), g1b = *(const f32x4*)(gkn + 36 + 8 * fq);
#pragma unroll
            for (int ai = 0; ai < 2; ++ai)
#pragma unroll
                for (int m = 0; m < 4; ++m) {
                    const f32x4 a0 = acc[ai][0][m][0], a1 = acc[ai][0][m][1], b0 = acc[ai][1][m][0], b1 = acc[ai][1][m][1];
                    const float rn = __builtin_amdgcn_rsqf(quad_sum((sq4(a0) + sq4(a1)) + (sq4(b0) + sq4(b1))) * (1.0f / 64.0f) + eps);
                    store_rows8(dst, rowA0 + ai * HALF + m * 16, 128u, pack8(a0 * (g0a * rn), a1 * (g0b * rn)), pack8(b0 * (g1a * rn), b1 * (g1b * rn)));
                }
        } else {
            bf16_t* dst = hb + 64 + hcol;
#pragma unroll
            for (int ai = 0; ai < 2; ++ai)
#pragma unroll
                for (int m = 0; m < 4; ++m) store_rows8(dst, rowA0 + ai * HALF + m * 16, 128u, pack8(acc[ai][0][m][0], acc[ai][0][m][1]), pack8(acc[ai][1][m][0], acc[ai][1][m][1]));
        }
    }
};
struct MUnit { int pm, pn, e, r0, par; };
struct MoeOrder {
    typedef MUnit UnitT;
    const int* tpre; int ncol, G, c, total;
    PG8_LAS unsigned char* etab = nullptr; const int* glist = nullptr; int ntok = 0;
    __device__ __forceinline__ bool next(int i, MUnit& u) const {
        const int L = i * G + c; if (L >= total) return false;
        const int rt = L / ncol, ct = L - rt * ncol; const int e = tpre[33 + rt];
        u.e = e; u.pm = rt; u.r0 = (rt - tpre[e]) * 256; u.pn = e * ncol + ct; u.par = i & 1; return true;
    }
    __device__ __forceinline__ void a_ready(const MUnit& u) const {
        if (etab) { const int t = threadIdx.x; if (__builtin_amdgcn_readfirstlane(t >> 6) == 0)
            __builtin_amdgcn_global_load_lds((const unsigned*)(glist + (size_t)u.e * ntok + u.r0 + 4 * (t & 63)), (PG8_LAS unsigned*)(etab + u.par * 1024), 16, 0, 0); }
    }
    __device__ __forceinline__ void done(const MUnit&) const {}
};
__device__ __forceinline__ float silu_f(float a) { return a * __builtin_amdgcn_rcpf(1.0f + __builtin_amdgcn_exp2f(-1.4426950408889634f * a)); }
struct EpiMoe1 {
    static constexpr bool PERM = true, AFTER_DRAIN = false; static constexpr int NVM = 0;
    bf16_t* hid; const int* glist; const PG8_LAS float* wtab; const int* cntl; int ntok;
    __device__ __forceinline__ void operator()(const f32x4 (&acc)[2][2][4][2], const MUnit& u, int wr, int wc, int fr, int fq) const {
        const int cnt = cntl[u.e], t = u.pn & 1;
        asm volatile("" : "+v"(fr), "+v"(fq));
        float wrow[2][4];
#pragma unroll
        for (int ai = 0; ai < 2; ++ai)
#pragma unroll
            for (int m = 0; m < 4; ++m) { const int rl_ = ai * HALF + wr * 64 + m * 16 + fr; const float w_ = wtab[u.par * 256 + rl_]; wrow[ai][m] = (u.r0 + rl_ < cnt) ? w_ : 0.f; }
#pragma unroll
        for (int ai = 0; ai < 2; ++ai)
#pragma unroll
            for (int m = 0; m < 4; ++m) {
                const int rl = ai * HALF + wr * 64 + m * 16 + fr; const float w = wrow[ai][m];
                const f32x4 a0 = acc[ai][0][m][0], a1 = acc[ai][0][m][1], b0 = acc[ai][1][m][0], b1 = acc[ai][1][m][1];
                u32x4 o;
                o.x = cvt_pk_bf16(silu_f(a0[0]) * b0[0] * w, silu_f(a0[1]) * b0[1] * w); o.y = cvt_pk_bf16(silu_f(a0[2]) * b0[2] * w, silu_f(a0[3]) * b0[3] * w);
                o.z = cvt_pk_bf16(silu_f(a1[0]) * b1[0] * w, silu_f(a1[1]) * b1[1] * w); o.w = cvt_pk_bf16(silu_f(a1[2]) * b1[2] * w, silu_f(a1[3]) * b1[3] * w);
                *(u32x4*)(hid + ((size_t)u.pm * BM + rl) * 256 + t * 128 + wc * 32 + fq * 8) = o;
                asm volatile("" ::: "memory");
            }
    }
};
struct EpiMoe2 {
    static constexpr bool PERM = true, AFTER_DRAIN = false; static constexpr int NVM = 8;
    unsigned char* y2; const PG8_LAS int* etab; const int* cntl; int ntok;
    __device__ __forceinline__ void operator()(const f32x4 (&acc)[2][2][4][2], const MUnit& u, int wr, int wc, int fr, int fq) const {
        const int cnt = cntl[u.e], ct = u.pn & 3;
        asm volatile("" : "+v"(fr), "+v"(fq));
        int ents[2][4];
#pragma unroll
        for (int ai = 0; ai < 2; ++ai)
#pragma unroll
            for (int m = 0; m < 4; ++m) { const int rl = ai * HALF + wr * 64 + m * 16 + fr; const int e_ = etab[u.par * 256 + rl]; ents[ai][m] = (u.r0 + rl < cnt) ? e_ : 2 * ntok; }
#pragma unroll
        for (int ai = 0; ai < 2; ++ai)
#pragma unroll
            for (int m = 0; m < 4; ++m) {
                unsigned char* rowp = y2 + (size_t)(unsigned)ents[ai][m] * 1024 + ct * 256 + wc * 64 + fq * 16;
                unsigned q[2][2];
#pragma unroll
                for (int bj = 0; bj < 2; ++bj) { const f32x4 v0 = acc[ai][bj][m][0] * 32.0f, v1 = acc[ai][bj][m][1] * 32.0f;
                    int p = __builtin_amdgcn_cvt_pk_fp8_f32(v0[0], v0[1], 0, false); p = __builtin_amdgcn_cvt_pk_fp8_f32(v0[2], v0[3], p, true); q[bj][0] = (unsigned)p;
                    p = __builtin_amdgcn_cvt_pk_fp8_f32(v1[0], v1[1], 0, false); p = __builtin_amdgcn_cvt_pk_fp8_f32(v1[2], v1[3], p, true); q[bj][1] = (unsigned)p; }
#pragma unroll
                for (int d = 0; d < 2; ++d) { auto s1 = __builtin_amdgcn_permlane32_swap(q[0][d], q[1][d], false, false); auto s2 = __builtin_amdgcn_permlane16_swap(s1[0], s1[1], false, false); q[0][d] = s2[0]; q[1][d] = s2[1]; }
                *(u32x4*)rowp = (u32x4){q[0][0], q[0][1], q[1][0], q[1][1]};
                asm volatile("" ::: "memory");
            }
    }
};
template <class Epi, class Sched, bool FP8 = false>
__device__ __forceinline__ void gemm_phase_gather(PG8_LAS unsigned char* lds, const bf16_t* A, const bf16_t* Bt, int K, const int* glist, int ntok, const int* cntl, const Sched& S, const Epi& E) {
    int tid_ = threadIdx.x; asm volatile("" : "+v"(tid_));
    const int tid = tid_, wid = __builtin_amdgcn_readfirstlane(tid >> 6), lane = tid & 63, wr = wid >> 2, wc = wid & 3, fr = lane & 15, fq = lane >> 4;
    const int rowb = FP8 ? K : 2 * K, nt = FP8 ? K / (2 * BK) : K / BK;
    unsigned voffB[2];
#pragma unroll
    for (int i = 0; i < 2; ++i) { int R, C; stage_rc(tid * 16 + i * 8192, R, C); const int Rb = Epi::PERM ? ((R & ~31) + perm32(R & 31)) : R;
        voffB[i] = (unsigned)(Rb * rowb + C * 2); }
    const size_t kstep = (size_t)(BK * 2);
    const size_t hstep = (size_t)HALF * rowb;
    const size_t tstep = 2 * hstep;
    const unsigned ldsw = (unsigned)wid * 1024u;
    const int aoff = lds_byte(wr * 64 + fr, fq * 8), boff = lds_byte(wc * 32 + fr, fq * 8);
#define PG8_SA(b, h) (((b) * 2 + (h)) * HTB)
#define PG8_SB(b, h) ((4 + (b) * 2 + (h)) * HTB)
#define PG8_STAGE(bufoff, gbase, voff) do { _Pragma("unroll") for (int _i = 0; _i < 2; ++_i) \
        __builtin_amdgcn_global_load_lds((const unsigned*)((const char*)(gbase) + (voff)[_i]), (PG8_LAS unsigned*)(lds + (bufoff) + ldsw + _i * 8192), 16, 0, 0); } while (0)
    typedef int i32x4_ __attribute__((ext_vector_type(4))); typedef int i32x8_ __attribute__((ext_vector_type(8)));
#define PG8_LDA(dst, b, h) do { _Pragma("unroll") for (int m = 0; m < 4; ++m) { if constexpr (FP8) { const i32x4_ l0_ = *(const PG8_LAS i32x4_*)(lds + PG8_SA(b, h) + aoff + m * 2048), l1_ = *(const PG8_LAS i32x4_*)(lds + PG8_SA(b, h) + aoff + m * 2048 + 1024); \
            dst##8[m] = __builtin_shufflevector(l0_, l1_, 0, 1, 2, 3, 4, 5, 6, 7); } else { _Pragma("unroll") for (int k = 0; k < 2; ++k) dst[m][k] = *(const PG8_LAS bf16x8*)(lds + PG8_SA(b, h) + aoff + m * 2048 + k * 1024); } } } while (0)
#define PG8_LDB(dst, b, h) do { _Pragma("unroll") for (int n = 0; n < 2; ++n) { if constexpr (FP8) { const i32x4_ l0_ = *(const PG8_LAS i32x4_*)(lds + PG8_SB(b, h) + boff + n * 2048), l1_ = *(const PG8_LAS i32x4_*)(lds + PG8_SB(b, h) + boff + n * 2048 + 1024); \
            dst##8[n] = __builtin_shufflevector(l0_, l1_, 0, 1, 2, 3, 4, 5, 6, 7); } else { _Pragma("unroll") for (int k = 0; k < 2; ++k) dst[n][k] = *(const PG8_LAS bf16x8*)(lds + PG8_SB(b, h) + boff + n * 2048 + k * 1024); } } } while (0)
#define PG8_MMA(ai, bj, At, Bt) do { __builtin_amdgcn_s_setprio(1); _Pragma("unroll") for (int m = 0; m < 4; ++m) _Pragma("unroll") for (int n = 0; n < 2; ++n) { \
        if constexpr (FP8) acc[ai][bj][m][n] = __builtin_amdgcn_mfma_scale_f32_16x16x128_f8f6f4(Bt##8[n], At##8[m], acc[ai][bj][m][n], 0, 0, 0, 0x7a7a7a7a, 0, 0x7f7f7f7f); \
        else { _Pragma("unroll") for (int k = 0; k < 2; ++k) acc[ai][bj][m][n] = __builtin_amdgcn_mfma_f32_16x16x32_bf16(Bt[n][k], At[m][k], acc[ai][bj][m][n], 0, 0, 0); } } \
        __builtin_amdgcn_s_setprio(0); } while (0)
#define PG8_WAIT_V(n) asm volatile("s_waitcnt vmcnt(" #n ")" ::: "memory")
#define PG8_WAIT_L(n) asm volatile("s_waitcnt lgkmcnt(" #n ")" ::: "memory")
#define PG8_BAR __builtin_amdgcn_s_barrier()
#define PG8_SCHED __builtin_amdgcn_sched_barrier(0)
#define PG8_GOFF(u, off) do { const int _cnt = cntl[(u).e]; _Pragma("unroll") for (int _h = 0; _h < 2; ++_h) _Pragma("unroll") for (int _i = 0; _i < 2; ++_i) { \
        int _R, _C; stage_rc(tid * 16 + _i * 8192, _R, _C); const int _r = (u).r0 + _h * HALF + _R; const int _ent = glist[(unsigned)((u).e * ntok + (_r < _cnt ? _r : 0))]; \
        off[_h][_i] = (unsigned)(_ent >> 1) * (unsigned)rowb + (unsigned)(_C * 2); } } while (0)
    typename Sched::UnitT cur, nxt; int ui = 0;
    if (!S.next(0, cur)) return;
    f32x4 acc[2][2][4][2];
#pragma unroll
    for (int a = 0; a < 2; ++a)
#pragma unroll
        for (int b = 0; b < 2; ++b)
#pragma unroll
            for (int m = 0; m < 4; ++m)
#pragma unroll
                for (int n = 0; n < 2; ++n) acc[a][b][m][n] = (f32x4){0.f, 0.f, 0.f, 0.f};
    bf16x8 At[4][2], B0[2][2], B1[2][2]; i32x8_ At8[4], B08[2], B18[2];
    unsigned coff[2][2], noff[2][2];
    PG8_GOFF(cur, coff); S.a_ready(cur);
    const char* cA = (const char*)A; const char* cB = (const char*)Bt + (size_t)cur.pn * tstep;
    PG8_STAGE(PG8_SB(0, 0), cB, voffB); PG8_STAGE(PG8_SB(0, 1), cB + hstep, voffB); PG8_STAGE(PG8_SA(0, 0), cA, coff[0]); PG8_STAGE(PG8_SA(0, 1), cA, coff[1]);
    if (wr == 1) PG8_BAR;
    PG8_WAIT_V(2); PG8_BAR;
    PG8_STAGE(PG8_SB(1, 0), cB + kstep, voffB); PG8_STAGE(PG8_SA(1, 0), cA + kstep, coff[0]); PG8_STAGE(PG8_SB(1, 1), cB + hstep + kstep, voffB);
    PG8_WAIT_V(6); PG8_BAR;
    for (;;) {
        const bool has_next = S.next(ui + 1, nxt);
        if (has_next) { PG8_GOFF(nxt, noff); } else {
#pragma unroll
            for (int h = 0; h < 2; ++h)
#pragma unroll
                for (int i = 0; i < 2; ++i) noff[h][i] = coff[h][i]; }
        const char* nB = has_next ? (const char*)Bt + (size_t)nxt.pn * tstep : cB;
        for (int t = 0; t < nt; t += 2) {
            const bool last = (t == nt - 2);
            if (last && has_next) S.a_ready(nxt);
            const char* a1 = cA + (size_t)(t + 1) * kstep;
            const char* a2 = last ? cA : cA + (size_t)(t + 2) * kstep; const char* b2 = last ? nB : cB + (size_t)(t + 2) * kstep;
            const char* a3 = a2 + kstep; const char* b3 = b2 + kstep;
            PG8_LDB(B0, 0, 0); PG8_LDB(B1, 0, 1); PG8_SCHED; PG8_LDA(At, 0, 0); PG8_STAGE(PG8_SA(1, 1), a1, coff[1]);
            if (last) {
#pragma unroll
                for (int h = 0; h < 2; ++h)
#pragma unroll
                    for (int i = 0; i < 2; ++i) coff[h][i] = noff[h][i]; }
            PG8_WAIT_V(8); PG8_WAIT_L(0); PG8_BAR; PG8_MMA(0, 0, At, B0); PG8_MMA(0, 1, At, B1); PG8_BAR; PG8_SCHED;
            PG8_LDA(At, 0, 1); PG8_STAGE(PG8_SB(0, 0), b2, voffB); PG8_STAGE(PG8_SB(0, 1), b2 + hstep, voffB); PG8_STAGE(PG8_SA(0, 0), a2, coff[0]);
            PG8_WAIT_V(8); PG8_WAIT_L(0); PG8_BAR; PG8_MMA(1, 0, At, B0); PG8_MMA(1, 1, At, B1); PG8_BAR; PG8_SCHED;
            PG8_LDB(B0, 1, 0); PG8_LDB(B1, 1, 1); PG8_SCHED; PG8_LDA(At, 1, 0); PG8_STAGE(PG8_SA(0, 1), a2, coff[1]);
            PG8_WAIT_V(8); PG8_WAIT_L(0); PG8_BAR; PG8_MMA(0, 0, At, B0); PG8_MMA(0, 1, At, B1); PG8_BAR; PG8_SCHED;
            PG8_LDA(At, 1, 1); PG8_STAGE(PG8_SB(1, 0), b3, voffB); PG8_STAGE(PG8_SB(1, 1), b3 + hstep, voffB); PG8_STAGE(PG8_SA(1, 0), a3, coff[0]);
            PG8_WAIT_V(8); PG8_WAIT_L(0); PG8_BAR; PG8_MMA(1, 0, At, B0); PG8_MMA(1, 1, At, B1); PG8_BAR; PG8_SCHED;
        }
        if (wr == 0) PG8_BAR;
        E(acc, cur, wr, wc, fr, fq);
        if (!has_next) break;
#pragma unroll
        for (int a = 0; a < 2; ++a)
#pragma unroll
            for (int b = 0; b < 2; ++b)
#pragma unroll
                for (int m = 0; m < 4; ++m)
#pragma unroll
                    for (int n = 0; n < 2; ++n) acc[a][b][m][n] = (f32x4){0.f, 0.f, 0.f, 0.f};
        cur = nxt; cB = nB; ++ui;
        if (wr == 1) PG8_BAR;
    }
    PG8_WAIT_V(0);
    PG8_BAR;
#undef PG8_SA
#undef PG8_SB
#undef PG8_STAGE
#undef PG8_LDA
#undef PG8_LDB
#undef PG8_MMA
#undef PG8_WAIT_V
#undef PG8_WAIT_L
#undef PG8_BAR
#undef PG8_SCHED
#undef PG8_GOFF
}
}

#define PG8_SP2 true
#define PG8_ALIGN true

struct Args { const float* in[33]; float* out; unsigned char* ws; int ph_lo, ph_hi; };
enum { I_X = 0, I_C, I_POS, I_ADAW, I_ADAB, I_NMIX, I_NFFN, I_DA_WQKV, I_DA_QN, I_DA_KN, I_DA_LQ1, I_DA_LK1, I_DA_LQ2, I_DA_LK2,
       I_DA_SUBLN, I_DA_WO, I_M_WIN, I_M_QAN, I_M_KVAN, I_M_WUQ, I_M_WUKV, I_M_QNN, I_M_QPN, I_M_KNN, I_M_KPN, I_M_WO,
       I_E_WG, I_E_BG, I_E_WR, I_E_BR, I_E_W1, I_E_W3, I_E_W2 };

typedef float f32x2c_ __attribute__((ext_vector_type(2))); typedef __bf16 bf16x2c_ __attribute__((ext_vector_type(2)));
__device__ __forceinline__ unsigned fa_cvtpk(float lo, float hi) { f32x2c_ v = {lo, hi}; bf16x2c_ b = __builtin_convertvector(v, bf16x2c_); return __builtin_bit_cast(unsigned, b); }
struct Ctx {
    const float* const* in; float* out; unsigned char* ws; unsigned char* lds;
    int tid, lane, wave, gw, ngw;
    __device__ __forceinline__ const float* mod(int layer, int b, int chunk) const { return (const float*)(ws + WS_MOD) + ((size_t)(layer * NB + b) * 6144 + chunk * 1024); }
};

__device__ __forceinline__ void normmod_row(const f32x4 (&v)[4], f32x4 (&h)[4], const float* g, const float* sh, const float* sc, int lane) {
    float s = 0.f;
#pragma unroll
    for (int j = 0; j < 4; ++j) s += (v[j].x * v[j].x + v[j].y * v[j].y) + (v[j].z * v[j].z + v[j].w * v[j].w);
    const float rstd = 1.0f / sqrtf(wave_sum(s) * (1.0f / D) + EPS);
#pragma unroll
    for (int j = 0; j < 4; ++j) {
        const f32x4 gg = *(const f32x4*)(g + 4 * lane + 256 * j), ss = *(const f32x4*)(sh + 4 * lane + 256 * j), cc = *(const f32x4*)(sc + 4 * lane + 256 * j);
        h[j] = (v[j] * rstd) * gg * (cc + 1.0f) + ss;
    }
}
__device__ __forceinline__ void store_row_bf16(bf16* row, const f32x4 (&h)[4], int lane) {
#pragma unroll
    for (int j = 0; j < 4; ++j) { u32x2 o; o.x = pk2(h[j].x, h[j].y); o.y = pk2(h[j].z, h[j].w); *(u32x2*)(row + 4 * lane + 256 * j) = o; }
}
__device__ __forceinline__ void load_row_fp8(const unsigned char* row, f32x4 (&h)[4], int lane) {
#pragma unroll
    for (int j = 0; j < 4; ++j) { const int w = *(const int*)(row + 4 * lane + 256 * j); const auto lo = __builtin_amdgcn_cvt_pk_f32_fp8(w, false), hi = __builtin_amdgcn_cvt_pk_f32_fp8(w, true);
        h[j] = (f32x4){lo[0], lo[1], hi[0], hi[1]} * 0.03125f; }
}
__device__ __forceinline__ void load_row_bf16(const bf16* row, f32x4 (&h)[4], int lane) {
#pragma unroll
    for (int j = 0; j < 4; ++j) { const u32x2 o = *(const u32x2*)(row + 4 * lane + 256 * j);
        h[j] = (f32x4){bf2f(o.x & 0xffffu), bf2f(o.x >> 16), bf2f(o.y & 0xffffu), bf2f(o.y >> 16)}; }
}


struct TItem { const float* src; bf16* dst; const float* kg; int ldw, K, perm, f8; };
__device__ __forceinline__ void titem_load(const TItem& t, f32x4 (&v)[8], int lane) {
    const float* p = t.src + (size_t)(lane >> 3) * t.ldw + 4 * (lane & 7);
#pragma unroll
    for (int i = 0; i < 8; ++i) v[i] = *(const f32x4*)(p + (size_t)(8 * i) * t.ldw);
}
__device__ __forceinline__ void titem_finish(const TItem& t, const f32x4 (&v)[8], float* scr, int lane) {
    const int rr = lane >> 3, c4 = lane & 7;
#pragma unroll
    for (int i = 0; i < 8; ++i) { f32x4 x = v[i]; if (t.kg) x = x * t.kg[8 * i + rr]; float* d = scr + (8 * i + rr) * 33 + 4 * c4; d[0] = x[0]; d[1] = x[1]; d[2] = x[2]; d[3] = x[3]; }
    asm volatile("s_waitcnt lgkmcnt(0)" ::: "memory");
    const int c = lane & 7;
#pragma unroll
    for (int j = 0; j < 4; ++j) { const int n = (lane >> 3) + 8 * j; const int nl = t.perm ? (16 * ((n >> 2) & 1) + 4 * (n >> 3) + (n & 3)) : n;
        const float* sp = scr + (8 * c) * 33 + nl;
        if (t.f8) { int p0 = __builtin_amdgcn_cvt_pk_fp8_f32(sp[0 * 33] * 32.0f, sp[1 * 33] * 32.0f, 0, false); p0 = __builtin_amdgcn_cvt_pk_fp8_f32(sp[2 * 33] * 32.0f, sp[3 * 33] * 32.0f, p0, true);
            int p1 = __builtin_amdgcn_cvt_pk_fp8_f32(sp[4 * 33] * 32.0f, sp[5 * 33] * 32.0f, 0, false); p1 = __builtin_amdgcn_cvt_pk_fp8_f32(sp[6 * 33] * 32.0f, sp[7 * 33] * 32.0f, p1, true);
            u32x2 o; o.x = (unsigned)p0; o.y = (unsigned)p1; *(u32x2*)((unsigned char*)t.dst + (size_t)n * t.K + 8 * c) = o; }
        else { u32x4 o; o.x = pk2(sp[0 * 33], sp[1 * 33]); o.y = pk2(sp[2 * 33], sp[3 * 33]); o.z = pk2(sp[4 * 33], sp[5 * 33]); o.w = pk2(sp[6 * 33], sp[7 * 33]);
            *(u32x4*)(t.dst + (size_t)n * t.K + 8 * c) = o; } }
    asm volatile("s_waitcnt lgkmcnt(0)" ::: "memory");
}
__device__ __forceinline__ TItem titem_make(const float* W, int ldw, int K, bf16* WT, int k0, int n0, int prow0, const float* kgain, bool perm) {
    TItem t; t.src = W + (size_t)k0 * ldw + n0; t.dst = WT + (size_t)prow0 * K + k0; t.kg = kgain ? kgain + k0 : nullptr; t.ldw = ldw; t.K = K; t.perm = perm ? 1 : 0; t.f8 = 0; return t;
}
constexpr int TI_QKV = 16 * 96, TI_O = 16 * 32, TI_WIN = 16 * 21, TI_UQ = 6 * 48, TI_UKV = 4 * 64, TI_DENSE = TI_QKV + 2 * TI_O + TI_WIN + TI_UQ + TI_UKV, TI_ALL = TI_DENSE + 24576;
__device__ __forceinline__ TItem titem_decode(const Ctx& C, int it) {
    int r = it;
    if (r < TI_QKV) { const int kb = r / 96, lb = r % 96; int pb = lb;
        if (lb < 64) { const int sect = lb >> 5, hm = (lb & 31) >> 1, half = lb & 1; pb = (sect * 4 + (hm >> 2)) * 8 + half * 4 + (hm & 3); }
        else pb = (lb & ~7) + 4 * (lb & 1) + ((lb & 7) >> 1);
        return titem_make(as_global(C.in[I_DA_WQKV]), 3072, 1024, (bf16*)(C.ws + WB_QKV), 64 * kb, 32 * lb, 32 * pb, nullptr, false); } r -= TI_QKV;
    if (r < TI_O) { const int cb = r % 32; return titem_make(as_global(C.in[I_DA_WO]), 1024, 1024, (bf16*)(C.ws + WB_DAO), 64 * (r / 32), 32 * cb, 32 * ((cb & ~7) + 4 * (cb & 1) + ((cb & 7) >> 1)), nullptr, false); } r -= TI_O;
    if (r < TI_O) { const int cb = r % 32; return titem_make(as_global(C.in[I_M_WO]), 1024, 1024, (bf16*)(C.ws + WB_MLO), 64 * (r / 32), 32 * cb, 32 * ((cb & ~7) + 4 * (cb & 1) + ((cb & 7) >> 1)), nullptr, false); } r -= TI_O;
    if (r < TI_WIN) { const int kb = r / 21, lb = r % 21; int pb = 18;
        if (lb < 20) { const int wsrc = lb >> 1, wsl = (wsrc < 4) ? wsrc : (wsrc < 6 ? wsrc + 4 : wsrc - 2);
            pb = (wsl >> 2) * 8 + (lb & 1) * 4 + (wsl & 3); }
        return titem_make(as_global(C.in[I_M_WIN]), 672, 1024, (bf16*)(C.ws + WB_WIN), 64 * kb, 32 * lb, 32 * pb, nullptr, lb == 20); } r -= TI_WIN;
    if (r < TI_UQ) { const int kb = r / 48, lb = r % 48, h = lb / 3, part = lb % 3; int pb;
        if (part < 2) pb = (h >> 2) * 8 + part * 4 + (h & 3); else { const int sl = h >> 1; pb = (4 + (sl >> 2)) * 8 + (h & 1) * 4 + (sl & 3); }
        return titem_make(as_global(C.in[I_M_WUQ]), 1536, 384, (bf16*)(C.ws + WB_WUQ), 64 * kb, 32 * lb, 32 * pb, as_global(C.in[I_M_QAN]), part == 2); } r -= TI_UQ;
    if (r < TI_UKV) { const int kb = r / 64, lb = r % 64, h = lb >> 2, part = lb & 3; const int pb = (((part < 2) ? 0 : 4) + (h >> 2)) * 8 + (part & 1) * 4 + (h & 3);
        return titem_make(as_global(C.in[I_M_WUKV]), 2048, 256, (bf16*)(C.ws + WB_WUKV), 64 * kb, 32 * lb, 32 * pb, as_global(C.in[I_M_KVAN]), false); } r -= TI_UKV;
    if (r < 16384) { const int item = r & 63, mat = (r >> 6) & 1, t = (r >> 7) & 1, e = (r >> 8) & 31, l = r >> 13; const int kb = item >> 2, nb = item & 3;
        const float* W = as_global(C.in[mat ? I_E_W3 : I_E_W1]) + (size_t)(l * 32 + e) * 1024 * 256 + 128 * t;
        TItem ti = titem_make(W, 256, 1024, (bf16*)(C.ws + WB_MOE + (size_t)l * 48 * MiB), 64 * kb, 32 * nb, e * 512 + 256 * t + 128 * mat + 32 * nb, nullptr, false);
        ti.f8 = 1; ti.dst = (bf16*)((unsigned char*)(C.ws + WB_MOE + (size_t)l * 48 * MiB) + (size_t)(e * 512 + 256 * t + 128 * mat + 32 * nb) * 1024 + 64 * kb); return ti; }
    r -= 16384;
    { const int item = r & 127, e = (r >> 7) & 31, l = r >> 12; const int kb = item >> 5, nb = item & 31;
      const float* W = as_global(C.in[I_E_W2]) + (size_t)(l * 32 + e) * 256 * 1024;
      return titem_make(W, 1024, 256, (bf16*)(C.ws + WB_MOE + (size_t)l * 48 * MiB + 32 * MiB), 64 * kb, 32 * nb, e * 1024 + 32 * ((nb & ~7) + 4 * (nb & 1) + ((nb & 7) >> 1)), nullptr, false); }
}
__device__ __forceinline__ void ph_prologue(const Ctx& C) {
    {
        float* sc = (float*)C.lds;
        float* red = sc + 16384;
        const float* c = as_global(C.in[I_C]); const float* adaw = as_global(C.in[I_ADAW]); const float* adab = as_global(C.in[I_ADAB]); float* mod = (float*)(C.ws + WS_MOD);
        int have_bhf = -1;
        for (int item = blockIdx.x; item < 384; item += gridDim.x) {
            const int layer = item / 192, r = item % 192, cc = r >> 1, bhf = r & 1;
            __syncthreads();
            if (bhf != have_bhf) {
                for (int idx = C.tid; idx < 16384; idx += NTHR) { const float v = c[(size_t)(bhf * 16) * D + idx]; sc[(idx & 1023) * 16 + (idx >> 10)] = v / (1.0f + expf(-v)); }
                have_bhf = bhf;
            }
            __syncthreads();
            const int c2 = C.lane & 31, ksub = C.lane >> 5, ks = C.wave;
            typedef float f32x2w __attribute__((ext_vector_type(2)));
            f32x2w acc2[16];
#pragma unroll
            for (int i = 0; i < 16; ++i) acc2[i] = (f32x2w){0.f, 0.f};
            const float* wp = adaw + ((size_t)layer * D + ks * 128 + ksub) * 6144 + cc * 64 + 2 * c2;
#pragma unroll 4
            for (int kk = 0; kk < 64; ++kk) {
                const f32x2w w = *(const f32x2w*)(wp + (size_t)(2 * kk) * 6144); const float* sp = sc + (ks * 128 + 2 * kk + ksub) * 16;
#pragma unroll
                for (int i = 0; i < 4; ++i) { const f32x4 s4 = *(const f32x4*)(sp + 4 * i);
#pragma unroll
                    for (int q = 0; q < 4; ++q) acc2[4 * i + q] += w * s4[q]; }
            }
#pragma unroll
            for (int i = 0; i < 16; ++i) {
                auto rx = __builtin_amdgcn_permlane32_swap(__float_as_uint(acc2[i].x), __float_as_uint(acc2[i].x), false, false), ry = __builtin_amdgcn_permlane32_swap(__float_as_uint(acc2[i].y), __float_as_uint(acc2[i].y), false, false);
                const float x = __uint_as_float(rx[0]) + __uint_as_float(rx[1]), y = __uint_as_float(ry[0]) + __uint_as_float(ry[1]);
                if (ksub == 0) *(f32x2w*)(red + (ks * 16 + i) * 64 + 2 * c2) = (f32x2w){x, y};
            }
            __syncthreads();
            for (int o = C.tid; o < 1024; o += NTHR) { const int i = o >> 6, cl = o & 63; float sm = adab[layer * 6144 + cc * 64 + cl];
#pragma unroll
                for (int k2 = 0; k2 < 8; ++k2) sm += red[(k2 * 16 + i) * 64 + cl];
                mod[(size_t)(layer * NB + bhf * 16 + i) * 6144 + cc * 64 + cl] = sm; }
        }
        if (blockIdx.x == 0 && C.wave == 0) {
            const float a = wave_sum(as_global(C.in[I_DA_LQ1])[C.lane] * as_global(C.in[I_DA_LK1])[C.lane]);
            const float b = wave_sum(as_global(C.in[I_DA_LQ2])[C.lane] * as_global(C.in[I_DA_LK2])[C.lane]);
            if (C.lane == 0) *(float*)(C.ws + WS_LAM) = expf(a) - expf(b) + 0.2f;
        }
    }
    __syncthreads();
    {
        float* ivf = (float*)C.lds;
        if (C.tid < 32) ivf[C.tid] = powf(10000.0f, -(float)(2 * C.tid) / 64.0f); else if (C.tid < 48) ivf[C.tid] = powf(10000.0f, -(float)(2 * (C.tid - 32)) / 32.0f);
        __syncthreads();
        const int* pos = (const int*)as_global(C.in[I_POS]);
        float* cosD = (float*)(C.ws + WS_COSD); float* sinD = (float*)(C.ws + WS_SIND); float* cosM = (float*)(C.ws + WS_COSM); float* sinM = (float*)(C.ws + WS_SINM);
        const int gt = blockIdx.x * NTHR + C.tid, ngt = gridDim.x * NTHR;
        for (int idx = gt; idx < NTOK * 32; idx += ngt) {
            const float ang = (float)pos[idx >> 5] * ivf[idx & 31]; float rev = ang * 0.15915494309189535f; rev -= floorf(rev);
            ((unsigned*)cosD)[idx] = fa_cvtpk(__builtin_amdgcn_cosf(rev), __builtin_amdgcn_sinf(rev)); (void)sinD;
        }
        for (int idx = gt; idx < NTOK * 16; idx += ngt) {
            const float ang = (float)pos[idx >> 4] * ivf[32 + (idx & 15)]; float rev = ang * 0.15915494309189535f; rev -= floorf(rev);
            cosM[idx] = __builtin_amdgcn_cosf(rev); sinM[idx] = __builtin_amdgcn_sinf(rev);
        }
        float* wrt = (float*)(C.ws + WS_WRT); const float* wr = as_global(C.in[I_E_WR]);
        for (int idx = gt; idx < 2 * 32 * 1024; idx += ngt) { const int l = idx >> 15, rem = idx & 32767, k8 = rem >> 8, e = (rem >> 3) & 31, kj = rem & 7, k = 8 * k8 + kj; wrt[idx] = wr[((size_t)l * 1024 + k) * 32 + e]; }
        for (int idx = gt; idx < 96 * 1024 / 8; idx += ngt) { const int blk = idx / 4096, rem = idx % 4096; const int pb = (blk == 0) ? 19 : 21 + blk;
            *(u32x4*)((bf16*)(C.ws + WB_WIN) + (size_t)pb * 32 * 1024 + (size_t)rem * 8) = (u32x4){0u, 0u, 0u, 0u}; }
    }
    __syncthreads();
    {
        float* scr = (float*)(C.lds + C.wave * 16384);
        f32x4 va[8], vb[8];
#pragma unroll 1
        for (int it = 2 * C.gw; it < TI_ALL; it += 2 * C.ngw) {
            const bool hasb = it + 1 < TI_ALL;
            const TItem ta = titem_decode(C, it), tb = titem_decode(C, hasb ? it + 1 : it);
            titem_load(ta, va, C.lane); if (hasb) titem_load(tb, vb, C.lane);
            titem_finish(ta, va, scr, C.lane); if (hasb) titem_finish(tb, vb, scr, C.lane);
        }
    }
}
__device__ __forceinline__ void ph_normmod0(const Ctx& C) {
    const float* x = as_global(C.in[I_X]); bf16* H = (bf16*)(C.ws + WS_H); const float* g = as_global(C.in[I_NMIX]);
    for (int chunk = blockIdx.x; chunk < NTOK / 256; chunk += gridDim.x) {
        const int tok0 = chunk * 256 + C.wave * 32, b = tok0 / SEQ;
        const float* shp = C.mod(0, b, 0); const float* scp = C.mod(0, b, 1);
        f32x4 gm[4], sh[4];
#pragma unroll
        for (int j = 0; j < 4; ++j) { gm[j] = *(const f32x4*)(g + 4 * C.lane + 256 * j) * (*(const f32x4*)(scp + 4 * C.lane + 256 * j) + 1.0f); sh[j] = *(const f32x4*)(shp + 4 * C.lane + 256 * j); }
#pragma unroll 2
        for (int i = 0; i < 32; ++i) {
            const int tok = tok0 + i; f32x4 v[4], h[4];
#pragma unroll
            for (int j = 0; j < 4; ++j) v[j] = *(const f32x4*)(x + (size_t)tok * D + 4 * C.lane + 256 * j);
            float sq = 0.f;
#pragma unroll
            for (int j = 0; j < 4; ++j) sq += (v[j].x * v[j].x + v[j].y * v[j].y) + (v[j].z * v[j].z + v[j].w * v[j].w);
            const float rstd = 1.0f / sqrtf(wave_sum(sq) * (1.0f / D) + EPS);
#pragma unroll
            for (int j = 0; j < 4; ++j) h[j] = (v[j] * rstd) * gm[j] + sh[j];
            store_row_bf16(H + (size_t)tok * D, h, C.lane);
        }
    }
}
template <bool FINAL>
__device__ __forceinline__ void ph_comb(const Ctx& C, const unsigned char* y2, const float* gate_chunk_base  , int nlayer, const float* gnorm) {
    bf16* H = (bf16*)(C.ws + WS_H); const int lane = C.lane;
    if constexpr (FINAL) {
    for (int chunk = blockIdx.x; chunk < NTOK / 256; chunk += gridDim.x) {
        const int bq = (chunk * 256) / SEQ; const float* gate = gate_chunk_base + (size_t)bq * 6144;
        f32x4 gg[4];
#pragma unroll
        for (int j = 0; j < 4; ++j) gg[j] = *(const f32x4*)(gate + 4 * lane + 256 * j);
        for (int i = 0; i < 32; ++i) {
            const int tok = chunk * 256 + C.wave * 32 + i;
            f32x4 v[4], a[4], a2[4];
            load_row_bf16((const bf16*)(C.ws + WS_XB) + (size_t)tok * D, v, lane);
            load_row_fp8(y2 + (size_t)(2 * tok) * D, a, lane); load_row_fp8(y2 + (size_t)(2 * tok + 1) * D, a2, lane);
#pragma unroll
            for (int j = 0; j < 4; ++j) { v[j] += gg[j] * (a[j] + a2[j]);
                *(f32x4*)(as_global(C.out) + (size_t)tok * D + 4 * lane + 256 * j) = v[j]; }
        }
    }
    } else {
    bf16* XB = (bf16*)(C.ws + WS_XB);
    for (int chunk = blockIdx.x; chunk < NTOK / 256; chunk += gridDim.x) {
        const int tok0 = chunk * 256 + C.wave * 32, b = tok0 / SEQ;
        const float* gate = gate_chunk_base + (size_t)b * 6144; const float* shp = C.mod(nlayer, b, 0); const float* scp = C.mod(nlayer, b, 1);
        f32x4 gt[2][2], gm[2][2], sh[2][2];
#pragma unroll
        for (int g = 0; g < 2; ++g)
#pragma unroll
            for (int q = 0; q < 2; ++q) { const int c = 512 * g + 8 * lane + 4 * q;
                gt[g][q] = *(const f32x4*)(gate + c) * 0.03125f;
                gm[g][q] = *(const f32x4*)(gnorm + c) * (*(const f32x4*)(scp + c) + 1.0f); sh[g][q] = *(const f32x4*)(shp + c); }
#pragma unroll 2
        for (int i = 0; i < 32; ++i) {
            const int tok = tok0 + i;
            u32x4 xw[2]; u32x2 ya[2], yb[2];
#pragma unroll
            for (int g = 0; g < 2; ++g) { xw[g] = *(const u32x4*)(XB + (size_t)tok * D + 512 * g + 8 * lane);
                ya[g] = *(const u32x2*)(y2 + (size_t)(2 * tok) * D + 512 * g + 8 * lane); yb[g] = *(const u32x2*)(y2 + (size_t)(2 * tok + 1) * D + 512 * g + 8 * lane); }
            f32x4 v[2][2]; float ssq = 0.f;
#pragma unroll
            for (int g = 0; g < 2; ++g) {
                const f32x4 x0 = {__uint_as_float(xw[g].x << 16), __uint_as_float(xw[g].x & 0xffff0000u), __uint_as_float(xw[g].y << 16), __uint_as_float(xw[g].y & 0xffff0000u)};
                const f32x4 x1 = {__uint_as_float(xw[g].z << 16), __uint_as_float(xw[g].z & 0xffff0000u), __uint_as_float(xw[g].w << 16), __uint_as_float(xw[g].w & 0xffff0000u)};
                const auto a0 = __builtin_amdgcn_cvt_pk_f32_fp8((int)ya[g].x, false), a1 = __builtin_amdgcn_cvt_pk_f32_fp8((int)ya[g].x, true), a2_ = __builtin_amdgcn_cvt_pk_f32_fp8((int)ya[g].y, false), a3 = __builtin_amdgcn_cvt_pk_f32_fp8((int)ya[g].y, true);
                const auto b0 = __builtin_amdgcn_cvt_pk_f32_fp8((int)yb[g].x, false), b1 = __builtin_amdgcn_cvt_pk_f32_fp8((int)yb[g].x, true), b2 = __builtin_amdgcn_cvt_pk_f32_fp8((int)yb[g].y, false), b3 = __builtin_amdgcn_cvt_pk_f32_fp8((int)yb[g].y, true);
                v[g][0] = x0 + gt[g][0] * (f32x4){a0[0] + b0[0], a0[1] + b0[1], a1[0] + b1[0], a1[1] + b1[1]};
                v[g][1] = x1 + gt[g][1] * (f32x4){a2_[0] + b2[0], a2_[1] + b2[1], a3[0] + b3[0], a3[1] + b3[1]};
                u32x4 o; o.x = fa_cvtpk(v[g][0][0], v[g][0][1]); o.y = fa_cvtpk(v[g][0][2], v[g][0][3]); o.z = fa_cvtpk(v[g][1][0], v[g][1][1]); o.w = fa_cvtpk(v[g][1][2], v[g][1][3]);
                *(u32x4*)(XB + (size_t)tok * D + 512 * g + 8 * lane) = o;
#pragma unroll
                for (int q = 0; q < 2; ++q) ssq += (v[g][q][0] * v[g][q][0] + v[g][q][1] * v[g][q][1]) + (v[g][q][2] * v[g][q][2] + v[g][q][3] * v[g][q][3]);
            }
            const float rstd = 1.0f / sqrtf(wave_sum(ssq) * (1.0f / D) + EPS);
#pragma unroll
            for (int g = 0; g < 2; ++g) {
                const f32x4 h0 = (v[g][0] * rstd) * gm[g][0] + sh[g][0], h1 = (v[g][1] * rstd) * gm[g][1] + sh[g][1];
                u32x4 o; o.x = fa_cvtpk(h0[0], h0[1]); o.y = fa_cvtpk(h0[2], h0[3]); o.z = fa_cvtpk(h1[0], h1[1]); o.w = fa_cvtpk(h1[2], h1[3]);
                *(u32x4*)(H + (size_t)tok * D + 512 * g + 8 * lane) = o;
            }
        }
    }
    }
}

constexpr int MOE_TAB_OFF = 131072 + 512;
__device__ __forceinline__ void moe_prefix256(const Ctx& C, int moe_layer, int* cntl, int* tpre) {
    const unsigned* cnt = (const unsigned*)(C.ws + WS_CTL) + CW_CNT + moe_layer * 32 * 64;
    __syncthreads();
    if (C.tid < 64) {
        const int e = C.tid & 31; const int c = (int)__hip_atomic_load(cnt + e * 64, __ATOMIC_RELAXED, __HIP_MEMORY_SCOPE_AGENT); const int nt = (c + 255) >> 8;
        int inc = nt;
#pragma unroll
        for (int d = 1; d < 32; d <<= 1) { const int o = __shfl_up(inc, d, 32); if (e >= d) inc += o; }
        const int ex = inc - nt;
        if (C.tid < 32) { cntl[e] = c; tpre[e] = ex; if (e == 31) tpre[32] = inc; for (int rt = ex; rt < inc; ++rt) tpre[33 + rt] = e; }
    }
    __syncthreads();
}
__device__ __forceinline__ void ph_moe1_mfma(const Ctx& C, int moe_layer) {
    int* cntl = (int*)(C.lds + MOE_TAB_OFF); int* tpre = cntl + 32;
    moe_prefix256(C, moe_layer, cntl, tpre);
    pg8::MoeOrder S{tpre, 2, (int)gridDim.x, (((int)blockIdx.x & 7) * 32 + ((int)blockIdx.x >> 3)), tpre[32] * 2};
    S.etab = (PG8_LAS unsigned char*)C.lds + 139264; S.glist = (const int*)(C.ws + WS_LISTW); S.ntok = NTOK;
    pg8::EpiMoe1 E{(bf16*)(C.ws + WS_A), (const int*)(C.ws + WS_LIST), (const PG8_LAS float*)((PG8_LAS unsigned char*)C.lds + 139264), cntl, NTOK};
    int K1 = 1024; asm volatile("" : "+s"(K1));
    pg8::gemm_phase_gather<pg8::EpiMoe1, pg8::MoeOrder, true>((PG8_LAS unsigned char*)C.lds, (const bf16*)(C.ws + WS_H), (const bf16*)(C.ws + WB_MOE + (size_t)moe_layer * 48 * MiB), K1,
                                                        (const int*)(C.ws + WS_LIST), NTOK, cntl, S, E);
}
__device__ __forceinline__ void ph_moe2_mfma(const Ctx& C, int moe_layer, bool have_tab) {
    int* cntl = (int*)(C.lds + MOE_TAB_OFF); int* tpre = cntl + 32;
    if (!have_tab) moe_prefix256(C, moe_layer, cntl, tpre);
    pg8::MoeOrder S{tpre, 4, (int)gridDim.x, (((int)blockIdx.x & 7) * 32 + ((int)blockIdx.x >> 3)), tpre[32] * 4};
    S.etab = (PG8_LAS unsigned char*)C.lds + 139264; S.glist = (const int*)(C.ws + WS_LIST); S.ntok = NTOK;
    pg8::EpiMoe2 E{(unsigned char*)(C.ws + WS_A + 128 * MiB), (const PG8_LAS int*)((PG8_LAS unsigned char*)C.lds + 139264), cntl, NTOK};
    int K2 = 256; asm volatile("" : "+s"(K2));
    pg8::Gemm g{(const bf16*)(C.ws + WS_A), (const bf16*)(C.ws + WB_MOE + (size_t)moe_layer * 48 * MiB + 32 * MiB), 0, 0, K2};
    pg8::gemm_phase<pg8::EpiMoe2, pg8::MoeOrder, PG8_ALIGN, PG8_SP2>((PG8_LAS unsigned char*)C.lds, g, S, E);
}

namespace fa {
typedef short bf16x8 __attribute__((ext_vector_type(8)));
typedef short s16x4 __attribute__((ext_vector_type(4)));
typedef float f32x16 __attribute__((ext_vector_type(16)));
typedef __attribute__((address_space(3))) const char* lds_cptr;
__device__ __forceinline__ int crow(int r, int hi) { return (r & 3) + 8 * (r >> 2) + 4 * hi; }
__device__ __forceinline__ s16x4 vtr(lds_cptr p) { return __builtin_bit_cast(s16x4, __builtin_amdgcn_ds_read_tr16_b64_v4i16((__attribute__((address_space(3))) s16x4*)p)); }
typedef float f32x2_t __attribute__((ext_vector_type(2))); typedef __bf16 bf16x2_t __attribute__((ext_vector_type(2)));
__device__ __forceinline__ unsigned cvtpk(float lo, float hi) { f32x2_t v = {lo, hi}; bf16x2_t b = __builtin_convertvector(v, bf16x2_t); return __builtin_bit_cast(unsigned, b); }
__device__ __forceinline__ float half_swap_max(float v) { auto rr = __builtin_amdgcn_permlane32_swap(__float_as_uint(v), __float_as_uint(v), false, false); return fmaxf(__uint_as_float(rr[0]), __uint_as_float(rr[1])); }
__device__ __forceinline__ float half_swap_sum(float v) { auto rr = __builtin_amdgcn_permlane32_swap(__float_as_uint(v), __float_as_uint(v), false, false); return __uint_as_float(rr[0]) + __uint_as_float(rr[1]); }
__device__ __forceinline__ void dma16(const void* gsrc, LAS unsigned char* ldsdst) { unsigned keep; const unsigned dst = (unsigned)__builtin_amdgcn_readfirstlane((int)(unsigned)(uintptr_t)ldsdst);
    asm volatile("s_mov_b32 %0, m0\n\ts_mov_b32 m0, %2\n\ts_nop 0\n\tglobal_load_lds_dwordx4 %1, off\n\ts_mov_b32 m0, %0" : "=&s"(keep) : "v"(gsrc), "s"(dst) : "memory"); }
__device__ __forceinline__ void dma16s(const void* sbase_, unsigned voff, LAS unsigned char* ldsdst) { unsigned keep; const unsigned dst = (unsigned)__builtin_amdgcn_readfirstlane((int)(unsigned)(uintptr_t)ldsdst);
    const unsigned long long sb_ = (unsigned long long)(uintptr_t)sbase_; const unsigned lo_ = (unsigned)__builtin_amdgcn_readfirstlane((int)(unsigned)sb_), hi_ = (unsigned)__builtin_amdgcn_readfirstlane((int)(unsigned)(sb_ >> 32));
    const void* sbase = (const void*)(uintptr_t)(((unsigned long long)hi_ << 32) | lo_);
    asm volatile("s_mov_b32 %0, m0\n\ts_mov_b32 m0, %3\n\ts_nop 0\n\tglobal_load_lds_dwordx4 %1, %2\n\ts_mov_b32 m0, %0" : "=&s"(keep) : "v"(voff), "s"(sbase), "s"(dst) : "memory"); }

template <int ND0, int NDB, bool NOMAX = false>
__device__ __forceinline__ void tile(lds_cptr Kslot, lds_cptr Vslot, const bf16x8 (&qf)[ND0], f32x16 (&o)[NDB], f32x16& negm, float& m, float& l,
                                     LAS float* wsf, bool first, bool chk, bool diag, int qloc, int lane) {
    const int r32 = lane & 31, hi = lane >> 5;
    lds_cptr kb = Kslot + hi * 1024 + r32 * 16; lds_cptr kr = Kslot + r32 * 128; const int ksw = (r32 >> 1) & 7;
    bf16x8 kf0[ND0], kf1[ND0];
#pragma unroll
    for (int d0 = 0; d0 < ND0; ++d0) {
        if (d0 < 4) { const int so = ((2 * d0 + hi) ^ ksw) * 16;
            kf0[d0] = *(const __attribute__((address_space(3))) bf16x8*)(kr + so);
            kf1[d0] = *(const __attribute__((address_space(3))) bf16x8*)(kr + so + 4096); }
        else {
        kf0[d0] = *(const __attribute__((address_space(3))) bf16x8*)(kb + d0 * 2048);
        kf1[d0] = *(const __attribute__((address_space(3))) bf16x8*)(kb + d0 * 2048 + 512); }
    }
#pragma unroll
    for (int d0 = 0; d0 < ND0; ++d0) asm volatile("" : "+v"(kf0[d0]), "+v"(kf1[d0]));
    const f32x16 zero16 = {0.f, 0.f, 0.f, 0.f, 0.f, 0.f, 0.f, 0.f, 0.f, 0.f, 0.f, 0.f, 0.f, 0.f, 0.f, 0.f};
    f32x16 p0 = __builtin_amdgcn_mfma_f32_32x32x16_bf16(kf0[0], qf[0], NOMAX ? zero16 : negm, 0, 0, 0);
    f32x16 p1 = __builtin_amdgcn_mfma_f32_32x32x16_bf16(kf1[0], qf[0], NOMAX ? zero16 : negm, 0, 0, 0);
#pragma unroll
    for (int d0 = 1; d0 < ND0; ++d0) {
        p0 = __builtin_amdgcn_mfma_f32_32x32x16_bf16(kf0[d0], qf[d0], p0, 0, 0, 0);
        p1 = __builtin_amdgcn_mfma_f32_32x32x16_bf16(kf1[d0], qf[d0], p1, 0, 0, 0);
    }
    __builtin_amdgcn_sched_barrier(0);
    lds_cptr vp = Vslot + ((lane >> 4) & 1) * 32 + (lane & 3) * 8 + (4 * hi + ((lane & 15) >> 2)) * 64;
    constexpr int NE = (NDB < 2 ? NDB : 2) * 4;
    s16x4 vlo[NDB * 4], vhi[NDB * 4];
#pragma unroll
    for (int i = 0; i < NE; ++i) { vlo[i] = vtr(vp + (i >> 2) * 4096 + (i & 3) * 1024); vhi[i] = vtr(vp + (i >> 2) * 4096 + (i & 3) * 1024 + 512); }
    __builtin_amdgcn_sched_barrier(0);
    if (diag) {
#pragma unroll
        for (int r = 0; r < 16; ++r) { const int kv = crow(r, hi); if (kv > qloc) p0[r] = -1e30f; if (kv + 32 > qloc) p1[r] = -1e30f; }
    }
    if (!NOMAX && chk) {
    float mx = fmaxf(fmaxf(p0[0], p1[0]), p0[1]);
#pragma unroll
    for (int r = 1; r < 16; ++r) { if (r > 1) mx = fmaxf(fmaxf(mx, p0[r]), p1[r]); else mx = fmaxf(mx, p1[r]); }
    mx = half_swap_max(mx);
    const bool need = first || (__builtin_amdgcn_ballot_w64(mx > 8.0f) != 0ull);
    if (need) {
        const float dl = first ? mx : fmaxf(mx, 0.f);
        m += dl;
#pragma unroll
        for (int r = 0; r < 16; ++r) { p0[r] -= dl; p1[r] -= dl; negm[r] = -m; }
        if (!first) {
            const float al = __builtin_amdgcn_exp2f(-dl); l *= al;
            if (hi == 0) wsf[r32] = al;
            asm volatile("s_waitcnt lgkmcnt(0)" ::: "memory");
            f32x4 a4[4];
#pragma unroll
            for (int g = 0; g < 4; ++g) a4[g] = *(const LAS f32x4*)(wsf + 8 * g + 4 * hi);
#pragma unroll
            for (int db = 0; db < NDB; ++db)
#pragma unroll
                for (int r = 0; r < 16; ++r) o[db][r] *= a4[r >> 2][r & 3];
        }
    }
    }
    float sum = 0.f;
#pragma unroll
    for (int ks = 0; ks < 4; ++ks) {
        float e[8];
#pragma unroll
        for (int j = 0; j < 8; ++j) { const float x = (ks < 2) ? p0[8 * ks + j] : p1[8 * (ks - 2) + j]; e[j] = __builtin_amdgcn_exp2f(x); }
        sum += ((e[0] + e[1]) + (e[2] + e[3])) + ((e[4] + e[5]) + (e[6] + e[7]));
        u32x4 w; w.x = cvtpk(e[0], e[1]); w.y = cvtpk(e[2], e[3]); w.z = cvtpk(e[4], e[5]); w.w = cvtpk(e[6], e[7]);
        const bf16x8 pa = __builtin_bit_cast(bf16x8, w);
        if (ks == 0 && NE < NDB * 4) {
#pragma unroll
            for (int i = NE; i < NDB * 4; ++i) { vlo[i] = vtr(vp + (i >> 2) * 4096 + (i & 3) * 1024); vhi[i] = vtr(vp + (i >> 2) * 4096 + (i & 3) * 1024 + 512); }
        }
        __builtin_amdgcn_s_setprio(1);
#pragma unroll
        for (int db = 0; db < NDB; ++db) {
            const s16x4 lo = vlo[db * 4 + ks], hh = vhi[db * 4 + ks];
            const bf16x8 vf = (bf16x8){lo[0], lo[1], lo[2], lo[3], hh[0], hh[1], hh[2], hh[3]};
            o[db] = __builtin_amdgcn_mfma_f32_32x32x16_bf16(pa, vf, o[db], 0, 0, 0);
        }
        __builtin_amdgcn_s_setprio(0);
    }
    l += sum;
}
}


__device__ __forceinline__ void ph_route(const Ctx& C, int layer) {
    typedef float f32x16 __attribute__((ext_vector_type(16)));
    LAS float* hT = (LAS float*)C.lds + C.wave * (32 * 68);
    LAS float* rsl = (LAS float*)C.lds + 8 * 32 * 68 + C.wave * 32;
    int* le0 = (int*)(C.lds + 73728); int* le1 = le0 + 256; int* hist = le1 + 256; int* base = hist + 32; float* lw0 = (float*)(base + 32); float* lw1 = lw0 + 256;
    const bf16* x1 = (const bf16*)(C.ws + WS_XB); unsigned char* H8 = C.ws + WS_H; float* listw = (float*)(C.ws + WS_LISTW); int* list = (int*)(C.ws + WS_LIST);
    unsigned* cnt = (unsigned*)(C.ws + WS_CTL) + CW_CNT + layer * 32 * 64;
    const float* ssqx = (const float*)(C.ws + WS_SSQX);
    const float* gn = as_global(C.in[I_NFFN]) + layer * D;
    const float* WrT = (const float*)(C.ws + WS_WRT) + (size_t)layer * 32 * 1024; const float* wg = as_global(C.in[I_E_WG]) + (size_t)layer * D * 4;
    const float* bg = as_global(C.in[I_E_BG]) + layer * 4; const float* br = as_global(C.in[I_E_BR]) + layer * 32;
    const int lane = C.lane, r32 = lane & 31, hi = lane >> 5, w = C.wave, kq = lane & 7, tsub = lane >> 3;
    LAS float* wgl = (LAS float*)(C.lds + 81920);
    LAS float* gmL = (LAS float*)(C.lds + 98304); LAS float* shL = gmL + 1024;
    __syncthreads();
    const f32x4 wgr0 = *(const f32x4*)(wg + (size_t)C.tid * 4), wgr1 = *(const f32x4*)(wg + (size_t)(C.tid + NTHR) * 4); bool wg_pending = true;
    for (int chunk = blockIdx.x; chunk < NTOK / 256; chunk += gridDim.x) {
        __syncthreads();
        if (C.tid < 32) hist[C.tid] = 0;
        const int tok0 = chunk * 256 + w * 32, b = tok0 >> 11;
        const float* shp = C.mod(layer, b, 3); const float* scp = C.mod(layer, b, 4);
        const int t4 = 4 * (C.tid & 255);
        const f32x4 g4 = *(const f32x4*)(gn + t4), sc4 = *(const f32x4*)(scp + t4), sh4 = *(const f32x4*)(shp + t4);
        const float* sp = ssqx + (size_t)(tok0 + r32) * 16; const f32x4 s0 = *(const f32x4*)sp, s1 = *(const f32x4*)(sp + 4), s2 = *(const f32x4*)(sp + 8), s3 = *(const f32x4*)(sp + 12);
        const unsigned xoff = (unsigned)(tok0 + tsub) * 1024u + 8u * kq;
        const unsigned woff = (unsigned)r32 * 8u + 4u * hi;
        u32x4 xr0[4];
#pragma unroll
        for (int i = 0; i < 4; ++i) xr0[i] = *(const u32x4*)(x1 + (xoff + 8192u * i));
        f32x4 X[4][2], Wa[8], Wb[8];
#pragma unroll
        for (int c = 0; c < 8; ++c) Wa[c] = *(const f32x4*)(WrT + (woff + 256u * c));
        if (wg_pending) { *(LAS f32x4*)(wgl + C.tid * 4) = wgr0; *(LAS f32x4*)(wgl + (C.tid + NTHR) * 4) = wgr1; wg_pending = false; }
        if (C.tid < 256) { *(LAS f32x4*)(gmL + t4) = g4 * (sc4 + 1.0f); *(LAS f32x4*)(shL + t4) = sh4; }
        { const float sm = ((s0[0] + s0[1]) + (s0[2] + s0[3])) + ((s1[0] + s1[1]) + (s1[2] + s1[3])) + ((s2[0] + s2[1]) + (s2[2] + s2[3])) + ((s3[0] + s3[1]) + (s3[2] + s3[3]));
          if (hi == 0) rsl[r32] = 1.0f / sqrtf(sm * (1.0f / D) + EPS); }
        __syncthreads();
#pragma unroll
        for (int i = 0; i < 4; ++i) { const u32x4 w_ = xr0[i];
            X[i][0] = (f32x4){__uint_as_float(w_.x << 16), __uint_as_float(w_.x & 0xffff0000u), __uint_as_float(w_.y << 16), __uint_as_float(w_.y & 0xffff0000u)};
            X[i][1] = (f32x4){__uint_as_float(w_.z << 16), __uint_as_float(w_.z & 0xffff0000u), __uint_as_float(w_.w << 16), __uint_as_float(w_.w & 0xffff0000u)}; }
        f32x16 acc;
#pragma unroll
        for (int r = 0; r < 16; ++r) acc[r] = 0.f;
        float gl[4] = {0.f, 0.f, 0.f, 0.f};
#define RT_LOADX(kc_) do { _Pragma("unroll") for (int i = 0; i < 4; ++i) { const u32x4 w_ = *(const u32x4*)(x1 + (xoff + 8192u * i + 64u * (kc_))); \
            X[i][0] = (f32x4){__uint_as_float(w_.x << 16), __uint_as_float(w_.x & 0xffff0000u), __uint_as_float(w_.y << 16), __uint_as_float(w_.y & 0xffff0000u)}; \
            X[i][1] = (f32x4){__uint_as_float(w_.z << 16), __uint_as_float(w_.z & 0xffff0000u), __uint_as_float(w_.w << 16), __uint_as_float(w_.w & 0xffff0000u)}; } } while (0)
#define RT_LOADW(W, kc_) do { _Pragma("unroll") for (int c = 0; c < 8; ++c) W[c] = *(const f32x4*)(WrT + (woff + 2048u * (kc_) + 256u * c)); } while (0)
#define RT_STEP(W, WN, kc_) do { const unsigned k8 = 64u * (kc_) + 8u * kq; \
            const f32x4 gma = *(const LAS f32x4*)(gmL + k8), gmb = *(const LAS f32x4*)(gmL + k8 + 4), sha = *(const LAS f32x4*)(shL + k8), shb = *(const LAS f32x4*)(shL + k8 + 4); \
            _Pragma("unroll") for (int i = 0; i < 4; ++i) { const int tl = 8 * i + tsub; const float rsd = rsl[tl]; const f32x4 ha = (X[i][0] * rsd) * gma + sha, hb = (X[i][1] * rsd) * gmb + shb; \
                int oa = __builtin_amdgcn_cvt_pk_fp8_f32(ha[0], ha[1], 0, false); oa = __builtin_amdgcn_cvt_pk_fp8_f32(ha[2], ha[3], oa, true); \
                int ob = __builtin_amdgcn_cvt_pk_fp8_f32(hb[0], hb[1], 0, false); ob = __builtin_amdgcn_cvt_pk_fp8_f32(hb[2], hb[3], ob, true); \
                u32x2 o8; o8.x = (unsigned)oa; o8.y = (unsigned)ob; *(u32x2*)(H8 + (xoff + 8192u * i + 64u * (kc_))) = o8; \
                *(LAS f32x4*)(hT + tl * 68 + 8 * kq) = ha; *(LAS f32x4*)(hT + tl * 68 + 8 * kq + 4) = hb; } \
            if ((kc_) + 1 < 16) { RT_LOADX((kc_) + 1); RT_LOADW(WN, (kc_) + 1); } \
            _Pragma("unroll") for (int c = 0; c < 8; ++c) { const f32x4 b4 = *(const LAS f32x4*)(hT + r32 * 68 + 8 * c + 4 * hi); \
                _Pragma("unroll") for (int j = 0; j < 4; ++j) { acc = __builtin_amdgcn_mfma_f32_32x32x2f32(W[c][j], b4[j], acc, 0, 0, 0); \
                    const f32x4 w4 = *(const LAS f32x4*)(wgl + (64 * (kc_) + 8 * c + 4 * hi + j) * 4); \
                    _Pragma("unroll") for (int q = 0; q < 4; ++q) gl[q] += b4[j] * w4[q]; } asm volatile("" : "+v"(gl[0]), "+v"(gl[1]), "+v"(gl[2]), "+v"(gl[3])); } } while (0)
#pragma unroll 1
        for (int kc = 0; kc < 16; kc += 2) {
            RT_STEP(Wa, Wb, kc);
            RT_STEP(Wb, Wa, kc + 1);
        }
#undef RT_LOADX
#undef RT_LOADW
#undef RT_STEP
#pragma unroll
        for (int q = 0; q < 4; ++q) gl[q] = fa::half_swap_sum(gl[q]);
        float gp[4]; { const float gm = fmaxf(fmaxf(gl[0], gl[1]), fmaxf(gl[2], gl[3])); float gs = 0.f;
#pragma unroll
            for (int g = 0; g < 4; ++g) { gp[g] = expf(gl[g] - gm); gs += gp[g]; }
#pragma unroll
            for (int g = 0; g < 4; ++g) gp[g] /= gs; }
        int gi = 0; float best = -1e30f, gate = 0.f;
#pragma unroll
        for (int g = 0; g < 4; ++g) { const float sv = gp[g] + bg[g]; if (sv > best) { best = sv; gi = g; gate = gp[g]; } }
        float el[8];
#pragma unroll
        for (int j = 0; j < 4; ++j) { const float own = (gi == 0) ? acc[j] : (gi == 1) ? acc[4 + j] : (gi == 2) ? acc[8 + j] : acc[12 + j];
            auto rr = __builtin_amdgcn_permlane32_swap(__float_as_uint(own), __float_as_uint(own), false, false);
            el[j] = __uint_as_float(rr[0]); el[4 + j] = __uint_as_float(rr[1]); }
        float em = el[0];
#pragma unroll
        for (int e = 1; e < 8; ++e) em = fmaxf(em, el[e]);
        float ep[8], es = 0.f;
#pragma unroll
        for (int e = 0; e < 8; ++e) { ep[e] = expf(el[e] - em); es += ep[e]; }
        int i0 = 0; float b0 = -1e30f, p0 = 0.f;
#pragma unroll
        for (int e = 0; e < 8; ++e) { ep[e] /= es; const float sv = ep[e] + br[gi * 8 + e]; if (sv > b0) { b0 = sv; i0 = e; p0 = ep[e]; } }
        int i1 = 0; float b1 = -1e30f, p1 = 0.f;
#pragma unroll
        for (int e = 0; e < 8; ++e) { const float sv = ep[e] + br[gi * 8 + e]; if (e != i0 && sv > b1) { b1 = sv; i1 = e; p1 = ep[e]; } }
        const float den = p0 + p1;
        if (hi == 0) { const int tl = w * 32 + r32; le0[tl] = gi * 8 + i0; le1[tl] = gi * 8 + i1; lw0[tl] = p0 / den * gate; lw1[tl] = p1 / den * gate; }
        __syncthreads();
        int e0 = 0, e1 = 0, q0 = 0, q1 = 0;
        if (C.tid < 256) { e0 = le0[C.tid]; e1 = le1[C.tid]; q0 = atomicAdd(&hist[e0], 1); q1 = atomicAdd(&hist[e1], 1); }
        __syncthreads();
        if (C.tid < 32) base[C.tid] = (int)__hip_atomic_fetch_add(cnt + C.tid * 64, (unsigned)hist[C.tid], __ATOMIC_RELAXED, __HIP_MEMORY_SCOPE_AGENT);
        __syncthreads();
        if (C.tid < 256) { const int tok = chunk * 256 + C.tid;
            const size_t i0_ = (size_t)e0 * NTOK + base[e0] + q0, i1_ = (size_t)e1 * NTOK + base[e1] + q1;
            list[i0_] = 2 * tok; list[i1_] = 2 * tok + 1; listw[i0_] = lw0[C.tid]; listw[i1_] = lw1[C.tid]; }
    }
}

template <bool NM>
__device__ __forceinline__ void ph_attn_da_impl(const Ctx& C, const int cmask) {
    using namespace fa;
    LAS unsigned char* L = (LAS unsigned char*)C.lds;
    constexpr int STG = 32768;
    LAS float* wsf = (LAS float*)(L + 3 * STG) + C.wave * 32;
    const int vcu = ((int)blockIdx.x & 7) * 32 + ((int)blockIdx.x >> 3), xcd = vcu >> 5, grp = (vcu >> 4) & 1, jj = vcu & 15;
    const bf16* Q = (const bf16*)(C.ws + WS_A); const bf16* Kb = Q + (size_t)NTOK * D; const bf16* Vb = Kb + (size_t)NTOK * D; bf16* O = (bf16*)(C.ws + WS_O);
    const float lam = *(const float*)(C.ws + WS_LAM);
    const int lane = C.lane, w = C.wave, c = w >> 2, wq = w & 3, r32 = lane & 31, hi = lane >> 5;
    const float c2 = 0.125f * 1.4426950408889634f;
    for (int u = 0; u < 16; ++u) {
        const int bh = xcd * 32 + 2 * u + grp, b = bh >> 3, h = bh & 7, qb = (u & 1) ? 15 - jj : jj, q0 = qb * 128;
        const size_t rowb = (size_t)b * SEQ;
        const int NT = (q0 + 128) / 64, qw0 = q0 + 32 * wq, T = qw0 >> 6;
        const bf16* sbase = (w < 4) ? Kb + (size_t)((b * 16 + 2 * h) * SEQ) * 64 : Vb + (size_t)((b * 8 + h) * SEQ) * 128;
        const size_t tstep = (w < 4) ? (size_t)64 * 64 : (size_t)64 * 128;
        unsigned soff[4]; int dsto[4];
#pragma unroll
        for (int i = 0; i < 4; ++i) {
            if (w < 4) { const int cm = w >> 1, ch = (w & 1) * 4 + i, krow = 8 * ch + (lane >> 3), kch = (lane & 7) ^ ((krow >> 1) & 7);
                soff[i] = (unsigned)(((cm * SEQ + krow) * 64 + kch * 8) * 2); dsto[i] = cm * 8192 + ch * 1024; }
            else { const int db = w - 4, rg = i; soff[i] = (unsigned)(((rg * 16 + (lane >> 2)) * 128 + db * 32 + (lane & 3) * 8) * 2); dsto[i] = 16384 + db * 4096 + rg * 1024; }
        }
        bf16x8 qf[4];
#pragma unroll
        for (int d0 = 0; d0 < 4; ++d0) qf[d0] = *(const bf16x8*)(Q + ((size_t)((b * 16 + 2 * h + c) * SEQ) + qw0 + r32) * 64 + d0 * 16 + hi * 8);
#pragma unroll
        for (int d0 = 0; d0 < 4; ++d0) asm volatile("" : "+v"(qf[d0]));
        f32x16 o[4];
#pragma unroll
        for (int db = 0; db < 4; ++db)
#pragma unroll
            for (int r = 0; r < 16; ++r) o[db][r] = 0.f;
        float m = 0.f, l = 0.f; f32x16 negm;
#pragma unroll
        for (int r = 0; r < 16; ++r) negm[r] = 0.f;
        asm volatile("s_waitcnt lgkmcnt(0)" ::: "memory"); __builtin_amdgcn_s_barrier();
#pragma unroll
        for (int i = 0; i < 4; ++i) dma16s(sbase, soff[i], L + dsto[i]);
#pragma unroll
        for (int i = 0; i < 4; ++i) dma16s(sbase + tstep, soff[i], L + STG + dsto[i]);
        int sc_ = 0, sn_ = 2;
        for (int t = 0; t < NT; ++t) {
            if (t + 1 < NT) asm volatile("s_waitcnt vmcnt(4) lgkmcnt(0)" ::: "memory"); else asm volatile("s_waitcnt vmcnt(0) lgkmcnt(0)" ::: "memory");
            __builtin_amdgcn_s_barrier();
            if (t + 2 < NT) {
#pragma unroll
                for (int i = 0; i < 4; ++i) dma16s(sbase + (size_t)(t + 2) * tstep, soff[i], L + sn_ * STG + dsto[i]);
            }
            if (t <= T) {
                lds_cptr stg = (lds_cptr)L + sc_ * STG;
                tile<4, 4, NM>(stg + c * 8192, stg + 16384, qf, o, negm, m, l, wsf, t == 0, (t & cmask) == 0, t == T, qw0 - 64 * T + r32, lane);
            }
            sc_ = (sc_ == 2) ? 0 : sc_ + 1; sn_ = (sn_ == 2) ? 0 : sn_ + 1;
        }
        l = half_swap_sum(l);
        if (hi == 0) wsf[r32] = 1.0f / l;
        asm volatile("s_waitcnt lgkmcnt(0)" ::: "memory");
        f32x4 a4[4];
#pragma unroll
        for (int g = 0; g < 4; ++g) a4[g] = *(const LAS f32x4*)(wsf + 8 * g + 4 * hi);
#pragma unroll
        for (int db = 0; db < 4; ++db)
#pragma unroll
            for (int r = 0; r < 16; ++r) o[db][r] *= a4[r >> 2][r & 3];
        asm volatile("s_waitcnt lgkmcnt(0)" ::: "memory"); __builtin_amdgcn_s_barrier();
        LAS float* X = (LAS float*)L + wq * 4352 + lane * 68;
        if (c == 1) {
#pragma unroll
            for (int db = 0; db < 4; ++db)
#pragma unroll
                for (int g = 0; g < 4; ++g) *(LAS f32x4*)(X + db * 16 + 4 * g) = (f32x4){o[db][4 * g], o[db][4 * g + 1], o[db][4 * g + 2], o[db][4 * g + 3]};
        }
        asm volatile("s_waitcnt lgkmcnt(0)" ::: "memory"); __builtin_amdgcn_s_barrier();
        if (c == 0) {
            float gsub[4];
#pragma unroll
            for (int db = 0; db < 4; ++db) gsub[db] = as_global(C.in[I_DA_SUBLN])[db * 32 + r32] * 0.8f;
#pragma unroll
            for (int db = 0; db < 4; ++db)
#pragma unroll
                for (int g = 0; g < 4; ++g) { const f32x4 x = *(const LAS f32x4*)(X + db * 16 + 4 * g);
#pragma unroll
                    for (int j2 = 0; j2 < 4; ++j2) o[db][4 * g + j2] -= lam * x[j2]; }
            float uu[8];
#pragma unroll
            for (int r = 0; r < 8; ++r) {
                const float sa = (o[0][r] * o[0][r] + o[1][r] * o[1][r]) + (o[2][r] * o[2][r] + o[3][r] * o[3][r]);
                const float sb = (o[0][r + 8] * o[0][r + 8] + o[1][r + 8] * o[1][r + 8]) + (o[2][r + 8] * o[2][r + 8] + o[3][r + 8] * o[3][r + 8]);
                auto sw = __builtin_amdgcn_permlane16_swap(__float_as_uint(sa), __float_as_uint(sb), false, false);
                uu[r] = __uint_as_float(sw[0]) + __uint_as_float(sw[1]);
            }
#pragma unroll
            for (int r = 0; r < 8; ++r) {
                uu[r] += __uint_as_float((unsigned)__builtin_amdgcn_update_dpp(0, (int)__float_as_uint(uu[r]), 0x128, 0xF, 0xF, true));
                uu[r] += __uint_as_float((unsigned)__builtin_amdgcn_update_dpp(0, (int)__float_as_uint(uu[r]), 0x124, 0xF, 0xF, true));
                uu[r] += __uint_as_float((unsigned)__builtin_amdgcn_update_dpp(0, (int)__float_as_uint(uu[r]), 0x122, 0xF, 0xF, true));
                uu[r] += __uint_as_float((unsigned)__builtin_amdgcn_update_dpp(0, (int)__float_as_uint(uu[r]), 0x121, 0xF, 0xF, true));
                uu[r] = __builtin_amdgcn_rsqf(uu[r] * (1.0f / 128.0f) + EPS);
            }
            float rs[16];
#pragma unroll
            for (int r = 0; r < 8; ++r) { auto sw = __builtin_amdgcn_permlane16_swap(__float_as_uint(uu[r]), __float_as_uint(uu[r]), false, false); rs[r] = __uint_as_float(sw[0]); rs[r + 8] = __uint_as_float(sw[1]); }
            asm volatile("s_waitcnt lgkmcnt(0)" ::: "memory");
            LAS unsigned char* TT = (LAS unsigned char*)((LAS float*)L + wq * 4352);
#pragma unroll
            for (int r = 0; r < 16; ++r) {
                const unsigned p01 = cvtpk(o[0][r] * (rs[r] * gsub[0]), o[1][r] * (rs[r] * gsub[1])), p23 = cvtpk(o[2][r] * (rs[r] * gsub[2]), o[3][r] * (rs[r] * gsub[3]));
                LAS unsigned short* tp = (LAS unsigned short*)(TT + crow(r, hi) * 272 + r32 * 2);
                tp[0] = (unsigned short)p01; tp[32] = (unsigned short)(p01 >> 16); tp[64] = (unsigned short)p23; tp[96] = (unsigned short)(p23 >> 16);
            }
            asm volatile("s_waitcnt lgkmcnt(0)" ::: "memory");
#pragma unroll
            for (int i = 0; i < 8; ++i) {
                const int row = 4 * i + (lane >> 4);
                const u32x4 v = *(const LAS u32x4*)(TT + row * 272 + (lane & 15) * 16);
                *(u32x4*)(O + (rowb + qw0 + row) * D + h * 128 + (lane & 15) * 8) = v;
            }
        }
    }
}
__device__ __forceinline__ void ph_attn_da_mfma(const Ctx& C) {
    const float c2 = 0.125f * 1.4426950408889634f;
    const float gqm = wave_max(fabsf(as_global(C.in[I_DA_QN])[C.lane])), gkm = wave_max(fabsf(as_global(C.in[I_DA_KN])[C.lane]));
    const float sbnd = 64.0f * gqm * gkm * c2;
    const int cmask = __builtin_amdgcn_readfirstlane((sbnd < 56.0f) ? 3 : 0);
    if (__builtin_amdgcn_readfirstlane(sbnd < 40.0f ? 1 : 0)) ph_attn_da_impl<true>(C, cmask); else ph_attn_da_impl<false>(C, cmask);
}
template <bool NM>
__device__ __forceinline__ void ph_attn_mla_impl(const Ctx& C, const int cmask) {
    using namespace fa;
    LAS unsigned char* L = (LAS unsigned char*)C.lds;
    constexpr int STG = 20480;
    LAS float* wsf = (LAS float*)(L + 3 * STG) + C.wave * 32;
    const int vcu = ((int)blockIdx.x & 7) * 32 + ((int)blockIdx.x >> 3), xcd = vcu >> 5, grp = (vcu >> 3) & 3, jj = vcu & 7;
    const bf16* Q2 = (const bf16*)(C.ws + WS_A); const bf16* KV2 = (const bf16*)(C.ws + WS_A + 192 * MiB);
    const bf16* KPE = (const bf16*)(C.ws + WS_KPE); bf16* O = (bf16*)(C.ws + WS_O);
    const int lane = C.lane, w = C.wave, r32 = lane & 31, hi = lane >> 5;
    const float c2 = 0.10206207261596575f * 1.4426950408889634f;
    for (int u = 0; u < 16; ++u) {
        const int bh = xcd * 64 + 4 * u + grp, b = bh >> 4, h = bh & 15, qb = (u & 1) ? 7 - jj : jj, q0 = qb * 256;
        const size_t rowb = (size_t)b * SEQ;
        const int NT = (q0 + 256) / 64, qw0 = q0 + 32 * w, T = qw0 >> 6;
        const bf16* src[3]; int dsto[3]; size_t sstep[3];
#pragma unroll
        for (int i = 0; i < 3; ++i) {
            const int pi = w + 8 * i;
            if (pi < 8) { const int krow = 8 * pi + (lane >> 3), kch = (lane & 7) ^ ((krow >> 1) & 7); src[i] = KV2 + ((size_t)bh * SEQ + krow) * 128 + kch * 8; dsto[i] = pi * 1024; sstep[i] = (size_t)64 * 128; }
            else if (pi < 12) { src[i] = KPE + (rowb + lane) * 32 + (pi - 8) * 8; dsto[i] = pi * 1024; sstep[i] = (size_t)64 * 32; }
            else { const int db = (pi - 12) >> 2, rg = (pi - 12) & 3; src[i] = KV2 + ((size_t)bh * SEQ + rg * 16 + (lane >> 2)) * 128 + 64 + db * 32 + (lane & 3) * 8; dsto[i] = 12288 + db * 4096 + rg * 1024; sstep[i] = (size_t)64 * 128; }
        }
        const bool has3 = (w + 16) < 20;
        bf16x8 qf[6];
#pragma unroll
        for (int d0 = 0; d0 < 6; ++d0) qf[d0] = (d0 < 4) ? *(const bf16x8*)(Q2 + ((size_t)bh * SEQ + qw0 + r32) * 64 + d0 * 16 + hi * 8)
                                                         : *(const bf16x8*)(Q2 + (size_t)NTOK * 1024 + ((size_t)bh * SEQ + qw0 + r32) * 32 + (d0 - 4) * 16 + hi * 8);
#pragma unroll
        for (int d0 = 0; d0 < 6; ++d0) asm volatile("" : "+v"(qf[d0]));
        f32x16 o[2];
#pragma unroll
        for (int db = 0; db < 2; ++db)
#pragma unroll
            for (int r = 0; r < 16; ++r) o[db][r] = 0.f;
        float m = 0.f, l = 0.f; f32x16 negm;
#pragma unroll
        for (int r = 0; r < 16; ++r) negm[r] = 0.f;
        asm volatile("s_waitcnt lgkmcnt(0)" ::: "memory"); __builtin_amdgcn_s_barrier();
        dma16(src[0], L + dsto[0]); dma16(src[1], L + dsto[1]); if (has3) dma16(src[2], L + dsto[2]);
        for (int t = 0; t < NT; ++t) {
            asm volatile("s_waitcnt vmcnt(0) lgkmcnt(0)" ::: "memory");
            __builtin_amdgcn_s_barrier();
            if (t + 1 < NT) {
                LAS unsigned char* nb = L + ((t + 1) & 1) * STG;
                dma16(src[0] + (t + 1) * sstep[0], nb + dsto[0]); dma16(src[1] + (t + 1) * sstep[1], nb + dsto[1]); if (has3) dma16(src[2] + (t + 1) * sstep[2], nb + dsto[2]);
            }
            if (t <= T) {
                lds_cptr stg = (lds_cptr)L + (t & 1) * STG;
                tile<6, 2, NM>(stg, stg + 12288, qf, o, negm, m, l, wsf, t == 0, (t & cmask) == 0, t == T, qw0 - 64 * T + r32, lane);
            }
        }
        l = half_swap_sum(l);
        if (hi == 0) wsf[r32] = 1.0f / l;
        asm volatile("s_waitcnt lgkmcnt(0)" ::: "memory");
        f32x4 a4[4];
#pragma unroll
        for (int g = 0; g < 4; ++g) a4[g] = *(const LAS f32x4*)(wsf + 8 * g + 4 * hi);
        LAS unsigned char* TT = L + 65536 + w * 4608;
#pragma unroll
        for (int r = 0; r < 16; ++r) {
            const unsigned pk = cvtpk(o[0][r] * a4[r >> 2][r & 3], o[1][r] * a4[r >> 2][r & 3]);
            LAS unsigned short* tp = (LAS unsigned short*)(TT + crow(r, hi) * 144 + r32 * 2);
            tp[0] = (unsigned short)pk; tp[32] = (unsigned short)(pk >> 16);
        }
        asm volatile("s_waitcnt lgkmcnt(0)" ::: "memory");
#pragma unroll
        for (int i = 0; i < 4; ++i) {
            const int row = 8 * i + (lane >> 3);
            const u32x4 v = *(const LAS u32x4*)(TT + row * 144 + (lane & 7) * 16);
            *(u32x4*)(O + (rowb + qw0 + row) * D + h * 64 + (lane & 7) * 8) = v;
        }
    }
}

__device__ __forceinline__ void ph_attn_mla_mfma(const Ctx& C) {
    const float c2 = 0.10206207261596575f * 1.4426950408889634f;
    const float gqn = wave_max(fabsf(as_global(C.in[I_M_QNN])[C.lane])), gkn = wave_max(fabsf(as_global(C.in[I_M_KNN])[C.lane]));
    const float gqp = wave_max(fabsf(as_global(C.in[I_M_QPN])[C.lane & 31])), gkp = wave_max(fabsf(as_global(C.in[I_M_KPN])[C.lane & 31]));
    const float sbnd = (64.0f * gqn * gkn + 32.0f * gqp * gkp) * c2;
    const int cmask = __builtin_amdgcn_readfirstlane((sbnd < 56.0f) ? 3 : 0);
    if (__builtin_amdgcn_readfirstlane(sbnd < 40.0f ? 1 : 0)) ph_attn_mla_impl<true>(C, cmask); else ph_attn_mla_impl<false>(C, cmask);
}

__global__ void __launch_bounds__(NTHR, 2) fwd(Args args) {
    extern __shared__ __attribute__((aligned(16))) unsigned char lds[];
    Ctx C; C.in = args.in; C.out = args.out; C.ws = args.ws; C.lds = lds;
    C.tid = threadIdx.x; C.lane = C.tid & 63; C.wave = __builtin_amdgcn_readfirstlane(C.tid >> 6);
    C.gw = blockIdx.x * NWAVES + C.wave; C.ngw = gridDim.x * NWAVES;
    const Ctx C0 = C;
    volatile LAS unsigned* MISC = (volatile LAS unsigned*)((LAS unsigned char*)lds + MISC_OFF);
    if (C.tid < 32) MISC[C.tid] = 0u;
    __syncthreads();
    XcdBarrier bar; bar.bar = (unsigned*)(args.ws + WS_CTL) + CW_BAR; bar.x = 0; bar.st = nullptr;
    const int lo = args.ph_lo, hi = args.ph_hi;
    if (hi - lo > 1) bar = xcd_barrier_post((unsigned*)(args.ws + WS_CTL) + CW_BAR, MISC + 8);
#ifndef REPMASK
#define REPMASK 0u
#endif
#ifndef PHMASK
#define PHMASK 0xFFFFFFFFu
#endif
#define IN(k) (lo <= (k) && (k) < hi && ((PHMASK >> (k)) & 1u))
#define SEAM(k) do { if (IN(k) && IN((k) + 1)) xcd_barrier(bar); } while (0)
#define PHLOCAL unsigned char* ws = args.ws; asm volatile("" : "+s"(ws)); ws = as_global(ws); int t_ = threadIdx.x; asm volatile("" : "+v"(t_)); Ctx C = C0; C.ws = ws; C.tid = t_; C.lane = t_ & 63; \
        bf16* H = (bf16*)(ws + WS_H); bf16* O = (bf16*)(ws + WS_O); bf16* A0 = (bf16*)(ws + WS_A); (void)H; (void)O; (void)A0;

    if (IN(0)) { PHLOCAL ph_prologue(C); } SEAM(0);
    if (IN(1)) { PHLOCAL ph_normmod0(C); } SEAM(1);
    if (IN(2)) { PHLOCAL
        pg8::Gemm g{H, (const bf16*)(ws + WB_QKV), NTOK, 3 * D, D}; pg8::StaticOrder S; S.init(NTOK, 3 * D, (int)gridDim.x, (int)blockIdx.x);
        pg8::EpiQKV E{A0, A0 + (size_t)NTOK * D, A0 + (size_t)2 * NTOK * D, (const float*)(ws + WS_COSD), (const float*)(ws + WS_SIND), as_global(args.in[I_DA_QN]), as_global(args.in[I_DA_KN]), 0.125f * 1.4426950408889634f, EPS};
        pg8::gemm_phase<pg8::EpiQKV, pg8::StaticOrder, PG8_ALIGN, PG8_SP2>((PG8_LAS unsigned char*)lds, g, S, E);
    } SEAM(2);
    if (IN(3)) { PHLOCAL ph_attn_da_mfma(C); } SEAM(3);
    if (IN(4)) { PHLOCAL
        pg8::Gemm g{O, (const bf16*)(ws + WB_DAO), NTOK, D, D}; pg8::StaticOrder S; S.init(NTOK, D, (int)gridDim.x, (int)blockIdx.x);
        pg8::EpiResid<true> E{as_global(args.in[I_X]), (bf16*)(ws + WS_XB), C.mod(0, 0, 2), (float*)(ws + WS_SSQX)};
        pg8::gemm_phase<pg8::EpiResid<true>, pg8::StaticOrder, PG8_ALIGN, PG8_SP2>((PG8_LAS unsigned char*)lds, g, S, E);
    } SEAM(4);
    if (IN(5)) { PHLOCAL ph_route(C, 0); } SEAM(5);
    if (IN(6)) { PHLOCAL ph_moe1_mfma(C, 0); } SEAM(6);
    if (IN(7)) { PHLOCAL ph_moe2_mfma(C, 0, IN(6)); } SEAM(7);
    if (IN(8)) { PHLOCAL ph_comb<false>(C, ws + WS_A + 128 * MiB, C.mod(0, 0, 5), 1, as_global(args.in[I_NMIX]) + D); } SEAM(8);
    if (IN(9)) { PHLOCAL
        bf16* CQ = (bf16*)(ws + WS_S); bf16* CKV = CQ + (size_t)NTOK * 384; bf16* KPE = (bf16*)(ws + WS_KPE);
        pg8::Gemm g{H, (const bf16*)(ws + WB_WIN), NTOK, 768, D}; pg8::StaticOrder S; S.init(NTOK, 768, (int)gridDim.x, (int)blockIdx.x);
        pg8::EpiWin E{CQ, CKV, KPE, (float*)(ws + WS_SSQ), (const float*)(ws + WS_COSM), (const float*)(ws + WS_SINM), as_global(args.in[I_M_KPN]), EPS, (PG8_LAS float*)((PG8_LAS unsigned char*)lds + 135168)};
        pg8::gemm_phase<pg8::EpiWin, pg8::StaticOrder, PG8_ALIGN, PG8_SP2>((PG8_LAS unsigned char*)lds, g, S, E);
    } SEAM(9);
    if (IN(10)) { PHLOCAL
        const bf16* CQ = (const bf16*)(ws + WS_S); const bf16* CKV = CQ + (size_t)NTOK * 384;
        int Kq = 384, Kkv = 256; asm volatile("" : "+s"(Kq), "+s"(Kkv));
        { pg8::Gemm g{CQ, (const bf16*)(ws + WB_WUQ), NTOK, 1536, Kq}; pg8::StaticOrder S; S.init(NTOK, 1536, (int)gridDim.x, (int)blockIdx.x);
          pg8::EpiUQ E{A0, (const float*)(ws + WS_SSQ), (const float*)(ws + WS_COSM), (const float*)(ws + WS_SINM), as_global(args.in[I_M_QNN]), as_global(args.in[I_M_QPN]), 0.10206207261596575f * 1.4426950408889634f, EPS};
          pg8::gemm_phase<pg8::EpiUQ, pg8::StaticOrder, PG8_ALIGN, PG8_SP2>((PG8_LAS unsigned char*)lds, g, S, E); }
        { pg8::Gemm g{CKV, (const bf16*)(ws + WB_WUKV), NTOK, 2048, Kkv}; pg8::StaticOrder S; S.init(NTOK, 2048, (int)gridDim.x, (int)blockIdx.x);
          pg8::EpiUKV E{(bf16*)(ws + WS_A + 192 * MiB), as_global(args.in[I_M_KNN]), EPS};
          pg8::gemm_phase<pg8::EpiUKV, pg8::StaticOrder, PG8_ALIGN, PG8_SP2>((PG8_LAS unsigned char*)lds, g, S, E); }
    } SEAM(10);
    if (IN(11)) { PHLOCAL ph_attn_mla_mfma(C); } SEAM(11);
    if (IN(12)) { PHLOCAL
        pg8::Gemm g{O, (const bf16*)(ws + WB_MLO), NTOK, D, D}; pg8::StaticOrder S; S.init(NTOK, D, (int)gridDim.x, (int)blockIdx.x);
        pg8::EpiResid<false> E{ws + WS_XB, (bf16*)(ws + WS_XB), C.mod(1, 0, 2), (float*)(ws + WS_SSQX)};
        pg8::gemm_phase<pg8::EpiResid<false>, pg8::StaticOrder, PG8_ALIGN, PG8_SP2>((PG8_LAS unsigned char*)lds, g, S, E);
    } SEAM(12);
    if (IN(13)) { PHLOCAL ph_route(C, 1); } SEAM(13);
    if (IN(14)) { PHLOCAL ph_moe1_mfma(C, 1); } SEAM(14);
    if (IN(15)) { PHLOCAL ph_moe2_mfma(C, 1, IN(14)); } SEAM(15);
    if (IN(16)) { PHLOCAL ph_comb<true>(C, ws + WS_A + 128 * MiB, C.mod(1, 0, 5), 1, as_global(args.in[I_NMIX])); }
#undef IN
#undef SEAM
}

extern "C" void kernel_launch(void* const* d_in, const int* in_sizes, int n_in, void* d_out, int out_size, void* d_ws, size_t ws_size, hipStream_t stream) {
    static int grid = 0;
    if (grid == 0) {
        if (n_in != 33 || out_size != NTOK * D || ws_size < WS_END) { fprintf(stderr, "kernel_launch: unexpected shapes n_in %d out %d ws %zu\n", n_in, out_size, ws_size); grid = -1; return; }
        int dev = 0, cus = 0;
        if (hipGetDevice(&dev) != hipSuccess || hipDeviceGetAttribute(&cus, hipDeviceAttributeMultiprocessorCount, dev) != hipSuccess) { grid = -1; return; }
        if (hipFuncSetAttribute((const void*)fwd, hipFuncAttributeMaxDynamicSharedMemorySize, LDS_BYTES) != hipSuccess) { fprintf(stderr, "hipFuncSetAttribute failed\n"); grid = -1; return; }
        (void)hipGetLastError();
        grid = cus;
        if (grid != 256) { fprintf(stderr, "kernel_launch: built for 256 CUs, device reports %d\n", cus); grid = -1; return; }
    }
    if (grid < 0) return;
    (void)hipMemsetAsync((char*)d_ws + WS_CTL, 0, CTL_ZERO_BYTES, stream);
    Args a{};
    for (int i = 0; i < 33; ++i) a.in[i] = (const float*)d_in[i];
    a.out = (float*)d_out; a.ws = (unsigned char*)d_ws;
#if MK_ONE_LAUNCH
    a.ph_lo = 0; a.ph_hi = N_PHASES;
    hipLaunchKernelGGL(fwd, dim3(grid), dim3(NTHR), LDS_BYTES, stream, a);
#else
    for (int p = 0; p < N_PHASES; ++p) { a.ph_lo = p; a.ph_hi = p + 1; hipLaunchKernelGGL(fwd, dim3(grid), dim3(NTHR), LDS_BYTES, stream, a); }
#endif
}
```
